# Optimizing an MI355X kernel written in HIP

```python
import math
import jax
import jax.numpy as jnp
from jax import lax
import numpy as np

D_MODEL = 1024
BATCH = 4
SEQ = 4096
DEPTH = 2

GRID_W = 64
CTX_LEN = 256
HEAD_DIM = 64
EPS = 1e-6
S5_WIDTH = 512
S5_GROUP = 16
S5_GROUPS = S5_WIDTH // S5_GROUP
S5_STATE = 64
NA_HEADS = 8
NA_WIDTH = NA_HEADS * HEAD_DIM
NA_ROWS = 8
NA_COLS = 16
LRU_WIDTH = 512
LRU_BLOCKS = 8
LRU_BLOCK = LRU_WIDTH // LRU_BLOCKS
LRU_CONV = 4
LRU_CONV_PAD = (1, 2)
LRU_C = 8.0
GQA_HEADS = 8
GQA_KV_HEADS = 2
GQA_WIDTH = GQA_HEADS * HEAD_DIM
GQA_KV_WIDTH = GQA_KV_HEADS * HEAD_DIM
Q_BLOCK = 128
ROPE_THETA = 10000.0
N_EVEN = (DEPTH + 1) // 2
N_ODD = DEPTH // 2
EVEN_SPLITS = (S5_WIDTH, 2 * S5_WIDTH, 2 * S5_WIDTH + NA_WIDTH, 2 * S5_WIDTH + 2 * NA_WIDTH, 2 * S5_WIDTH + 3 * NA_WIDTH)
EVEN_IN = 2 * S5_WIDTH + 4 * NA_WIDTH
EVEN_MIX = S5_WIDTH + NA_WIDTH
ODD_SPLITS = (LRU_WIDTH, 2 * LRU_WIDTH, 2 * LRU_WIDTH + GQA_WIDTH, 2 * LRU_WIDTH + GQA_WIDTH + GQA_KV_WIDTH, 2 * LRU_WIDTH + GQA_WIDTH + 2 * GQA_KV_WIDTH)
ODD_IN = 2 * LRU_WIDTH + 2 * GQA_WIDTH + 2 * GQA_KV_WIDTH
ODD_MIX = LRU_WIDTH + GQA_WIDTH

kernel_name = "hybrid_s5_natten_rglru_gqa_prefix_dit"

F32 = jnp.float32


def rms_norm(x, g):
    xf = x.astype(F32)
    y = xf * lax.rsqrt(jnp.mean(xf * xf, axis=-1, keepdims=True) + EPS)
    return (y * g.astype(F32)).astype(x.dtype)


def heads(t, n):
    return t.reshape(*t.shape[:-1], n, HEAD_DIM)


def linear_scan(a, b, h0, reverse):
    first = -1 if reverse else 0
    b = b.at[:, first].add(a[:, first] * h0)

    def combine(left, right):
        a_l, b_l = left
        a_r, b_r = right
        return a_r * a_l, a_r * b_l + b_r

    _, h = lax.associative_scan(combine, (a, b), axis=1, reverse=reverse)
    return h


def s5_states(u, h0s, lam_re, lam_im, log_dt, b_re, b_im):
    bsz, length, _ = u.shape
    ug = u.astype(F32).reshape(bsz, length, S5_GROUPS, S5_GROUP).astype(jnp.complex64)
    hs, finals = [], []
    for dirn in range(2):
        lam = lax.complex(lam_re[dirn].astype(F32), lam_im[dirn].astype(F32))
        dt = jnp.exp(log_dt[dirn].astype(F32))[:, None]
        lam_bar = jnp.exp(lam * dt)
        b = lax.complex(b_re[dirn].astype(F32), b_im[dirn].astype(F32))
        b_bar = ((lam_bar - 1.0) / lam)[..., None] * b
        bu = jnp.einsum('blgh,gph->blgp', ug, b_bar)
        a = jnp.broadcast_to(lam_bar, bu.shape)
        h = linear_scan(a, bu, h0s[dirn], reverse=(dirn == 1))
        hs.append(h)
        finals.append(h[:, 0] if dirn == 1 else h[:, -1])
    return hs, finals


def s5_readout(u, hs, c_re, c_im, d_skip, w_glu, b_glu):
    bsz, length, width = u.shape
    y = d_skip.astype(F32) * u.astype(F32)
    for dirn in range(2):
        cm = lax.complex(c_re[dirn].astype(F32), c_im[dirn].astype(F32))
        y = y + jnp.einsum('blgp,ghp->blgh', hs[dirn], cm).real.reshape(bsz, length, width)
    y = jax.nn.gelu(y)
    y = y * jax.nn.sigmoid(y @ w_glu.astype(F32) + b_glu.astype(F32))
    return y.astype(u.dtype)


def neighbourhood_attention(q, k, v, k_ctx, v_ctx, rel_bias):
    bsz, length, n_h, dh = q.shape
    rows = length // GRID_W
    kr = min(NA_ROWS, rows)
    kc = NA_COLS
    scale = dh ** -0.5
    qg = q.reshape(bsz, rows, GRID_W, n_h, dh)
    kg = k.reshape(bsz, rows, GRID_W, n_h, dh)
    vg = v.reshape(bsz, rows, GRID_W, n_h, dh)
    col = jnp.arange(GRID_W)
    col_idx = jnp.clip(col - kc // 2, 0, GRID_W - kc)[:, None] + jnp.arange(kc)[None, :]
    dc = col_idx - col[:, None] + (NA_COLS - 1)

    def one_row(r):
        row_start = jnp.clip(r - kr // 2, 0, rows - kr)
        k_win = lax.dynamic_slice_in_dim(kg, row_start, kr, axis=1)[:, :, col_idx]
        v_win = lax.dynamic_slice_in_dim(vg, row_start, kr, axis=1)[:, :, col_idx]
        q_r = lax.dynamic_index_in_dim(qg, r, axis=1, keepdims=False)
        dr = row_start + jnp.arange(kr) - r + (NA_ROWS - 1)
        bias = rel_bias[:, dr][:, :, dc].transpose(0, 2, 1, 3).astype(F32)
        s_loc = jnp.einsum('bwhd,brwjhd->bhwrj', q_r, k_win).astype(F32) * scale + bias[None]
        s_ctx = jnp.einsum('bwhd,bchd->bhwc', q_r, k_ctx).astype(F32) * scale
        s = jnp.concatenate([s_loc.reshape(bsz, n_h, GRID_W, kr * kc), s_ctx], axis=-1)
        p = jax.nn.softmax(s, axis=-1).astype(v.dtype)
        p_loc = p[..., :kr * kc].reshape(bsz, n_h, GRID_W, kr, kc)
        o = jnp.einsum('bhwrj,brwjhd->bwhd', p_loc, v_win) + jnp.einsum('bhwc,bchd->bwhd', p[..., kr * kc:], v_ctx)
        return o

    out = lax.map(one_row, jnp.arange(rows))
    return out.transpose(1, 0, 2, 3, 4).reshape(bsz, length, n_h * dh)


def context_attention(q, k, v):
    bsz, lc, hq, dh = q.shape
    hkv = k.shape[2]
    qg = q.reshape(bsz, lc, hkv, hq // hkv, dh)
    s = jnp.einsum('bqkgd,bskd->bkgqs', qg, k).astype(F32) * dh ** -0.5
    p = jax.nn.softmax(s, axis=-1).astype(v.dtype)
    return jnp.einsum('bkgqs,bskd->bqkgd', p, v).reshape(bsz, lc, hq * dh)


def centred_depthwise_conv(x, w, b):
    y = lax.conv_general_dilated(x, w[:, None, :], window_strides=(1,), padding=[LRU_CONV_PAD],
                                 dimension_numbers=('NWC', 'WIO', 'NWC'), feature_group_count=x.shape[-1])
    return y + b


def rglru_states(x, h0s, lam, w_a, b_a, w_x, b_x):
    bsz, length, width = x.shape
    xf = x.astype(F32)
    xb = xf.reshape(bsz, length, LRU_BLOCKS, LRU_BLOCK)
    hs, finals = [], []
    for dirn in range(2):
        gate_r = jax.nn.sigmoid(jnp.einsum('blni,nij->blnj', xb, w_a[dirn].astype(F32)).reshape(bsz, length, width) + b_a[dirn].astype(F32))
        gate_i = jax.nn.sigmoid(jnp.einsum('blni,nij->blnj', xb, w_x[dirn].astype(F32)).reshape(bsz, length, width) + b_x[dirn].astype(F32))
        log_a = -LRU_C * gate_r * jax.nn.softplus(-lam[dirn].astype(F32))
        a = jnp.exp(log_a)
        mult = jnp.sqrt(jnp.maximum(-jnp.expm1(2.0 * log_a), 0.0))
        h = linear_scan(a, mult * gate_i * xf, h0s[dirn], reverse=(dirn == 1))
        hs.append(h)
        finals.append(h[:, 0] if dirn == 1 else h[:, -1])
    return hs, finals


def axial_rope_tables(n_tokens):
    t = jnp.arange(n_tokens)
    row = (t // GRID_W).astype(F32)
    col = (t % GRID_W).astype(F32)
    half = HEAD_DIM // 2
    inv = ROPE_THETA ** (-jnp.arange(0, half, 2, dtype=F32) / half)
    ang = jnp.concatenate([row[:, None] * inv, col[:, None] * inv], axis=-1)
    return jnp.cos(ang), jnp.sin(ang)


def apply_rope(x, cos, sin):
    xf = x.astype(F32)
    x1, x2 = xf[..., 0::2], xf[..., 1::2]
    cs, sn = cos[None, :, None, :], sin[None, :, None, :]
    return jnp.stack([x1 * cs - x2 * sn, x1 * sn + x2 * cs], axis=-1).reshape(x.shape).astype(x.dtype)


def gqa_latent(q, k, v, k_ctx, v_ctx):
    bsz, length, hq, dh = q.shape
    g = hq // GQA_KV_HEADS
    k_all = jnp.concatenate([k_ctx, k], axis=1)
    v_all = jnp.concatenate([v_ctx, v], axis=1)
    nb = length // Q_BLOCK
    qb = jnp.moveaxis(q.reshape(bsz, nb, Q_BLOCK, GQA_KV_HEADS, g, dh), 1, 0)
    scale = dh ** -0.5

    def block(q_blk):
        s = jnp.einsum('bqkgd,bskd->bkgqs', q_blk, k_all).astype(F32) * scale
        p = jax.nn.softmax(s, axis=-1).astype(v.dtype)
        return jnp.einsum('bkgqs,bskd->bqkgd', p, v_all)

    o = lax.map(block, qb)
    return jnp.moveaxis(o, 0, 1).reshape(bsz, length, hq * dh)


def even_layer(xl, xc, w_in, w_out, lam_re, lam_im, log_dt, b_re, b_im, c_re, c_im, d_skip, w_glu, b_glu, rel_bias, ctx_out):
    bsz = xl.shape[0]
    u_l, ga_l, q_l, k_l, v_l, gb_l = jnp.split(xl @ w_in, list(EVEN_SPLITS), axis=-1)
    u_c, ga_c, q_c, k_c, v_c, gb_c = jnp.split(xc @ w_in, list(EVEN_SPLITS), axis=-1)
    zero = jnp.zeros((bsz, S5_GROUPS, S5_STATE), jnp.complex64)
    hs_c, fin_c = s5_states(u_c, (zero, zero), lam_re, lam_im, log_dt, b_re, b_im)
    hs_l, _ = s5_states(u_l, fin_c, lam_re, lam_im, log_dt, b_re, b_im)
    y_a = s5_readout(u_l, hs_l, c_re, c_im, d_skip, w_glu, b_glu) * jax.nn.silu(ga_l)
    kc, vc = heads(k_c, NA_HEADS), heads(v_c, NA_HEADS)
    y_b = neighbourhood_attention(heads(q_l, NA_HEADS), heads(k_l, NA_HEADS), heads(v_l, NA_HEADS), kc, vc, rel_bias) * jax.nn.silu(gb_l)
    out_l = jnp.concatenate([y_a, y_b], axis=-1) @ w_out
    if not ctx_out:
        return out_l, None
    y_ac = s5_readout(u_c, hs_c, c_re, c_im, d_skip, w_glu, b_glu) * jax.nn.silu(ga_c)
    y_bc = context_attention(heads(q_c, NA_HEADS), kc, vc) * jax.nn.silu(gb_c)
    out_c = jnp.concatenate([y_ac, y_bc], axis=-1) @ w_out
    return out_l, out_c


def odd_layer(xl, xc, w_in, w_out, conv_w, conv_b, lam, w_a, b_a, w_x, b_x, q_norm, k_norm, ctx_out):
    bsz, length, _ = xl.shape
    x_l, gc_l, q_l, k_l, v_l, gd_l = jnp.split(xl @ w_in, list(ODD_SPLITS), axis=-1)
    x_c, gc_c, q_c, k_c, v_c, gd_c = jnp.split(xc @ w_in, list(ODD_SPLITS), axis=-1)
    zero = jnp.zeros((bsz, LRU_WIDTH), F32)
    hs_c, fin_c = rglru_states(centred_depthwise_conv(x_c, conv_w, conv_b), (zero, zero), lam, w_a, b_a, w_x, b_x)
    hs_l, _ = rglru_states(centred_depthwise_conv(x_l, conv_w, conv_b), fin_c, lam, w_a, b_a, w_x, b_x)
    y_c = (hs_l[0] + hs_l[1]).astype(xl.dtype) * jax.nn.silu(gc_l)
    cos, sin = axial_rope_tables(length)
    q = apply_rope(rms_norm(heads(q_l, GQA_HEADS), q_norm), cos, sin)
    k = apply_rope(rms_norm(heads(k_l, GQA_KV_HEADS), k_norm), cos, sin)
    kc = rms_norm(heads(k_c, GQA_KV_HEADS), k_norm)
    vc = heads(v_c, GQA_KV_HEADS)
    y_d = gqa_latent(q, k, heads(v_l, GQA_KV_HEADS), kc, vc) * jax.nn.silu(gd_l)
    out_l = jnp.concatenate([y_c, y_d], axis=-1) @ w_out
    if not ctx_out:
        return out_l, None
    y_cc = (hs_c[0] + hs_c[1]).astype(xc.dtype) * jax.nn.silu(gc_c)
    y_dc = context_attention(rms_norm(heads(q_c, GQA_HEADS), q_norm), kc, vc) * jax.nn.silu(gd_c)
    out_c = jnp.concatenate([y_cc, y_dc], axis=-1) @ w_out
    return out_l, out_c


def setup_inputs(seed: int = 0) -> dict:
    key = jax.random.key(seed)
    ks = jax.random.split(key, 32)
    d = D_MODEL
    g, p, hgrp = S5_GROUPS, S5_STATE, S5_GROUP

    def nrm(k, shape, s):
        return jax.random.normal(k, shape, F32) * s

    lru_u = jax.random.uniform(ks[25], (N_ODD, 2, LRU_WIDTH), F32, 0.9, 0.999)
    lru_p = lru_u ** (1.0 / LRU_C)
    return {
        "x": nrm(ks[0], (BATCH, SEQ, d), 1.0),
        "c": nrm(ks[1], (BATCH, d), 1.0),
        "ctx": nrm(ks[2], (BATCH, CTX_LEN, d), 1.0),
        "c_ctx": nrm(ks[3], (d,), 1.0),
        "ada_w": nrm(ks[4], (DEPTH, d, 3 * d), 0.5 * d ** -0.5),
        "ada_b": nrm(ks[5], (DEPTH, 3 * d), 0.02),
        "pre_g": 1.0 + nrm(ks[6], (DEPTH, d), 0.05),
        "post_g": 1.0 + nrm(ks[7], (DEPTH, d), 0.05),
        "ev_w_in": nrm(ks[8], (N_EVEN, d, EVEN_IN), d ** -0.5),
        "ev_w_out": nrm(ks[9], (N_EVEN, EVEN_MIX, d), EVEN_MIX ** -0.5),
        "s5_lam_re": -0.5 * jnp.exp(nrm(ks[10], (N_EVEN, 2, g, p), 0.1)),
        "s5_lam_im": math.pi * jnp.arange(p, dtype=F32) + nrm(ks[11], (N_EVEN, 2, g, p), 0.05),
        "s5_log_dt": jax.random.uniform(ks[12], (N_EVEN, 2, g), F32, math.log(1e-3), math.log(1e-1)),
        "s5_b_re": nrm(ks[13], (N_EVEN, 2, g, p, hgrp), (2 * hgrp) ** -0.5),
        "s5_b_im": nrm(ks[14], (N_EVEN, 2, g, p, hgrp), (2 * hgrp) ** -0.5),
        "s5_c_re": nrm(ks[15], (N_EVEN, 2, g, hgrp, p), p ** -0.5),
        "s5_c_im": nrm(ks[16], (N_EVEN, 2, g, hgrp, p), p ** -0.5),
        "s5_d": nrm(ks[17], (N_EVEN, S5_WIDTH), 1.0),
        "s5_w_glu": nrm(ks[18], (N_EVEN, S5_WIDTH, S5_WIDTH), S5_WIDTH ** -0.5),
        "s5_b_glu": nrm(ks[19], (N_EVEN, S5_WIDTH), 0.02),
        "na_rel_bias": nrm(ks[20], (N_EVEN, NA_HEADS, 2 * NA_ROWS - 1, 2 * NA_COLS - 1), 0.1),
        "od_w_in": nrm(ks[21], (N_ODD, d, ODD_IN), d ** -0.5),
        "od_w_out": nrm(ks[22], (N_ODD, ODD_MIX, d), ODD_MIX ** -0.5),
        "lru_conv_w": nrm(ks[23], (N_ODD, LRU_CONV, LRU_WIDTH), LRU_CONV ** -0.5),
        "lru_conv_b": nrm(ks[24], (N_ODD, LRU_WIDTH), 0.02),
        "lru_lam": jnp.log(lru_p) - jnp.log1p(-lru_p),
        "lru_w_a": nrm(ks[26], (N_ODD, 2, LRU_BLOCKS, LRU_BLOCK, LRU_BLOCK), LRU_BLOCK ** -0.5),
        "lru_b_a": nrm(ks[27], (N_ODD, 2, LRU_WIDTH), 0.02),
        "lru_w_x": nrm(ks[28], (N_ODD, 2, LRU_BLOCKS, LRU_BLOCK, LRU_BLOCK), LRU_BLOCK ** -0.5),
        "lru_b_x": nrm(ks[29], (N_ODD, 2, LRU_WIDTH), 0.02),
        "gqa_q_norm": 1.0 + nrm(ks[30], (N_ODD, HEAD_DIM), 0.05),
        "gqa_k_norm": 1.0 + nrm(ks[31], (N_ODD, HEAD_DIM), 0.05),
    }


def reference(x, c, ctx, c_ctx, ada_w, ada_b, pre_g, post_g,
              ev_w_in, ev_w_out, s5_lam_re, s5_lam_im, s5_log_dt, s5_b_re, s5_b_im, s5_c_re, s5_c_im,
              s5_d, s5_w_glu, s5_b_glu, na_rel_bias,
              od_w_in, od_w_out, lru_conv_w, lru_conv_b, lru_lam, lru_w_a, lru_b_a, lru_w_x, lru_b_x,
              gqa_q_norm, gqa_k_norm):
    h_lat, h_ctx = x, ctx
    for i in range(DEPTH):
        j = i // 2
        last = i == DEPTH - 1
        sh_l, sc_l, gt_l = jnp.split(jax.nn.silu(c) @ ada_w[i] + ada_b[i], 3, axis=-1)
        sh_c, sc_c, gt_c = jnp.split(jax.nn.silu(c_ctx) @ ada_w[i] + ada_b[i], 3, axis=-1)
        xl = rms_norm(h_lat, pre_g[i]) * (1.0 + sc_l[:, None]) + sh_l[:, None]
        xc = rms_norm(h_ctx, pre_g[i]) * (1.0 + sc_c) + sh_c
        if i % 2 == 0:
            out_l, out_c = even_layer(xl, xc, ev_w_in[j], ev_w_out[j], s5_lam_re[j], s5_lam_im[j], s5_log_dt[j],
                                      s5_b_re[j], s5_b_im[j], s5_c_re[j], s5_c_im[j], s5_d[j], s5_w_glu[j],
                                      s5_b_glu[j], na_rel_bias[j], not last)
        else:
            out_l, out_c = odd_layer(xl, xc, od_w_in[j], od_w_out[j], lru_conv_w[j], lru_conv_b[j], lru_lam[j],
                                     lru_w_a[j], lru_b_a[j], lru_w_x[j], lru_b_x[j], gqa_q_norm[j], gqa_k_norm[j],
                                     not last)
        h_lat = h_lat + gt_l[:, None] * rms_norm(out_l, post_g[i])
        if not last:
            h_ctx = h_ctx + gt_c * rms_norm(out_c, post_g[i])
    return h_lat
```

```cpp
#include <hip/hip_runtime.h>
#include <cstdint>
#include <cstdio>

typedef unsigned short bf16_t;
#define DI __device__ __forceinline__
DI float bf2f(bf16_t v) { return __uint_as_float((unsigned)v << 16); }
DI bf16_t f2bf(float f) { unsigned u = __float_as_uint(f); return (bf16_t)((u + 0x7fffu + ((u >> 16) & 1u)) >> 16); }
DI float rbf(float f) { return bf2f(f2bf(f)); }
DI float wave_sum(float v) {
#pragma unroll
    for (int o = 1; o < 64; o <<= 1) v += __shfl_xor(v, o);
    return v;
}
DI float silu_f(float x) { return x / (1.f + __expf(-x)); }
DI float sigmoid_f(float x) { return 1.f / (1.f + __expf(-x)); }
DI float gelu_tanh(float x) { const float u = 0.7978845608028654f * (x + 0.044715f * x * x * x); return 0.5f * x * (1.f + tanhf(u)); }

constexpr int DM = 1024, NB = 4, SEQ = 4096, LC = 256;
constexpr int NLAT = NB * SEQ, NCTX = NB * LC, MROWS = NLAT + NCTX;
constexpr int N0 = 3072, N1 = 2304, POSN = LC + SEQ;
constexpr float EPSN = 1e-6f;
constexpr float LOG2E = 1.4426950408889634f;

constexpr size_t MiB = 1u << 20;
constexpr size_t WS_CTL = 0;
constexpr size_t WS_MOD = 1 * MiB;
constexpr size_t WS_HC1 = 4 * MiB;
constexpr size_t WS_XN = 32 * MiB;
constexpr size_t WS_YMIX = 66 * MiB;
constexpr size_t WS_PROJ = 100 * MiB;
constexpr size_t WS_VT0 = 202 * MiB;
constexpr size_t WS_YPRE = 228 * MiB;
constexpr size_t WS_QP = 202 * MiB;
constexpr size_t WS_KP = 218 * MiB;
constexpr size_t WS_VT1 = 223 * MiB;
constexpr size_t WS_YS = 32 * MiB;
constexpr size_t WS_HS = 32 * MiB;

DI int row_batch(int r) { return r < NLAT ? (r >> 12) : ((r - NLAT) >> 8); }
DI int row_pos(int r) { return r < NLAT ? LC + (r & 4095) : ((r - NLAT) & 255); }
DI int pos_row(int b, int pos) { return pos < LC ? NLAT + b * LC + pos : b * SEQ + (pos - LC); }

__global__ void k_adaln(const float* c, const float* cctx, const float* ada_w, const float* ada_b, float* mod) {
    const int idx = blockIdx.x * blockDim.x + threadIdx.x;
    if (idx >= 2 * 5 * 3072) return;
    const int col = idx % 3072, r = (idx / 3072) % 5, i = idx / (3072 * 5);
    const float* cv = r < 4 ? c + r * 1024 : cctx;
    const float* W = ada_w + (size_t)i * 1024 * 3072;
    float acc = 0.f;
    for (int k = 0; k < 1024; ++k) acc += silu_f(cv[k]) * W[(size_t)k * 3072 + col];
    mod[idx] = acc + ada_b[i * 3072 + col];
}

__global__ void k_prenorm(const float* lat, const float* ctx, const float* g, const float* mod  , bf16_t* XN) {
    const int r = blockIdx.x * 4 + (threadIdx.x >> 6), lane = threadIdx.x & 63;
    if (r >= MROWS) return;
    const float* src = r < NLAT ? lat + (size_t)r * DM : ctx + (size_t)(r - NLAT) * DM;
    const float* m = mod + (r < NLAT ? (r >> 12) : 4) * 3072;
    float v[16]; float ss = 0.f;
#pragma unroll
    for (int j = 0; j < 4; ++j) { const float4 t = *(const float4*)(src + j * 256 + lane * 4); v[4 * j] = t.x; v[4 * j + 1] = t.y; v[4 * j + 2] = t.z; v[4 * j + 3] = t.w; }
#pragma unroll
    for (int j = 0; j < 16; ++j) ss += v[j] * v[j];
    ss = wave_sum(ss);
    const float rinv = rsqrtf(ss * (1.f / DM) + EPSN);
#pragma unroll
    for (int j = 0; j < 4; ++j)
#pragma unroll
        for (int e = 0; e < 4; ++e) { const int col = j * 256 + lane * 4 + e; const float y = v[4 * j + e] * rinv * g[col] * (1.f + m[1024 + col]) + m[col]; XN[(size_t)r * DM + col] = f2bf(y); }
}

__global__ void k_postnorm(const float* hlat, const float* hctx, const float* OUT, const float* pg, const float* mod, float* olat, float* octx, int nrows) {
    const int r = blockIdx.x * 4 + (threadIdx.x >> 6), lane = threadIdx.x & 63;
    if (r >= nrows) return;
    const float* hin = r < NLAT ? hlat + (size_t)r * DM : hctx + (size_t)(r - NLAT) * DM;
    float* ho = r < NLAT ? olat + (size_t)r * DM : octx + (size_t)(r - NLAT) * DM;
    const float* m = mod + (r < NLAT ? (r >> 12) : 4) * 3072 + 2048;
    const float* src = OUT + (size_t)r * DM;
    float v[16]; float ss = 0.f;
#pragma unroll
    for (int j = 0; j < 4; ++j) { const float4 t = *(const float4*)(src + j * 256 + lane * 4); v[4 * j] = t.x; v[4 * j + 1] = t.y; v[4 * j + 2] = t.z; v[4 * j + 3] = t.w; }
#pragma unroll
    for (int j = 0; j < 16; ++j) ss += v[j] * v[j];
    ss = wave_sum(ss);
    const float rinv = rsqrtf(ss * (1.f / DM) + EPSN);
#pragma unroll
    for (int j = 0; j < 4; ++j)
#pragma unroll
        for (int e = 0; e < 4; ++e) { const int col = j * 256 + lane * 4 + e; ho[col] = hin[col] + m[col] * (v[4 * j + e] * rinv * pg[col]); }
}

enum { GM_PROJ0 = 0, GM_PROJ1 = 1, GM_GLU = 2, GM_F32 = 3 };
struct GemmEpi { bf16_t* P; bf16_t* VT; const bf16_t* YPRE; const bf16_t* PROJ; const float* bglu; bf16_t* YMIX; float* OUT; };
template <int MODE> __global__ void __launch_bounds__(256) k_gemm(const bf16_t* A, const float* W, int M, int N, int K, GemmEpi e) {
    const int tx = threadIdx.x & 15, ty = threadIdx.x >> 4;
    const int c0 = blockIdx.x * 64 + tx * 4, r0 = blockIdx.y * 64 + ty * 4;
    float acc[4][4] = {};
    for (int k = 0; k < K; ++k) {
        const float4 w = *(const float4*)(W + (size_t)k * N + c0);
        const float wv[4] = {rbf(w.x), rbf(w.y), rbf(w.z), rbf(w.w)};
#pragma unroll
        for (int i = 0; i < 4; ++i) { const float a = bf2f(A[(size_t)(r0 + i) * K + k]);
#pragma unroll
            for (int j = 0; j < 4; ++j) acc[i][j] += a * wv[j]; }
    }
#pragma unroll
    for (int i = 0; i < 4; ++i)
#pragma unroll
        for (int j = 0; j < 4; ++j) {
            const int r = r0 + i, c = c0 + j; const float v = acc[i][j];
            if (MODE == GM_PROJ0) { e.P[(size_t)r * N0 + c] = f2bf(v);
                if (c >= 2048 && c < 2560) { const int hd = c - 2048; e.VT[((size_t)(row_batch(r) * 8) * 64 + hd) * POSN + row_pos(r)] = f2bf(v); } }
            else if (MODE == GM_PROJ1) { e.P[(size_t)r * N1 + c] = f2bf(v);
                if (c >= 1664 && c < 1792) { const int hd = c - 1664; e.VT[((size_t)(row_batch(r) * 2) * 64 + hd) * POSN + row_pos(r)] = f2bf(v); } }
            else if (MODE == GM_GLU) { const float y = bf2f(e.YPRE[(size_t)r * 512 + c]); const float ga = bf2f(e.PROJ[(size_t)r * N0 + 512 + c]);
                e.YMIX[(size_t)r * DM + c] = f2bf(y * sigmoid_f(v + e.bglu[c]) * silu_f(ga)); }
            else e.OUT[(size_t)r * N + c] = v;
        }
}

__global__ void __launch_bounds__(64) k_s5_scan(const bf16_t* PROJ, const float* lam_re, const float* lam_im, const float* log_dt, const float* b_re, const float* b_im,
                                                 const float* c_re, const float* c_im, float* YS) {
    const int p = threadIdx.x, id = blockIdx.x, dir = id & 1, g = (id >> 1) & 31, b = id >> 6;
    const int gi = (dir * 32 + g);
    const double lre = lam_re[gi * 64 + p], lim = lam_im[gi * 64 + p], dt = exp((double)log_dt[gi]);
    const double mag = exp(lre * dt); const float ar = (float)(mag * cos(lim * dt)), ai = (float)(mag * sin(lim * dt));
    const double nr = mag * cos(lim * dt) - 1.0, ni = mag * sin(lim * dt), den = lre * lre + lim * lim;
    const float cfr = (float)((nr * lre + ni * lim) / den), cfi = (float)((ni * lre - nr * lim) / den);
    float bbr[16], bbi[16], cr[16], ci[16];
#pragma unroll
    for (int h = 0; h < 16; ++h) { const float br = b_re[(gi * 64 + p) * 16 + h], bi = b_im[(gi * 64 + p) * 16 + h]; bbr[h] = cfr * br - cfi * bi; bbi[h] = cfr * bi + cfi * br;
        cr[h] = c_re[(gi * 16 + h) * 64 + p]; ci[h] = c_im[(gi * 16 + h) * 64 + p]; }
    float hr = 0.f, hi = 0.f;
    float* ys = YS + (size_t)dir * MROWS * 512;
    for (int pos = 0; pos < POSN; ++pos) {
        int row;
        if (dir == 0) row = pos_row(b, pos); else row = pos < LC ? NLAT + b * LC + (LC - 1 - pos) : b * SEQ + (SEQ - 1 - (pos - LC));
        const bf16_t* up = PROJ + (size_t)row * N0 + g * 16;
        float bur = 0.f, bui = 0.f;
#pragma unroll
        for (int h = 0; h < 16; ++h) { const float u = bf2f(up[h]); bur += bbr[h] * u; bui += bbi[h] * u; }
        const float nhr = ar * hr - ai * hi + bur, nhi = ar * hi + ai * hr + bui; hr = nhr; hi = nhi;
        float mine = 0.f;
#pragma unroll
        for (int h = 0; h < 16; ++h) { const float y = wave_sum(cr[h] * hr - ci[h] * hi); if (p == h) mine = y; }
        if (p < 16) ys[(size_t)row * 512 + g * 16 + p] = mine;
    }
}
__global__ void k_s5_finish(const bf16_t* PROJ, const float* YS, const float* dsk, bf16_t* YPRE) {
    const size_t idx = (size_t)blockIdx.x * blockDim.x + threadIdx.x; if (idx >= (size_t)MROWS * 512) return;
    const int ch = idx & 511; const size_t r = idx >> 9;
    const float y = dsk[ch] * bf2f(PROJ[r * N0 + ch]) + YS[idx] + YS[(size_t)MROWS * 512 + idx];
    YPRE[idx] = f2bf(gelu_tanh(y));
}

__global__ void __launch_bounds__(256) k_na_attn(const bf16_t* PROJ, const float* relb, bf16_t* YMIX) {
    const int wv = blockIdx.x * 4 + (threadIdx.x >> 6), lane = threadIdx.x & 63;
    if (wv >= MROWS * 8) return;
    const int h = wv & 7, r = wv >> 3, b = row_batch(r);
    const float q = bf2f(PROJ[(size_t)r * N0 + 1024 + h * 64 + lane]);
    float m = -INFINITY, l = 0.f, o = 0.f;
    if (r < NLAT) {
        const int t = r & 4095, qr = t >> 6, qc = t & 63;
        const int rs = min(max(qr - 4, 0), 56), cs = min(max(qc - 8, 0), 48);
        for (int kr = rs; kr < rs + 8; ++kr)
            for (int kc = cs; kc < cs + 16; ++kc) {
                const size_t kro = (size_t)(b * SEQ + kr * 64 + kc) * N0;
                float s = wave_sum(q * bf2f(PROJ[kro + 1536 + h * 64 + lane])) * 0.125f + relb[(h * 15 + (kr - qr + 7)) * 31 + (kc - qc + 15)];
                const float mn = fmaxf(m, s), al = __expf(m - mn), pp = __expf(s - mn);
                l = l * al + pp; o = o * al + pp * bf2f(PROJ[kro + 2048 + h * 64 + lane]); m = mn;
            }
    }
    for (int c = 0; c < LC; ++c) {
        const size_t kro = (size_t)(NLAT + b * LC + c) * N0;
        const float s = wave_sum(q * bf2f(PROJ[kro + 1536 + h * 64 + lane])) * 0.125f;
        const float mn = fmaxf(m, s), al = __expf(m - mn), pp = __expf(s - mn);
        l = l * al + pp; o = o * al + pp * bf2f(PROJ[kro + 2048 + h * 64 + lane]); m = mn;
    }
    const float gb = bf2f(PROJ[(size_t)r * N0 + 2560 + h * 64 + lane]);
    YMIX[(size_t)r * DM + 512 + h * 64 + lane] = f2bf(o / l * silu_f(gb));
}

__global__ void __launch_bounds__(64) k_lru(const bf16_t* P1, const float* conv_w, const float* conv_b, const float* lam, const float* w_a, const float* b_a,
                                            const float* w_x, const float* b_x, float* HS, bf16_t* YMIX) {
    __shared__ float xs[64];
    const int j = threadIdx.x, nb = blockIdx.x & 7, b = blockIdx.x >> 3, ch = nb * 64 + j;
    const float cw0 = conv_w[0 * 512 + ch], cw1 = conv_w[1 * 512 + ch], cw2 = conv_w[2 * 512 + ch], cw3 = conv_w[3 * 512 + ch], cb = conv_b[ch];
    for (int dir = 0; dir < 2; ++dir) {
        float wa[64], wx[64];
#pragma unroll
        for (int i = 0; i < 64; ++i) { wa[i] = w_a[((dir * 8 + nb) * 64 + i) * 64 + j]; wx[i] = w_x[((dir * 8 + nb) * 64 + i) * 64 + j]; }
        const float ba = b_a[dir * 512 + ch], bx = b_x[dir * 512 + ch];
        const float lm = lam[dir * 512 + ch]; const float sp = (-lm > 20.f) ? -lm : log1pf(__expf(-lm));
        float hst = 0.f;
        for (int pos = 0; pos < POSN; ++pos) {
            int s0, sl, t;
            if (pos < LC) { s0 = NLAT + b * LC; sl = LC; t = dir == 0 ? pos : LC - 1 - pos; }
            else { s0 = b * SEQ; sl = SEQ; t = dir == 0 ? pos - LC : SEQ - 1 - (pos - LC); }
            float xm1 = 0.f, x0, xp1 = 0.f, xp2 = 0.f;
            x0 = bf2f(P1[(size_t)(s0 + t) * N1 + ch]);
            if (t - 1 >= 0) xm1 = bf2f(P1[(size_t)(s0 + t - 1) * N1 + ch]);
            if (t + 1 < sl) xp1 = bf2f(P1[(size_t)(s0 + t + 1) * N1 + ch]);
            if (t + 2 < sl) xp2 = bf2f(P1[(size_t)(s0 + t + 2) * N1 + ch]);
            const float xc = cw0 * xm1 + cw1 * x0 + cw2 * xp1 + cw3 * xp2 + cb;
            __syncthreads(); xs[j] = xc; __syncthreads();
            float ga = ba, gx = bx;
#pragma unroll
            for (int i = 0; i < 64; ++i) { const float xi = xs[i]; ga += xi * wa[i]; gx += xi * wx[i]; }
            const float gr = sigmoid_f(ga), gi = sigmoid_f(gx);
            const float log_a = -8.f * gr * sp; const float a = __expf(log_a); const float mult = sqrtf(fmaxf(-expm1f(2.f * log_a), 0.f));
            hst = a * hst + mult * gi * xc;
            if (pos >= LC) { const size_t rr = (size_t)(s0 + t);
                if (dir == 0) HS[rr * 512 + ch] = hst;
                else { const float gc = bf2f(P1[rr * N1 + 512 + ch]); YMIX[rr * DM + ch] = f2bf((HS[rr * 512 + ch] + hst) * silu_f(gc)); } }
        }
    }
}

__global__ void __launch_bounds__(256) k_qkprep(const bf16_t* P1, const float* qn, const float* kn, bf16_t* QP, bf16_t* KP) {
    const int wv = blockIdx.x * 4 + (threadIdx.x >> 6), lane = threadIdx.x & 63;
    if (wv >= MROWS * 10) return;
    const int slot = wv % 10, r = wv / 10, b = row_batch(r);
    if (slot < 8 && r >= NLAT) return;
    const int col0 = slot < 8 ? 1024 + slot * 64 : 1536 + (slot - 8) * 64;
    const float x = bf2f(P1[(size_t)r * N1 + col0 + lane]);
    const float ss = wave_sum(x * x);
    float y = x * rsqrtf(ss * (1.f / 64.f) + EPSN) * (slot < 8 ? qn[lane] : kn[lane]);
    if (r < NLAT) {
        const int t = r & 4095, i = lane >> 1, f = i & 15; const float pos = (float)(i < 16 ? (t >> 6) : (t & 63));
        const float inv = (float)exp(-log(10000.0) * (double)(2 * f) / 32.0);
        const float ang = pos * inv; const float cs = cosf(ang), sn = sinf(ang);
        const float pr = __shfl_xor(y, 1);
        y = (lane & 1) ? (pr * sn + y * cs) : (y * cs - pr * sn);
    }
    if (slot < 8) QP[((size_t)(b * 8 + slot) * SEQ + (r & 4095)) * 64 + lane] = f2bf(y * (0.125f * LOG2E));
    else KP[((size_t)(b * 2 + (slot - 8)) * POSN + row_pos(r)) * 64 + lane] = f2bf(y);
}

__global__ void __launch_bounds__(256) k_gqa(const bf16_t* QP, const bf16_t* KP, const bf16_t* P1, bf16_t* YMIX) {
    const int wv = blockIdx.x * 4 + (threadIdx.x >> 6), lane = threadIdx.x & 63;
    if (wv >= NLAT * 8) return;
    const int hq = wv & 7, r = wv >> 3, b = r >> 12, t = r & 4095, kvh = hq >> 2;
    const float q = bf2f(QP[((size_t)(b * 8 + hq) * SEQ + t) * 64 + lane]);
    const bf16_t* kp = KP + (size_t)(b * 2 + kvh) * POSN * 64;
    float m = -INFINITY, l = 0.f, o = 0.f;
    for (int pos = 0; pos < POSN; ++pos) {
        const float s = wave_sum(q * bf2f(kp[(size_t)pos * 64 + lane]));
        const float v = bf2f(P1[(size_t)pos_row(b, pos) * N1 + 1664 + kvh * 64 + lane]);
        const float mn = fmaxf(m, s), al = exp2f(m - mn), pp = exp2f(s - mn);
        l = l * al + pp; o = o * al + pp * v; m = mn;
    }
    const float gd = bf2f(P1[(size_t)r * N1 + 1792 + hq * 64 + lane]);
    YMIX[(size_t)r * DM + 512 + hq * 64 + lane] = f2bf(o / l * silu_f(gd));
}

extern "C" void kernel_launch(void* const* d_in, const int* in_sizes, int n_in, void* d_out, int out_size, void* d_ws, size_t ws_size, hipStream_t stream) {
    const float* x = (const float*)d_in[0]; const float* c = (const float*)d_in[1]; const float* ctx = (const float*)d_in[2]; const float* cctx = (const float*)d_in[3];
    const float* ada_w = (const float*)d_in[4]; const float* ada_b = (const float*)d_in[5]; const float* pre_g = (const float*)d_in[6]; const float* post_g = (const float*)d_in[7];
    const float* ev_w_in = (const float*)d_in[8]; const float* ev_w_out = (const float*)d_in[9];
    const float* s5_lre = (const float*)d_in[10]; const float* s5_lim = (const float*)d_in[11]; const float* s5_ldt = (const float*)d_in[12];
    const float* s5_bre = (const float*)d_in[13]; const float* s5_bim = (const float*)d_in[14]; const float* s5_cre = (const float*)d_in[15]; const float* s5_cim = (const float*)d_in[16];
    const float* s5_d = (const float*)d_in[17]; const float* s5_wglu = (const float*)d_in[18]; const float* s5_bglu = (const float*)d_in[19]; const float* relb = (const float*)d_in[20];
    const float* od_w_in = (const float*)d_in[21]; const float* od_w_out = (const float*)d_in[22]; const float* conv_w = (const float*)d_in[23]; const float* conv_b = (const float*)d_in[24];
    const float* lru_lam = (const float*)d_in[25]; const float* w_a = (const float*)d_in[26]; const float* b_a = (const float*)d_in[27]; const float* w_x = (const float*)d_in[28]; const float* b_x = (const float*)d_in[29];
    const float* qn = (const float*)d_in[30]; const float* kn = (const float*)d_in[31];
    char* ws = (char*)d_ws; float* out = (float*)d_out;
    float* MOD = (float*)(ws + WS_MOD); float* HC1 = (float*)(ws + WS_HC1);
    bf16_t* XN = (bf16_t*)(ws + WS_XN); bf16_t* YMIX = (bf16_t*)(ws + WS_YMIX); bf16_t* PROJ = (bf16_t*)(ws + WS_PROJ); float* OUTF = (float*)(ws + WS_PROJ);
    bf16_t* VT0 = (bf16_t*)(ws + WS_VT0); bf16_t* YPRE = (bf16_t*)(ws + WS_YPRE); bf16_t* QP = (bf16_t*)(ws + WS_QP); bf16_t* KP = (bf16_t*)(ws + WS_KP); bf16_t* VT1 = (bf16_t*)(ws + WS_VT1);
    float* YS = (float*)(ws + WS_YS); float* HS = (float*)(ws + WS_HS);

    k_adaln<<<(2 * 5 * 3072 + 255) / 256, 256, 0, stream>>>(c, cctx, ada_w, ada_b, MOD);
    k_prenorm<<<MROWS / 4, 256, 0, stream>>>(x, ctx, pre_g, MOD, XN);
    { GemmEpi e{}; e.P = PROJ; e.VT = VT0; k_gemm<GM_PROJ0><<<dim3(N0 / 64, MROWS / 64), 256, 0, stream>>>(XN, ev_w_in, MROWS, N0, DM, e); }
    k_s5_scan<<<NB * 32 * 2, 64, 0, stream>>>(PROJ, s5_lre, s5_lim, s5_ldt, s5_bre, s5_bim, s5_cre, s5_cim, YS);
    k_s5_finish<<<(MROWS * 512) / 256, 256, 0, stream>>>(PROJ, YS, s5_d, YPRE);
    k_na_attn<<<MROWS * 8 / 4, 256, 0, stream>>>(PROJ, relb, YMIX);
    { GemmEpi e{}; e.YPRE = YPRE; e.PROJ = PROJ; e.bglu = s5_bglu; e.YMIX = YMIX; k_gemm<GM_GLU><<<dim3(512 / 64, MROWS / 64), 256, 0, stream>>>(YPRE, s5_wglu, MROWS, 512, 512, e); }
    { GemmEpi e{}; e.OUT = OUTF; k_gemm<GM_F32><<<dim3(DM / 64, MROWS / 64), 256, 0, stream>>>(YMIX, ev_w_out, MROWS, DM, DM, e); }
    k_postnorm<<<MROWS / 4, 256, 0, stream>>>(x, ctx, OUTF, post_g, MOD, out, HC1, MROWS);
    k_prenorm<<<MROWS / 4, 256, 0, stream>>>(out, HC1, pre_g + DM, MOD + 5 * 3072, XN);
    { GemmEpi e{}; e.P = PROJ; e.VT = VT1; k_gemm<GM_PROJ1><<<dim3(N1 / 64, MROWS / 64), 256, 0, stream>>>(XN, od_w_in, MROWS, N1, DM, e); }
    k_lru<<<NB * 8, 64, 0, stream>>>(PROJ, conv_w, conv_b, lru_lam, w_a, b_a, w_x, b_x, HS, YMIX);
    k_qkprep<<<(MROWS * 10 + 3) / 4, 256, 0, stream>>>(PROJ, qn, kn, QP, KP);
    k_gqa<<<NLAT * 8 / 4, 256, 0, stream>>>(QP, KP, PROJ, YMIX);
    { GemmEpi e{}; e.OUT = OUTF; k_gemm<GM_F32><<<dim3(DM / 64, NLAT / 64), 256, 0, stream>>>(YMIX, od_w_out, NLAT, DM, DM, e); }
    k_postnorm<<<NLAT / 4, 256, 0, stream>>>(out, nullptr, OUTF, post_g + DM, MOD + 5 * 3072, out, nullptr, NLAT);
}
```

```cpp
#include <hip/hip_runtime.h>
#include <cstdint>
#include <cstdio>

typedef unsigned short bf16_t;
#define DI __device__ __forceinline__
#define GAS __attribute__((address_space(1)))
#define LAS __attribute__((address_space(3)))
typedef unsigned v4u __attribute__((ext_vector_type(4)));
typedef unsigned v2u __attribute__((ext_vector_type(2)));
typedef float f32x4_t __attribute__((ext_vector_type(4)));
typedef float f32x16_t __attribute__((ext_vector_type(16)));
typedef short bf16x8_t __attribute__((ext_vector_type(8)));
typedef short s16x4_t __attribute__((ext_vector_type(4)));
typedef GAS unsigned gu32;
typedef GAS unsigned long long gu64;
#define RLX_AGENT __ATOMIC_RELAXED, __HIP_MEMORY_SCOPE_AGENT
#define LDS_WAIT() asm volatile("s_waitcnt lgkmcnt(0)" ::: "memory")
#define VM_WAIT() asm volatile("s_waitcnt vmcnt(0)" ::: "memory")

DI float bf2f(bf16_t v) { return __uint_as_float((unsigned)v << 16); }
DI bf16_t f2bf(float f) { unsigned u = __float_as_uint(f); return (bf16_t)((u + 0x7fffu + ((u >> 16) & 1u)) >> 16); }
DI unsigned pk2(float lo, float hi) { return (unsigned)f2bf(lo) | ((unsigned)f2bf(hi) << 16); }
DI float bflo(unsigned w) { return __uint_as_float(w << 16); }
DI float bfhi(unsigned w) { return __uint_as_float(w & 0xffff0000u); }
DI float rbf(float f) { return bf2f(f2bf(f)); }
DI float wave_sum(float v) {
#pragma unroll
    for (int o = 1; o < 64; o <<= 1) v += __shfl_xor(v, o);
    return v;
}
DI float silu_f(float x) { return x / (1.f + __expf(-x)); }
DI float sigmoid_f(float x) { return 1.f / (1.f + __expf(-x)); }
DI float gelu_tanh(float x) { const float u = 0.7978845608028654f * (x + 0.044715f * x * x * x); return 0.5f * x * (1.f + tanhf(u)); }
DI float gelu_fast(float x) { const float u = 1.5957691216057308f * (x + 0.044715f * x * x * x); return x / (1.f + __expf(-u)); }

constexpr int DM = 1024, NB = 4, SEQ = 4096, LC = 256;
constexpr int NLAT = NB * SEQ, NCTX = NB * LC, MROWS = NLAT + NCTX;
constexpr int N0 = 3072, N1 = 2304, POSN = LC + SEQ;
constexpr float EPSN = 1e-6f;
constexpr float LOG2E = 1.4426950408889634f;

constexpr size_t MiB = 1u << 20;
constexpr size_t WS_CTL = 0, CTL_ZERO_BYTES = 1 * MiB;
constexpr size_t WS_MOD = 1 * MiB;
constexpr size_t WS_ROPE = 2 * MiB;
constexpr size_t WS_L16 = 3 * MiB;
constexpr size_t WS_WIN0T = 4 * MiB;
constexpr size_t WS_WOUT0T = 10 * MiB;
constexpr size_t WS_WIN1T = 12 * MiB;
constexpr size_t WS_WOUT1T = 17 * MiB;
constexpr size_t WS_WGLUT = 19 * MiB;
constexpr size_t WS_LRUWT = 19 * MiB + 512 * 1024;
constexpr size_t WS_W16 = 20 * MiB;
constexpr size_t WS_WC = 24 * MiB;
constexpr size_t WS_KT = 28 * MiB;
constexpr size_t WS_LSUM = 29 * MiB;
constexpr size_t WS_XN = 32 * MiB;
constexpr size_t WS_YMIX = 66 * MiB;
constexpr size_t WS_PROJ = 100 * MiB;
constexpr size_t WS_VT0 = 202 * MiB;
constexpr size_t WS_CARRY1 = 219 * MiB;
constexpr size_t WS_YPRE = 228 * MiB;
constexpr size_t WS_QP = 202 * MiB;
constexpr size_t WS_KP = 218 * MiB;
constexpr size_t WS_VT1 = 223 * MiB;
constexpr size_t WS_YS = 32 * MiB;
constexpr size_t WS_HS = 32 * MiB;
constexpr size_t WS_HC1 = 246 * MiB;

DI int row_batch(int r) { return r < NLAT ? (r >> 12) : ((r - NLAT) >> 8); }
DI int row_pos(int r) { return r < NLAT ? LC + (r & 4095) : ((r - NLAT) & 255); }
DI int pos_row(int b, int pos) { return pos < LC ? NLAT + b * LC + pos : b * SEQ + (pos - LC); }

namespace pg8 {
#define PG8_LAS __attribute__((address_space(3)))
typedef unsigned short bf16_t;
typedef short bf16x8 __attribute__((ext_vector_type(8)));
typedef float f32x4 __attribute__((ext_vector_type(4)));
typedef unsigned u32x4 __attribute__((ext_vector_type(4)));
constexpr int BM = 256, BK = 64, HALF = 128, HTB = HALF * BK * 2  , STAGE_BYTES = 8 * HTB, NXCD = 8, WGM = 8;

__host__ __device__ __forceinline__ int lds_byte(int r, int c) { const int st = (r >> 4) * 2 + (c >> 5), rr = r & 15, cc = c & 31, ob = rr * 64 + cc * 2; return st * 1024 + (ob ^ (((ob >> 9) & 1) << 5)); }
__host__ __device__ __forceinline__ void stage_rc(int b, int& R, int& C) { const int st = b / 1024, sb = b % 1024, swz = sb ^ (((sb >> 9) & 1) << 5); R = (st >> 1) * 16 + swz / 64; C = (st & 1) * 32 + (swz % 64) / 2; }
__host__ __device__ __forceinline__ int perm32(int rho) { const int n = rho >> 4, i = rho & 15; return 8 * (i >> 2) + 4 * n + (i & 3); }

struct Unit { int pm, pn; };
struct Gemm { const bf16_t* A; const bf16_t* Bt; int M, N, K; };

struct StaticOrder {
    int nM, nN, nwg, G, c;
    __host__ __device__ void init(int M, int N, int G_, int c_) { nM = M / BM; nN = N / BM; nwg = nM * nN; G = G_; c = c_; }
    __host__ __device__ bool next(int i, Unit& u) const {
        const long L = (long)i * G + c; if (L >= nwg) return false;
        int wgid = (int)L; { const int q = nwg / NXCD, r = nwg % NXCD, xcd = wgid % NXCD, off = wgid / NXCD; wgid = (xcd < r ? xcd * (q + 1) : r * (q + 1) + (xcd - r) * q) + off; }
        const int nig = WGM * nN, gid = wgid / nig, fm = gid * WGM, gsz = (nM - fm) < WGM ? (nM - fm) : WGM;
        u.pm = fm + ((wgid % nig) % gsz); u.pn = (wgid % nig) / gsz; return true;
    }
    __device__ __forceinline__ void a_ready(const Unit&) const {}
    __device__ __forceinline__ void done(const Unit&) const {}
};

__device__ __forceinline__ unsigned cvt_pk_bf16(float lo, float hi) { unsigned r; asm volatile("v_cvt_pk_bf16_f32 %0, %1, %2" : "=v"(r) : "v"(lo), "v"(hi)); return r; }

struct EpiProj {
    static constexpr bool PERM = true, AFTER_DRAIN = false;
    bf16_t* P; int ldc; bf16_t* VT; int vt_lo, vt_hi, vt_w;
    __device__ __forceinline__ void operator()(const f32x4 (&acc)[2][2][4][2], const Unit& u, int wr, int wc, int fr, int fq) const {
        const int row0 = u.pm * BM + wr * 64 + fr, colt = u.pn * BM + wc * 32 + 8 * fq;
#pragma unroll
        for (int ai = 0; ai < 2; ++ai)
#pragma unroll
            for (int m = 0; m < 4; ++m) { const int r = row0 + ai * HALF + m * 16; bf16_t* rowp = P + (size_t)r * ldc + colt;
#pragma unroll
                for (int bj = 0; bj < 2; ++bj) { const f32x4 v0 = acc[ai][bj][m][0], v1 = acc[ai][bj][m][1];
                    u32x4 w; w.x = cvt_pk_bf16(v0[0], v0[1]); w.y = cvt_pk_bf16(v0[2], v0[3]); w.z = cvt_pk_bf16(v1[0], v1[1]); w.w = cvt_pk_bf16(v1[2], v1[3]);
                    *(u32x4*)(rowp + bj * HALF) = w;
                    const int c0 = colt + bj * HALF;
                    if (c0 >= vt_lo && c0 < vt_hi) {
                        bf16_t* vp = VT + ((size_t)row_batch(r) * vt_w + (c0 - vt_lo)) * POSN + row_pos(r);
                        vp[0 * POSN] = (bf16_t)(w.x & 0xffffu); vp[1 * POSN] = (bf16_t)(w.x >> 16); vp[2 * POSN] = (bf16_t)(w.y & 0xffffu); vp[3 * POSN] = (bf16_t)(w.y >> 16);
                        vp[4 * POSN] = (bf16_t)(w.z & 0xffffu); vp[5 * POSN] = (bf16_t)(w.z >> 16); vp[6 * POSN] = (bf16_t)(w.w & 0xffffu); vp[7 * POSN] = (bf16_t)(w.w >> 16);
                    } } }
    }
};
struct EpiGlu {
    static constexpr bool PERM = true, AFTER_DRAIN = false;
    const bf16_t* YPRE; const bf16_t* PROJ; const float* bglu; bf16_t* YMIX;
    __device__ __forceinline__ void operator()(const f32x4 (&acc)[2][2][4][2], const Unit& u, int wr, int wc, int fr, int fq) const {
        const int row0 = u.pm * BM + wr * 64 + fr, colt = u.pn * BM + wc * 32 + 8 * fq;
#pragma unroll
        for (int bj = 0; bj < 2; ++bj) { const int c0 = colt + bj * HALF;
            const f32x4 b0 = *(const f32x4*)(bglu + c0), b1 = *(const f32x4*)(bglu + c0 + 4);
#pragma unroll
            for (int ai = 0; ai < 2; ++ai)
#pragma unroll
                for (int m = 0; m < 4; ++m) { const int r = row0 + ai * HALF + m * 16;
                    const u32x4 yv = *(const u32x4*)(YPRE + (size_t)r * 512 + c0), gv = *(const u32x4*)(PROJ + (size_t)r * N0 + 512 + c0);
                    const f32x4 a0 = acc[ai][bj][m][0] + b0, a1 = acc[ai][bj][m][1] + b1;
                    float o[8];
                    o[0] = bflo(yv.x) * sigmoid_f(a0[0]) * silu_f(bflo(gv.x)); o[1] = bfhi(yv.x) * sigmoid_f(a0[1]) * silu_f(bfhi(gv.x));
                    o[2] = bflo(yv.y) * sigmoid_f(a0[2]) * silu_f(bflo(gv.y)); o[3] = bfhi(yv.y) * sigmoid_f(a0[3]) * silu_f(bfhi(gv.y));
                    o[4] = bflo(yv.z) * sigmoid_f(a1[0]) * silu_f(bflo(gv.z)); o[5] = bfhi(yv.z) * sigmoid_f(a1[1]) * silu_f(bfhi(gv.z));
                    o[6] = bflo(yv.w) * sigmoid_f(a1[2]) * silu_f(bflo(gv.w)); o[7] = bfhi(yv.w) * sigmoid_f(a1[3]) * silu_f(bfhi(gv.w));
                    u32x4 w; w.x = cvt_pk_bf16(o[0], o[1]); w.y = cvt_pk_bf16(o[2], o[3]); w.z = cvt_pk_bf16(o[4], o[5]); w.w = cvt_pk_bf16(o[6], o[7]);
                    *(u32x4*)(YMIX + (size_t)r * DM + c0) = w; } }
    }
};
struct EpiF32 {
    static constexpr bool PERM = false, AFTER_DRAIN = false;
    float* O; int ldc;
    __device__ __forceinline__ void operator()(const f32x4 (&acc)[2][2][4][2], const Unit& u, int wr, int wc, int fr, int fq) const {
        const int row0 = u.pm * BM + wr * 64 + fr, col0 = u.pn * BM + wc * 32 + 4 * fq;
#pragma unroll
        for (int ai = 0; ai < 2; ++ai)
#pragma unroll
            for (int m = 0; m < 4; ++m) { float* rowp = O + (size_t)(row0 + ai * HALF + m * 16) * ldc + col0;
#pragma unroll
                for (int bj = 0; bj < 2; ++bj)
#pragma unroll
                    for (int n = 0; n < 2; ++n) *(f32x4*)(rowp + bj * HALF + n * 16) = acc[ai][bj][m][n]; }
    }
};
template <class Epi, class Sched, bool ALIGN_EPI = false, bool SP2 = false>
__device__ __forceinline__ void gemm_phase(PG8_LAS unsigned char* lds, const Gemm g, const Sched& S, const Epi& E) {
    const int tid = threadIdx.x, wid = __builtin_amdgcn_readfirstlane(tid >> 6), lane = tid & 63, wr = wid >> 2, wc = wid & 3, fr = lane & 15, fq = lane >> 4;
    const int K = g.K, nt = K / BK;
    unsigned voffA[2], voffB[2];
#pragma unroll
    for (int i = 0; i < 2; ++i) { int R, C; stage_rc(tid * 16 + i * 8192, R, C); const int Rb = Epi::PERM ? ((R & ~31) + perm32(R & 31)) : R;
        voffA[i] = (unsigned)(R * K + C) * 2u; voffB[i] = (unsigned)(Rb * K + C) * 2u; }
    const size_t kstep = (size_t)(BK * 2);
    const size_t hstep = (size_t)HALF * K * 2;
    const size_t tstep = 2 * hstep;
    const unsigned ldsw = (unsigned)wid * 1024u;
    const int aoff = lds_byte(wr * 64 + fr, fq * 8), boff = lds_byte(wc * 32 + fr, fq * 8);
#define PG8_SA(b, h) (((b) * 2 + (h)) * HTB)
#define PG8_SB(b, h) ((4 + (b) * 2 + (h)) * HTB)
#define PG8_STAGE(bufoff, gbase, voff) do { _Pragma("unroll") for (int _i = 0; _i < 2; ++_i) \
        __builtin_amdgcn_global_load_lds((const unsigned*)((const char*)(gbase) + (voff)[_i]), (PG8_LAS unsigned*)(lds + (bufoff) + ldsw + _i * 8192), 16, 0, 0); } while (0)
#define PG8_LDA(dst, b, h) do { _Pragma("unroll") for (int m = 0; m < 4; ++m) _Pragma("unroll") for (int k = 0; k < 2; ++k) dst[m][k] = *(const PG8_LAS bf16x8*)(lds + PG8_SA(b, h) + aoff + m * 2048 + k * 1024); } while (0)
#define PG8_LDB(dst, b, h) do { _Pragma("unroll") for (int n = 0; n < 2; ++n) _Pragma("unroll") for (int k = 0; k < 2; ++k) dst[n][k] = *(const PG8_LAS bf16x8*)(lds + PG8_SB(b, h) + boff + n * 2048 + k * 1024); } while (0)
#define PG8_MMA(ai, bj, At, Bt) do { __builtin_amdgcn_s_setprio(1); _Pragma("unroll") for (int m = 0; m < 4; ++m) _Pragma("unroll") for (int n = 0; n < 2; ++n) _Pragma("unroll") for (int k = 0; k < 2; ++k) \
        acc[ai][bj][m][n] = __builtin_amdgcn_mfma_f32_16x16x32_bf16(Bt[n][k], At[m][k], acc[ai][bj][m][n], 0, 0, 0); __builtin_amdgcn_s_setprio(0); } while (0)
#define PG8_WAIT_V(n) asm volatile("s_waitcnt vmcnt(" #n ")" ::: "memory")
#define PG8_WAIT_L(n) asm volatile("s_waitcnt lgkmcnt(" #n ")" ::: "memory")
#define PG8_BAR __builtin_amdgcn_s_barrier()
#define PG8_SCHED __builtin_amdgcn_sched_barrier(0)
    Unit cur, nxt; int ui = 0;
    if (!S.next(0, cur)) return;
    f32x4 acc[2][2][4][2];
#pragma unroll
    for (int a = 0; a < 2; ++a)
#pragma unroll
        for (int b = 0; b < 2; ++b)
#pragma unroll
            for (int m = 0; m < 4; ++m)
#pragma unroll
                for (int n = 0; n < 2; ++n) acc[a][b][m][n] = (f32x4){0.f, 0.f, 0.f, 0.f};
    bf16x8 At[4][2], B0[2][2], B1[2][2];
    const char* cA = (const char*)g.A + (size_t)cur.pm * tstep; const char* cB = (const char*)g.Bt + (size_t)cur.pn * tstep;
    S.a_ready(cur);
    if constexpr (SP2) {
        PG8_STAGE(PG8_SB(0, 0), cB, voffB); PG8_STAGE(PG8_SB(0, 1), cB + hstep, voffB); PG8_STAGE(PG8_SA(0, 0), cA, voffA); PG8_STAGE(PG8_SA(0, 1), cA + hstep, voffA);
        if (wr == 1) PG8_BAR;
        PG8_WAIT_V(2); PG8_BAR;
        PG8_STAGE(PG8_SB(1, 0), cB + kstep, voffB); PG8_STAGE(PG8_SA(1, 0), cA + kstep, voffA); PG8_STAGE(PG8_SB(1, 1), cB + hstep + kstep, voffB);
        PG8_WAIT_V(6); PG8_BAR;
    } else {
        PG8_STAGE(PG8_SB(0, 0), cB, voffB); PG8_STAGE(PG8_SA(0, 0), cA, voffA); PG8_STAGE(PG8_SB(0, 1), cB + hstep, voffB); PG8_STAGE(PG8_SA(0, 1), cA + hstep, voffA);
        if (wr == 1) PG8_BAR;
        PG8_WAIT_V(4); PG8_BAR;
        PG8_STAGE(PG8_SB(1, 0), cB + kstep, voffB); PG8_STAGE(PG8_SA(1, 0), cA + kstep, voffA); PG8_STAGE(PG8_SB(1, 1), cB + hstep + kstep, voffB);
        PG8_WAIT_V(6); PG8_BAR;
    }
    for (;;) {
        const bool has_next = S.next(ui + 1, nxt);
        const char* nA = has_next ? (const char*)g.A + (size_t)nxt.pm * tstep : cA; const char* nB = has_next ? (const char*)g.Bt + (size_t)nxt.pn * tstep : cB;
        for (int t = 0; t < nt; t += 2) {
            const bool last = (t == nt - 2);
            const char* a1 = cA + (size_t)(t + 1) * kstep;
            const char* a2 = last ? nA : cA + (size_t)(t + 2) * kstep; const char* b2 = last ? nB : cB + (size_t)(t + 2) * kstep;
            const char* a3 = a2 + kstep; const char* b3 = b2 + kstep;
            if (last && has_next) S.a_ready(nxt);
            if constexpr (SP2) {
            PG8_LDB(B0, 0, 0); PG8_LDB(B1, 0, 1); PG8_SCHED; PG8_LDA(At, 0, 0); PG8_STAGE(PG8_SA(1, 1), a1 + hstep, voffA);
            PG8_WAIT_V(8); PG8_WAIT_L(0); PG8_BAR; PG8_MMA(0, 0, At, B0); PG8_MMA(0, 1, At, B1); PG8_BAR; PG8_SCHED;
            PG8_LDA(At, 0, 1); PG8_STAGE(PG8_SB(0, 0), b2, voffB); PG8_STAGE(PG8_SB(0, 1), b2 + hstep, voffB); PG8_STAGE(PG8_SA(0, 0), a2, voffA);
            PG8_WAIT_V(8); PG8_WAIT_L(0); PG8_BAR; PG8_MMA(1, 0, At, B0); PG8_MMA(1, 1, At, B1); PG8_BAR; PG8_SCHED;
            PG8_LDB(B0, 1, 0); PG8_LDB(B1, 1, 1); PG8_SCHED; PG8_LDA(At, 1, 0); PG8_STAGE(PG8_SA(0, 1), a2 + hstep, voffA);
            PG8_WAIT_V(8); PG8_WAIT_L(0); PG8_BAR; PG8_MMA(0, 0, At, B0); PG8_MMA(0, 1, At, B1); PG8_BAR; PG8_SCHED;
            PG8_LDA(At, 1, 1); PG8_STAGE(PG8_SB(1, 0), b3, voffB); PG8_STAGE(PG8_SB(1, 1), b3 + hstep, voffB); PG8_STAGE(PG8_SA(1, 0), a3, voffA);
            PG8_WAIT_V(8); PG8_WAIT_L(0); PG8_BAR; PG8_MMA(1, 0, At, B0); PG8_MMA(1, 1, At, B1); PG8_BAR; PG8_SCHED;
            } else {
            PG8_LDB(B0, 0, 0); PG8_SCHED; PG8_LDA(At, 0, 0); PG8_STAGE(PG8_SA(1, 1), a1 + hstep, voffA);
            PG8_WAIT_L(8); PG8_BAR; PG8_WAIT_L(0); PG8_MMA(0, 0, At, B0); PG8_BAR; PG8_SCHED;
            PG8_LDB(B1, 0, 1); PG8_STAGE(PG8_SB(0, 0), b2, voffB);
            PG8_BAR; PG8_WAIT_L(0); PG8_MMA(0, 1, At, B1); PG8_BAR;
            PG8_LDA(At, 0, 1); PG8_STAGE(PG8_SA(0, 0), a2, voffA);
            PG8_BAR; PG8_WAIT_L(0); PG8_MMA(1, 0, At, B0); PG8_BAR; PG8_SCHED;
            PG8_STAGE(PG8_SB(0, 1), b2 + hstep, voffB);
            PG8_WAIT_V(6); PG8_BAR; PG8_MMA(1, 1, At, B1); PG8_BAR;
            PG8_LDB(B0, 1, 0); PG8_SCHED; PG8_LDA(At, 1, 0); PG8_STAGE(PG8_SA(0, 1), a2 + hstep, voffA);
            PG8_WAIT_L(8); PG8_BAR; PG8_WAIT_L(0); PG8_MMA(0, 0, At, B0); PG8_BAR; PG8_SCHED;
            PG8_LDB(B1, 1, 1); PG8_STAGE(PG8_SB(1, 0), b3, voffB);
            PG8_BAR; PG8_WAIT_L(0); PG8_MMA(0, 1, At, B1); PG8_BAR;
            PG8_LDA(At, 1, 1); PG8_STAGE(PG8_SA(1, 0), a3, voffA);
            PG8_BAR; PG8_WAIT_L(0); PG8_MMA(1, 0, At, B0); PG8_BAR; PG8_SCHED;
            PG8_STAGE(PG8_SB(1, 1), b3 + hstep, voffB);
            PG8_WAIT_V(6); PG8_BAR; PG8_MMA(1, 1, At, B1); PG8_BAR;
            }
        }
        if constexpr (ALIGN_EPI) { if (wr == 0) PG8_BAR; }
        if constexpr (!Epi::AFTER_DRAIN) { E(acc, cur, wr, wc, fr, fq); S.done(cur); }
        if (!has_next) break;
#pragma unroll
        for (int a = 0; a < 2; ++a)
#pragma unroll
            for (int b = 0; b < 2; ++b)
#pragma unroll
                for (int m = 0; m < 4; ++m)
#pragma unroll
                    for (int n = 0; n < 2; ++n) acc[a][b][m][n] = (f32x4){0.f, 0.f, 0.f, 0.f};
        cur = nxt; cA = nA; cB = nB; ++ui;
        if constexpr (ALIGN_EPI) { if (wr == 1) PG8_BAR; }
    }
    PG8_WAIT_V(0);
    if constexpr (!ALIGN_EPI) { if (wr == 0) PG8_BAR; }
    PG8_BAR;
    if constexpr (Epi::AFTER_DRAIN) { E.fused(acc, cur, wr, wc, fr, fq, lds, wid, lane); S.done(cur); }
#undef PG8_SA
#undef PG8_SB
#undef PG8_STAGE
#undef PG8_LDA
#undef PG8_LDB
#undef PG8_MMA
#undef PG8_WAIT_V
#undef PG8_WAIT_L
#undef PG8_BAR
#undef PG8_SCHED
}
}
#define XB_TMO      128
#define XB_XCNT(j)  (256  + 64 * (j))
#define XB_XSUB(j)  (1280 + 64 * (j))
#define XB_XGEN(j)  (2304 + 64 * (j))
#define XB_TOP      3328
#define XB_TOPGEN   3392
#define XCD_BAR_WORDS 3456
#define XB_SPIN_CAP (1u << 18)

__device__ __forceinline__ unsigned xb_ld(unsigned* p)              { return __hip_atomic_load(p, __ATOMIC_RELAXED, __HIP_MEMORY_SCOPE_AGENT); }
__device__ __forceinline__ unsigned xb_add(unsigned* p, unsigned v) { return __hip_atomic_fetch_add(p, v, __ATOMIC_RELAXED, __HIP_MEMORY_SCOPE_AGENT); }
__device__ __forceinline__ unsigned xb_xcc_id() { return (unsigned)__builtin_amdgcn_s_getreg((3 << 11) | 20) & 0xFu; }
#define XB_SPIN(cond, bar) do { unsigned _sp = 0; while (cond) { __builtin_amdgcn_s_sleep(1); \
    if ((++_sp & 255u) == 0u) { if (xb_ld(&(bar)[XB_TMO])) break; if (_sp > XB_SPIN_CAP) { atomicAdd(&(bar)[XB_TMO], 1u); break; } } } } while (0)

struct XcdBarrier {
    unsigned* bar; unsigned x;
    volatile LAS unsigned* st;
};

__device__ __forceinline__ XcdBarrier xcd_barrier_post(unsigned* bar, volatile LAS unsigned* st) {
    XcdBarrier b; b.bar = bar; b.x = xb_xcc_id(); b.st = st;
    if (threadIdx.x == 0) (void)xb_add(&bar[XB_XCNT(b.x)], 1u);
    return b;
}
__device__ __forceinline__ void xcd_barrier_complete(unsigned* bar, unsigned x, unsigned& nloc, unsigned& nx) {
    const unsigned G = gridDim.x * gridDim.y * gridDim.z;
    unsigned sum, cnt, mine, sp = 0u;
    for (;;) {
        sum = 0u; cnt = 0u; mine = 0u;
#pragma unroll
        for (unsigned j = 0; j < 16; ++j) { const unsigned c = xb_ld(&bar[XB_XCNT(j)]); sum += c; cnt += (c > 0u) ? 1u : 0u; mine = (j == x) ? c : mine; }
        if (sum == G) break;
        __builtin_amdgcn_s_sleep(1);
        if ((++sp & 255u) == 0u) { if (xb_ld(&bar[XB_TMO])) break; if (sp > XB_SPIN_CAP) { atomicAdd(&bar[XB_TMO], 1u); break; } }
    }
    nloc = mine > 0u ? mine : 1u; nx = cnt > 0u ? cnt : 1u;
}

__device__ __forceinline__ void xcd_barrier(const XcdBarrier& b) {
    asm volatile("s_waitcnt vmcnt(0)" ::: "memory");
    __syncthreads();
    if (threadIdx.x == 0) {
        unsigned* bar = b.bar;
        __builtin_amdgcn_s_waitcnt(0);
        unsigned nloc = b.st[0], nx = b.st[1];
        if (nloc == 0u) { xcd_barrier_complete(bar, b.x, nloc, nx); b.st[0] = nloc; b.st[1] = nx; }
        const unsigned old = xb_add(&bar[XB_XSUB(b.x)], 1u);
        const unsigned gen = old / nloc;
        if (old + 1u == (gen + 1u) * nloc) {
            __builtin_amdgcn_fence(__ATOMIC_RELEASE, "agent");
            asm volatile("s_waitcnt vmcnt(0)" ::: "memory");
            const unsigned og = xb_add(&bar[XB_TOP], 1u);
            const unsigned tg = og / nx;
            if (og + 1u == (tg + 1u) * nx) xb_add(&bar[XB_TOPGEN], 1u);
            else XB_SPIN(xb_ld(&bar[XB_TOPGEN]) == tg, bar);
            __builtin_amdgcn_fence(__ATOMIC_ACQUIRE, "agent");
            xb_add(&bar[XB_XGEN(b.x)], 1u);
            asm volatile("s_waitcnt vmcnt(0)" ::: "memory");
        } else {
            XB_SPIN(xb_ld(&bar[XB_XGEN(b.x)]) == gen, bar);
            __builtin_amdgcn_fence(__ATOMIC_ACQUIRE, "agent");
            asm volatile("s_waitcnt vmcnt(0)" ::: "memory");
        }
    }
    __syncthreads();
}

struct Args;
DI void phase3(const Args& args, LAS unsigned char* lds, int tid, int wave, int lane, int G) {}
DI void phase8(const Args& args, LAS unsigned char* lds, int tid, int wave, int lane, int G) {}
DI void phase9(const Args& args, LAS unsigned char* lds, int tid, int wave, int lane, int G) {}

constexpr int NWAVES = 8, NTHREADS = 512;
constexpr int RING_BYTES = 131072, LDSCTL_OFF = RING_BYTES, MISC_OFF = LDSCTL_OFF + 320, LDS_BYTES = 147456;
constexpr int CW_BAR = 4096;
constexpr int N_PHASES = 12;
constexpr bool kSP2 = true, kALIGN = true;

DI void p0_adaln(LAS unsigned char* lds, const float* c, const float* cctx, const float* ada_w, const float* ada_b, float* MOD, int tid, int wave, int lane, int G) {
    LAS float* sl = (LAS float*)lds;
    LAS float* red = (LAS float*)(lds + 5 * 1024 * 4);
    if ((int)blockIdx.x >= 192) return;
    for (int e = tid; e < 5 * 1024; e += NTHREADS) { const int r = e >> 10, k = e & 1023; const float x = r < 4 ? c[r * 1024 + k] : cctx[k]; sl[e] = silu_f(x); }
    __syncthreads();
    for (int item = blockIdx.x; item < 192; item += G) {
        const int i = item / 96, cb = item % 96, col = cb * 32 + (lane & 31), kh = lane >> 5;
        const float* W = ada_w + (size_t)i * 1024 * 3072 + col;
        float acc[5] = {0.f, 0.f, 0.f, 0.f, 0.f};
#pragma unroll 8
        for (int kk = 0; kk < 64; ++kk) { const int k = wave * 128 + 2 * kk + kh; const float w = W[(size_t)k * 3072];
#pragma unroll
            for (int r = 0; r < 5; ++r) acc[r] += sl[r * 1024 + k] * w; }
#pragma unroll
        for (int r = 0; r < 5; ++r) { acc[r] += __shfl_xor(acc[r], 32); if (lane < 32) red[(wave * 5 + r) * 32 + lane] = acc[r]; }
        __syncthreads();
        if (tid < 160) { const int r = tid >> 5, cl = tid & 31; float s = ada_b[i * 3072 + cb * 32 + cl];
#pragma unroll
            for (int w = 0; w < 8; ++w) s += red[(w * 5 + r) * 32 + cl];
            MOD[(i * 5 + r) * 3072 + cb * 32 + cl] = s; }
        __syncthreads();
    }
}
DI void p0_transpose_item(const float* W, int K, int N, bf16_t* WT, int row_off, LAS float* scr, int item, int lane) {
    const int nblk = N / 32, kb = item / nblk, nb = item % nblk, k0 = 64 * kb, n0 = 32 * nb;
#pragma unroll 8
    for (int i = 0; i < 32; ++i) { const int kk = 2 * i + (lane >> 5); scr[kk * 33 + (lane & 31)] = W[(size_t)(k0 + kk) * N + n0 + (lane & 31)]; }
    LDS_WAIT(); asm volatile("" ::: "memory");
    const int c = lane & 7;
#pragma unroll
    for (int j = 0; j < 4; ++j) { const int n = (lane >> 3) + 8 * j; const LAS float* s = scr + (8 * c) * 33 + n;
        v4u o; o.x = pk2(s[0 * 33], s[1 * 33]); o.y = pk2(s[2 * 33], s[3 * 33]); o.z = pk2(s[4 * 33], s[5 * 33]); o.w = pk2(s[6 * 33], s[7 * 33]);
        *(v4u*)(WT + (size_t)(row_off + n0 + n) * K + k0 + 8 * c) = o; }
    LDS_WAIT(); asm volatile("" ::: "memory");
}
struct TrJob { const float* W; int K, N; bf16_t* WT; int row_off; int items; };

DI void load_row16(const float* src, int lane, float (&v)[16]) {
#pragma unroll
    for (int j = 0; j < 4; ++j) { const f32x4_t t = *(const f32x4_t*)(src + j * 256 + lane * 4); v[4 * j] = t[0]; v[4 * j + 1] = t[1]; v[4 * j + 2] = t[2]; v[4 * j + 3] = t[3]; }
}
DI float row_rinv(const float (&v)[16]) {
    float ss = 0.f;
#pragma unroll
    for (int j = 0; j < 16; ++j) ss += v[j] * v[j];
    ss = wave_sum(ss);
    return rsqrtf(ss * (1.f / DM) + EPSN);
}
DI void store_modnorm(const float (&v)[16], float rinv, const float* g, const float* m, bf16_t* dst, int lane) {
#pragma unroll
    for (int j = 0; j < 4; ++j) { const int col = j * 256 + lane * 4;
        const f32x4_t gg = *(const f32x4_t*)(g + col), sc = *(const f32x4_t*)(m + 1024 + col), sh = *(const f32x4_t*)(m + col);
        float y[4];
#pragma unroll
        for (int e = 0; e < 4; ++e) y[e] = v[4 * j + e] * rinv * gg[e] * (1.f + sc[e]) + sh[e];
        v2u o; o.x = pk2(y[0], y[1]); o.y = pk2(y[2], y[3]); *(v2u*)(dst + col) = o; }
}

struct Args { const float* in[32]; float* out; unsigned char* ws; int ph_lo, ph_hi, li, pad; };

__global__ void __launch_bounds__(NTHREADS, 2) mega(Args args) {
    extern __shared__ __attribute__((aligned(16))) unsigned char lds_raw[];
    LAS unsigned char* lds = (LAS unsigned char*)lds_raw;
    volatile LAS unsigned* MISC = (volatile LAS unsigned*)(lds + MISC_OFF);
    const int tid = threadIdx.x, lane = tid & 63, wave = __builtin_amdgcn_readfirstlane(tid >> 6);
    const int G = gridDim.x;
    unsigned char* ws = args.ws;
    gu32* ctl = (gu32*)(ws + WS_CTL);
    for (int u = tid; u < (LDS_BYTES - LDSCTL_OFF) / 4; u += NTHREADS) ((LAS unsigned*)(lds + LDSCTL_OFF))[u] = 0u;
    __syncthreads();
    XcdBarrier bar = xcd_barrier_post((unsigned*)(ctl + CW_BAR) + args.li * XCD_BAR_WORDS, MISC + 8);
    const int lo = args.ph_lo, hi = args.ph_hi;
#define IN(k) (lo <= (k) && (k) < hi)
#define SEAM(k) do { if (IN(k) && IN((k) + 1)) xcd_barrier(bar); } while (0)

    const float* x = args.in[0]; const float* cvec = args.in[1]; const float* ctxin = args.in[2]; const float* cctx = args.in[3];
    const float* ada_w = args.in[4]; const float* ada_b = args.in[5]; const float* pre_g = args.in[6]; const float* post_g = args.in[7];
    float* out = args.out;
    float* MOD = (float*)(ws + WS_MOD);
    bf16_t* XN = (bf16_t*)(ws + WS_XN); bf16_t* YMIX = (bf16_t*)(ws + WS_YMIX); bf16_t* PROJ = (bf16_t*)(ws + WS_PROJ); float* OUTF = (float*)(ws + WS_PROJ);
    bf16_t* YPRE = (bf16_t*)(ws + WS_YPRE);
    const int gw = blockIdx.x * NWAVES + wave, NGW = G * NWAVES;

    if (IN(0)) {
        p0_adaln(lds, cvec, cctx, ada_w, ada_b, MOD, tid, wave, lane, G);
        __syncthreads();
        LAS float* scr = (LAS float*)(lds + 32768 + wave * 8704);
        const TrJob jobs[5] = {
            {args.in[8], 1024, 3072, (bf16_t*)(ws + WS_WIN0T), 0, 16 * 96}, {args.in[9], 1024, 1024, (bf16_t*)(ws + WS_WOUT0T), 0, 16 * 32},
            {args.in[21], 1024, 2304, (bf16_t*)(ws + WS_WIN1T), 0, 16 * 72}, {args.in[22], 1024, 1024, (bf16_t*)(ws + WS_WOUT1T), 0, 16 * 32},
            {args.in[18], 512, 512, (bf16_t*)(ws + WS_WGLUT), 0, 8 * 16}};
        constexpr int NBIG = 16 * 96 + 16 * 32 + 16 * 72 + 16 * 32 + 8 * 16, NLRU = 32 * 2;
        for (int it = gw; it < NBIG + NLRU; it += NGW) {
            if (it < NBIG) { int r = it;
#pragma unroll
                for (int j = 0; j < 5; ++j) { if (r >= 0 && r < jobs[j].items) p0_transpose_item(jobs[j].W, jobs[j].K, jobs[j].N, jobs[j].WT, 0, scr, r, lane); r -= jobs[j].items; }
            } else { const int q = it - NBIG, mat = q >> 1, sub = q & 1, dir = mat >> 4, gate = (mat >> 3) & 1, blk = mat & 7;
                const float* W = (gate ? args.in[28] : args.in[26]) + (size_t)(dir * 8 + blk) * 4096;
                p0_transpose_item(W, 64, 64, (bf16_t*)(ws + WS_LRUWT), blk * 256 + (dir * 2 + gate) * 64, scr, sub, lane); }
        }
    }
    SEAM(0);
    if (IN(1)) {
        for (int r = gw; r < MROWS; r += NGW) {
            const float* src = r < NLAT ? x + (size_t)r * DM : ctxin + (size_t)(r - NLAT) * DM;
            float v[16]; load_row16(src, lane, v);
            store_modnorm(v, row_rinv(v), pre_g, MOD + (r < NLAT ? (r >> 12) : 4) * 3072, XN + (size_t)r * DM, lane);
        }
    }
    SEAM(1);
    if (IN(2)) {
        pg8::Gemm g{XN, (const bf16_t*)(ws + WS_WIN0T), MROWS, N0, DM}; pg8::StaticOrder S; S.init(MROWS, N0, G, (int)blockIdx.x);
        pg8::EpiProj E{PROJ, N0, (bf16_t*)(ws + WS_VT0), 2048, 2560, 512};
        pg8::gemm_phase<pg8::EpiProj, pg8::StaticOrder, kALIGN, kSP2>(lds, g, S, E);
    }
    SEAM(2);
    if (IN(3)) { phase3(args, lds, tid, wave, lane, G); }
    SEAM(3);
    if (IN(4)) {
        pg8::Gemm g{YPRE, (const bf16_t*)(ws + WS_WGLUT), MROWS, 512, 512}; pg8::StaticOrder S; S.init(MROWS, 512, G, (int)blockIdx.x);
        pg8::EpiGlu E{YPRE, PROJ, args.in[19], YMIX};
        pg8::gemm_phase<pg8::EpiGlu, pg8::StaticOrder, kALIGN, kSP2>(lds, g, S, E);
    }
    SEAM(4);
    if (IN(5)) {
        pg8::Gemm g{YMIX, (const bf16_t*)(ws + WS_WOUT0T), MROWS, DM, DM}; pg8::StaticOrder S; S.init(MROWS, DM, G, (int)blockIdx.x);
        pg8::EpiF32 E{OUTF, DM};
        pg8::gemm_phase<pg8::EpiF32, pg8::StaticOrder, kALIGN, kSP2>(lds, g, S, E);
    }
    SEAM(5);
    if (IN(6)) {
        for (int r = gw; r < MROWS; r += NGW) {
            const int mrow = r < NLAT ? (r >> 12) : 4;
            const float* hin = r < NLAT ? x + (size_t)r * DM : ctxin + (size_t)(r - NLAT) * DM;
            float v[16], h[16]; load_row16(OUTF + (size_t)r * DM, lane, v); load_row16(hin, lane, h);
            const float rinv = row_rinv(v); const float* gt = MOD + mrow * 3072 + 2048;
#pragma unroll
            for (int j = 0; j < 4; ++j) { const int col = j * 256 + lane * 4; const f32x4_t pg = *(const f32x4_t*)(post_g + col), gg = *(const f32x4_t*)(gt + col);
#pragma unroll
                for (int e = 0; e < 4; ++e) h[4 * j + e] += gg[e] * (v[4 * j + e] * rinv * pg[e]);
                if (r < NLAT) *(f32x4_t*)(out + (size_t)r * DM + col) = (f32x4_t){h[4 * j], h[4 * j + 1], h[4 * j + 2], h[4 * j + 3]}; }
            store_modnorm(h, row_rinv(h), pre_g + DM, MOD + (5 + mrow) * 3072, XN + (size_t)r * DM, lane);
        }
    }
    SEAM(6);
    if (IN(7)) {
        pg8::Gemm g{XN, (const bf16_t*)(ws + WS_WIN1T), MROWS, N1, DM}; pg8::StaticOrder S; S.init(MROWS, N1, G, (int)blockIdx.x);
        pg8::EpiProj E{PROJ, N1, (bf16_t*)(ws + WS_VT1), 1664, 1792, 128};
        pg8::gemm_phase<pg8::EpiProj, pg8::StaticOrder, kALIGN, kSP2>(lds, g, S, E);
    }
    SEAM(7);
    if (IN(8)) { phase8(args, lds, tid, wave, lane, G); }
    SEAM(8);
    if (IN(9)) { phase9(args, lds, tid, wave, lane, G); }
    SEAM(9);
    if (IN(10)) {
        pg8::Gemm g{YMIX, (const bf16_t*)(ws + WS_WOUT1T), NLAT, DM, DM}; pg8::StaticOrder S; S.init(NLAT, DM, G, (int)blockIdx.x);
        pg8::EpiF32 E{OUTF, DM};
        pg8::gemm_phase<pg8::EpiF32, pg8::StaticOrder, kALIGN, kSP2>(lds, g, S, E);
    }
    SEAM(10);
    if (IN(11)) {
        for (int r = gw; r < NLAT; r += NGW) {
            float v[16], h[16]; load_row16(OUTF + (size_t)r * DM, lane, v); load_row16(out + (size_t)r * DM, lane, h);
            const float rinv = row_rinv(v); const float* gt = MOD + (5 + (r >> 12)) * 3072 + 2048;
#pragma unroll
            for (int j = 0; j < 4; ++j) { const int col = j * 256 + lane * 4; const f32x4_t pg = *(const f32x4_t*)(post_g + DM + col), gg = *(const f32x4_t*)(gt + col);
                f32x4_t o;
#pragma unroll
                for (int e = 0; e < 4; ++e) o[e] = h[4 * j + e] + gg[e] * (v[4 * j + e] * rinv * pg[e]);
                *(f32x4_t*)(out + (size_t)r * DM + col) = o; }
        }
    }
#undef IN
#undef SEAM
}
__global__ void k_adaln(const float* c, const float* cctx, const float* ada_w, const float* ada_b, float* mod) {
    const int idx = blockIdx.x * blockDim.x + threadIdx.x;
    if (idx >= 2 * 5 * 3072) return;
    const int col = idx % 3072, r = (idx / 3072) % 5, i = idx / (3072 * 5);
    const float* cv = r < 4 ? c + r * 1024 : cctx;
    const float* W = ada_w + (size_t)i * 1024 * 3072;
    float acc = 0.f;
    for (int k = 0; k < 1024; ++k) acc += silu_f(cv[k]) * W[(size_t)k * 3072 + col];
    mod[idx] = acc + ada_b[i * 3072 + col];
}

__global__ void k_prenorm(const float* lat, const float* ctx, const float* g, const float* mod  , bf16_t* XN) {
    const int r = blockIdx.x * 4 + (threadIdx.x >> 6), lane = threadIdx.x & 63;
    if (r >= MROWS) return;
    const float* src = r < NLAT ? lat + (size_t)r * DM : ctx + (size_t)(r - NLAT) * DM;
    const float* m = mod + (r < NLAT ? (r >> 12) : 4) * 3072;
    float v[16]; float ss = 0.f;
#pragma unroll
    for (int j = 0; j < 4; ++j) { const float4 t = *(const float4*)(src + j * 256 + lane * 4); v[4 * j] = t.x; v[4 * j + 1] = t.y; v[4 * j + 2] = t.z; v[4 * j + 3] = t.w; }
#pragma unroll
    for (int j = 0; j < 16; ++j) ss += v[j] * v[j];
    ss = wave_sum(ss);
    const float rinv = rsqrtf(ss * (1.f / DM) + EPSN);
#pragma unroll
    for (int j = 0; j < 4; ++j)
#pragma unroll
        for (int e = 0; e < 4; ++e) { const int col = j * 256 + lane * 4 + e; const float y = v[4 * j + e] * rinv * g[col] * (1.f + m[1024 + col]) + m[col]; XN[(size_t)r * DM + col] = f2bf(y); }
}

__global__ void k_postnorm(const float* hlat, const float* hctx, const float* OUT, const float* pg, const float* mod, float* olat, float* octx, int nrows) {
    const int r = blockIdx.x * 4 + (threadIdx.x >> 6), lane = threadIdx.x & 63;
    if (r >= nrows) return;
    const float* hin = r < NLAT ? hlat + (size_t)r * DM : hctx + (size_t)(r - NLAT) * DM;
    float* ho = r < NLAT ? olat + (size_t)r * DM : octx + (size_t)(r - NLAT) * DM;
    const float* m = mod + (r < NLAT ? (r >> 12) : 4) * 3072 + 2048;
    const float* src = OUT + (size_t)r * DM;
    float v[16]; float ss = 0.f;
#pragma unroll
    for (int j = 0; j < 4; ++j) { const float4 t = *(const float4*)(src + j * 256 + lane * 4); v[4 * j] = t.x; v[4 * j + 1] = t.y; v[4 * j + 2] = t.z; v[4 * j + 3] = t.w; }
#pragma unroll
    for (int j = 0; j < 16; ++j) ss += v[j] * v[j];
    ss = wave_sum(ss);
    const float rinv = rsqrtf(ss * (1.f / DM) + EPSN);
#pragma unroll
    for (int j = 0; j < 4; ++j)
#pragma unroll
        for (int e = 0; e < 4; ++e) { const int col = j * 256 + lane * 4 + e; ho[col] = hin[col] + m[col] * (v[4 * j + e] * rinv * pg[col]); }
}

enum { GM_PROJ0 = 0, GM_PROJ1 = 1, GM_GLU = 2, GM_F32 = 3 };
struct GemmEpi { bf16_t* P; bf16_t* VT; const bf16_t* YPRE; const bf16_t* PROJ; const float* bglu; bf16_t* YMIX; float* OUT; };
template <int MODE> __global__ void __launch_bounds__(256) k_gemm(const bf16_t* A, const float* W, int M, int N, int K, GemmEpi e) {
    const int tx = threadIdx.x & 15, ty = threadIdx.x >> 4;
    const int c0 = blockIdx.x * 64 + tx * 4, r0 = blockIdx.y * 64 + ty * 4;
    float acc[4][4] = {};
    for (int k = 0; k < K; ++k) {
        const float4 w = *(const float4*)(W + (size_t)k * N + c0);
        const float wv[4] = {rbf(w.x), rbf(w.y), rbf(w.z), rbf(w.w)};
#pragma unroll
        for (int i = 0; i < 4; ++i) { const float a = bf2f(A[(size_t)(r0 + i) * K + k]);
#pragma unroll
            for (int j = 0; j < 4; ++j) acc[i][j] += a * wv[j]; }
    }
#pragma unroll
    for (int i = 0; i < 4; ++i)
#pragma unroll
        for (int j = 0; j < 4; ++j) {
            const int r = r0 + i, c = c0 + j; const float v = acc[i][j];
            if (MODE == GM_PROJ0) { e.P[(size_t)r * N0 + c] = f2bf(v);
                if (c >= 2048 && c < 2560) { const int hd = c - 2048; e.VT[((size_t)(row_batch(r) * 8) * 64 + hd) * POSN + row_pos(r)] = f2bf(v); } }
            else if (MODE == GM_PROJ1) { e.P[(size_t)r * N1 + c] = f2bf(v);
                if (c >= 1664 && c < 1792) { const int hd = c - 1664; e.VT[((size_t)(row_batch(r) * 2) * 64 + hd) * POSN + row_pos(r)] = f2bf(v); } }
            else if (MODE == GM_GLU) { const float y = bf2f(e.YPRE[(size_t)r * 512 + c]); const float ga = bf2f(e.PROJ[(size_t)r * N0 + 512 + c]);
                e.YMIX[(size_t)r * DM + c] = f2bf(y * sigmoid_f(v + e.bglu[c]) * silu_f(ga)); }
            else e.OUT[(size_t)r * N + c] = v;
        }
}

__global__ void __launch_bounds__(64) k_s5_scan(const bf16_t* PROJ, const float* lam_re, const float* lam_im, const float* log_dt, const float* b_re, const float* b_im,
                                                 const float* c_re, const float* c_im, float* YS) {
    const int p = threadIdx.x, id = blockIdx.x, dir = id & 1, g = (id >> 1) & 31, b = id >> 6;
    const int gi = (dir * 32 + g);
    const double lre = lam_re[gi * 64 + p], lim = lam_im[gi * 64 + p], dt = exp((double)log_dt[gi]);
    const double mag = exp(lre * dt); const float ar = (float)(mag * cos(lim * dt)), ai = (float)(mag * sin(lim * dt));
    const double nr = mag * cos(lim * dt) - 1.0, ni = mag * sin(lim * dt), den = lre * lre + lim * lim;
    const float cfr = (float)((nr * lre + ni * lim) / den), cfi = (float)((ni * lre - nr * lim) / den);
    float bbr[16], bbi[16], cr[16], ci[16];
#pragma unroll
    for (int h = 0; h < 16; ++h) { const float br = b_re[(gi * 64 + p) * 16 + h], bi = b_im[(gi * 64 + p) * 16 + h]; bbr[h] = cfr * br - cfi * bi; bbi[h] = cfr * bi + cfi * br;
        cr[h] = c_re[(gi * 16 + h) * 64 + p]; ci[h] = c_im[(gi * 16 + h) * 64 + p]; }
    float hr = 0.f, hi = 0.f;
    float* ys = YS + (size_t)dir * MROWS * 512;
    for (int pos = 0; pos < POSN; ++pos) {
        int row;
        if (dir == 0) row = pos_row(b, pos); else row = pos < LC ? NLAT + b * LC + (LC - 1 - pos) : b * SEQ + (SEQ - 1 - (pos - LC));
        const bf16_t* up = PROJ + (size_t)row * N0 + g * 16;
        float bur = 0.f, bui = 0.f;
#pragma unroll
        for (int h = 0; h < 16; ++h) { const float u = bf2f(up[h]); bur += bbr[h] * u; bui += bbi[h] * u; }
        const float nhr = ar * hr - ai * hi + bur, nhi = ar * hi + ai * hr + bui; hr = nhr; hi = nhi;
        float mine = 0.f;
#pragma unroll
        for (int h = 0; h < 16; ++h) { const float y = wave_sum(cr[h] * hr - ci[h] * hi); if (p == h) mine = y; }
        if (p < 16) ys[(size_t)row * 512 + g * 16 + p] = mine;
    }
}
__global__ void k_s5_finish(const bf16_t* PROJ, const float* YS, const float* dsk, bf16_t* YPRE) {
    const size_t idx = (size_t)blockIdx.x * blockDim.x + threadIdx.x; if (idx >= (size_t)MROWS * 512) return;
    const int ch = idx & 511; const size_t r = idx >> 9;
    const float y = dsk[ch] * bf2f(PROJ[r * N0 + ch]) + YS[idx] + YS[(size_t)MROWS * 512 + idx];
    YPRE[idx] = f2bf(gelu_tanh(y));
}

__global__ void __launch_bounds__(256) k_na_attn(const bf16_t* PROJ, const float* relb, bf16_t* YMIX) {
    const int wv = blockIdx.x * 4 + (threadIdx.x >> 6), lane = threadIdx.x & 63;
    if (wv >= MROWS * 8) return;
    const int h = wv & 7, r = wv >> 3, b = row_batch(r);
    const float q = bf2f(PROJ[(size_t)r * N0 + 1024 + h * 64 + lane]);
    float m = -INFINITY, l = 0.f, o = 0.f;
    if (r < NLAT) {
        const int t = r & 4095, qr = t >> 6, qc = t & 63;
        const int rs = min(max(qr - 4, 0), 56), cs = min(max(qc - 8, 0), 48);
        for (int kr = rs; kr < rs + 8; ++kr)
            for (int kc = cs; kc < cs + 16; ++kc) {
                const size_t kro = (size_t)(b * SEQ + kr * 64 + kc) * N0;
                float s = wave_sum(q * bf2f(PROJ[kro + 1536 + h * 64 + lane])) * 0.125f + relb[(h * 15 + (kr - qr + 7)) * 31 + (kc - qc + 15)];
                const float mn = fmaxf(m, s), al = __expf(m - mn), pp = __expf(s - mn);
                l = l * al + pp; o = o * al + pp * bf2f(PROJ[kro + 2048 + h * 64 + lane]); m = mn;
            }
    }
    for (int c = 0; c < LC; ++c) {
        const size_t kro = (size_t)(NLAT + b * LC + c) * N0;
        const float s = wave_sum(q * bf2f(PROJ[kro + 1536 + h * 64 + lane])) * 0.125f;
        const float mn = fmaxf(m, s), al = __expf(m - mn), pp = __expf(s - mn);
        l = l * al + pp; o = o * al + pp * bf2f(PROJ[kro + 2048 + h * 64 + lane]); m = mn;
    }
    const float gb = bf2f(PROJ[(size_t)r * N0 + 2560 + h * 64 + lane]);
    YMIX[(size_t)r * DM + 512 + h * 64 + lane] = f2bf(o / l * silu_f(gb));
}

__global__ void __launch_bounds__(64) k_lru(const bf16_t* P1, const float* conv_w, const float* conv_b, const float* lam, const float* w_a, const float* b_a,
                                            const float* w_x, const float* b_x, float* HS, bf16_t* YMIX) {
    __shared__ float xs[64];
    const int j = threadIdx.x, nb = blockIdx.x & 7, b = blockIdx.x >> 3, ch = nb * 64 + j;
    const float cw0 = conv_w[0 * 512 + ch], cw1 = conv_w[1 * 512 + ch], cw2 = conv_w[2 * 512 + ch], cw3 = conv_w[3 * 512 + ch], cb = conv_b[ch];
    for (int dir = 0; dir < 2; ++dir) {
        float wa[64], wx[64];
#pragma unroll
        for (int i = 0; i < 64; ++i) { wa[i] = w_a[((dir * 8 + nb) * 64 + i) * 64 + j]; wx[i] = w_x[((dir * 8 + nb) * 64 + i) * 64 + j]; }
        const float ba = b_a[dir * 512 + ch], bx = b_x[dir * 512 + ch];
        const float lm = lam[dir * 512 + ch]; const float sp = (-lm > 20.f) ? -lm : log1pf(__expf(-lm));
        float hst = 0.f;
        for (int pos = 0; pos < POSN; ++pos) {
            int s0, sl, t;
            if (pos < LC) { s0 = NLAT + b * LC; sl = LC; t = dir == 0 ? pos : LC - 1 - pos; }
            else { s0 = b * SEQ; sl = SEQ; t = dir == 0 ? pos - LC : SEQ - 1 - (pos - LC); }
            float xm1 = 0.f, x0, xp1 = 0.f, xp2 = 0.f;
            x0 = bf2f(P1[(size_t)(s0 + t) * N1 + ch]);
            if (t - 1 >= 0) xm1 = bf2f(P1[(size_t)(s0 + t - 1) * N1 + ch]);
            if (t + 1 < sl) xp1 = bf2f(P1[(size_t)(s0 + t + 1) * N1 + ch]);
            if (t + 2 < sl) xp2 = bf2f(P1[(size_t)(s0 + t + 2) * N1 + ch]);
            const float xc = cw0 * xm1 + cw1 * x0 + cw2 * xp1 + cw3 * xp2 + cb;
            __syncthreads(); xs[j] = xc; __syncthreads();
            float ga = ba, gx = bx;
#pragma unroll
            for (int i = 0; i < 64; ++i) { const float xi = xs[i]; ga += xi * wa[i]; gx += xi * wx[i]; }
            const float gr = sigmoid_f(ga), gi = sigmoid_f(gx);
            const float log_a = -8.f * gr * sp; const float a = __expf(log_a); const float mult = sqrtf(fmaxf(-expm1f(2.f * log_a), 0.f));
            hst = a * hst + mult * gi * xc;
            if (pos >= LC) { const size_t rr = (size_t)(s0 + t);
                if (dir == 0) HS[rr * 512 + ch] = hst;
                else { const float gc = bf2f(P1[rr * N1 + 512 + ch]); YMIX[rr * DM + ch] = f2bf((HS[rr * 512 + ch] + hst) * silu_f(gc)); } }
        }
    }
}

__global__ void __launch_bounds__(256) k_qkprep(const bf16_t* P1, const float* qn, const float* kn, bf16_t* QP, bf16_t* KP) {
    const int wv = blockIdx.x * 4 + (threadIdx.x >> 6), lane = threadIdx.x & 63;
    if (wv >= MROWS * 10) return;
    const int slot = wv % 10, r = wv / 10, b = row_batch(r);
    if (slot < 8 && r >= NLAT) return;
    const int col0 = slot < 8 ? 1024 + slot * 64 : 1536 + (slot - 8) * 64;
    const float x = bf2f(P1[(size_t)r * N1 + col0 + lane]);
    const float ss = wave_sum(x * x);
    float y = x * rsqrtf(ss * (1.f / 64.f) + EPSN) * (slot < 8 ? qn[lane] : kn[lane]);
    if (r < NLAT) {
        const int t = r & 4095, i = lane >> 1, f = i & 15; const float pos = (float)(i < 16 ? (t >> 6) : (t & 63));
        const float inv = (float)exp(-log(10000.0) * (double)(2 * f) / 32.0);
        const float ang = pos * inv; const float cs = cosf(ang), sn = sinf(ang);
        const float pr = __shfl_xor(y, 1);
        y = (lane & 1) ? (pr * sn + y * cs) : (y * cs - pr * sn);
    }
    if (slot < 8) QP[((size_t)(b * 8 + slot) * SEQ + (r & 4095)) * 64 + lane] = f2bf(y * (0.125f * LOG2E));
    else KP[((size_t)(b * 2 + (slot - 8)) * POSN + row_pos(r)) * 64 + lane] = f2bf(y);
}

__global__ void __launch_bounds__(256) k_gqa(const bf16_t* QP, const bf16_t* KP, const bf16_t* P1, bf16_t* YMIX) {
    const int wv = blockIdx.x * 4 + (threadIdx.x >> 6), lane = threadIdx.x & 63;
    if (wv >= NLAT * 8) return;
    const int hq = wv & 7, r = wv >> 3, b = r >> 12, t = r & 4095, kvh = hq >> 2;
    const float q = bf2f(QP[((size_t)(b * 8 + hq) * SEQ + t) * 64 + lane]);
    const bf16_t* kp = KP + (size_t)(b * 2 + kvh) * POSN * 64;
    float m = -INFINITY, l = 0.f, o = 0.f;
    for (int pos = 0; pos < POSN; ++pos) {
        const float s = wave_sum(q * bf2f(kp[(size_t)pos * 64 + lane]));
        const float v = bf2f(P1[(size_t)pos_row(b, pos) * N1 + 1664 + kvh * 64 + lane]);
        const float mn = fmaxf(m, s), al = exp2f(m - mn), pp = exp2f(s - mn);
        l = l * al + pp; o = o * al + pp * v; m = mn;
    }
    const float gd = bf2f(P1[(size_t)r * N1 + 1792 + hq * 64 + lane]);
    YMIX[(size_t)r * DM + 512 + hq * 64 + lane] = f2bf(o / l * silu_f(gd));
}

static int g_grid = 0;
static void launch_mega(Args a, int lo, int hi, int li, hipStream_t stream) {
    a.ph_lo = lo; a.ph_hi = hi; a.li = li;
    hipLaunchKernelGGL(mega, dim3(g_grid), dim3(NTHREADS), LDS_BYTES, stream, a);
    const hipError_t le = hipPeekAtLastError();
    if (le != hipSuccess) fprintf(stderr, "kernel_launch: mega[%d,%d) failed: %s\n", lo, hi, hipGetErrorName(le));
}
extern "C" void kernel_launch(void* const* d_in, const int* in_sizes, int n_in, void* d_out, int out_size, void* d_ws, size_t ws_size, hipStream_t stream) {
    if (g_grid == 0) {
        int dev = 0, cus = 0;
        if (hipGetDevice(&dev) != hipSuccess || hipDeviceGetAttribute(&cus, hipDeviceAttributeMultiprocessorCount, dev) != hipSuccess) { fprintf(stderr, "kernel_launch: device query failed\n"); g_grid = -1; return; }
        if (hipFuncSetAttribute((const void*)mega, hipFuncAttributeMaxDynamicSharedMemorySize, LDS_BYTES) != hipSuccess) { fprintf(stderr, "kernel_launch: hipFuncSetAttribute failed\n"); g_grid = -1; return; }
        int per_cu = 0;
        if (hipOccupancyMaxActiveBlocksPerMultiprocessor(&per_cu, (const void*)mega, NTHREADS, LDS_BYTES) != hipSuccess || per_cu < 1) fprintf(stderr, "kernel_launch: occupancy query says %d blocks/CU\n", per_cu);
        (void)hipGetLastError();
        g_grid = cus;
    }
    if (g_grid < 0) return;
    const float* x = (const float*)d_in[0]; const float* c = (const float*)d_in[1]; const float* ctx = (const float*)d_in[2]; const float* cctx = (const float*)d_in[3];
    const float* ada_w = (const float*)d_in[4]; const float* ada_b = (const float*)d_in[5]; const float* pre_g = (const float*)d_in[6]; const float* post_g = (const float*)d_in[7];
    const float* ev_w_in = (const float*)d_in[8]; const float* ev_w_out = (const float*)d_in[9];
    const float* s5_lre = (const float*)d_in[10]; const float* s5_lim = (const float*)d_in[11]; const float* s5_ldt = (const float*)d_in[12];
    const float* s5_bre = (const float*)d_in[13]; const float* s5_bim = (const float*)d_in[14]; const float* s5_cre = (const float*)d_in[15]; const float* s5_cim = (const float*)d_in[16];
    const float* s5_d = (const float*)d_in[17]; const float* s5_wglu = (const float*)d_in[18]; const float* s5_bglu = (const float*)d_in[19]; const float* relb = (const float*)d_in[20];
    const float* od_w_in = (const float*)d_in[21]; const float* od_w_out = (const float*)d_in[22]; const float* conv_w = (const float*)d_in[23]; const float* conv_b = (const float*)d_in[24];
    const float* lru_lam = (const float*)d_in[25]; const float* w_a = (const float*)d_in[26]; const float* b_a = (const float*)d_in[27]; const float* w_x = (const float*)d_in[28]; const float* b_x = (const float*)d_in[29];
    const float* qn = (const float*)d_in[30]; const float* kn = (const float*)d_in[31];
    char* ws = (char*)d_ws; float* out = (float*)d_out;
    float* MOD = (float*)(ws + WS_MOD); float* HC1 = (float*)(ws + WS_HC1);
    bf16_t* XN = (bf16_t*)(ws + WS_XN); bf16_t* YMIX = (bf16_t*)(ws + WS_YMIX); bf16_t* PROJ = (bf16_t*)(ws + WS_PROJ); float* OUTF = (float*)(ws + WS_PROJ);
    bf16_t* VT0 = (bf16_t*)(ws + WS_VT0); bf16_t* YPRE = (bf16_t*)(ws + WS_YPRE); bf16_t* QP = (bf16_t*)(ws + WS_QP); bf16_t* KP = (bf16_t*)(ws + WS_KP); bf16_t* VT1 = (bf16_t*)(ws + WS_VT1);
    float* YS = (float*)(ws + WS_YS); float* HS = (float*)(ws + WS_HS);
    (void)x; (void)c; (void)ctx; (void)cctx; (void)ada_w; (void)ada_b; (void)pre_g; (void)post_g; (void)ev_w_in; (void)ev_w_out; (void)s5_wglu; (void)od_w_in; (void)od_w_out; (void)MOD; (void)HC1; (void)XN; (void)OUTF; (void)VT0; (void)VT1; (void)out;

    if (hipMemsetAsync(ws + WS_CTL, 0, CTL_ZERO_BYTES, stream) != hipSuccess) { fprintf(stderr, "kernel_launch: memset failed\n"); return; }
    Args a{};
    for (int i = 0; i < 32; ++i) a.in[i] = (const float*)d_in[i];
    a.out = (float*)d_out; a.ws = (unsigned char*)d_ws;

    launch_mega(a, 0, 3, 0, stream);
    k_s5_scan<<<NB * 32 * 2, 64, 0, stream>>>(PROJ, s5_lre, s5_lim, s5_ldt, s5_bre, s5_bim, s5_cre, s5_cim, YS);
    k_s5_finish<<<(MROWS * 512) / 256, 256, 0, stream>>>(PROJ, YS, s5_d, YPRE);
    k_na_attn<<<MROWS * 8 / 4, 256, 0, stream>>>(PROJ, relb, YMIX);
    launch_mega(a, 4, 8, 1, stream);
    k_lru<<<NB * 8, 64, 0, stream>>>(PROJ, conv_w, conv_b, lru_lam, w_a, b_a, w_x, b_x, HS, YMIX);
    k_qkprep<<<(MROWS * 10 + 3) / 4, 256, 0, stream>>>(PROJ, qn, kn, QP, KP);
    k_gqa<<<NLAT * 8 / 4, 256, 0, stream>>>(QP, KP, PROJ, YMIX);
    launch_mega(a, 10, 12, 2, stream);
}
```

```cpp
#include <hip/hip_runtime.h>
#include <cstdint>
#include <cstdio>

typedef unsigned short bf16_t;
#define DI __device__ __forceinline__
#define GAS __attribute__((address_space(1)))
#define LAS __attribute__((address_space(3)))
typedef unsigned v4u __attribute__((ext_vector_type(4)));
typedef unsigned v2u __attribute__((ext_vector_type(2)));
typedef float f32x4_t __attribute__((ext_vector_type(4)));
typedef float f32x16_t __attribute__((ext_vector_type(16)));
typedef short bf16x8_t __attribute__((ext_vector_type(8)));
typedef short s16x4_t __attribute__((ext_vector_type(4)));
typedef GAS unsigned gu32;
typedef GAS unsigned long long gu64;
#define RLX_AGENT __ATOMIC_RELAXED, __HIP_MEMORY_SCOPE_AGENT
#define LDS_WAIT() asm volatile("s_waitcnt lgkmcnt(0)" ::: "memory")
#define VM_WAIT() asm volatile("s_waitcnt vmcnt(0)" ::: "memory")

DI float bf2f(bf16_t v) { return __uint_as_float((unsigned)v << 16); }
DI bf16_t f2bf(float f) { unsigned u = __float_as_uint(f); return (bf16_t)((u + 0x7fffu + ((u >> 16) & 1u)) >> 16); }
DI unsigned pk2(float lo, float hi) { return (unsigned)f2bf(lo) | ((unsigned)f2bf(hi) << 16); }
DI float bflo(unsigned w) { return __uint_as_float(w << 16); }
DI float bfhi(unsigned w) { return __uint_as_float(w & 0xffff0000u); }
DI float rbf(float f) { return bf2f(f2bf(f)); }
DI float wave_sum(float v) {
#pragma unroll
    for (int o = 1; o < 64; o <<= 1) v += __shfl_xor(v, o);
    return v;
}
DI float silu_f(float x) { return x / (1.f + __expf(-x)); }
DI float sigmoid_f(float x) { return 1.f / (1.f + __expf(-x)); }
DI float gelu_tanh(float x) { const float u = 0.7978845608028654f * (x + 0.044715f * x * x * x); return 0.5f * x * (1.f + tanhf(u)); }
DI float gelu_fast(float x) { const float u = 1.5957691216057308f * (x + 0.044715f * x * x * x); return x / (1.f + __expf(-u)); }

constexpr int NWAVES = 8, NTHREADS = 512;
constexpr int DM = 1024, NB = 4, SEQ = 4096, LC = 256;
constexpr int NLAT = NB * SEQ, NCTX = NB * LC, MROWS = NLAT + NCTX;
constexpr int N0 = 3072, N1 = 2304, POSN = LC + SEQ;
constexpr float EPSN = 1e-6f;
constexpr float LOG2E = 1.4426950408889634f;

constexpr size_t MiB = 1u << 20;
constexpr size_t WS_CTL = 0, CTL_ZERO_BYTES = 1 * MiB;
constexpr size_t WS_MOD = 1 * MiB;
constexpr size_t WS_ROPE = 2 * MiB;
constexpr size_t WS_L16 = 3 * MiB;
constexpr size_t WS_WIN0T = 4 * MiB;
constexpr size_t WS_WOUT0T = 10 * MiB;
constexpr size_t WS_WIN1T = 12 * MiB;
constexpr size_t WS_WOUT1T = 17 * MiB;
constexpr size_t WS_WGLUT = 19 * MiB;
constexpr size_t WS_LRUWT = 19 * MiB + 512 * 1024;
constexpr size_t WS_W16 = 20 * MiB;
constexpr size_t WS_WC = 24 * MiB;
constexpr size_t WS_KT = 28 * MiB;
constexpr size_t WS_LSUM = 29 * MiB;
constexpr size_t WS_XN = 32 * MiB;
constexpr size_t WS_YMIX = 66 * MiB;
constexpr size_t WS_PROJ = 100 * MiB;
constexpr size_t WS_VT0 = 202 * MiB;
constexpr size_t WS_CARRY1 = 219 * MiB;
constexpr size_t WS_YPRE = 228 * MiB;
constexpr size_t WS_QP = 202 * MiB;
constexpr size_t WS_KP = 218 * MiB;
constexpr size_t WS_VT1 = 223 * MiB;
constexpr size_t WS_YS = 32 * MiB;
constexpr size_t WS_HS = 32 * MiB;
constexpr size_t WS_HC1 = 246 * MiB;

DI int row_batch(int r) { return r < NLAT ? (r >> 12) : ((r - NLAT) >> 8); }
DI int row_pos(int r) { return r < NLAT ? LC + (r & 4095) : ((r - NLAT) & 255); }
DI int pos_row(int b, int pos) { return pos < LC ? NLAT + b * LC + pos : b * SEQ + (pos - LC); }

namespace pg8 {
#define PG8_LAS __attribute__((address_space(3)))
typedef unsigned short bf16_t;
typedef short bf16x8 __attribute__((ext_vector_type(8)));
typedef float f32x4 __attribute__((ext_vector_type(4)));
typedef unsigned u32x4 __attribute__((ext_vector_type(4)));
constexpr int BM = 256, BK = 64, HALF = 128, HTB = HALF * BK * 2  , STAGE_BYTES = 8 * HTB, NXCD = 8, WGM = 8;

__host__ __device__ __forceinline__ int lds_byte(int r, int c) { const int st = (r >> 4) * 2 + (c >> 5), rr = r & 15, cc = c & 31, ob = rr * 64 + cc * 2; return st * 1024 + (ob ^ (((ob >> 9) & 1) << 5)); }
__host__ __device__ __forceinline__ void stage_rc(int b, int& R, int& C) { const int st = b / 1024, sb = b % 1024, swz = sb ^ (((sb >> 9) & 1) << 5); R = (st >> 1) * 16 + swz / 64; C = (st & 1) * 32 + (swz % 64) / 2; }
__host__ __device__ __forceinline__ int perm32(int rho) { const int n = rho >> 4, i = rho & 15; return 8 * (i >> 2) + 4 * n + (i & 3); }

struct Unit { int pm, pn; };
struct Gemm { const bf16_t* A; const bf16_t* Bt; int M, N, K; };

struct StaticOrder {
    int nM, nN, nwg, G, c;
    __host__ __device__ void init(int M, int N, int G_, int c_) { nM = M / BM; nN = N / BM; nwg = nM * nN; G = G_; c = c_; }
    __host__ __device__ bool next(int i, Unit& u) const {
        const long L = (long)i * G + c; if (L >= nwg) return false;
        int wgid = (int)L; { const int q = nwg / NXCD, r = nwg % NXCD, xcd = wgid % NXCD, off = wgid / NXCD; wgid = (xcd < r ? xcd * (q + 1) : r * (q + 1) + (xcd - r) * q) + off; }
        const int nig = WGM * nN, gid = wgid / nig, fm = gid * WGM, gsz = (nM - fm) < WGM ? (nM - fm) : WGM;
        u.pm = fm + ((wgid % nig) % gsz); u.pn = (wgid % nig) / gsz; return true;
    }
    __device__ __forceinline__ void a_ready(const Unit&) const {}
    __device__ __forceinline__ void done(const Unit&) const {}
};

__device__ __forceinline__ unsigned cvt_pk_bf16(float lo, float hi) { unsigned r; asm volatile("v_cvt_pk_bf16_f32 %0, %1, %2" : "=v"(r) : "v"(lo), "v"(hi)); return r; }

struct EpiProj {
    static constexpr bool PERM = true, AFTER_DRAIN = false;
    bf16_t* P; int ldc; bf16_t* VT; int vt_lo, vt_hi, vt_w;
    __device__ __forceinline__ void operator()(const f32x4 (&acc)[2][2][4][2], const Unit& u, int wr, int wc, int fr, int fq) const {
        const int row0 = u.pm * BM + wr * 64 + fr, colt = u.pn * BM + wc * 32 + 8 * fq;
#pragma unroll
        for (int ai = 0; ai < 2; ++ai)
#pragma unroll
            for (int m = 0; m < 4; ++m) { const int r = row0 + ai * HALF + m * 16; bf16_t* rowp = P + (size_t)r * ldc + colt;
#pragma unroll
                for (int bj = 0; bj < 2; ++bj) { const f32x4 v0 = acc[ai][bj][m][0], v1 = acc[ai][bj][m][1];
                    u32x4 w; w.x = cvt_pk_bf16(v0[0], v0[1]); w.y = cvt_pk_bf16(v0[2], v0[3]); w.z = cvt_pk_bf16(v1[0], v1[1]); w.w = cvt_pk_bf16(v1[2], v1[3]);
                    *(u32x4*)(rowp + bj * HALF) = w;
                    const int c0 = colt + bj * HALF;
                    if (c0 >= vt_lo && c0 < vt_hi) {
                        bf16_t* vp = VT + ((size_t)row_batch(r) * vt_w + (c0 - vt_lo)) * POSN + row_pos(r);
                        vp[0 * POSN] = (bf16_t)(w.x & 0xffffu); vp[1 * POSN] = (bf16_t)(w.x >> 16); vp[2 * POSN] = (bf16_t)(w.y & 0xffffu); vp[3 * POSN] = (bf16_t)(w.y >> 16);
                        vp[4 * POSN] = (bf16_t)(w.z & 0xffffu); vp[5 * POSN] = (bf16_t)(w.z >> 16); vp[6 * POSN] = (bf16_t)(w.w & 0xffffu); vp[7 * POSN] = (bf16_t)(w.w >> 16);
                    } } }
    }
};
struct EpiGlu {
    static constexpr bool PERM = true, AFTER_DRAIN = false;
    const bf16_t* YPRE; const bf16_t* PROJ; const float* bglu; bf16_t* YMIX;
    __device__ __forceinline__ void operator()(const f32x4 (&acc)[2][2][4][2], const Unit& u, int wr, int wc, int fr, int fq) const {
        const int row0 = u.pm * BM + wr * 64 + fr, colt = u.pn * BM + wc * 32 + 8 * fq;
#pragma unroll
        for (int bj = 0; bj < 2; ++bj) { const int c0 = colt + bj * HALF;
            const f32x4 b0 = *(const f32x4*)(bglu + c0), b1 = *(const f32x4*)(bglu + c0 + 4);
#pragma unroll
            for (int ai = 0; ai < 2; ++ai)
#pragma unroll
                for (int m = 0; m < 4; ++m) { const int r = row0 + ai * HALF + m * 16;
                    const u32x4 yv = *(const u32x4*)(YPRE + (size_t)r * 512 + c0), gv = *(const u32x4*)(PROJ + (size_t)r * N0 + 512 + c0);
                    const f32x4 a0 = acc[ai][bj][m][0] + b0, a1 = acc[ai][bj][m][1] + b1;
                    float o[8];
                    o[0] = bflo(yv.x) * sigmoid_f(a0[0]) * silu_f(bflo(gv.x)); o[1] = bfhi(yv.x) * sigmoid_f(a0[1]) * silu_f(bfhi(gv.x));
                    o[2] = bflo(yv.y) * sigmoid_f(a0[2]) * silu_f(bflo(gv.y)); o[3] = bfhi(yv.y) * sigmoid_f(a0[3]) * silu_f(bfhi(gv.y));
                    o[4] = bflo(yv.z) * sigmoid_f(a1[0]) * silu_f(bflo(gv.z)); o[5] = bfhi(yv.z) * sigmoid_f(a1[1]) * silu_f(bfhi(gv.z));
                    o[6] = bflo(yv.w) * sigmoid_f(a1[2]) * silu_f(bflo(gv.w)); o[7] = bfhi(yv.w) * sigmoid_f(a1[3]) * silu_f(bfhi(gv.w));
                    u32x4 w; w.x = cvt_pk_bf16(o[0], o[1]); w.y = cvt_pk_bf16(o[2], o[3]); w.z = cvt_pk_bf16(o[4], o[5]); w.w = cvt_pk_bf16(o[6], o[7]);
                    *(u32x4*)(YMIX + (size_t)r * DM + c0) = w; } }
    }
};
struct EpiF32 {
    static constexpr bool PERM = false, AFTER_DRAIN = false;
    float* O; int ldc;
    __device__ __forceinline__ void operator()(const f32x4 (&acc)[2][2][4][2], const Unit& u, int wr, int wc, int fr, int fq) const {
        const int row0 = u.pm * BM + wr * 64 + fr, col0 = u.pn * BM + wc * 32 + 4 * fq;
#pragma unroll
        for (int ai = 0; ai < 2; ++ai)
#pragma unroll
            for (int m = 0; m < 4; ++m) { float* rowp = O + (size_t)(row0 + ai * HALF + m * 16) * ldc + col0;
#pragma unroll
                for (int bj = 0; bj < 2; ++bj)
#pragma unroll
                    for (int n = 0; n < 2; ++n) *(f32x4*)(rowp + bj * HALF + n * 16) = acc[ai][bj][m][n]; }
    }
};
template <class Epi, class Sched, bool ALIGN_EPI = false, bool SP2 = false>
__device__ __forceinline__ void gemm_phase(PG8_LAS unsigned char* lds, const Gemm g, const Sched& S, const Epi& E) {
    const int tid = threadIdx.x, wid = __builtin_amdgcn_readfirstlane(tid >> 6), lane = tid & 63, wr = wid >> 2, wc = wid & 3, fr = lane & 15, fq = lane >> 4;
    const int K = g.K, nt = K / BK;
    unsigned voffA[2], voffB[2];
#pragma unroll
    for (int i = 0; i < 2; ++i) { int R, C; stage_rc(tid * 16 + i * 8192, R, C); const int Rb = Epi::PERM ? ((R & ~31) + perm32(R & 31)) : R;
        voffA[i] = (unsigned)(R * K + C) * 2u; voffB[i] = (unsigned)(Rb * K + C) * 2u; }
    const size_t kstep = (size_t)(BK * 2);
    const size_t hstep = (size_t)HALF * K * 2;
    const size_t tstep = 2 * hstep;
    const unsigned ldsw = (unsigned)wid * 1024u;
    const int aoff = lds_byte(wr * 64 + fr, fq * 8), boff = lds_byte(wc * 32 + fr, fq * 8);
#define PG8_SA(b, h) (((b) * 2 + (h)) * HTB)
#define PG8_SB(b, h) ((4 + (b) * 2 + (h)) * HTB)
#define PG8_STAGE(bufoff, gbase, voff) do { _Pragma("unroll") for (int _i = 0; _i < 2; ++_i) \
        __builtin_amdgcn_global_load_lds((const unsigned*)((const char*)(gbase) + (voff)[_i]), (PG8_LAS unsigned*)(lds + (bufoff) + ldsw + _i * 8192), 16, 0, 0); } while (0)
#define PG8_LDA(dst, b, h) do { _Pragma("unroll") for (int m = 0; m < 4; ++m) _Pragma("unroll") for (int k = 0; k < 2; ++k) dst[m][k] = *(const PG8_LAS bf16x8*)(lds + PG8_SA(b, h) + aoff + m * 2048 + k * 1024); } while (0)
#define PG8_LDB(dst, b, h) do { _Pragma("unroll") for (int n = 0; n < 2; ++n) _Pragma("unroll") for (int k = 0; k < 2; ++k) dst[n][k] = *(const PG8_LAS bf16x8*)(lds + PG8_SB(b, h) + boff + n * 2048 + k * 1024); } while (0)
#define PG8_MMA(ai, bj, At, Bt) do { __builtin_amdgcn_s_setprio(1); _Pragma("unroll") for (int m = 0; m < 4; ++m) _Pragma("unroll") for (int n = 0; n < 2; ++n) _Pragma("unroll") for (int k = 0; k < 2; ++k) \
        acc[ai][bj][m][n] = __builtin_amdgcn_mfma_f32_16x16x32_bf16(Bt[n][k], At[m][k], acc[ai][bj][m][n], 0, 0, 0); __builtin_amdgcn_s_setprio(0); } while (0)
#define PG8_WAIT_V(n) asm volatile("s_waitcnt vmcnt(" #n ")" ::: "memory")
#define PG8_WAIT_L(n) asm volatile("s_waitcnt lgkmcnt(" #n ")" ::: "memory")
#define PG8_BAR __builtin_amdgcn_s_barrier()
#define PG8_SCHED __builtin_amdgcn_sched_barrier(0)
    Unit cur, nxt; int ui = 0;
    if (!S.next(0, cur)) return;
    f32x4 acc[2][2][4][2];
#pragma unroll
    for (int a = 0; a < 2; ++a)
#pragma unroll
        for (int b = 0; b < 2; ++b)
#pragma unroll
            for (int m = 0; m < 4; ++m)
#pragma unroll
                for (int n = 0; n < 2; ++n) acc[a][b][m][n] = (f32x4){0.f, 0.f, 0.f, 0.f};
    bf16x8 At[4][2], B0[2][2], B1[2][2];
    const char* cA = (const char*)g.A + (size_t)cur.pm * tstep; const char* cB = (const char*)g.Bt + (size_t)cur.pn * tstep;
    S.a_ready(cur);
    if constexpr (SP2) {
        PG8_STAGE(PG8_SB(0, 0), cB, voffB); PG8_STAGE(PG8_SB(0, 1), cB + hstep, voffB); PG8_STAGE(PG8_SA(0, 0), cA, voffA); PG8_STAGE(PG8_SA(0, 1), cA + hstep, voffA);
        if (wr == 1) PG8_BAR;
        PG8_WAIT_V(2); PG8_BAR;
        PG8_STAGE(PG8_SB(1, 0), cB + kstep, voffB); PG8_STAGE(PG8_SA(1, 0), cA + kstep, voffA); PG8_STAGE(PG8_SB(1, 1), cB + hstep + kstep, voffB);
        PG8_WAIT_V(6); PG8_BAR;
    } else {
        PG8_STAGE(PG8_SB(0, 0), cB, voffB); PG8_STAGE(PG8_SA(0, 0), cA, voffA); PG8_STAGE(PG8_SB(0, 1), cB + hstep, voffB); PG8_STAGE(PG8_SA(0, 1), cA + hstep, voffA);
        if (wr == 1) PG8_BAR;
        PG8_WAIT_V(4); PG8_BAR;
        PG8_STAGE(PG8_SB(1, 0), cB + kstep, voffB); PG8_STAGE(PG8_SA(1, 0), cA + kstep, voffA); PG8_STAGE(PG8_SB(1, 1), cB + hstep + kstep, voffB);
        PG8_WAIT_V(6); PG8_BAR;
    }
    for (;;) {
        const bool has_next = S.next(ui + 1, nxt);
        const char* nA = has_next ? (const char*)g.A + (size_t)nxt.pm * tstep : cA; const char* nB = has_next ? (const char*)g.Bt + (size_t)nxt.pn * tstep : cB;
        for (int t = 0; t < nt; t += 2) {
            const bool last = (t == nt - 2);
            const char* a1 = cA + (size_t)(t + 1) * kstep;
            const char* a2 = last ? nA : cA + (size_t)(t + 2) * kstep; const char* b2 = last ? nB : cB + (size_t)(t + 2) * kstep;
            const char* a3 = a2 + kstep; const char* b3 = b2 + kstep;
            if (last && has_next) S.a_ready(nxt);
            if constexpr (SP2) {
            PG8_LDB(B0, 0, 0); PG8_LDB(B1, 0, 1); PG8_SCHED; PG8_LDA(At, 0, 0); PG8_STAGE(PG8_SA(1, 1), a1 + hstep, voffA);
            PG8_WAIT_V(8); PG8_WAIT_L(0); PG8_BAR; PG8_MMA(0, 0, At, B0); PG8_MMA(0, 1, At, B1); PG8_BAR; PG8_SCHED;
            PG8_LDA(At, 0, 1); PG8_STAGE(PG8_SB(0, 0), b2, voffB); PG8_STAGE(PG8_SB(0, 1), b2 + hstep, voffB); PG8_STAGE(PG8_SA(0, 0), a2, voffA);
            PG8_WAIT_V(8); PG8_WAIT_L(0); PG8_BAR; PG8_MMA(1, 0, At, B0); PG8_MMA(1, 1, At, B1); PG8_BAR; PG8_SCHED;
            PG8_LDB(B0, 1, 0); PG8_LDB(B1, 1, 1); PG8_SCHED; PG8_LDA(At, 1, 0); PG8_STAGE(PG8_SA(0, 1), a2 + hstep, voffA);
            PG8_WAIT_V(8); PG8_WAIT_L(0); PG8_BAR; PG8_MMA(0, 0, At, B0); PG8_MMA(0, 1, At, B1); PG8_BAR; PG8_SCHED;
            PG8_LDA(At, 1, 1); PG8_STAGE(PG8_SB(1, 0), b3, voffB); PG8_STAGE(PG8_SB(1, 1), b3 + hstep, voffB); PG8_STAGE(PG8_SA(1, 0), a3, voffA);
            PG8_WAIT_V(8); PG8_WAIT_L(0); PG8_BAR; PG8_MMA(1, 0, At, B0); PG8_MMA(1, 1, At, B1); PG8_BAR; PG8_SCHED;
            } else {
            PG8_LDB(B0, 0, 0); PG8_SCHED; PG8_LDA(At, 0, 0); PG8_STAGE(PG8_SA(1, 1), a1 + hstep, voffA);
            PG8_WAIT_L(8); PG8_BAR; PG8_WAIT_L(0); PG8_MMA(0, 0, At, B0); PG8_BAR; PG8_SCHED;
            PG8_LDB(B1, 0, 1); PG8_STAGE(PG8_SB(0, 0), b2, voffB);
            PG8_BAR; PG8_WAIT_L(0); PG8_MMA(0, 1, At, B1); PG8_BAR;
            PG8_LDA(At, 0, 1); PG8_STAGE(PG8_SA(0, 0), a2, voffA);
            PG8_BAR; PG8_WAIT_L(0); PG8_MMA(1, 0, At, B0); PG8_BAR; PG8_SCHED;
            PG8_STAGE(PG8_SB(0, 1), b2 + hstep, voffB);
            PG8_WAIT_V(6); PG8_BAR; PG8_MMA(1, 1, At, B1); PG8_BAR;
            PG8_LDB(B0, 1, 0); PG8_SCHED; PG8_LDA(At, 1, 0); PG8_STAGE(PG8_SA(0, 1), a2 + hstep, voffA);
            PG8_WAIT_L(8); PG8_BAR; PG8_WAIT_L(0); PG8_MMA(0, 0, At, B0); PG8_BAR; PG8_SCHED;
            PG8_LDB(B1, 1, 1); PG8_STAGE(PG8_SB(1, 0), b3, voffB);
            PG8_BAR; PG8_WAIT_L(0); PG8_MMA(0, 1, At, B1); PG8_BAR;
            PG8_LDA(At, 1, 1); PG8_STAGE(PG8_SA(1, 0), a3, voffA);
            PG8_BAR; PG8_WAIT_L(0); PG8_MMA(1, 0, At, B0); PG8_BAR; PG8_SCHED;
            PG8_STAGE(PG8_SB(1, 1), b3 + hstep, voffB);
            PG8_WAIT_V(6); PG8_BAR; PG8_MMA(1, 1, At, B1); PG8_BAR;
            }
        }
        if constexpr (ALIGN_EPI) { if (wr == 0) PG8_BAR; }
        if constexpr (!Epi::AFTER_DRAIN) { E(acc, cur, wr, wc, fr, fq); S.done(cur); }
        if (!has_next) break;
#pragma unroll
        for (int a = 0; a < 2; ++a)
#pragma unroll
            for (int b = 0; b < 2; ++b)
#pragma unroll
                for (int m = 0; m < 4; ++m)
#pragma unroll
                    for (int n = 0; n < 2; ++n) acc[a][b][m][n] = (f32x4){0.f, 0.f, 0.f, 0.f};
        cur = nxt; cA = nA; cB = nB; ++ui;
        if constexpr (ALIGN_EPI) { if (wr == 1) PG8_BAR; }
    }
    PG8_WAIT_V(0);
    if constexpr (!ALIGN_EPI) { if (wr == 0) PG8_BAR; }
    PG8_BAR;
    if constexpr (Epi::AFTER_DRAIN) { E.fused(acc, cur, wr, wc, fr, fq, lds, wid, lane); S.done(cur); }
#undef PG8_SA
#undef PG8_SB
#undef PG8_STAGE
#undef PG8_LDA
#undef PG8_LDB
#undef PG8_MMA
#undef PG8_WAIT_V
#undef PG8_WAIT_L
#undef PG8_BAR
#undef PG8_SCHED
}
}
#define XB_TMO      128
#define XB_XCNT(j)  (256  + 64 * (j))
#define XB_XSUB(j)  (1280 + 64 * (j))
#define XB_XGEN(j)  (2304 + 64 * (j))
#define XB_TOP      3328
#define XB_TOPGEN   3392
#define XCD_BAR_WORDS 3456
#define XB_SPIN_CAP (1u << 18)

__device__ __forceinline__ unsigned xb_ld(unsigned* p)              { return __hip_atomic_load(p, __ATOMIC_RELAXED, __HIP_MEMORY_SCOPE_AGENT); }
__device__ __forceinline__ unsigned xb_add(unsigned* p, unsigned v) { return __hip_atomic_fetch_add(p, v, __ATOMIC_RELAXED, __HIP_MEMORY_SCOPE_AGENT); }
__device__ __forceinline__ unsigned xb_xcc_id() { return (unsigned)__builtin_amdgcn_s_getreg((3 << 11) | 20) & 0xFu; }
#define XB_SPIN(cond, bar) do { unsigned _sp = 0; while (cond) { __builtin_amdgcn_s_sleep(1); \
    if ((++_sp & 255u) == 0u) { if (xb_ld(&(bar)[XB_TMO])) break; if (_sp > XB_SPIN_CAP) { atomicAdd(&(bar)[XB_TMO], 1u); break; } } } } while (0)

struct XcdBarrier {
    unsigned* bar; unsigned x;
    volatile LAS unsigned* st;
};

__device__ __forceinline__ XcdBarrier xcd_barrier_post(unsigned* bar, volatile LAS unsigned* st) {
    XcdBarrier b; b.bar = bar; b.x = xb_xcc_id(); b.st = st;
    if (threadIdx.x == 0) (void)xb_add(&bar[XB_XCNT(b.x)], 1u);
    return b;
}
__device__ __forceinline__ void xcd_barrier_complete(unsigned* bar, unsigned x, unsigned& nloc, unsigned& nx) {
    const unsigned G = gridDim.x * gridDim.y * gridDim.z;
    unsigned sum, cnt, mine, sp = 0u;
    for (;;) {
        sum = 0u; cnt = 0u; mine = 0u;
#pragma unroll
        for (unsigned j = 0; j < 16; ++j) { const unsigned c = xb_ld(&bar[XB_XCNT(j)]); sum += c; cnt += (c > 0u) ? 1u : 0u; mine = (j == x) ? c : mine; }
        if (sum == G) break;
        __builtin_amdgcn_s_sleep(1);
        if ((++sp & 255u) == 0u) { if (xb_ld(&bar[XB_TMO])) break; if (sp > XB_SPIN_CAP) { atomicAdd(&bar[XB_TMO], 1u); break; } }
    }
    nloc = mine > 0u ? mine : 1u; nx = cnt > 0u ? cnt : 1u;
}

__device__ __forceinline__ void xcd_barrier(const XcdBarrier& b) {
    asm volatile("s_waitcnt vmcnt(0)" ::: "memory");
    __syncthreads();
    if (threadIdx.x == 0) {
        unsigned* bar = b.bar;
        __builtin_amdgcn_s_waitcnt(0);
        unsigned nloc = b.st[0], nx = b.st[1];
        if (nloc == 0u) { xcd_barrier_complete(bar, b.x, nloc, nx); b.st[0] = nloc; b.st[1] = nx; }
        const unsigned old = xb_add(&bar[XB_XSUB(b.x)], 1u);
        const unsigned gen = old / nloc;
        if (old + 1u == (gen + 1u) * nloc) {
            __builtin_amdgcn_fence(__ATOMIC_RELEASE, "agent");
            asm volatile("s_waitcnt vmcnt(0)" ::: "memory");
            const unsigned og = xb_add(&bar[XB_TOP], 1u);
            const unsigned tg = og / nx;
            if (og + 1u == (tg + 1u) * nx) xb_add(&bar[XB_TOPGEN], 1u);
            else XB_SPIN(xb_ld(&bar[XB_TOPGEN]) == tg, bar);
            __builtin_amdgcn_fence(__ATOMIC_ACQUIRE, "agent");
            xb_add(&bar[XB_XGEN(b.x)], 1u);
            asm volatile("s_waitcnt vmcnt(0)" ::: "memory");
        } else {
            XB_SPIN(xb_ld(&bar[XB_XGEN(b.x)]) == gen, bar);
            __builtin_amdgcn_fence(__ATOMIC_ACQUIRE, "agent");
            asm volatile("s_waitcnt vmcnt(0)" ::: "memory");
        }
    }
    __syncthreads();
}

DI int crow16(int reg, int hf) { return (reg & 3) + 8 * (reg >> 2) + 4 * hf; }
DI unsigned cvtpk(float lo, float hi) { typedef float f2 __attribute__((ext_vector_type(2))); typedef __bf16 b2 __attribute__((ext_vector_type(2))); f2 v = {lo, hi}; b2 b = __builtin_convertvector(v, b2); return __builtin_bit_cast(unsigned, b); }
struct AttnP { const bf16_t* Q; const bf16_t* K; const bf16_t* VT; const bf16_t* Gt; bf16_t* Y; const float* relb; };

template <int MODE> DI void attn_unit(int unit, const AttnP& P, int lane) {
    const int ql = lane & 31, hf = lane >> 5;
    int b, h, kvh, qrow, NT, rp = 0, ci = 0, rs0 = 0, c0 = 0, qr = 0, qc = 0, rsq = 0, csq = 0;
    if (MODE == 0) { ci = unit & 3; rp = (unit >> 2) & 31; h = (unit >> 7) & 7; b = unit >> 10; kvh = h;
        qr = 2 * rp + (ql >> 4); qc = 16 * ci + (ql & 15); qrow = b * SEQ + qr * 64 + qc;
        rs0 = min(max(2 * rp - 4, 0), 56); const int rs1 = min(max(2 * rp - 3, 0), 56); NT = 8 + (rs1 + 8 - rs0);
        c0 = min(max(16 * ci - 8, 0), 32); rsq = min(max(qr - 4, 0), 56); csq = min(max(qc - 8, 0), 48);
    } else if (MODE == 1) { const int qt = unit & 7; h = (unit >> 3) & 7; b = unit >> 6; kvh = h; qrow = NLAT + b * LC + 32 * qt + ql; NT = 8; }
    else { const int qt = unit & 127; h = (unit >> 7) & 7; b = unit >> 10; kvh = h >> 2; qrow = b * SEQ + 32 * qt + ql; NT = POSN / 32; }
    const bf16_t* qp; const bf16_t* kb; size_t kpitch; const bf16_t* vt; const bf16_t* gp; bf16_t* yp;
    if (MODE == 2) { qp = P.Q + ((size_t)(b * 8 + h) * SEQ + (qrow - b * SEQ)) * 64; kb = P.K + (size_t)(b * 2 + kvh) * POSN * 64; kpitch = 64;
        vt = P.VT + (size_t)(b * 2 + kvh) * 64 * POSN; gp = P.Gt + (size_t)qrow * N1 + 1792 + h * 64; }
    else { qp = P.Q + (size_t)qrow * N0 + 1024 + h * 64; kb = P.K + 1536 + h * 64; kpitch = N0; vt = P.VT + (size_t)(b * 8 + h) * 64 * POSN; gp = P.Gt + (size_t)qrow * N0 + 2560 + h * 64; }
    yp = P.Y + (size_t)qrow * DM + 512 + h * 64;
    bf16x8_t qf[4];
#pragma unroll
    for (int ks = 0; ks < 4; ++ks) qf[ks] = *(const bf16x8_t*)(qp + 16 * ks + 8 * hf);
    const bf16_t* vt0 = vt + (size_t)ql * POSN + 4 * hf;
    f32x16_t o0 = {}, o1 = {};
    float m = -1e30f, l = 0.f;
    auto tile_krow = [&](int t) -> int { if (MODE == 2) return 32 * t + ql; if (t < 8) return NLAT + b * LC + 32 * t + ql; return b * SEQ + (rs0 + t - 8) * 64 + c0 + ql; };
    auto tile_pos0 = [&](int t) -> int { if (MODE == 2) return 32 * t; if (t < 8) return 32 * t; return LC + (rs0 + t - 8) * 64 + c0; };
    bf16x8_t kn[4];
    { const bf16_t* kp = kb + (size_t)tile_krow(0) * kpitch + 8 * hf;
#pragma unroll
      for (int ks = 0; ks < 4; ++ks) kn[ks] = *(const bf16x8_t*)(kp + 16 * ks); }
#pragma unroll 1
    for (int t = 0; t < NT; ++t) {
        bf16x8_t kf[4];
#pragma unroll
        for (int ks = 0; ks < 4; ++ks) kf[ks] = kn[ks];
        if (t + 1 < NT) { const bf16_t* kp = kb + (size_t)tile_krow(t + 1) * kpitch + 8 * hf;
#pragma unroll
            for (int ks = 0; ks < 4; ++ks) kn[ks] = *(const bf16x8_t*)(kp + 16 * ks); }
        const bf16_t* vp = vt0 + tile_pos0(t);
        s16x4_t va[2][2][2];
#pragma unroll
        for (int dt = 0; dt < 2; ++dt)
#pragma unroll
            for (int s = 0; s < 2; ++s) { va[dt][s][0] = *(const s16x4_t*)(vp + (size_t)dt * 32 * POSN + 16 * s); va[dt][s][1] = *(const s16x4_t*)(vp + (size_t)dt * 32 * POSN + 16 * s + 8); }
        f32x16_t sc = {};
#pragma unroll
        for (int ks = 0; ks < 4; ++ks) sc = __builtin_amdgcn_mfma_f32_32x32x16_bf16(kf[ks], qf[ks], sc, 0, 0, 0);
        float xs[16];
        if (MODE == 0 && t >= 8) {
            const int kr = rs0 + t - 8; const bool row_ok = (kr >= rsq) && (kr < rsq + 8);
            const float* rb = P.relb + (h * 15 + (kr - qr + 7)) * 31 + (15 - qc);
#pragma unroll
            for (int r = 0; r < 16; ++r) { const int kc = c0 + crow16(r, hf); const bool ok = row_ok && (kc >= csq) && (kc < csq + 16);
                const float bias = ok ? rb[kc] : 0.f; xs[r] = ok ? (sc[r] * 0.125f + bias) * LOG2E : -1e30f; }
        } else {
#pragma unroll
            for (int r = 0; r < 16; ++r) xs[r] = (MODE == 2) ? sc[r] : sc[r] * (0.125f * LOG2E);
        }
        float tm = xs[0];
#pragma unroll
        for (int r = 1; r < 16; ++r) tm = fmaxf(tm, xs[r]);
        tm = fmaxf(tm, __shfl_xor(tm, 32));
        const float mn = fmaxf(m, tm), al = __builtin_amdgcn_exp2f(m - mn);
        float ps = 0.f;
#pragma unroll
        for (int r = 0; r < 16; ++r) { xs[r] = __builtin_amdgcn_exp2f(xs[r] - mn); ps += xs[r]; }
        l = l * al + ps; m = mn;
#pragma unroll
        for (int r = 0; r < 16; ++r) { o0[r] *= al; o1[r] *= al; }
        bf16x8_t pf[2];
#pragma unroll
        for (int s = 0; s < 2; ++s) { v4u w; w.x = cvtpk(xs[8 * s], xs[8 * s + 1]); w.y = cvtpk(xs[8 * s + 2], xs[8 * s + 3]); w.z = cvtpk(xs[8 * s + 4], xs[8 * s + 5]); w.w = cvtpk(xs[8 * s + 6], xs[8 * s + 7]);
            pf[s] = __builtin_bit_cast(bf16x8_t, w); }
#pragma unroll
        for (int s = 0; s < 2; ++s) {
            const bf16x8_t a0 = __builtin_shufflevector(va[0][s][0], va[0][s][1], 0, 1, 2, 3, 4, 5, 6, 7);
            const bf16x8_t a1 = __builtin_shufflevector(va[1][s][0], va[1][s][1], 0, 1, 2, 3, 4, 5, 6, 7);
            o0 = __builtin_amdgcn_mfma_f32_32x32x16_bf16(a0, pf[s], o0, 0, 0, 0);
            o1 = __builtin_amdgcn_mfma_f32_32x32x16_bf16(a1, pf[s], o1, 0, 0, 0);
        }
    }
    l += __shfl_xor(l, 32);
    const float rl = 1.f / l;
#pragma unroll
    for (int dt = 0; dt < 2; ++dt)
#pragma unroll
        for (int rg = 0; rg < 4; ++rg) { const int d = 32 * dt + 8 * rg + 4 * hf;
            const v2u gv = *(const v2u*)(gp + d);
            const float g0 = silu_f(bflo(gv.x)), g1 = silu_f(bfhi(gv.x)), g2 = silu_f(bflo(gv.y)), g3 = silu_f(bfhi(gv.y));
            const f32x16_t& oo = dt ? o1 : o0;
            v2u w; w.x = pk2(oo[4 * rg] * rl * g0, oo[4 * rg + 1] * rl * g1); w.y = pk2(oo[4 * rg + 2] * rl * g2, oo[4 * rg + 3] * rl * g3);
            *(v2u*)(yp + d) = w; }
}

struct Args { const float* in[32]; float* out; unsigned char* ws; int ph_lo, ph_hi, li, pad; };
DI void phase3(const Args& args, LAS unsigned char* lds, int tid, int wave, int lane, int G) {
    unsigned char* ws = args.ws; const bf16_t* PROJ = (const bf16_t*)(ws + WS_PROJ);
    const AttnP P{PROJ, PROJ, (const bf16_t*)(ws + WS_VT0), PROJ, (bf16_t*)(ws + WS_YMIX), args.in[20]};
    const int gw = blockIdx.x * NWAVES + wave, NGW = G * NWAVES;
    for (int u = gw; u < 4096 + 256; u += NGW) { if (u < 4096) attn_unit<0>(u, P, lane); else attn_unit<1>(u - 4096, P, lane); }
}
DI void phase8(const Args& args, LAS unsigned char* lds, int tid, int wave, int lane, int G) {}
DI void phase9(const Args& args, LAS unsigned char* lds, int tid, int wave, int lane, int G) {
    unsigned char* ws = args.ws; const bf16_t* PROJ = (const bf16_t*)(ws + WS_PROJ);
    const AttnP P{(const bf16_t*)(ws + WS_QP), (const bf16_t*)(ws + WS_KP), (const bf16_t*)(ws + WS_VT1), PROJ, (bf16_t*)(ws + WS_YMIX), nullptr};
    const int gw = blockIdx.x * NWAVES + wave, NGW = G * NWAVES;
    for (int u = gw; u < 4096; u += NGW) attn_unit<2>(u, P, lane);
}

constexpr int RING_BYTES = 131072, LDSCTL_OFF = RING_BYTES, MISC_OFF = LDSCTL_OFF + 320, LDS_BYTES = 147456;
constexpr int CW_BAR = 4096;
constexpr int N_PHASES = 12;
constexpr bool kSP2 = true, kALIGN = true;

DI void p0_adaln(LAS unsigned char* lds, const float* c, const float* cctx, const float* ada_w, const float* ada_b, float* MOD, int tid, int wave, int lane, int G) {
    LAS float* sl = (LAS float*)lds;
    LAS float* red = (LAS float*)(lds + 5 * 1024 * 4);
    if ((int)blockIdx.x >= 192) return;
    for (int e = tid; e < 5 * 1024; e += NTHREADS) { const int r = e >> 10, k = e & 1023; const float x = r < 4 ? c[r * 1024 + k] : cctx[k]; sl[e] = silu_f(x); }
    __syncthreads();
    for (int item = blockIdx.x; item < 192; item += G) {
        const int i = item / 96, cb = item % 96, col = cb * 32 + (lane & 31), kh = lane >> 5;
        const float* W = ada_w + (size_t)i * 1024 * 3072 + col;
        float acc[5] = {0.f, 0.f, 0.f, 0.f, 0.f};
#pragma unroll 8
        for (int kk = 0; kk < 64; ++kk) { const int k = wave * 128 + 2 * kk + kh; const float w = W[(size_t)k * 3072];
#pragma unroll
            for (int r = 0; r < 5; ++r) acc[r] += sl[r * 1024 + k] * w; }
#pragma unroll
        for (int r = 0; r < 5; ++r) { acc[r] += __shfl_xor(acc[r], 32); if (lane < 32) red[(wave * 5 + r) * 32 + lane] = acc[r]; }
        __syncthreads();
        if (tid < 160) { const int r = tid >> 5, cl = tid & 31; float s = ada_b[i * 3072 + cb * 32 + cl];
#pragma unroll
            for (int w = 0; w < 8; ++w) s += red[(w * 5 + r) * 32 + cl];
            MOD[(i * 5 + r) * 3072 + cb * 32 + cl] = s; }
        __syncthreads();
    }
}
DI void p0_transpose_item(const float* W, int K, int N, bf16_t* WT, int row_off, LAS float* scr, int item, int lane) {
    const int nblk = N / 32, kb = item / nblk, nb = item % nblk, k0 = 64 * kb, n0 = 32 * nb;
#pragma unroll 8
    for (int i = 0; i < 32; ++i) { const int kk = 2 * i + (lane >> 5); scr[kk * 33 + (lane & 31)] = W[(size_t)(k0 + kk) * N + n0 + (lane & 31)]; }
    LDS_WAIT(); asm volatile("" ::: "memory");
    const int c = lane & 7;
#pragma unroll
    for (int j = 0; j < 4; ++j) { const int n = (lane >> 3) + 8 * j; const LAS float* s = scr + (8 * c) * 33 + n;
        v4u o; o.x = pk2(s[0 * 33], s[1 * 33]); o.y = pk2(s[2 * 33], s[3 * 33]); o.z = pk2(s[4 * 33], s[5 * 33]); o.w = pk2(s[6 * 33], s[7 * 33]);
        *(v4u*)(WT + (size_t)(row_off + n0 + n) * K + k0 + 8 * c) = o; }
    LDS_WAIT(); asm volatile("" ::: "memory");
}
struct TrJob { const float* W; int K, N; bf16_t* WT; int row_off; int items; };

DI void load_row16(const float* src, int lane, float (&v)[16]) {
#pragma unroll
    for (int j = 0; j < 4; ++j) { const f32x4_t t = *(const f32x4_t*)(src + j * 256 + lane * 4); v[4 * j] = t[0]; v[4 * j + 1] = t[1]; v[4 * j + 2] = t[2]; v[4 * j + 3] = t[3]; }
}
DI float row_rinv(const float (&v)[16]) {
    float ss = 0.f;
#pragma unroll
    for (int j = 0; j < 16; ++j) ss += v[j] * v[j];
    ss = wave_sum(ss);
    return rsqrtf(ss * (1.f / DM) + EPSN);
}
DI void store_modnorm(const float (&v)[16], float rinv, const float* g, const float* m, bf16_t* dst, int lane) {
#pragma unroll
    for (int j = 0; j < 4; ++j) { const int col = j * 256 + lane * 4;
        const f32x4_t gg = *(const f32x4_t*)(g + col), sc = *(const f32x4_t*)(m + 1024 + col), sh = *(const f32x4_t*)(m + col);
        float y[4];
#pragma unroll
        for (int e = 0; e < 4; ++e) y[e] = v[4 * j + e] * rinv * gg[e] * (1.f + sc[e]) + sh[e];
        v2u o; o.x = pk2(y[0], y[1]); o.y = pk2(y[2], y[3]); *(v2u*)(dst + col) = o; }
}

__global__ void __launch_bounds__(NTHREADS, 2) mega(Args args) {
    extern __shared__ __attribute__((aligned(16))) unsigned char lds_raw[];
    LAS unsigned char* lds = (LAS unsigned char*)lds_raw;
    volatile LAS unsigned* MISC = (volatile LAS unsigned*)(lds + MISC_OFF);
    const int tid = threadIdx.x, lane = tid & 63, wave = __builtin_amdgcn_readfirstlane(tid >> 6);
    const int G = gridDim.x;
    unsigned char* ws = args.ws;
    gu32* ctl = (gu32*)(ws + WS_CTL);
    for (int u = tid; u < (LDS_BYTES - LDSCTL_OFF) / 4; u += NTHREADS) ((LAS unsigned*)(lds + LDSCTL_OFF))[u] = 0u;
    __syncthreads();
    XcdBarrier bar = xcd_barrier_post((unsigned*)(ctl + CW_BAR) + args.li * XCD_BAR_WORDS, MISC + 8);
    const int lo = args.ph_lo, hi = args.ph_hi;
#define IN(k) (lo <= (k) && (k) < hi)
#define SEAM(k) do { if (IN(k) && IN((k) + 1)) xcd_barrier(bar); } while (0)

    const float* x = args.in[0]; const float* cvec = args.in[1]; const float* ctxin = args.in[2]; const float* cctx = args.in[3];
    const float* ada_w = args.in[4]; const float* ada_b = args.in[5]; const float* pre_g = args.in[6]; const float* post_g = args.in[7];
    float* out = args.out;
    float* MOD = (float*)(ws + WS_MOD);
    bf16_t* XN = (bf16_t*)(ws + WS_XN); bf16_t* YMIX = (bf16_t*)(ws + WS_YMIX); bf16_t* PROJ = (bf16_t*)(ws + WS_PROJ); float* OUTF = (float*)(ws + WS_PROJ);
    bf16_t* YPRE = (bf16_t*)(ws + WS_YPRE);
    const int gw = blockIdx.x * NWAVES + wave, NGW = G * NWAVES;

    if (IN(0)) {
        p0_adaln(lds, cvec, cctx, ada_w, ada_b, MOD, tid, wave, lane, G);
        __syncthreads();
        LAS float* scr = (LAS float*)(lds + 32768 + wave * 8704);
        const TrJob jobs[5] = {
            {args.in[8], 1024, 3072, (bf16_t*)(ws + WS_WIN0T), 0, 16 * 96}, {args.in[9], 1024, 1024, (bf16_t*)(ws + WS_WOUT0T), 0, 16 * 32},
            {args.in[21], 1024, 2304, (bf16_t*)(ws + WS_WIN1T), 0, 16 * 72}, {args.in[22], 1024, 1024, (bf16_t*)(ws + WS_WOUT1T), 0, 16 * 32},
            {args.in[18], 512, 512, (bf16_t*)(ws + WS_WGLUT), 0, 8 * 16}};
        constexpr int NBIG = 16 * 96 + 16 * 32 + 16 * 72 + 16 * 32 + 8 * 16, NLRU = 32 * 2;
        for (int it = gw; it < NBIG + NLRU; it += NGW) {
            if (it < NBIG) { int r = it;
#pragma unroll
                for (int j = 0; j < 5; ++j) { if (r >= 0 && r < jobs[j].items) p0_transpose_item(jobs[j].W, jobs[j].K, jobs[j].N, jobs[j].WT, 0, scr, r, lane); r -= jobs[j].items; }
            } else { const int q = it - NBIG, mat = q >> 1, sub = q & 1, dir = mat >> 4, gate = (mat >> 3) & 1, blk = mat & 7;
                const float* W = (gate ? args.in[28] : args.in[26]) + (size_t)(dir * 8 + blk) * 4096;
                p0_transpose_item(W, 64, 64, (bf16_t*)(ws + WS_LRUWT), blk * 256 + (dir * 2 + gate) * 64, scr, sub, lane); }
        }
    }
    SEAM(0);
    if (IN(1)) {
        for (int r = gw; r < MROWS; r += NGW) {
            const float* src = r < NLAT ? x + (size_t)r * DM : ctxin + (size_t)(r - NLAT) * DM;
            float v[16]; load_row16(src, lane, v);
            store_modnorm(v, row_rinv(v), pre_g, MOD + (r < NLAT ? (r >> 12) : 4) * 3072, XN + (size_t)r * DM, lane);
        }
    }
    SEAM(1);
    if (IN(2)) {
        pg8::Gemm g{XN, (const bf16_t*)(ws + WS_WIN0T), MROWS, N0, DM}; pg8::StaticOrder S; S.init(MROWS, N0, G, (int)blockIdx.x);
        pg8::EpiProj E{PROJ, N0, (bf16_t*)(ws + WS_VT0), 2048, 2560, 512};
        pg8::gemm_phase<pg8::EpiProj, pg8::StaticOrder, kALIGN, kSP2>(lds, g, S, E);
    }
    SEAM(2);
    if (IN(3)) { phase3(args, lds, tid, wave, lane, G); }
    SEAM(3);
    if (IN(4)) {
        pg8::Gemm g{YPRE, (const bf16_t*)(ws + WS_WGLUT), MROWS, 512, 512}; pg8::StaticOrder S; S.init(MROWS, 512, G, (int)blockIdx.x);
        pg8::EpiGlu E{YPRE, PROJ, args.in[19], YMIX};
        pg8::gemm_phase<pg8::EpiGlu, pg8::StaticOrder, kALIGN, kSP2>(lds, g, S, E);
    }
    SEAM(4);
    if (IN(5)) {
        pg8::Gemm g{YMIX, (const bf16_t*)(ws + WS_WOUT0T), MROWS, DM, DM}; pg8::StaticOrder S; S.init(MROWS, DM, G, (int)blockIdx.x);
        pg8::EpiF32 E{OUTF, DM};
        pg8::gemm_phase<pg8::EpiF32, pg8::StaticOrder, kALIGN, kSP2>(lds, g, S, E);
    }
    SEAM(5);
    if (IN(6)) {
        for (int r = gw; r < MROWS; r += NGW) {
            const int mrow = r < NLAT ? (r >> 12) : 4;
            const float* hin = r < NLAT ? x + (size_t)r * DM : ctxin + (size_t)(r - NLAT) * DM;
            float v[16], h[16]; load_row16(OUTF + (size_t)r * DM, lane, v); load_row16(hin, lane, h);
            const float rinv = row_rinv(v); const float* gt = MOD + mrow * 3072 + 2048;
#pragma unroll
            for (int j = 0; j < 4; ++j) { const int col = j * 256 + lane * 4; const f32x4_t pg = *(const f32x4_t*)(post_g + col), gg = *(const f32x4_t*)(gt + col);
#pragma unroll
                for (int e = 0; e < 4; ++e) h[4 * j + e] += gg[e] * (v[4 * j + e] * rinv * pg[e]);
                if (r < NLAT) *(f32x4_t*)(out + (size_t)r * DM + col) = (f32x4_t){h[4 * j], h[4 * j + 1], h[4 * j + 2], h[4 * j + 3]}; }
            store_modnorm(h, row_rinv(h), pre_g + DM, MOD + (5 + mrow) * 3072, XN + (size_t)r * DM, lane);
        }
    }
    SEAM(6);
    if (IN(7)) {
        pg8::Gemm g{XN, (const bf16_t*)(ws + WS_WIN1T), MROWS, N1, DM}; pg8::StaticOrder S; S.init(MROWS, N1, G, (int)blockIdx.x);
        pg8::EpiProj E{PROJ, N1, (bf16_t*)(ws + WS_VT1), 1664, 1792, 128};
        pg8::gemm_phase<pg8::EpiProj, pg8::StaticOrder, kALIGN, kSP2>(lds, g, S, E);
    }
    SEAM(7);
    if (IN(8)) { phase8(args, lds, tid, wave, lane, G); }
    SEAM(8);
    if (IN(9)) { phase9(args, lds, tid, wave, lane, G); }
    SEAM(9);
    if (IN(10)) {
        pg8::Gemm g{YMIX, (const bf16_t*)(ws + WS_WOUT1T), NLAT, DM, DM}; pg8::StaticOrder S; S.init(NLAT, DM, G, (int)blockIdx.x);
        pg8::EpiF32 E{OUTF, DM};
        pg8::gemm_phase<pg8::EpiF32, pg8::StaticOrder, kALIGN, kSP2>(lds, g, S, E);
    }
    SEAM(10);
    if (IN(11)) {
        for (int r = gw; r < NLAT; r += NGW) {
            float v[16], h[16]; load_row16(OUTF + (size_t)r * DM, lane, v); load_row16(out + (size_t)r * DM, lane, h);
            const float rinv = row_rinv(v); const float* gt = MOD + (5 + (r >> 12)) * 3072 + 2048;
#pragma unroll
            for (int j = 0; j < 4; ++j) { const int col = j * 256 + lane * 4; const f32x4_t pg = *(const f32x4_t*)(post_g + DM + col), gg = *(const f32x4_t*)(gt + col);
                f32x4_t o;
#pragma unroll
                for (int e = 0; e < 4; ++e) o[e] = h[4 * j + e] + gg[e] * (v[4 * j + e] * rinv * pg[e]);
                *(f32x4_t*)(out + (size_t)r * DM + col) = o; }
        }
    }
#undef IN
#undef SEAM
}
__global__ void k_adaln(const float* c, const float* cctx, const float* ada_w, const float* ada_b, float* mod) {
    const int idx = blockIdx.x * blockDim.x + threadIdx.x;
    if (idx >= 2 * 5 * 3072) return;
    const int col = idx % 3072, r = (idx / 3072) % 5, i = idx / (3072 * 5);
    const float* cv = r < 4 ? c + r * 1024 : cctx;
    const float* W = ada_w + (size_t)i * 1024 * 3072;
    float acc = 0.f;
    for (int k = 0; k < 1024; ++k) acc += silu_f(cv[k]) * W[(size_t)k * 3072 + col];
    mod[idx] = acc + ada_b[i * 3072 + col];
}

__global__ void k_prenorm(const float* lat, const float* ctx, const float* g, const float* mod  , bf16_t* XN) {
    const int r = blockIdx.x * 4 + (threadIdx.x >> 6), lane = threadIdx.x & 63;
    if (r >= MROWS) return;
    const float* src = r < NLAT ? lat + (size_t)r * DM : ctx + (size_t)(r - NLAT) * DM;
    const float* m = mod + (r < NLAT ? (r >> 12) : 4) * 3072;
    float v[16]; float ss = 0.f;
#pragma unroll
    for (int j = 0; j < 4; ++j) { const float4 t = *(const float4*)(src + j * 256 + lane * 4); v[4 * j] = t.x; v[4 * j + 1] = t.y; v[4 * j + 2] = t.z; v[4 * j + 3] = t.w; }
#pragma unroll
    for (int j = 0; j < 16; ++j) ss += v[j] * v[j];
    ss = wave_sum(ss);
    const float rinv = rsqrtf(ss * (1.f / DM) + EPSN);
#pragma unroll
    for (int j = 0; j < 4; ++j)
#pragma unroll
        for (int e = 0; e < 4; ++e) { const int col = j * 256 + lane * 4 + e; const float y = v[4 * j + e] * rinv * g[col] * (1.f + m[1024 + col]) + m[col]; XN[(size_t)r * DM + col] = f2bf(y); }
}

__global__ void k_postnorm(const float* hlat, const float* hctx, const float* OUT, const float* pg, const float* mod, float* olat, float* octx, int nrows) {
    const int r = blockIdx.x * 4 + (threadIdx.x >> 6), lane = threadIdx.x & 63;
    if (r >= nrows) return;
    const float* hin = r < NLAT ? hlat + (size_t)r * DM : hctx + (size_t)(r - NLAT) * DM;
    float* ho = r < NLAT ? olat + (size_t)r * DM : octx + (size_t)(r - NLAT) * DM;
    const float* m = mod + (r < NLAT ? (r >> 12) : 4) * 3072 + 2048;
    const float* src = OUT + (size_t)r * DM;
    float v[16]; float ss = 0.f;
#pragma unroll
    for (int j = 0; j < 4; ++j) { const float4 t = *(const float4*)(src + j * 256 + lane * 4); v[4 * j] = t.x; v[4 * j + 1] = t.y; v[4 * j + 2] = t.z; v[4 * j + 3] = t.w; }
#pragma unroll
    for (int j = 0; j < 16; ++j) ss += v[j] * v[j];
    ss = wave_sum(ss);
    const float rinv = rsqrtf(ss * (1.f / DM) + EPSN);
#pragma unroll
    for (int j = 0; j < 4; ++j)
#pragma unroll
        for (int e = 0; e < 4; ++e) { const int col = j * 256 + lane * 4 + e; ho[col] = hin[col] + m[col] * (v[4 * j + e] * rinv * pg[col]); }
}

enum { GM_PROJ0 = 0, GM_PROJ1 = 1, GM_GLU = 2, GM_F32 = 3 };
struct GemmEpi { bf16_t* P; bf16_t* VT; const bf16_t* YPRE; const bf16_t* PROJ; const float* bglu; bf16_t* YMIX; float* OUT; };
template <int MODE> __global__ void __launch_bounds__(256) k_gemm(const bf16_t* A, const float* W, int M, int N, int K, GemmEpi e) {
    const int tx = threadIdx.x & 15, ty = threadIdx.x >> 4;
    const int c0 = blockIdx.x * 64 + tx * 4, r0 = blockIdx.y * 64 + ty * 4;
    float acc[4][4] = {};
    for (int k = 0; k < K; ++k) {
        const float4 w = *(const float4*)(W + (size_t)k * N + c0);
        const float wv[4] = {rbf(w.x), rbf(w.y), rbf(w.z), rbf(w.w)};
#pragma unroll
        for (int i = 0; i < 4; ++i) { const float a = bf2f(A[(size_t)(r0 + i) * K + k]);
#pragma unroll
            for (int j = 0; j < 4; ++j) acc[i][j] += a * wv[j]; }
    }
#pragma unroll
    for (int i = 0; i < 4; ++i)
#pragma unroll
        for (int j = 0; j < 4; ++j) {
            const int r = r0 + i, c = c0 + j; const float v = acc[i][j];
            if (MODE == GM_PROJ0) { e.P[(size_t)r * N0 + c] = f2bf(v);
                if (c >= 2048 && c < 2560) { const int hd = c - 2048; e.VT[((size_t)(row_batch(r) * 8) * 64 + hd) * POSN + row_pos(r)] = f2bf(v); } }
            else if (MODE == GM_PROJ1) { e.P[(size_t)r * N1 + c] = f2bf(v);
                if (c >= 1664 && c < 1792) { const int hd = c - 1664; e.VT[((size_t)(row_batch(r) * 2) * 64 + hd) * POSN + row_pos(r)] = f2bf(v); } }
            else if (MODE == GM_GLU) { const float y = bf2f(e.YPRE[(size_t)r * 512 + c]); const float ga = bf2f(e.PROJ[(size_t)r * N0 + 512 + c]);
                e.YMIX[(size_t)r * DM + c] = f2bf(y * sigmoid_f(v + e.bglu[c]) * silu_f(ga)); }
            else e.OUT[(size_t)r * N + c] = v;
        }
}

__global__ void __launch_bounds__(64) k_s5_scan(const bf16_t* PROJ, const float* lam_re, const float* lam_im, const float* log_dt, const float* b_re, const float* b_im,
                                                 const float* c_re, const float* c_im, float* YS) {
    const int p = threadIdx.x, id = blockIdx.x, dir = id & 1, g = (id >> 1) & 31, b = id >> 6;
    const int gi = (dir * 32 + g);
    const double lre = lam_re[gi * 64 + p], lim = lam_im[gi * 64 + p], dt = exp((double)log_dt[gi]);
    const double mag = exp(lre * dt); const float ar = (float)(mag * cos(lim * dt)), ai = (float)(mag * sin(lim * dt));
    const double nr = mag * cos(lim * dt) - 1.0, ni = mag * sin(lim * dt), den = lre * lre + lim * lim;
    const float cfr = (float)((nr * lre + ni * lim) / den), cfi = (float)((ni * lre - nr * lim) / den);
    float bbr[16], bbi[16], cr[16], ci[16];
#pragma unroll
    for (int h = 0; h < 16; ++h) { const float br = b_re[(gi * 64 + p) * 16 + h], bi = b_im[(gi * 64 + p) * 16 + h]; bbr[h] = cfr * br - cfi * bi; bbi[h] = cfr * bi + cfi * br;
        cr[h] = c_re[(gi * 16 + h) * 64 + p]; ci[h] = c_im[(gi * 16 + h) * 64 + p]; }
    float hr = 0.f, hi = 0.f;
    float* ys = YS + (size_t)dir * MROWS * 512;
    for (int pos = 0; pos < POSN; ++pos) {
        int row;
        if (dir == 0) row = pos_row(b, pos); else row = pos < LC ? NLAT + b * LC + (LC - 1 - pos) : b * SEQ + (SEQ - 1 - (pos - LC));
        const bf16_t* up = PROJ + (size_t)row * N0 + g * 16;
        float bur = 0.f, bui = 0.f;
#pragma unroll
        for (int h = 0; h < 16; ++h) { const float u = bf2f(up[h]); bur += bbr[h] * u; bui += bbi[h] * u; }
        const float nhr = ar * hr - ai * hi + bur, nhi = ar * hi + ai * hr + bui; hr = nhr; hi = nhi;
        float mine = 0.f;
#pragma unroll
        for (int h = 0; h < 16; ++h) { const float y = wave_sum(cr[h] * hr - ci[h] * hi); if (p == h) mine = y; }
        if (p < 16) ys[(size_t)row * 512 + g * 16 + p] = mine;
    }
}
__global__ void k_s5_finish(const bf16_t* PROJ, const float* YS, const float* dsk, bf16_t* YPRE) {
    const size_t idx = (size_t)blockIdx.x * blockDim.x + threadIdx.x; if (idx >= (size_t)MROWS * 512) return;
    const int ch = idx & 511; const size_t r = idx >> 9;
    const float y = dsk[ch] * bf2f(PROJ[r * N0 + ch]) + YS[idx] + YS[(size_t)MROWS * 512 + idx];
    YPRE[idx] = f2bf(gelu_tanh(y));
}

__global__ void __launch_bounds__(256) k_na_attn(const bf16_t* PROJ, const float* relb, bf16_t* YMIX) {
    const int wv = blockIdx.x * 4 + (threadIdx.x >> 6), lane = threadIdx.x & 63;
    if (wv >= MROWS * 8) return;
    const int h = wv & 7, r = wv >> 3, b = row_batch(r);
    const float q = bf2f(PROJ[(size_t)r * N0 + 1024 + h * 64 + lane]);
    float m = -INFINITY, l = 0.f, o = 0.f;
    if (r < NLAT) {
        const int t = r & 4095, qr = t >> 6, qc = t & 63;
        const int rs = min(max(qr - 4, 0), 56), cs = min(max(qc - 8, 0), 48);
        for (int kr = rs; kr < rs + 8; ++kr)
            for (int kc = cs; kc < cs + 16; ++kc) {
                const size_t kro = (size_t)(b * SEQ + kr * 64 + kc) * N0;
                float s = wave_sum(q * bf2f(PROJ[kro + 1536 + h * 64 + lane])) * 0.125f + relb[(h * 15 + (kr - qr + 7)) * 31 + (kc - qc + 15)];
                const float mn = fmaxf(m, s), al = __expf(m - mn), pp = __expf(s - mn);
                l = l * al + pp; o = o * al + pp * bf2f(PROJ[kro + 2048 + h * 64 + lane]); m = mn;
            }
    }
    for (int c = 0; c < LC; ++c) {
        const size_t kro = (size_t)(NLAT + b * LC + c) * N0;
        const float s = wave_sum(q * bf2f(PROJ[kro + 1536 + h * 64 + lane])) * 0.125f;
        const float mn = fmaxf(m, s), al = __expf(m - mn), pp = __expf(s - mn);
        l = l * al + pp; o = o * al + pp * bf2f(PROJ[kro + 2048 + h * 64 + lane]); m = mn;
    }
    const float gb = bf2f(PROJ[(size_t)r * N0 + 2560 + h * 64 + lane]);
    YMIX[(size_t)r * DM + 512 + h * 64 + lane] = f2bf(o / l * silu_f(gb));
}

__global__ void __launch_bounds__(64) k_lru(const bf16_t* P1, const float* conv_w, const float* conv_b, const float* lam, const float* w_a, const float* b_a,
                                            const float* w_x, const float* b_x, float* HS, bf16_t* YMIX) {
    __shared__ float xs[64];
    const int j = threadIdx.x, nb = blockIdx.x & 7, b = blockIdx.x >> 3, ch = nb * 64 + j;
    const float cw0 = conv_w[0 * 512 + ch], cw1 = conv_w[1 * 512 + ch], cw2 = conv_w[2 * 512 + ch], cw3 = conv_w[3 * 512 + ch], cb = conv_b[ch];
    for (int dir = 0; dir < 2; ++dir) {
        float wa[64], wx[64];
#pragma unroll
        for (int i = 0; i < 64; ++i) { wa[i] = w_a[((dir * 8 + nb) * 64 + i) * 64 + j]; wx[i] = w_x[((dir * 8 + nb) * 64 + i) * 64 + j]; }
        const float ba = b_a[dir * 512 + ch], bx = b_x[dir * 512 + ch];
        const float lm = lam[dir * 512 + ch]; const float sp = (-lm > 20.f) ? -lm : log1pf(__expf(-lm));
        float hst = 0.f;
        for (int pos = 0; pos < POSN; ++pos) {
            int s0, sl, t;
            if (pos < LC) { s0 = NLAT + b * LC; sl = LC; t = dir == 0 ? pos : LC - 1 - pos; }
            else { s0 = b * SEQ; sl = SEQ; t = dir == 0 ? pos - LC : SEQ - 1 - (pos - LC); }
            float xm1 = 0.f, x0, xp1 = 0.f, xp2 = 0.f;
            x0 = bf2f(P1[(size_t)(s0 + t) * N1 + ch]);
            if (t - 1 >= 0) xm1 = bf2f(P1[(size_t)(s0 + t - 1) * N1 + ch]);
            if (t + 1 < sl) xp1 = bf2f(P1[(size_t)(s0 + t + 1) * N1 + ch]);
            if (t + 2 < sl) xp2 = bf2f(P1[(size_t)(s0 + t + 2) * N1 + ch]);
            const float xc = cw0 * xm1 + cw1 * x0 + cw2 * xp1 + cw3 * xp2 + cb;
            __syncthreads(); xs[j] = xc; __syncthreads();
            float ga = ba, gx = bx;
#pragma unroll
            for (int i = 0; i < 64; ++i) { const float xi = xs[i]; ga += xi * wa[i]; gx += xi * wx[i]; }
            const float gr = sigmoid_f(ga), gi = sigmoid_f(gx);
            const float log_a = -8.f * gr * sp; const float a = __expf(log_a); const float mult = sqrtf(fmaxf(-expm1f(2.f * log_a), 0.f));
            hst = a * hst + mult * gi * xc;
            if (pos >= LC) { const size_t rr = (size_t)(s0 + t);
                if (dir == 0) HS[rr * 512 + ch] = hst;
                else { const float gc = bf2f(P1[rr * N1 + 512 + ch]); YMIX[rr * DM + ch] = f2bf((HS[rr * 512 + ch] + hst) * silu_f(gc)); } }
        }
    }
}

__global__ void __launch_bounds__(256) k_qkprep(const bf16_t* P1, const float* qn, const float* kn, bf16_t* QP, bf16_t* KP) {
    const int wv = blockIdx.x * 4 + (threadIdx.x >> 6), lane = threadIdx.x & 63;
    if (wv >= MROWS * 10) return;
    const int slot = wv % 10, r = wv / 10, b = row_batch(r);
    if (slot < 8 && r >= NLAT) return;
    const int col0 = slot < 8 ? 1024 + slot * 64 : 1536 + (slot - 8) * 64;
    const float x = bf2f(P1[(size_t)r * N1 + col0 + lane]);
    const float ss = wave_sum(x * x);
    float y = x * rsqrtf(ss * (1.f / 64.f) + EPSN) * (slot < 8 ? qn[lane] : kn[lane]);
    if (r < NLAT) {
        const int t = r & 4095, i = lane >> 1, f = i & 15; const float pos = (float)(i < 16 ? (t >> 6) : (t & 63));
        const float inv = (float)exp(-log(10000.0) * (double)(2 * f) / 32.0);
        const float ang = pos * inv; const float cs = cosf(ang), sn = sinf(ang);
        const float pr = __shfl_xor(y, 1);
        y = (lane & 1) ? (pr * sn + y * cs) : (y * cs - pr * sn);
    }
    if (slot < 8) QP[((size_t)(b * 8 + slot) * SEQ + (r & 4095)) * 64 + lane] = f2bf(y * (0.125f * LOG2E));
    else KP[((size_t)(b * 2 + (slot - 8)) * POSN + row_pos(r)) * 64 + lane] = f2bf(y);
}

__global__ void __launch_bounds__(256) k_gqa(const bf16_t* QP, const bf16_t* KP, const bf16_t* P1, bf16_t* YMIX) {
    const int wv = blockIdx.x * 4 + (threadIdx.x >> 6), lane = threadIdx.x & 63;
    if (wv >= NLAT * 8) return;
    const int hq = wv & 7, r = wv >> 3, b = r >> 12, t = r & 4095, kvh = hq >> 2;
    const float q = bf2f(QP[((size_t)(b * 8 + hq) * SEQ + t) * 64 + lane]);
    const bf16_t* kp = KP + (size_t)(b * 2 + kvh) * POSN * 64;
    float m = -INFINITY, l = 0.f, o = 0.f;
    for (int pos = 0; pos < POSN; ++pos) {
        const float s = wave_sum(q * bf2f(kp[(size_t)pos * 64 + lane]));
        const float v = bf2f(P1[(size_t)pos_row(b, pos) * N1 + 1664 + kvh * 64 + lane]);
        const float mn = fmaxf(m, s), al = exp2f(m - mn), pp = exp2f(s - mn);
        l = l * al + pp; o = o * al + pp * v; m = mn;
    }
    const float gd = bf2f(P1[(size_t)r * N1 + 1792 + hq * 64 + lane]);
    YMIX[(size_t)r * DM + 512 + hq * 64 + lane] = f2bf(o / l * silu_f(gd));
}

static int g_grid = 0;
static void launch_mega(Args a, int lo, int hi, int li, hipStream_t stream) {
    a.ph_lo = lo; a.ph_hi = hi; a.li = li;
    hipLaunchKernelGGL(mega, dim3(g_grid), dim3(NTHREADS), LDS_BYTES, stream, a);
    const hipError_t le = hipPeekAtLastError();
    if (le != hipSuccess) fprintf(stderr, "kernel_launch: mega[%d,%d) failed: %s\n", lo, hi, hipGetErrorName(le));
}
extern "C" void kernel_launch(void* const* d_in, const int* in_sizes, int n_in, void* d_out, int out_size, void* d_ws, size_t ws_size, hipStream_t stream) {
    if (g_grid == 0) {
        int dev = 0, cus = 0;
        if (hipGetDevice(&dev) != hipSuccess || hipDeviceGetAttribute(&cus, hipDeviceAttributeMultiprocessorCount, dev) != hipSuccess) { fprintf(stderr, "kernel_launch: device query failed\n"); g_grid = -1; return; }
        if (hipFuncSetAttribute((const void*)mega, hipFuncAttributeMaxDynamicSharedMemorySize, LDS_BYTES) != hipSuccess) { fprintf(stderr, "kernel_launch: hipFuncSetAttribute failed\n"); g_grid = -1; return; }
        int per_cu = 0;
        if (hipOccupancyMaxActiveBlocksPerMultiprocessor(&per_cu, (const void*)mega, NTHREADS, LDS_BYTES) != hipSuccess || per_cu < 1) fprintf(stderr, "kernel_launch: occupancy query says %d blocks/CU\n", per_cu);
        (void)hipGetLastError();
        g_grid = cus;
    }
    if (g_grid < 0) return;
    const float* x = (const float*)d_in[0]; const float* c = (const float*)d_in[1]; const float* ctx = (const float*)d_in[2]; const float* cctx = (const float*)d_in[3];
    const float* ada_w = (const float*)d_in[4]; const float* ada_b = (const float*)d_in[5]; const float* pre_g = (const float*)d_in[6]; const float* post_g = (const float*)d_in[7];
    const float* ev_w_in = (const float*)d_in[8]; const float* ev_w_out = (const float*)d_in[9];
    const float* s5_lre = (const float*)d_in[10]; const float* s5_lim = (const float*)d_in[11]; const float* s5_ldt = (const float*)d_in[12];
    const float* s5_bre = (const float*)d_in[13]; const float* s5_bim = (const float*)d_in[14]; const float* s5_cre = (const float*)d_in[15]; const float* s5_cim = (const float*)d_in[16];
    const float* s5_d = (const float*)d_in[17]; const float* s5_wglu = (const float*)d_in[18]; const float* s5_bglu = (const float*)d_in[19]; const float* relb = (const float*)d_in[20];
    const float* od_w_in = (const float*)d_in[21]; const float* od_w_out = (const float*)d_in[22]; const float* conv_w = (const float*)d_in[23]; const float* conv_b = (const float*)d_in[24];
    const float* lru_lam = (const float*)d_in[25]; const float* w_a = (const float*)d_in[26]; const float* b_a = (const float*)d_in[27]; const float* w_x = (const float*)d_in[28]; const float* b_x = (const float*)d_in[29];
    const float* qn = (const float*)d_in[30]; const float* kn = (const float*)d_in[31];
    char* ws = (char*)d_ws; float* out = (float*)d_out;
    float* MOD = (float*)(ws + WS_MOD); float* HC1 = (float*)(ws + WS_HC1);
    bf16_t* XN = (bf16_t*)(ws + WS_XN); bf16_t* YMIX = (bf16_t*)(ws + WS_YMIX); bf16_t* PROJ = (bf16_t*)(ws + WS_PROJ); float* OUTF = (float*)(ws + WS_PROJ);
    bf16_t* VT0 = (bf16_t*)(ws + WS_VT0); bf16_t* YPRE = (bf16_t*)(ws + WS_YPRE); bf16_t* QP = (bf16_t*)(ws + WS_QP); bf16_t* KP = (bf16_t*)(ws + WS_KP); bf16_t* VT1 = (bf16_t*)(ws + WS_VT1);
    float* YS = (float*)(ws + WS_YS); float* HS = (float*)(ws + WS_HS);
    (void)x; (void)c; (void)ctx; (void)cctx; (void)ada_w; (void)ada_b; (void)pre_g; (void)post_g; (void)ev_w_in; (void)ev_w_out; (void)s5_wglu; (void)od_w_in; (void)od_w_out; (void)MOD; (void)HC1; (void)XN; (void)OUTF; (void)VT0; (void)VT1; (void)out;

    if (hipMemsetAsync(ws + WS_CTL, 0, CTL_ZERO_BYTES, stream) != hipSuccess) { fprintf(stderr, "kernel_launch: memset failed\n"); return; }
    Args a{};
    for (int i = 0; i < 32; ++i) a.in[i] = (const float*)d_in[i];
    a.out = (float*)d_out; a.ws = (unsigned char*)d_ws;

    launch_mega(a, 0, 3, 0, stream);
    k_s5_scan<<<NB * 32 * 2, 64, 0, stream>>>(PROJ, s5_lre, s5_lim, s5_ldt, s5_bre, s5_bim, s5_cre, s5_cim, YS);
    k_s5_finish<<<(MROWS * 512) / 256, 256, 0, stream>>>(PROJ, YS, s5_d, YPRE);
    launch_mega(a, 3, 8, 1, stream);
    k_lru<<<NB * 8, 64, 0, stream>>>(PROJ, conv_w, conv_b, lru_lam, w_a, b_a, w_x, b_x, HS, YMIX);
    k_qkprep<<<(MROWS * 10 + 3) / 4, 256, 0, stream>>>(PROJ, qn, kn, QP, KP);
    launch_mega(a, 9, 12, 2, stream);
    (void)relb;
}
```

```cpp
#include <hip/hip_runtime.h>
#include <cstdint>
#include <cstdio>

typedef unsigned short bf16_t;
#define DI __device__ __forceinline__
#define GAS __attribute__((address_space(1)))
#define LAS __attribute__((address_space(3)))
typedef unsigned v4u __attribute__((ext_vector_type(4)));
typedef unsigned v2u __attribute__((ext_vector_type(2)));
typedef float f32x4_t __attribute__((ext_vector_type(4)));
typedef float f32x16_t __attribute__((ext_vector_type(16)));
typedef short bf16x8_t __attribute__((ext_vector_type(8)));
typedef short s16x4_t __attribute__((ext_vector_type(4)));
typedef GAS unsigned gu32;
typedef GAS unsigned long long gu64;
#define RLX_AGENT __ATOMIC_RELAXED, __HIP_MEMORY_SCOPE_AGENT
#define LDS_WAIT() asm volatile("s_waitcnt lgkmcnt(0)" ::: "memory")
#define VM_WAIT() asm volatile("s_waitcnt vmcnt(0)" ::: "memory")

DI float bf2f(bf16_t v) { return __uint_as_float((unsigned)v << 16); }
DI bf16_t f2bf(float f) { unsigned u = __float_as_uint(f); return (bf16_t)((u + 0x7fffu + ((u >> 16) & 1u)) >> 16); }
DI unsigned pk2(float lo, float hi) { return (unsigned)f2bf(lo) | ((unsigned)f2bf(hi) << 16); }
DI float bflo(unsigned w) { return __uint_as_float(w << 16); }
DI float bfhi(unsigned w) { return __uint_as_float(w & 0xffff0000u); }
DI float rbf(float f) { return bf2f(f2bf(f)); }
DI float wave_sum(float v) {
#pragma unroll
    for (int o = 1; o < 64; o <<= 1) v += __shfl_xor(v, o);
    return v;
}
DI float silu_f(float x) { return x / (1.f + __expf(-x)); }
DI float sigmoid_f(float x) { return 1.f / (1.f + __expf(-x)); }
DI float gelu_tanh(float x) { const float u = 0.7978845608028654f * (x + 0.044715f * x * x * x); return 0.5f * x * (1.f + tanhf(u)); }
DI float gelu_fast(float x) { const float u = 1.5957691216057308f * (x + 0.044715f * x * x * x); return x / (1.f + __expf(-u)); }

constexpr int NWAVES = 8, NTHREADS = 512;
constexpr int DM = 1024, NB = 4, SEQ = 4096, LC = 256;
constexpr int NLAT = NB * SEQ, NCTX = NB * LC, MROWS = NLAT + NCTX;
constexpr int N0 = 3072, N1 = 2304, POSN = LC + SEQ;
constexpr float EPSN = 1e-6f;
constexpr float LOG2E = 1.4426950408889634f;

constexpr size_t MiB = 1u << 20;
constexpr size_t WS_CTL = 0, CTL_ZERO_BYTES = 1 * MiB;
constexpr size_t WS_MOD = 1 * MiB;
constexpr size_t WS_ROPE = 2 * MiB;
constexpr size_t WS_L16 = 3 * MiB;
constexpr size_t WS_WIN0T = 4 * MiB;
constexpr size_t WS_WOUT0T = 10 * MiB;
constexpr size_t WS_WIN1T = 12 * MiB;
constexpr size_t WS_WOUT1T = 17 * MiB;
constexpr size_t WS_WGLUT = 19 * MiB;
constexpr size_t WS_LRUWT = 19 * MiB + 512 * 1024;
constexpr size_t WS_W16 = 20 * MiB;
constexpr size_t WS_WC = 24 * MiB;
constexpr size_t WS_KT = 28 * MiB;
constexpr size_t WS_LSUM = 29 * MiB;
constexpr size_t WS_XN = 32 * MiB;
constexpr size_t WS_YMIX = 66 * MiB;
constexpr size_t WS_PROJ = 100 * MiB;
constexpr size_t WS_VT0 = 202 * MiB;
constexpr size_t WS_CARRY1 = 219 * MiB;
constexpr size_t WS_YPRE = 228 * MiB;
constexpr size_t WS_QP = 202 * MiB;
constexpr size_t WS_KP = 218 * MiB;
constexpr size_t WS_VT1 = 223 * MiB;
constexpr size_t WS_YS = 32 * MiB;
constexpr size_t WS_HS = 32 * MiB;
constexpr size_t WS_HC1 = 246 * MiB;

DI int row_batch(int r) { return r < NLAT ? (r >> 12) : ((r - NLAT) >> 8); }
DI int row_pos(int r) { return r < NLAT ? LC + (r & 4095) : ((r - NLAT) & 255); }
DI int pos_row(int b, int pos) { return pos < LC ? NLAT + b * LC + pos : b * SEQ + (pos - LC); }

namespace pg8 {
#define PG8_LAS __attribute__((address_space(3)))
typedef unsigned short bf16_t;
typedef short bf16x8 __attribute__((ext_vector_type(8)));
typedef float f32x4 __attribute__((ext_vector_type(4)));
typedef unsigned u32x4 __attribute__((ext_vector_type(4)));
constexpr int BM = 256, BK = 64, HALF = 128, HTB = HALF * BK * 2  , STAGE_BYTES = 8 * HTB, NXCD = 8, WGM = 8;

__host__ __device__ __forceinline__ int lds_byte(int r, int c) { const int st = (r >> 4) * 2 + (c >> 5), rr = r & 15, cc = c & 31, ob = rr * 64 + cc * 2; return st * 1024 + (ob ^ (((ob >> 9) & 1) << 5)); }
__host__ __device__ __forceinline__ void stage_rc(int b, int& R, int& C) { const int st = b / 1024, sb = b % 1024, swz = sb ^ (((sb >> 9) & 1) << 5); R = (st >> 1) * 16 + swz / 64; C = (st & 1) * 32 + (swz % 64) / 2; }
__host__ __device__ __forceinline__ int perm32(int rho) { const int n = rho >> 4, i = rho & 15; return 8 * (i >> 2) + 4 * n + (i & 3); }

struct Unit { int pm, pn; };
struct Gemm { const bf16_t* A; const bf16_t* Bt; int M, N, K; };

struct StaticOrder {
    int nM, nN, nwg, G, c;
    __host__ __device__ void init(int M, int N, int G_, int c_) { nM = M / BM; nN = N / BM; nwg = nM * nN; G = G_; c = c_; }
    __host__ __device__ bool next(int i, Unit& u) const {
        const long L = (long)i * G + c; if (L >= nwg) return false;
        int wgid = (int)L; { const int q = nwg / NXCD, r = nwg % NXCD, xcd = wgid % NXCD, off = wgid / NXCD; wgid = (xcd < r ? xcd * (q + 1) : r * (q + 1) + (xcd - r) * q) + off; }
        const int nig = WGM * nN, gid = wgid / nig, fm = gid * WGM, gsz = (nM - fm) < WGM ? (nM - fm) : WGM;
        u.pm = fm + ((wgid % nig) % gsz); u.pn = (wgid % nig) / gsz; return true;
    }
    __device__ __forceinline__ void a_ready(const Unit&) const {}
    __device__ __forceinline__ void done(const Unit&) const {}
};

__device__ __forceinline__ unsigned cvt_pk_bf16(float lo, float hi) { unsigned r; asm volatile("v_cvt_pk_bf16_f32 %0, %1, %2" : "=v"(r) : "v"(lo), "v"(hi)); return r; }

struct EpiProj {
    static constexpr bool PERM = true, AFTER_DRAIN = false;
    bf16_t* P; int ldc; bf16_t* VT; int vt_lo, vt_hi, vt_w;
    __device__ __forceinline__ void operator()(const f32x4 (&acc)[2][2][4][2], const Unit& u, int wr, int wc, int fr, int fq) const {
        const int row0 = u.pm * BM + wr * 64 + fr, colt = u.pn * BM + wc * 32 + 8 * fq;
#pragma unroll
        for (int ai = 0; ai < 2; ++ai)
#pragma unroll
            for (int m = 0; m < 4; ++m) { const int r = row0 + ai * HALF + m * 16; bf16_t* rowp = P + (size_t)r * ldc + colt;
#pragma unroll
                for (int bj = 0; bj < 2; ++bj) { const f32x4 v0 = acc[ai][bj][m][0], v1 = acc[ai][bj][m][1];
                    u32x4 w; w.x = cvt_pk_bf16(v0[0], v0[1]); w.y = cvt_pk_bf16(v0[2], v0[3]); w.z = cvt_pk_bf16(v1[0], v1[1]); w.w = cvt_pk_bf16(v1[2], v1[3]);
                    *(u32x4*)(rowp + bj * HALF) = w;
                    const int c0 = colt + bj * HALF;
                    if (c0 >= vt_lo && c0 < vt_hi) {
                        bf16_t* vp = VT + ((size_t)row_batch(r) * vt_w + (c0 - vt_lo)) * POSN + row_pos(r);
                        vp[0 * POSN] = (bf16_t)(w.x & 0xffffu); vp[1 * POSN] = (bf16_t)(w.x >> 16); vp[2 * POSN] = (bf16_t)(w.y & 0xffffu); vp[3 * POSN] = (bf16_t)(w.y >> 16);
                        vp[4 * POSN] = (bf16_t)(w.z & 0xffffu); vp[5 * POSN] = (bf16_t)(w.z >> 16); vp[6 * POSN] = (bf16_t)(w.w & 0xffffu); vp[7 * POSN] = (bf16_t)(w.w >> 16);
                    } } }
    }
};
struct EpiGlu {
    static constexpr bool PERM = true, AFTER_DRAIN = false;
    const bf16_t* YPRE; const bf16_t* PROJ; const float* bglu; bf16_t* YMIX;
    __device__ __forceinline__ void operator()(const f32x4 (&acc)[2][2][4][2], const Unit& u, int wr, int wc, int fr, int fq) const {
        const int row0 = u.pm * BM + wr * 64 + fr, colt = u.pn * BM + wc * 32 + 8 * fq;
#pragma unroll
        for (int bj = 0; bj < 2; ++bj) { const int c0 = colt + bj * HALF;
            const f32x4 b0 = *(const f32x4*)(bglu + c0), b1 = *(const f32x4*)(bglu + c0 + 4);
#pragma unroll
            for (int ai = 0; ai < 2; ++ai)
#pragma unroll
                for (int m = 0; m < 4; ++m) { const int r = row0 + ai * HALF + m * 16;
                    const u32x4 yv = *(const u32x4*)(YPRE + (size_t)r * 512 + c0), gv = *(const u32x4*)(PROJ + (size_t)r * N0 + 512 + c0);
                    const f32x4 a0 = acc[ai][bj][m][0] + b0, a1 = acc[ai][bj][m][1] + b1;
                    float o[8];
                    o[0] = bflo(yv.x) * sigmoid_f(a0[0]) * silu_f(bflo(gv.x)); o[1] = bfhi(yv.x) * sigmoid_f(a0[1]) * silu_f(bfhi(gv.x));
                    o[2] = bflo(yv.y) * sigmoid_f(a0[2]) * silu_f(bflo(gv.y)); o[3] = bfhi(yv.y) * sigmoid_f(a0[3]) * silu_f(bfhi(gv.y));
                    o[4] = bflo(yv.z) * sigmoid_f(a1[0]) * silu_f(bflo(gv.z)); o[5] = bfhi(yv.z) * sigmoid_f(a1[1]) * silu_f(bfhi(gv.z));
                    o[6] = bflo(yv.w) * sigmoid_f(a1[2]) * silu_f(bflo(gv.w)); o[7] = bfhi(yv.w) * sigmoid_f(a1[3]) * silu_f(bfhi(gv.w));
                    u32x4 w; w.x = cvt_pk_bf16(o[0], o[1]); w.y = cvt_pk_bf16(o[2], o[3]); w.z = cvt_pk_bf16(o[4], o[5]); w.w = cvt_pk_bf16(o[6], o[7]);
                    *(u32x4*)(YMIX + (size_t)r * DM + c0) = w; } }
    }
};
struct EpiF32 {
    static constexpr bool PERM = false, AFTER_DRAIN = false;
    float* O; int ldc;
    __device__ __forceinline__ void operator()(const f32x4 (&acc)[2][2][4][2], const Unit& u, int wr, int wc, int fr, int fq) const {
        const int row0 = u.pm * BM + wr * 64 + fr, col0 = u.pn * BM + wc * 32 + 4 * fq;
#pragma unroll
        for (int ai = 0; ai < 2; ++ai)
#pragma unroll
            for (int m = 0; m < 4; ++m) { float* rowp = O + (size_t)(row0 + ai * HALF + m * 16) * ldc + col0;
#pragma unroll
                for (int bj = 0; bj < 2; ++bj)
#pragma unroll
                    for (int n = 0; n < 2; ++n) *(f32x4*)(rowp + bj * HALF + n * 16) = acc[ai][bj][m][n]; }
    }
};
template <class Epi, class Sched, bool ALIGN_EPI = false, bool SP2 = false>
__device__ __forceinline__ void gemm_phase(PG8_LAS unsigned char* lds, const Gemm g, const Sched& S, const Epi& E) {
    const int tid = threadIdx.x, wid = __builtin_amdgcn_readfirstlane(tid >> 6), lane = tid & 63, wr = wid >> 2, wc = wid & 3, fr = lane & 15, fq = lane >> 4;
    const int K = g.K, nt = K / BK;
    unsigned voffA[2], voffB[2];
#pragma unroll
    for (int i = 0; i < 2; ++i) { int R, C; stage_rc(tid * 16 + i * 8192, R, C); const int Rb = Epi::PERM ? ((R & ~31) + perm32(R & 31)) : R;
        voffA[i] = (unsigned)(R * K + C) * 2u; voffB[i] = (unsigned)(Rb * K + C) * 2u; }
    const size_t kstep = (size_t)(BK * 2);
    const size_t hstep = (size_t)HALF * K * 2;
    const size_t tstep = 2 * hstep;
    const unsigned ldsw = (unsigned)wid * 1024u;
    const int aoff = lds_byte(wr * 64 + fr, fq * 8), boff = lds_byte(wc * 32 + fr, fq * 8);
#define PG8_SA(b, h) (((b) * 2 + (h)) * HTB)
#define PG8_SB(b, h) ((4 + (b) * 2 + (h)) * HTB)
#define PG8_STAGE(bufoff, gbase, voff) do { _Pragma("unroll") for (int _i = 0; _i < 2; ++_i) \
        __builtin_amdgcn_global_load_lds((const unsigned*)((const char*)(gbase) + (voff)[_i]), (PG8_LAS unsigned*)(lds + (bufoff) + ldsw + _i * 8192), 16, 0, 0); } while (0)
#define PG8_LDA(dst, b, h) do { _Pragma("unroll") for (int m = 0; m < 4; ++m) _Pragma("unroll") for (int k = 0; k < 2; ++k) dst[m][k] = *(const PG8_LAS bf16x8*)(lds + PG8_SA(b, h) + aoff + m * 2048 + k * 1024); } while (0)
#define PG8_LDB(dst, b, h) do { _Pragma("unroll") for (int n = 0; n < 2; ++n) _Pragma("unroll") for (int k = 0; k < 2; ++k) dst[n][k] = *(const PG8_LAS bf16x8*)(lds + PG8_SB(b, h) + boff + n * 2048 + k * 1024); } while (0)
#define PG8_MMA(ai, bj, At, Bt) do { __builtin_amdgcn_s_setprio(1); _Pragma("unroll") for (int m = 0; m < 4; ++m) _Pragma("unroll") for (int n = 0; n < 2; ++n) _Pragma("unroll") for (int k = 0; k < 2; ++k) \
        acc[ai][bj][m][n] = __builtin_amdgcn_mfma_f32_16x16x32_bf16(Bt[n][k], At[m][k], acc[ai][bj][m][n], 0, 0, 0); __builtin_amdgcn_s_setprio(0); } while (0)
#define PG8_WAIT_V(n) asm volatile("s_waitcnt vmcnt(" #n ")" ::: "memory")
#define PG8_WAIT_L(n) asm volatile("s_waitcnt lgkmcnt(" #n ")" ::: "memory")
#define PG8_BAR __builtin_amdgcn_s_barrier()
#define PG8_SCHED __builtin_amdgcn_sched_barrier(0)
    Unit cur, nxt; int ui = 0;
    if (!S.next(0, cur)) return;
    f32x4 acc[2][2][4][2];
#pragma unroll
    for (int a = 0; a < 2; ++a)
#pragma unroll
        for (int b = 0; b < 2; ++b)
#pragma unroll
            for (int m = 0; m < 4; ++m)
#pragma unroll
                for (int n = 0; n < 2; ++n) acc[a][b][m][n] = (f32x4){0.f, 0.f, 0.f, 0.f};
    bf16x8 At[4][2], B0[2][2], B1[2][2];
    const char* cA = (const char*)g.A + (size_t)cur.pm * tstep; const char* cB = (const char*)g.Bt + (size_t)cur.pn * tstep;
    S.a_ready(cur);
    if constexpr (SP2) {
        PG8_STAGE(PG8_SB(0, 0), cB, voffB); PG8_STAGE(PG8_SB(0, 1), cB + hstep, voffB); PG8_STAGE(PG8_SA(0, 0), cA, voffA); PG8_STAGE(PG8_SA(0, 1), cA + hstep, voffA);
        if (wr == 1) PG8_BAR;
        PG8_WAIT_V(2); PG8_BAR;
        PG8_STAGE(PG8_SB(1, 0), cB + kstep, voffB); PG8_STAGE(PG8_SA(1, 0), cA + kstep, voffA); PG8_STAGE(PG8_SB(1, 1), cB + hstep + kstep, voffB);
        PG8_WAIT_V(6); PG8_BAR;
    } else {
        PG8_STAGE(PG8_SB(0, 0), cB, voffB); PG8_STAGE(PG8_SA(0, 0), cA, voffA); PG8_STAGE(PG8_SB(0, 1), cB + hstep, voffB); PG8_STAGE(PG8_SA(0, 1), cA + hstep, voffA);
        if (wr == 1) PG8_BAR;
        PG8_WAIT_V(4); PG8_BAR;
        PG8_STAGE(PG8_SB(1, 0), cB + kstep, voffB); PG8_STAGE(PG8_SA(1, 0), cA + kstep, voffA); PG8_STAGE(PG8_SB(1, 1), cB + hstep + kstep, voffB);
        PG8_WAIT_V(6); PG8_BAR;
    }
    for (;;) {
        const bool has_next = S.next(ui + 1, nxt);
        const char* nA = has_next ? (const char*)g.A + (size_t)nxt.pm * tstep : cA; const char* nB = has_next ? (const char*)g.Bt + (size_t)nxt.pn * tstep : cB;
        for (int t = 0; t < nt; t += 2) {
            const bool last = (t == nt - 2);
            const char* a1 = cA + (size_t)(t + 1) * kstep;
            const char* a2 = last ? nA : cA + (size_t)(t + 2) * kstep; const char* b2 = last ? nB : cB + (size_t)(t + 2) * kstep;
            const char* a3 = a2 + kstep; const char* b3 = b2 + kstep;
            if (last && has_next) S.a_ready(nxt);
            if constexpr (SP2) {
            PG8_LDB(B0, 0, 0); PG8_LDB(B1, 0, 1); PG8_SCHED; PG8_LDA(At, 0, 0); PG8_STAGE(PG8_SA(1, 1), a1 + hstep, voffA);
            PG8_WAIT_V(8); PG8_WAIT_L(0); PG8_BAR; PG8_MMA(0, 0, At, B0); PG8_MMA(0, 1, At, B1); PG8_BAR; PG8_SCHED;
            PG8_LDA(At, 0, 1); PG8_STAGE(PG8_SB(0, 0), b2, voffB); PG8_STAGE(PG8_SB(0, 1), b2 + hstep, voffB); PG8_STAGE(PG8_SA(0, 0), a2, voffA);
            PG8_WAIT_V(8); PG8_WAIT_L(0); PG8_BAR; PG8_MMA(1, 0, At, B0); PG8_MMA(1, 1, At, B1); PG8_BAR; PG8_SCHED;
            PG8_LDB(B0, 1, 0); PG8_LDB(B1, 1, 1); PG8_SCHED; PG8_LDA(At, 1, 0); PG8_STAGE(PG8_SA(0, 1), a2 + hstep, voffA);
            PG8_WAIT_V(8); PG8_WAIT_L(0); PG8_BAR; PG8_MMA(0, 0, At, B0); PG8_MMA(0, 1, At, B1); PG8_BAR; PG8_SCHED;
            PG8_LDA(At, 1, 1); PG8_STAGE(PG8_SB(1, 0), b3, voffB); PG8_STAGE(PG8_SB(1, 1), b3 + hstep, voffB); PG8_STAGE(PG8_SA(1, 0), a3, voffA);
            PG8_WAIT_V(8); PG8_WAIT_L(0); PG8_BAR; PG8_MMA(1, 0, At, B0); PG8_MMA(1, 1, At, B1); PG8_BAR; PG8_SCHED;
            } else {
            PG8_LDB(B0, 0, 0); PG8_SCHED; PG8_LDA(At, 0, 0); PG8_STAGE(PG8_SA(1, 1), a1 + hstep, voffA);
            PG8_WAIT_L(8); PG8_BAR; PG8_WAIT_L(0); PG8_MMA(0, 0, At, B0); PG8_BAR; PG8_SCHED;
            PG8_LDB(B1, 0, 1); PG8_STAGE(PG8_SB(0, 0), b2, voffB);
            PG8_BAR; PG8_WAIT_L(0); PG8_MMA(0, 1, At, B1); PG8_BAR;
            PG8_LDA(At, 0, 1); PG8_STAGE(PG8_SA(0, 0), a2, voffA);
            PG8_BAR; PG8_WAIT_L(0); PG8_MMA(1, 0, At, B0); PG8_BAR; PG8_SCHED;
            PG8_STAGE(PG8_SB(0, 1), b2 + hstep, voffB);
            PG8_WAIT_V(6); PG8_BAR; PG8_MMA(1, 1, At, B1); PG8_BAR;
            PG8_LDB(B0, 1, 0); PG8_SCHED; PG8_LDA(At, 1, 0); PG8_STAGE(PG8_SA(0, 1), a2 + hstep, voffA);
            PG8_WAIT_L(8); PG8_BAR; PG8_WAIT_L(0); PG8_MMA(0, 0, At, B0); PG8_BAR; PG8_SCHED;
            PG8_LDB(B1, 1, 1); PG8_STAGE(PG8_SB(1, 0), b3, voffB);
            PG8_BAR; PG8_WAIT_L(0); PG8_MMA(0, 1, At, B1); PG8_BAR;
            PG8_LDA(At, 1, 1); PG8_STAGE(PG8_SA(1, 0), a3, voffA);
            PG8_BAR; PG8_WAIT_L(0); PG8_MMA(1, 0, At, B0); PG8_BAR; PG8_SCHED;
            PG8_STAGE(PG8_SB(1, 1), b3 + hstep, voffB);
            PG8_WAIT_V(6); PG8_BAR; PG8_MMA(1, 1, At, B1); PG8_BAR;
            }
        }
        if constexpr (ALIGN_EPI) { if (wr == 0) PG8_BAR; }
        if constexpr (!Epi::AFTER_DRAIN) { E(acc, cur, wr, wc, fr, fq); S.done(cur); }
        if (!has_next) break;
#pragma unroll
        for (int a = 0; a < 2; ++a)
#pragma unroll
            for (int b = 0; b < 2; ++b)
#pragma unroll
                for (int m = 0; m < 4; ++m)
#pragma unroll
                    for (int n = 0; n < 2; ++n) acc[a][b][m][n] = (f32x4){0.f, 0.f, 0.f, 0.f};
        cur = nxt; cA = nA; cB = nB; ++ui;
        if constexpr (ALIGN_EPI) { if (wr == 1) PG8_BAR; }
    }
    PG8_WAIT_V(0);
    if constexpr (!ALIGN_EPI) { if (wr == 0) PG8_BAR; }
    PG8_BAR;
    if constexpr (Epi::AFTER_DRAIN) { E.fused(acc, cur, wr, wc, fr, fq, lds, wid, lane); S.done(cur); }
#undef PG8_SA
#undef PG8_SB
#undef PG8_STAGE
#undef PG8_LDA
#undef PG8_LDB
#undef PG8_MMA
#undef PG8_WAIT_V
#undef PG8_WAIT_L
#undef PG8_BAR
#undef PG8_SCHED
}
}
#define XB_TMO      128
#define XB_XCNT(j)  (256  + 64 * (j))
#define XB_XSUB(j)  (1280 + 64 * (j))
#define XB_XGEN(j)  (2304 + 64 * (j))
#define XB_TOP      3328
#define XB_TOPGEN   3392
#define XCD_BAR_WORDS 3456
#define XB_SPIN_CAP (1u << 18)

__device__ __forceinline__ unsigned xb_ld(unsigned* p)              { return __hip_atomic_load(p, __ATOMIC_RELAXED, __HIP_MEMORY_SCOPE_AGENT); }
__device__ __forceinline__ unsigned xb_add(unsigned* p, unsigned v) { return __hip_atomic_fetch_add(p, v, __ATOMIC_RELAXED, __HIP_MEMORY_SCOPE_AGENT); }
__device__ __forceinline__ unsigned xb_xcc_id() { return (unsigned)__builtin_amdgcn_s_getreg((3 << 11) | 20) & 0xFu; }
#define XB_SPIN(cond, bar) do { unsigned _sp = 0; while (cond) { __builtin_amdgcn_s_sleep(1); \
    if ((++_sp & 255u) == 0u) { if (xb_ld(&(bar)[XB_TMO])) break; if (_sp > XB_SPIN_CAP) { atomicAdd(&(bar)[XB_TMO], 1u); break; } } } } while (0)

struct XcdBarrier {
    unsigned* bar; unsigned x;
    volatile LAS unsigned* st;
};

__device__ __forceinline__ XcdBarrier xcd_barrier_post(unsigned* bar, volatile LAS unsigned* st) {
    XcdBarrier b; b.bar = bar; b.x = xb_xcc_id(); b.st = st;
    if (threadIdx.x == 0) (void)xb_add(&bar[XB_XCNT(b.x)], 1u);
    return b;
}
__device__ __forceinline__ void xcd_barrier_complete(unsigned* bar, unsigned x, unsigned& nloc, unsigned& nx) {
    const unsigned G = gridDim.x * gridDim.y * gridDim.z;
    unsigned sum, cnt, mine, sp = 0u;
    for (;;) {
        sum = 0u; cnt = 0u; mine = 0u;
#pragma unroll
        for (unsigned j = 0; j < 16; ++j) { const unsigned c = xb_ld(&bar[XB_XCNT(j)]); sum += c; cnt += (c > 0u) ? 1u : 0u; mine = (j == x) ? c : mine; }
        if (sum == G) break;
        __builtin_amdgcn_s_sleep(1);
        if ((++sp & 255u) == 0u) { if (xb_ld(&bar[XB_TMO])) break; if (sp > XB_SPIN_CAP) { atomicAdd(&bar[XB_TMO], 1u); break; } }
    }
    nloc = mine > 0u ? mine : 1u; nx = cnt > 0u ? cnt : 1u;
}

__device__ __forceinline__ void xcd_barrier(const XcdBarrier& b) {
    asm volatile("s_waitcnt vmcnt(0)" ::: "memory");
    __syncthreads();
    if (threadIdx.x == 0) {
        unsigned* bar = b.bar;
        __builtin_amdgcn_s_waitcnt(0);
        unsigned nloc = b.st[0], nx = b.st[1];
        if (nloc == 0u) { xcd_barrier_complete(bar, b.x, nloc, nx); b.st[0] = nloc; b.st[1] = nx; }
        const unsigned old = xb_add(&bar[XB_XSUB(b.x)], 1u);
        const unsigned gen = old / nloc;
        if (old + 1u == (gen + 1u) * nloc) {
            __builtin_amdgcn_fence(__ATOMIC_RELEASE, "agent");
            asm volatile("s_waitcnt vmcnt(0)" ::: "memory");
            const unsigned og = xb_add(&bar[XB_TOP], 1u);
            const unsigned tg = og / nx;
            if (og + 1u == (tg + 1u) * nx) xb_add(&bar[XB_TOPGEN], 1u);
            else XB_SPIN(xb_ld(&bar[XB_TOPGEN]) == tg, bar);
            __builtin_amdgcn_fence(__ATOMIC_ACQUIRE, "agent");
            xb_add(&bar[XB_XGEN(b.x)], 1u);
            asm volatile("s_waitcnt vmcnt(0)" ::: "memory");
        } else {
            XB_SPIN(xb_ld(&bar[XB_XGEN(b.x)]) == gen, bar);
            __builtin_amdgcn_fence(__ATOMIC_ACQUIRE, "agent");
            asm volatile("s_waitcnt vmcnt(0)" ::: "memory");
        }
    }
    __syncthreads();
}

DI int crow16(int reg, int hf) { return (reg & 3) + 8 * (reg >> 2) + 4 * hf; }
DI unsigned cvtpk(float lo, float hi) { typedef float f2 __attribute__((ext_vector_type(2))); typedef __bf16 b2 __attribute__((ext_vector_type(2))); f2 v = {lo, hi}; b2 b = __builtin_convertvector(v, b2); return __builtin_bit_cast(unsigned, b); }
struct AttnP { const bf16_t* Q; const bf16_t* K; const bf16_t* VT; const bf16_t* Gt; bf16_t* Y; const float* relb; };

template <int MODE> DI void attn_unit(int unit, const AttnP& P, int lane) {
    const int ql = lane & 31, hf = lane >> 5;
    int b, h, kvh, qrow, NT, rp = 0, ci = 0, rs0 = 0, c0 = 0, qr = 0, qc = 0, rsq = 0, csq = 0;
    if (MODE == 0) { ci = unit & 3; rp = (unit >> 2) & 31; h = (unit >> 7) & 7; b = unit >> 10; kvh = h;
        qr = 2 * rp + (ql >> 4); qc = 16 * ci + (ql & 15); qrow = b * SEQ + qr * 64 + qc;
        rs0 = min(max(2 * rp - 4, 0), 56); const int rs1 = min(max(2 * rp - 3, 0), 56); NT = 8 + (rs1 + 8 - rs0);
        c0 = min(max(16 * ci - 8, 0), 32); rsq = min(max(qr - 4, 0), 56); csq = min(max(qc - 8, 0), 48);
    } else if (MODE == 1) { const int qt = unit & 7; h = (unit >> 3) & 7; b = unit >> 6; kvh = h; qrow = NLAT + b * LC + 32 * qt + ql; NT = 8; }
    else { const int qt = unit & 127; h = (unit >> 7) & 7; b = unit >> 10; kvh = h >> 2; qrow = b * SEQ + 32 * qt + ql; NT = POSN / 32; }
    const bf16_t* qp; const bf16_t* kb; size_t kpitch; const bf16_t* vt; const bf16_t* gp; bf16_t* yp;
    if (MODE == 2) { qp = P.Q + ((size_t)(b * 8 + h) * SEQ + (qrow - b * SEQ)) * 64; kb = P.K + (size_t)(b * 2 + kvh) * POSN * 64; kpitch = 64;
        vt = P.VT + (size_t)(b * 2 + kvh) * 64 * POSN; gp = P.Gt + (size_t)qrow * N1 + 1792 + h * 64; }
    else { qp = P.Q + (size_t)qrow * N0 + 1024 + h * 64; kb = P.K + 1536 + h * 64; kpitch = N0; vt = P.VT + (size_t)(b * 8 + h) * 64 * POSN; gp = P.Gt + (size_t)qrow * N0 + 2560 + h * 64; }
    yp = P.Y + (size_t)qrow * DM + 512 + h * 64;
    bf16x8_t qf[4];
#pragma unroll
    for (int ks = 0; ks < 4; ++ks) qf[ks] = *(const bf16x8_t*)(qp + 16 * ks + 8 * hf);
    const bf16_t* vt0 = vt + (size_t)ql * POSN + 4 * hf;
    f32x16_t o0 = {}, o1 = {};
    float m = -1e30f, l = 0.f;
    auto tile_krow = [&](int t) -> int { if (MODE == 2) return 32 * t + ql; if (t < 8) return NLAT + b * LC + 32 * t + ql; return b * SEQ + (rs0 + t - 8) * 64 + c0 + ql; };
    auto tile_pos0 = [&](int t) -> int { if (MODE == 2) return 32 * t; if (t < 8) return 32 * t; return LC + (rs0 + t - 8) * 64 + c0; };
    bf16x8_t kn[4];
    { const bf16_t* kp = kb + (size_t)tile_krow(0) * kpitch + 8 * hf;
#pragma unroll
      for (int ks = 0; ks < 4; ++ks) kn[ks] = *(const bf16x8_t*)(kp + 16 * ks); }
#pragma unroll 1
    for (int t = 0; t < NT; ++t) {
        bf16x8_t kf[4];
#pragma unroll
        for (int ks = 0; ks < 4; ++ks) kf[ks] = kn[ks];
        if (t + 1 < NT) { const bf16_t* kp = kb + (size_t)tile_krow(t + 1) * kpitch + 8 * hf;
#pragma unroll
            for (int ks = 0; ks < 4; ++ks) kn[ks] = *(const bf16x8_t*)(kp + 16 * ks); }
        const bf16_t* vp = vt0 + tile_pos0(t);
        s16x4_t va[2][2][2];
#pragma unroll
        for (int dt = 0; dt < 2; ++dt)
#pragma unroll
            for (int s = 0; s < 2; ++s) { va[dt][s][0] = *(const s16x4_t*)(vp + (size_t)dt * 32 * POSN + 16 * s); va[dt][s][1] = *(const s16x4_t*)(vp + (size_t)dt * 32 * POSN + 16 * s + 8); }
        f32x16_t sc = {};
#pragma unroll
        for (int ks = 0; ks < 4; ++ks) sc = __builtin_amdgcn_mfma_f32_32x32x16_bf16(kf[ks], qf[ks], sc, 0, 0, 0);
        float xs[16];
        if (MODE == 0 && t >= 8) {
            const int kr = rs0 + t - 8; const bool row_ok = (kr >= rsq) && (kr < rsq + 8);
            const float* rb = P.relb + (h * 15 + (kr - qr + 7)) * 31 + (15 - qc);
#pragma unroll
            for (int r = 0; r < 16; ++r) { const int kc = c0 + crow16(r, hf); const bool ok = row_ok && (kc >= csq) && (kc < csq + 16);
                const float bias = ok ? rb[kc] : 0.f; xs[r] = ok ? (sc[r] * 0.125f + bias) * LOG2E : -1e30f; }
        } else {
#pragma unroll
            for (int r = 0; r < 16; ++r) xs[r] = (MODE == 2) ? sc[r] : sc[r] * (0.125f * LOG2E);
        }
        float tm = xs[0];
#pragma unroll
        for (int r = 1; r < 16; ++r) tm = fmaxf(tm, xs[r]);
        tm = fmaxf(tm, __shfl_xor(tm, 32));
        const float mn = fmaxf(m, tm), al = __builtin_amdgcn_exp2f(m - mn);
        float ps = 0.f;
#pragma unroll
        for (int r = 0; r < 16; ++r) { xs[r] = __builtin_amdgcn_exp2f(xs[r] - mn); ps += xs[r]; }
        l = l * al + ps; m = mn;
#pragma unroll
        for (int r = 0; r < 16; ++r) { o0[r] *= al; o1[r] *= al; }
        bf16x8_t pf[2];
#pragma unroll
        for (int s = 0; s < 2; ++s) { v4u w; w.x = cvtpk(xs[8 * s], xs[8 * s + 1]); w.y = cvtpk(xs[8 * s + 2], xs[8 * s + 3]); w.z = cvtpk(xs[8 * s + 4], xs[8 * s + 5]); w.w = cvtpk(xs[8 * s + 6], xs[8 * s + 7]);
            pf[s] = __builtin_bit_cast(bf16x8_t, w); }
#pragma unroll
        for (int s = 0; s < 2; ++s) {
            const bf16x8_t a0 = __builtin_shufflevector(va[0][s][0], va[0][s][1], 0, 1, 2, 3, 4, 5, 6, 7);
            const bf16x8_t a1 = __builtin_shufflevector(va[1][s][0], va[1][s][1], 0, 1, 2, 3, 4, 5, 6, 7);
            o0 = __builtin_amdgcn_mfma_f32_32x32x16_bf16(a0, pf[s], o0, 0, 0, 0);
            o1 = __builtin_amdgcn_mfma_f32_32x32x16_bf16(a1, pf[s], o1, 0, 0, 0);
        }
    }
    l += __shfl_xor(l, 32);
    const float rl = 1.f / l;
#pragma unroll
    for (int dt = 0; dt < 2; ++dt)
#pragma unroll
        for (int rg = 0; rg < 4; ++rg) { const int d = 32 * dt + 8 * rg + 4 * hf;
            const v2u gv = *(const v2u*)(gp + d);
            const float g0 = silu_f(bflo(gv.x)), g1 = silu_f(bfhi(gv.x)), g2 = silu_f(bflo(gv.y)), g3 = silu_f(bfhi(gv.y));
            const f32x16_t& oo = dt ? o1 : o0;
            v2u w; w.x = pk2(oo[4 * rg] * rl * g0, oo[4 * rg + 1] * rl * g1); w.y = pk2(oo[4 * rg + 2] * rl * g2, oo[4 * rg + 3] * rl * g3);
            *(v2u*)(yp + d) = w; }
}

constexpr int LRU_NCH = 34;
typedef float f32x2_t __attribute__((ext_vector_type(2)));
struct LruP { const bf16_t* P1; const float* conv_w; const float* conv_b; const float* lam; const float* b_a; const float* b_x; const bf16_t* WT; f32x2_t* LSUM; bf16_t* YMIX; };

template <bool PASS2> DI void lru_item(int item, const LruP& p, LAS unsigned char* lds, int tid, int wave, int lane) {
    LAS bf16_t* XA = (LAS bf16_t*)lds;
    LAS float* XF = (LAS float*)(lds + 18432);
    LAS float* CW = (LAS float*)(lds + 18432 + 33280);
    LAS f32x2_t* SEG = (LAS f32x2_t*)(lds + 18432 + 33280 + 1280);
    LAS f32x2_t* CS = (LAS f32x2_t*)(lds + 18432 + 33280 + 1280 + 4096);
    LAS float* CC = (LAS float*)(lds + 18432 + 33280 + 1280 + 4096 + 34816);
    int nb, cidx, b;
    if (PASS2) { nb = item & 7; cidx = 2 + ((item >> 3) & 31); b = item >> 8; } else { nb = item & 7; cidx = (item >> 3) % LRU_NCH; b = (item >> 3) / LRU_NCH; }
    const int s0 = cidx < 2 ? NLAT + b * LC : b * SEQ, sl = cidx < 2 ? LC : SEQ, t0 = cidx < 2 ? cidx * 128 : (cidx - 2) * 128;
    const int n = lane & 15, q = lane >> 4;
    __syncthreads();
    if (tid < 320) CW[tid] = tid < 256 ? p.conv_w[(tid >> 6) * 512 + nb * 64 + (tid & 63)] : p.conv_b[nb * 64 + (tid & 63)];
    if (PASS2) { for (int e = tid; e < 2 * LRU_NCH * 64; e += NTHREADS) { const int ch = e & 63, cc = (e >> 6) % LRU_NCH, dir = (e >> 6) / LRU_NCH; CS[e] = p.LSUM[((size_t)(b * LRU_NCH + cc) * 2 + dir) * 512 + nb * 64 + ch]; } }
    __syncthreads();
    {
        const int tl = tid >> 2, cg = tid & 3;
        float xv[4][16];
#pragma unroll
        for (int j = 0; j < 4; ++j) { const int tt = t0 + tl + j - 1; const bool ok = tt >= 0 && tt < sl;
            v4u w0 = {0u, 0u, 0u, 0u}, w1 = {0u, 0u, 0u, 0u};
            if (ok) { const bf16_t* src = p.P1 + (size_t)(s0 + tt) * N1 + nb * 64 + cg * 16; w0 = *(const v4u*)src; w1 = *(const v4u*)(src + 8); }
            xv[j][0] = bflo(w0.x); xv[j][1] = bfhi(w0.x); xv[j][2] = bflo(w0.y); xv[j][3] = bfhi(w0.y); xv[j][4] = bflo(w0.z); xv[j][5] = bfhi(w0.z); xv[j][6] = bflo(w0.w); xv[j][7] = bfhi(w0.w);
            xv[j][8] = bflo(w1.x); xv[j][9] = bfhi(w1.x); xv[j][10] = bflo(w1.y); xv[j][11] = bfhi(w1.y); xv[j][12] = bflo(w1.z); xv[j][13] = bfhi(w1.z); xv[j][14] = bflo(w1.w); xv[j][15] = bfhi(w1.w); }
#pragma unroll
        for (int e = 0; e < 16; ++e) { const int c = cg * 16 + e;
            const float xc = CW[c] * xv[0][e] + CW[64 + c] * xv[1][e] + CW[128 + c] * xv[2][e] + CW[192 + c] * xv[3][e] + CW[256 + c];
            XF[tl * 65 + c] = xc; XA[tl * 72 + c] = f2bf(xc); }
    }
    __syncthreads();
    bf16x8_t af[2];
#pragma unroll
    for (int ks = 0; ks < 2; ++ks) af[ks] = *(const LAS bf16x8_t*)(XA + (wave * 16 + n) * 72 + 32 * ks + 8 * q);
    float hsum[4][4];
#pragma unroll
    for (int c4 = 0; c4 < 4; ++c4)
#pragma unroll
        for (int r = 0; r < 4; ++r) hsum[c4][r] = 0.f;
#pragma unroll 1
    for (int dir = 0; dir < 2; ++dir) {
        f32x4_t acc[8];
#pragma unroll
        for (int nt = 0; nt < 8; ++nt) { acc[nt] = (f32x4_t){0.f, 0.f, 0.f, 0.f};
            const bf16_t* wrow = p.WT + (size_t)(nb * 256 + (dir * 2 + (nt >> 2)) * 64 + (nt & 3) * 16 + n) * 64 + 8 * q;
#pragma unroll
            for (int ks = 0; ks < 2; ++ks) { const bf16x8_t bfr = *(const bf16x8_t*)(wrow + 32 * ks); acc[nt] = __builtin_amdgcn_mfma_f32_16x16x32_bf16(af[ks], bfr, acc[nt], 0, 0, 0); } }
        float a[4][4], bt[4][4];
#pragma unroll
        for (int c4 = 0; c4 < 4; ++c4) { const int ch = nb * 64 + c4 * 16 + n;
            const float ba = p.b_a[dir * 512 + ch], bx = p.b_x[dir * 512 + ch], lm = p.lam[dir * 512 + ch]; const float sp = log1pf(__expf(-lm));
#pragma unroll
            for (int r = 0; r < 4; ++r) { const float gr = sigmoid_f(acc[c4][r] + ba), gi = sigmoid_f(acc[c4 + 4][r] + bx);
                const float log_a = -8.f * gr * sp; a[c4][r] = __expf(log_a); const float mult = sqrtf(fmaxf(-expm1f(2.f * log_a), 0.f));
                bt[c4][r] = mult * gi * XF[(wave * 16 + 4 * q + r) * 65 + c4 * 16 + n]; } }
        float Pq[4], Sq[4];
#pragma unroll
        for (int c4 = 0; c4 < 4; ++c4) { float P = 1.f, S = 0.f;
#pragma unroll
            for (int rr = 0; rr < 4; ++rr) { const int r = dir == 0 ? rr : 3 - rr; S = a[c4][r] * S + bt[c4][r]; P *= a[c4][r]; }
            Pq[c4] = P; Sq[c4] = S; }
        float Pin[4], Sin[4];
#pragma unroll
        for (int c4 = 0; c4 < 4; ++c4) { float P = 1.f, S = 0.f, Pw = 1.f, Sw = 0.f;
#pragma unroll
            for (int kk = 0; kk < 4; ++kk) { const int k = dir == 0 ? kk : 3 - kk;
                const float pk = __shfl(Pq[c4], n + 16 * k), sk = __shfl(Sq[c4], n + 16 * k);
                const bool before = dir == 0 ? (k < q) : (k > q);
                if (before) { S = pk * S + sk; P *= pk; }
                Sw = pk * Sw + sk; Pw *= pk; }
            Pin[c4] = P; Sin[c4] = S;
            if (q == 0) SEG[wave * 64 + c4 * 16 + n] = (f32x2_t){Pw, Sw}; }
        __syncthreads();
        if (!PASS2) {
            if (tid < 64) { float P = 1.f, S = 0.f;
#pragma unroll
                for (int ww = 0; ww < 8; ++ww) { const int w = dir == 0 ? ww : 7 - ww; const f32x2_t s = SEG[w * 64 + tid]; S = s[0] * S + s[1]; P *= s[0]; }
                p.LSUM[((size_t)(b * LRU_NCH + cidx) * 2 + dir) * 512 + nb * 64 + tid] = (f32x2_t){P, S}; }
            __syncthreads();
        } else {
            if (tid < 64) {
                float S = 0.f;
                if (dir == 0) { for (int cc = 0; cc < cidx; ++cc) { const f32x2_t s = CS[(0 * LRU_NCH + cc) * 64 + tid]; S = s[0] * S + s[1]; } }
                else { for (int cc = 1; cc >= 0; --cc) { const f32x2_t s = CS[(1 * LRU_NCH + cc) * 64 + tid]; S = s[0] * S + s[1]; }
                       for (int cc = LRU_NCH - 1; cc > cidx; --cc) { const f32x2_t s = CS[(1 * LRU_NCH + cc) * 64 + tid]; S = s[0] * S + s[1]; } }
                CC[dir * 64 + tid] = S; }
            __syncthreads();
#pragma unroll
            for (int c4 = 0; c4 < 4; ++c4) { float h = CC[dir * 64 + c4 * 16 + n];
                for (int ww = 0; ww < 8; ++ww) { const int w = dir == 0 ? ww : 7 - ww; const bool before = dir == 0 ? (w < wave) : (w > wave);
                    if (before) { const f32x2_t s = SEG[w * 64 + c4 * 16 + n]; h = s[0] * h + s[1]; } }
                h = Pin[c4] * h + Sin[c4];
#pragma unroll
                for (int rr = 0; rr < 4; ++rr) { const int r = dir == 0 ? rr : 3 - rr; h = a[c4][r] * h + bt[c4][r]; hsum[c4][r] += h; } }
            __syncthreads();
        }
    }
    if (PASS2) {
#pragma unroll
        for (int c4 = 0; c4 < 4; ++c4)
#pragma unroll
            for (int r = 0; r < 4; ++r) { const size_t row = (size_t)(s0 + t0 + wave * 16 + 4 * q + r); const int ch = nb * 64 + c4 * 16 + n;
                const float gc = bf2f(p.P1[row * N1 + 512 + ch]); p.YMIX[row * DM + ch] = f2bf(hsum[c4][r] * silu_f(gc)); }
    }
}

DI void qkprep_row(int r, const bf16_t* P1, const float* qn, const float* kn, const float* ROPE, bf16_t* QP, bf16_t* KP, int lane) {
    const int b = row_batch(r); const bool lat = r < NLAT; const int t = r & 4095;
    float cs = 1.f, sn = 0.f;
    if (lat) { const f32x2_t cv = *(const f32x2_t*)(ROPE + ((size_t)t * 32 + (lane >> 1)) * 2); cs = cv[0]; sn = cv[1]; }
    const float wq = qn[lane], wk = kn[lane];
#pragma unroll 2
    for (int slot = lat ? 0 : 8; slot < 10; ++slot) {
        const int col0 = slot < 8 ? 1024 + slot * 64 : 1536 + (slot - 8) * 64;
        const float x = bf2f(P1[(size_t)r * N1 + col0 + lane]);
        const float ss = wave_sum(x * x);
        float y = x * rsqrtf(ss * (1.f / 64.f) + EPSN) * (slot < 8 ? wq : wk);
        if (lat) { const float pr = __shfl_xor(y, 1); y = (lane & 1) ? (pr * sn + y * cs) : (y * cs - pr * sn); }
        if (slot < 8) QP[((size_t)(b * 8 + slot) * SEQ + t) * 64 + lane] = f2bf(y * (0.125f * LOG2E));
        else KP[((size_t)(b * 2 + (slot - 8)) * POSN + row_pos(r)) * 64 + lane] = f2bf(y);
    }
}

struct Args { const float* in[32]; float* out; unsigned char* ws; int ph_lo, ph_hi, li, pad; };
DI void phase3(const Args& args, LAS unsigned char* lds, int tid, int wave, int lane, int G) {
    unsigned char* ws = args.ws; const bf16_t* PROJ = (const bf16_t*)(ws + WS_PROJ);
    const AttnP P{PROJ, PROJ, (const bf16_t*)(ws + WS_VT0), PROJ, (bf16_t*)(ws + WS_YMIX), args.in[20]};
    const int gw = blockIdx.x * NWAVES + wave, NGW = G * NWAVES;
    for (int u = gw; u < 4096 + 256; u += NGW) { if (u < 4096) attn_unit<0>(u, P, lane); else attn_unit<1>(u - 4096, P, lane); }
}
DI LruP make_lrup(const Args& args) { unsigned char* ws = args.ws;
    return LruP{(const bf16_t*)(ws + WS_PROJ), args.in[23], args.in[24], args.in[25], args.in[27], args.in[29], (const bf16_t*)(ws + WS_LRUWT), (f32x2_t*)(ws + WS_LSUM), (bf16_t*)(ws + WS_YMIX)}; }
DI void phase8(const Args& args, LAS unsigned char* lds, int tid, int wave, int lane, int G) {
    unsigned char* ws = args.ws; const LruP lp = make_lrup(args);
    for (int it = blockIdx.x; it < NB * LRU_NCH * 8; it += G) lru_item<false>(it, lp, lds, tid, wave, lane);
    const int gw = blockIdx.x * NWAVES + wave, NGW = G * NWAVES;
    for (int r = gw; r < MROWS; r += NGW) qkprep_row(r, (const bf16_t*)(ws + WS_PROJ), args.in[30], args.in[31], (const float*)(ws + WS_ROPE), (bf16_t*)(ws + WS_QP), (bf16_t*)(ws + WS_KP), lane);
}
DI void phase9(const Args& args, LAS unsigned char* lds, int tid, int wave, int lane, int G) {
    unsigned char* ws = args.ws; const bf16_t* PROJ = (const bf16_t*)(ws + WS_PROJ);
    const AttnP P{(const bf16_t*)(ws + WS_QP), (const bf16_t*)(ws + WS_KP), (const bf16_t*)(ws + WS_VT1), PROJ, (bf16_t*)(ws + WS_YMIX), nullptr};
    const LruP lp = make_lrup(args);
    for (int it = blockIdx.x; it < NB * 32 * 8; it += G) lru_item<true>(it, lp, lds, tid, wave, lane);
    const int gw = blockIdx.x * NWAVES + wave, NGW = G * NWAVES;
    for (int u = gw; u < 4096; u += NGW) attn_unit<2>(u, P, lane);
}

constexpr int RING_BYTES = 131072, LDSCTL_OFF = RING_BYTES, MISC_OFF = LDSCTL_OFF + 320, LDS_BYTES = 147456;
constexpr int CW_BAR = 4096;
constexpr int N_PHASES = 12;
constexpr bool kSP2 = true, kALIGN = true;

DI void p0_adaln(LAS unsigned char* lds, const float* c, const float* cctx, const float* ada_w, const float* ada_b, float* MOD, int tid, int wave, int lane, int G) {
    LAS float* sl = (LAS float*)lds;
    LAS float* red = (LAS float*)(lds + 5 * 1024 * 4);
    if ((int)blockIdx.x >= 192) return;
    for (int e = tid; e < 5 * 1024; e += NTHREADS) { const int r = e >> 10, k = e & 1023; const float x = r < 4 ? c[r * 1024 + k] : cctx[k]; sl[e] = silu_f(x); }
    __syncthreads();
    for (int item = blockIdx.x; item < 192; item += G) {
        const int i = item / 96, cb = item % 96, col = cb * 32 + (lane & 31), kh = lane >> 5;
        const float* W = ada_w + (size_t)i * 1024 * 3072 + col;
        float acc[5] = {0.f, 0.f, 0.f, 0.f, 0.f};
#pragma unroll 8
        for (int kk = 0; kk < 64; ++kk) { const int k = wave * 128 + 2 * kk + kh; const float w = W[(size_t)k * 3072];
#pragma unroll
            for (int r = 0; r < 5; ++r) acc[r] += sl[r * 1024 + k] * w; }
#pragma unroll
        for (int r = 0; r < 5; ++r) { acc[r] += __shfl_xor(acc[r], 32); if (lane < 32) red[(wave * 5 + r) * 32 + lane] = acc[r]; }
        __syncthreads();
        if (tid < 160) { const int r = tid >> 5, cl = tid & 31; float s = ada_b[i * 3072 + cb * 32 + cl];
#pragma unroll
            for (int w = 0; w < 8; ++w) s += red[(w * 5 + r) * 32 + cl];
            MOD[(i * 5 + r) * 3072 + cb * 32 + cl] = s; }
        __syncthreads();
    }
}
DI void p0_transpose_item(const float* W, int K, int N, bf16_t* WT, int row_off, LAS float* scr, int item, int lane) {
    const int nblk = N / 32, kb = item / nblk, nb = item % nblk, k0 = 64 * kb, n0 = 32 * nb;
#pragma unroll 8
    for (int i = 0; i < 32; ++i) { const int kk = 2 * i + (lane >> 5); scr[kk * 33 + (lane & 31)] = W[(size_t)(k0 + kk) * N + n0 + (lane & 31)]; }
    LDS_WAIT(); asm volatile("" ::: "memory");
    const int c = lane & 7;
#pragma unroll
    for (int j = 0; j < 4; ++j) { const int n = (lane >> 3) + 8 * j; const LAS float* s = scr + (8 * c) * 33 + n;
        v4u o; o.x = pk2(s[0 * 33], s[1 * 33]); o.y = pk2(s[2 * 33], s[3 * 33]); o.z = pk2(s[4 * 33], s[5 * 33]); o.w = pk2(s[6 * 33], s[7 * 33]);
        *(v4u*)(WT + (size_t)(row_off + n0 + n) * K + k0 + 8 * c) = o; }
    LDS_WAIT(); asm volatile("" ::: "memory");
}
struct TrJob { const float* W; int K, N; bf16_t* WT; int row_off; int items; };

DI void load_row16(const float* src, int lane, float (&v)[16]) {
#pragma unroll
    for (int j = 0; j < 4; ++j) { const f32x4_t t = *(const f32x4_t*)(src + j * 256 + lane * 4); v[4 * j] = t[0]; v[4 * j + 1] = t[1]; v[4 * j + 2] = t[2]; v[4 * j + 3] = t[3]; }
}
DI float row_rinv(const float (&v)[16]) {
    float ss = 0.f;
#pragma unroll
    for (int j = 0; j < 16; ++j) ss += v[j] * v[j];
    ss = wave_sum(ss);
    return rsqrtf(ss * (1.f / DM) + EPSN);
}
DI void store_modnorm(const float (&v)[16], float rinv, const float* g, const float* m, bf16_t* dst, int lane) {
#pragma unroll
    for (int j = 0; j < 4; ++j) { const int col = j * 256 + lane * 4;
        const f32x4_t gg = *(const f32x4_t*)(g + col), sc = *(const f32x4_t*)(m + 1024 + col), sh = *(const f32x4_t*)(m + col);
        float y[4];
#pragma unroll
        for (int e = 0; e < 4; ++e) y[e] = v[4 * j + e] * rinv * gg[e] * (1.f + sc[e]) + sh[e];
        v2u o; o.x = pk2(y[0], y[1]); o.y = pk2(y[2], y[3]); *(v2u*)(dst + col) = o; }
}

__global__ void __launch_bounds__(NTHREADS, 2) mega(Args args) {
    extern __shared__ __attribute__((aligned(16))) unsigned char lds_raw[];
    LAS unsigned char* lds = (LAS unsigned char*)lds_raw;
    volatile LAS unsigned* MISC = (volatile LAS unsigned*)(lds + MISC_OFF);
    const int tid = threadIdx.x, lane = tid & 63, wave = __builtin_amdgcn_readfirstlane(tid >> 6);
    const int G = gridDim.x;
    unsigned char* ws = args.ws;
    gu32* ctl = (gu32*)(ws + WS_CTL);
    for (int u = tid; u < (LDS_BYTES - LDSCTL_OFF) / 4; u += NTHREADS) ((LAS unsigned*)(lds + LDSCTL_OFF))[u] = 0u;
    __syncthreads();
    XcdBarrier bar = xcd_barrier_post((unsigned*)(ctl + CW_BAR) + args.li * XCD_BAR_WORDS, MISC + 8);
    const int lo = args.ph_lo, hi = args.ph_hi;
#define IN(k) (lo <= (k) && (k) < hi)
#define SEAM(k) do { if (IN(k) && IN((k) + 1)) xcd_barrier(bar); } while (0)

    const float* x = args.in[0]; const float* cvec = args.in[1]; const float* ctxin = args.in[2]; const float* cctx = args.in[3];
    const float* ada_w = args.in[4]; const float* ada_b = args.in[5]; const float* pre_g = args.in[6]; const float* post_g = args.in[7];
    float* out = args.out;
    float* MOD = (float*)(ws + WS_MOD);
    bf16_t* XN = (bf16_t*)(ws + WS_XN); bf16_t* YMIX = (bf16_t*)(ws + WS_YMIX); bf16_t* PROJ = (bf16_t*)(ws + WS_PROJ); float* OUTF = (float*)(ws + WS_PROJ);
    bf16_t* YPRE = (bf16_t*)(ws + WS_YPRE);
    const int gw = blockIdx.x * NWAVES + wave, NGW = G * NWAVES;

    if (IN(0)) {
        p0_adaln(lds, cvec, cctx, ada_w, ada_b, MOD, tid, wave, lane, G);
        __syncthreads();
        LAS float* scr = (LAS float*)(lds + 32768 + wave * 8704);
        const TrJob jobs[5] = {
            {args.in[8], 1024, 3072, (bf16_t*)(ws + WS_WIN0T), 0, 16 * 96}, {args.in[9], 1024, 1024, (bf16_t*)(ws + WS_WOUT0T), 0, 16 * 32},
            {args.in[21], 1024, 2304, (bf16_t*)(ws + WS_WIN1T), 0, 16 * 72}, {args.in[22], 1024, 1024, (bf16_t*)(ws + WS_WOUT1T), 0, 16 * 32},
            {args.in[18], 512, 512, (bf16_t*)(ws + WS_WGLUT), 0, 8 * 16}};
        constexpr int NBIG = 16 * 96 + 16 * 32 + 16 * 72 + 16 * 32 + 8 * 16, NLRU = 32 * 2;
        for (int it = gw; it < NBIG + NLRU; it += NGW) {
            if (it < NBIG) { int r = it;
#pragma unroll
                for (int j = 0; j < 5; ++j) { if (r >= 0 && r < jobs[j].items) p0_transpose_item(jobs[j].W, jobs[j].K, jobs[j].N, jobs[j].WT, 0, scr, r, lane); r -= jobs[j].items; }
            } else { const int q = it - NBIG, mat = q >> 1, sub = q & 1, dir = mat >> 4, gate = (mat >> 3) & 1, blk = mat & 7;
                const float* W = (gate ? args.in[28] : args.in[26]) + (size_t)(dir * 8 + blk) * 4096;
                p0_transpose_item(W, 64, 64, (bf16_t*)(ws + WS_LRUWT), blk * 256 + (dir * 2 + gate) * 64, scr, sub, lane); }
        }
    }
    if (IN(0)) {
        float* ROPE = (float*)(ws + WS_ROPE);
        for (int e = blockIdx.x * NTHREADS + tid; e < SEQ * 32; e += G * NTHREADS) { const int t = e >> 5, i = e & 31, f = i & 15; const float pos = (float)(i < 16 ? (t >> 6) : (t & 63));
            const float inv = (float)exp(-log(10000.0) * (double)(2 * f) / 32.0); const float ang = pos * inv; ROPE[2 * e] = cosf(ang); ROPE[2 * e + 1] = sinf(ang); }
    }
    SEAM(0);
    if (IN(1)) {
        for (int r = gw; r < MROWS; r += NGW) {
            const float* src = r < NLAT ? x + (size_t)r * DM : ctxin + (size_t)(r - NLAT) * DM;
            float v[16]; load_row16(src, lane, v);
            store_modnorm(v, row_rinv(v), pre_g, MOD + (r < NLAT ? (r >> 12) : 4) * 3072, XN + (size_t)r * DM, lane);
        }
    }
    SEAM(1);
    if (IN(2)) {
        pg8::Gemm g{XN, (const bf16_t*)(ws + WS_WIN0T), MROWS, N0, DM}; pg8::StaticOrder S; S.init(MROWS, N0, G, (int)blockIdx.x);
        pg8::EpiProj E{PROJ, N0, (bf16_t*)(ws + WS_VT0), 2048, 2560, 512};
        pg8::gemm_phase<pg8::EpiProj, pg8::StaticOrder, kALIGN, kSP2>(lds, g, S, E);
    }
    SEAM(2);
    if (IN(3)) { phase3(args, lds, tid, wave, lane, G); }
    SEAM(3);
    if (IN(4)) {
        pg8::Gemm g{YPRE, (const bf16_t*)(ws + WS_WGLUT), MROWS, 512, 512}; pg8::StaticOrder S; S.init(MROWS, 512, G, (int)blockIdx.x);
        pg8::EpiGlu E{YPRE, PROJ, args.in[19], YMIX};
        pg8::gemm_phase<pg8::EpiGlu, pg8::StaticOrder, kALIGN, kSP2>(lds, g, S, E);
    }
    SEAM(4);
    if (IN(5)) {
        pg8::Gemm g{YMIX, (const bf16_t*)(ws + WS_WOUT0T), MROWS, DM, DM}; pg8::StaticOrder S; S.init(MROWS, DM, G, (int)blockIdx.x);
        pg8::EpiF32 E{OUTF, DM};
        pg8::gemm_phase<pg8::EpiF32, pg8::StaticOrder, kALIGN, kSP2>(lds, g, S, E);
    }
    SEAM(5);
    if (IN(6)) {
        for (int r = gw; r < MROWS; r += NGW) {
            const int mrow = r < NLAT ? (r >> 12) : 4;
            const float* hin = r < NLAT ? x + (size_t)r * DM : ctxin + (size_t)(r - NLAT) * DM;
            float v[16], h[16]; load_row16(OUTF + (size_t)r * DM, lane, v); load_row16(hin, lane, h);
            const float rinv = row_rinv(v); const float* gt = MOD + mrow * 3072 + 2048;
#pragma unroll
            for (int j = 0; j < 4; ++j) { const int col = j * 256 + lane * 4; const f32x4_t pg = *(const f32x4_t*)(post_g + col), gg = *(const f32x4_t*)(gt + col);
#pragma unroll
                for (int e = 0; e < 4; ++e) h[4 * j + e] += gg[e] * (v[4 * j + e] * rinv * pg[e]);
                if (r < NLAT) *(f32x4_t*)(out + (size_t)r * DM + col) = (f32x4_t){h[4 * j], h[4 * j + 1], h[4 * j + 2], h[4 * j + 3]}; }
            store_modnorm(h, row_rinv(h), pre_g + DM, MOD + (5 + mrow) * 3072, XN + (size_t)r * DM, lane);
        }
    }
    SEAM(6);
    if (IN(7)) {
        pg8::Gemm g{XN, (const bf16_t*)(ws + WS_WIN1T), MROWS, N1, DM}; pg8::StaticOrder S; S.init(MROWS, N1, G, (int)blockIdx.x);
        pg8::EpiProj E{PROJ, N1, (bf16_t*)(ws + WS_VT1), 1664, 1792, 128};
        pg8::gemm_phase<pg8::EpiProj, pg8::StaticOrder, kALIGN, kSP2>(lds, g, S, E);
    }
    SEAM(7);
    if (IN(8)) { phase8(args, lds, tid, wave, lane, G); }
    SEAM(8);
    if (IN(9)) { phase9(args, lds, tid, wave, lane, G); }
    SEAM(9);
    if (IN(10)) {
        pg8::Gemm g{YMIX, (const bf16_t*)(ws + WS_WOUT1T), NLAT, DM, DM}; pg8::StaticOrder S; S.init(NLAT, DM, G, (int)blockIdx.x);
        pg8::EpiF32 E{OUTF, DM};
        pg8::gemm_phase<pg8::EpiF32, pg8::StaticOrder, kALIGN, kSP2>(lds, g, S, E);
    }
    SEAM(10);
    if (IN(11)) {
        for (int r = gw; r < NLAT; r += NGW) {
            float v[16], h[16]; load_row16(OUTF + (size_t)r * DM, lane, v); load_row16(out + (size_t)r * DM, lane, h);
            const float rinv = row_rinv(v); const float* gt = MOD + (5 + (r >> 12)) * 3072 + 2048;
#pragma unroll
            for (int j = 0; j < 4; ++j) { const int col = j * 256 + lane * 4; const f32x4_t pg = *(const f32x4_t*)(post_g + DM + col), gg = *(const f32x4_t*)(gt + col);
                f32x4_t o;
#pragma unroll
                for (int e = 0; e < 4; ++e) o[e] = h[4 * j + e] + gg[e] * (v[4 * j + e] * rinv * pg[e]);
                *(f32x4_t*)(out + (size_t)r * DM + col) = o; }
        }
    }
#undef IN
#undef SEAM
}
__global__ void k_adaln(const float* c, const float* cctx, const float* ada_w, const float* ada_b, float* mod) {
    const int idx = blockIdx.x * blockDim.x + threadIdx.x;
    if (idx >= 2 * 5 * 3072) return;
    const int col = idx % 3072, r = (idx / 3072) % 5, i = idx / (3072 * 5);
    const float* cv = r < 4 ? c + r * 1024 : cctx;
    const float* W = ada_w + (size_t)i * 1024 * 3072;
    float acc = 0.f;
    for (int k = 0; k < 1024; ++k) acc += silu_f(cv[k]) * W[(size_t)k * 3072 + col];
    mod[idx] = acc + ada_b[i * 3072 + col];
}

__global__ void k_prenorm(const float* lat, const float* ctx, const float* g, const float* mod  , bf16_t* XN) {
    const int r = blockIdx.x * 4 + (threadIdx.x >> 6), lane = threadIdx.x & 63;
    if (r >= MROWS) return;
    const float* src = r < NLAT ? lat + (size_t)r * DM : ctx + (size_t)(r - NLAT) * DM;
    const float* m = mod + (r < NLAT ? (r >> 12) : 4) * 3072;
    float v[16]; float ss = 0.f;
#pragma unroll
    for (int j = 0; j < 4; ++j) { const float4 t = *(const float4*)(src + j * 256 + lane * 4); v[4 * j] = t.x; v[4 * j + 1] = t.y; v[4 * j + 2] = t.z; v[4 * j + 3] = t.w; }
#pragma unroll
    for (int j = 0; j < 16; ++j) ss += v[j] * v[j];
    ss = wave_sum(ss);
    const float rinv = rsqrtf(ss * (1.f / DM) + EPSN);
#pragma unroll
    for (int j = 0; j < 4; ++j)
#pragma unroll
        for (int e = 0; e < 4; ++e) { const int col = j * 256 + lane * 4 + e; const float y = v[4 * j + e] * rinv * g[col] * (1.f + m[1024 + col]) + m[col]; XN[(size_t)r * DM + col] = f2bf(y); }
}

__global__ void k_postnorm(const float* hlat, const float* hctx, const float* OUT, const float* pg, const float* mod, float* olat, float* octx, int nrows) {
    const int r = blockIdx.x * 4 + (threadIdx.x >> 6), lane = threadIdx.x & 63;
    if (r >= nrows) return;
    const float* hin = r < NLAT ? hlat + (size_t)r * DM : hctx + (size_t)(r - NLAT) * DM;
    float* ho = r < NLAT ? olat + (size_t)r * DM : octx + (size_t)(r - NLAT) * DM;
    const float* m = mod + (r < NLAT ? (r >> 12) : 4) * 3072 + 2048;
    const float* src = OUT + (size_t)r * DM;
    float v[16]; float ss = 0.f;
#pragma unroll
    for (int j = 0; j < 4; ++j) { const float4 t = *(const float4*)(src + j * 256 + lane * 4); v[4 * j] = t.x; v[4 * j + 1] = t.y; v[4 * j + 2] = t.z; v[4 * j + 3] = t.w; }
#pragma unroll
    for (int j = 0; j < 16; ++j) ss += v[j] * v[j];
    ss = wave_sum(ss);
    const float rinv = rsqrtf(ss * (1.f / DM) + EPSN);
#pragma unroll
    for (int j = 0; j < 4; ++j)
#pragma unroll
        for (int e = 0; e < 4; ++e) { const int col = j * 256 + lane * 4 + e; ho[col] = hin[col] + m[col] * (v[4 * j + e] * rinv * pg[col]); }
}

enum { GM_PROJ0 = 0, GM_PROJ1 = 1, GM_GLU = 2, GM_F32 = 3 };
struct GemmEpi { bf16_t* P; bf16_t* VT; const bf16_t* YPRE; const bf16_t* PROJ; const float* bglu; bf16_t* YMIX; float* OUT; };
template <int MODE> __global__ void __launch_bounds__(256) k_gemm(const bf16_t* A, const float* W, int M, int N, int K, GemmEpi e) {
    const int tx = threadIdx.x & 15, ty = threadIdx.x >> 4;
    const int c0 = blockIdx.x * 64 + tx * 4, r0 = blockIdx.y * 64 + ty * 4;
    float acc[4][4] = {};
    for (int k = 0; k < K; ++k) {
        const float4 w = *(const float4*)(W + (size_t)k * N + c0);
        const float wv[4] = {rbf(w.x), rbf(w.y), rbf(w.z), rbf(w.w)};
#pragma unroll
        for (int i = 0; i < 4; ++i) { const float a = bf2f(A[(size_t)(r0 + i) * K + k]);
#pragma unroll
            for (int j = 0; j < 4; ++j) acc[i][j] += a * wv[j]; }
    }
#pragma unroll
    for (int i = 0; i < 4; ++i)
#pragma unroll
        for (int j = 0; j < 4; ++j) {
            const int r = r0 + i, c = c0 + j; const float v = acc[i][j];
            if (MODE == GM_PROJ0) { e.P[(size_t)r * N0 + c] = f2bf(v);
                if (c >= 2048 && c < 2560) { const int hd = c - 2048; e.VT[((size_t)(row_batch(r) * 8) * 64 + hd) * POSN + row_pos(r)] = f2bf(v); } }
            else if (MODE == GM_PROJ1) { e.P[(size_t)r * N1 + c] = f2bf(v);
                if (c >= 1664 && c < 1792) { const int hd = c - 1664; e.VT[((size_t)(row_batch(r) * 2) * 64 + hd) * POSN + row_pos(r)] = f2bf(v); } }
            else if (MODE == GM_GLU) { const float y = bf2f(e.YPRE[(size_t)r * 512 + c]); const float ga = bf2f(e.PROJ[(size_t)r * N0 + 512 + c]);
                e.YMIX[(size_t)r * DM + c] = f2bf(y * sigmoid_f(v + e.bglu[c]) * silu_f(ga)); }
            else e.OUT[(size_t)r * N + c] = v;
        }
}

__global__ void __launch_bounds__(64) k_s5_scan(const bf16_t* PROJ, const float* lam_re, const float* lam_im, const float* log_dt, const float* b_re, const float* b_im,
                                                 const float* c_re, const float* c_im, float* YS) {
    const int p = threadIdx.x, id = blockIdx.x, dir = id & 1, g = (id >> 1) & 31, b = id >> 6;
    const int gi = (dir * 32 + g);
    const double lre = lam_re[gi * 64 + p], lim = lam_im[gi * 64 + p], dt = exp((double)log_dt[gi]);
    const double mag = exp(lre * dt); const float ar = (float)(mag * cos(lim * dt)), ai = (float)(mag * sin(lim * dt));
    const double nr = mag * cos(lim * dt) - 1.0, ni = mag * sin(lim * dt), den = lre * lre + lim * lim;
    const float cfr = (float)((nr * lre + ni * lim) / den), cfi = (float)((ni * lre - nr * lim) / den);
    float bbr[16], bbi[16], cr[16], ci[16];
#pragma unroll
    for (int h = 0; h < 16; ++h) { const float br = b_re[(gi * 64 + p) * 16 + h], bi = b_im[(gi * 64 + p) * 16 + h]; bbr[h] = cfr * br - cfi * bi; bbi[h] = cfr * bi + cfi * br;
        cr[h] = c_re[(gi * 16 + h) * 64 + p]; ci[h] = c_im[(gi * 16 + h) * 64 + p]; }
    float hr = 0.f, hi = 0.f;
    float* ys = YS + (size_t)dir * MROWS * 512;
    for (int pos = 0; pos < POSN; ++pos) {
        int row;
        if (dir == 0) row = pos_row(b, pos); else row = pos < LC ? NLAT + b * LC + (LC - 1 - pos) : b * SEQ + (SEQ - 1 - (pos - LC));
        const bf16_t* up = PROJ + (size_t)row * N0 + g * 16;
        float bur = 0.f, bui = 0.f;
#pragma unroll
        for (int h = 0; h < 16; ++h) { const float u = bf2f(up[h]); bur += bbr[h] * u; bui += bbi[h] * u; }
        const float nhr = ar * hr - ai * hi + bur, nhi = ar * hi + ai * hr + bui; hr = nhr; hi = nhi;
        float mine = 0.f;
#pragma unroll
        for (int h = 0; h < 16; ++h) { const float y = wave_sum(cr[h] * hr - ci[h] * hi); if (p == h) mine = y; }
        if (p < 16) ys[(size_t)row * 512 + g * 16 + p] = mine;
    }
}
__global__ void k_s5_finish(const bf16_t* PROJ, const float* YS, const float* dsk, bf16_t* YPRE) {
    const size_t idx = (size_t)blockIdx.x * blockDim.x + threadIdx.x; if (idx >= (size_t)MROWS * 512) return;
    const int ch = idx & 511; const size_t r = idx >> 9;
    const float y = dsk[ch] * bf2f(PROJ[r * N0 + ch]) + YS[idx] + YS[(size_t)MROWS * 512 + idx];
    YPRE[idx] = f2bf(gelu_tanh(y));
}

__global__ void __launch_bounds__(256) k_na_attn(const bf16_t* PROJ, const float* relb, bf16_t* YMIX) {
    const int wv = blockIdx.x * 4 + (threadIdx.x >> 6), lane = threadIdx.x & 63;
    if (wv >= MROWS * 8) return;
    const int h = wv & 7, r = wv >> 3, b = row_batch(r);
    const float q = bf2f(PROJ[(size_t)r * N0 + 1024 + h * 64 + lane]);
    float m = -INFINITY, l = 0.f, o = 0.f;
    if (r < NLAT) {
        const int t = r & 4095, qr = t >> 6, qc = t & 63;
        const int rs = min(max(qr - 4, 0), 56), cs = min(max(qc - 8, 0), 48);
        for (int kr = rs; kr < rs + 8; ++kr)
            for (int kc = cs; kc < cs + 16; ++kc) {
                const size_t kro = (size_t)(b * SEQ + kr * 64 + kc) * N0;
                float s = wave_sum(q * bf2f(PROJ[kro + 1536 + h * 64 + lane])) * 0.125f + relb[(h * 15 + (kr - qr + 7)) * 31 + (kc - qc + 15)];
                const float mn = fmaxf(m, s), al = __expf(m - mn), pp = __expf(s - mn);
                l = l * al + pp; o = o * al + pp * bf2f(PROJ[kro + 2048 + h * 64 + lane]); m = mn;
            }
    }
    for (int c = 0; c < LC; ++c) {
        const size_t kro = (size_t)(NLAT + b * LC + c) * N0;
        const float s = wave_sum(q * bf2f(PROJ[kro + 1536 + h * 64 + lane])) * 0.125f;
        const float mn = fmaxf(m, s), al = __expf(m - mn), pp = __expf(s - mn);
        l = l * al + pp; o = o * al + pp * bf2f(PROJ[kro + 2048 + h * 64 + lane]); m = mn;
    }
    const float gb = bf2f(PROJ[(size_t)r * N0 + 2560 + h * 64 + lane]);
    YMIX[(size_t)r * DM + 512 + h * 64 + lane] = f2bf(o / l * silu_f(gb));
}

__global__ void __launch_bounds__(64) k_lru(const bf16_t* P1, const float* conv_w, const float* conv_b, const float* lam, const float* w_a, const float* b_a,
                                            const float* w_x, const float* b_x, float* HS, bf16_t* YMIX) {
    __shared__ float xs[64];
    const int j = threadIdx.x, nb = blockIdx.x & 7, b = blockIdx.x >> 3, ch = nb * 64 + j;
    const float cw0 = conv_w[0 * 512 + ch], cw1 = conv_w[1 * 512 + ch], cw2 = conv_w[2 * 512 + ch], cw3 = conv_w[3 * 512 + ch], cb = conv_b[ch];
    for (int dir = 0; dir < 2; ++dir) {
        float wa[64], wx[64];
#pragma unroll
        for (int i = 0; i < 64; ++i) { wa[i] = w_a[((dir * 8 + nb) * 64 + i) * 64 + j]; wx[i] = w_x[((dir * 8 + nb) * 64 + i) * 64 + j]; }
        const float ba = b_a[dir * 512 + ch], bx = b_x[dir * 512 + ch];
        const float lm = lam[dir * 512 + ch]; const float sp = (-lm > 20.f) ? -lm : log1pf(__expf(-lm));
        float hst = 0.f;
        for (int pos = 0; pos < POSN; ++pos) {
            int s0, sl, t;
            if (pos < LC) { s0 = NLAT + b * LC; sl = LC; t = dir == 0 ? pos : LC - 1 - pos; }
            else { s0 = b * SEQ; sl = SEQ; t = dir == 0 ? pos - LC : SEQ - 1 - (pos - LC); }
            float xm1 = 0.f, x0, xp1 = 0.f, xp2 = 0.f;
            x0 = bf2f(P1[(size_t)(s0 + t) * N1 + ch]);
            if (t - 1 >= 0) xm1 = bf2f(P1[(size_t)(s0 + t - 1) * N1 + ch]);
            if (t + 1 < sl) xp1 = bf2f(P1[(size_t)(s0 + t + 1) * N1 + ch]);
            if (t + 2 < sl) xp2 = bf2f(P1[(size_t)(s0 + t + 2) * N1 + ch]);
            const float xc = cw0 * xm1 + cw1 * x0 + cw2 * xp1 + cw3 * xp2 + cb;
            __syncthreads(); xs[j] = xc; __syncthreads();
            float ga = ba, gx = bx;
#pragma unroll
            for (int i = 0; i < 64; ++i) { const float xi = xs[i]; ga += xi * wa[i]; gx += xi * wx[i]; }
            const float gr = sigmoid_f(ga), gi = sigmoid_f(gx);
            const float log_a = -8.f * gr * sp; const float a = __expf(log_a); const float mult = sqrtf(fmaxf(-expm1f(2.f * log_a), 0.f));
            hst = a * hst + mult * gi * xc;
            if (pos >= LC) { const size_t rr = (size_t)(s0 + t);
                if (dir == 0) HS[rr * 512 + ch] = hst;
                else { const float gc = bf2f(P1[rr * N1 + 512 + ch]); YMIX[rr * DM + ch] = f2bf((HS[rr * 512 + ch] + hst) * silu_f(gc)); } }
        }
    }
}

__global__ void __launch_bounds__(256) k_qkprep(const bf16_t* P1, const float* qn, const float* kn, bf16_t* QP, bf16_t* KP) {
    const int wv = blockIdx.x * 4 + (threadIdx.x >> 6), lane = threadIdx.x & 63;
    if (wv >= MROWS * 10) return;
    const int slot = wv % 10, r = wv / 10, b = row_batch(r);
    if (slot < 8 && r >= NLAT) return;
    const int col0 = slot < 8 ? 1024 + slot * 64 : 1536 + (slot - 8) * 64;
    const float x = bf2f(P1[(size_t)r * N1 + col0 + lane]);
    const float ss = wave_sum(x * x);
    float y = x * rsqrtf(ss * (1.f / 64.f) + EPSN) * (slot < 8 ? qn[lane] : kn[lane]);
    if (r < NLAT) {
        const int t = r & 4095, i = lane >> 1, f = i & 15; const float pos = (float)(i < 16 ? (t >> 6) : (t & 63));
        const float inv = (float)exp(-log(10000.0) * (double)(2 * f) / 32.0);
        const float ang = pos * inv; const float cs = cosf(ang), sn = sinf(ang);
        const float pr = __shfl_xor(y, 1);
        y = (lane & 1) ? (pr * sn + y * cs) : (y * cs - pr * sn);
    }
    if (slot < 8) QP[((size_t)(b * 8 + slot) * SEQ + (r & 4095)) * 64 + lane] = f2bf(y * (0.125f * LOG2E));
    else KP[((size_t)(b * 2 + (slot - 8)) * POSN + row_pos(r)) * 64 + lane] = f2bf(y);
}

__global__ void __launch_bounds__(256) k_gqa(const bf16_t* QP, const bf16_t* KP, const bf16_t* P1, bf16_t* YMIX) {
    const int wv = blockIdx.x * 4 + (threadIdx.x >> 6), lane = threadIdx.x & 63;
    if (wv >= NLAT * 8) return;
    const int hq = wv & 7, r = wv >> 3, b = r >> 12, t = r & 4095, kvh = hq >> 2;
    const float q = bf2f(QP[((size_t)(b * 8 + hq) * SEQ + t) * 64 + lane]);
    const bf16_t* kp = KP + (size_t)(b * 2 + kvh) * POSN * 64;
    float m = -INFINITY, l = 0.f, o = 0.f;
    for (int pos = 0; pos < POSN; ++pos) {
        const float s = wave_sum(q * bf2f(kp[(size_t)pos * 64 + lane]));
        const float v = bf2f(P1[(size_t)pos_row(b, pos) * N1 + 1664 + kvh * 64 + lane]);
        const float mn = fmaxf(m, s), al = exp2f(m - mn), pp = exp2f(s - mn);
        l = l * al + pp; o = o * al + pp * v; m = mn;
    }
    const float gd = bf2f(P1[(size_t)r * N1 + 1792 + hq * 64 + lane]);
    YMIX[(size_t)r * DM + 512 + hq * 64 + lane] = f2bf(o / l * silu_f(gd));
}

static int g_grid = 0;
static void launch_mega(Args a, int lo, int hi, int li, hipStream_t stream) {
    a.ph_lo = lo; a.ph_hi = hi; a.li = li;
    hipLaunchKernelGGL(mega, dim3(g_grid), dim3(NTHREADS), LDS_BYTES, stream, a);
    const hipError_t le = hipPeekAtLastError();
    if (le != hipSuccess) fprintf(stderr, "kernel_launch: mega[%d,%d) failed: %s\n", lo, hi, hipGetErrorName(le));
}
extern "C" void kernel_launch(void* const* d_in, const int* in_sizes, int n_in, void* d_out, int out_size, void* d_ws, size_t ws_size, hipStream_t stream) {
    if (g_grid == 0) {
        int dev = 0, cus = 0;
        if (hipGetDevice(&dev) != hipSuccess || hipDeviceGetAttribute(&cus, hipDeviceAttributeMultiprocessorCount, dev) != hipSuccess) { fprintf(stderr, "kernel_launch: device query failed\n"); g_grid = -1; return; }
        if (hipFuncSetAttribute((const void*)mega, hipFuncAttributeMaxDynamicSharedMemorySize, LDS_BYTES) != hipSuccess) { fprintf(stderr, "kernel_launch: hipFuncSetAttribute failed\n"); g_grid = -1; return; }
        int per_cu = 0;
        if (hipOccupancyMaxActiveBlocksPerMultiprocessor(&per_cu, (const void*)mega, NTHREADS, LDS_BYTES) != hipSuccess || per_cu < 1) fprintf(stderr, "kernel_launch: occupancy query says %d blocks/CU\n", per_cu);
        (void)hipGetLastError();
        g_grid = cus;
    }
    if (g_grid < 0) return;
    const float* x = (const float*)d_in[0]; const float* c = (const float*)d_in[1]; const float* ctx = (const float*)d_in[2]; const float* cctx = (const float*)d_in[3];
    const float* ada_w = (const float*)d_in[4]; const float* ada_b = (const float*)d_in[5]; const float* pre_g = (const float*)d_in[6]; const float* post_g = (const float*)d_in[7];
    const float* ev_w_in = (const float*)d_in[8]; const float* ev_w_out = (const float*)d_in[9];
    const float* s5_lre = (const float*)d_in[10]; const float* s5_lim = (const float*)d_in[11]; const float* s5_ldt = (const float*)d_in[12];
    const float* s5_bre = (const float*)d_in[13]; const float* s5_bim = (const float*)d_in[14]; const float* s5_cre = (const float*)d_in[15]; const float* s5_cim = (const float*)d_in[16];
    const float* s5_d = (const float*)d_in[17]; const float* s5_wglu = (const float*)d_in[18]; const float* s5_bglu = (const float*)d_in[19]; const float* relb = (const float*)d_in[20];
    const float* od_w_in = (const float*)d_in[21]; const float* od_w_out = (const float*)d_in[22]; const float* conv_w = (const float*)d_in[23]; const float* conv_b = (const float*)d_in[24];
    const float* lru_lam = (const float*)d_in[25]; const float* w_a = (const float*)d_in[26]; const float* b_a = (const float*)d_in[27]; const float* w_x = (const float*)d_in[28]; const float* b_x = (const float*)d_in[29];
    const float* qn = (const float*)d_in[30]; const float* kn = (const float*)d_in[31];
    char* ws = (char*)d_ws; float* out = (float*)d_out;
    float* MOD = (float*)(ws + WS_MOD); float* HC1 = (float*)(ws + WS_HC1);
    bf16_t* XN = (bf16_t*)(ws + WS_XN); bf16_t* YMIX = (bf16_t*)(ws + WS_YMIX); bf16_t* PROJ = (bf16_t*)(ws + WS_PROJ); float* OUTF = (float*)(ws + WS_PROJ);
    bf16_t* VT0 = (bf16_t*)(ws + WS_VT0); bf16_t* YPRE = (bf16_t*)(ws + WS_YPRE); bf16_t* QP = (bf16_t*)(ws + WS_QP); bf16_t* KP = (bf16_t*)(ws + WS_KP); bf16_t* VT1 = (bf16_t*)(ws + WS_VT1);
    float* YS = (float*)(ws + WS_YS); float* HS = (float*)(ws + WS_HS);
    (void)x; (void)c; (void)ctx; (void)cctx; (void)ada_w; (void)ada_b; (void)pre_g; (void)post_g; (void)ev_w_in; (void)ev_w_out; (void)s5_wglu; (void)od_w_in; (void)od_w_out; (void)MOD; (void)HC1; (void)XN; (void)OUTF; (void)VT0; (void)VT1; (void)out;

    if (hipMemsetAsync(ws + WS_CTL, 0, CTL_ZERO_BYTES, stream) != hipSuccess) { fprintf(stderr, "kernel_launch: memset failed\n"); return; }
    Args a{};
    for (int i = 0; i < 32; ++i) a.in[i] = (const float*)d_in[i];
    a.out = (float*)d_out; a.ws = (unsigned char*)d_ws;

    launch_mega(a, 0, 3, 0, stream);
    k_s5_scan<<<NB * 32 * 2, 64, 0, stream>>>(PROJ, s5_lre, s5_lim, s5_ldt, s5_bre, s5_bim, s5_cre, s5_cim, YS);
    k_s5_finish<<<(MROWS * 512) / 256, 256, 0, stream>>>(PROJ, YS, s5_d, YPRE);
    launch_mega(a, 3, 12, 1, stream);
    (void)relb; (void)conv_w; (void)conv_b; (void)lru_lam; (void)w_a; (void)b_a; (void)w_x; (void)b_x; (void)HS; (void)qn; (void)kn; (void)QP; (void)KP;
}
```

```cpp
#include <hip/hip_runtime.h>
#include <cstdint>
#include <cstdio>

typedef unsigned short bf16_t;
#define DI __device__ __forceinline__
#define GAS __attribute__((address_space(1)))
#define LAS __attribute__((address_space(3)))
typedef unsigned v4u __attribute__((ext_vector_type(4)));
typedef unsigned v2u __attribute__((ext_vector_type(2)));
typedef float f32x4_t __attribute__((ext_vector_type(4)));
typedef float f32x16_t __attribute__((ext_vector_type(16)));
typedef short bf16x8_t __attribute__((ext_vector_type(8)));
typedef short s16x4_t __attribute__((ext_vector_type(4)));
typedef GAS unsigned gu32;
typedef GAS unsigned long long gu64;
#define RLX_AGENT __ATOMIC_RELAXED, __HIP_MEMORY_SCOPE_AGENT
#define LDS_WAIT() asm volatile("s_waitcnt lgkmcnt(0)" ::: "memory")
#define VM_WAIT() asm volatile("s_waitcnt vmcnt(0)" ::: "memory")

DI float bf2f(bf16_t v) { return __uint_as_float((unsigned)v << 16); }
DI bf16_t f2bf(float f) { unsigned u = __float_as_uint(f); return (bf16_t)((u + 0x7fffu + ((u >> 16) & 1u)) >> 16); }
DI unsigned pk2(float lo, float hi) { return (unsigned)f2bf(lo) | ((unsigned)f2bf(hi) << 16); }
DI float bflo(unsigned w) { return __uint_as_float(w << 16); }
DI float bfhi(unsigned w) { return __uint_as_float(w & 0xffff0000u); }
DI float rbf(float f) { return bf2f(f2bf(f)); }
DI float wave_sum(float v) {
#pragma unroll
    for (int o = 1; o < 64; o <<= 1) v += __shfl_xor(v, o);
    return v;
}
DI float silu_f(float x) { return x / (1.f + __expf(-x)); }
DI float sigmoid_f(float x) { return 1.f / (1.f + __expf(-x)); }
DI float gelu_tanh(float x) { const float u = 0.7978845608028654f * (x + 0.044715f * x * x * x); return 0.5f * x * (1.f + tanhf(u)); }
DI float gelu_fast(float x) { const float u = 1.5957691216057308f * (x + 0.044715f * x * x * x); return x / (1.f + __expf(-u)); }

constexpr int NWAVES = 8, NTHREADS = 512;
constexpr int DM = 1024, NB = 4, SEQ = 4096, LC = 256;
constexpr int NLAT = NB * SEQ, NCTX = NB * LC, MROWS = NLAT + NCTX;
constexpr int N0 = 3072, N1 = 2304, POSN = LC + SEQ;
constexpr float EPSN = 1e-6f;
constexpr float LOG2E = 1.4426950408889634f;

constexpr size_t MiB = 1u << 20;
constexpr size_t WS_CTL = 0, CTL_ZERO_BYTES = 1 * MiB;
constexpr size_t WS_MOD = 1 * MiB;
constexpr size_t WS_ROPE = 2 * MiB;
constexpr size_t WS_L16 = 3 * MiB;
constexpr size_t WS_WIN0T = 4 * MiB;
constexpr size_t WS_WOUT0T = 10 * MiB;
constexpr size_t WS_WIN1T = 12 * MiB;
constexpr size_t WS_WOUT1T = 17 * MiB;
constexpr size_t WS_WGLUT = 19 * MiB;
constexpr size_t WS_LRUWT = 19 * MiB + 512 * 1024;
constexpr size_t WS_W16 = 20 * MiB;
constexpr size_t WS_WC = 24 * MiB;
constexpr size_t WS_KT = 28 * MiB;
constexpr size_t WS_LSUM = 29 * MiB;
constexpr size_t WS_XN = 32 * MiB;
constexpr size_t WS_YMIX = 66 * MiB;
constexpr size_t WS_PROJ = 100 * MiB;
constexpr size_t WS_VT0 = 202 * MiB;
constexpr size_t WS_CARRY1 = 219 * MiB;
constexpr size_t WS_YPRE = 228 * MiB;
constexpr size_t WS_QP = 202 * MiB;
constexpr size_t WS_KP = 218 * MiB;
constexpr size_t WS_VT1 = 223 * MiB;
constexpr size_t WS_YS = 32 * MiB;
constexpr size_t WS_HS = 32 * MiB;
constexpr size_t WS_HC1 = 246 * MiB;

DI int row_batch(int r) { return r < NLAT ? (r >> 12) : ((r - NLAT) >> 8); }
DI int row_pos(int r) { return r < NLAT ? LC + (r & 4095) : ((r - NLAT) & 255); }
DI int pos_row(int b, int pos) { return pos < LC ? NLAT + b * LC + pos : b * SEQ + (pos - LC); }

namespace pg8 {
#define PG8_LAS __attribute__((address_space(3)))
typedef unsigned short bf16_t;
typedef short bf16x8 __attribute__((ext_vector_type(8)));
typedef float f32x4 __attribute__((ext_vector_type(4)));
typedef unsigned u32x4 __attribute__((ext_vector_type(4)));
constexpr int BM = 256, BK = 64, HALF = 128, HTB = HALF * BK * 2  , STAGE_BYTES = 8 * HTB, NXCD = 8, WGM = 8;

__host__ __device__ __forceinline__ int lds_byte(int r, int c) { const int st = (r >> 4) * 2 + (c >> 5), rr = r & 15, cc = c & 31, ob = rr * 64 + cc * 2; return st * 1024 + (ob ^ (((ob >> 9) & 1) << 5)); }
__host__ __device__ __forceinline__ void stage_rc(int b, int& R, int& C) { const int st = b / 1024, sb = b % 1024, swz = sb ^ (((sb >> 9) & 1) << 5); R = (st >> 1) * 16 + swz / 64; C = (st & 1) * 32 + (swz % 64) / 2; }
__host__ __device__ __forceinline__ int perm32(int rho) { const int n = rho >> 4, i = rho & 15; return 8 * (i >> 2) + 4 * n + (i & 3); }

struct Unit { int pm, pn; };
struct Gemm { const bf16_t* A; const bf16_t* Bt; int M, N, K; };

struct StaticOrder {
    int nM, nN, nwg, G, c;
    __host__ __device__ void init(int M, int N, int G_, int c_) { nM = M / BM; nN = N / BM; nwg = nM * nN; G = G_; c = c_; }
    __host__ __device__ bool next(int i, Unit& u) const {
        const long L = (long)i * G + c; if (L >= nwg) return false;
        int wgid = (int)L; { const int q = nwg / NXCD, r = nwg % NXCD, xcd = wgid % NXCD, off = wgid / NXCD; wgid = (xcd < r ? xcd * (q + 1) : r * (q + 1) + (xcd - r) * q) + off; }
        const int nig = WGM * nN, gid = wgid / nig, fm = gid * WGM, gsz = (nM - fm) < WGM ? (nM - fm) : WGM;
        u.pm = fm + ((wgid % nig) % gsz); u.pn = (wgid % nig) / gsz; return true;
    }
    __device__ __forceinline__ void a_ready(const Unit&) const {}
    __device__ __forceinline__ void done(const Unit&) const {}
};

__device__ __forceinline__ unsigned cvt_pk_bf16(float lo, float hi) { unsigned r; asm volatile("v_cvt_pk_bf16_f32 %0, %1, %2" : "=v"(r) : "v"(lo), "v"(hi)); return r; }

struct EpiProj {
    static constexpr bool PERM = true, AFTER_DRAIN = false;
    bf16_t* P; int ldc; bf16_t* VT; int vt_lo, vt_hi, vt_w;
    __device__ __forceinline__ void operator()(const f32x4 (&acc)[2][2][4][2], const Unit& u, int wr, int wc, int fr, int fq) const {
        const int row0 = u.pm * BM + wr * 64 + fr, colt = u.pn * BM + wc * 32 + 8 * fq;
#pragma unroll
        for (int ai = 0; ai < 2; ++ai)
#pragma unroll
            for (int m = 0; m < 4; ++m) { const int r = row0 + ai * HALF + m * 16; bf16_t* rowp = P + (size_t)r * ldc + colt;
#pragma unroll
                for (int bj = 0; bj < 2; ++bj) { const f32x4 v0 = acc[ai][bj][m][0], v1 = acc[ai][bj][m][1];
                    u32x4 w; w.x = cvt_pk_bf16(v0[0], v0[1]); w.y = cvt_pk_bf16(v0[2], v0[3]); w.z = cvt_pk_bf16(v1[0], v1[1]); w.w = cvt_pk_bf16(v1[2], v1[3]);
                    *(u32x4*)(rowp + bj * HALF) = w;
                    const int c0 = colt + bj * HALF;
                    if (c0 >= vt_lo && c0 < vt_hi) {
                        bf16_t* vp = VT + ((size_t)row_batch(r) * vt_w + (c0 - vt_lo)) * POSN + row_pos(r);
                        vp[0 * POSN] = (bf16_t)(w.x & 0xffffu); vp[1 * POSN] = (bf16_t)(w.x >> 16); vp[2 * POSN] = (bf16_t)(w.y & 0xffffu); vp[3 * POSN] = (bf16_t)(w.y >> 16);
                        vp[4 * POSN] = (bf16_t)(w.z & 0xffffu); vp[5 * POSN] = (bf16_t)(w.z >> 16); vp[6 * POSN] = (bf16_t)(w.w & 0xffffu); vp[7 * POSN] = (bf16_t)(w.w >> 16);
                    } } }
    }
};
struct EpiGlu {
    static constexpr bool PERM = true, AFTER_DRAIN = false;
    const bf16_t* YPRE; const bf16_t* PROJ; const float* bglu; bf16_t* YMIX;
    __device__ __forceinline__ void operator()(const f32x4 (&acc)[2][2][4][2], const Unit& u, int wr, int wc, int fr, int fq) const {
        const int row0 = u.pm * BM + wr * 64 + fr, colt = u.pn * BM + wc * 32 + 8 * fq;
#pragma unroll
        for (int bj = 0; bj < 2; ++bj) { const int c0 = colt + bj * HALF;
            const f32x4 b0 = *(const f32x4*)(bglu + c0), b1 = *(const f32x4*)(bglu + c0 + 4);
#pragma unroll
            for (int ai = 0; ai < 2; ++ai)
#pragma unroll
                for (int m = 0; m < 4; ++m) { const int r = row0 + ai * HALF + m * 16;
                    const u32x4 yv = *(const u32x4*)(YPRE + (size_t)r * 512 + c0), gv = *(const u32x4*)(PROJ + (size_t)r * N0 + 512 + c0);
                    const f32x4 a0 = acc[ai][bj][m][0] + b0, a1 = acc[ai][bj][m][1] + b1;
                    float o[8];
                    o[0] = bflo(yv.x) * sigmoid_f(a0[0]) * silu_f(bflo(gv.x)); o[1] = bfhi(yv.x) * sigmoid_f(a0[1]) * silu_f(bfhi(gv.x));
                    o[2] = bflo(yv.y) * sigmoid_f(a0[2]) * silu_f(bflo(gv.y)); o[3] = bfhi(yv.y) * sigmoid_f(a0[3]) * silu_f(bfhi(gv.y));
                    o[4] = bflo(yv.z) * sigmoid_f(a1[0]) * silu_f(bflo(gv.z)); o[5] = bfhi(yv.z) * sigmoid_f(a1[1]) * silu_f(bfhi(gv.z));
                    o[6] = bflo(yv.w) * sigmoid_f(a1[2]) * silu_f(bflo(gv.w)); o[7] = bfhi(yv.w) * sigmoid_f(a1[3]) * silu_f(bfhi(gv.w));
                    u32x4 w; w.x = cvt_pk_bf16(o[0], o[1]); w.y = cvt_pk_bf16(o[2], o[3]); w.z = cvt_pk_bf16(o[4], o[5]); w.w = cvt_pk_bf16(o[6], o[7]);
                    *(u32x4*)(YMIX + (size_t)r * DM + c0) = w; } }
    }
};
struct EpiF32 {
    static constexpr bool PERM = false, AFTER_DRAIN = false;
    float* O; int ldc;
    __device__ __forceinline__ void operator()(const f32x4 (&acc)[2][2][4][2], const Unit& u, int wr, int wc, int fr, int fq) const {
        const int row0 = u.pm * BM + wr * 64 + fr, col0 = u.pn * BM + wc * 32 + 4 * fq;
#pragma unroll
        for (int ai = 0; ai < 2; ++ai)
#pragma unroll
            for (int m = 0; m < 4; ++m) { float* rowp = O + (size_t)(row0 + ai * HALF + m * 16) * ldc + col0;
#pragma unroll
                for (int bj = 0; bj < 2; ++bj)
#pragma unroll
                    for (int n = 0; n < 2; ++n) *(f32x4*)(rowp + bj * HALF + n * 16) = acc[ai][bj][m][n]; }
    }
};
template <class Epi, class Sched, bool ALIGN_EPI = false, bool SP2 = false>
__device__ __forceinline__ void gemm_phase(PG8_LAS unsigned char* lds, const Gemm g, const Sched& S, const Epi& E) {
    const int tid = threadIdx.x, wid = __builtin_amdgcn_readfirstlane(tid >> 6), lane = tid & 63, wr = wid >> 2, wc = wid & 3, fr = lane & 15, fq = lane >> 4;
    const int K = g.K, nt = K / BK;
    unsigned voffA[2], voffB[2];
#pragma unroll
    for (int i = 0; i < 2; ++i) { int R, C; stage_rc(tid * 16 + i * 8192, R, C); const int Rb = Epi::PERM ? ((R & ~31) + perm32(R & 31)) : R;
        voffA[i] = (unsigned)(R * K + C) * 2u; voffB[i] = (unsigned)(Rb * K + C) * 2u; }
    const size_t kstep = (size_t)(BK * 2);
    const size_t hstep = (size_t)HALF * K * 2;
    const size_t tstep = 2 * hstep;
    const unsigned ldsw = (unsigned)wid * 1024u;
    const int aoff = lds_byte(wr * 64 + fr, fq * 8), boff = lds_byte(wc * 32 + fr, fq * 8);
#define PG8_SA(b, h) (((b) * 2 + (h)) * HTB)
#define PG8_SB(b, h) ((4 + (b) * 2 + (h)) * HTB)
#define PG8_STAGE(bufoff, gbase, voff) do { _Pragma("unroll") for (int _i = 0; _i < 2; ++_i) \
        __builtin_amdgcn_global_load_lds((const unsigned*)((const char*)(gbase) + (voff)[_i]), (PG8_LAS unsigned*)(lds + (bufoff) + ldsw + _i * 8192), 16, 0, 0); } while (0)
#define PG8_LDA(dst, b, h) do { _Pragma("unroll") for (int m = 0; m < 4; ++m) _Pragma("unroll") for (int k = 0; k < 2; ++k) dst[m][k] = *(const PG8_LAS bf16x8*)(lds + PG8_SA(b, h) + aoff + m * 2048 + k * 1024); } while (0)
#define PG8_LDB(dst, b, h) do { _Pragma("unroll") for (int n = 0; n < 2; ++n) _Pragma("unroll") for (int k = 0; k < 2; ++k) dst[n][k] = *(const PG8_LAS bf16x8*)(lds + PG8_SB(b, h) + boff + n * 2048 + k * 1024); } while (0)
#define PG8_MMA(ai, bj, At, Bt) do { __builtin_amdgcn_s_setprio(1); _Pragma("unroll") for (int m = 0; m < 4; ++m) _Pragma("unroll") for (int n = 0; n < 2; ++n) _Pragma("unroll") for (int k = 0; k < 2; ++k) \
        acc[ai][bj][m][n] = __builtin_amdgcn_mfma_f32_16x16x32_bf16(Bt[n][k], At[m][k], acc[ai][bj][m][n], 0, 0, 0); __builtin_amdgcn_s_setprio(0); } while (0)
#define PG8_WAIT_V(n) asm volatile("s_waitcnt vmcnt(" #n ")" ::: "memory")
#define PG8_WAIT_L(n) asm volatile("s_waitcnt lgkmcnt(" #n ")" ::: "memory")
#define PG8_BAR __builtin_amdgcn_s_barrier()
#define PG8_SCHED __builtin_amdgcn_sched_barrier(0)
    Unit cur, nxt; int ui = 0;
    if (!S.next(0, cur)) return;
    f32x4 acc[2][2][4][2];
#pragma unroll
    for (int a = 0; a < 2; ++a)
#pragma unroll
        for (int b = 0; b < 2; ++b)
#pragma unroll
            for (int m = 0; m < 4; ++m)
#pragma unroll
                for (int n = 0; n < 2; ++n) acc[a][b][m][n] = (f32x4){0.f, 0.f, 0.f, 0.f};
    bf16x8 At[4][2], B0[2][2], B1[2][2];
    const char* cA = (const char*)g.A + (size_t)cur.pm * tstep; const char* cB = (const char*)g.Bt + (size_t)cur.pn * tstep;
    S.a_ready(cur);
    if constexpr (SP2) {
        PG8_STAGE(PG8_SB(0, 0), cB, voffB); PG8_STAGE(PG8_SB(0, 1), cB + hstep, voffB); PG8_STAGE(PG8_SA(0, 0), cA, voffA); PG8_STAGE(PG8_SA(0, 1), cA + hstep, voffA);
        if (wr == 1) PG8_BAR;
        PG8_WAIT_V(2); PG8_BAR;
        PG8_STAGE(PG8_SB(1, 0), cB + kstep, voffB); PG8_STAGE(PG8_SA(1, 0), cA + kstep, voffA); PG8_STAGE(PG8_SB(1, 1), cB + hstep + kstep, voffB);
        PG8_WAIT_V(6); PG8_BAR;
    } else {
        PG8_STAGE(PG8_SB(0, 0), cB, voffB); PG8_STAGE(PG8_SA(0, 0), cA, voffA); PG8_STAGE(PG8_SB(0, 1), cB + hstep, voffB); PG8_STAGE(PG8_SA(0, 1), cA + hstep, voffA);
        if (wr == 1) PG8_BAR;
        PG8_WAIT_V(4); PG8_BAR;
        PG8_STAGE(PG8_SB(1, 0), cB + kstep, voffB); PG8_STAGE(PG8_SA(1, 0), cA + kstep, voffA); PG8_STAGE(PG8_SB(1, 1), cB + hstep + kstep, voffB);
        PG8_WAIT_V(6); PG8_BAR;
    }
    for (;;) {
        const bool has_next = S.next(ui + 1, nxt);
        const char* nA = has_next ? (const char*)g.A + (size_t)nxt.pm * tstep : cA; const char* nB = has_next ? (const char*)g.Bt + (size_t)nxt.pn * tstep : cB;
        for (int t = 0; t < nt; t += 2) {
            const bool last = (t == nt - 2);
            const char* a1 = cA + (size_t)(t + 1) * kstep;
            const char* a2 = last ? nA : cA + (size_t)(t + 2) * kstep; const char* b2 = last ? nB : cB + (size_t)(t + 2) * kstep;
            const char* a3 = a2 + kstep; const char* b3 = b2 + kstep;
            if (last && has_next) S.a_ready(nxt);
            if constexpr (SP2) {
            PG8_LDB(B0, 0, 0); PG8_LDB(B1, 0, 1); PG8_SCHED; PG8_LDA(At, 0, 0); PG8_STAGE(PG8_SA(1, 1), a1 + hstep, voffA);
            PG8_WAIT_V(8); PG8_WAIT_L(0); PG8_BAR; PG8_MMA(0, 0, At, B0); PG8_MMA(0, 1, At, B1); PG8_BAR; PG8_SCHED;
            PG8_LDA(At, 0, 1); PG8_STAGE(PG8_SB(0, 0), b2, voffB); PG8_STAGE(PG8_SB(0, 1), b2 + hstep, voffB); PG8_STAGE(PG8_SA(0, 0), a2, voffA);
            PG8_WAIT_V(8); PG8_WAIT_L(0); PG8_BAR; PG8_MMA(1, 0, At, B0); PG8_MMA(1, 1, At, B1); PG8_BAR; PG8_SCHED;
            PG8_LDB(B0, 1, 0); PG8_LDB(B1, 1, 1); PG8_SCHED; PG8_LDA(At, 1, 0); PG8_STAGE(PG8_SA(0, 1), a2 + hstep, voffA);
            PG8_WAIT_V(8); PG8_WAIT_L(0); PG8_BAR; PG8_MMA(0, 0, At, B0); PG8_MMA(0, 1, At, B1); PG8_BAR; PG8_SCHED;
            PG8_LDA(At, 1, 1); PG8_STAGE(PG8_SB(1, 0), b3, voffB); PG8_STAGE(PG8_SB(1, 1), b3 + hstep, voffB); PG8_STAGE(PG8_SA(1, 0), a3, voffA);
            PG8_WAIT_V(8); PG8_WAIT_L(0); PG8_BAR; PG8_MMA(1, 0, At, B0); PG8_MMA(1, 1, At, B1); PG8_BAR; PG8_SCHED;
            } else {
            PG8_LDB(B0, 0, 0); PG8_SCHED; PG8_LDA(At, 0, 0); PG8_STAGE(PG8_SA(1, 1), a1 + hstep, voffA);
            PG8_WAIT_L(8); PG8_BAR; PG8_WAIT_L(0); PG8_MMA(0, 0, At, B0); PG8_BAR; PG8_SCHED;
            PG8_LDB(B1, 0, 1); PG8_STAGE(PG8_SB(0, 0), b2, voffB);
            PG8_BAR; PG8_WAIT_L(0); PG8_MMA(0, 1, At, B1); PG8_BAR;
            PG8_LDA(At, 0, 1); PG8_STAGE(PG8_SA(0, 0), a2, voffA);
            PG8_BAR; PG8_WAIT_L(0); PG8_MMA(1, 0, At, B0); PG8_BAR; PG8_SCHED;
            PG8_STAGE(PG8_SB(0, 1), b2 + hstep, voffB);
            PG8_WAIT_V(6); PG8_BAR; PG8_MMA(1, 1, At, B1); PG8_BAR;
            PG8_LDB(B0, 1, 0); PG8_SCHED; PG8_LDA(At, 1, 0); PG8_STAGE(PG8_SA(0, 1), a2 + hstep, voffA);
            PG8_WAIT_L(8); PG8_BAR; PG8_WAIT_L(0); PG8_MMA(0, 0, At, B0); PG8_BAR; PG8_SCHED;
            PG8_LDB(B1, 1, 1); PG8_STAGE(PG8_SB(1, 0), b3, voffB);
            PG8_BAR; PG8_WAIT_L(0); PG8_MMA(0, 1, At, B1); PG8_BAR;
            PG8_LDA(At, 1, 1); PG8_STAGE(PG8_SA(1, 0), a3, voffA);
            PG8_BAR; PG8_WAIT_L(0); PG8_MMA(1, 0, At, B0); PG8_BAR; PG8_SCHED;
            PG8_STAGE(PG8_SB(1, 1), b3 + hstep, voffB);
            PG8_WAIT_V(6); PG8_BAR; PG8_MMA(1, 1, At, B1); PG8_BAR;
            }
        }
        if constexpr (ALIGN_EPI) { if (wr == 0) PG8_BAR; }
        if constexpr (!Epi::AFTER_DRAIN) { E(acc, cur, wr, wc, fr, fq); S.done(cur); }
        if (!has_next) break;
#pragma unroll
        for (int a = 0; a < 2; ++a)
#pragma unroll
            for (int b = 0; b < 2; ++b)
#pragma unroll
                for (int m = 0; m < 4; ++m)
#pragma unroll
                    for (int n = 0; n < 2; ++n) acc[a][b][m][n] = (f32x4){0.f, 0.f, 0.f, 0.f};
        cur = nxt; cA = nA; cB = nB; ++ui;
        if constexpr (ALIGN_EPI) { if (wr == 1) PG8_BAR; }
    }
    PG8_WAIT_V(0);
    if constexpr (!ALIGN_EPI) { if (wr == 0) PG8_BAR; }
    PG8_BAR;
    if constexpr (Epi::AFTER_DRAIN) { E.fused(acc, cur, wr, wc, fr, fq, lds, wid, lane); S.done(cur); }
#undef PG8_SA
#undef PG8_SB
#undef PG8_STAGE
#undef PG8_LDA
#undef PG8_LDB
#undef PG8_MMA
#undef PG8_WAIT_V
#undef PG8_WAIT_L
#undef PG8_BAR
#undef PG8_SCHED
}
}
#define XB_TMO      128
#define XB_XCNT(j)  (256  + 64 * (j))
#define XB_XSUB(j)  (1280 + 64 * (j))
#define XB_XGEN(j)  (2304 + 64 * (j))
#define XB_TOP      3328
#define XB_TOPGEN   3392
#define XCD_BAR_WORDS 3456
#define XB_SPIN_CAP (1u << 18)

__device__ __forceinline__ unsigned xb_ld(unsigned* p)              { return __hip_atomic_load(p, __ATOMIC_RELAXED, __HIP_MEMORY_SCOPE_AGENT); }
__device__ __forceinline__ unsigned xb_add(unsigned* p, unsigned v) { return __hip_atomic_fetch_add(p, v, __ATOMIC_RELAXED, __HIP_MEMORY_SCOPE_AGENT); }
__device__ __forceinline__ unsigned xb_xcc_id() { return (unsigned)__builtin_amdgcn_s_getreg((3 << 11) | 20) & 0xFu; }
#define XB_SPIN(cond, bar) do { unsigned _sp = 0; while (cond) { __builtin_amdgcn_s_sleep(1); \
    if ((++_sp & 255u) == 0u) { if (xb_ld(&(bar)[XB_TMO])) break; if (_sp > XB_SPIN_CAP) { atomicAdd(&(bar)[XB_TMO], 1u); break; } } } } while (0)

struct XcdBarrier {
    unsigned* bar; unsigned x;
    volatile LAS unsigned* st;
};

__device__ __forceinline__ XcdBarrier xcd_barrier_post(unsigned* bar, volatile LAS unsigned* st) {
    XcdBarrier b; b.bar = bar; b.x = xb_xcc_id(); b.st = st;
    if (threadIdx.x == 0) (void)xb_add(&bar[XB_XCNT(b.x)], 1u);
    return b;
}
__device__ __forceinline__ void xcd_barrier_complete(unsigned* bar, unsigned x, unsigned& nloc, unsigned& nx) {
    const unsigned G = gridDim.x * gridDim.y * gridDim.z;
    unsigned sum, cnt, mine, sp = 0u;
    for (;;) {
        sum = 0u; cnt = 0u; mine = 0u;
#pragma unroll
        for (unsigned j = 0; j < 16; ++j) { const unsigned c = xb_ld(&bar[XB_XCNT(j)]); sum += c; cnt += (c > 0u) ? 1u : 0u; mine = (j == x) ? c : mine; }
        if (sum == G) break;
        __builtin_amdgcn_s_sleep(1);
        if ((++sp & 255u) == 0u) { if (xb_ld(&bar[XB_TMO])) break; if (sp > XB_SPIN_CAP) { atomicAdd(&bar[XB_TMO], 1u); break; } }
    }
    nloc = mine > 0u ? mine : 1u; nx = cnt > 0u ? cnt : 1u;
}

__device__ __forceinline__ void xcd_barrier(const XcdBarrier& b) {
    asm volatile("s_waitcnt vmcnt(0)" ::: "memory");
    __syncthreads();
    if (threadIdx.x == 0) {
        unsigned* bar = b.bar;
        __builtin_amdgcn_s_waitcnt(0);
        unsigned nloc = b.st[0], nx = b.st[1];
        if (nloc == 0u) { xcd_barrier_complete(bar, b.x, nloc, nx); b.st[0] = nloc; b.st[1] = nx; }
        const unsigned old = xb_add(&bar[XB_XSUB(b.x)], 1u);
        const unsigned gen = old / nloc;
        if (old + 1u == (gen + 1u) * nloc) {
            __builtin_amdgcn_fence(__ATOMIC_RELEASE, "agent");
            asm volatile("s_waitcnt vmcnt(0)" ::: "memory");
            const unsigned og = xb_add(&bar[XB_TOP], 1u);
            const unsigned tg = og / nx;
            if (og + 1u == (tg + 1u) * nx) xb_add(&bar[XB_TOPGEN], 1u);
            else XB_SPIN(xb_ld(&bar[XB_TOPGEN]) == tg, bar);
            __builtin_amdgcn_fence(__ATOMIC_ACQUIRE, "agent");
            xb_add(&bar[XB_XGEN(b.x)], 1u);
            asm volatile("s_waitcnt vmcnt(0)" ::: "memory");
        } else {
            XB_SPIN(xb_ld(&bar[XB_XGEN(b.x)]) == gen, bar);
            __builtin_amdgcn_fence(__ATOMIC_ACQUIRE, "agent");
            asm volatile("s_waitcnt vmcnt(0)" ::: "memory");
        }
    }
    __syncthreads();
}

DI int crow16(int reg, int hf) { return (reg & 3) + 8 * (reg >> 2) + 4 * hf; }
DI unsigned cvtpk(float lo, float hi) { typedef float f2 __attribute__((ext_vector_type(2))); typedef __bf16 b2 __attribute__((ext_vector_type(2))); f2 v = {lo, hi}; b2 b = __builtin_convertvector(v, b2); return __builtin_bit_cast(unsigned, b); }
struct AttnP { const bf16_t* Q; const bf16_t* K; const bf16_t* VT; const bf16_t* Gt; bf16_t* Y; const float* relb; };

template <int MODE> DI void attn_unit(int unit, const AttnP& P, int lane) {
    const int ql = lane & 31, hf = lane >> 5;
    int b, h, kvh, qrow, NT, rp = 0, ci = 0, rs0 = 0, c0 = 0, qr = 0, qc = 0, rsq = 0, csq = 0;
    if (MODE == 0) { ci = unit & 3; rp = (unit >> 2) & 31; h = (unit >> 7) & 7; b = unit >> 10; kvh = h;
        qr = 2 * rp + (ql >> 4); qc = 16 * ci + (ql & 15); qrow = b * SEQ + qr * 64 + qc;
        rs0 = min(max(2 * rp - 4, 0), 56); const int rs1 = min(max(2 * rp - 3, 0), 56); NT = 8 + (rs1 + 8 - rs0);
        c0 = min(max(16 * ci - 8, 0), 32); rsq = min(max(qr - 4, 0), 56); csq = min(max(qc - 8, 0), 48);
    } else if (MODE == 1) { const int qt = unit & 7; h = (unit >> 3) & 7; b = unit >> 6; kvh = h; qrow = NLAT + b * LC + 32 * qt + ql; NT = 8; }
    else { const int qt = unit & 127; h = (unit >> 7) & 7; b = unit >> 10; kvh = h >> 2; qrow = b * SEQ + 32 * qt + ql; NT = POSN / 32; }
    const bf16_t* qp; const bf16_t* kb; size_t kpitch; const bf16_t* vt; const bf16_t* gp; bf16_t* yp;
    if (MODE == 2) { qp = P.Q + ((size_t)(b * 8 + h) * SEQ + (qrow - b * SEQ)) * 64; kb = P.K + (size_t)(b * 2 + kvh) * POSN * 64; kpitch = 64;
        vt = P.VT + (size_t)(b * 2 + kvh) * 64 * POSN; gp = P.Gt + (size_t)qrow * N1 + 1792 + h * 64; }
    else { qp = P.Q + (size_t)qrow * N0 + 1024 + h * 64; kb = P.K + 1536 + h * 64; kpitch = N0; vt = P.VT + (size_t)(b * 8 + h) * 64 * POSN; gp = P.Gt + (size_t)qrow * N0 + 2560 + h * 64; }
    yp = P.Y + (size_t)qrow * DM + 512 + h * 64;
    bf16x8_t qf[4];
#pragma unroll
    for (int ks = 0; ks < 4; ++ks) qf[ks] = *(const bf16x8_t*)(qp + 16 * ks + 8 * hf);
    const bf16_t* vt0 = vt + (size_t)ql * POSN + 4 * hf;
    f32x16_t o0 = {}, o1 = {};
    float m = -1e30f, l = 0.f;
    auto tile_krow = [&](int t) -> int { if (MODE == 2) return 32 * t + ql; if (t < 8) return NLAT + b * LC + 32 * t + ql; return b * SEQ + (rs0 + t - 8) * 64 + c0 + ql; };
    auto tile_pos0 = [&](int t) -> int { if (MODE == 2) return 32 * t; if (t < 8) return 32 * t; return LC + (rs0 + t - 8) * 64 + c0; };
    bf16x8_t kn[4];
    { const bf16_t* kp = kb + (size_t)tile_krow(0) * kpitch + 8 * hf;
#pragma unroll
      for (int ks = 0; ks < 4; ++ks) kn[ks] = *(const bf16x8_t*)(kp + 16 * ks); }
#pragma unroll 1
    for (int t = 0; t < NT; ++t) {
        bf16x8_t kf[4];
#pragma unroll
        for (int ks = 0; ks < 4; ++ks) kf[ks] = kn[ks];
        if (t + 1 < NT) { const bf16_t* kp = kb + (size_t)tile_krow(t + 1) * kpitch + 8 * hf;
#pragma unroll
            for (int ks = 0; ks < 4; ++ks) kn[ks] = *(const bf16x8_t*)(kp + 16 * ks); }
        const bf16_t* vp = vt0 + tile_pos0(t);
        s16x4_t va[2][2][2];
#pragma unroll
        for (int dt = 0; dt < 2; ++dt)
#pragma unroll
            for (int s = 0; s < 2; ++s) { va[dt][s][0] = *(const s16x4_t*)(vp + (size_t)dt * 32 * POSN + 16 * s); va[dt][s][1] = *(const s16x4_t*)(vp + (size_t)dt * 32 * POSN + 16 * s + 8); }
        f32x16_t sc = {};
#pragma unroll
        for (int ks = 0; ks < 4; ++ks) sc = __builtin_amdgcn_mfma_f32_32x32x16_bf16(kf[ks], qf[ks], sc, 0, 0, 0);
        float xs[16];
        if (MODE == 0 && t >= 8) {
            const int kr = rs0 + t - 8; const bool row_ok = (kr >= rsq) && (kr < rsq + 8);
            const float* rb = P.relb + (h * 15 + (kr - qr + 7)) * 31 + (15 - qc);
#pragma unroll
            for (int r = 0; r < 16; ++r) { const int kc = c0 + crow16(r, hf); const bool ok = row_ok && (kc >= csq) && (kc < csq + 16);
                const float bias = ok ? rb[kc] : 0.f; xs[r] = ok ? (sc[r] * 0.125f + bias) * LOG2E : -1e30f; }
        } else {
#pragma unroll
            for (int r = 0; r < 16; ++r) xs[r] = (MODE == 2) ? sc[r] : sc[r] * (0.125f * LOG2E);
        }
        float tm = xs[0];
#pragma unroll
        for (int r = 1; r < 16; ++r) tm = fmaxf(tm, xs[r]);
        tm = fmaxf(tm, __shfl_xor(tm, 32));
        const float mn = fmaxf(m, tm), al = __builtin_amdgcn_exp2f(m - mn);
        float ps = 0.f;
#pragma unroll
        for (int r = 0; r < 16; ++r) { xs[r] = __builtin_amdgcn_exp2f(xs[r] - mn); ps += xs[r]; }
        l = l * al + ps; m = mn;
#pragma unroll
        for (int r = 0; r < 16; ++r) { o0[r] *= al; o1[r] *= al; }
        bf16x8_t pf[2];
#pragma unroll
        for (int s = 0; s < 2; ++s) { v4u w; w.x = cvtpk(xs[8 * s], xs[8 * s + 1]); w.y = cvtpk(xs[8 * s + 2], xs[8 * s + 3]); w.z = cvtpk(xs[8 * s + 4], xs[8 * s + 5]); w.w = cvtpk(xs[8 * s + 6], xs[8 * s + 7]);
            pf[s] = __builtin_bit_cast(bf16x8_t, w); }
#pragma unroll
        for (int s = 0; s < 2; ++s) {
            const bf16x8_t a0 = __builtin_shufflevector(va[0][s][0], va[0][s][1], 0, 1, 2, 3, 4, 5, 6, 7);
            const bf16x8_t a1 = __builtin_shufflevector(va[1][s][0], va[1][s][1], 0, 1, 2, 3, 4, 5, 6, 7);
            o0 = __builtin_amdgcn_mfma_f32_32x32x16_bf16(a0, pf[s], o0, 0, 0, 0);
            o1 = __builtin_amdgcn_mfma_f32_32x32x16_bf16(a1, pf[s], o1, 0, 0, 0);
        }
    }
    l += __shfl_xor(l, 32);
    const float rl = 1.f / l;
#pragma unroll
    for (int dt = 0; dt < 2; ++dt)
#pragma unroll
        for (int rg = 0; rg < 4; ++rg) { const int d = 32 * dt + 8 * rg + 4 * hf;
            const v2u gv = *(const v2u*)(gp + d);
            const float g0 = silu_f(bflo(gv.x)), g1 = silu_f(bfhi(gv.x)), g2 = silu_f(bflo(gv.y)), g3 = silu_f(bfhi(gv.y));
            const f32x16_t& oo = dt ? o1 : o0;
            v2u w; w.x = pk2(oo[4 * rg] * rl * g0, oo[4 * rg + 1] * rl * g1); w.y = pk2(oo[4 * rg + 2] * rl * g2, oo[4 * rg + 3] * rl * g3);
            *(v2u*)(yp + d) = w; }
}

constexpr int LRU_NCH = 34;
typedef float f32x2_t __attribute__((ext_vector_type(2)));
struct LruP { const bf16_t* P1; const float* conv_w; const float* conv_b; const float* lam; const float* b_a; const float* b_x; const bf16_t* WT; f32x2_t* LSUM; bf16_t* YMIX; };

template <bool PASS2> DI void lru_item(int item, const LruP& p, LAS unsigned char* lds, int tid, int wave, int lane) {
    LAS bf16_t* XA = (LAS bf16_t*)lds;
    LAS float* XF = (LAS float*)(lds + 18432);
    LAS float* CW = (LAS float*)(lds + 18432 + 33280);
    LAS f32x2_t* SEG = (LAS f32x2_t*)(lds + 18432 + 33280 + 1280);
    LAS f32x2_t* CS = (LAS f32x2_t*)(lds + 18432 + 33280 + 1280 + 4096);
    LAS float* CC = (LAS float*)(lds + 18432 + 33280 + 1280 + 4096 + 34816);
    int nb, cidx, b;
    if (PASS2) { nb = item & 7; cidx = 2 + ((item >> 3) & 31); b = item >> 8; } else { nb = item & 7; cidx = (item >> 3) % LRU_NCH; b = (item >> 3) / LRU_NCH; }
    const int s0 = cidx < 2 ? NLAT + b * LC : b * SEQ, sl = cidx < 2 ? LC : SEQ, t0 = cidx < 2 ? cidx * 128 : (cidx - 2) * 128;
    const int n = lane & 15, q = lane >> 4;
    __syncthreads();
    if (tid < 320) CW[tid] = tid < 256 ? p.conv_w[(tid >> 6) * 512 + nb * 64 + (tid & 63)] : p.conv_b[nb * 64 + (tid & 63)];
    if (PASS2) { for (int e = tid; e < 2 * LRU_NCH * 64; e += NTHREADS) { const int ch = e & 63, cc = (e >> 6) % LRU_NCH, dir = (e >> 6) / LRU_NCH; CS[e] = p.LSUM[((size_t)(b * LRU_NCH + cc) * 2 + dir) * 512 + nb * 64 + ch]; } }
    __syncthreads();
    {
        const int tl = tid >> 2, cg = tid & 3;
        float xv[4][16];
#pragma unroll
        for (int j = 0; j < 4; ++j) { const int tt = t0 + tl + j - 1; const bool ok = tt >= 0 && tt < sl;
            v4u w0 = {0u, 0u, 0u, 0u}, w1 = {0u, 0u, 0u, 0u};
            if (ok) { const bf16_t* src = p.P1 + (size_t)(s0 + tt) * N1 + nb * 64 + cg * 16; w0 = *(const v4u*)src; w1 = *(const v4u*)(src + 8); }
            xv[j][0] = bflo(w0.x); xv[j][1] = bfhi(w0.x); xv[j][2] = bflo(w0.y); xv[j][3] = bfhi(w0.y); xv[j][4] = bflo(w0.z); xv[j][5] = bfhi(w0.z); xv[j][6] = bflo(w0.w); xv[j][7] = bfhi(w0.w);
            xv[j][8] = bflo(w1.x); xv[j][9] = bfhi(w1.x); xv[j][10] = bflo(w1.y); xv[j][11] = bfhi(w1.y); xv[j][12] = bflo(w1.z); xv[j][13] = bfhi(w1.z); xv[j][14] = bflo(w1.w); xv[j][15] = bfhi(w1.w); }
#pragma unroll
        for (int e = 0; e < 16; ++e) { const int c = cg * 16 + e;
            const float xc = CW[c] * xv[0][e] + CW[64 + c] * xv[1][e] + CW[128 + c] * xv[2][e] + CW[192 + c] * xv[3][e] + CW[256 + c];
            XF[tl * 65 + c] = xc; XA[tl * 72 + c] = f2bf(xc); }
    }
    __syncthreads();
    bf16x8_t af[2];
#pragma unroll
    for (int ks = 0; ks < 2; ++ks) af[ks] = *(const LAS bf16x8_t*)(XA + (wave * 16 + n) * 72 + 32 * ks + 8 * q);
    float hsum[4][4];
#pragma unroll
    for (int c4 = 0; c4 < 4; ++c4)
#pragma unroll
        for (int r = 0; r < 4; ++r) hsum[c4][r] = 0.f;
#pragma unroll 1
    for (int dir = 0; dir < 2; ++dir) {
        f32x4_t acc[8];
#pragma unroll
        for (int nt = 0; nt < 8; ++nt) { acc[nt] = (f32x4_t){0.f, 0.f, 0.f, 0.f};
            const bf16_t* wrow = p.WT + (size_t)(nb * 256 + (dir * 2 + (nt >> 2)) * 64 + (nt & 3) * 16 + n) * 64 + 8 * q;
#pragma unroll
            for (int ks = 0; ks < 2; ++ks) { const bf16x8_t bfr = *(const bf16x8_t*)(wrow + 32 * ks); acc[nt] = __builtin_amdgcn_mfma_f32_16x16x32_bf16(af[ks], bfr, acc[nt], 0, 0, 0); } }
        float a[4][4], bt[4][4];
#pragma unroll
        for (int c4 = 0; c4 < 4; ++c4) { const int ch = nb * 64 + c4 * 16 + n;
            const float ba = p.b_a[dir * 512 + ch], bx = p.b_x[dir * 512 + ch], lm = p.lam[dir * 512 + ch]; const float sp = log1pf(__expf(-lm));
#pragma unroll
            for (int r = 0; r < 4; ++r) { const float gr = sigmoid_f(acc[c4][r] + ba), gi = sigmoid_f(acc[c4 + 4][r] + bx);
                const float log_a = -8.f * gr * sp; a[c4][r] = __expf(log_a); const float mult = sqrtf(fmaxf(-expm1f(2.f * log_a), 0.f));
                bt[c4][r] = mult * gi * XF[(wave * 16 + 4 * q + r) * 65 + c4 * 16 + n]; } }
        float Pq[4], Sq[4];
#pragma unroll
        for (int c4 = 0; c4 < 4; ++c4) { float P = 1.f, S = 0.f;
#pragma unroll
            for (int rr = 0; rr < 4; ++rr) { const int r = dir == 0 ? rr : 3 - rr; S = a[c4][r] * S + bt[c4][r]; P *= a[c4][r]; }
            Pq[c4] = P; Sq[c4] = S; }
        float Pin[4], Sin[4];
#pragma unroll
        for (int c4 = 0; c4 < 4; ++c4) { float P = 1.f, S = 0.f, Pw = 1.f, Sw = 0.f;
#pragma unroll
            for (int kk = 0; kk < 4; ++kk) { const int k = dir == 0 ? kk : 3 - kk;
                const float pk = __shfl(Pq[c4], n + 16 * k), sk = __shfl(Sq[c4], n + 16 * k);
                const bool before = dir == 0 ? (k < q) : (k > q);
                if (before) { S = pk * S + sk; P *= pk; }
                Sw = pk * Sw + sk; Pw *= pk; }
            Pin[c4] = P; Sin[c4] = S;
            if (q == 0) SEG[wave * 64 + c4 * 16 + n] = (f32x2_t){Pw, Sw}; }
        __syncthreads();
        if (!PASS2) {
            if (tid < 64) { float P = 1.f, S = 0.f;
#pragma unroll
                for (int ww = 0; ww < 8; ++ww) { const int w = dir == 0 ? ww : 7 - ww; const f32x2_t s = SEG[w * 64 + tid]; S = s[0] * S + s[1]; P *= s[0]; }
                p.LSUM[((size_t)(b * LRU_NCH + cidx) * 2 + dir) * 512 + nb * 64 + tid] = (f32x2_t){P, S}; }
            __syncthreads();
        } else {
            if (tid < 64) {
                float S = 0.f;
                if (dir == 0) { for (int cc = 0; cc < cidx; ++cc) { const f32x2_t s = CS[(0 * LRU_NCH + cc) * 64 + tid]; S = s[0] * S + s[1]; } }
                else { for (int cc = 1; cc >= 0; --cc) { const f32x2_t s = CS[(1 * LRU_NCH + cc) * 64 + tid]; S = s[0] * S + s[1]; }
                       for (int cc = LRU_NCH - 1; cc > cidx; --cc) { const f32x2_t s = CS[(1 * LRU_NCH + cc) * 64 + tid]; S = s[0] * S + s[1]; } }
                CC[dir * 64 + tid] = S; }
            __syncthreads();
#pragma unroll
            for (int c4 = 0; c4 < 4; ++c4) { float h = CC[dir * 64 + c4 * 16 + n];
                for (int ww = 0; ww < 8; ++ww) { const int w = dir == 0 ? ww : 7 - ww; const bool before = dir == 0 ? (w < wave) : (w > wave);
                    if (before) { const f32x2_t s = SEG[w * 64 + c4 * 16 + n]; h = s[0] * h + s[1]; } }
                h = Pin[c4] * h + Sin[c4];
#pragma unroll
                for (int rr = 0; rr < 4; ++rr) { const int r = dir == 0 ? rr : 3 - rr; h = a[c4][r] * h + bt[c4][r]; hsum[c4][r] += h; } }
            __syncthreads();
        }
    }
    if (PASS2) {
#pragma unroll
        for (int c4 = 0; c4 < 4; ++c4)
#pragma unroll
            for (int r = 0; r < 4; ++r) { const size_t row = (size_t)(s0 + t0 + wave * 16 + 4 * q + r); const int ch = nb * 64 + c4 * 16 + n;
                const float gc = bf2f(p.P1[row * N1 + 512 + ch]); p.YMIX[row * DM + ch] = f2bf(hsum[c4][r] * silu_f(gc)); }
    }
}

DI void qkprep_row(int r, const bf16_t* P1, const float* qn, const float* kn, const float* ROPE, bf16_t* QP, bf16_t* KP, int lane) {
    const int b = row_batch(r); const bool lat = r < NLAT; const int t = r & 4095;
    float cs = 1.f, sn = 0.f;
    if (lat) { const f32x2_t cv = *(const f32x2_t*)(ROPE + ((size_t)t * 32 + (lane >> 1)) * 2); cs = cv[0]; sn = cv[1]; }
    const float wq = qn[lane], wk = kn[lane];
#pragma unroll 2
    for (int slot = lat ? 0 : 8; slot < 10; ++slot) {
        const int col0 = slot < 8 ? 1024 + slot * 64 : 1536 + (slot - 8) * 64;
        const float x = bf2f(P1[(size_t)r * N1 + col0 + lane]);
        const float ss = wave_sum(x * x);
        float y = x * rsqrtf(ss * (1.f / 64.f) + EPSN) * (slot < 8 ? wq : wk);
        if (lat) { const float pr = __shfl_xor(y, 1); y = (lane & 1) ? (pr * sn + y * cs) : (y * cs - pr * sn); }
        if (slot < 8) QP[((size_t)(b * 8 + slot) * SEQ + t) * 64 + lane] = f2bf(y * (0.125f * LOG2E));
        else KP[((size_t)(b * 2 + (slot - 8)) * POSN + row_pos(r)) * 64 + lane] = f2bf(y);
    }
}

constexpr size_t WS_CARRY0 = 246 * MiB;
constexpr int S5_NCOL = 272;

DI void s5_lambar_pow(double lre, double lim, double dt, int e, double& pr, double& pi) { const double mag = exp(lre * dt * e), ang = lim * dt * e; pr = mag * cos(ang); pi = mag * sin(ang); }
DI void s5_tables_unit(int e, const float* lam_re, const float* lam_im, const float* log_dt, const float* b_re, const float* b_im, const float* c_re, const float* c_im,
                       bf16_t* W16, bf16_t* WC, bf16_t* KT, float* L16) {
    if (e < 65536) {
        const int t = e & 15, p = (e >> 4) & 63, dir = (e >> 10) & 1, g = e >> 11, gi = dir * 32 + g;
        const double lre = lam_re[gi * 64 + p], lim = lam_im[gi * 64 + p], dt = exp((double)log_dt[gi]);
        double l1r, l1i; s5_lambar_pow(lre, lim, dt, 1, l1r, l1i);
        const double nr = l1r - 1.0, ni = l1i, den = lre * lre + lim * lim, cfr = (nr * lre + ni * lim) / den, cfi = (ni * lre - nr * lim) / den;
        double p1r, p1i, p2r, p2i; s5_lambar_pow(lre, lim, dt, dir == 0 ? 15 - t : t, p1r, p1i); s5_lambar_pow(lre, lim, dt, (dir == 0 ? t : 15 - t) + 1, p2r, p2i);
        const double zr = p1r * cfr - p1i * cfi, zi = p1r * cfi + p1i * cfr;
        bf16_t* w0 = W16 + ((size_t)(g * 2 + dir) * 128 + 2 * p) * 256 + t * 16;
#pragma unroll 4
        for (int h = 0; h < 16; ++h) { const double br = b_re[(gi * 64 + p) * 16 + h], bi = b_im[(gi * 64 + p) * 16 + h]; w0[h] = f2bf((float)(zr * br - zi * bi)); w0[256 + h] = f2bf((float)(zr * bi + zi * br)); }
        bf16_t* c0 = WC + ((size_t)(g * 2 + dir) * 256 + t * 16) * 128 + 2 * p;
#pragma unroll 4
        for (int h = 0; h < 16; ++h) { const double cr = c_re[(gi * 16 + h) * 64 + p], ci = c_im[(gi * 16 + h) * 64 + p];
            *(unsigned*)(c0 + (size_t)h * 128) = pk2((float)(cr * p2r - ci * p2i), (float)(-(cr * p2i + ci * p2r))); }
    } else if (e < 65536 + 16384) {
        const int q = e - 65536, ho = q & 15, tau = (q >> 4) & 15, dir = (q >> 8) & 1, g = q >> 9, gi = dir * 32 + g;
        const double dt = exp((double)log_dt[gi]);
        double acc[16];
#pragma unroll
        for (int h = 0; h < 16; ++h) acc[h] = 0.0;
        for (int p = 0; p < 64; ++p) {
            const double lre = lam_re[gi * 64 + p], lim = lam_im[gi * 64 + p];
            double l1r, l1i, pr, pi; s5_lambar_pow(lre, lim, dt, 1, l1r, l1i); s5_lambar_pow(lre, lim, dt, tau, pr, pi);
            const double nr = l1r - 1.0, ni = l1i, den = lre * lre + lim * lim, cfr = (nr * lre + ni * lim) / den, cfi = (ni * lre - nr * lim) / den;
            const double cr = c_re[(gi * 16 + ho) * 64 + p], ci = c_im[(gi * 16 + ho) * 64 + p];
            const double ar = cr * pr - ci * pi, ai = cr * pi + ci * pr;
            const double zr = ar * cfr - ai * cfi, zi = ar * cfi + ai * cfr;
#pragma unroll
            for (int h = 0; h < 16; ++h) acc[h] += zr * b_re[(gi * 64 + p) * 16 + h] - zi * b_im[(gi * 64 + p) * 16 + h];
        }
        bf16_t* kt = KT + ((size_t)((g * 2 + dir) * 16 + tau) * 16 + ho) * 16;
#pragma unroll
        for (int h = 0; h < 16; ++h) kt[h] = f2bf((float)acc[h]);
    } else {
        const int q = e - 65536 - 16384, p = q & 63, dir = (q >> 6) & 1, g = q >> 7, gi = dir * 32 + g;
        double pr, pi; s5_lambar_pow(lam_re[gi * 64 + p], lam_im[gi * 64 + p], exp((double)log_dt[gi]), 16, pr, pi);
        L16[((g * 2 + dir) * 64 + p) * 2] = (float)pr; L16[((g * 2 + dir) * 64 + p) * 2 + 1] = (float)pi;
    }
}
constexpr int S5_TABLE_UNITS = 65536 + 16384 + 4096;

DI int s5_tile_row0(int b, int s) { return s == 0 ? NLAT + b * LC : b * SEQ + (s - 1) * 256; }
DI void cmul(float ar, float ai, float br, float bi, float& cr, float& ci) { cr = ar * br - ai * bi; ci = ar * bi + ai * br; }

DI void s5_scan_unit(int unit, const bf16_t* PROJ, const bf16_t* W16, const float* L16, bf16_t* CARRY0, bf16_t* CARRY1, int lane) {
    const int wl = unit & 3, dir = (unit >> 2) & 1, b = (unit >> 3) & 3, g = unit >> 5;
    const int n = lane & 15, q = lane >> 4;
    bf16x8_t wf[2][8];
#pragma unroll
    for (int m2 = 0; m2 < 2; ++m2)
#pragma unroll
        for (int ks = 0; ks < 8; ++ks) wf[m2][ks] = *(const bf16x8_t*)(W16 + ((size_t)(g * 2 + dir) * 128 + (2 * wl + m2) * 16 + n) * 256 + 32 * ks + 8 * q);
    float Lr[2][2][5], Li[2][2][5];
    float Lnr[2][2], Lni[2][2];
    float cr[2][2], ci[2][2];
#pragma unroll
    for (int m2 = 0; m2 < 2; ++m2)
#pragma unroll
        for (int st = 0; st < 2; ++st) { const int p = 8 * (2 * wl + m2) + 2 * q + st;
            Lr[m2][st][0] = L16[((g * 2 + dir) * 64 + p) * 2]; Li[m2][st][0] = L16[((g * 2 + dir) * 64 + p) * 2 + 1];
#pragma unroll
            for (int k = 1; k < 5; ++k) cmul(Lr[m2][st][k - 1], Li[m2][st][k - 1], Lr[m2][st][k - 1], Li[m2][st][k - 1], Lr[m2][st][k], Li[m2][st][k]);
            float rr = 1.f, ri = 0.f;
#pragma unroll
            for (int k = 0; k < 5; ++k) if ((n + 1) & (1 << k)) { float tr, ti; cmul(rr, ri, Lr[m2][st][k], Li[m2][st][k], tr, ti); rr = tr; ri = ti; }
            Lnr[m2][st] = rr; Lni[m2][st] = ri; cr[m2][st] = 0.f; ci[m2][st] = 0.f; }
    bf16_t* CARRY = (dir == 0 ? CARRY0 : CARRY1) + (size_t)(b * 32 + g) * S5_NCOL * 128;
    const int jcol = dir == 0 ? n : 15 - n;
#pragma unroll 1
    for (int it = 0; it < 17; ++it) {
        const int s = it == 0 ? 0 : (dir == 0 ? it : 17 - it);
        const bf16_t* ub = PROJ + (size_t)(s5_tile_row0(b, s) + jcol * 16 + (q >> 1)) * N0 + g * 16 + 8 * (q & 1);
        bf16x8_t uf[8];
#pragma unroll
        for (int ks = 0; ks < 8; ++ks) uf[ks] = *(const bf16x8_t*)(ub + (size_t)(2 * ks) * N0);
        f32x4_t acc[2] = {{0.f, 0.f, 0.f, 0.f}, {0.f, 0.f, 0.f, 0.f}};
#pragma unroll
        for (int ks = 0; ks < 8; ++ks) { acc[0] = __builtin_amdgcn_mfma_f32_16x16x32_bf16(wf[0][ks], uf[ks], acc[0], 0, 0, 0); acc[1] = __builtin_amdgcn_mfma_f32_16x16x32_bf16(wf[1][ks], uf[ks], acc[1], 0, 0, 0); }
#pragma unroll
        for (int m2 = 0; m2 < 2; ++m2) {
            float hin[4];
#pragma unroll
            for (int st = 0; st < 2; ++st) {
                float xr = acc[m2][2 * st], xi = acc[m2][2 * st + 1];
#pragma unroll
                for (int k = 0; k < 4; ++k) { const int d = 1 << k; const float yr = __shfl_up(xr, d, 16), yi = __shfl_up(xi, d, 16);
                    if (n >= d) { float tr, ti; cmul(Lr[m2][st][k], Li[m2][st][k], yr, yi, tr, ti); xr += tr; xi += ti; } }
                float tr, ti; cmul(Lnr[m2][st], Lni[m2][st], cr[m2][st], ci[m2][st], tr, ti);
                const float Hr = xr + tr, Hi = xi + ti;
                const float pr = __shfl_up(Hr, 1, 16), pi = __shfl_up(Hi, 1, 16);
                hin[2 * st] = n == 0 ? cr[m2][st] : pr; hin[2 * st + 1] = n == 0 ? ci[m2][st] : pi;
                cr[m2][st] = __shfl(Hr, (lane & 48) | 15); ci[m2][st] = __shfl(Hi, (lane & 48) | 15);
            }
            v2u w; w.x = pk2(hin[0], hin[1]); w.y = pk2(hin[2], hin[3]);
            *(v2u*)(CARRY + (size_t)(s * 16 + jcol) * 128 + (2 * wl + m2) * 16 + 4 * q) = w;
        }
    }
}

DI void s5_out_item(int g, int b, int s, const bf16_t* PROJ, const bf16_t* WC, const bf16_t* CARRY0, const bf16_t* CARRY1, const float* dsk, bf16_t* YPRE, LAS unsigned char* lds, int wave, int lane) {
    const int n = lane & 15, q = lane >> 4;
    const int row0 = s5_tile_row0(b, s);
    const bf16_t* ub = PROJ + (size_t)(row0 + n * 16 + (q >> 1)) * N0 + g * 16 + 8 * (q & 1);
    bf16x8_t uf[8];
#pragma unroll
    for (int ks = 0; ks < 8; ++ks) uf[ks] = *(const bf16x8_t*)(ub + (size_t)(2 * ks) * N0);
    bf16x8_t cf[2][4];
#pragma unroll
    for (int dir = 0; dir < 2; ++dir)
#pragma unroll
        for (int ks = 0; ks < 4; ++ks) cf[dir][ks] = *(const bf16x8_t*)((dir == 0 ? CARRY0 : CARRY1) + ((size_t)(b * 32 + g) * S5_NCOL + s * 16 + n) * 128 + 32 * ks + 8 * q);
    const LAS bf16_t* KTl = (const LAS bf16_t*)lds;
#pragma unroll
    for (int m2 = 0; m2 < 2; ++m2) {
        const int mt = 2 * wave + m2;
        f32x4_t acc = {0.f, 0.f, 0.f, 0.f};
#pragma unroll
        for (int dir = 0; dir < 2; ++dir) {
            const bf16_t* wc = WC + ((size_t)(g * 2 + dir) * 256 + mt * 16 + n) * 128 + 8 * q;
#pragma unroll
            for (int ks = 0; ks < 4; ++ks) { const bf16x8_t a = *(const bf16x8_t*)(wc + 32 * ks); acc = __builtin_amdgcn_mfma_f32_16x16x32_bf16(a, cf[dir][ks], acc, 0, 0, 0); }
#pragma unroll
            for (int ks = 0; ks < 8; ++ks) {
                const bool need = dir == 0 ? (2 * ks <= mt) : (2 * ks + 1 >= mt);
                if (need) { const int tp = 2 * ks + (q >> 1), tau = dir == 0 ? mt - tp : tp - mt;
                    bf16x8_t a = {0, 0, 0, 0, 0, 0, 0, 0};
                    if (tau >= 0) a = *(const LAS bf16x8_t*)(KTl + ((dir * 16 + tau) * 16 + n) * 16 + 8 * (q & 1));
                    acc = __builtin_amdgcn_mfma_f32_16x16x32_bf16(a, uf[ks], acc, 0, 0, 0); }
            }
        }
        const size_t tok = (size_t)(row0 + n * 16 + mt);
        const v2u uu = *(const v2u*)(PROJ + tok * N0 + g * 16 + 4 * q);
        const f32x4_t dd = *(const f32x4_t*)(dsk + g * 16 + 4 * q);
        const float y0 = gelu_fast(acc[0] + dd[0] * bflo(uu.x)), y1 = gelu_fast(acc[1] + dd[1] * bfhi(uu.x)), y2 = gelu_fast(acc[2] + dd[2] * bflo(uu.y)), y3 = gelu_fast(acc[3] + dd[3] * bfhi(uu.y));
        v2u w; w.x = pk2(y0, y1); w.y = pk2(y2, y3);
        *(v2u*)(YPRE + tok * 512 + g * 16 + 4 * q) = w;
    }
}

struct Args { const float* in[32]; float* out; unsigned char* ws; int ph_lo, ph_hi, li, pad; };
constexpr int CW_NAQ = 2048;
constexpr int NA_UNITS = 4096 + 256;
DI void na_queue(const Args& args, gu32* ctl, int lane) {
    unsigned char* ws = args.ws; const bf16_t* PROJ = (const bf16_t*)(ws + WS_PROJ);
    const AttnP P{PROJ, PROJ, (const bf16_t*)(ws + WS_VT0), PROJ, (bf16_t*)(ws + WS_YMIX), args.in[20]};
    for (;;) {
        unsigned u = 0; if (lane == 0) u = __hip_atomic_fetch_add(ctl + CW_NAQ, 1u, RLX_AGENT);
        u = (unsigned)__builtin_amdgcn_readfirstlane((int)u);
        if (u >= (unsigned)NA_UNITS) break;
        if (u < 4096u) attn_unit<0>((int)u, P, lane); else attn_unit<1>((int)u - 4096, P, lane);
    }
}
DI void phase3(const Args& args, LAS unsigned char* lds, int tid, int wave, int lane, int G) {
    unsigned char* ws = args.ws; gu32* ctl = (gu32*)(ws + WS_CTL);
    if (wave < 4) for (int cu = blockIdx.x; cu < 256; cu += G)
        s5_scan_unit(cu * 4 + wave, (const bf16_t*)(ws + WS_PROJ), (const bf16_t*)(ws + WS_W16), (const float*)(ws + WS_L16), (bf16_t*)(ws + WS_CARRY0), (bf16_t*)(ws + WS_CARRY1), lane);
    na_queue(args, ctl, lane);
}
DI void phase4(const Args& args, LAS unsigned char* lds, int tid, int wave, int lane, int G) {
    unsigned char* ws = args.ws; gu32* ctl = (gu32*)(ws + WS_CTL);
    constexpr int NIT = 32 * 4 * 17;
    const int i0 = (int)(((long)blockIdx.x * NIT) / G), i1 = (int)(((long)(blockIdx.x + 1) * NIT) / G);
    int gcur = -1;
    for (int it = i0; it < i1; ++it) {
        const int g = it / 68, b = (it % 68) / 17, s = it % 17;
        if (g != gcur) { __syncthreads(); for (int e = tid; e < 1024; e += NTHREADS) ((LAS v4u*)lds)[e] = ((const v4u*)(ws + WS_KT))[(size_t)g * 1024 + e]; gcur = g; __syncthreads(); }
        s5_out_item(g, b, s, (const bf16_t*)(ws + WS_PROJ), (const bf16_t*)(ws + WS_WC), (const bf16_t*)(ws + WS_CARRY0), (const bf16_t*)(ws + WS_CARRY1), args.in[17], (bf16_t*)(ws + WS_YPRE), lds, wave, lane);
    }
    na_queue(args, ctl, lane);
}
DI LruP make_lrup(const Args& args) { unsigned char* ws = args.ws;
    return LruP{(const bf16_t*)(ws + WS_PROJ), args.in[23], args.in[24], args.in[25], args.in[27], args.in[29], (const bf16_t*)(ws + WS_LRUWT), (f32x2_t*)(ws + WS_LSUM), (bf16_t*)(ws + WS_YMIX)}; }
DI void phase9(const Args& args, LAS unsigned char* lds, int tid, int wave, int lane, int G) {
    unsigned char* ws = args.ws; const LruP lp = make_lrup(args);
    for (int it = blockIdx.x; it < NB * LRU_NCH * 8; it += G) lru_item<false>(it, lp, lds, tid, wave, lane);
    const int gw = blockIdx.x * NWAVES + wave, NGW = G * NWAVES;
    for (int r = gw; r < MROWS; r += NGW) qkprep_row(r, (const bf16_t*)(ws + WS_PROJ), args.in[30], args.in[31], (const float*)(ws + WS_ROPE), (bf16_t*)(ws + WS_QP), (bf16_t*)(ws + WS_KP), lane);
}
DI void phase10(const Args& args, LAS unsigned char* lds, int tid, int wave, int lane, int G) {
    unsigned char* ws = args.ws; const bf16_t* PROJ = (const bf16_t*)(ws + WS_PROJ);
    const AttnP P{(const bf16_t*)(ws + WS_QP), (const bf16_t*)(ws + WS_KP), (const bf16_t*)(ws + WS_VT1), PROJ, (bf16_t*)(ws + WS_YMIX), nullptr};
    const LruP lp = make_lrup(args);
    for (int it = blockIdx.x; it < NB * 32 * 8; it += G) lru_item<true>(it, lp, lds, tid, wave, lane);
    const int gw = blockIdx.x * NWAVES + wave, NGW = G * NWAVES;
    for (int u = gw; u < 4096; u += NGW) attn_unit<2>(u, P, lane);
}

constexpr int RING_BYTES = 131072, LDSCTL_OFF = RING_BYTES, MISC_OFF = LDSCTL_OFF + 320, LDS_BYTES = 147456;
constexpr int CW_BAR = 4096;
constexpr int N_PHASES = 13;
constexpr bool kSP2 = true, kALIGN = true;

DI void p0_adaln(LAS unsigned char* lds, const float* c, const float* cctx, const float* ada_w, const float* ada_b, float* MOD, int tid, int wave, int lane, int G) {
    LAS float* sl = (LAS float*)lds;
    LAS float* red = (LAS float*)(lds + 5 * 1024 * 4);
    if ((int)blockIdx.x >= 192) return;
    for (int e = tid; e < 5 * 1024; e += NTHREADS) { const int r = e >> 10, k = e & 1023; const float x = r < 4 ? c[r * 1024 + k] : cctx[k]; sl[e] = silu_f(x); }
    __syncthreads();
    for (int item = blockIdx.x; item < 192; item += G) {
        const int i = item / 96, cb = item % 96, col = cb * 32 + (lane & 31), kh = lane >> 5;
        const float* W = ada_w + (size_t)i * 1024 * 3072 + col;
        float acc[5] = {0.f, 0.f, 0.f, 0.f, 0.f};
#pragma unroll 8
        for (int kk = 0; kk < 64; ++kk) { const int k = wave * 128 + 2 * kk + kh; const float w = W[(size_t)k * 3072];
#pragma unroll
            for (int r = 0; r < 5; ++r) acc[r] += sl[r * 1024 + k] * w; }
#pragma unroll
        for (int r = 0; r < 5; ++r) { acc[r] += __shfl_xor(acc[r], 32); if (lane < 32) red[(wave * 5 + r) * 32 + lane] = acc[r]; }
        __syncthreads();
        if (tid < 160) { const int r = tid >> 5, cl = tid & 31; float s = ada_b[i * 3072 + cb * 32 + cl];
#pragma unroll
            for (int w = 0; w < 8; ++w) s += red[(w * 5 + r) * 32 + cl];
            MOD[(i * 5 + r) * 3072 + cb * 32 + cl] = s; }
        __syncthreads();
    }
}
DI void p0_transpose_item(const float* W, int K, int N, bf16_t* WT, int row_off, LAS float* scr, int item, int lane) {
    const int nblk = N / 32, kb = item / nblk, nb = item % nblk, k0 = 64 * kb, n0 = 32 * nb;
#pragma unroll 8
    for (int i = 0; i < 32; ++i) { const int kk = 2 * i + (lane >> 5); scr[kk * 33 + (lane & 31)] = W[(size_t)(k0 + kk) * N + n0 + (lane & 31)]; }
    LDS_WAIT(); asm volatile("" ::: "memory");
    const int c = lane & 7;
#pragma unroll
    for (int j = 0; j < 4; ++j) { const int n = (lane >> 3) + 8 * j; const LAS float* s = scr + (8 * c) * 33 + n;
        v4u o; o.x = pk2(s[0 * 33], s[1 * 33]); o.y = pk2(s[2 * 33], s[3 * 33]); o.z = pk2(s[4 * 33], s[5 * 33]); o.w = pk2(s[6 * 33], s[7 * 33]);
        *(v4u*)(WT + (size_t)(row_off + n0 + n) * K + k0 + 8 * c) = o; }
    LDS_WAIT(); asm volatile("" ::: "memory");
}
struct TrJob { const float* W; int K, N; bf16_t* WT; int row_off; int items; };

DI void load_row16(const float* src, int lane, float (&v)[16]) {
#pragma unroll
    for (int j = 0; j < 4; ++j) { const f32x4_t t = *(const f32x4_t*)(src + j * 256 + lane * 4); v[4 * j] = t[0]; v[4 * j + 1] = t[1]; v[4 * j + 2] = t[2]; v[4 * j + 3] = t[3]; }
}
DI float row_rinv(const float (&v)[16]) {
    float ss = 0.f;
#pragma unroll
    for (int j = 0; j < 16; ++j) ss += v[j] * v[j];
    ss = wave_sum(ss);
    return rsqrtf(ss * (1.f / DM) + EPSN);
}
DI void store_modnorm(const float (&v)[16], float rinv, const float* g, const float* m, bf16_t* dst, int lane) {
#pragma unroll
    for (int j = 0; j < 4; ++j) { const int col = j * 256 + lane * 4;
        const f32x4_t gg = *(const f32x4_t*)(g + col), sc = *(const f32x4_t*)(m + 1024 + col), sh = *(const f32x4_t*)(m + col);
        float y[4];
#pragma unroll
        for (int e = 0; e < 4; ++e) y[e] = v[4 * j + e] * rinv * gg[e] * (1.f + sc[e]) + sh[e];
        v2u o; o.x = pk2(y[0], y[1]); o.y = pk2(y[2], y[3]); *(v2u*)(dst + col) = o; }
}

__global__ void __launch_bounds__(NTHREADS, 2) mega(Args args) {
    extern __shared__ __attribute__((aligned(16))) unsigned char lds_raw[];
    LAS unsigned char* lds = (LAS unsigned char*)lds_raw;
    volatile LAS unsigned* MISC = (volatile LAS unsigned*)(lds + MISC_OFF);
    const int tid = threadIdx.x, lane = tid & 63, wave = __builtin_amdgcn_readfirstlane(tid >> 6);
    const int G = gridDim.x;
    unsigned char* ws = args.ws;
    gu32* ctl = (gu32*)(ws + WS_CTL);
    for (int u = tid; u < (LDS_BYTES - LDSCTL_OFF) / 4; u += NTHREADS) ((LAS unsigned*)(lds + LDSCTL_OFF))[u] = 0u;
    __syncthreads();
    XcdBarrier bar = xcd_barrier_post((unsigned*)(ctl + CW_BAR) + args.li * XCD_BAR_WORDS, MISC + 8);
    const int lo = args.ph_lo, hi = args.ph_hi;
#define IN(k) (lo <= (k) && (k) < hi)
#define SEAM(k) do { if (IN(k) && IN((k) + 1)) xcd_barrier(bar); } while (0)

    const float* x = args.in[0]; const float* cvec = args.in[1]; const float* ctxin = args.in[2]; const float* cctx = args.in[3];
    const float* ada_w = args.in[4]; const float* ada_b = args.in[5]; const float* pre_g = args.in[6]; const float* post_g = args.in[7];
    float* out = args.out;
    float* MOD = (float*)(ws + WS_MOD);
    bf16_t* XN = (bf16_t*)(ws + WS_XN); bf16_t* YMIX = (bf16_t*)(ws + WS_YMIX); bf16_t* PROJ = (bf16_t*)(ws + WS_PROJ); float* OUTF = (float*)(ws + WS_PROJ);
    bf16_t* YPRE = (bf16_t*)(ws + WS_YPRE);
    const int gw = blockIdx.x * NWAVES + wave, NGW = G * NWAVES;

    if (IN(0)) {
        p0_adaln(lds, cvec, cctx, ada_w, ada_b, MOD, tid, wave, lane, G);
        __syncthreads();
        LAS float* scr = (LAS float*)(lds + 32768 + wave * 8704);
        const TrJob jobs[5] = {
            {args.in[8], 1024, 3072, (bf16_t*)(ws + WS_WIN0T), 0, 16 * 96}, {args.in[9], 1024, 1024, (bf16_t*)(ws + WS_WOUT0T), 0, 16 * 32},
            {args.in[21], 1024, 2304, (bf16_t*)(ws + WS_WIN1T), 0, 16 * 72}, {args.in[22], 1024, 1024, (bf16_t*)(ws + WS_WOUT1T), 0, 16 * 32},
            {args.in[18], 512, 512, (bf16_t*)(ws + WS_WGLUT), 0, 8 * 16}};
        constexpr int NBIG = 16 * 96 + 16 * 32 + 16 * 72 + 16 * 32 + 8 * 16, NLRU = 32 * 2;
        for (int it = gw; it < NBIG + NLRU; it += NGW) {
            if (it < NBIG) { int r = it;
#pragma unroll
                for (int j = 0; j < 5; ++j) { if (r >= 0 && r < jobs[j].items) p0_transpose_item(jobs[j].W, jobs[j].K, jobs[j].N, jobs[j].WT, 0, scr, r, lane); r -= jobs[j].items; }
            } else { const int q = it - NBIG, mat = q >> 1, sub = q & 1, dir = mat >> 4, gate = (mat >> 3) & 1, blk = mat & 7;
                const float* W = (gate ? args.in[28] : args.in[26]) + (size_t)(dir * 8 + blk) * 4096;
                p0_transpose_item(W, 64, 64, (bf16_t*)(ws + WS_LRUWT), blk * 256 + (dir * 2 + gate) * 64, scr, sub, lane); }
        }
    }
    if (IN(0)) {
        float* ROPE = (float*)(ws + WS_ROPE);
        for (int e = blockIdx.x * NTHREADS + tid; e < SEQ * 32; e += G * NTHREADS) { const int t = e >> 5, i = e & 31, f = i & 15; const float pos = (float)(i < 16 ? (t >> 6) : (t & 63));
            const float inv = (float)exp(-log(10000.0) * (double)(2 * f) / 32.0); const float ang = pos * inv; ROPE[2 * e] = cosf(ang); ROPE[2 * e + 1] = sinf(ang); }
    }
    if (IN(0)) {
        for (int e = blockIdx.x * NTHREADS + tid; e < S5_TABLE_UNITS; e += G * NTHREADS)
            s5_tables_unit(e, args.in[10], args.in[11], args.in[12], args.in[13], args.in[14], args.in[15], args.in[16], (bf16_t*)(ws + WS_W16), (bf16_t*)(ws + WS_WC), (bf16_t*)(ws + WS_KT), (float*)(ws + WS_L16));
    }
    SEAM(0);
    if (IN(1)) {
        for (int r = gw; r < MROWS; r += NGW) {
            const float* src = r < NLAT ? x + (size_t)r * DM : ctxin + (size_t)(r - NLAT) * DM;
            float v[16]; load_row16(src, lane, v);
            store_modnorm(v, row_rinv(v), pre_g, MOD + (r < NLAT ? (r >> 12) : 4) * 3072, XN + (size_t)r * DM, lane);
        }
    }
    SEAM(1);
    if (IN(2)) {
        pg8::Gemm g{XN, (const bf16_t*)(ws + WS_WIN0T), MROWS, N0, DM}; pg8::StaticOrder S; S.init(MROWS, N0, G, (int)blockIdx.x);
        pg8::EpiProj E{PROJ, N0, (bf16_t*)(ws + WS_VT0), 2048, 2560, 512};
        pg8::gemm_phase<pg8::EpiProj, pg8::StaticOrder, kALIGN, kSP2>(lds, g, S, E);
    }
    SEAM(2);
    if (IN(3)) { phase3(args, lds, tid, wave, lane, G); }
    SEAM(3);
    if (IN(4)) { phase4(args, lds, tid, wave, lane, G); }
    SEAM(4);
    if (IN(5)) {
        pg8::Gemm g{YPRE, (const bf16_t*)(ws + WS_WGLUT), MROWS, 512, 512}; pg8::StaticOrder S; S.init(MROWS, 512, G, (int)blockIdx.x);
        pg8::EpiGlu E{YPRE, PROJ, args.in[19], YMIX};
        pg8::gemm_phase<pg8::EpiGlu, pg8::StaticOrder, kALIGN, kSP2>(lds, g, S, E);
    }
    SEAM(5);
    if (IN(6)) {
        pg8::Gemm g{YMIX, (const bf16_t*)(ws + WS_WOUT0T), MROWS, DM, DM}; pg8::StaticOrder S; S.init(MROWS, DM, G, (int)blockIdx.x);
        pg8::EpiF32 E{OUTF, DM};
        pg8::gemm_phase<pg8::EpiF32, pg8::StaticOrder, kALIGN, kSP2>(lds, g, S, E);
    }
    SEAM(6);
    if (IN(7)) {
        for (int r = gw; r < MROWS; r += NGW) {
            const int mrow = r < NLAT ? (r >> 12) : 4;
            const float* hin = r < NLAT ? x + (size_t)r * DM : ctxin + (size_t)(r - NLAT) * DM;
            float v[16], h[16]; load_row16(OUTF + (size_t)r * DM, lane, v); load_row16(hin, lane, h);
            const float rinv = row_rinv(v); const float* gt = MOD + mrow * 3072 + 2048;
#pragma unroll
            for (int j = 0; j < 4; ++j) { const int col = j * 256 + lane * 4; const f32x4_t pg = *(const f32x4_t*)(post_g + col), gg = *(const f32x4_t*)(gt + col);
#pragma unroll
                for (int e = 0; e < 4; ++e) h[4 * j + e] += gg[e] * (v[4 * j + e] * rinv * pg[e]);
                if (r < NLAT) *(f32x4_t*)(out + (size_t)r * DM + col) = (f32x4_t){h[4 * j], h[4 * j + 1], h[4 * j + 2], h[4 * j + 3]}; }
            store_modnorm(h, row_rinv(h), pre_g + DM, MOD + (5 + mrow) * 3072, XN + (size_t)r * DM, lane);
        }
    }
    SEAM(7);
    if (IN(8)) {
        pg8::Gemm g{XN, (const bf16_t*)(ws + WS_WIN1T), MROWS, N1, DM}; pg8::StaticOrder S; S.init(MROWS, N1, G, (int)blockIdx.x);
        pg8::EpiProj E{PROJ, N1, (bf16_t*)(ws + WS_VT1), 1664, 1792, 128};
        pg8::gemm_phase<pg8::EpiProj, pg8::StaticOrder, kALIGN, kSP2>(lds, g, S, E);
    }
    SEAM(8);
    if (IN(9)) { phase9(args, lds, tid, wave, lane, G); }
    SEAM(9);
    if (IN(10)) { phase10(args, lds, tid, wave, lane, G); }
    SEAM(10);
    if (IN(11)) {
        pg8::Gemm g{YMIX, (const bf16_t*)(ws + WS_WOUT1T), NLAT, DM, DM}; pg8::StaticOrder S; S.init(NLAT, DM, G, (int)blockIdx.x);
        pg8::EpiF32 E{OUTF, DM};
        pg8::gemm_phase<pg8::EpiF32, pg8::StaticOrder, kALIGN, kSP2>(lds, g, S, E);
    }
    SEAM(11);
    if (IN(12)) {
        for (int r = gw; r < NLAT; r += NGW) {
            float v[16], h[16]; load_row16(OUTF + (size_t)r * DM, lane, v); load_row16(out + (size_t)r * DM, lane, h);
            const float rinv = row_rinv(v); const float* gt = MOD + (5 + (r >> 12)) * 3072 + 2048;
#pragma unroll
            for (int j = 0; j < 4; ++j) { const int col = j * 256 + lane * 4; const f32x4_t pg = *(const f32x4_t*)(post_g + DM + col), gg = *(const f32x4_t*)(gt + col);
                f32x4_t o;
#pragma unroll
                for (int e = 0; e < 4; ++e) o[e] = h[4 * j + e] + gg[e] * (v[4 * j + e] * rinv * pg[e]);
                *(f32x4_t*)(out + (size_t)r * DM + col) = o; }
        }
    }
#undef IN
#undef SEAM
}
__global__ void k_adaln(const float* c, const float* cctx, const float* ada_w, const float* ada_b, float* mod) {
    const int idx = blockIdx.x * blockDim.x + threadIdx.x;
    if (idx >= 2 * 5 * 3072) return;
    const int col = idx % 3072, r = (idx / 3072) % 5, i = idx / (3072 * 5);
    const float* cv = r < 4 ? c + r * 1024 : cctx;
    const float* W = ada_w + (size_t)i * 1024 * 3072;
    float acc = 0.f;
    for (int k = 0; k < 1024; ++k) acc += silu_f(cv[k]) * W[(size_t)k * 3072 + col];
    mod[idx] = acc + ada_b[i * 3072 + col];
}

__global__ void k_prenorm(const float* lat, const float* ctx, const float* g, const float* mod  , bf16_t* XN) {
    const int r = blockIdx.x * 4 + (threadIdx.x >> 6), lane = threadIdx.x & 63;
    if (r >= MROWS) return;
    const float* src = r < NLAT ? lat + (size_t)r * DM : ctx + (size_t)(r - NLAT) * DM;
    const float* m = mod + (r < NLAT ? (r >> 12) : 4) * 3072;
    float v[16]; float ss = 0.f;
#pragma unroll
    for (int j = 0; j < 4; ++j) { const float4 t = *(const float4*)(src + j * 256 + lane * 4); v[4 * j] = t.x; v[4 * j + 1] = t.y; v[4 * j + 2] = t.z; v[4 * j + 3] = t.w; }
#pragma unroll
    for (int j = 0; j < 16; ++j) ss += v[j] * v[j];
    ss = wave_sum(ss);
    const float rinv = rsqrtf(ss * (1.f / DM) + EPSN);
#pragma unroll
    for (int j = 0; j < 4; ++j)
#pragma unroll
        for (int e = 0; e < 4; ++e) { const int col = j * 256 + lane * 4 + e; const float y = v[4 * j + e] * rinv * g[col] * (1.f + m[1024 + col]) + m[col]; XN[(size_t)r * DM + col] = f2bf(y); }
}

__global__ void k_postnorm(const float* hlat, const float* hctx, const float* OUT, const float* pg, const float* mod, float* olat, float* octx, int nrows) {
    const int r = blockIdx.x * 4 + (threadIdx.x >> 6), lane = threadIdx.x & 63;
    if (r >= nrows) return;
    const float* hin = r < NLAT ? hlat + (size_t)r * DM : hctx + (size_t)(r - NLAT) * DM;
    float* ho = r < NLAT ? olat + (size_t)r * DM : octx + (size_t)(r - NLAT) * DM;
    const float* m = mod + (r < NLAT ? (r >> 12) : 4) * 3072 + 2048;
    const float* src = OUT + (size_t)r * DM;
    float v[16]; float ss = 0.f;
#pragma unroll
    for (int j = 0; j < 4; ++j) { const float4 t = *(const float4*)(src + j * 256 + lane * 4); v[4 * j] = t.x; v[4 * j + 1] = t.y; v[4 * j + 2] = t.z; v[4 * j + 3] = t.w; }
#pragma unroll
    for (int j = 0; j < 16; ++j) ss += v[j] * v[j];
    ss = wave_sum(ss);
    const float rinv = rsqrtf(ss * (1.f / DM) + EPSN);
#pragma unroll
    for (int j = 0; j < 4; ++j)
#pragma unroll
        for (int e = 0; e < 4; ++e) { const int col = j * 256 + lane * 4 + e; ho[col] = hin[col] + m[col] * (v[4 * j + e] * rinv * pg[col]); }
}

enum { GM_PROJ0 = 0, GM_PROJ1 = 1, GM_GLU = 2, GM_F32 = 3 };
struct GemmEpi { bf16_t* P; bf16_t* VT; const bf16_t* YPRE; const bf16_t* PROJ; const float* bglu; bf16_t* YMIX; float* OUT; };
template <int MODE> __global__ void __launch_bounds__(256) k_gemm(const bf16_t* A, const float* W, int M, int N, int K, GemmEpi e) {
    const int tx = threadIdx.x & 15, ty = threadIdx.x >> 4;
    const int c0 = blockIdx.x * 64 + tx * 4, r0 = blockIdx.y * 64 + ty * 4;
    float acc[4][4] = {};
    for (int k = 0; k < K; ++k) {
        const float4 w = *(const float4*)(W + (size_t)k * N + c0);
        const float wv[4] = {rbf(w.x), rbf(w.y), rbf(w.z), rbf(w.w)};
#pragma unroll
        for (int i = 0; i < 4; ++i) { const float a = bf2f(A[(size_t)(r0 + i) * K + k]);
#pragma unroll
            for (int j = 0; j < 4; ++j) acc[i][j] += a * wv[j]; }
    }
#pragma unroll
    for (int i = 0; i < 4; ++i)
#pragma unroll
        for (int j = 0; j < 4; ++j) {
            const int r = r0 + i, c = c0 + j; const float v = acc[i][j];
            if (MODE == GM_PROJ0) { e.P[(size_t)r * N0 + c] = f2bf(v);
                if (c >= 2048 && c < 2560) { const int hd = c - 2048; e.VT[((size_t)(row_batch(r) * 8) * 64 + hd) * POSN + row_pos(r)] = f2bf(v); } }
            else if (MODE == GM_PROJ1) { e.P[(size_t)r * N1 + c] = f2bf(v);
                if (c >= 1664 && c < 1792) { const int hd = c - 1664; e.VT[((size_t)(row_batch(r) * 2) * 64 + hd) * POSN + row_pos(r)] = f2bf(v); } }
            else if (MODE == GM_GLU) { const float y = bf2f(e.YPRE[(size_t)r * 512 + c]); const float ga = bf2f(e.PROJ[(size_t)r * N0 + 512 + c]);
                e.YMIX[(size_t)r * DM + c] = f2bf(y * sigmoid_f(v + e.bglu[c]) * silu_f(ga)); }
            else e.OUT[(size_t)r * N + c] = v;
        }
}

__global__ void __launch_bounds__(64) k_s5_scan(const bf16_t* PROJ, const float* lam_re, const float* lam_im, const float* log_dt, const float* b_re, const float* b_im,
                                                 const float* c_re, const float* c_im, float* YS) {
    const int p = threadIdx.x, id = blockIdx.x, dir = id & 1, g = (id >> 1) & 31, b = id >> 6;
    const int gi = (dir * 32 + g);
    const double lre = lam_re[gi * 64 + p], lim = lam_im[gi * 64 + p], dt = exp((double)log_dt[gi]);
    const double mag = exp(lre * dt); const float ar = (float)(mag * cos(lim * dt)), ai = (float)(mag * sin(lim * dt));
    const double nr = mag * cos(lim * dt) - 1.0, ni = mag * sin(lim * dt), den = lre * lre + lim * lim;
    const float cfr = (float)((nr * lre + ni * lim) / den), cfi = (float)((ni * lre - nr * lim) / den);
    float bbr[16], bbi[16], cr[16], ci[16];
#pragma unroll
    for (int h = 0; h < 16; ++h) { const float br = b_re[(gi * 64 + p) * 16 + h], bi = b_im[(gi * 64 + p) * 16 + h]; bbr[h] = cfr * br - cfi * bi; bbi[h] = cfr * bi + cfi * br;
        cr[h] = c_re[(gi * 16 + h) * 64 + p]; ci[h] = c_im[(gi * 16 + h) * 64 + p]; }
    float hr = 0.f, hi = 0.f;
    float* ys = YS + (size_t)dir * MROWS * 512;
    for (int pos = 0; pos < POSN; ++pos) {
        int row;
        if (dir == 0) row = pos_row(b, pos); else row = pos < LC ? NLAT + b * LC + (LC - 1 - pos) : b * SEQ + (SEQ - 1 - (pos - LC));
        const bf16_t* up = PROJ + (size_t)row * N0 + g * 16;
        float bur = 0.f, bui = 0.f;
#pragma unroll
        for (int h = 0; h < 16; ++h) { const float u = bf2f(up[h]); bur += bbr[h] * u; bui += bbi[h] * u; }
        const float nhr = ar * hr - ai * hi + bur, nhi = ar * hi + ai * hr + bui; hr = nhr; hi = nhi;
        float mine = 0.f;
#pragma unroll
        for (int h = 0; h < 16; ++h) { const float y = wave_sum(cr[h] * hr - ci[h] * hi); if (p == h) mine = y; }
        if (p < 16) ys[(size_t)row * 512 + g * 16 + p] = mine;
    }
}
__global__ void k_s5_finish(const bf16_t* PROJ, const float* YS, const float* dsk, bf16_t* YPRE) {
    const size_t idx = (size_t)blockIdx.x * blockDim.x + threadIdx.x; if (idx >= (size_t)MROWS * 512) return;
    const int ch = idx & 511; const size_t r = idx >> 9;
    const float y = dsk[ch] * bf2f(PROJ[r * N0 + ch]) + YS[idx] + YS[(size_t)MROWS * 512 + idx];
    YPRE[idx] = f2bf(gelu_tanh(y));
}

__global__ void __launch_bounds__(256) k_na_attn(const bf16_t* PROJ, const float* relb, bf16_t* YMIX) {
    const int wv = blockIdx.x * 4 + (threadIdx.x >> 6), lane = threadIdx.x & 63;
    if (wv >= MROWS * 8) return;
    const int h = wv & 7, r = wv >> 3, b = row_batch(r);
    const float q = bf2f(PROJ[(size_t)r * N0 + 1024 + h * 64 + lane]);
    float m = -INFINITY, l = 0.f, o = 0.f;
    if (r < NLAT) {
        const int t = r & 4095, qr = t >> 6, qc = t & 63;
        const int rs = min(max(qr - 4, 0), 56), cs = min(max(qc - 8, 0), 48);
        for (int kr = rs; kr < rs + 8; ++kr)
            for (int kc = cs; kc < cs + 16; ++kc) {
                const size_t kro = (size_t)(b * SEQ + kr * 64 + kc) * N0;
                float s = wave_sum(q * bf2f(PROJ[kro + 1536 + h * 64 + lane])) * 0.125f + relb[(h * 15 + (kr - qr + 7)) * 31 + (kc - qc + 15)];
                const float mn = fmaxf(m, s), al = __expf(m - mn), pp = __expf(s - mn);
                l = l * al + pp; o = o * al + pp * bf2f(PROJ[kro + 2048 + h * 64 + lane]); m = mn;
            }
    }
    for (int c = 0; c < LC; ++c) {
        const size_t kro = (size_t)(NLAT + b * LC + c) * N0;
        const float s = wave_sum(q * bf2f(PROJ[kro + 1536 + h * 64 + lane])) * 0.125f;
        const float mn = fmaxf(m, s), al = __expf(m - mn), pp = __expf(s - mn);
        l = l * al + pp; o = o * al + pp * bf2f(PROJ[kro + 2048 + h * 64 + lane]); m = mn;
    }
    const float gb = bf2f(PROJ[(size_t)r * N0 + 2560 + h * 64 + lane]);
    YMIX[(size_t)r * DM + 512 + h * 64 + lane] = f2bf(o / l * silu_f(gb));
}

__global__ void __launch_bounds__(64) k_lru(const bf16_t* P1, const float* conv_w, const float* conv_b, const float* lam, const float* w_a, const float* b_a,
                                            const float* w_x, const float* b_x, float* HS, bf16_t* YMIX) {
    __shared__ float xs[64];
    const int j = threadIdx.x, nb = blockIdx.x & 7, b = blockIdx.x >> 3, ch = nb * 64 + j;
    const float cw0 = conv_w[0 * 512 + ch], cw1 = conv_w[1 * 512 + ch], cw2 = conv_w[2 * 512 + ch], cw3 = conv_w[3 * 512 + ch], cb = conv_b[ch];
    for (int dir = 0; dir < 2; ++dir) {
        float wa[64], wx[64];
#pragma unroll
        for (int i = 0; i < 64; ++i) { wa[i] = w_a[((dir * 8 + nb) * 64 + i) * 64 + j]; wx[i] = w_x[((dir * 8 + nb) * 64 + i) * 64 + j]; }
        const float ba = b_a[dir * 512 + ch], bx = b_x[dir * 512 + ch];
        const float lm = lam[dir * 512 + ch]; const float sp = (-lm > 20.f) ? -lm : log1pf(__expf(-lm));
        float hst = 0.f;
        for (int pos = 0; pos < POSN; ++pos) {
            int s0, sl, t;
            if (pos < LC) { s0 = NLAT + b * LC; sl = LC; t = dir == 0 ? pos : LC - 1 - pos; }
            else { s0 = b * SEQ; sl = SEQ; t = dir == 0 ? pos - LC : SEQ - 1 - (pos - LC); }
            float xm1 = 0.f, x0, xp1 = 0.f, xp2 = 0.f;
            x0 = bf2f(P1[(size_t)(s0 + t) * N1 + ch]);
            if (t - 1 >= 0) xm1 = bf2f(P1[(size_t)(s0 + t - 1) * N1 + ch]);
            if (t + 1 < sl) xp1 = bf2f(P1[(size_t)(s0 + t + 1) * N1 + ch]);
            if (t + 2 < sl) xp2 = bf2f(P1[(size_t)(s0 + t + 2) * N1 + ch]);
            const float xc = cw0 * xm1 + cw1 * x0 + cw2 * xp1 + cw3 * xp2 + cb;
            __syncthreads(); xs[j] = xc; __syncthreads();
            float ga = ba, gx = bx;
#pragma unroll
            for (int i = 0; i < 64; ++i) { const float xi = xs[i]; ga += xi * wa[i]; gx += xi * wx[i]; }
            const float gr = sigmoid_f(ga), gi = sigmoid_f(gx);
            const float log_a = -8.f * gr * sp; const float a = __expf(log_a); const float mult = sqrtf(fmaxf(-expm1f(2.f * log_a), 0.f));
            hst = a * hst + mult * gi * xc;
            if (pos >= LC) { const size_t rr = (size_t)(s0 + t);
                if (dir == 0) HS[rr * 512 + ch] = hst;
                else { const float gc = bf2f(P1[rr * N1 + 512 + ch]); YMIX[rr * DM + ch] = f2bf((HS[rr * 512 + ch] + hst) * silu_f(gc)); } }
        }
    }
}

__global__ void __launch_bounds__(256) k_qkprep(const bf16_t* P1, const float* qn, const float* kn, bf16_t* QP, bf16_t* KP) {
    const int wv = blockIdx.x * 4 + (threadIdx.x >> 6), lane = threadIdx.x & 63;
    if (wv >= MROWS * 10) return;
    const int slot = wv % 10, r = wv / 10, b = row_batch(r);
    if (slot < 8 && r >= NLAT) return;
    const int col0 = slot < 8 ? 1024 + slot * 64 : 1536 + (slot - 8) * 64;
    const float x = bf2f(P1[(size_t)r * N1 + col0 + lane]);
    const float ss = wave_sum(x * x);
    float y = x * rsqrtf(ss * (1.f / 64.f) + EPSN) * (slot < 8 ? qn[lane] : kn[lane]);
    if (r < NLAT) {
        const int t = r & 4095, i = lane >> 1, f = i & 15; const float pos = (float)(i < 16 ? (t >> 6) : (t & 63));
        const float inv = (float)exp(-log(10000.0) * (double)(2 * f) / 32.0);
        const float ang = pos * inv; const float cs = cosf(ang), sn = sinf(ang);
        const float pr = __shfl_xor(y, 1);
        y = (lane & 1) ? (pr * sn + y * cs) : (y * cs - pr * sn);
    }
    if (slot < 8) QP[((size_t)(b * 8 + slot) * SEQ + (r & 4095)) * 64 + lane] = f2bf(y * (0.125f * LOG2E));
    else KP[((size_t)(b * 2 + (slot - 8)) * POSN + row_pos(r)) * 64 + lane] = f2bf(y);
}

__global__ void __launch_bounds__(256) k_gqa(const bf16_t* QP, const bf16_t* KP, const bf16_t* P1, bf16_t* YMIX) {
    const int wv = blockIdx.x * 4 + (threadIdx.x >> 6), lane = threadIdx.x & 63;
    if (wv >= NLAT * 8) return;
    const int hq = wv & 7, r = wv >> 3, b = r >> 12, t = r & 4095, kvh = hq >> 2;
    const float q = bf2f(QP[((size_t)(b * 8 + hq) * SEQ + t) * 64 + lane]);
    const bf16_t* kp = KP + (size_t)(b * 2 + kvh) * POSN * 64;
    float m = -INFINITY, l = 0.f, o = 0.f;
    for (int pos = 0; pos < POSN; ++pos) {
        const float s = wave_sum(q * bf2f(kp[(size_t)pos * 64 + lane]));
        const float v = bf2f(P1[(size_t)pos_row(b, pos) * N1 + 1664 + kvh * 64 + lane]);
        const float mn = fmaxf(m, s), al = exp2f(m - mn), pp = exp2f(s - mn);
        l = l * al + pp; o = o * al + pp * v; m = mn;
    }
    const float gd = bf2f(P1[(size_t)r * N1 + 1792 + hq * 64 + lane]);
    YMIX[(size_t)r * DM + 512 + hq * 64 + lane] = f2bf(o / l * silu_f(gd));
}

static int g_grid = 0;
static void launch_mega(Args a, int lo, int hi, int li, hipStream_t stream) {
    a.ph_lo = lo; a.ph_hi = hi; a.li = li;
    hipLaunchKernelGGL(mega, dim3(g_grid), dim3(NTHREADS), LDS_BYTES, stream, a);
    const hipError_t le = hipPeekAtLastError();
    if (le != hipSuccess) fprintf(stderr, "kernel_launch: mega[%d,%d) failed: %s\n", lo, hi, hipGetErrorName(le));
}
extern "C" void kernel_launch(void* const* d_in, const int* in_sizes, int n_in, void* d_out, int out_size, void* d_ws, size_t ws_size, hipStream_t stream) {
    if (g_grid == 0) {
        int dev = 0, cus = 0;
        if (hipGetDevice(&dev) != hipSuccess || hipDeviceGetAttribute(&cus, hipDeviceAttributeMultiprocessorCount, dev) != hipSuccess) { fprintf(stderr, "kernel_launch: device query failed\n"); g_grid = -1; return; }
        if (hipFuncSetAttribute((const void*)mega, hipFuncAttributeMaxDynamicSharedMemorySize, LDS_BYTES) != hipSuccess) { fprintf(stderr, "kernel_launch: hipFuncSetAttribute failed\n"); g_grid = -1; return; }
        int per_cu = 0;
        if (hipOccupancyMaxActiveBlocksPerMultiprocessor(&per_cu, (const void*)mega, NTHREADS, LDS_BYTES) != hipSuccess || per_cu < 1) fprintf(stderr, "kernel_launch: occupancy query says %d blocks/CU\n", per_cu);
        (void)hipGetLastError();
        g_grid = cus;
    }
    if (g_grid < 0) return;
    const float* x = (const float*)d_in[0]; const float* c = (const float*)d_in[1]; const float* ctx = (const float*)d_in[2]; const float* cctx = (const float*)d_in[3];
    const float* ada_w = (const float*)d_in[4]; const float* ada_b = (const float*)d_in[5]; const float* pre_g = (const float*)d_in[6]; const float* post_g = (const float*)d_in[7];
    const float* ev_w_in = (const float*)d_in[8]; const float* ev_w_out = (const float*)d_in[9];
    const float* s5_lre = (const float*)d_in[10]; const float* s5_lim = (const float*)d_in[11]; const float* s5_ldt = (const float*)d_in[12];
    const float* s5_bre = (const float*)d_in[13]; const float* s5_bim = (const float*)d_in[14]; const float* s5_cre = (const float*)d_in[15]; const float* s5_cim = (const float*)d_in[16];
    const float* s5_d = (const float*)d_in[17]; const float* s5_wglu = (const float*)d_in[18]; const float* s5_bglu = (const float*)d_in[19]; const float* relb = (const float*)d_in[20];
    const float* od_w_in = (const float*)d_in[21]; const float* od_w_out = (const float*)d_in[22]; const float* conv_w = (const float*)d_in[23]; const float* conv_b = (const float*)d_in[24];
    const float* lru_lam = (const float*)d_in[25]; const float* w_a = (const float*)d_in[26]; const float* b_a = (const float*)d_in[27]; const float* w_x = (const float*)d_in[28]; const float* b_x = (const float*)d_in[29];
    const float* qn = (const float*)d_in[30]; const float* kn = (const float*)d_in[31];
    char* ws = (char*)d_ws; float* out = (float*)d_out;
    float* MOD = (float*)(ws + WS_MOD); float* HC1 = (float*)(ws + WS_HC1);
    bf16_t* XN = (bf16_t*)(ws + WS_XN); bf16_t* YMIX = (bf16_t*)(ws + WS_YMIX); bf16_t* PROJ = (bf16_t*)(ws + WS_PROJ); float* OUTF = (float*)(ws + WS_PROJ);
    bf16_t* VT0 = (bf16_t*)(ws + WS_VT0); bf16_t* YPRE = (bf16_t*)(ws + WS_YPRE); bf16_t* QP = (bf16_t*)(ws + WS_QP); bf16_t* KP = (bf16_t*)(ws + WS_KP); bf16_t* VT1 = (bf16_t*)(ws + WS_VT1);
    float* YS = (float*)(ws + WS_YS); float* HS = (float*)(ws + WS_HS);
    (void)x; (void)c; (void)ctx; (void)cctx; (void)ada_w; (void)ada_b; (void)pre_g; (void)post_g; (void)ev_w_in; (void)ev_w_out; (void)s5_wglu; (void)od_w_in; (void)od_w_out; (void)MOD; (void)HC1; (void)XN; (void)OUTF; (void)VT0; (void)VT1; (void)out;

    if (hipMemsetAsync(ws + WS_CTL, 0, CTL_ZERO_BYTES, stream) != hipSuccess) { fprintf(stderr, "kernel_launch: memset failed\n"); return; }
    Args a{};
    for (int i = 0; i < 32; ++i) a.in[i] = (const float*)d_in[i];
    a.out = (float*)d_out; a.ws = (unsigned char*)d_ws;

    launch_mega(a, 0, N_PHASES, 0, stream);
    (void)relb; (void)conv_w; (void)conv_b; (void)lru_lam; (void)w_a; (void)b_a; (void)w_x; (void)b_x; (void)HS; (void)qn; (void)kn; (void)QP; (void)KP;
    (void)s5_lre; (void)s5_lim; (void)s5_ldt; (void)s5_bre; (void)s5_bim; (void)s5_cre; (void)s5_cim; (void)s5_d; (void)s5_bglu; (void)YS; (void)YPRE; (void)PROJ; (void)YMIX;
}
```

```cpp
#include <hip/hip_runtime.h>
#include <cstdint>
#include <cstdio>

typedef unsigned short bf16_t;
#define DI __device__ __forceinline__
#define GAS __attribute__((address_space(1)))
#define LAS __attribute__((address_space(3)))
typedef unsigned v4u __attribute__((ext_vector_type(4)));
typedef unsigned v2u __attribute__((ext_vector_type(2)));
typedef float f32x4_t __attribute__((ext_vector_type(4)));
typedef float f32x16_t __attribute__((ext_vector_type(16)));
typedef short bf16x8_t __attribute__((ext_vector_type(8)));
typedef short s16x4_t __attribute__((ext_vector_type(4)));
typedef GAS unsigned gu32;
typedef GAS unsigned long long gu64;
#define RLX_AGENT __ATOMIC_RELAXED, __HIP_MEMORY_SCOPE_AGENT
#define LDS_WAIT() asm volatile("s_waitcnt lgkmcnt(0)" ::: "memory")
#define VM_WAIT() asm volatile("s_waitcnt vmcnt(0)" ::: "memory")

DI float bf2f(bf16_t v) { return __uint_as_float((unsigned)v << 16); }
DI bf16_t f2bf(float f) { unsigned u = __float_as_uint(f); return (bf16_t)((u + 0x7fffu + ((u >> 16) & 1u)) >> 16); }
DI unsigned pk2(float lo, float hi) { return (unsigned)f2bf(lo) | ((unsigned)f2bf(hi) << 16); }
DI float bflo(unsigned w) { return __uint_as_float(w << 16); }
DI float bfhi(unsigned w) { return __uint_as_float(w & 0xffff0000u); }
DI float rbf(float f) { return bf2f(f2bf(f)); }
DI float wave_sum(float v) {
#pragma unroll
    for (int o = 1; o < 64; o <<= 1) v += __shfl_xor(v, o);
    return v;
}
DI float silu_f(float x) { return x / (1.f + __expf(-x)); }
DI float sigmoid_f(float x) { return 1.f / (1.f + __expf(-x)); }
DI float gelu_tanh(float x) { const float u = 0.7978845608028654f * (x + 0.044715f * x * x * x); return 0.5f * x * (1.f + tanhf(u)); }
DI float gelu_fast(float x) { const float u = 1.5957691216057308f * (x + 0.044715f * x * x * x); return x / (1.f + __expf(-u)); }

constexpr int NWAVES = 8, NTHREADS = 512;
constexpr int DM = 1024, NB = 4, SEQ = 4096, LC = 256;
constexpr int NLAT = NB * SEQ, NCTX = NB * LC, MROWS = NLAT + NCTX;
constexpr int N0 = 3072, N1 = 2304, POSN = LC + SEQ;
constexpr float EPSN = 1e-6f;
constexpr float LOG2E = 1.4426950408889634f;

constexpr size_t MiB = 1u << 20;
constexpr size_t WS_CTL = 0, CTL_ZERO_BYTES = 1 * MiB;
constexpr size_t WS_MOD = 1 * MiB;
constexpr size_t WS_ROPE = 2 * MiB;
constexpr size_t WS_L16 = 3 * MiB;
constexpr size_t WS_WIN0T = 4 * MiB;
constexpr size_t WS_WOUT0T = 10 * MiB;
constexpr size_t WS_WIN1T = 12 * MiB;
constexpr size_t WS_WOUT1T = 17 * MiB;
constexpr size_t WS_WGLUT = 19 * MiB;
constexpr size_t WS_LRUWT = 19 * MiB + 512 * 1024;
constexpr size_t WS_W16 = 20 * MiB;
constexpr size_t WS_WC = 24 * MiB;
constexpr size_t WS_KT = 28 * MiB;
constexpr size_t WS_LSUM = 29 * MiB;
constexpr size_t WS_XN = 32 * MiB;
constexpr size_t WS_YMIX = 66 * MiB;
constexpr size_t WS_PROJ = 100 * MiB;
constexpr size_t WS_VT0 = 202 * MiB;
constexpr size_t WS_CARRY1 = 219 * MiB;
constexpr size_t WS_YPRE = 228 * MiB;
constexpr size_t WS_QP = 202 * MiB;
constexpr size_t WS_KP = 218 * MiB;
constexpr size_t WS_VT1 = 223 * MiB;
constexpr size_t WS_YS = 32 * MiB;
constexpr size_t WS_HS = 32 * MiB;
constexpr size_t WS_HC1 = 246 * MiB;

DI int row_batch(int r) { return r < NLAT ? (r >> 12) : ((r - NLAT) >> 8); }
DI int row_pos(int r) { return r < NLAT ? LC + (r & 4095) : ((r - NLAT) & 255); }
DI int pos_row(int b, int pos) { return pos < LC ? NLAT + b * LC + pos : b * SEQ + (pos - LC); }

namespace pg8 {
#define PG8_LAS __attribute__((address_space(3)))
typedef unsigned short bf16_t;
typedef short bf16x8 __attribute__((ext_vector_type(8)));
typedef float f32x4 __attribute__((ext_vector_type(4)));
typedef unsigned u32x4 __attribute__((ext_vector_type(4)));
constexpr int BM = 256, BK = 64, HALF = 128, HTB = HALF * BK * 2  , STAGE_BYTES = 8 * HTB, NXCD = 8, WGM = 8;

__host__ __device__ __forceinline__ int lds_byte(int r, int c) { const int st = (r >> 4) * 2 + (c >> 5), rr = r & 15, cc = c & 31, ob = rr * 64 + cc * 2; return st * 1024 + (ob ^ (((ob >> 9) & 1) << 5)); }
__host__ __device__ __forceinline__ void stage_rc(int b, int& R, int& C) { const int st = b / 1024, sb = b % 1024, swz = sb ^ (((sb >> 9) & 1) << 5); R = (st >> 1) * 16 + swz / 64; C = (st & 1) * 32 + (swz % 64) / 2; }
__host__ __device__ __forceinline__ int perm32(int rho) { const int n = rho >> 4, i = rho & 15; return 8 * (i >> 2) + 4 * n + (i & 3); }

struct Unit { int pm, pn; };
struct Gemm { const bf16_t* A; const bf16_t* Bt; int M, N, K; };

struct StaticOrder {
    int nM, nN, nwg, G, c;
    __host__ __device__ void init(int M, int N, int G_, int c_) { nM = M / BM; nN = N / BM; nwg = nM * nN; G = G_; c = c_; }
    __host__ __device__ bool next(int i, Unit& u) const {
        const long L = (long)i * G + c; if (L >= nwg) return false;
        int wgid = (int)L; { const int q = nwg / NXCD, r = nwg % NXCD, xcd = wgid % NXCD, off = wgid / NXCD; wgid = (xcd < r ? xcd * (q + 1) : r * (q + 1) + (xcd - r) * q) + off; }
        const int nig = WGM * nN, gid = wgid / nig, fm = gid * WGM, gsz = (nM - fm) < WGM ? (nM - fm) : WGM;
        u.pm = fm + ((wgid % nig) % gsz); u.pn = (wgid % nig) / gsz; return true;
    }
    __device__ __forceinline__ void a_ready(const Unit&) const {}
    __device__ __forceinline__ void done(const Unit&) const {}
};

__device__ __forceinline__ unsigned cvt_pk_bf16(float lo, float hi) { unsigned r; asm volatile("v_cvt_pk_bf16_f32 %0, %1, %2" : "=v"(r) : "v"(lo), "v"(hi)); return r; }

struct EpiProj {
    static constexpr bool PERM = true, AFTER_DRAIN = false;
    bf16_t* P; int ldc; bf16_t* VT; int vt_lo, vt_hi, vt_w; bool vrow;
    __device__ __forceinline__ void operator()(const f32x4 (&acc)[2][2][4][2], const Unit& u, int wr, int wc, int fr, int fq) const {
        const int row0 = u.pm * BM + wr * 64 + fr, colt = u.pn * BM + wc * 32 + 8 * fq;
#pragma unroll
        for (int ai = 0; ai < 2; ++ai)
#pragma unroll
            for (int m = 0; m < 4; ++m) { const int r = row0 + ai * HALF + m * 16; bf16_t* rowp = P + (size_t)r * ldc + colt;
#pragma unroll
                for (int bj = 0; bj < 2; ++bj) { const f32x4 v0 = acc[ai][bj][m][0], v1 = acc[ai][bj][m][1];
                    u32x4 w; w.x = cvt_pk_bf16(v0[0], v0[1]); w.y = cvt_pk_bf16(v0[2], v0[3]); w.z = cvt_pk_bf16(v1[0], v1[1]); w.w = cvt_pk_bf16(v1[2], v1[3]);
                    *(u32x4*)(rowp + bj * HALF) = w;
                    const int c0 = colt + bj * HALF;
                    if (c0 >= vt_lo && c0 < vt_hi && vrow) {
                        const int hd = c0 - vt_lo; *(u32x4*)(VT + ((size_t)(row_batch(r) * (vt_w >> 6) + (hd >> 6)) * POSN + row_pos(r)) * 64 + (hd & 63)) = w;
                    } else if (c0 >= vt_lo && c0 < vt_hi) {
                        bf16_t* vp = VT + ((size_t)row_batch(r) * vt_w + (c0 - vt_lo)) * POSN + row_pos(r);
                        vp[0 * POSN] = (bf16_t)(w.x & 0xffffu); vp[1 * POSN] = (bf16_t)(w.x >> 16); vp[2 * POSN] = (bf16_t)(w.y & 0xffffu); vp[3 * POSN] = (bf16_t)(w.y >> 16);
                        vp[4 * POSN] = (bf16_t)(w.z & 0xffffu); vp[5 * POSN] = (bf16_t)(w.z >> 16); vp[6 * POSN] = (bf16_t)(w.w & 0xffffu); vp[7 * POSN] = (bf16_t)(w.w >> 16);
                    } } }
    }
};
struct EpiGlu {
    static constexpr bool PERM = true, AFTER_DRAIN = false;
    const bf16_t* YPRE; const bf16_t* PROJ; const float* bglu; bf16_t* YMIX;
    __device__ __forceinline__ void operator()(const f32x4 (&acc)[2][2][4][2], const Unit& u, int wr, int wc, int fr, int fq) const {
        const int row0 = u.pm * BM + wr * 64 + fr, colt = u.pn * BM + wc * 32 + 8 * fq;
#pragma unroll
        for (int bj = 0; bj < 2; ++bj) { const int c0 = colt + bj * HALF;
            const f32x4 b0 = *(const f32x4*)(bglu + c0), b1 = *(const f32x4*)(bglu + c0 + 4);
#pragma unroll
            for (int ai = 0; ai < 2; ++ai)
#pragma unroll
                for (int m = 0; m < 4; ++m) { const int r = row0 + ai * HALF + m * 16;
                    const u32x4 yv = *(const u32x4*)(YPRE + (size_t)r * 512 + c0), gv = *(const u32x4*)(PROJ + (size_t)r * N0 + 512 + c0);
                    const f32x4 a0 = acc[ai][bj][m][0] + b0, a1 = acc[ai][bj][m][1] + b1;
                    float o[8];
                    o[0] = bflo(yv.x) * sigmoid_f(a0[0]) * silu_f(bflo(gv.x)); o[1] = bfhi(yv.x) * sigmoid_f(a0[1]) * silu_f(bfhi(gv.x));
                    o[2] = bflo(yv.y) * sigmoid_f(a0[2]) * silu_f(bflo(gv.y)); o[3] = bfhi(yv.y) * sigmoid_f(a0[3]) * silu_f(bfhi(gv.y));
                    o[4] = bflo(yv.z) * sigmoid_f(a1[0]) * silu_f(bflo(gv.z)); o[5] = bfhi(yv.z) * sigmoid_f(a1[1]) * silu_f(bfhi(gv.z));
                    o[6] = bflo(yv.w) * sigmoid_f(a1[2]) * silu_f(bflo(gv.w)); o[7] = bfhi(yv.w) * sigmoid_f(a1[3]) * silu_f(bfhi(gv.w));
                    u32x4 w; w.x = cvt_pk_bf16(o[0], o[1]); w.y = cvt_pk_bf16(o[2], o[3]); w.z = cvt_pk_bf16(o[4], o[5]); w.w = cvt_pk_bf16(o[6], o[7]);
                    *(u32x4*)(YMIX + (size_t)r * DM + c0) = w; } }
    }
};
struct EpiF32 {
    static constexpr bool PERM = false, AFTER_DRAIN = false;
    float* O; int ldc;
    __device__ __forceinline__ void operator()(const f32x4 (&acc)[2][2][4][2], const Unit& u, int wr, int wc, int fr, int fq) const {
        const int row0 = u.pm * BM + wr * 64 + fr, col0 = u.pn * BM + wc * 32 + 4 * fq;
#pragma unroll
        for (int ai = 0; ai < 2; ++ai)
#pragma unroll
            for (int m = 0; m < 4; ++m) { float* rowp = O + (size_t)(row0 + ai * HALF + m * 16) * ldc + col0;
#pragma unroll
                for (int bj = 0; bj < 2; ++bj)
#pragma unroll
                    for (int n = 0; n < 2; ++n) *(f32x4*)(rowp + bj * HALF + n * 16) = acc[ai][bj][m][n]; }
    }
};
template <class Epi, class Sched, bool ALIGN_EPI = false, bool SP2 = false>
__device__ __forceinline__ void gemm_phase(PG8_LAS unsigned char* lds, const Gemm g, const Sched& S, const Epi& E) {
    const int tid = threadIdx.x, wid = __builtin_amdgcn_readfirstlane(tid >> 6), lane = tid & 63, wr = wid >> 2, wc = wid & 3, fr = lane & 15, fq = lane >> 4;
    const int K = g.K, nt = K / BK;
    unsigned voffA[2], voffB[2];
#pragma unroll
    for (int i = 0; i < 2; ++i) { int R, C; stage_rc(tid * 16 + i * 8192, R, C); const int Rb = Epi::PERM ? ((R & ~31) + perm32(R & 31)) : R;
        voffA[i] = (unsigned)(R * K + C) * 2u; voffB[i] = (unsigned)(Rb * K + C) * 2u; }
    const size_t kstep = (size_t)(BK * 2);
    const size_t hstep = (size_t)HALF * K * 2;
    const size_t tstep = 2 * hstep;
    const unsigned ldsw = (unsigned)wid * 1024u;
    const int aoff = lds_byte(wr * 64 + fr, fq * 8), boff = lds_byte(wc * 32 + fr, fq * 8);
#define PG8_SA(b, h) (((b) * 2 + (h)) * HTB)
#define PG8_SB(b, h) ((4 + (b) * 2 + (h)) * HTB)
#define PG8_STAGE(bufoff, gbase, voff) do { _Pragma("unroll") for (int _i = 0; _i < 2; ++_i) \
        __builtin_amdgcn_global_load_lds((const unsigned*)((const char*)(gbase) + (voff)[_i]), (PG8_LAS unsigned*)(lds + (bufoff) + ldsw + _i * 8192), 16, 0, 0); } while (0)
#define PG8_LDA(dst, b, h) do { _Pragma("unroll") for (int m = 0; m < 4; ++m) _Pragma("unroll") for (int k = 0; k < 2; ++k) dst[m][k] = *(const PG8_LAS bf16x8*)(lds + PG8_SA(b, h) + aoff + m * 2048 + k * 1024); } while (0)
#define PG8_LDB(dst, b, h) do { _Pragma("unroll") for (int n = 0; n < 2; ++n) _Pragma("unroll") for (int k = 0; k < 2; ++k) dst[n][k] = *(const PG8_LAS bf16x8*)(lds + PG8_SB(b, h) + boff + n * 2048 + k * 1024); } while (0)
#define PG8_MMA(ai, bj, At, Bt) do { __builtin_amdgcn_s_setprio(1); _Pragma("unroll") for (int m = 0; m < 4; ++m) _Pragma("unroll") for (int n = 0; n < 2; ++n) _Pragma("unroll") for (int k = 0; k < 2; ++k) \
        acc[ai][bj][m][n] = __builtin_amdgcn_mfma_f32_16x16x32_bf16(Bt[n][k], At[m][k], acc[ai][bj][m][n], 0, 0, 0); __builtin_amdgcn_s_setprio(0); } while (0)
#define PG8_WAIT_V(n) asm volatile("s_waitcnt vmcnt(" #n ")" ::: "memory")
#define PG8_WAIT_L(n) asm volatile("s_waitcnt lgkmcnt(" #n ")" ::: "memory")
#define PG8_BAR __builtin_amdgcn_s_barrier()
#define PG8_SCHED __builtin_amdgcn_sched_barrier(0)
    Unit cur, nxt; int ui = 0;
    if (!S.next(0, cur)) return;
    f32x4 acc[2][2][4][2];
#pragma unroll
    for (int a = 0; a < 2; ++a)
#pragma unroll
        for (int b = 0; b < 2; ++b)
#pragma unroll
            for (int m = 0; m < 4; ++m)
#pragma unroll
                for (int n = 0; n < 2; ++n) acc[a][b][m][n] = (f32x4){0.f, 0.f, 0.f, 0.f};
    bf16x8 At[4][2], B0[2][2], B1[2][2];
    const char* cA = (const char*)g.A + (size_t)cur.pm * tstep; const char* cB = (const char*)g.Bt + (size_t)cur.pn * tstep;
    S.a_ready(cur);
    if constexpr (SP2) {
        PG8_STAGE(PG8_SB(0, 0), cB, voffB); PG8_STAGE(PG8_SB(0, 1), cB + hstep, voffB); PG8_STAGE(PG8_SA(0, 0), cA, voffA); PG8_STAGE(PG8_SA(0, 1), cA + hstep, voffA);
        if (wr == 1) PG8_BAR;
        PG8_WAIT_V(2); PG8_BAR;
        PG8_STAGE(PG8_SB(1, 0), cB + kstep, voffB); PG8_STAGE(PG8_SA(1, 0), cA + kstep, voffA); PG8_STAGE(PG8_SB(1, 1), cB + hstep + kstep, voffB);
        PG8_WAIT_V(6); PG8_BAR;
    } else {
        PG8_STAGE(PG8_SB(0, 0), cB, voffB); PG8_STAGE(PG8_SA(0, 0), cA, voffA); PG8_STAGE(PG8_SB(0, 1), cB + hstep, voffB); PG8_STAGE(PG8_SA(0, 1), cA + hstep, voffA);
        if (wr == 1) PG8_BAR;
        PG8_WAIT_V(4); PG8_BAR;
        PG8_STAGE(PG8_SB(1, 0), cB + kstep, voffB); PG8_STAGE(PG8_SA(1, 0), cA + kstep, voffA); PG8_STAGE(PG8_SB(1, 1), cB + hstep + kstep, voffB);
        PG8_WAIT_V(6); PG8_BAR;
    }
    for (;;) {
        const bool has_next = S.next(ui + 1, nxt);
        const char* nA = has_next ? (const char*)g.A + (size_t)nxt.pm * tstep : cA; const char* nB = has_next ? (const char*)g.Bt + (size_t)nxt.pn * tstep : cB;
        for (int t = 0; t < nt; t += 2) {
            const bool last = (t == nt - 2);
            const char* a1 = cA + (size_t)(t + 1) * kstep;
            const char* a2 = last ? nA : cA + (size_t)(t + 2) * kstep; const char* b2 = last ? nB : cB + (size_t)(t + 2) * kstep;
            const char* a3 = a2 + kstep; const char* b3 = b2 + kstep;
            if (last && has_next) S.a_ready(nxt);
            if constexpr (SP2) {
            PG8_LDB(B0, 0, 0); PG8_LDB(B1, 0, 1); PG8_SCHED; PG8_LDA(At, 0, 0); PG8_STAGE(PG8_SA(1, 1), a1 + hstep, voffA);
            PG8_WAIT_V(8); PG8_WAIT_L(0); PG8_BAR; PG8_MMA(0, 0, At, B0); PG8_MMA(0, 1, At, B1); PG8_BAR; PG8_SCHED;
            PG8_LDA(At, 0, 1); PG8_STAGE(PG8_SB(0, 0), b2, voffB); PG8_STAGE(PG8_SB(0, 1), b2 + hstep, voffB); PG8_STAGE(PG8_SA(0, 0), a2, voffA);
            PG8_WAIT_V(8); PG8_WAIT_L(0); PG8_BAR; PG8_MMA(1, 0, At, B0); PG8_MMA(1, 1, At, B1); PG8_BAR; PG8_SCHED;
            PG8_LDB(B0, 1, 0); PG8_LDB(B1, 1, 1); PG8_SCHED; PG8_LDA(At, 1, 0); PG8_STAGE(PG8_SA(0, 1), a2 + hstep, voffA);
            PG8_WAIT_V(8); PG8_WAIT_L(0); PG8_BAR; PG8_MMA(0, 0, At, B0); PG8_MMA(0, 1, At, B1); PG8_BAR; PG8_SCHED;
            PG8_LDA(At, 1, 1); PG8_STAGE(PG8_SB(1, 0), b3, voffB); PG8_STAGE(PG8_SB(1, 1), b3 + hstep, voffB); PG8_STAGE(PG8_SA(1, 0), a3, voffA);
            PG8_WAIT_V(8); PG8_WAIT_L(0); PG8_BAR; PG8_MMA(1, 0, At, B0); PG8_MMA(1, 1, At, B1); PG8_BAR; PG8_SCHED;
            } else {
            PG8_LDB(B0, 0, 0); PG8_SCHED; PG8_LDA(At, 0, 0); PG8_STAGE(PG8_SA(1, 1), a1 + hstep, voffA);
            PG8_WAIT_L(8); PG8_BAR; PG8_WAIT_L(0); PG8_MMA(0, 0, At, B0); PG8_BAR; PG8_SCHED;
            PG8_LDB(B1, 0, 1); PG8_STAGE(PG8_SB(0, 0), b2, voffB);
            PG8_BAR; PG8_WAIT_L(0); PG8_MMA(0, 1, At, B1); PG8_BAR;
            PG8_LDA(At, 0, 1); PG8_STAGE(PG8_SA(0, 0), a2, voffA);
            PG8_BAR; PG8_WAIT_L(0); PG8_MMA(1, 0, At, B0); PG8_BAR; PG8_SCHED;
            PG8_STAGE(PG8_SB(0, 1), b2 + hstep, voffB);
            PG8_WAIT_V(6); PG8_BAR; PG8_MMA(1, 1, At, B1); PG8_BAR;
            PG8_LDB(B0, 1, 0); PG8_SCHED; PG8_LDA(At, 1, 0); PG8_STAGE(PG8_SA(0, 1), a2 + hstep, voffA);
            PG8_WAIT_L(8); PG8_BAR; PG8_WAIT_L(0); PG8_MMA(0, 0, At, B0); PG8_BAR; PG8_SCHED;
            PG8_LDB(B1, 1, 1); PG8_STAGE(PG8_SB(1, 0), b3, voffB);
            PG8_BAR; PG8_WAIT_L(0); PG8_MMA(0, 1, At, B1); PG8_BAR;
            PG8_LDA(At, 1, 1); PG8_STAGE(PG8_SA(1, 0), a3, voffA);
            PG8_BAR; PG8_WAIT_L(0); PG8_MMA(1, 0, At, B0); PG8_BAR; PG8_SCHED;
            PG8_STAGE(PG8_SB(1, 1), b3 + hstep, voffB);
            PG8_WAIT_V(6); PG8_BAR; PG8_MMA(1, 1, At, B1); PG8_BAR;
            }
        }
        if constexpr (ALIGN_EPI) { if (wr == 0) PG8_BAR; }
        if constexpr (!Epi::AFTER_DRAIN) { E(acc, cur, wr, wc, fr, fq); S.done(cur); }
        if (!has_next) break;
#pragma unroll
        for (int a = 0; a < 2; ++a)
#pragma unroll
            for (int b = 0; b < 2; ++b)
#pragma unroll
                for (int m = 0; m < 4; ++m)
#pragma unroll
                    for (int n = 0; n < 2; ++n) acc[a][b][m][n] = (f32x4){0.f, 0.f, 0.f, 0.f};
        cur = nxt; cA = nA; cB = nB; ++ui;
        if constexpr (ALIGN_EPI) { if (wr == 1) PG8_BAR; }
    }
    PG8_WAIT_V(0);
    if constexpr (!ALIGN_EPI) { if (wr == 0) PG8_BAR; }
    PG8_BAR;
    if constexpr (Epi::AFTER_DRAIN) { E.fused(acc, cur, wr, wc, fr, fq, lds, wid, lane); S.done(cur); }
#undef PG8_SA
#undef PG8_SB
#undef PG8_STAGE
#undef PG8_LDA
#undef PG8_LDB
#undef PG8_MMA
#undef PG8_WAIT_V
#undef PG8_WAIT_L
#undef PG8_BAR
#undef PG8_SCHED
}
}
#define XB_TMO      128
#define XB_XCNT(j)  (256  + 64 * (j))
#define XB_XSUB(j)  (1280 + 64 * (j))
#define XB_XGEN(j)  (2304 + 64 * (j))
#define XB_TOP      3328
#define XB_TOPGEN   3392
#define XCD_BAR_WORDS 3456
#define XB_SPIN_CAP (1u << 18)

__device__ __forceinline__ unsigned xb_ld(unsigned* p)              { return __hip_atomic_load(p, __ATOMIC_RELAXED, __HIP_MEMORY_SCOPE_AGENT); }
__device__ __forceinline__ unsigned xb_add(unsigned* p, unsigned v) { return __hip_atomic_fetch_add(p, v, __ATOMIC_RELAXED, __HIP_MEMORY_SCOPE_AGENT); }
__device__ __forceinline__ unsigned xb_xcc_id() { return (unsigned)__builtin_amdgcn_s_getreg((3 << 11) | 20) & 0xFu; }
#define XB_SPIN(cond, bar) do { unsigned _sp = 0; while (cond) { __builtin_amdgcn_s_sleep(1); \
    if ((++_sp & 255u) == 0u) { if (xb_ld(&(bar)[XB_TMO])) break; if (_sp > XB_SPIN_CAP) { atomicAdd(&(bar)[XB_TMO], 1u); break; } } } } while (0)

struct XcdBarrier {
    unsigned* bar; unsigned x;
    volatile LAS unsigned* st;
};

__device__ __forceinline__ XcdBarrier xcd_barrier_post(unsigned* bar, volatile LAS unsigned* st) {
    XcdBarrier b; b.bar = bar; b.x = xb_xcc_id(); b.st = st;
    if (threadIdx.x == 0) (void)xb_add(&bar[XB_XCNT(b.x)], 1u);
    return b;
}
__device__ __forceinline__ void xcd_barrier_complete(unsigned* bar, unsigned x, unsigned& nloc, unsigned& nx) {
    const unsigned G = gridDim.x * gridDim.y * gridDim.z;
    unsigned sum, cnt, mine, sp = 0u;
    for (;;) {
        sum = 0u; cnt = 0u; mine = 0u;
#pragma unroll
        for (unsigned j = 0; j < 16; ++j) { const unsigned c = xb_ld(&bar[XB_XCNT(j)]); sum += c; cnt += (c > 0u) ? 1u : 0u; mine = (j == x) ? c : mine; }
        if (sum == G) break;
        __builtin_amdgcn_s_sleep(1);
        if ((++sp & 255u) == 0u) { if (xb_ld(&bar[XB_TMO])) break; if (sp > XB_SPIN_CAP) { atomicAdd(&bar[XB_TMO], 1u); break; } }
    }
    nloc = mine > 0u ? mine : 1u; nx = cnt > 0u ? cnt : 1u;
}

__device__ __forceinline__ void xcd_barrier(const XcdBarrier& b) {
    asm volatile("s_waitcnt vmcnt(0)" ::: "memory");
    __syncthreads();
    if (threadIdx.x == 0) {
        unsigned* bar = b.bar;
        __builtin_amdgcn_s_waitcnt(0);
        unsigned nloc = b.st[0], nx = b.st[1];
        if (nloc == 0u) { xcd_barrier_complete(bar, b.x, nloc, nx); b.st[0] = nloc; b.st[1] = nx; }
        const unsigned old = xb_add(&bar[XB_XSUB(b.x)], 1u);
        const unsigned gen = old / nloc;
        if (old + 1u == (gen + 1u) * nloc) {
            __builtin_amdgcn_fence(__ATOMIC_RELEASE, "agent");
            asm volatile("s_waitcnt vmcnt(0)" ::: "memory");
            const unsigned og = xb_add(&bar[XB_TOP], 1u);
            const unsigned tg = og / nx;
            if (og + 1u == (tg + 1u) * nx) xb_add(&bar[XB_TOPGEN], 1u);
            else XB_SPIN(xb_ld(&bar[XB_TOPGEN]) == tg, bar);
            __builtin_amdgcn_fence(__ATOMIC_ACQUIRE, "agent");
            xb_add(&bar[XB_XGEN(b.x)], 1u);
            asm volatile("s_waitcnt vmcnt(0)" ::: "memory");
        } else {
            XB_SPIN(xb_ld(&bar[XB_XGEN(b.x)]) == gen, bar);
            __builtin_amdgcn_fence(__ATOMIC_ACQUIRE, "agent");
            asm volatile("s_waitcnt vmcnt(0)" ::: "memory");
        }
    }
    __syncthreads();
}

DI int crow16(int reg, int hf) { return (reg & 3) + 8 * (reg >> 2) + 4 * hf; }
DI unsigned cvtpk(float lo, float hi) { typedef float f2 __attribute__((ext_vector_type(2))); typedef __bf16 b2 __attribute__((ext_vector_type(2))); f2 v = {lo, hi}; b2 b = __builtin_convertvector(v, b2); return __builtin_bit_cast(unsigned, b); }
struct AttnP { const bf16_t* Q; const bf16_t* K; const bf16_t* VT; const bf16_t* Gt; bf16_t* Y; const float* relb; };

template <int MODE> DI void attn_unit(int unit, const AttnP& P, int lane) {
    const int ql = lane & 31, hf = lane >> 5;
    int b, h, kvh, qrow, NT, rp = 0, ci = 0, rs0 = 0, c0 = 0, qr = 0, qc = 0, rsq = 0, csq = 0;
    if (MODE == 0) { ci = unit & 3; rp = (unit >> 2) & 31; h = (unit >> 7) & 7; b = unit >> 10; kvh = h;
        qr = 2 * rp + (ql >> 4); qc = 16 * ci + (ql & 15); qrow = b * SEQ + qr * 64 + qc;
        rs0 = min(max(2 * rp - 4, 0), 56); const int rs1 = min(max(2 * rp - 3, 0), 56); NT = 8 + (rs1 + 8 - rs0);
        c0 = min(max(16 * ci - 8, 0), 32); rsq = min(max(qr - 4, 0), 56); csq = min(max(qc - 8, 0), 48);
    } else if (MODE == 1) { const int qt = unit & 7; h = (unit >> 3) & 7; b = unit >> 6; kvh = h; qrow = NLAT + b * LC + 32 * qt + ql; NT = 8; }
    else { const int qt = unit & 127; h = (unit >> 7) & 7; b = unit >> 10; kvh = h >> 2; qrow = b * SEQ + 32 * qt + ql; NT = POSN / 32; }
    const bf16_t* qp; const bf16_t* kb; size_t kpitch; const bf16_t* vt; const bf16_t* gp; bf16_t* yp;
    if (MODE == 2) { qp = P.Q + ((size_t)(b * 8 + h) * SEQ + (qrow - b * SEQ)) * 64; kb = P.K + (size_t)(b * 2 + kvh) * POSN * 64; kpitch = 64;
        vt = P.VT + (size_t)(b * 2 + kvh) * 64 * POSN; gp = P.Gt + (size_t)qrow * N1 + 1792 + h * 64; }
    else { qp = P.Q + (size_t)qrow * N0 + 1024 + h * 64; kb = P.K + 1536 + h * 64; kpitch = N0; vt = P.VT + (size_t)(b * 8 + h) * 64 * POSN; gp = P.Gt + (size_t)qrow * N0 + 2560 + h * 64; }
    yp = P.Y + (size_t)qrow * DM + 512 + h * 64;
    bf16x8_t qf[4];
#pragma unroll
    for (int ks = 0; ks < 4; ++ks) qf[ks] = *(const bf16x8_t*)(qp + 16 * ks + 8 * hf);
    const bf16_t* vt0 = vt + (size_t)ql * POSN + 4 * hf;
    f32x16_t o0 = {}, o1 = {};
    float m = -1e30f, l = 0.f;
    auto tile_krow = [&](int t) -> int { if (MODE == 2) return 32 * t + ql; if (t < 8) return NLAT + b * LC + 32 * t + ql; return b * SEQ + (rs0 + t - 8) * 64 + c0 + ql; };
    auto tile_pos0 = [&](int t) -> int { if (MODE == 2) return 32 * t; if (t < 8) return 32 * t; return LC + (rs0 + t - 8) * 64 + c0; };
    bf16x8_t kn[4];
    { const bf16_t* kp = kb + (size_t)tile_krow(0) * kpitch + 8 * hf;
#pragma unroll
      for (int ks = 0; ks < 4; ++ks) kn[ks] = *(const bf16x8_t*)(kp + 16 * ks); }
#pragma unroll 1
    for (int t = 0; t < NT; ++t) {
        bf16x8_t kf[4];
#pragma unroll
        for (int ks = 0; ks < 4; ++ks) kf[ks] = kn[ks];
        if (t + 1 < NT) { const bf16_t* kp = kb + (size_t)tile_krow(t + 1) * kpitch + 8 * hf;
#pragma unroll
            for (int ks = 0; ks < 4; ++ks) kn[ks] = *(const bf16x8_t*)(kp + 16 * ks); }
        const bf16_t* vp = vt0 + tile_pos0(t);
        s16x4_t va[2][2][2];
#pragma unroll
        for (int dt = 0; dt < 2; ++dt)
#pragma unroll
            for (int s = 0; s < 2; ++s) { va[dt][s][0] = *(const s16x4_t*)(vp + (size_t)dt * 32 * POSN + 16 * s); va[dt][s][1] = *(const s16x4_t*)(vp + (size_t)dt * 32 * POSN + 16 * s + 8); }
        f32x16_t sc = {};
#pragma unroll
        for (int ks = 0; ks < 4; ++ks) sc = __builtin_amdgcn_mfma_f32_32x32x16_bf16(kf[ks], qf[ks], sc, 0, 0, 0);
        float xs[16];
        if (MODE == 0 && t >= 8) {
            const int kr = rs0 + t - 8; const bool row_ok = (kr >= rsq) && (kr < rsq + 8);
            const float* rb = P.relb + (h * 15 + (kr - qr + 7)) * 31 + (15 - qc);
#pragma unroll
            for (int r = 0; r < 16; ++r) { const int kc = c0 + crow16(r, hf); const bool ok = row_ok && (kc >= csq) && (kc < csq + 16);
                const float bias = ok ? rb[kc] : 0.f; xs[r] = ok ? (sc[r] * 0.125f + bias) * LOG2E : -1e30f; }
        } else {
#pragma unroll
            for (int r = 0; r < 16; ++r) xs[r] = (MODE == 2) ? sc[r] : sc[r] * (0.125f * LOG2E);
        }
        float tm = xs[0];
#pragma unroll
        for (int r = 1; r < 16; ++r) tm = fmaxf(tm, xs[r]);
        tm = fmaxf(tm, __shfl_xor(tm, 32));
        const float mn = fmaxf(m, tm), al = __builtin_amdgcn_exp2f(m - mn);
        float ps = 0.f;
#pragma unroll
        for (int r = 0; r < 16; ++r) { xs[r] = __builtin_amdgcn_exp2f(xs[r] - mn); ps += xs[r]; }
        l = l * al + ps; m = mn;
#pragma unroll
        for (int r = 0; r < 16; ++r) { o0[r] *= al; o1[r] *= al; }
        bf16x8_t pf[2];
#pragma unroll
        for (int s = 0; s < 2; ++s) { v4u w; w.x = cvtpk(xs[8 * s], xs[8 * s + 1]); w.y = cvtpk(xs[8 * s + 2], xs[8 * s + 3]); w.z = cvtpk(xs[8 * s + 4], xs[8 * s + 5]); w.w = cvtpk(xs[8 * s + 6], xs[8 * s + 7]);
            pf[s] = __builtin_bit_cast(bf16x8_t, w); }
#pragma unroll
        for (int s = 0; s < 2; ++s) {
            const bf16x8_t a0 = __builtin_shufflevector(va[0][s][0], va[0][s][1], 0, 1, 2, 3, 4, 5, 6, 7);
            const bf16x8_t a1 = __builtin_shufflevector(va[1][s][0], va[1][s][1], 0, 1, 2, 3, 4, 5, 6, 7);
            o0 = __builtin_amdgcn_mfma_f32_32x32x16_bf16(a0, pf[s], o0, 0, 0, 0);
            o1 = __builtin_amdgcn_mfma_f32_32x32x16_bf16(a1, pf[s], o1, 0, 0, 0);
        }
    }
    l += __shfl_xor(l, 32);
    const float rl = 1.f / l;
#pragma unroll
    for (int dt = 0; dt < 2; ++dt)
#pragma unroll
        for (int rg = 0; rg < 4; ++rg) { const int d = 32 * dt + 8 * rg + 4 * hf;
            const v2u gv = *(const v2u*)(gp + d);
            const float g0 = silu_f(bflo(gv.x)), g1 = silu_f(bfhi(gv.x)), g2 = silu_f(bflo(gv.y)), g3 = silu_f(bfhi(gv.y));
            const f32x16_t& oo = dt ? o1 : o0;
            v2u w; w.x = pk2(oo[4 * rg] * rl * g0, oo[4 * rg + 1] * rl * g1); w.y = pk2(oo[4 * rg + 2] * rl * g2, oo[4 * rg + 3] * rl * g3);
            *(v2u*)(yp + d) = w; }
}

constexpr int LRU_NCH = 34;
typedef float f32x2_t __attribute__((ext_vector_type(2)));
struct LruP { const bf16_t* P1; const float* conv_w; const float* conv_b; const float* lam; const float* b_a; const float* b_x; const bf16_t* WT; f32x2_t* LSUM; bf16_t* YMIX; };

template <bool PASS2> DI void lru_item(int item, const LruP& p, LAS unsigned char* lds, int tid, int wave, int lane) {
    LAS bf16_t* XA = (LAS bf16_t*)lds;
    LAS float* XF = (LAS float*)(lds + 18432);
    LAS float* CW = (LAS float*)(lds + 18432 + 33280);
    LAS f32x2_t* SEG = (LAS f32x2_t*)(lds + 18432 + 33280 + 1280);
    LAS f32x2_t* CS = (LAS f32x2_t*)(lds + 18432 + 33280 + 1280 + 4096);
    LAS float* CC = (LAS float*)(lds + 18432 + 33280 + 1280 + 4096 + 34816);
    int nb, cidx, b;
    if (PASS2) { nb = item & 7; cidx = 2 + ((item >> 3) & 31); b = item >> 8; } else { nb = item & 7; cidx = (item >> 3) % LRU_NCH; b = (item >> 3) / LRU_NCH; }
    const int s0 = cidx < 2 ? NLAT + b * LC : b * SEQ, sl = cidx < 2 ? LC : SEQ, t0 = cidx < 2 ? cidx * 128 : (cidx - 2) * 128;
    const int n = lane & 15, q = lane >> 4;
    __syncthreads();
    if (tid < 320) CW[tid] = tid < 256 ? p.conv_w[(tid >> 6) * 512 + nb * 64 + (tid & 63)] : p.conv_b[nb * 64 + (tid & 63)];
    if (PASS2) { for (int e = tid; e < 2 * LRU_NCH * 64; e += NTHREADS) { const int ch = e & 63, cc = (e >> 6) % LRU_NCH, dir = (e >> 6) / LRU_NCH; CS[e] = p.LSUM[((size_t)(b * LRU_NCH + cc) * 2 + dir) * 512 + nb * 64 + ch]; } }
    __syncthreads();
    {
        const int tl = tid >> 2, cg = tid & 3;
        float xv[4][16];
#pragma unroll
        for (int j = 0; j < 4; ++j) { const int tt = t0 + tl + j - 1; const bool ok = tt >= 0 && tt < sl;
            v4u w0 = {0u, 0u, 0u, 0u}, w1 = {0u, 0u, 0u, 0u};
            if (ok) { const bf16_t* src = p.P1 + (size_t)(s0 + tt) * N1 + nb * 64 + cg * 16; w0 = *(const v4u*)src; w1 = *(const v4u*)(src + 8); }
            xv[j][0] = bflo(w0.x); xv[j][1] = bfhi(w0.x); xv[j][2] = bflo(w0.y); xv[j][3] = bfhi(w0.y); xv[j][4] = bflo(w0.z); xv[j][5] = bfhi(w0.z); xv[j][6] = bflo(w0.w); xv[j][7] = bfhi(w0.w);
            xv[j][8] = bflo(w1.x); xv[j][9] = bfhi(w1.x); xv[j][10] = bflo(w1.y); xv[j][11] = bfhi(w1.y); xv[j][12] = bflo(w1.z); xv[j][13] = bfhi(w1.z); xv[j][14] = bflo(w1.w); xv[j][15] = bfhi(w1.w); }
#pragma unroll
        for (int e = 0; e < 16; ++e) { const int c = cg * 16 + e;
            const float xc = CW[c] * xv[0][e] + CW[64 + c] * xv[1][e] + CW[128 + c] * xv[2][e] + CW[192 + c] * xv[3][e] + CW[256 + c];
            XF[tl * 65 + c] = xc; XA[tl * 72 + c] = f2bf(xc); }
    }
    __syncthreads();
    bf16x8_t af[2];
#pragma unroll
    for (int ks = 0; ks < 2; ++ks) af[ks] = *(const LAS bf16x8_t*)(XA + (wave * 16 + n) * 72 + 32 * ks + 8 * q);
    float hsum[4][4];
#pragma unroll
    for (int c4 = 0; c4 < 4; ++c4)
#pragma unroll
        for (int r = 0; r < 4; ++r) hsum[c4][r] = 0.f;
#pragma unroll 1
    for (int dir = 0; dir < 2; ++dir) {
        f32x4_t acc[8];
#pragma unroll
        for (int nt = 0; nt < 8; ++nt) { acc[nt] = (f32x4_t){0.f, 0.f, 0.f, 0.f};
            const bf16_t* wrow = p.WT + (size_t)(nb * 256 + (dir * 2 + (nt >> 2)) * 64 + (nt & 3) * 16 + n) * 64 + 8 * q;
#pragma unroll
            for (int ks = 0; ks < 2; ++ks) { const bf16x8_t bfr = *(const bf16x8_t*)(wrow + 32 * ks); acc[nt] = __builtin_amdgcn_mfma_f32_16x16x32_bf16(af[ks], bfr, acc[nt], 0, 0, 0); } }
        float a[4][4], bt[4][4];
#pragma unroll
        for (int c4 = 0; c4 < 4; ++c4) { const int ch = nb * 64 + c4 * 16 + n;
            const float ba = p.b_a[dir * 512 + ch], bx = p.b_x[dir * 512 + ch], lm = p.lam[dir * 512 + ch]; const float sp = log1pf(__expf(-lm));
#pragma unroll
            for (int r = 0; r < 4; ++r) { const float gr = sigmoid_f(acc[c4][r] + ba), gi = sigmoid_f(acc[c4 + 4][r] + bx);
                const float log_a = -8.f * gr * sp; a[c4][r] = __expf(log_a); const float mult = sqrtf(fmaxf(-expm1f(2.f * log_a), 0.f));
                bt[c4][r] = mult * gi * XF[(wave * 16 + 4 * q + r) * 65 + c4 * 16 + n]; } }
        float Pq[4], Sq[4];
#pragma unroll
        for (int c4 = 0; c4 < 4; ++c4) { float P = 1.f, S = 0.f;
#pragma unroll
            for (int rr = 0; rr < 4; ++rr) { const int r = dir == 0 ? rr : 3 - rr; S = a[c4][r] * S + bt[c4][r]; P *= a[c4][r]; }
            Pq[c4] = P; Sq[c4] = S; }
        float Pin[4], Sin[4];
#pragma unroll
        for (int c4 = 0; c4 < 4; ++c4) { float P = 1.f, S = 0.f, Pw = 1.f, Sw = 0.f;
#pragma unroll
            for (int kk = 0; kk < 4; ++kk) { const int k = dir == 0 ? kk : 3 - kk;
                const float pk = __shfl(Pq[c4], n + 16 * k), sk = __shfl(Sq[c4], n + 16 * k);
                const bool before = dir == 0 ? (k < q) : (k > q);
                if (before) { S = pk * S + sk; P *= pk; }
                Sw = pk * Sw + sk; Pw *= pk; }
            Pin[c4] = P; Sin[c4] = S;
            if (q == 0) SEG[wave * 64 + c4 * 16 + n] = (f32x2_t){Pw, Sw}; }
        __syncthreads();
        if (!PASS2) {
            if (tid < 64) { float P = 1.f, S = 0.f;
#pragma unroll
                for (int ww = 0; ww < 8; ++ww) { const int w = dir == 0 ? ww : 7 - ww; const f32x2_t s = SEG[w * 64 + tid]; S = s[0] * S + s[1]; P *= s[0]; }
                p.LSUM[((size_t)(b * LRU_NCH + cidx) * 2 + dir) * 512 + nb * 64 + tid] = (f32x2_t){P, S}; }
            __syncthreads();
        } else {
            if (tid < 64) {
                float S = 0.f;
                if (dir == 0) { for (int cc = 0; cc < cidx; ++cc) { const f32x2_t s = CS[(0 * LRU_NCH + cc) * 64 + tid]; S = s[0] * S + s[1]; } }
                else { for (int cc = 1; cc >= 0; --cc) { const f32x2_t s = CS[(1 * LRU_NCH + cc) * 64 + tid]; S = s[0] * S + s[1]; }
                       for (int cc = LRU_NCH - 1; cc > cidx; --cc) { const f32x2_t s = CS[(1 * LRU_NCH + cc) * 64 + tid]; S = s[0] * S + s[1]; } }
                CC[dir * 64 + tid] = S; }
            __syncthreads();
#pragma unroll
            for (int c4 = 0; c4 < 4; ++c4) { float h = CC[dir * 64 + c4 * 16 + n];
                for (int ww = 0; ww < 8; ++ww) { const int w = dir == 0 ? ww : 7 - ww; const bool before = dir == 0 ? (w < wave) : (w > wave);
                    if (before) { const f32x2_t s = SEG[w * 64 + c4 * 16 + n]; h = s[0] * h + s[1]; } }
                h = Pin[c4] * h + Sin[c4];
#pragma unroll
                for (int rr = 0; rr < 4; ++rr) { const int r = dir == 0 ? rr : 3 - rr; h = a[c4][r] * h + bt[c4][r]; hsum[c4][r] += h; } }
            __syncthreads();
        }
    }
    if (PASS2) {
#pragma unroll
        for (int c4 = 0; c4 < 4; ++c4)
#pragma unroll
            for (int r = 0; r < 4; ++r) { const size_t row = (size_t)(s0 + t0 + wave * 16 + 4 * q + r); const int ch = nb * 64 + c4 * 16 + n;
                const float gc = bf2f(p.P1[row * N1 + 512 + ch]); p.YMIX[row * DM + ch] = f2bf(hsum[c4][r] * silu_f(gc)); }
    }
}

DI void qkprep_row(int r, const bf16_t* P1, const float* qn, const float* kn, const float* ROPE, bf16_t* QP, bf16_t* KP, int lane) {
    const int b = row_batch(r); const bool lat = r < NLAT; const int t = r & 4095;
    float cs = 1.f, sn = 0.f;
    if (lat) { const f32x2_t cv = *(const f32x2_t*)(ROPE + ((size_t)t * 32 + (lane >> 1)) * 2); cs = cv[0]; sn = cv[1]; }
    const float wq = qn[lane], wk = kn[lane];
#pragma unroll 2
    for (int slot = lat ? 0 : 8; slot < 10; ++slot) {
        const int col0 = slot < 8 ? 1024 + slot * 64 : 1536 + (slot - 8) * 64;
        const float x = bf2f(P1[(size_t)r * N1 + col0 + lane]);
        const float ss = wave_sum(x * x);
        float y = x * rsqrtf(ss * (1.f / 64.f) + EPSN) * (slot < 8 ? wq : wk);
        if (lat) { const float pr = __shfl_xor(y, 1); y = (lane & 1) ? (pr * sn + y * cs) : (y * cs - pr * sn); }
        if (slot < 8) QP[((size_t)(b * 8 + slot) * SEQ + t) * 64 + lane] = f2bf(y * (0.125f * LOG2E));
        else KP[((size_t)(b * 2 + (slot - 8)) * POSN + row_pos(r)) * 64 + lane] = f2bf(y);
    }
}

constexpr size_t WS_CARRY0 = 246 * MiB;
constexpr int S5_NCOL = 272;

DI void s5_lambar_pow(double lre, double lim, double dt, int e, double& pr, double& pi) { const double mag = exp(lre * dt * e), ang = lim * dt * e; pr = mag * cos(ang); pi = mag * sin(ang); }
DI void s5_tables_unit(int e, const float* lam_re, const float* lam_im, const float* log_dt, const float* b_re, const float* b_im, const float* c_re, const float* c_im,
                       bf16_t* W16, bf16_t* WC, bf16_t* KT, float* L16) {
    if (e < 65536) {
        const int t = e & 15, p = (e >> 4) & 63, dir = (e >> 10) & 1, g = e >> 11, gi = dir * 32 + g;
        const double lre = lam_re[gi * 64 + p], lim = lam_im[gi * 64 + p], dt = exp((double)log_dt[gi]);
        double l1r, l1i; s5_lambar_pow(lre, lim, dt, 1, l1r, l1i);
        const double nr = l1r - 1.0, ni = l1i, den = lre * lre + lim * lim, cfr = (nr * lre + ni * lim) / den, cfi = (ni * lre - nr * lim) / den;
        double p1r, p1i, p2r, p2i; s5_lambar_pow(lre, lim, dt, dir == 0 ? 15 - t : t, p1r, p1i); s5_lambar_pow(lre, lim, dt, (dir == 0 ? t : 15 - t) + 1, p2r, p2i);
        const double zr = p1r * cfr - p1i * cfi, zi = p1r * cfi + p1i * cfr;
        bf16_t* w0 = W16 + ((size_t)(g * 2 + dir) * 128 + 2 * p) * 256 + t * 16;
#pragma unroll 4
        for (int h = 0; h < 16; ++h) { const double br = b_re[(gi * 64 + p) * 16 + h], bi = b_im[(gi * 64 + p) * 16 + h]; w0[h] = f2bf((float)(zr * br - zi * bi)); w0[256 + h] = f2bf((float)(zr * bi + zi * br)); }
        bf16_t* c0 = WC + ((size_t)(g * 2 + dir) * 256 + t * 16) * 128 + 2 * p;
#pragma unroll 4
        for (int h = 0; h < 16; ++h) { const double cr = c_re[(gi * 16 + h) * 64 + p], ci = c_im[(gi * 16 + h) * 64 + p];
            *(unsigned*)(c0 + (size_t)h * 128) = pk2((float)(cr * p2r - ci * p2i), (float)(-(cr * p2i + ci * p2r))); }
    } else if (e < 65536 + 16384) {
        const int q = e - 65536, ho = q & 15, tau = (q >> 4) & 15, dir = (q >> 8) & 1, g = q >> 9, gi = dir * 32 + g;
        const double dt = exp((double)log_dt[gi]);
        double acc[16];
#pragma unroll
        for (int h = 0; h < 16; ++h) acc[h] = 0.0;
        for (int p = 0; p < 64; ++p) {
            const double lre = lam_re[gi * 64 + p], lim = lam_im[gi * 64 + p];
            double l1r, l1i, pr, pi; s5_lambar_pow(lre, lim, dt, 1, l1r, l1i); s5_lambar_pow(lre, lim, dt, tau, pr, pi);
            const double nr = l1r - 1.0, ni = l1i, den = lre * lre + lim * lim, cfr = (nr * lre + ni * lim) / den, cfi = (ni * lre - nr * lim) / den;
            const double cr = c_re[(gi * 16 + ho) * 64 + p], ci = c_im[(gi * 16 + ho) * 64 + p];
            const double ar = cr * pr - ci * pi, ai = cr * pi + ci * pr;
            const double zr = ar * cfr - ai * cfi, zi = ar * cfi + ai * cfr;
#pragma unroll
            for (int h = 0; h < 16; ++h) acc[h] += zr * b_re[(gi * 64 + p) * 16 + h] - zi * b_im[(gi * 64 + p) * 16 + h];
        }
        bf16_t* kt = KT + ((size_t)((g * 2 + dir) * 16 + tau) * 16 + ho) * 16;
#pragma unroll
        for (int h = 0; h < 16; ++h) kt[h] = f2bf((float)acc[h]);
    } else {
        const int q = e - 65536 - 16384, p = q & 63, dir = (q >> 6) & 1, g = q >> 7, gi = dir * 32 + g;
        double pr, pi; s5_lambar_pow(lam_re[gi * 64 + p], lam_im[gi * 64 + p], exp((double)log_dt[gi]), 16, pr, pi);
        L16[((g * 2 + dir) * 64 + p) * 2] = (float)pr; L16[((g * 2 + dir) * 64 + p) * 2 + 1] = (float)pi;
    }
}
constexpr int S5_TABLE_UNITS = 65536 + 16384 + 4096;

DI int s5_tile_row0(int b, int s) { return s == 0 ? NLAT + b * LC : b * SEQ + (s - 1) * 256; }
DI void cmul(float ar, float ai, float br, float bi, float& cr, float& ci) { cr = ar * br - ai * bi; ci = ar * bi + ai * br; }

DI void s5_scan_unit(int unit, const bf16_t* PROJ, const bf16_t* W16, const float* L16, bf16_t* CARRY0, bf16_t* CARRY1, int lane) {
    const int wl = unit & 3, dir = (unit >> 2) & 1, b = (unit >> 3) & 3, g = unit >> 5;
    const int n = lane & 15, q = lane >> 4;
    bf16x8_t wf[2][8];
#pragma unroll
    for (int m2 = 0; m2 < 2; ++m2)
#pragma unroll
        for (int ks = 0; ks < 8; ++ks) wf[m2][ks] = *(const bf16x8_t*)(W16 + ((size_t)(g * 2 + dir) * 128 + (2 * wl + m2) * 16 + n) * 256 + 32 * ks + 8 * q);
    float Lr[2][2][5], Li[2][2][5];
    float Lnr[2][2], Lni[2][2];
    float cr[2][2], ci[2][2];
#pragma unroll
    for (int m2 = 0; m2 < 2; ++m2)
#pragma unroll
        for (int st = 0; st < 2; ++st) { const int p = 8 * (2 * wl + m2) + 2 * q + st;
            Lr[m2][st][0] = L16[((g * 2 + dir) * 64 + p) * 2]; Li[m2][st][0] = L16[((g * 2 + dir) * 64 + p) * 2 + 1];
#pragma unroll
            for (int k = 1; k < 5; ++k) cmul(Lr[m2][st][k - 1], Li[m2][st][k - 1], Lr[m2][st][k - 1], Li[m2][st][k - 1], Lr[m2][st][k], Li[m2][st][k]);
            float rr = 1.f, ri = 0.f;
#pragma unroll
            for (int k = 0; k < 5; ++k) if ((n + 1) & (1 << k)) { float tr, ti; cmul(rr, ri, Lr[m2][st][k], Li[m2][st][k], tr, ti); rr = tr; ri = ti; }
            Lnr[m2][st] = rr; Lni[m2][st] = ri; cr[m2][st] = 0.f; ci[m2][st] = 0.f; }
    bf16_t* CARRY = (dir == 0 ? CARRY0 : CARRY1) + (size_t)(b * 32 + g) * S5_NCOL * 128;
    const int jcol = dir == 0 ? n : 15 - n;
#pragma unroll 1
    for (int it = 0; it < 17; ++it) {
        const int s = it == 0 ? 0 : (dir == 0 ? it : 17 - it);
        const bf16_t* ub = PROJ + (size_t)(s5_tile_row0(b, s) + jcol * 16 + (q >> 1)) * N0 + g * 16 + 8 * (q & 1);
        bf16x8_t uf[8];
#pragma unroll
        for (int ks = 0; ks < 8; ++ks) uf[ks] = *(const bf16x8_t*)(ub + (size_t)(2 * ks) * N0);
        f32x4_t acc[2] = {{0.f, 0.f, 0.f, 0.f}, {0.f, 0.f, 0.f, 0.f}};
#pragma unroll
        for (int ks = 0; ks < 8; ++ks) { acc[0] = __builtin_amdgcn_mfma_f32_16x16x32_bf16(wf[0][ks], uf[ks], acc[0], 0, 0, 0); acc[1] = __builtin_amdgcn_mfma_f32_16x16x32_bf16(wf[1][ks], uf[ks], acc[1], 0, 0, 0); }
#pragma unroll
        for (int m2 = 0; m2 < 2; ++m2) {
            float hin[4];
#pragma unroll
            for (int st = 0; st < 2; ++st) {
                float xr = acc[m2][2 * st], xi = acc[m2][2 * st + 1];
#pragma unroll
                for (int k = 0; k < 4; ++k) { const int d = 1 << k; const float yr = __shfl_up(xr, d, 16), yi = __shfl_up(xi, d, 16);
                    if (n >= d) { float tr, ti; cmul(Lr[m2][st][k], Li[m2][st][k], yr, yi, tr, ti); xr += tr; xi += ti; } }
                float tr, ti; cmul(Lnr[m2][st], Lni[m2][st], cr[m2][st], ci[m2][st], tr, ti);
                const float Hr = xr + tr, Hi = xi + ti;
                const float pr = __shfl_up(Hr, 1, 16), pi = __shfl_up(Hi, 1, 16);
                hin[2 * st] = n == 0 ? cr[m2][st] : pr; hin[2 * st + 1] = n == 0 ? ci[m2][st] : pi;
                cr[m2][st] = __shfl(Hr, (lane & 48) | 15); ci[m2][st] = __shfl(Hi, (lane & 48) | 15);
            }
            v2u w; w.x = pk2(hin[0], hin[1]); w.y = pk2(hin[2], hin[3]);
            *(v2u*)(CARRY + (size_t)(s * 16 + jcol) * 128 + (2 * wl + m2) * 16 + 4 * q) = w;
        }
    }
}

DI void s5_out_item(int g, int b, int s, const bf16_t* PROJ, const bf16_t* WC, const bf16_t* CARRY0, const bf16_t* CARRY1, const float* dsk, bf16_t* YPRE, LAS unsigned char* lds, int wave, int lane) {
    const int n = lane & 15, q = lane >> 4;
    const int row0 = s5_tile_row0(b, s);
    const bf16_t* ub = PROJ + (size_t)(row0 + n * 16 + (q >> 1)) * N0 + g * 16 + 8 * (q & 1);
    bf16x8_t uf[8];
#pragma unroll
    for (int ks = 0; ks < 8; ++ks) uf[ks] = *(const bf16x8_t*)(ub + (size_t)(2 * ks) * N0);
    bf16x8_t cf[2][4];
#pragma unroll
    for (int dir = 0; dir < 2; ++dir)
#pragma unroll
        for (int ks = 0; ks < 4; ++ks) cf[dir][ks] = *(const bf16x8_t*)((dir == 0 ? CARRY0 : CARRY1) + ((size_t)(b * 32 + g) * S5_NCOL + s * 16 + n) * 128 + 32 * ks + 8 * q);
    const LAS bf16_t* KTl = (const LAS bf16_t*)lds;
#pragma unroll
    for (int m2 = 0; m2 < 2; ++m2) {
        const int mt = 2 * wave + m2;
        f32x4_t acc = {0.f, 0.f, 0.f, 0.f};
#pragma unroll
        for (int dir = 0; dir < 2; ++dir) {
            const bf16_t* wc = WC + ((size_t)(g * 2 + dir) * 256 + mt * 16 + n) * 128 + 8 * q;
#pragma unroll
            for (int ks = 0; ks < 4; ++ks) { const bf16x8_t a = *(const bf16x8_t*)(wc + 32 * ks); acc = __builtin_amdgcn_mfma_f32_16x16x32_bf16(a, cf[dir][ks], acc, 0, 0, 0); }
#pragma unroll
            for (int ks = 0; ks < 8; ++ks) {
                const bool need = dir == 0 ? (2 * ks <= mt) : (2 * ks + 1 >= mt);
                if (need) { const int tp = 2 * ks + (q >> 1), tau = dir == 0 ? mt - tp : tp - mt;
                    bf16x8_t a = {0, 0, 0, 0, 0, 0, 0, 0};
                    if (tau >= 0) a = *(const LAS bf16x8_t*)(KTl + ((dir * 16 + tau) * 16 + n) * 16 + 8 * (q & 1));
                    acc = __builtin_amdgcn_mfma_f32_16x16x32_bf16(a, uf[ks], acc, 0, 0, 0); }
            }
        }
        const size_t tok = (size_t)(row0 + n * 16 + mt);
        const v2u uu = *(const v2u*)(PROJ + tok * N0 + g * 16 + 4 * q);
        const f32x4_t dd = *(const f32x4_t*)(dsk + g * 16 + 4 * q);
        const float y0 = gelu_fast(acc[0] + dd[0] * bflo(uu.x)), y1 = gelu_fast(acc[1] + dd[1] * bfhi(uu.x)), y2 = gelu_fast(acc[2] + dd[2] * bflo(uu.y)), y3 = gelu_fast(acc[3] + dd[3] * bfhi(uu.y));
        v2u w; w.x = pk2(y0, y1); w.y = pk2(y2, y3);
        *(v2u*)(YPRE + tok * 512 + g * 16 + 4 * q) = w;
    }
}

#include <hip/hip_bf16.h>
namespace gqa_body {
using bf16=__hip_bfloat16;
using bf16x8=__attribute__((ext_vector_type(8)))short;
using s16x4=__attribute__((ext_vector_type(4)))short;
using f32x16=__attribute__((ext_vector_type(16)))float;
using u32x4=__attribute__((ext_vector_type(4)))unsigned;
constexpr int NHEAD=8,SEQQ=4096,SKV=4352,D=64,QPITCH=64,KPITCH=64,VPITCH=64,OPITCH=1024,GPITCH=2304;
constexpr int NW=8,QBLK=32,QB=QBLK*NW,KVBLK=64,NQB=SEQQ/QB,NTILES=SKV/KVBLK;
constexpr int ATTN_UNIT_ROWS=QB;
__device__ __forceinline__ int crow(int r,int hi){return (r&3)+8*(r>>2)+4*hi;}
#define SBAR() __builtin_amdgcn_sched_barrier(0)
constexpr int NSLOT=3, SLOTB=8192;
constexpr int LDS_K=0, LDS_V=NSLOT*SLOTB, LDS_WS=2*NSLOT*SLOTB, LDS_OST=LDS_WS+NW*64*4, LDS_BYTES=LDS_OST+NW*4096;
constexpr float C2=0.125f*1.4426950408889634f;
__device__ __forceinline__ void glds16(const void*gsrc,unsigned lds_dst){unsigned keep;
  asm volatile("s_mov_b32 %0, m0\n\ts_mov_b32 m0, %2\n\ts_nop 0\n\tglobal_load_lds_dwordx4 %1, off\n\ts_mov_b32 m0, %0":"=&s"(keep):"v"(gsrc),"s"(lds_dst):"memory");}
__device__ __forceinline__ float max3f(float a,float b,float c){float r;asm("v_max3_f32 %0, %1, %2, %3":"=v"(r):"v"(a),"v"(b),"v"(c));return r;}
__device__ __forceinline__ float max2f(float a,float b){float r;asm("v_max_f32_e32 %0, %1, %2":"=v"(r):"v"(a),"v"(b));return r;}
__device__ __forceinline__ float fadd_s(float a,float b){float r;asm("v_add_f32_e32 %0, %1, %2":"=v"(r):"v"(a),"v"(b));return r;}
__device__ __forceinline__ float fsub_s(float a,float b){float r;asm("v_sub_f32_e32 %0, %1, %2":"=v"(r):"v"(a),"v"(b));return r;}
typedef float f32x2_t __attribute__((ext_vector_type(2))); typedef __bf16 bf16x2_t __attribute__((ext_vector_type(2)));
__device__ __forceinline__ unsigned cvtpk_s(float lo,float hi){f32x2_t v={lo,hi};bf16x2_t b=__builtin_convertvector(v,bf16x2_t);return __builtin_bit_cast(unsigned,b);}
#define WAIT_BAR(N) asm volatile("s_waitcnt vmcnt(" #N ") lgkmcnt(0)\n\ts_barrier":::"memory")

__device__ __forceinline__ void qkt(f32x16&p0,f32x16&p1,const char*Kslot,const bf16x8*qr,const f32x16&negm,int r32,int hi){
  const char*kb=Kslot+hi*1024+r32*16;
  #pragma unroll
  for(int d0=0;d0<4;++d0){
    const bf16x8 b0=*reinterpret_cast<const bf16x8*>(kb+d0*2048);
    const bf16x8 b1=*reinterpret_cast<const bf16x8*>(kb+d0*2048+512);
    if(d0==0){p0=__builtin_amdgcn_mfma_f32_32x32x16_bf16(b0,qr[0],negm,0,0,0);p1=__builtin_amdgcn_mfma_f32_32x32x16_bf16(b1,qr[0],negm,0,0,0);}
    else{p0=__builtin_amdgcn_mfma_f32_32x32x16_bf16(b0,qr[d0],p0,0,0,0);p1=__builtin_amdgcn_mfma_f32_32x32x16_bf16(b1,qr[d0],p1,0,0,0);}}
}
typedef __attribute__((address_space(3))) const char* lds_cptr;
typedef short v4i16_t __attribute__((ext_vector_type(4)));
__device__ __forceinline__ void kload8(bf16x8*kf,lds_cptr kp){
  kf[0]=*(const __attribute__((address_space(3))) bf16x8*)(kp);      kf[1]=*(const __attribute__((address_space(3))) bf16x8*)(kp+512);
  kf[2]=*(const __attribute__((address_space(3))) bf16x8*)(kp+2048); kf[3]=*(const __attribute__((address_space(3))) bf16x8*)(kp+2560);
  kf[4]=*(const __attribute__((address_space(3))) bf16x8*)(kp+4096); kf[5]=*(const __attribute__((address_space(3))) bf16x8*)(kp+4608);
  kf[6]=*(const __attribute__((address_space(3))) bf16x8*)(kp+6144); kf[7]=*(const __attribute__((address_space(3))) bf16x8*)(kp+6656);
}
__device__ __forceinline__ void kload2(bf16x8*kf,lds_cptr kp,int j){ kf[2*j]=*(const __attribute__((address_space(3))) bf16x8*)(kp+j*2048); kf[2*j+1]=*(const __attribute__((address_space(3))) bf16x8*)(kp+j*2048+512); }
__device__ __forceinline__ s16x4 vtr(lds_cptr p){ return __builtin_bit_cast(s16x4,__builtin_amdgcn_ds_read_tr16_b64_v4i16((__attribute__((address_space(3))) v4i16_t*)p)); }
__device__ __forceinline__ float rowmax(const f32x16&p0,const f32x16&p1){
  float a=max3f(p0[0],p0[1],p1[0]),b=max3f(p0[2],p0[3],p1[1]);a=max3f(a,p1[2],p1[3]);
  #pragma unroll
  for(int r=4;r<16;r+=4){a=max3f(a,p0[r],p0[r+1]);b=max3f(b,p0[r+2],p0[r+3]);a=max3f(a,p1[r],p1[r+1]);b=max3f(b,p1[r+2],p1[r+3]);}
  const float m=max2f(a,b);
  auto rr=__builtin_amdgcn_permlane32_swap(__float_as_uint(m),__float_as_uint(m),false,false);
  return max2f(__uint_as_float(rr[0]),__uint_as_float(rr[1]));
}
__device__ __forceinline__ void pv(f32x16*o,int vb,bf16x8 pa0,bf16x8 pa1,bf16x8 pa2,bf16x8 pa3){
  #pragma unroll
  for(int d0=0;d0<2;++d0){s16x4 lo[4],hi[4];
    #pragma unroll
    for(int ks=0;ks<4;++ks){
      asm volatile("ds_read_b64_tr_b16 %0,%1 offset:%c2":"=&v"(lo[ks]):"v"(vb),"i"(d0*4096+ks*1024):"memory");
      asm volatile("ds_read_b64_tr_b16 %0,%1 offset:%c2":"=&v"(hi[ks]):"v"(vb),"i"(d0*4096+ks*1024+512):"memory");}
    asm volatile("s_waitcnt lgkmcnt(0)":::"memory");SBAR();
    #define PK(k) (bf16x8){lo[k][0],lo[k][1],lo[k][2],lo[k][3],hi[k][0],hi[k][1],hi[k][2],hi[k][3]}
    o[d0]=__builtin_amdgcn_mfma_f32_32x32x16_bf16(pa0,PK(0),o[d0],0,0,0);
    o[d0]=__builtin_amdgcn_mfma_f32_32x32x16_bf16(pa1,PK(1),o[d0],0,0,0);
    o[d0]=__builtin_amdgcn_mfma_f32_32x32x16_bf16(pa2,PK(2),o[d0],0,0,0);
    o[d0]=__builtin_amdgcn_mfma_f32_32x32x16_bf16(pa3,PK(3),o[d0],0,0,0);
    #undef PK
  }
}

#ifndef ATTN_STORE16
#define ATTN_STORE16(p,v) (*(u32x4*)(p)=(v))
#endif
template<int THRL> __device__ __forceinline__ void attn_unit(int b,int h,int qb,const bf16*Q,const bf16*__restrict__ K,const bf16*__restrict__ V,bf16*O,const bf16*Gt,char*shm){
  const int tid=threadIdx.x,lane=tid&63,r32=lane&31,hi=lane>>5; const int wid=__builtin_amdgcn_readfirstlane(tid>>6);
  const int q0=qb*QB;
  const bf16*Qw=Q+((long)(b*NHEAD+h)*SEQQ+q0+wid*QBLK)*QPITCH;
  const bf16*Kh=K+(long)(b*2+(h>>2))*SKV*KPITCH,*Vh=V+(long)(b*2+(h>>2))*SKV*VPITCH;
  const unsigned lds0=(unsigned)(uintptr_t)shm;
  float*wsf=(float*)(shm+LDS_WS)+wid*64;
  const bf16*ksrc=Kh+(long)lane*KPITCH+wid*8;
  const bf16*vsrc=Vh+(long)(16*(wid&3)+(lane>>2))*VPITCH+(wid>>2)*32+(lane&3)*8;
  const unsigned kdst=lds0+LDS_K+wid*1024, vdst=lds0+LDS_V+wid*1024;
  #define DMA_K(t,slot) glds16(ksrc+(long)(t)*KVBLK*KPITCH,(unsigned)__builtin_amdgcn_readfirstlane(kdst+(slot)))
  #define DMA_V(t,slot) glds16(vsrc+(long)(t)*KVBLK*VPITCH,(unsigned)__builtin_amdgcn_readfirstlane(vdst+(slot)))
  const int vb0=(int)(lds0+LDS_V)+((lane>>4)&1)*32+(lane&3)*8+(4*hi+((lane&15)>>2))*64;
  const char*Kbase=shm+LDS_K; bf16x8 kf[8];
  const lds_cptr shm3=(lds_cptr)shm; const lds_cptr kp0=shm3+LDS_K+hi*1024+r32*16; const lds_cptr vp0=shm3+LDS_V+((lane>>4)&1)*32+(lane&3)*8+(4*hi+((lane&15)>>2))*64;
  constexpr int NT=NTILES;
  DMA_K(0,0);DMA_V(0,0);DMA_K(1,SLOTB);
  bf16x8 qr[4];
  #pragma unroll
  for(int d0=0;d0<4;++d0)qr[d0]=*reinterpret_cast<const bf16x8*>(&Qw[(long)r32*QPITCH+d0*16+hi*8]);
  float mhat=0.f,l_reg=0.f;f32x16 o[2];o[0]=f32x16{};o[1]=f32x16{};f32x16 negm=f32x16{};asm volatile("":"+v"(negm));
  #define CMASK(P0,P1,t) do{}while(0)
  bool resc=false;
  #define START(P0,P1) do{ const float rm=rowmax(P0,P1); resc=false; \
    { const float dl=rm; mhat=fadd_s(mhat,dl); \
      _Pragma("unroll") for(int r=0;r<16;++r){P0[r]=fsub_s(P0[r],dl);P1[r]=fsub_s(P1[r],dl);} \
      _Pragma("unroll") for(int r=0;r<16;++r)negm[r]=-mhat; asm volatile("":"+v"(negm)); } \
    _Pragma("unroll") for(int r=0;r<16;++r)P0[r]=__builtin_amdgcn_exp2f(P0[r]); }while(0)
  #define RESC() do{ if(resc){ asm volatile("s_waitcnt lgkmcnt(0)":::"memory"); \
      _Pragma("unroll") for(int d_=0;d_<2;++d_) _Pragma("unroll") for(int r=0;r<16;++r)o[d_][r]*=wsf[crow(r,hi)]; } }while(0)
  f32x16 pA0,pA1,pB0,pB1;
  int sl_prev=0,sl_cur=0,sl_next=SLOTB;
  #define ROT() do{sl_prev=sl_cur;sl_cur=sl_next;sl_next=(sl_next==(NSLOT-1)*SLOTB)?0:sl_next+SLOTB;}while(0)
  DMA_K(2,2*SLOTB);
  WAIT_BAR(3);
  qkt(pA0,pA1,Kbase,qr,negm,r32,hi);asm volatile("s_nop 15\n\ts_nop 7":"+v"(pA0),"+v"(pA1));CMASK(pA0,pA1,0);
  START(pA0,pA1);
  _Pragma("unroll") for(int r=0;r<16;++r)pA1[r]=__builtin_amdgcn_exp2f(pA1[r]);
  WAIT_BAR(0);
  DMA_K(3,0);DMA_V(1,SLOTB);
  ROT();
  kload8(kf,kp0+sl_cur);
  WAIT_BAR(2);
  s16x4 vlo[8],vhi[8]; u32x4 pw0,pw1,pw2,pw3;
  #define PKW(P,B) cvtpk_s(P[B],P[B+1])
  #define PAF(k) __builtin_bit_cast(bf16x8,pw##k)
  #define VFR(i) (bf16x8){vlo[i][0],vlo[i][1],vlo[i][2],vlo[i][3],vhi[i][0],vhi[i][1],vhi[i][2],vhi[i][3]}
  #define PIN(x) asm volatile("":"+v"(x))
  #define MX3(a,b,c) __builtin_fmaxf(__builtin_fmaxf((a),(b)),(c))
  #define GAPA(MF,A0,A1,A2,A3,W0,W1,PW) do{ MF; sacc+=A0; sacc+=A1; sacc+=A2; sacc+=A3; PIN(sacc); W0; W1; PIN(PW); SBAR(); }while(0)
  #define EX(v) __builtin_amdgcn_exp2f(v)
  #define GAPB(MF,X,B) do{ MF; X[B]=EX(X[B]); X[B+1]=EX(X[B+1]); X[B+2]=EX(X[B+2]); X[B+3]=EX(X[B+3]); PIN(X); SBAR(); }while(0)
  #define VRD(i) do{ vlo[i]=vtr(vp_+(((i)>>2)*4096+((i)&3)*1024)); vhi[i]=vtr(vp_+(((i)>>2)*4096+((i)&3)*1024+512)); }while(0)
  #define KRD(G,j) do{ if(G){ kload2(kf,kp0+sl_next,j); SBAR(); } }while(0)
  #define STEP(C0,C1,P0,P1,t,GK,GV,GL) do{ SBAR(); \
    const lds_cptr vp_=vp0+sl_prev; \
    VRD(0); SBAR(); float sacc=(P0[0]+P0[1]); \
    GAPA(C0=__builtin_amdgcn_mfma_f32_32x32x16_bf16(kf[0],qr[0],negm,0,0,0), P0[2],P0[3],P0[4],P0[5],     pw0[0]=PKW(P0,0), pw0[1]=PKW(P0,2), pw0); \
    VRD(4); SBAR(); GAPA(C1=__builtin_amdgcn_mfma_f32_32x32x16_bf16(kf[1],qr[0],negm,0,0,0), P0[6],P0[7],P0[8],P0[9],     pw0[2]=PKW(P0,4), pw0[3]=PKW(P0,6), pw0); \
    VRD(1); SBAR(); GAPA(C0=__builtin_amdgcn_mfma_f32_32x32x16_bf16(kf[2],qr[1],C0,0,0,0),   P0[10],P0[11],P0[12],P0[13], pw1[0]=PKW(P0,8), pw1[1]=PKW(P0,10), pw1); \
    VRD(5); SBAR(); GAPA(C1=__builtin_amdgcn_mfma_f32_32x32x16_bf16(kf[3],qr[1],C1,0,0,0),   P0[14],P0[15],P1[0],P1[1],   pw1[2]=PKW(P0,12),pw1[3]=PKW(P0,14), pw1); \
    VRD(2); SBAR(); GAPA(C0=__builtin_amdgcn_mfma_f32_32x32x16_bf16(kf[4],qr[2],C0,0,0,0),   P1[2],P1[3],P1[4],P1[5],     pw2[0]=PKW(P1,0), pw2[1]=PKW(P1,2), pw2); \
    VRD(6); SBAR(); GAPA(C1=__builtin_amdgcn_mfma_f32_32x32x16_bf16(kf[5],qr[2],C1,0,0,0),   P1[6],P1[7],P1[8],P1[9],     pw2[2]=PKW(P1,4), pw2[3]=PKW(P1,6), pw2); \
    VRD(3); SBAR(); GAPA(C0=__builtin_amdgcn_mfma_f32_32x32x16_bf16(kf[6],qr[3],C0,0,0,0),   P1[10],P1[11],P1[12],P1[13], pw3[0]=PKW(P1,8), pw3[1]=PKW(P1,10), pw3); \
    VRD(7); SBAR(); GAPA(C1=__builtin_amdgcn_mfma_f32_32x32x16_bf16(kf[7],qr[3],C1,0,0,0),   P1[14],P1[15],0.f,0.f,       pw3[2]=PKW(P1,12),pw3[3]=PKW(P1,14), pw3); \
    l_reg+=sacc; \
    if(GK){DMA_K((t)+3,sl_cur);} if(GV){DMA_V((t)+1,sl_next);} \
    CMASK(C0,C1,t); \
    { float a=MX3(C0[0],C0[1],C1[0]),b=MX3(C0[2],C0[3],C1[1]); a=MX3(a,C1[2],C1[3]); \
      _Pragma("unroll") for(int r=4;r<16;r+=4){a=MX3(a,C0[r],C0[r+1]);b=MX3(b,C0[r+2],C0[r+3]);a=MX3(a,C1[r],C1[r+1]);b=MX3(b,C1[r+2],C1[r+3]);} \
      float rm=__builtin_fmaxf(a,b); { auto rr=__builtin_amdgcn_permlane32_swap(__float_as_uint(rm),__float_as_uint(rm),false,false); rm=__builtin_fmaxf(__uint_as_float(rr[0]),__uint_as_float(rr[1])); } \
      resc=false; \
      if(__builtin_expect(__any(rm>(float)THRL),0)){ const float dl=__builtin_fmaxf(rm,0.f); mhat+=dl; \
        _Pragma("unroll") for(int r=0;r<16;++r){C0[r]-=dl;C1[r]-=dl;} \
        _Pragma("unroll") for(int r=0;r<16;++r)negm[r]=-mhat; asm volatile("":"+v"(negm)); \
        const float f=__builtin_amdgcn_exp2f(-dl); l_reg*=f; if(hi==0)wsf[r32]=f; resc=true; } } \
    SBAR(); \
    GAPB(o[0]=__builtin_amdgcn_mfma_f32_32x32x16_bf16(PAF(0),VFR(0),o[0],0,0,0), C0,0); \
    GAPB(o[1]=__builtin_amdgcn_mfma_f32_32x32x16_bf16(PAF(0),VFR(4),o[1],0,0,0), C0,4); \
    KRD(GL,0); GAPB(o[0]=__builtin_amdgcn_mfma_f32_32x32x16_bf16(PAF(1),VFR(1),o[0],0,0,0), C0,8); \
    KRD(GL,1); GAPB(o[1]=__builtin_amdgcn_mfma_f32_32x32x16_bf16(PAF(1),VFR(5),o[1],0,0,0), C0,12); \
    KRD(GL,2); GAPB(o[0]=__builtin_amdgcn_mfma_f32_32x32x16_bf16(PAF(2),VFR(2),o[0],0,0,0), C1,0); \
    KRD(GL,3); GAPB(o[1]=__builtin_amdgcn_mfma_f32_32x32x16_bf16(PAF(2),VFR(6),o[1],0,0,0), C1,4); \
    GAPB(o[0]=__builtin_amdgcn_mfma_f32_32x32x16_bf16(PAF(3),VFR(3),o[0],0,0,0), C1,8); \
    GAPB(o[1]=__builtin_amdgcn_mfma_f32_32x32x16_bf16(PAF(3),VFR(7),o[1],0,0,0), C1,12); \
    }while(0)
  int t=1;
  #undef CMASK
  #define CMASK(P0,P1,t) do{}while(0)
  for(;t+5<NT;t+=2){
    STEP(pB0,pB1,pA0,pA1,t,true,true,true);     WAIT_BAR(2); RESC(); ROT();
    STEP(pA0,pA1,pB0,pB1,t+1,true,true,true);   WAIT_BAR(2); RESC(); ROT();
  }
  #undef CMASK
  #define CMASK(P0,P1,t) do{}while(0)
  #define ENDW(tt) do{ if((tt)+3<NT){WAIT_BAR(2);} else if((tt)+2<NT){WAIT_BAR(1);} else {WAIT_BAR(0);} }while(0)
  for(;t+1<NT;t+=2){
    STEP(pB0,pB1,pA0,pA1,t,(t+3<NT),(t+1<NT),(t+1<NT));       ENDW(t);   RESC(); ROT();
    STEP(pA0,pA1,pB0,pB1,t+1,(t+4<NT),(t+2<NT),(t+2<NT));     ENDW(t+1); RESC(); ROT();
  }
  STEP(pB0,pB1,pA0,pA1,NT-1,false,false,false); RESC();
  { float sacc=pB0[0]+pB0[1]; _Pragma("unroll") for(int r=2;r<16;++r)sacc+=pB0[r]; _Pragma("unroll") for(int r=0;r<16;++r)sacc+=pB1[r]; l_reg+=sacc;
    pw0=(u32x4){PKW(pB0,0),PKW(pB0,2),PKW(pB0,4),PKW(pB0,6)};pw1=(u32x4){PKW(pB0,8),PKW(pB0,10),PKW(pB0,12),PKW(pB0,14)};pw2=(u32x4){PKW(pB1,0),PKW(pB1,2),PKW(pB1,4),PKW(pB1,6)};pw3=(u32x4){PKW(pB1,8),PKW(pB1,10),PKW(pB1,12),PKW(pB1,14)};
    SBAR(); pv(o,vb0+sl_cur,PAF(0),PAF(1),PAF(2),PAF(3)); }
  #undef PKW
  #undef PAF
  #undef VFR
  #undef PIN
  #undef MX3
  #undef GAPA
  #undef GAPB
  #undef EX
  #undef VRD
  #undef KRD
  #undef STEP
  #undef ENDW
  {auto rr=__builtin_amdgcn_permlane32_swap(__float_as_uint(l_reg),__float_as_uint(l_reg),false,false);l_reg=__uint_as_float(rr[0])+__uint_as_float(rr[1]);}
  if(hi==0)wsf[32+r32]=l_reg;asm volatile("s_waitcnt lgkmcnt(0)":::"memory");
  float rli[16];
  #pragma unroll
  for(int r=0;r<16;++r)rli[r]=__builtin_amdgcn_rcpf(wsf[32+crow(r,hi)]);
  bf16*Ow=O+((long)b*SEQQ+q0+wid*QBLK)*OPITCH+h*D; const bf16*Gw=Gt+((long)b*SEQQ+q0+wid*QBLK)*GPITCH+h*D;
  { bf16*stg=(bf16*)(shm+LDS_OST)+wid*2048;
    #pragma unroll
    for(int r=0;r<16;++r){const int orow=crow(r,hi);
      #pragma unroll
      for(int d0=0;d0<2;++d0)stg[orow*64+d0*32+r32]=__float2bfloat16(o[d0][r]*rli[r]);}
    asm volatile("s_waitcnt lgkmcnt(0)":::"memory");
    #pragma unroll
    for(int i=0;i<4;++i){const int row=i*8+(lane>>3),ch=lane&7; const u32x4 v=*(const u32x4*)(stg+row*64+ch*8); const u32x4 gv=*(const u32x4*)(Gw+(long)row*GPITCH+ch*8); u32x4 w;
      w.x=pk2(bflo(v.x)*silu_f(bflo(gv.x)),bfhi(v.x)*silu_f(bfhi(gv.x))); w.y=pk2(bflo(v.y)*silu_f(bflo(gv.y)),bfhi(v.y)*silu_f(bfhi(gv.y)));
      w.z=pk2(bflo(v.z)*silu_f(bflo(gv.z)),bfhi(v.z)*silu_f(bfhi(gv.z))); w.w=pk2(bflo(v.w)*silu_f(bflo(gv.w)),bfhi(v.w)*silu_f(bfhi(gv.w)));
      ATTN_STORE16(Ow+(long)row*OPITCH+ch*8,w);} }
  asm volatile("s_waitcnt lgkmcnt(0)\n\ts_barrier":::"memory");
  #undef DMA_K
  #undef DMA_V
  #undef CMASK
  #undef START
  #undef RESC
  #undef ROT
}
constexpr int ATTN_LDS_BYTES=LDS_BYTES;
#undef SBAR
#undef WAIT_BAR
}

struct Args { const float* in[32]; float* out; unsigned char* ws; int ph_lo, ph_hi, li, pad; };
constexpr int CW_NAQ = 2048;
constexpr int NA_UNITS = 4096 + 256;
DI void na_queue(const Args& args, gu32* ctl, int lane, int pass) {
    unsigned char* ws = args.ws; const bf16_t* PROJ = (const bf16_t*)(ws + WS_PROJ);
    const AttnP P{PROJ, PROJ, (const bf16_t*)(ws + WS_VT0), PROJ, (bf16_t*)(ws + WS_YMIX), args.in[20]};
    for (;;) {
        unsigned u = 0; if (lane == 0) u = __hip_atomic_fetch_add(ctl + CW_NAQ + 64 * pass, 1u, RLX_AGENT);
        u = (unsigned)__builtin_amdgcn_readfirstlane((int)u);
        if (u >= (unsigned)NA_UNITS) break;
        if (u < 4096u) attn_unit<0>((int)u, P, lane); else attn_unit<1>((int)u - 4096, P, lane);
    }
}
DI void phase3(const Args& args, LAS unsigned char* lds, int tid, int wave, int lane, int G, int pass) {
    unsigned char* ws = args.ws; gu32* ctl = (gu32*)(ws + WS_CTL);
    if (wave < 4) for (int cu = blockIdx.x; cu < 256; cu += G)
        s5_scan_unit(cu * 4 + wave, (const bf16_t*)(ws + WS_PROJ), (const bf16_t*)(ws + WS_W16), (const float*)(ws + WS_L16), (bf16_t*)(ws + WS_CARRY0), (bf16_t*)(ws + WS_CARRY1), lane);
    na_queue(args, ctl, lane, pass);
}
DI void phase4(const Args& args, LAS unsigned char* lds, int tid, int wave, int lane, int G) {
    unsigned char* ws = args.ws; gu32* ctl = (gu32*)(ws + WS_CTL);
    constexpr int NIT = 32 * 4 * 17;
    const int i0 = (int)(((long)blockIdx.x * NIT) / G), i1 = (int)(((long)(blockIdx.x + 1) * NIT) / G);
    int gcur = -1;
    for (int it = i0; it < i1; ++it) {
        const int g = it / 68, b = (it % 68) / 17, s = it % 17;
        if (g != gcur) { __syncthreads(); for (int e = tid; e < 1024; e += NTHREADS) ((LAS v4u*)lds)[e] = ((const v4u*)(ws + WS_KT))[(size_t)g * 1024 + e]; gcur = g; __syncthreads(); }
        s5_out_item(g, b, s, (const bf16_t*)(ws + WS_PROJ), (const bf16_t*)(ws + WS_WC), (const bf16_t*)(ws + WS_CARRY0), (const bf16_t*)(ws + WS_CARRY1), args.in[17], (bf16_t*)(ws + WS_YPRE), lds, wave, lane);
    }
    na_queue(args, ctl, lane, 0);
}
DI LruP make_lrup(const Args& args) { unsigned char* ws = args.ws;
    return LruP{(const bf16_t*)(ws + WS_PROJ), args.in[23], args.in[24], args.in[25], args.in[27], args.in[29], (const bf16_t*)(ws + WS_LRUWT), (f32x2_t*)(ws + WS_LSUM), (bf16_t*)(ws + WS_YMIX)}; }
DI void phase9(const Args& args, LAS unsigned char* lds, int tid, int wave, int lane, int G) {
    unsigned char* ws = args.ws; const LruP lp = make_lrup(args);
    for (int it = blockIdx.x; it < NB * LRU_NCH * 8; it += G) lru_item<false>(it, lp, lds, tid, wave, lane);
    const int gw = blockIdx.x * NWAVES + wave, NGW = G * NWAVES;
    for (int r = gw; r < MROWS; r += NGW) qkprep_row(r, (const bf16_t*)(ws + WS_PROJ), args.in[30], args.in[31], (const float*)(ws + WS_ROPE), (bf16_t*)(ws + WS_QP), (bf16_t*)(ws + WS_KP), lane);
}
DI void phase10(const Args& args, LAS unsigned char* lds, int tid, int wave, int lane, int G) {
    unsigned char* ws = args.ws;
    const LruP lp = make_lrup(args);
    for (int it = blockIdx.x; it < NB * 32 * 8; it += G) lru_item<true>(it, lp, lds, tid, wave, lane);
    __syncthreads();
    const int bx = blockIdx.x, vcu = (G % 8 == 0) ? (bx % 8) * (G / 8) + bx / 8 : bx;
    typedef gqa_body::bf16 abf;
    for (int u = vcu; u < 512; u += G) {
        const int qb = u & 15, hq = (u >> 4) & 7, b = u >> 7;
        gqa_body::attn_unit<8>(b, hq, qb, (const abf*)(ws + WS_QP), (const abf*)(ws + WS_KP), (const abf*)(ws + WS_VT1), (abf*)(ws + WS_YMIX) + 512, (const abf*)(ws + WS_PROJ) + 1792, (char*)lds);
    }
}

constexpr int RING_BYTES = 131072, LDSCTL_OFF = RING_BYTES, MISC_OFF = LDSCTL_OFF + 320, LDS_BYTES = 147456;
constexpr int CW_BAR = 4096;
constexpr int N_PHASES = 13;
constexpr bool kSP2 = true, kALIGN = true;

DI void p0_adaln(LAS unsigned char* lds, const float* c, const float* cctx, const float* ada_w, const float* ada_b, float* MOD, int tid, int wave, int lane, int G) {
    LAS float* sl = (LAS float*)lds;
    LAS float* red = (LAS float*)(lds + 5 * 1024 * 4);
    if ((int)blockIdx.x >= 192) return;
    for (int e = tid; e < 5 * 1024; e += NTHREADS) { const int r = e >> 10, k = e & 1023; const float x = r < 4 ? c[r * 1024 + k] : cctx[k]; sl[e] = silu_f(x); }
    __syncthreads();
    for (int item = blockIdx.x; item < 192; item += G) {
        const int i = item / 96, cb = item % 96, col = cb * 32 + (lane & 31), kh = lane >> 5;
        const float* W = ada_w + (size_t)i * 1024 * 3072 + col;
        float acc[5] = {0.f, 0.f, 0.f, 0.f, 0.f};
#pragma unroll 8
        for (int kk = 0; kk < 64; ++kk) { const int k = wave * 128 + 2 * kk + kh; const float w = W[(size_t)k * 3072];
#pragma unroll
            for (int r = 0; r < 5; ++r) acc[r] += sl[r * 1024 + k] * w; }
#pragma unroll
        for (int r = 0; r < 5; ++r) { acc[r] += __shfl_xor(acc[r], 32); if (lane < 32) red[(wave * 5 + r) * 32 + lane] = acc[r]; }
        __syncthreads();
        if (tid < 160) { const int r = tid >> 5, cl = tid & 31; float s = ada_b[i * 3072 + cb * 32 + cl];
#pragma unroll
            for (int w = 0; w < 8; ++w) s += red[(w * 5 + r) * 32 + cl];
            MOD[(i * 5 + r) * 3072 + cb * 32 + cl] = s; }
        __syncthreads();
    }
}
DI void p0_transpose_item(const float* W, int K, int N, bf16_t* WT, int row_off, LAS float* scr, int item, int lane) {
    const int nblk = N / 32, kb = item / nblk, nb = item % nblk, k0 = 64 * kb, n0 = 32 * nb;
#pragma unroll 8
    for (int i = 0; i < 32; ++i) { const int kk = 2 * i + (lane >> 5); scr[kk * 33 + (lane & 31)] = W[(size_t)(k0 + kk) * N + n0 + (lane & 31)]; }
    LDS_WAIT(); asm volatile("" ::: "memory");
    const int c = lane & 7;
#pragma unroll
    for (int j = 0; j < 4; ++j) { const int n = (lane >> 3) + 8 * j; const LAS float* s = scr + (8 * c) * 33 + n;
        v4u o; o.x = pk2(s[0 * 33], s[1 * 33]); o.y = pk2(s[2 * 33], s[3 * 33]); o.z = pk2(s[4 * 33], s[5 * 33]); o.w = pk2(s[6 * 33], s[7 * 33]);
        *(v4u*)(WT + (size_t)(row_off + n0 + n) * K + k0 + 8 * c) = o; }
    LDS_WAIT(); asm volatile("" ::: "memory");
}
struct TrJob { const float* W; int K, N; bf16_t* WT; int row_off; int items; };

DI void load_row16(const float* src, int lane, float (&v)[16]) {
#pragma unroll
    for (int j = 0; j < 4; ++j) { const f32x4_t t = *(const f32x4_t*)(src + j * 256 + lane * 4); v[4 * j] = t[0]; v[4 * j + 1] = t[1]; v[4 * j + 2] = t[2]; v[4 * j + 3] = t[3]; }
}
DI float row_rinv(const float (&v)[16]) {
    float ss = 0.f;
#pragma unroll
    for (int j = 0; j < 16; ++j) ss += v[j] * v[j];
    ss = wave_sum(ss);
    return rsqrtf(ss * (1.f / DM) + EPSN);
}
DI void store_modnorm(const float (&v)[16], float rinv, const float* g, const float* m, bf16_t* dst, int lane) {
#pragma unroll
    for (int j = 0; j < 4; ++j) { const int col = j * 256 + lane * 4;
        const f32x4_t gg = *(const f32x4_t*)(g + col), sc = *(const f32x4_t*)(m + 1024 + col), sh = *(const f32x4_t*)(m + col);
        float y[4];
#pragma unroll
        for (int e = 0; e < 4; ++e) y[e] = v[4 * j + e] * rinv * gg[e] * (1.f + sc[e]) + sh[e];
        v2u o; o.x = pk2(y[0], y[1]); o.y = pk2(y[2], y[3]); *(v2u*)(dst + col) = o; }
}

__global__ void __launch_bounds__(NTHREADS, 2) mega(Args args) {
    extern __shared__ __attribute__((aligned(16))) unsigned char lds_raw[];
    LAS unsigned char* lds = (LAS unsigned char*)lds_raw;
    volatile LAS unsigned* MISC = (volatile LAS unsigned*)(lds + MISC_OFF);
    const int tid = threadIdx.x, lane = tid & 63, wave = __builtin_amdgcn_readfirstlane(tid >> 6);
    const int G = gridDim.x;
    unsigned char* ws = args.ws;
    gu32* ctl = (gu32*)(ws + WS_CTL);
    for (int u = tid; u < (LDS_BYTES - LDSCTL_OFF) / 4; u += NTHREADS) ((LAS unsigned*)(lds + LDSCTL_OFF))[u] = 0u;
    __syncthreads();
    XcdBarrier bar = xcd_barrier_post((unsigned*)(ctl + CW_BAR) + args.li * XCD_BAR_WORDS, MISC + 8);
    const int lo = args.ph_lo, hi = args.ph_hi;
#define IN(k) (lo <= (k) && (k) < hi)
#ifndef PROBE_REP
#define PROBE_REP 0
#endif
#define PHASE_LOOP(k) for (int rep_ = 0, nrep_ = IN(k) ? 1 + ((PROBE_REP >> (k)) & 1) : 0; rep_ < nrep_; (++rep_ < nrep_) ? xcd_barrier(bar) : (void)0)
#define SEAM(k) do { if (IN(k) && IN((k) + 1)) xcd_barrier(bar); } while (0)

    const float* x = args.in[0]; const float* cvec = args.in[1]; const float* ctxin = args.in[2]; const float* cctx = args.in[3];
    const float* ada_w = args.in[4]; const float* ada_b = args.in[5]; const float* pre_g = args.in[6]; const float* post_g = args.in[7];
    float* out = args.out;
    float* MOD = (float*)(ws + WS_MOD);
    bf16_t* XN = (bf16_t*)(ws + WS_XN); bf16_t* YMIX = (bf16_t*)(ws + WS_YMIX); bf16_t* PROJ = (bf16_t*)(ws + WS_PROJ); float* OUTF = (float*)(ws + WS_PROJ);
    bf16_t* YPRE = (bf16_t*)(ws + WS_YPRE);
    const int gw = blockIdx.x * NWAVES + wave, NGW = G * NWAVES;

    PHASE_LOOP(0) {
        p0_adaln(lds, cvec, cctx, ada_w, ada_b, MOD, tid, wave, lane, G);
        __syncthreads();
        LAS float* scr = (LAS float*)(lds + 32768 + wave * 8704);
        const TrJob jobs[5] = {
            {args.in[8], 1024, 3072, (bf16_t*)(ws + WS_WIN0T), 0, 16 * 96}, {args.in[9], 1024, 1024, (bf16_t*)(ws + WS_WOUT0T), 0, 16 * 32},
            {args.in[21], 1024, 2304, (bf16_t*)(ws + WS_WIN1T), 0, 16 * 72}, {args.in[22], 1024, 1024, (bf16_t*)(ws + WS_WOUT1T), 0, 16 * 32},
            {args.in[18], 512, 512, (bf16_t*)(ws + WS_WGLUT), 0, 8 * 16}};
        constexpr int NBIG = 16 * 96 + 16 * 32 + 16 * 72 + 16 * 32 + 8 * 16, NLRU = 32 * 2;
        for (int it = gw; it < NBIG + NLRU; it += NGW) {
            if (it < NBIG) { int r = it;
#pragma unroll
                for (int j = 0; j < 5; ++j) { if (r >= 0 && r < jobs[j].items) p0_transpose_item(jobs[j].W, jobs[j].K, jobs[j].N, jobs[j].WT, 0, scr, r, lane); r -= jobs[j].items; }
            } else { const int q = it - NBIG, mat = q >> 1, sub = q & 1, dir = mat >> 4, gate = (mat >> 3) & 1, blk = mat & 7;
                const float* W = (gate ? args.in[28] : args.in[26]) + (size_t)(dir * 8 + blk) * 4096;
                p0_transpose_item(W, 64, 64, (bf16_t*)(ws + WS_LRUWT), blk * 256 + (dir * 2 + gate) * 64, scr, sub, lane); }
        }
    }
    PHASE_LOOP(0) {
        float* ROPE = (float*)(ws + WS_ROPE);
        for (int e = blockIdx.x * NTHREADS + tid; e < SEQ * 32; e += G * NTHREADS) { const int t = e >> 5, i = e & 31, f = i & 15; const float pos = (float)(i < 16 ? (t >> 6) : (t & 63));
            const float inv = (float)exp(-log(10000.0) * (double)(2 * f) / 32.0); const float ang = pos * inv; ROPE[2 * e] = cosf(ang); ROPE[2 * e + 1] = sinf(ang); }
    }
    PHASE_LOOP(0) {
        for (int e = blockIdx.x * NTHREADS + tid; e < S5_TABLE_UNITS; e += G * NTHREADS)
            s5_tables_unit(e, args.in[10], args.in[11], args.in[12], args.in[13], args.in[14], args.in[15], args.in[16], (bf16_t*)(ws + WS_W16), (bf16_t*)(ws + WS_WC), (bf16_t*)(ws + WS_KT), (float*)(ws + WS_L16));
    }
    SEAM(0);
    PHASE_LOOP(1) {
        for (int r = gw; r < MROWS; r += NGW) {
            const float* src = r < NLAT ? x + (size_t)r * DM : ctxin + (size_t)(r - NLAT) * DM;
            float v[16]; load_row16(src, lane, v);
            store_modnorm(v, row_rinv(v), pre_g, MOD + (r < NLAT ? (r >> 12) : 4) * 3072, XN + (size_t)r * DM, lane);
        }
    }
    SEAM(1);
    PHASE_LOOP(2) {
        pg8::Gemm g{XN, (const bf16_t*)(ws + WS_WIN0T), MROWS, N0, DM}; pg8::StaticOrder S; S.init(MROWS, N0, G, (int)blockIdx.x);
        pg8::EpiProj E{PROJ, N0, (bf16_t*)(ws + WS_VT0), 2048, 2560, 512, false};
        pg8::gemm_phase<pg8::EpiProj, pg8::StaticOrder, kALIGN, kSP2>(lds, g, S, E);
    }
    SEAM(2);
    PHASE_LOOP(3) { phase3(args, lds, tid, wave, lane, G, rep_); }
    SEAM(3);
    PHASE_LOOP(4) { phase4(args, lds, tid, wave, lane, G); }
    SEAM(4);
    PHASE_LOOP(5) {
        pg8::Gemm g{YPRE, (const bf16_t*)(ws + WS_WGLUT), MROWS, 512, 512}; pg8::StaticOrder S; S.init(MROWS, 512, G, (int)blockIdx.x);
        pg8::EpiGlu E{YPRE, PROJ, args.in[19], YMIX};
        pg8::gemm_phase<pg8::EpiGlu, pg8::StaticOrder, kALIGN, kSP2>(lds, g, S, E);
    }
    SEAM(5);
    PHASE_LOOP(6) {
        pg8::Gemm g{YMIX, (const bf16_t*)(ws + WS_WOUT0T), MROWS, DM, DM}; pg8::StaticOrder S; S.init(MROWS, DM, G, (int)blockIdx.x);
        pg8::EpiF32 E{OUTF, DM};
        pg8::gemm_phase<pg8::EpiF32, pg8::StaticOrder, kALIGN, kSP2>(lds, g, S, E);
    }
    SEAM(6);
    PHASE_LOOP(7) {
        for (int r = gw; r < MROWS; r += NGW) {
            const int mrow = r < NLAT ? (r >> 12) : 4;
            const float* hin = r < NLAT ? x + (size_t)r * DM : ctxin + (size_t)(r - NLAT) * DM;
            float v[16], h[16]; load_row16(OUTF + (size_t)r * DM, lane, v); load_row16(hin, lane, h);
            const float rinv = row_rinv(v); const float* gt = MOD + mrow * 3072 + 2048;
#pragma unroll
            for (int j = 0; j < 4; ++j) { const int col = j * 256 + lane * 4; const f32x4_t pg = *(const f32x4_t*)(post_g + col), gg = *(const f32x4_t*)(gt + col);
#pragma unroll
                for (int e = 0; e < 4; ++e) h[4 * j + e] += gg[e] * (v[4 * j + e] * rinv * pg[e]);
                if (r < NLAT) *(f32x4_t*)(out + (size_t)r * DM + col) = (f32x4_t){h[4 * j], h[4 * j + 1], h[4 * j + 2], h[4 * j + 3]}; }
            store_modnorm(h, row_rinv(h), pre_g + DM, MOD + (5 + mrow) * 3072, XN + (size_t)r * DM, lane);
        }
    }
    SEAM(7);
    PHASE_LOOP(8) {
        pg8::Gemm g{XN, (const bf16_t*)(ws + WS_WIN1T), MROWS, N1, DM}; pg8::StaticOrder S; S.init(MROWS, N1, G, (int)blockIdx.x);
        pg8::EpiProj E{PROJ, N1, (bf16_t*)(ws + WS_VT1), 1664, 1792, 128, true};
        pg8::gemm_phase<pg8::EpiProj, pg8::StaticOrder, kALIGN, kSP2>(lds, g, S, E);
    }
    SEAM(8);
    PHASE_LOOP(9) { phase9(args, lds, tid, wave, lane, G); }
    SEAM(9);
    PHASE_LOOP(10) { phase10(args, lds, tid, wave, lane, G); }
    SEAM(10);
    PHASE_LOOP(11) {
        pg8::Gemm g{YMIX, (const bf16_t*)(ws + WS_WOUT1T), NLAT, DM, DM}; pg8::StaticOrder S; S.init(NLAT, DM, G, (int)blockIdx.x);
        pg8::EpiF32 E{OUTF, DM};
        pg8::gemm_phase<pg8::EpiF32, pg8::StaticOrder, kALIGN, kSP2>(lds, g, S, E);
    }
    SEAM(11);
    PHASE_LOOP(12) {
        for (int r = gw; r < NLAT; r += NGW) {
            float v[16], h[16]; load_row16(OUTF + (size_t)r * DM, lane, v); load_row16(out + (size_t)r * DM, lane, h);
            const float rinv = row_rinv(v); const float* gt = MOD + (5 + (r >> 12)) * 3072 + 2048;
#pragma unroll
            for (int j = 0; j < 4; ++j) { const int col = j * 256 + lane * 4; const f32x4_t pg = *(const f32x4_t*)(post_g + DM + col), gg = *(const f32x4_t*)(gt + col);
                f32x4_t o;
#pragma unroll
                for (int e = 0; e < 4; ++e) o[e] = h[4 * j + e] + gg[e] * (v[4 * j + e] * rinv * pg[e]);
                *(f32x4_t*)(out + (size_t)r * DM + col) = o; }
        }
    }
#undef IN
#undef SEAM
}
__global__ void k_adaln(const float* c, const float* cctx, const float* ada_w, const float* ada_b, float* mod) {
    const int idx = blockIdx.x * blockDim.x + threadIdx.x;
    if (idx >= 2 * 5 * 3072) return;
    const int col = idx % 3072, r = (idx / 3072) % 5, i = idx / (3072 * 5);
    const float* cv = r < 4 ? c + r * 1024 : cctx;
    const float* W = ada_w + (size_t)i * 1024 * 3072;
    float acc = 0.f;
    for (int k = 0; k < 1024; ++k) acc += silu_f(cv[k]) * W[(size_t)k * 3072 + col];
    mod[idx] = acc + ada_b[i * 3072 + col];
}

__global__ void k_prenorm(const float* lat, const float* ctx, const float* g, const float* mod  , bf16_t* XN) {
    const int r = blockIdx.x * 4 + (threadIdx.x >> 6), lane = threadIdx.x & 63;
    if (r >= MROWS) return;
    const float* src = r < NLAT ? lat + (size_t)r * DM : ctx + (size_t)(r - NLAT) * DM;
    const float* m = mod + (r < NLAT ? (r >> 12) : 4) * 3072;
    float v[16]; float ss = 0.f;
#pragma unroll
    for (int j = 0; j < 4; ++j) { const float4 t = *(const float4*)(src + j * 256 + lane * 4); v[4 * j] = t.x; v[4 * j + 1] = t.y; v[4 * j + 2] = t.z; v[4 * j + 3] = t.w; }
#pragma unroll
    for (int j = 0; j < 16; ++j) ss += v[j] * v[j];
    ss = wave_sum(ss);
    const float rinv = rsqrtf(ss * (1.f / DM) + EPSN);
#pragma unroll
    for (int j = 0; j < 4; ++j)
#pragma unroll
        for (int e = 0; e < 4; ++e) { const int col = j * 256 + lane * 4 + e; const float y = v[4 * j + e] * rinv * g[col] * (1.f + m[1024 + col]) + m[col]; XN[(size_t)r * DM + col] = f2bf(y); }
}

__global__ void k_postnorm(const float* hlat, const float* hctx, const float* OUT, const float* pg, const float* mod, float* olat, float* octx, int nrows) {
    const int r = blockIdx.x * 4 + (threadIdx.x >> 6), lane = threadIdx.x & 63;
    if (r >= nrows) return;
    const float* hin = r < NLAT ? hlat + (size_t)r * DM : hctx + (size_t)(r - NLAT) * DM;
    float* ho = r < NLAT ? olat + (size_t)r * DM : octx + (size_t)(r - NLAT) * DM;
    const float* m = mod + (r < NLAT ? (r >> 12) : 4) * 3072 + 2048;
    const float* src = OUT + (size_t)r * DM;
    float v[16]; float ss = 0.f;
#pragma unroll
    for (int j = 0; j < 4; ++j) { const float4 t = *(const float4*)(src + j * 256 + lane * 4); v[4 * j] = t.x; v[4 * j + 1] = t.y; v[4 * j + 2] = t.z; v[4 * j + 3] = t.w; }
#pragma unroll
    for (int j = 0; j < 16; ++j) ss += v[j] * v[j];
    ss = wave_sum(ss);
    const float rinv = rsqrtf(ss * (1.f / DM) + EPSN);
#pragma unroll
    for (int j = 0; j < 4; ++j)
#pragma unroll
        for (int e = 0; e < 4; ++e) { const int col = j * 256 + lane * 4 + e; ho[col] = hin[col] + m[col] * (v[4 * j + e] * rinv * pg[col]); }
}

enum { GM_PROJ0 = 0, GM_PROJ1 = 1, GM_GLU = 2, GM_F32 = 3 };
struct GemmEpi { bf16_t* P; bf16_t* VT; const bf16_t* YPRE; const bf16_t* PROJ; const float* bglu; bf16_t* YMIX; float* OUT; };
template <int MODE> __global__ void __launch_bounds__(256) k_gemm(const bf16_t* A, const float* W, int M, int N, int K, GemmEpi e) {
    const int tx = threadIdx.x & 15, ty = threadIdx.x >> 4;
    const int c0 = blockIdx.x * 64 + tx * 4, r0 = blockIdx.y * 64 + ty * 4;
    float acc[4][4] = {};
    for (int k = 0; k < K; ++k) {
        const float4 w = *(const float4*)(W + (size_t)k * N + c0);
        const float wv[4] = {rbf(w.x), rbf(w.y), rbf(w.z), rbf(w.w)};
#pragma unroll
        for (int i = 0; i < 4; ++i) { const float a = bf2f(A[(size_t)(r0 + i) * K + k]);
#pragma unroll
            for (int j = 0; j < 4; ++j) acc[i][j] += a * wv[j]; }
    }
#pragma unroll
    for (int i = 0; i < 4; ++i)
#pragma unroll
        for (int j = 0; j < 4; ++j) {
            const int r = r0 + i, c = c0 + j; const float v = acc[i][j];
            if (MODE == GM_PROJ0) { e.P[(size_t)r * N0 + c] = f2bf(v);
                if (c >= 2048 && c < 2560) { const int hd = c - 2048; e.VT[((size_t)(row_batch(r) * 8) * 64 + hd) * POSN + row_pos(r)] = f2bf(v); } }
            else if (MODE == GM_PROJ1) { e.P[(size_t)r * N1 + c] = f2bf(v);
                if (c >= 1664 && c < 1792) { const int hd = c - 1664; e.VT[((size_t)(row_batch(r) * 2) * 64 + hd) * POSN + row_pos(r)] = f2bf(v); } }
            else if (MODE == GM_GLU) { const float y = bf2f(e.YPRE[(size_t)r * 512 + c]); const float ga = bf2f(e.PROJ[(size_t)r * N0 + 512 + c]);
                e.YMIX[(size_t)r * DM + c] = f2bf(y * sigmoid_f(v + e.bglu[c]) * silu_f(ga)); }
            else e.OUT[(size_t)r * N + c] = v;
        }
}

__global__ void __launch_bounds__(64) k_s5_scan(const bf16_t* PROJ, const float* lam_re, const float* lam_im, const float* log_dt, const float* b_re, const float* b_im,
                                                 const float* c_re, const float* c_im, float* YS) {
    const int p = threadIdx.x, id = blockIdx.x, dir = id & 1, g = (id >> 1) & 31, b = id >> 6;
    const int gi = (dir * 32 + g);
    const double lre = lam_re[gi * 64 + p], lim = lam_im[gi * 64 + p], dt = exp((double)log_dt[gi]);
    const double mag = exp(lre * dt); const float ar = (float)(mag * cos(lim * dt)), ai = (float)(mag * sin(lim * dt));
    const double nr = mag * cos(lim * dt) - 1.0, ni = mag * sin(lim * dt), den = lre * lre + lim * lim;
    const float cfr = (float)((nr * lre + ni * lim) / den), cfi = (float)((ni * lre - nr * lim) / den);
    float bbr[16], bbi[16], cr[16], ci[16];
#pragma unroll
    for (int h = 0; h < 16; ++h) { const float br = b_re[(gi * 64 + p) * 16 + h], bi = b_im[(gi * 64 + p) * 16 + h]; bbr[h] = cfr * br - cfi * bi; bbi[h] = cfr * bi + cfi * br;
        cr[h] = c_re[(gi * 16 + h) * 64 + p]; ci[h] = c_im[(gi * 16 + h) * 64 + p]; }
    float hr = 0.f, hi = 0.f;
    float* ys = YS + (size_t)dir * MROWS * 512;
    for (int pos = 0; pos < POSN; ++pos) {
        int row;
        if (dir == 0) row = pos_row(b, pos); else row = pos < LC ? NLAT + b * LC + (LC - 1 - pos) : b * SEQ + (SEQ - 1 - (pos - LC));
        const bf16_t* up = PROJ + (size_t)row * N0 + g * 16;
        float bur = 0.f, bui = 0.f;
#pragma unroll
        for (int h = 0; h < 16; ++h) { const float u = bf2f(up[h]); bur += bbr[h] * u; bui += bbi[h] * u; }
        const float nhr = ar * hr - ai * hi + bur, nhi = ar * hi + ai * hr + bui; hr = nhr; hi = nhi;
        float mine = 0.f;
#pragma unroll
        for (int h = 0; h < 16; ++h) { const float y = wave_sum(cr[h] * hr - ci[h] * hi); if (p == h) mine = y; }
        if (p < 16) ys[(size_t)row * 512 + g * 16 + p] = mine;
    }
}
__global__ void k_s5_finish(const bf16_t* PROJ, const float* YS, const float* dsk, bf16_t* YPRE) {
    const size_t idx = (size_t)blockIdx.x * blockDim.x + threadIdx.x; if (idx >= (size_t)MROWS * 512) return;
    const int ch = idx & 511; const size_t r = idx >> 9;
    const float y = dsk[ch] * bf2f(PROJ[r * N0 + ch]) + YS[idx] + YS[(size_t)MROWS * 512 + idx];
    YPRE[idx] = f2bf(gelu_tanh(y));
}

__global__ void __launch_bounds__(256) k_na_attn(const bf16_t* PROJ, const float* relb, bf16_t* YMIX) {
    const int wv = blockIdx.x * 4 + (threadIdx.x >> 6), lane = threadIdx.x & 63;
    if (wv >= MROWS * 8) return;
    const int h = wv & 7, r = wv >> 3, b = row_batch(r);
    const float q = bf2f(PROJ[(size_t)r * N0 + 1024 + h * 64 + lane]);
    float m = -INFINITY, l = 0.f, o = 0.f;
    if (r < NLAT) {
        const int t = r & 4095, qr = t >> 6, qc = t & 63;
        const int rs = min(max(qr - 4, 0), 56), cs = min(max(qc - 8, 0), 48);
        for (int kr = rs; kr < rs + 8; ++kr)
            for (int kc = cs; kc < cs + 16; ++kc) {
                const size_t kro = (size_t)(b * SEQ + kr * 64 + kc) * N0;
                float s = wave_sum(q * bf2f(PROJ[kro + 1536 + h * 64 + lane])) * 0.125f + relb[(h * 15 + (kr - qr + 7)) * 31 + (kc - qc + 15)];
                const float mn = fmaxf(m, s), al = __expf(m - mn), pp = __expf(s - mn);
                l = l * al + pp; o = o * al + pp * bf2f(PROJ[kro + 2048 + h * 64 + lane]); m = mn;
            }
    }
    for (int c = 0; c < LC; ++c) {
        const size_t kro = (size_t)(NLAT + b * LC + c) * N0;
        const float s = wave_sum(q * bf2f(PROJ[kro + 1536 + h * 64 + lane])) * 0.125f;
        const float mn = fmaxf(m, s), al = __expf(m - mn), pp = __expf(s - mn);
        l = l * al + pp; o = o * al + pp * bf2f(PROJ[kro + 2048 + h * 64 + lane]); m = mn;
    }
    const float gb = bf2f(PROJ[(size_t)r * N0 + 2560 + h * 64 + lane]);
    YMIX[(size_t)r * DM + 512 + h * 64 + lane] = f2bf(o / l * silu_f(gb));
}

__global__ void __launch_bounds__(64) k_lru(const bf16_t* P1, const float* conv_w, const float* conv_b, const float* lam, const float* w_a, const float* b_a,
                                            const float* w_x, const float* b_x, float* HS, bf16_t* YMIX) {
    __shared__ float xs[64];
    const int j = threadIdx.x, nb = blockIdx.x & 7, b = blockIdx.x >> 3, ch = nb * 64 + j;
    const float cw0 = conv_w[0 * 512 + ch], cw1 = conv_w[1 * 512 + ch], cw2 = conv_w[2 * 512 + ch], cw3 = conv_w[3 * 512 + ch], cb = conv_b[ch];
    for (int dir = 0; dir < 2; ++dir) {
        float wa[64], wx[64];
#pragma unroll
        for (int i = 0; i < 64; ++i) { wa[i] = w_a[((dir * 8 + nb) * 64 + i) * 64 + j]; wx[i] = w_x[((dir * 8 + nb) * 64 + i) * 64 + j]; }
        const float ba = b_a[dir * 512 + ch], bx = b_x[dir * 512 + ch];
        const float lm = lam[dir * 512 + ch]; const float sp = (-lm > 20.f) ? -lm : log1pf(__expf(-lm));
        float hst = 0.f;
        for (int pos = 0; pos < POSN; ++pos) {
            int s0, sl, t;
            if (pos < LC) { s0 = NLAT + b * LC; sl = LC; t = dir == 0 ? pos : LC - 1 - pos; }
            else { s0 = b * SEQ; sl = SEQ; t = dir == 0 ? pos - LC : SEQ - 1 - (pos - LC); }
            float xm1 = 0.f, x0, xp1 = 0.f, xp2 = 0.f;
            x0 = bf2f(P1[(size_t)(s0 + t) * N1 + ch]);
            if (t - 1 >= 0) xm1 = bf2f(P1[(size_t)(s0 + t - 1) * N1 + ch]);
            if (t + 1 < sl) xp1 = bf2f(P1[(size_t)(s0 + t + 1) * N1 + ch]);
            if (t + 2 < sl) xp2 = bf2f(P1[(size_t)(s0 + t + 2) * N1 + ch]);
            const float xc = cw0 * xm1 + cw1 * x0 + cw2 * xp1 + cw3 * xp2 + cb;
            __syncthreads(); xs[j] = xc; __syncthreads();
            float ga = ba, gx = bx;
#pragma unroll
            for (int i = 0; i < 64; ++i) { const float xi = xs[i]; ga += xi * wa[i]; gx += xi * wx[i]; }
            const float gr = sigmoid_f(ga), gi = sigmoid_f(gx);
            const float log_a = -8.f * gr * sp; const float a = __expf(log_a); const float mult = sqrtf(fmaxf(-expm1f(2.f * log_a), 0.f));
            hst = a * hst + mult * gi * xc;
            if (pos >= LC) { const size_t rr = (size_t)(s0 + t);
                if (dir == 0) HS[rr * 512 + ch] = hst;
                else { const float gc = bf2f(P1[rr * N1 + 512 + ch]); YMIX[rr * DM + ch] = f2bf((HS[rr * 512 + ch] + hst) * silu_f(gc)); } }
        }
    }
}

__global__ void __launch_bounds__(256) k_qkprep(const bf16_t* P1, const float* qn, const float* kn, bf16_t* QP, bf16_t* KP) {
    const int wv = blockIdx.x * 4 + (threadIdx.x >> 6), lane = threadIdx.x & 63;
    if (wv >= MROWS * 10) return;
    const int slot = wv % 10, r = wv / 10, b = row_batch(r);
    if (slot < 8 && r >= NLAT) return;
    const int col0 = slot < 8 ? 1024 + slot * 64 : 1536 + (slot - 8) * 64;
    const float x = bf2f(P1[(size_t)r * N1 + col0 + lane]);
    const float ss = wave_sum(x * x);
    float y = x * rsqrtf(ss * (1.f / 64.f) + EPSN) * (slot < 8 ? qn[lane] : kn[lane]);
    if (r < NLAT) {
        const int t = r & 4095, i = lane >> 1, f = i & 15; const float pos = (float)(i < 16 ? (t >> 6) : (t & 63));
        const float inv = (float)exp(-log(10000.0) * (double)(2 * f) / 32.0);
        const float ang = pos * inv; const float cs = cosf(ang), sn = sinf(ang);
        const float pr = __shfl_xor(y, 1);
        y = (lane & 1) ? (pr * sn + y * cs) : (y * cs - pr * sn);
    }
    if (slot < 8) QP[((size_t)(b * 8 + slot) * SEQ + (r & 4095)) * 64 + lane] = f2bf(y * (0.125f * LOG2E));
    else KP[((size_t)(b * 2 + (slot - 8)) * POSN + row_pos(r)) * 64 + lane] = f2bf(y);
}

__global__ void __launch_bounds__(256) k_gqa(const bf16_t* QP, const bf16_t* KP, const bf16_t* P1, bf16_t* YMIX) {
    const int wv = blockIdx.x * 4 + (threadIdx.x >> 6), lane = threadIdx.x & 63;
    if (wv >= NLAT * 8) return;
    const int hq = wv & 7, r = wv >> 3, b = r >> 12, t = r & 4095, kvh = hq >> 2;
    const float q = bf2f(QP[((size_t)(b * 8 + hq) * SEQ + t) * 64 + lane]);
    const bf16_t* kp = KP + (size_t)(b * 2 + kvh) * POSN * 64;
    float m = -INFINITY, l = 0.f, o = 0.f;
    for (int pos = 0; pos < POSN; ++pos) {
        const float s = wave_sum(q * bf2f(kp[(size_t)pos * 64 + lane]));
        const float v = bf2f(P1[(size_t)pos_row(b, pos) * N1 + 1664 + kvh * 64 + lane]);
        const float mn = fmaxf(m, s), al = exp2f(m - mn), pp = exp2f(s - mn);
        l = l * al + pp; o = o * al + pp * v; m = mn;
    }
    const float gd = bf2f(P1[(size_t)r * N1 + 1792 + hq * 64 + lane]);
    YMIX[(size_t)r * DM + 512 + hq * 64 + lane] = f2bf(o / l * silu_f(gd));
}

static int g_grid = 0;
static void launch_mega(Args a, int lo, int hi, int li, hipStream_t stream) {
    a.ph_lo = lo; a.ph_hi = hi; a.li = li;
    hipLaunchKernelGGL(mega, dim3(g_grid), dim3(NTHREADS), LDS_BYTES, stream, a);
    const hipError_t le = hipPeekAtLastError();
    if (le != hipSuccess) fprintf(stderr, "kernel_launch: mega[%d,%d) failed: %s\n", lo, hi, hipGetErrorName(le));
}
extern "C" void kernel_launch(void* const* d_in, const int* in_sizes, int n_in, void* d_out, int out_size, void* d_ws, size_t ws_size, hipStream_t stream) {
    if (g_grid == 0) {
        int dev = 0, cus = 0;
        if (hipGetDevice(&dev) != hipSuccess || hipDeviceGetAttribute(&cus, hipDeviceAttributeMultiprocessorCount, dev) != hipSuccess) { fprintf(stderr, "kernel_launch: device query failed\n"); g_grid = -1; return; }
        if (hipFuncSetAttribute((const void*)mega, hipFuncAttributeMaxDynamicSharedMemorySize, LDS_BYTES) != hipSuccess) { fprintf(stderr, "kernel_launch: hipFuncSetAttribute failed\n"); g_grid = -1; return; }
        int per_cu = 0;
        if (hipOccupancyMaxActiveBlocksPerMultiprocessor(&per_cu, (const void*)mega, NTHREADS, LDS_BYTES) != hipSuccess || per_cu < 1) fprintf(stderr, "kernel_launch: occupancy query says %d blocks/CU\n", per_cu);
        (void)hipGetLastError();
        g_grid = cus;
    }
    if (g_grid < 0) return;
    const float* x = (const float*)d_in[0]; const float* c = (const float*)d_in[1]; const float* ctx = (const float*)d_in[2]; const float* cctx = (const float*)d_in[3];
    const float* ada_w = (const float*)d_in[4]; const float* ada_b = (const float*)d_in[5]; const float* pre_g = (const float*)d_in[6]; const float* post_g = (const float*)d_in[7];
    const float* ev_w_in = (const float*)d_in[8]; const float* ev_w_out = (const float*)d_in[9];
    const float* s5_lre = (const float*)d_in[10]; const float* s5_lim = (const float*)d_in[11]; const float* s5_ldt = (const float*)d_in[12];
    const float* s5_bre = (const float*)d_in[13]; const float* s5_bim = (const float*)d_in[14]; const float* s5_cre = (const float*)d_in[15]; const float* s5_cim = (const float*)d_in[16];
    const float* s5_d = (const float*)d_in[17]; const float* s5_wglu = (const float*)d_in[18]; const float* s5_bglu = (const float*)d_in[19]; const float* relb = (const float*)d_in[20];
    const float* od_w_in = (const float*)d_in[21]; const float* od_w_out = (const float*)d_in[22]; const float* conv_w = (const float*)d_in[23]; const float* conv_b = (const float*)d_in[24];
    const float* lru_lam = (const float*)d_in[25]; const float* w_a = (const float*)d_in[26]; const float* b_a = (const float*)d_in[27]; const float* w_x = (const float*)d_in[28]; const float* b_x = (const float*)d_in[29];
    const float* qn = (const float*)d_in[30]; const float* kn = (const float*)d_in[31];
    char* ws = (char*)d_ws; float* out = (float*)d_out;
    float* MOD = (float*)(ws + WS_MOD); float* HC1 = (float*)(ws + WS_HC1);
    bf16_t* XN = (bf16_t*)(ws + WS_XN); bf16_t* YMIX = (bf16_t*)(ws + WS_YMIX); bf16_t* PROJ = (bf16_t*)(ws + WS_PROJ); float* OUTF = (float*)(ws + WS_PROJ);
    bf16_t* VT0 = (bf16_t*)(ws + WS_VT0); bf16_t* YPRE = (bf16_t*)(ws + WS_YPRE); bf16_t* QP = (bf16_t*)(ws + WS_QP); bf16_t* KP = (bf16_t*)(ws + WS_KP); bf16_t* VT1 = (bf16_t*)(ws + WS_VT1);
    float* YS = (float*)(ws + WS_YS); float* HS = (float*)(ws + WS_HS);
    (void)x; (void)c; (void)ctx; (void)cctx; (void)ada_w; (void)ada_b; (void)pre_g; (void)post_g; (void)ev_w_in; (void)ev_w_out; (void)s5_wglu; (void)od_w_in; (void)od_w_out; (void)MOD; (void)HC1; (void)XN; (void)OUTF; (void)VT0; (void)VT1; (void)out;

    if (hipMemsetAsync(ws + WS_CTL, 0, CTL_ZERO_BYTES, stream) != hipSuccess) { fprintf(stderr, "kernel_launch: memset failed\n"); return; }
    Args a{};
    for (int i = 0; i < 32; ++i) a.in[i] = (const float*)d_in[i];
    a.out = (float*)d_out; a.ws = (unsigned char*)d_ws;

    launch_mega(a, 0, N_PHASES, 0, stream);
    (void)relb; (void)conv_w; (void)conv_b; (void)lru_lam; (void)w_a; (void)b_a; (void)w_x; (void)b_x; (void)HS; (void)qn; (void)kn; (void)QP; (void)KP;
    (void)s5_lre; (void)s5_lim; (void)s5_ldt; (void)s5_bre; (void)s5_bim; (void)s5_cre; (void)s5_cim; (void)s5_d; (void)s5_bglu; (void)YS; (void)YPRE; (void)PROJ; (void)YMIX;
}
```

```cpp
#include <hip/hip_runtime.h>
#include <cstdint>
#include <cstdio>

typedef unsigned short bf16_t;
#define DI __device__ __forceinline__
#define GAS __attribute__((address_space(1)))
#define LAS __attribute__((address_space(3)))
typedef unsigned v4u __attribute__((ext_vector_type(4)));
typedef unsigned v2u __attribute__((ext_vector_type(2)));
typedef float f32x4_t __attribute__((ext_vector_type(4)));
typedef float f32x16_t __attribute__((ext_vector_type(16)));
typedef short bf16x8_t __attribute__((ext_vector_type(8)));
typedef short s16x4_t __attribute__((ext_vector_type(4)));
typedef GAS unsigned gu32;
typedef GAS unsigned long long gu64;
#define RLX_AGENT __ATOMIC_RELAXED, __HIP_MEMORY_SCOPE_AGENT
#define LDS_WAIT() asm volatile("s_waitcnt lgkmcnt(0)" ::: "memory")
#define VM_WAIT() asm volatile("s_waitcnt vmcnt(0)" ::: "memory")

DI float bf2f(bf16_t v) { return __uint_as_float((unsigned)v << 16); }
DI bf16_t f2bf(float f) { unsigned u = __float_as_uint(f); return (bf16_t)((u + 0x7fffu + ((u >> 16) & 1u)) >> 16); }
DI unsigned pk2(float lo, float hi) { return (unsigned)f2bf(lo) | ((unsigned)f2bf(hi) << 16); }
DI float bflo(unsigned w) { return __uint_as_float(w << 16); }
DI float bfhi(unsigned w) { return __uint_as_float(w & 0xffff0000u); }
DI float rbf(float f) { return bf2f(f2bf(f)); }
DI float wave_sum(float v) {
#pragma unroll
    for (int o = 1; o < 64; o <<= 1) v += __shfl_xor(v, o);
    return v;
}
DI float sigmoid_f(float x) { return __builtin_amdgcn_rcpf(1.f + __builtin_amdgcn_exp2f(-1.4426950408889634f * x)); }
DI float silu_f(float x) { return x * sigmoid_f(x); }
DI float gelu_tanh(float x) { const float u = 0.7978845608028654f * (x + 0.044715f * x * x * x); return 0.5f * x * (1.f + tanhf(u)); }
DI float gelu_fast(float x) { const float u = 1.5957691216057308f * (x + 0.044715f * x * x * x); return x * sigmoid_f(u); }

constexpr int NWAVES = 8, NTHREADS = 512;
constexpr int DM = 1024, NB = 4, SEQ = 4096, LC = 256;
constexpr int NLAT = NB * SEQ, NCTX = NB * LC, MROWS = NLAT + NCTX;
constexpr int N0 = 3072, N1 = 2304, POSN = LC + SEQ;
constexpr float EPSN = 1e-6f;
constexpr float LOG2E = 1.4426950408889634f;

constexpr size_t MiB = 1u << 20;
constexpr size_t WS_CTL = 0, CTL_ZERO_BYTES = 1 * MiB;
constexpr size_t WS_MOD = 1 * MiB;
constexpr size_t WS_ROPE = 2 * MiB;
constexpr size_t WS_L16 = 3 * MiB;
constexpr size_t WS_WIN0T = 4 * MiB;
constexpr size_t WS_WOUT0T = 10 * MiB;
constexpr size_t WS_WIN1T = 12 * MiB;
constexpr size_t WS_WOUT1T = 17 * MiB;
constexpr size_t WS_WGLUT = 19 * MiB;
constexpr size_t WS_LRUWT = 19 * MiB + 512 * 1024;
constexpr size_t WS_W16 = 20 * MiB;
constexpr size_t WS_WC = 24 * MiB;
constexpr size_t WS_KT = 28 * MiB;
constexpr size_t WS_LSUM = 29 * MiB;
constexpr size_t WS_XN = 32 * MiB;
constexpr size_t WS_YMIX = 66 * MiB;
constexpr size_t WS_PROJ = 100 * MiB;
constexpr size_t WS_VT0 = 202 * MiB;
constexpr size_t WS_CARRY1 = 219 * MiB;
constexpr size_t WS_YPRE = 228 * MiB;
constexpr size_t WS_QP = 202 * MiB;
constexpr size_t WS_KP = 218 * MiB;
constexpr size_t WS_VT1 = 223 * MiB;
constexpr size_t WS_YS = 32 * MiB;
constexpr size_t WS_HS = 32 * MiB;
constexpr size_t WS_HC1 = 246 * MiB;

DI int row_batch(int r) { return r < NLAT ? (r >> 12) : ((r - NLAT) >> 8); }
DI int row_pos(int r) { return r < NLAT ? LC + (r & 4095) : ((r - NLAT) & 255); }
DI int pos_row(int b, int pos) { return pos < LC ? NLAT + b * LC + pos : b * SEQ + (pos - LC); }

namespace pg8 {
#define PG8_LAS __attribute__((address_space(3)))
typedef unsigned short bf16_t;
typedef short bf16x8 __attribute__((ext_vector_type(8)));
typedef float f32x4 __attribute__((ext_vector_type(4)));
typedef unsigned u32x4 __attribute__((ext_vector_type(4)));
constexpr int BM = 256, BK = 64, HALF = 128, HTB = HALF * BK * 2  , STAGE_BYTES = 8 * HTB, NXCD = 8, WGM = 8;

__host__ __device__ __forceinline__ int lds_byte(int r, int c) { const int st = (r >> 4) * 2 + (c >> 5), rr = r & 15, cc = c & 31, ob = rr * 64 + cc * 2; return st * 1024 + (ob ^ (((ob >> 9) & 1) << 5)); }
__host__ __device__ __forceinline__ void stage_rc(int b, int& R, int& C) { const int st = b / 1024, sb = b % 1024, swz = sb ^ (((sb >> 9) & 1) << 5); R = (st >> 1) * 16 + swz / 64; C = (st & 1) * 32 + (swz % 64) / 2; }
__host__ __device__ __forceinline__ int perm32(int rho) { const int n = rho >> 4, i = rho & 15; return 8 * (i >> 2) + 4 * n + (i & 3); }

struct Unit { int pm, pn; };
struct Gemm { const bf16_t* A; const bf16_t* Bt; int M, N, K; };

struct StaticOrder {
    int nM, nN, nwg, G, c;
    __host__ __device__ void init(int M, int N, int G_, int c_) { nM = M / BM; nN = N / BM; nwg = nM * nN; G = G_; c = c_; }
    __host__ __device__ bool next(int i, Unit& u) const {
        const long L = (long)i * G + c; if (L >= nwg) return false;
        int wgid = (int)L; { const int q = nwg / NXCD, r = nwg % NXCD, xcd = wgid % NXCD, off = wgid / NXCD; wgid = (xcd < r ? xcd * (q + 1) : r * (q + 1) + (xcd - r) * q) + off; }
        const int nig = WGM * nN, gid = wgid / nig, fm = gid * WGM, gsz = (nM - fm) < WGM ? (nM - fm) : WGM;
        u.pm = fm + ((wgid % nig) % gsz); u.pn = (wgid % nig) / gsz; return true;
    }
    __device__ __forceinline__ void a_ready(const Unit&) const {}
    __device__ __forceinline__ void done(const Unit&) const {}
};

__device__ __forceinline__ unsigned cvt_pk_bf16(float lo, float hi) { unsigned r; asm volatile("v_cvt_pk_bf16_f32 %0, %1, %2" : "=v"(r) : "v"(lo), "v"(hi)); return r; }

struct EpiProj {
    static constexpr bool PERM = true, AFTER_DRAIN = false;
    bf16_t* P; int ldc; bf16_t* VT; int vt_lo, vt_hi, vt_w; bool vrow;
    __device__ __forceinline__ void operator()(const f32x4 (&acc)[2][2][4][2], const Unit& u, int wr, int wc, int fr, int fq) const {
        const int row0 = u.pm * BM + wr * 64 + fr, colt = u.pn * BM + wc * 32 + 8 * fq;
#pragma unroll
        for (int ai = 0; ai < 2; ++ai)
#pragma unroll
            for (int m = 0; m < 4; ++m) { const int r = row0 + ai * HALF + m * 16; bf16_t* rowp = P + (size_t)r * ldc + colt;
#pragma unroll
                for (int bj = 0; bj < 2; ++bj) { const f32x4 v0 = acc[ai][bj][m][0], v1 = acc[ai][bj][m][1];
                    u32x4 w; w.x = cvt_pk_bf16(v0[0], v0[1]); w.y = cvt_pk_bf16(v0[2], v0[3]); w.z = cvt_pk_bf16(v1[0], v1[1]); w.w = cvt_pk_bf16(v1[2], v1[3]);
                    *(u32x4*)(rowp + bj * HALF) = w;
                    const int c0 = colt + bj * HALF;
                    if (c0 >= vt_lo && c0 < vt_hi && vrow) {
                        const int hd = c0 - vt_lo; *(u32x4*)(VT + ((size_t)(row_batch(r) * (vt_w >> 6) + (hd >> 6)) * POSN + row_pos(r)) * 64 + (hd & 63)) = w;
                    } else if (c0 >= vt_lo && c0 < vt_hi) {
                        bf16_t* vp = VT + ((size_t)row_batch(r) * vt_w + (c0 - vt_lo)) * POSN + row_pos(r);
                        vp[0 * POSN] = (bf16_t)(w.x & 0xffffu); vp[1 * POSN] = (bf16_t)(w.x >> 16); vp[2 * POSN] = (bf16_t)(w.y & 0xffffu); vp[3 * POSN] = (bf16_t)(w.y >> 16);
                        vp[4 * POSN] = (bf16_t)(w.z & 0xffffu); vp[5 * POSN] = (bf16_t)(w.z >> 16); vp[6 * POSN] = (bf16_t)(w.w & 0xffffu); vp[7 * POSN] = (bf16_t)(w.w >> 16);
                    } } }
    }
};
struct EpiGlu {
    static constexpr bool PERM = true, AFTER_DRAIN = false;
    const bf16_t* YPRE; const bf16_t* PROJ; const float* bglu; bf16_t* YMIX;
    __device__ __forceinline__ void operator()(const f32x4 (&acc)[2][2][4][2], const Unit& u, int wr, int wc, int fr, int fq) const {
        const int row0 = u.pm * BM + wr * 64 + fr, colt = u.pn * BM + wc * 32 + 8 * fq;
#pragma unroll
        for (int bj = 0; bj < 2; ++bj) { const int c0 = colt + bj * HALF;
            const f32x4 b0 = *(const f32x4*)(bglu + c0), b1 = *(const f32x4*)(bglu + c0 + 4);
#pragma unroll
            for (int ai = 0; ai < 2; ++ai)
#pragma unroll
                for (int m = 0; m < 4; ++m) { const int r = row0 + ai * HALF + m * 16;
                    const u32x4 yv = *(const u32x4*)(YPRE + (size_t)r * 512 + c0), gv = *(const u32x4*)(PROJ + (size_t)r * N0 + 512 + c0);
                    const f32x4 a0 = acc[ai][bj][m][0] + b0, a1 = acc[ai][bj][m][1] + b1;
                    float o[8];
                    o[0] = bflo(yv.x) * sigmoid_f(a0[0]) * silu_f(bflo(gv.x)); o[1] = bfhi(yv.x) * sigmoid_f(a0[1]) * silu_f(bfhi(gv.x));
                    o[2] = bflo(yv.y) * sigmoid_f(a0[2]) * silu_f(bflo(gv.y)); o[3] = bfhi(yv.y) * sigmoid_f(a0[3]) * silu_f(bfhi(gv.y));
                    o[4] = bflo(yv.z) * sigmoid_f(a1[0]) * silu_f(bflo(gv.z)); o[5] = bfhi(yv.z) * sigmoid_f(a1[1]) * silu_f(bfhi(gv.z));
                    o[6] = bflo(yv.w) * sigmoid_f(a1[2]) * silu_f(bflo(gv.w)); o[7] = bfhi(yv.w) * sigmoid_f(a1[3]) * silu_f(bfhi(gv.w));
                    u32x4 w; w.x = cvt_pk_bf16(o[0], o[1]); w.y = cvt_pk_bf16(o[2], o[3]); w.z = cvt_pk_bf16(o[4], o[5]); w.w = cvt_pk_bf16(o[6], o[7]);
                    *(u32x4*)(YMIX + (size_t)r * DM + c0) = w; } }
    }
};
struct EpiF32 {
    static constexpr bool PERM = false, AFTER_DRAIN = false;
    float* O; int ldc;
    __device__ __forceinline__ void operator()(const f32x4 (&acc)[2][2][4][2], const Unit& u, int wr, int wc, int fr, int fq) const {
        const int row0 = u.pm * BM + wr * 64 + fr, col0 = u.pn * BM + wc * 32 + 4 * fq;
#pragma unroll
        for (int ai = 0; ai < 2; ++ai)
#pragma unroll
            for (int m = 0; m < 4; ++m) { float* rowp = O + (size_t)(row0 + ai * HALF + m * 16) * ldc + col0;
#pragma unroll
                for (int bj = 0; bj < 2; ++bj)
#pragma unroll
                    for (int n = 0; n < 2; ++n) *(f32x4*)(rowp + bj * HALF + n * 16) = acc[ai][bj][m][n]; }
    }
};
template <class Epi, class Sched, bool ALIGN_EPI = false, bool SP2 = false>
__device__ __forceinline__ void gemm_phase(PG8_LAS unsigned char* lds, const Gemm g, const Sched& S, const Epi& E) {
    const int tid = threadIdx.x, wid = __builtin_amdgcn_readfirstlane(tid >> 6), lane = tid & 63, wr = wid >> 2, wc = wid & 3, fr = lane & 15, fq = lane >> 4;
    const int K = g.K, nt = K / BK;
    unsigned voffA[2], voffB[2];
#pragma unroll
    for (int i = 0; i < 2; ++i) { int R, C; stage_rc(tid * 16 + i * 8192, R, C); const int Rb = Epi::PERM ? ((R & ~31) + perm32(R & 31)) : R;
        voffA[i] = (unsigned)(R * K + C) * 2u; voffB[i] = (unsigned)(Rb * K + C) * 2u; }
    const size_t kstep = (size_t)(BK * 2);
    const size_t hstep = (size_t)HALF * K * 2;
    const size_t tstep = 2 * hstep;
    const unsigned ldsw = (unsigned)wid * 1024u;
    const int aoff = lds_byte(wr * 64 + fr, fq * 8), boff = lds_byte(wc * 32 + fr, fq * 8);
#define PG8_SA(b, h) (((b) * 2 + (h)) * HTB)
#define PG8_SB(b, h) ((4 + (b) * 2 + (h)) * HTB)
#define PG8_STAGE(bufoff, gbase, voff) do { _Pragma("unroll") for (int _i = 0; _i < 2; ++_i) \
        __builtin_amdgcn_global_load_lds((const unsigned*)((const char*)(gbase) + (voff)[_i]), (PG8_LAS unsigned*)(lds + (bufoff) + ldsw + _i * 8192), 16, 0, 0); } while (0)
#define PG8_LDA(dst, b, h) do { _Pragma("unroll") for (int m = 0; m < 4; ++m) _Pragma("unroll") for (int k = 0; k < 2; ++k) dst[m][k] = *(const PG8_LAS bf16x8*)(lds + PG8_SA(b, h) + aoff + m * 2048 + k * 1024); } while (0)
#define PG8_LDB(dst, b, h) do { _Pragma("unroll") for (int n = 0; n < 2; ++n) _Pragma("unroll") for (int k = 0; k < 2; ++k) dst[n][k] = *(const PG8_LAS bf16x8*)(lds + PG8_SB(b, h) + boff + n * 2048 + k * 1024); } while (0)
#define PG8_MMA(ai, bj, At, Bt) do { __builtin_amdgcn_s_setprio(1); _Pragma("unroll") for (int m = 0; m < 4; ++m) _Pragma("unroll") for (int n = 0; n < 2; ++n) _Pragma("unroll") for (int k = 0; k < 2; ++k) \
        acc[ai][bj][m][n] = __builtin_amdgcn_mfma_f32_16x16x32_bf16(Bt[n][k], At[m][k], acc[ai][bj][m][n], 0, 0, 0); __builtin_amdgcn_s_setprio(0); } while (0)
#define PG8_WAIT_V(n) asm volatile("s_waitcnt vmcnt(" #n ")" ::: "memory")
#define PG8_WAIT_L(n) asm volatile("s_waitcnt lgkmcnt(" #n ")" ::: "memory")
#define PG8_BAR __builtin_amdgcn_s_barrier()
#define PG8_SCHED __builtin_amdgcn_sched_barrier(0)
    Unit cur, nxt; int ui = 0;
    if (!S.next(0, cur)) return;
    f32x4 acc[2][2][4][2];
#pragma unroll
    for (int a = 0; a < 2; ++a)
#pragma unroll
        for (int b = 0; b < 2; ++b)
#pragma unroll
            for (int m = 0; m < 4; ++m)
#pragma unroll
                for (int n = 0; n < 2; ++n) acc[a][b][m][n] = (f32x4){0.f, 0.f, 0.f, 0.f};
    bf16x8 At[4][2], B0[2][2], B1[2][2];
    const char* cA = (const char*)g.A + (size_t)cur.pm * tstep; const char* cB = (const char*)g.Bt + (size_t)cur.pn * tstep;
    S.a_ready(cur);
    if constexpr (SP2) {
        PG8_STAGE(PG8_SB(0, 0), cB, voffB); PG8_STAGE(PG8_SB(0, 1), cB + hstep, voffB); PG8_STAGE(PG8_SA(0, 0), cA, voffA); PG8_STAGE(PG8_SA(0, 1), cA + hstep, voffA);
        if (wr == 1) PG8_BAR;
        PG8_WAIT_V(2); PG8_BAR;
        PG8_STAGE(PG8_SB(1, 0), cB + kstep, voffB); PG8_STAGE(PG8_SA(1, 0), cA + kstep, voffA); PG8_STAGE(PG8_SB(1, 1), cB + hstep + kstep, voffB);
        PG8_WAIT_V(6); PG8_BAR;
    } else {
        PG8_STAGE(PG8_SB(0, 0), cB, voffB); PG8_STAGE(PG8_SA(0, 0), cA, voffA); PG8_STAGE(PG8_SB(0, 1), cB + hstep, voffB); PG8_STAGE(PG8_SA(0, 1), cA + hstep, voffA);
        if (wr == 1) PG8_BAR;
        PG8_WAIT_V(4); PG8_BAR;
        PG8_STAGE(PG8_SB(1, 0), cB + kstep, voffB); PG8_STAGE(PG8_SA(1, 0), cA + kstep, voffA); PG8_STAGE(PG8_SB(1, 1), cB + hstep + kstep, voffB);
        PG8_WAIT_V(6); PG8_BAR;
    }
    for (;;) {
        const bool has_next = S.next(ui + 1, nxt);
        const char* nA = has_next ? (const char*)g.A + (size_t)nxt.pm * tstep : cA; const char* nB = has_next ? (const char*)g.Bt + (size_t)nxt.pn * tstep : cB;
        for (int t = 0; t < nt; t += 2) {
            const bool last = (t == nt - 2);
            const char* a1 = cA + (size_t)(t + 1) * kstep;
            const char* a2 = last ? nA : cA + (size_t)(t + 2) * kstep; const char* b2 = last ? nB : cB + (size_t)(t + 2) * kstep;
            const char* a3 = a2 + kstep; const char* b3 = b2 + kstep;
            if (last && has_next) S.a_ready(nxt);
            if constexpr (SP2) {
            PG8_LDB(B0, 0, 0); PG8_LDB(B1, 0, 1); PG8_SCHED; PG8_LDA(At, 0, 0); PG8_STAGE(PG8_SA(1, 1), a1 + hstep, voffA);
            PG8_WAIT_V(8); PG8_WAIT_L(0); PG8_BAR; PG8_MMA(0, 0, At, B0); PG8_MMA(0, 1, At, B1); PG8_BAR; PG8_SCHED;
            PG8_LDA(At, 0, 1); PG8_STAGE(PG8_SB(0, 0), b2, voffB); PG8_STAGE(PG8_SB(0, 1), b2 + hstep, voffB); PG8_STAGE(PG8_SA(0, 0), a2, voffA);
            PG8_WAIT_V(8); PG8_WAIT_L(0); PG8_BAR; PG8_MMA(1, 0, At, B0); PG8_MMA(1, 1, At, B1); PG8_BAR; PG8_SCHED;
            PG8_LDB(B0, 1, 0); PG8_LDB(B1, 1, 1); PG8_SCHED; PG8_LDA(At, 1, 0); PG8_STAGE(PG8_SA(0, 1), a2 + hstep, voffA);
            PG8_WAIT_V(8); PG8_WAIT_L(0); PG8_BAR; PG8_MMA(0, 0, At, B0); PG8_MMA(0, 1, At, B1); PG8_BAR; PG8_SCHED;
            PG8_LDA(At, 1, 1); PG8_STAGE(PG8_SB(1, 0), b3, voffB); PG8_STAGE(PG8_SB(1, 1), b3 + hstep, voffB); PG8_STAGE(PG8_SA(1, 0), a3, voffA);
            PG8_WAIT_V(8); PG8_WAIT_L(0); PG8_BAR; PG8_MMA(1, 0, At, B0); PG8_MMA(1, 1, At, B1); PG8_BAR; PG8_SCHED;
            } else {
            PG8_LDB(B0, 0, 0); PG8_SCHED; PG8_LDA(At, 0, 0); PG8_STAGE(PG8_SA(1, 1), a1 + hstep, voffA);
            PG8_WAIT_L(8); PG8_BAR; PG8_WAIT_L(0); PG8_MMA(0, 0, At, B0); PG8_BAR; PG8_SCHED;
            PG8_LDB(B1, 0, 1); PG8_STAGE(PG8_SB(0, 0), b2, voffB);
            PG8_BAR; PG8_WAIT_L(0); PG8_MMA(0, 1, At, B1); PG8_BAR;
            PG8_LDA(At, 0, 1); PG8_STAGE(PG8_SA(0, 0), a2, voffA);
            PG8_BAR; PG8_WAIT_L(0); PG8_MMA(1, 0, At, B0); PG8_BAR; PG8_SCHED;
            PG8_STAGE(PG8_SB(0, 1), b2 + hstep, voffB);
            PG8_WAIT_V(6); PG8_BAR; PG8_MMA(1, 1, At, B1); PG8_BAR;
            PG8_LDB(B0, 1, 0); PG8_SCHED; PG8_LDA(At, 1, 0); PG8_STAGE(PG8_SA(0, 1), a2 + hstep, voffA);
            PG8_WAIT_L(8); PG8_BAR; PG8_WAIT_L(0); PG8_MMA(0, 0, At, B0); PG8_BAR; PG8_SCHED;
            PG8_LDB(B1, 1, 1); PG8_STAGE(PG8_SB(1, 0), b3, voffB);
            PG8_BAR; PG8_WAIT_L(0); PG8_MMA(0, 1, At, B1); PG8_BAR;
            PG8_LDA(At, 1, 1); PG8_STAGE(PG8_SA(1, 0), a3, voffA);
            PG8_BAR; PG8_WAIT_L(0); PG8_MMA(1, 0, At, B0); PG8_BAR; PG8_SCHED;
            PG8_STAGE(PG8_SB(1, 1), b3 + hstep, voffB);
            PG8_WAIT_V(6); PG8_BAR; PG8_MMA(1, 1, At, B1); PG8_BAR;
            }
        }
        if constexpr (ALIGN_EPI) { if (wr == 0) PG8_BAR; }
        if constexpr (!Epi::AFTER_DRAIN) { E(acc, cur, wr, wc, fr, fq); S.done(cur); }
        if (!has_next) break;
#pragma unroll
        for (int a = 0; a < 2; ++a)
#pragma unroll
            for (int b = 0; b < 2; ++b)
#pragma unroll
                for (int m = 0; m < 4; ++m)
#pragma unroll
                    for (int n = 0; n < 2; ++n) acc[a][b][m][n] = (f32x4){0.f, 0.f, 0.f, 0.f};
        cur = nxt; cA = nA; cB = nB; ++ui;
        if constexpr (ALIGN_EPI) { if (wr == 1) PG8_BAR; }
    }
    PG8_WAIT_V(0);
    if constexpr (!ALIGN_EPI) { if (wr == 0) PG8_BAR; }
    PG8_BAR;
    if constexpr (Epi::AFTER_DRAIN) { E.fused(acc, cur, wr, wc, fr, fq, lds, wid, lane); S.done(cur); }
#undef PG8_SA
#undef PG8_SB
#undef PG8_STAGE
#undef PG8_LDA
#undef PG8_LDB
#undef PG8_MMA
#undef PG8_WAIT_V
#undef PG8_WAIT_L
#undef PG8_BAR
#undef PG8_SCHED
}
}
#define XB_TMO      128
#define XB_XCNT(j)  (256  + 64 * (j))
#define XB_XSUB(j)  (1280 + 64 * (j))
#define XB_XGEN(j)  (2304 + 64 * (j))
#define XB_TOP      3328
#define XB_TOPGEN   3392
#define XCD_BAR_WORDS 3456
#define XB_SPIN_CAP (1u << 18)

__device__ __forceinline__ unsigned xb_ld(unsigned* p)              { return __hip_atomic_load(p, __ATOMIC_RELAXED, __HIP_MEMORY_SCOPE_AGENT); }
__device__ __forceinline__ unsigned xb_add(unsigned* p, unsigned v) { return __hip_atomic_fetch_add(p, v, __ATOMIC_RELAXED, __HIP_MEMORY_SCOPE_AGENT); }
__device__ __forceinline__ unsigned xb_xcc_id() { return (unsigned)__builtin_amdgcn_s_getreg((3 << 11) | 20) & 0xFu; }
#define XB_SPIN(cond, bar) do { unsigned _sp = 0; while (cond) { __builtin_amdgcn_s_sleep(1); \
    if ((++_sp & 255u) == 0u) { if (xb_ld(&(bar)[XB_TMO])) break; if (_sp > XB_SPIN_CAP) { atomicAdd(&(bar)[XB_TMO], 1u); break; } } } } while (0)

struct XcdBarrier {
    unsigned* bar; unsigned x;
    volatile LAS unsigned* st;
};

__device__ __forceinline__ XcdBarrier xcd_barrier_post(unsigned* bar, volatile LAS unsigned* st) {
    XcdBarrier b; b.bar = bar; b.x = xb_xcc_id(); b.st = st;
    if (threadIdx.x == 0) (void)xb_add(&bar[XB_XCNT(b.x)], 1u);
    return b;
}
__device__ __forceinline__ void xcd_barrier_complete(unsigned* bar, unsigned x, unsigned& nloc, unsigned& nx) {
    const unsigned G = gridDim.x * gridDim.y * gridDim.z;
    unsigned sum, cnt, mine, sp = 0u;
    for (;;) {
        sum = 0u; cnt = 0u; mine = 0u;
#pragma unroll
        for (unsigned j = 0; j < 16; ++j) { const unsigned c = xb_ld(&bar[XB_XCNT(j)]); sum += c; cnt += (c > 0u) ? 1u : 0u; mine = (j == x) ? c : mine; }
        if (sum == G) break;
        __builtin_amdgcn_s_sleep(1);
        if ((++sp & 255u) == 0u) { if (xb_ld(&bar[XB_TMO])) break; if (sp > XB_SPIN_CAP) { atomicAdd(&bar[XB_TMO], 1u); break; } }
    }
    nloc = mine > 0u ? mine : 1u; nx = cnt > 0u ? cnt : 1u;
}

__device__ __forceinline__ void xcd_barrier(const XcdBarrier& b) {
    asm volatile("s_waitcnt vmcnt(0)" ::: "memory");
    __syncthreads();
    if (threadIdx.x == 0) {
        unsigned* bar = b.bar;
        __builtin_amdgcn_s_waitcnt(0);
        unsigned nloc = b.st[0], nx = b.st[1];
        if (nloc == 0u) { xcd_barrier_complete(bar, b.x, nloc, nx); b.st[0] = nloc; b.st[1] = nx; }
        const unsigned old = xb_add(&bar[XB_XSUB(b.x)], 1u);
        const unsigned gen = old / nloc;
        if (old + 1u == (gen + 1u) * nloc) {
            __builtin_amdgcn_fence(__ATOMIC_RELEASE, "agent");
            asm volatile("s_waitcnt vmcnt(0)" ::: "memory");
            const unsigned og = xb_add(&bar[XB_TOP], 1u);
            const unsigned tg = og / nx;
            if (og + 1u == (tg + 1u) * nx) xb_add(&bar[XB_TOPGEN], 1u);
            else XB_SPIN(xb_ld(&bar[XB_TOPGEN]) == tg, bar);
            __builtin_amdgcn_fence(__ATOMIC_ACQUIRE, "agent");
            xb_add(&bar[XB_XGEN(b.x)], 1u);
            asm volatile("s_waitcnt vmcnt(0)" ::: "memory");
        } else {
            XB_SPIN(xb_ld(&bar[XB_XGEN(b.x)]) == gen, bar);
            __builtin_amdgcn_fence(__ATOMIC_ACQUIRE, "agent");
            asm volatile("s_waitcnt vmcnt(0)" ::: "memory");
        }
    }
    __syncthreads();
}

DI int crow16(int reg, int hf) { return (reg & 3) + 8 * (reg >> 2) + 4 * hf; }
DI unsigned cvtpk(float lo, float hi) { typedef float f2 __attribute__((ext_vector_type(2))); typedef __bf16 b2 __attribute__((ext_vector_type(2))); f2 v = {lo, hi}; b2 b = __builtin_convertvector(v, b2); return __builtin_bit_cast(unsigned, b); }
struct AttnP { const bf16_t* Q; const bf16_t* K; const bf16_t* VT; const bf16_t* Gt; bf16_t* Y; const float* relb; };

template <int MODE> DI void attn_unit(int unit, const AttnP& P, int lane) {
    const int ql = lane & 31, hf = lane >> 5;
    int b, h, kvh, qrow, NT, rp = 0, ci = 0, rs0 = 0, c0 = 0, qr = 0, qc = 0, rsq = 0, csq = 0;
    if (MODE == 0) { ci = unit & 3; rp = (unit >> 2) & 31; h = (unit >> 7) & 7; b = unit >> 10; kvh = h;
        qr = 2 * rp + (ql >> 4); qc = 16 * ci + (ql & 15); qrow = b * SEQ + qr * 64 + qc;
        rs0 = min(max(2 * rp - 4, 0), 56); const int rs1 = min(max(2 * rp - 3, 0), 56); NT = 8 + (rs1 + 8 - rs0);
        c0 = min(max(16 * ci - 8, 0), 32); rsq = min(max(qr - 4, 0), 56); csq = min(max(qc - 8, 0), 48);
    } else if (MODE == 1) { const int qt = unit & 7; h = (unit >> 3) & 7; b = unit >> 6; kvh = h; qrow = NLAT + b * LC + 32 * qt + ql; NT = 8; }
    else { const int qt = unit & 127; h = (unit >> 7) & 7; b = unit >> 10; kvh = h >> 2; qrow = b * SEQ + 32 * qt + ql; NT = POSN / 32; }
    const bf16_t* qp; const bf16_t* kb; size_t kpitch; const bf16_t* vt; const bf16_t* gp; bf16_t* yp;
    if (MODE == 2) { qp = P.Q + ((size_t)(b * 8 + h) * SEQ + (qrow - b * SEQ)) * 64; kb = P.K + (size_t)(b * 2 + kvh) * POSN * 64; kpitch = 64;
        vt = P.VT + (size_t)(b * 2 + kvh) * 64 * POSN; gp = P.Gt + (size_t)qrow * N1 + 1792 + h * 64; }
    else { qp = P.Q + (size_t)qrow * N0 + 1024 + h * 64; kb = P.K + 1536 + h * 64; kpitch = N0; vt = P.VT + (size_t)(b * 8 + h) * 64 * POSN; gp = P.Gt + (size_t)qrow * N0 + 2560 + h * 64; }
    yp = P.Y + (size_t)qrow * DM + 512 + h * 64;
    bf16x8_t qf[4];
#pragma unroll
    for (int ks = 0; ks < 4; ++ks) qf[ks] = *(const bf16x8_t*)(qp + 16 * ks + 8 * hf);
    const bf16_t* vt0 = vt + (size_t)ql * POSN + 4 * hf;
    f32x16_t o0 = {}, o1 = {};
    float m = -1e30f, l = 0.f;
    auto tile_krow = [&](int t) -> int { if (MODE == 2) return 32 * t + ql; if (t < 8) return NLAT + b * LC + 32 * t + ql; return b * SEQ + (rs0 + t - 8) * 64 + c0 + ql; };
    auto tile_pos0 = [&](int t) -> int { if (MODE == 2) return 32 * t; if (t < 8) return 32 * t; return LC + (rs0 + t - 8) * 64 + c0; };
    bf16x8_t kn[4];
    { const bf16_t* kp = kb + (size_t)tile_krow(0) * kpitch + 8 * hf;
#pragma unroll
      for (int ks = 0; ks < 4; ++ks) kn[ks] = *(const bf16x8_t*)(kp + 16 * ks); }
#pragma unroll 1
    for (int t = 0; t < NT; ++t) {
        bf16x8_t kf[4];
#pragma unroll
        for (int ks = 0; ks < 4; ++ks) kf[ks] = kn[ks];
        if (t + 1 < NT) { const bf16_t* kp = kb + (size_t)tile_krow(t + 1) * kpitch + 8 * hf;
#pragma unroll
            for (int ks = 0; ks < 4; ++ks) kn[ks] = *(const bf16x8_t*)(kp + 16 * ks); }
        const bf16_t* vp = vt0 + tile_pos0(t);
        s16x4_t va[2][2][2];
#pragma unroll
        for (int dt = 0; dt < 2; ++dt)
#pragma unroll
            for (int s = 0; s < 2; ++s) { va[dt][s][0] = *(const s16x4_t*)(vp + (size_t)dt * 32 * POSN + 16 * s); va[dt][s][1] = *(const s16x4_t*)(vp + (size_t)dt * 32 * POSN + 16 * s + 8); }
        f32x16_t sc = {};
#pragma unroll
        for (int ks = 0; ks < 4; ++ks) sc = __builtin_amdgcn_mfma_f32_32x32x16_bf16(kf[ks], qf[ks], sc, 0, 0, 0);
        float xs[16];
        if (MODE == 0 && t >= 8) {
            const int kr = rs0 + t - 8; const bool row_ok = (kr >= rsq) && (kr < rsq + 8);
            const float* rb = P.relb + (h * 15 + (kr - qr + 7)) * 31 + (15 - qc);
#pragma unroll
            for (int r = 0; r < 16; ++r) { const int kc = c0 + crow16(r, hf); const bool ok = row_ok && (kc >= csq) && (kc < csq + 16);
                const float bias = ok ? rb[kc] : 0.f; xs[r] = ok ? (sc[r] * 0.125f + bias) * LOG2E : -1e30f; }
        } else {
#pragma unroll
            for (int r = 0; r < 16; ++r) xs[r] = (MODE == 2) ? sc[r] : sc[r] * (0.125f * LOG2E);
        }
        float tm = xs[0];
#pragma unroll
        for (int r = 1; r < 16; ++r) tm = fmaxf(tm, xs[r]);
        tm = fmaxf(tm, __shfl_xor(tm, 32));
        const float mn = fmaxf(m, tm), al = __builtin_amdgcn_exp2f(m - mn);
        float ps = 0.f;
#pragma unroll
        for (int r = 0; r < 16; ++r) { xs[r] = __builtin_amdgcn_exp2f(xs[r] - mn); ps += xs[r]; }
        l = l * al + ps; m = mn;
#pragma unroll
        for (int r = 0; r < 16; ++r) { o0[r] *= al; o1[r] *= al; }
        bf16x8_t pf[2];
#pragma unroll
        for (int s = 0; s < 2; ++s) { v4u w; w.x = cvtpk(xs[8 * s], xs[8 * s + 1]); w.y = cvtpk(xs[8 * s + 2], xs[8 * s + 3]); w.z = cvtpk(xs[8 * s + 4], xs[8 * s + 5]); w.w = cvtpk(xs[8 * s + 6], xs[8 * s + 7]);
            pf[s] = __builtin_bit_cast(bf16x8_t, w); }
#pragma unroll
        for (int s = 0; s < 2; ++s) {
            const bf16x8_t a0 = __builtin_shufflevector(va[0][s][0], va[0][s][1], 0, 1, 2, 3, 4, 5, 6, 7);
            const bf16x8_t a1 = __builtin_shufflevector(va[1][s][0], va[1][s][1], 0, 1, 2, 3, 4, 5, 6, 7);
            o0 = __builtin_amdgcn_mfma_f32_32x32x16_bf16(a0, pf[s], o0, 0, 0, 0);
            o1 = __builtin_amdgcn_mfma_f32_32x32x16_bf16(a1, pf[s], o1, 0, 0, 0);
        }
    }
    l += __shfl_xor(l, 32);
    const float rl = 1.f / l;
#pragma unroll
    for (int dt = 0; dt < 2; ++dt)
#pragma unroll
        for (int rg = 0; rg < 4; ++rg) { const int d = 32 * dt + 8 * rg + 4 * hf;
            const v2u gv = *(const v2u*)(gp + d);
            const float g0 = silu_f(bflo(gv.x)), g1 = silu_f(bfhi(gv.x)), g2 = silu_f(bflo(gv.y)), g3 = silu_f(bfhi(gv.y));
            const f32x16_t& oo = dt ? o1 : o0;
            v2u w; w.x = pk2(oo[4 * rg] * rl * g0, oo[4 * rg + 1] * rl * g1); w.y = pk2(oo[4 * rg + 2] * rl * g2, oo[4 * rg + 3] * rl * g3);
            *(v2u*)(yp + d) = w; }
}

constexpr int LRU_NCH = 34;
typedef float f32x2_t __attribute__((ext_vector_type(2)));
struct LruP { const bf16_t* P1; const float* conv_w; const float* conv_b; const float* lam; const float* b_a; const float* b_x; const bf16_t* WT; f32x2_t* LSUM; bf16_t* YMIX; };

template <bool PASS2> DI void lru_item(int item, const LruP& p, LAS unsigned char* lds, int tid, int wave, int lane) {
    LAS bf16_t* XA = (LAS bf16_t*)lds;
    LAS float* XF = (LAS float*)(lds + 18432);
    LAS float* CW = (LAS float*)(lds + 18432 + 33280);
    LAS f32x2_t* SEG = (LAS f32x2_t*)(lds + 18432 + 33280 + 1280);
    LAS f32x2_t* CS = (LAS f32x2_t*)(lds + 18432 + 33280 + 1280 + 4096);
    LAS float* CC = (LAS float*)(lds + 18432 + 33280 + 1280 + 4096 + 34816);
    int nb, cidx, b;
    if (PASS2) { nb = item & 7; cidx = 2 + ((item >> 3) & 31); b = item >> 8; } else { nb = item & 7; cidx = (item >> 3) % LRU_NCH; b = (item >> 3) / LRU_NCH; }
    const int s0 = cidx < 2 ? NLAT + b * LC : b * SEQ, sl = cidx < 2 ? LC : SEQ, t0 = cidx < 2 ? cidx * 128 : (cidx - 2) * 128;
    const int n = lane & 15, q = lane >> 4;
    __syncthreads();
    if (tid < 320) CW[tid] = tid < 256 ? p.conv_w[(tid >> 6) * 512 + nb * 64 + (tid & 63)] : p.conv_b[nb * 64 + (tid & 63)];
    if (PASS2) { for (int e = tid; e < 2 * LRU_NCH * 64; e += NTHREADS) { const int ch = e & 63, cc = (e >> 6) % LRU_NCH, dir = (e >> 6) / LRU_NCH; CS[e] = p.LSUM[((size_t)(b * LRU_NCH + cc) * 2 + dir) * 512 + nb * 64 + ch]; } }
    __syncthreads();
    {
        const int tl = tid >> 2, cg = tid & 3;
        float xv[4][16];
#pragma unroll
        for (int j = 0; j < 4; ++j) { const int tt = t0 + tl + j - 1; const bool ok = tt >= 0 && tt < sl;
            v4u w0 = {0u, 0u, 0u, 0u}, w1 = {0u, 0u, 0u, 0u};
            if (ok) { const bf16_t* src = p.P1 + (size_t)(s0 + tt) * N1 + nb * 64 + cg * 16; w0 = *(const v4u*)src; w1 = *(const v4u*)(src + 8); }
            xv[j][0] = bflo(w0.x); xv[j][1] = bfhi(w0.x); xv[j][2] = bflo(w0.y); xv[j][3] = bfhi(w0.y); xv[j][4] = bflo(w0.z); xv[j][5] = bfhi(w0.z); xv[j][6] = bflo(w0.w); xv[j][7] = bfhi(w0.w);
            xv[j][8] = bflo(w1.x); xv[j][9] = bfhi(w1.x); xv[j][10] = bflo(w1.y); xv[j][11] = bfhi(w1.y); xv[j][12] = bflo(w1.z); xv[j][13] = bfhi(w1.z); xv[j][14] = bflo(w1.w); xv[j][15] = bfhi(w1.w); }
#pragma unroll
        for (int e = 0; e < 16; ++e) { const int c = cg * 16 + e;
            const float xc = CW[c] * xv[0][e] + CW[64 + c] * xv[1][e] + CW[128 + c] * xv[2][e] + CW[192 + c] * xv[3][e] + CW[256 + c];
            XF[tl * 65 + c] = xc; XA[tl * 72 + c] = f2bf(xc); }
    }
    __syncthreads();
    bf16x8_t af[2];
#pragma unroll
    for (int ks = 0; ks < 2; ++ks) af[ks] = *(const LAS bf16x8_t*)(XA + (wave * 16 + n) * 72 + 32 * ks + 8 * q);
    float hsum[4][4];
#pragma unroll
    for (int c4 = 0; c4 < 4; ++c4)
#pragma unroll
        for (int r = 0; r < 4; ++r) hsum[c4][r] = 0.f;
#pragma unroll 1
    for (int dir = 0; dir < 2; ++dir) {
        f32x4_t acc[8];
#pragma unroll
        for (int nt = 0; nt < 8; ++nt) { acc[nt] = (f32x4_t){0.f, 0.f, 0.f, 0.f};
            const bf16_t* wrow = p.WT + (size_t)(nb * 256 + (dir * 2 + (nt >> 2)) * 64 + (nt & 3) * 16 + n) * 64 + 8 * q;
#pragma unroll
            for (int ks = 0; ks < 2; ++ks) { const bf16x8_t bfr = *(const bf16x8_t*)(wrow + 32 * ks); acc[nt] = __builtin_amdgcn_mfma_f32_16x16x32_bf16(af[ks], bfr, acc[nt], 0, 0, 0); } }
        float a[4][4], bt[4][4];
#pragma unroll
        for (int c4 = 0; c4 < 4; ++c4) { const int ch = nb * 64 + c4 * 16 + n;
            const float ba = p.b_a[dir * 512 + ch], bx = p.b_x[dir * 512 + ch], lm = p.lam[dir * 512 + ch]; const float sp = log1pf(__expf(-lm));
#pragma unroll
            for (int r = 0; r < 4; ++r) { const float gr = sigmoid_f(acc[c4][r] + ba), gi = sigmoid_f(acc[c4 + 4][r] + bx);
                const float log_a = -8.f * gr * sp; const float av = __builtin_amdgcn_exp2f(log_a * LOG2E); a[c4][r] = av;
                const float x2 = 2.f * log_a;
                const float ser = -x2 * (1.f + x2 * (0.5f + x2 * (0.16666667f + x2 * (0.041666668f + x2 * 0.0083333338f))));
                const float om = x2 > -0.5f ? ser : 1.f - av * av;
                const float mult = __builtin_amdgcn_sqrtf(fmaxf(om, 0.f));
                bt[c4][r] = mult * gi * XF[(wave * 16 + 4 * q + r) * 65 + c4 * 16 + n]; } }
        float Pq[4], Sq[4];
#pragma unroll
        for (int c4 = 0; c4 < 4; ++c4) { float P = 1.f, S = 0.f;
#pragma unroll
            for (int rr = 0; rr < 4; ++rr) { const int r = dir == 0 ? rr : 3 - rr; S = a[c4][r] * S + bt[c4][r]; P *= a[c4][r]; }
            Pq[c4] = P; Sq[c4] = S; }
        float Pin[4], Sin[4];
#pragma unroll
        for (int c4 = 0; c4 < 4; ++c4) { float P = 1.f, S = 0.f, Pw = 1.f, Sw = 0.f;
#pragma unroll
            for (int kk = 0; kk < 4; ++kk) { const int k = dir == 0 ? kk : 3 - kk;
                const float pk = __shfl(Pq[c4], n + 16 * k), sk = __shfl(Sq[c4], n + 16 * k);
                const bool before = dir == 0 ? (k < q) : (k > q);
                if (before) { S = pk * S + sk; P *= pk; }
                Sw = pk * Sw + sk; Pw *= pk; }
            Pin[c4] = P; Sin[c4] = S;
            if (q == 0) SEG[wave * 64 + c4 * 16 + n] = (f32x2_t){Pw, Sw}; }
        __syncthreads();
        if (!PASS2) {
            if (tid < 64) { float P = 1.f, S = 0.f;
#pragma unroll
                for (int ww = 0; ww < 8; ++ww) { const int w = dir == 0 ? ww : 7 - ww; const f32x2_t s = SEG[w * 64 + tid]; S = s[0] * S + s[1]; P *= s[0]; }
                p.LSUM[((size_t)(b * LRU_NCH + cidx) * 2 + dir) * 512 + nb * 64 + tid] = (f32x2_t){P, S}; }
            __syncthreads();
        } else {
            if (tid < 64) {
                float S = 0.f;
                if (dir == 0) { for (int cc = 0; cc < cidx; ++cc) { const f32x2_t s = CS[(0 * LRU_NCH + cc) * 64 + tid]; S = s[0] * S + s[1]; } }
                else { for (int cc = 1; cc >= 0; --cc) { const f32x2_t s = CS[(1 * LRU_NCH + cc) * 64 + tid]; S = s[0] * S + s[1]; }
                       for (int cc = LRU_NCH - 1; cc > cidx; --cc) { const f32x2_t s = CS[(1 * LRU_NCH + cc) * 64 + tid]; S = s[0] * S + s[1]; } }
                CC[dir * 64 + tid] = S; }
            __syncthreads();
#pragma unroll
            for (int c4 = 0; c4 < 4; ++c4) { float h = CC[dir * 64 + c4 * 16 + n];
                for (int ww = 0; ww < 8; ++ww) { const int w = dir == 0 ? ww : 7 - ww; const bool before = dir == 0 ? (w < wave) : (w > wave);
                    if (before) { const f32x2_t s = SEG[w * 64 + c4 * 16 + n]; h = s[0] * h + s[1]; } }
                h = Pin[c4] * h + Sin[c4];
#pragma unroll
                for (int rr = 0; rr < 4; ++rr) { const int r = dir == 0 ? rr : 3 - rr; h = a[c4][r] * h + bt[c4][r]; hsum[c4][r] += h; } }
            __syncthreads();
        }
    }
    if (PASS2) {
#pragma unroll
        for (int c4 = 0; c4 < 4; ++c4)
#pragma unroll
            for (int r = 0; r < 4; ++r) { const size_t row = (size_t)(s0 + t0 + wave * 16 + 4 * q + r); const int ch = nb * 64 + c4 * 16 + n;
                const float gc = bf2f(p.P1[row * N1 + 512 + ch]); p.YMIX[row * DM + ch] = f2bf(hsum[c4][r] * silu_f(gc)); }
    }
}

DI void qkprep_row(int r, const bf16_t* P1, const float* qn, const float* kn, const float* ROPE, bf16_t* QP, bf16_t* KP, int lane) {
    const int b = row_batch(r); const bool lat = r < NLAT; const int t = r & 4095;
    float cs = 1.f, sn = 0.f;
    if (lat) { const f32x2_t cv = *(const f32x2_t*)(ROPE + ((size_t)t * 32 + (lane >> 1)) * 2); cs = cv[0]; sn = cv[1]; }
    const float wq = qn[lane], wk = kn[lane];
#pragma unroll 2
    for (int slot = lat ? 0 : 8; slot < 10; ++slot) {
        const int col0 = slot < 8 ? 1024 + slot * 64 : 1536 + (slot - 8) * 64;
        const float x = bf2f(P1[(size_t)r * N1 + col0 + lane]);
        const float ss = wave_sum(x * x);
        float y = x * rsqrtf(ss * (1.f / 64.f) + EPSN) * (slot < 8 ? wq : wk);
        if (lat) { const float pr = __shfl_xor(y, 1); y = (lane & 1) ? (pr * sn + y * cs) : (y * cs - pr * sn); }
        if (slot < 8) QP[((size_t)(b * 8 + slot) * SEQ + t) * 64 + lane] = f2bf(y * (0.125f * LOG2E));
        else KP[((size_t)(b * 2 + (slot - 8)) * POSN + row_pos(r)) * 64 + lane] = f2bf(y);
    }
}

constexpr size_t WS_CARRY0 = 246 * MiB;
constexpr int S5_NCOL = 272;

DI void s5_lambar_pow(double lre, double lim, double dt, int e, double& pr, double& pi) { const double mag = exp(lre * dt * e), ang = lim * dt * e; pr = mag * cos(ang); pi = mag * sin(ang); }
typedef double f64x2_t __attribute__((ext_vector_type(2)));
DI void s5_tables_block(int gd, const float* lam_re, const float* lam_im, const float* log_dt, const float* b_re, const float* b_im, const float* c_re, const float* c_im,
                        bf16_t* W16, bf16_t* WC, bf16_t* KT, float* L16, LAS unsigned char* lds, int tid) {
    const int g = gd >> 1, dir = gd & 1, gi = dir * 32 + g;
    LAS f64x2_t* POW = (LAS f64x2_t*)lds;
    LAS f64x2_t* PC = POW + 17 * 64;
    __syncthreads();
    const double dt = exp((double)log_dt[gi]);
    for (int idx = tid; idx < 17 * 64; idx += NTHREADS) { const int e = idx >> 6, p = idx & 63;
        const double lre = lam_re[gi * 64 + p], lim = lam_im[gi * 64 + p];
        double pr, pi, l1r, l1i; s5_lambar_pow(lre, lim, dt, e, pr, pi); s5_lambar_pow(lre, lim, dt, 1, l1r, l1i);
        const double nr = l1r - 1.0, ni = l1i, den = lre * lre + lim * lim, cfr = (nr * lre + ni * lim) / den, cfi = (ni * lre - nr * lim) / den;
        POW[idx] = (f64x2_t){pr, pi}; PC[idx] = (f64x2_t){pr * cfr - pi * cfi, pr * cfi + pi * cfr};
        if (e == 16) { L16[((g * 2 + dir) * 64 + p) * 2] = (float)pr; L16[((g * 2 + dir) * 64 + p) * 2 + 1] = (float)pi; } }
    __syncthreads();
    for (int idx = tid; idx < 128 * 256; idx += NTHREADS) { const int row = idx >> 8, k = idx & 255, p = row >> 1, c = row & 1, tp = k >> 4, hi = k & 15;
        const f64x2_t z = PC[(dir == 0 ? 15 - tp : tp) * 64 + p]; const double br = b_re[(gi * 64 + p) * 16 + hi], bi = b_im[(gi * 64 + p) * 16 + hi];
        W16[(size_t)(gd * 128 + row) * 256 + k] = f2bf((float)(c == 0 ? z[0] * br - z[1] * bi : z[0] * bi + z[1] * br)); }
    for (int idx = tid; idx < 256 * 128; idx += NTHREADS) { const int row = idx >> 7, k = idx & 127, p = k >> 1, c = k & 1, t = row >> 4, ho = row & 15;
        const f64x2_t z = POW[((dir == 0 ? t : 15 - t) + 1) * 64 + p]; const double cr = c_re[(gi * 16 + ho) * 64 + p], ci = c_im[(gi * 16 + ho) * 64 + p];
        WC[(size_t)(gd * 256 + row) * 128 + k] = f2bf((float)(c == 0 ? cr * z[0] - ci * z[1] : -(cr * z[1] + ci * z[0]))); }
    for (int idx = tid; idx < 4096; idx += NTHREADS) { const int tau = idx >> 8, ho = (idx >> 4) & 15, hi = idx & 15;
        double acc = 0.0;
        for (int p = 0; p < 64; ++p) { const f64x2_t z = PC[tau * 64 + p]; const double cr = c_re[(gi * 16 + ho) * 64 + p], ci = c_im[(gi * 16 + ho) * 64 + p];
            const double ar = cr * z[0] - ci * z[1], ai = cr * z[1] + ci * z[0];
            acc += ar * (double)b_re[(gi * 64 + p) * 16 + hi] - ai * (double)b_im[(gi * 64 + p) * 16 + hi]; }
        KT[(size_t)gd * 4096 + idx] = f2bf((float)acc); }
}

DI int s5_tile_row0(int b, int s) { return s == 0 ? NLAT + b * LC : b * SEQ + (s - 1) * 256; }
DI void cmul(float ar, float ai, float br, float bi, float& cr, float& ci) { cr = ar * br - ai * bi; ci = ar * bi + ai * br; }

DI void s5_scan_unit(int unit, const bf16_t* PROJ, const bf16_t* W16, const float* L16, bf16_t* CARRY0, bf16_t* CARRY1, int lane) {
    const int wl = unit & 3, dir = (unit >> 2) & 1, b = (unit >> 3) & 3, g = unit >> 5;
    const int n = lane & 15, q = lane >> 4;
    bf16x8_t wf[2][8];
#pragma unroll
    for (int m2 = 0; m2 < 2; ++m2)
#pragma unroll
        for (int ks = 0; ks < 8; ++ks) wf[m2][ks] = *(const bf16x8_t*)(W16 + ((size_t)(g * 2 + dir) * 128 + (2 * wl + m2) * 16 + n) * 256 + 32 * ks + 8 * q);
    float Lr[2][2][5], Li[2][2][5];
    float Lnr[2][2], Lni[2][2];
    float cr[2][2], ci[2][2];
#pragma unroll
    for (int m2 = 0; m2 < 2; ++m2)
#pragma unroll
        for (int st = 0; st < 2; ++st) { const int p = 8 * (2 * wl + m2) + 2 * q + st;
            Lr[m2][st][0] = L16[((g * 2 + dir) * 64 + p) * 2]; Li[m2][st][0] = L16[((g * 2 + dir) * 64 + p) * 2 + 1];
#pragma unroll
            for (int k = 1; k < 5; ++k) cmul(Lr[m2][st][k - 1], Li[m2][st][k - 1], Lr[m2][st][k - 1], Li[m2][st][k - 1], Lr[m2][st][k], Li[m2][st][k]);
            float rr = 1.f, ri = 0.f;
#pragma unroll
            for (int k = 0; k < 5; ++k) if ((n + 1) & (1 << k)) { float tr, ti; cmul(rr, ri, Lr[m2][st][k], Li[m2][st][k], tr, ti); rr = tr; ri = ti; }
            Lnr[m2][st] = rr; Lni[m2][st] = ri; cr[m2][st] = 0.f; ci[m2][st] = 0.f; }
    bf16_t* CARRY = (dir == 0 ? CARRY0 : CARRY1) + (size_t)(b * 32 + g) * S5_NCOL * 128;
    const int jcol = dir == 0 ? n : 15 - n;
#pragma unroll 1
    for (int it = 0; it < 17; ++it) {
        const int s = it == 0 ? 0 : (dir == 0 ? it : 17 - it);
        const bf16_t* ub = PROJ + (size_t)(s5_tile_row0(b, s) + jcol * 16 + (q >> 1)) * N0 + g * 16 + 8 * (q & 1);
        bf16x8_t uf[8];
#pragma unroll
        for (int ks = 0; ks < 8; ++ks) uf[ks] = *(const bf16x8_t*)(ub + (size_t)(2 * ks) * N0);
        f32x4_t acc[2] = {{0.f, 0.f, 0.f, 0.f}, {0.f, 0.f, 0.f, 0.f}};
#pragma unroll
        for (int ks = 0; ks < 8; ++ks) { acc[0] = __builtin_amdgcn_mfma_f32_16x16x32_bf16(wf[0][ks], uf[ks], acc[0], 0, 0, 0); acc[1] = __builtin_amdgcn_mfma_f32_16x16x32_bf16(wf[1][ks], uf[ks], acc[1], 0, 0, 0); }
#pragma unroll
        for (int m2 = 0; m2 < 2; ++m2) {
            float hin[4];
#pragma unroll
            for (int st = 0; st < 2; ++st) {
                float xr = acc[m2][2 * st], xi = acc[m2][2 * st + 1];
#pragma unroll
                for (int k = 0; k < 4; ++k) { const int d = 1 << k; const float yr = __shfl_up(xr, d, 16), yi = __shfl_up(xi, d, 16);
                    if (n >= d) { float tr, ti; cmul(Lr[m2][st][k], Li[m2][st][k], yr, yi, tr, ti); xr += tr; xi += ti; } }
                float tr, ti; cmul(Lnr[m2][st], Lni[m2][st], cr[m2][st], ci[m2][st], tr, ti);
                const float Hr = xr + tr, Hi = xi + ti;
                const float pr = __shfl_up(Hr, 1, 16), pi = __shfl_up(Hi, 1, 16);
                hin[2 * st] = n == 0 ? cr[m2][st] : pr; hin[2 * st + 1] = n == 0 ? ci[m2][st] : pi;
                cr[m2][st] = __shfl(Hr, (lane & 48) | 15); ci[m2][st] = __shfl(Hi, (lane & 48) | 15);
            }
            v2u w; w.x = pk2(hin[0], hin[1]); w.y = pk2(hin[2], hin[3]);
            *(v2u*)(CARRY + (size_t)(s * 16 + jcol) * 128 + (2 * wl + m2) * 16 + 4 * q) = w;
        }
    }
}

DI void s5_out_item(int g, int b, int s, const bf16_t* PROJ, const bf16_t* WC, const bf16_t* CARRY0, const bf16_t* CARRY1, const float* dsk, bf16_t* YPRE, LAS unsigned char* lds, int wave, int lane) {
    const int n = lane & 15, q = lane >> 4;
    const int row0 = s5_tile_row0(b, s);
    const bf16_t* ub = PROJ + (size_t)(row0 + n * 16 + (q >> 1)) * N0 + g * 16 + 8 * (q & 1);
    bf16x8_t uf[8];
#pragma unroll
    for (int ks = 0; ks < 8; ++ks) uf[ks] = *(const bf16x8_t*)(ub + (size_t)(2 * ks) * N0);
    bf16x8_t cf[2][4];
#pragma unroll
    for (int dir = 0; dir < 2; ++dir)
#pragma unroll
        for (int ks = 0; ks < 4; ++ks) cf[dir][ks] = *(const bf16x8_t*)((dir == 0 ? CARRY0 : CARRY1) + ((size_t)(b * 32 + g) * S5_NCOL + s * 16 + n) * 128 + 32 * ks + 8 * q);
    const LAS bf16_t* KTl = (const LAS bf16_t*)lds;
#pragma unroll
    for (int m2 = 0; m2 < 2; ++m2) {
        const int mt = 2 * wave + m2;
        f32x4_t acc = {0.f, 0.f, 0.f, 0.f};
#pragma unroll
        for (int dir = 0; dir < 2; ++dir) {
            const bf16_t* wc = WC + ((size_t)(g * 2 + dir) * 256 + mt * 16 + n) * 128 + 8 * q;
#pragma unroll
            for (int ks = 0; ks < 4; ++ks) { const bf16x8_t a = *(const bf16x8_t*)(wc + 32 * ks); acc = __builtin_amdgcn_mfma_f32_16x16x32_bf16(a, cf[dir][ks], acc, 0, 0, 0); }
#pragma unroll
            for (int ks = 0; ks < 8; ++ks) {
                const bool need = dir == 0 ? (2 * ks <= mt) : (2 * ks + 1 >= mt);
                if (need) { const int tp = 2 * ks + (q >> 1), tau = dir == 0 ? mt - tp : tp - mt;
                    bf16x8_t a = {0, 0, 0, 0, 0, 0, 0, 0};
                    if (tau >= 0) a = *(const LAS bf16x8_t*)(KTl + ((dir * 16 + tau) * 16 + n) * 16 + 8 * (q & 1));
                    acc = __builtin_amdgcn_mfma_f32_16x16x32_bf16(a, uf[ks], acc, 0, 0, 0); }
            }
        }
        const size_t tok = (size_t)(row0 + n * 16 + mt);
        const v2u uu = *(const v2u*)(PROJ + tok * N0 + g * 16 + 4 * q);
        const f32x4_t dd = *(const f32x4_t*)(dsk + g * 16 + 4 * q);
        const float y0 = gelu_fast(acc[0] + dd[0] * bflo(uu.x)), y1 = gelu_fast(acc[1] + dd[1] * bfhi(uu.x)), y2 = gelu_fast(acc[2] + dd[2] * bflo(uu.y)), y3 = gelu_fast(acc[3] + dd[3] * bfhi(uu.y));
        v2u w; w.x = pk2(y0, y1); w.y = pk2(y2, y3);
        *(v2u*)(YPRE + tok * 512 + g * 16 + 4 * q) = w;
    }
}

#include <hip/hip_bf16.h>
namespace gqa_body {
using bf16=__hip_bfloat16;
using bf16x8=__attribute__((ext_vector_type(8)))short;
using s16x4=__attribute__((ext_vector_type(4)))short;
using f32x16=__attribute__((ext_vector_type(16)))float;
using u32x4=__attribute__((ext_vector_type(4)))unsigned;
constexpr int NHEAD=8,SEQQ=4096,SKV=4352,D=64,QPITCH=64,KPITCH=64,VPITCH=64,OPITCH=1024,GPITCH=2304;
constexpr int NW=8,QBLK=32,QB=QBLK*NW,KVBLK=64,NQB=SEQQ/QB,NTILES=SKV/KVBLK;
constexpr int ATTN_UNIT_ROWS=QB;
__device__ __forceinline__ int crow(int r,int hi){return (r&3)+8*(r>>2)+4*hi;}
#define SBAR() __builtin_amdgcn_sched_barrier(0)
constexpr int NSLOT=3, SLOTB=8192;
constexpr int LDS_K=0, LDS_V=NSLOT*SLOTB, LDS_WS=2*NSLOT*SLOTB, LDS_OST=LDS_WS+NW*64*4, LDS_BYTES=LDS_OST+NW*4096;
constexpr float C2=0.125f*1.4426950408889634f;
__device__ __forceinline__ void glds16(const void*gsrc,unsigned lds_dst){unsigned keep;
  asm volatile("s_mov_b32 %0, m0\n\ts_mov_b32 m0, %2\n\ts_nop 0\n\tglobal_load_lds_dwordx4 %1, off\n\ts_mov_b32 m0, %0":"=&s"(keep):"v"(gsrc),"s"(lds_dst):"memory");}
__device__ __forceinline__ float max3f(float a,float b,float c){float r;asm("v_max3_f32 %0, %1, %2, %3":"=v"(r):"v"(a),"v"(b),"v"(c));return r;}
__device__ __forceinline__ float max2f(float a,float b){float r;asm("v_max_f32_e32 %0, %1, %2":"=v"(r):"v"(a),"v"(b));return r;}
__device__ __forceinline__ float fadd_s(float a,float b){float r;asm("v_add_f32_e32 %0, %1, %2":"=v"(r):"v"(a),"v"(b));return r;}
__device__ __forceinline__ float fsub_s(float a,float b){float r;asm("v_sub_f32_e32 %0, %1, %2":"=v"(r):"v"(a),"v"(b));return r;}
typedef float f32x2_t __attribute__((ext_vector_type(2))); typedef __bf16 bf16x2_t __attribute__((ext_vector_type(2)));
__device__ __forceinline__ unsigned cvtpk_s(float lo,float hi){f32x2_t v={lo,hi};bf16x2_t b=__builtin_convertvector(v,bf16x2_t);return __builtin_bit_cast(unsigned,b);}
#define WAIT_BAR(N) asm volatile("s_waitcnt vmcnt(" #N ") lgkmcnt(0)\n\ts_barrier":::"memory")

__device__ __forceinline__ void qkt(f32x16&p0,f32x16&p1,const char*Kslot,const bf16x8*qr,const f32x16&negm,int r32,int hi){
  const char*kb=Kslot+hi*1024+r32*16;
  #pragma unroll
  for(int d0=0;d0<4;++d0){
    const bf16x8 b0=*reinterpret_cast<const bf16x8*>(kb+d0*2048);
    const bf16x8 b1=*reinterpret_cast<const bf16x8*>(kb+d0*2048+512);
    if(d0==0){p0=__builtin_amdgcn_mfma_f32_32x32x16_bf16(b0,qr[0],negm,0,0,0);p1=__builtin_amdgcn_mfma_f32_32x32x16_bf16(b1,qr[0],negm,0,0,0);}
    else{p0=__builtin_amdgcn_mfma_f32_32x32x16_bf16(b0,qr[d0],p0,0,0,0);p1=__builtin_amdgcn_mfma_f32_32x32x16_bf16(b1,qr[d0],p1,0,0,0);}}
}
typedef __attribute__((address_space(3))) const char* lds_cptr;
typedef short v4i16_t __attribute__((ext_vector_type(4)));
__device__ __forceinline__ void kload8(bf16x8*kf,lds_cptr kp){
  kf[0]=*(const __attribute__((address_space(3))) bf16x8*)(kp);      kf[1]=*(const __attribute__((address_space(3))) bf16x8*)(kp+512);
  kf[2]=*(const __attribute__((address_space(3))) bf16x8*)(kp+2048); kf[3]=*(const __attribute__((address_space(3))) bf16x8*)(kp+2560);
  kf[4]=*(const __attribute__((address_space(3))) bf16x8*)(kp+4096); kf[5]=*(const __attribute__((address_space(3))) bf16x8*)(kp+4608);
  kf[6]=*(const __attribute__((address_space(3))) bf16x8*)(kp+6144); kf[7]=*(const __attribute__((address_space(3))) bf16x8*)(kp+6656);
}
__device__ __forceinline__ void kload2(bf16x8*kf,lds_cptr kp,int j){ kf[2*j]=*(const __attribute__((address_space(3))) bf16x8*)(kp+j*2048); kf[2*j+1]=*(const __attribute__((address_space(3))) bf16x8*)(kp+j*2048+512); }
__device__ __forceinline__ s16x4 vtr(lds_cptr p){ return __builtin_bit_cast(s16x4,__builtin_amdgcn_ds_read_tr16_b64_v4i16((__attribute__((address_space(3))) v4i16_t*)p)); }
__device__ __forceinline__ float rowmax(const f32x16&p0,const f32x16&p1){
  float a=max3f(p0[0],p0[1],p1[0]),b=max3f(p0[2],p0[3],p1[1]);a=max3f(a,p1[2],p1[3]);
  #pragma unroll
  for(int r=4;r<16;r+=4){a=max3f(a,p0[r],p0[r+1]);b=max3f(b,p0[r+2],p0[r+3]);a=max3f(a,p1[r],p1[r+1]);b=max3f(b,p1[r+2],p1[r+3]);}
  const float m=max2f(a,b);
  auto rr=__builtin_amdgcn_permlane32_swap(__float_as_uint(m),__float_as_uint(m),false,false);
  return max2f(__uint_as_float(rr[0]),__uint_as_float(rr[1]));
}
__device__ __forceinline__ void pv(f32x16*o,int vb,bf16x8 pa0,bf16x8 pa1,bf16x8 pa2,bf16x8 pa3){
  #pragma unroll
  for(int d0=0;d0<2;++d0){s16x4 lo[4],hi[4];
    #pragma unroll
    for(int ks=0;ks<4;++ks){
      asm volatile("ds_read_b64_tr_b16 %0,%1 offset:%c2":"=&v"(lo[ks]):"v"(vb),"i"(d0*4096+ks*1024):"memory");
      asm volatile("ds_read_b64_tr_b16 %0,%1 offset:%c2":"=&v"(hi[ks]):"v"(vb),"i"(d0*4096+ks*1024+512):"memory");}
    asm volatile("s_waitcnt lgkmcnt(0)":::"memory");SBAR();
    #define PK(k) (bf16x8){lo[k][0],lo[k][1],lo[k][2],lo[k][3],hi[k][0],hi[k][1],hi[k][2],hi[k][3]}
    o[d0]=__builtin_amdgcn_mfma_f32_32x32x16_bf16(pa0,PK(0),o[d0],0,0,0);
    o[d0]=__builtin_amdgcn_mfma_f32_32x32x16_bf16(pa1,PK(1),o[d0],0,0,0);
    o[d0]=__builtin_amdgcn_mfma_f32_32x32x16_bf16(pa2,PK(2),o[d0],0,0,0);
    o[d0]=__builtin_amdgcn_mfma_f32_32x32x16_bf16(pa3,PK(3),o[d0],0,0,0);
    #undef PK
  }
}

#ifndef ATTN_STORE16
#define ATTN_STORE16(p,v) (*(u32x4*)(p)=(v))
#endif
template<int THRL> __device__ __forceinline__ void attn_unit(int b,int h,int qb,const bf16*Q,const bf16*__restrict__ K,const bf16*__restrict__ V,bf16*O,const bf16*Gt,char*shm){
  const int tid=threadIdx.x,lane=tid&63,r32=lane&31,hi=lane>>5; const int wid=__builtin_amdgcn_readfirstlane(tid>>6);
  const int q0=qb*QB;
  const bf16*Qw=Q+((long)(b*NHEAD+h)*SEQQ+q0+wid*QBLK)*QPITCH;
  const bf16*Kh=K+(long)(b*2+(h>>2))*SKV*KPITCH,*Vh=V+(long)(b*2+(h>>2))*SKV*VPITCH;
  const unsigned lds0=(unsigned)(uintptr_t)shm;
  float*wsf=(float*)(shm+LDS_WS)+wid*64;
  const bf16*ksrc=Kh+(long)lane*KPITCH+wid*8;
  const bf16*vsrc=Vh+(long)(16*(wid&3)+(lane>>2))*VPITCH+(wid>>2)*32+(lane&3)*8;
  const unsigned kdst=lds0+LDS_K+wid*1024, vdst=lds0+LDS_V+wid*1024;
  #define DMA_K(t,slot) glds16(ksrc+(long)(t)*KVBLK*KPITCH,(unsigned)__builtin_amdgcn_readfirstlane(kdst+(slot)))
  #define DMA_V(t,slot) glds16(vsrc+(long)(t)*KVBLK*VPITCH,(unsigned)__builtin_amdgcn_readfirstlane(vdst+(slot)))
  const int vb0=(int)(lds0+LDS_V)+((lane>>4)&1)*32+(lane&3)*8+(4*hi+((lane&15)>>2))*64;
  const char*Kbase=shm+LDS_K; bf16x8 kf[8];
  const lds_cptr shm3=(lds_cptr)shm; const lds_cptr kp0=shm3+LDS_K+hi*1024+r32*16; const lds_cptr vp0=shm3+LDS_V+((lane>>4)&1)*32+(lane&3)*8+(4*hi+((lane&15)>>2))*64;
  constexpr int NT=NTILES;
  DMA_K(0,0);DMA_V(0,0);DMA_K(1,SLOTB);
  bf16x8 qr[4];
  #pragma unroll
  for(int d0=0;d0<4;++d0)qr[d0]=*reinterpret_cast<const bf16x8*>(&Qw[(long)r32*QPITCH+d0*16+hi*8]);
  float mhat=0.f,l_reg=0.f;f32x16 o[2];o[0]=f32x16{};o[1]=f32x16{};f32x16 negm=f32x16{};asm volatile("":"+v"(negm));
  #define CMASK(P0,P1,t) do{}while(0)
  bool resc=false;
  #define START(P0,P1) do{ const float rm=rowmax(P0,P1); resc=false; \
    { const float dl=rm; mhat=fadd_s(mhat,dl); \
      _Pragma("unroll") for(int r=0;r<16;++r){P0[r]=fsub_s(P0[r],dl);P1[r]=fsub_s(P1[r],dl);} \
      _Pragma("unroll") for(int r=0;r<16;++r)negm[r]=-mhat; asm volatile("":"+v"(negm)); } \
    _Pragma("unroll") for(int r=0;r<16;++r)P0[r]=__builtin_amdgcn_exp2f(P0[r]); }while(0)
  #define RESC() do{ if(resc){ asm volatile("s_waitcnt lgkmcnt(0)":::"memory"); \
      _Pragma("unroll") for(int d_=0;d_<2;++d_) _Pragma("unroll") for(int r=0;r<16;++r)o[d_][r]*=wsf[crow(r,hi)]; } }while(0)
  f32x16 pA0,pA1,pB0,pB1;
  int sl_prev=0,sl_cur=0,sl_next=SLOTB;
  #define ROT() do{sl_prev=sl_cur;sl_cur=sl_next;sl_next=(sl_next==(NSLOT-1)*SLOTB)?0:sl_next+SLOTB;}while(0)
  DMA_K(2,2*SLOTB);
  WAIT_BAR(3);
  qkt(pA0,pA1,Kbase,qr,negm,r32,hi);asm volatile("s_nop 15\n\ts_nop 7":"+v"(pA0),"+v"(pA1));CMASK(pA0,pA1,0);
  START(pA0,pA1);
  _Pragma("unroll") for(int r=0;r<16;++r)pA1[r]=__builtin_amdgcn_exp2f(pA1[r]);
  WAIT_BAR(0);
  DMA_K(3,0);DMA_V(1,SLOTB);
  ROT();
  kload8(kf,kp0+sl_cur);
  WAIT_BAR(2);
  s16x4 vlo[8],vhi[8]; u32x4 pw0,pw1,pw2,pw3;
  #define PKW(P,B) cvtpk_s(P[B],P[B+1])
  #define PAF(k) __builtin_bit_cast(bf16x8,pw##k)
  #define VFR(i) (bf16x8){vlo[i][0],vlo[i][1],vlo[i][2],vlo[i][3],vhi[i][0],vhi[i][1],vhi[i][2],vhi[i][3]}
  #define PIN(x) asm volatile("":"+v"(x))
  #define MX3(a,b,c) __builtin_fmaxf(__builtin_fmaxf((a),(b)),(c))
  #define GAPA(MF,A0,A1,A2,A3,W0,W1,PW) do{ MF; sacc+=A0; sacc+=A1; sacc+=A2; sacc+=A3; PIN(sacc); W0; W1; PIN(PW); SBAR(); }while(0)
  #define EX(v) __builtin_amdgcn_exp2f(v)
  #define GAPB(MF,X,B) do{ MF; X[B]=EX(X[B]); X[B+1]=EX(X[B+1]); X[B+2]=EX(X[B+2]); X[B+3]=EX(X[B+3]); PIN(X); SBAR(); }while(0)
  #define VRD(i) do{ vlo[i]=vtr(vp_+(((i)>>2)*4096+((i)&3)*1024)); vhi[i]=vtr(vp_+(((i)>>2)*4096+((i)&3)*1024+512)); }while(0)
  #define KRD(G,j) do{ if(G){ kload2(kf,kp0+sl_next,j); SBAR(); } }while(0)
  #define STEP(C0,C1,P0,P1,t,GK,GV,GL) do{ SBAR(); \
    const lds_cptr vp_=vp0+sl_prev; \
    VRD(0); SBAR(); float sacc=(P0[0]+P0[1]); \
    GAPA(C0=__builtin_amdgcn_mfma_f32_32x32x16_bf16(kf[0],qr[0],negm,0,0,0), P0[2],P0[3],P0[4],P0[5],     pw0[0]=PKW(P0,0), pw0[1]=PKW(P0,2), pw0); \
    VRD(4); SBAR(); GAPA(C1=__builtin_amdgcn_mfma_f32_32x32x16_bf16(kf[1],qr[0],negm,0,0,0), P0[6],P0[7],P0[8],P0[9],     pw0[2]=PKW(P0,4), pw0[3]=PKW(P0,6), pw0); \
    VRD(1); SBAR(); GAPA(C0=__builtin_amdgcn_mfma_f32_32x32x16_bf16(kf[2],qr[1],C0,0,0,0),   P0[10],P0[11],P0[12],P0[13], pw1[0]=PKW(P0,8), pw1[1]=PKW(P0,10), pw1); \
    VRD(5); SBAR(); GAPA(C1=__builtin_amdgcn_mfma_f32_32x32x16_bf16(kf[3],qr[1],C1,0,0,0),   P0[14],P0[15],P1[0],P1[1],   pw1[2]=PKW(P0,12),pw1[3]=PKW(P0,14), pw1); \
    VRD(2); SBAR(); GAPA(C0=__builtin_amdgcn_mfma_f32_32x32x16_bf16(kf[4],qr[2],C0,0,0,0),   P1[2],P1[3],P1[4],P1[5],     pw2[0]=PKW(P1,0), pw2[1]=PKW(P1,2), pw2); \
    VRD(6); SBAR(); GAPA(C1=__builtin_amdgcn_mfma_f32_32x32x16_bf16(kf[5],qr[2],C1,0,0,0),   P1[6],P1[7],P1[8],P1[9],     pw2[2]=PKW(P1,4), pw2[3]=PKW(P1,6), pw2); \
    VRD(3); SBAR(); GAPA(C0=__builtin_amdgcn_mfma_f32_32x32x16_bf16(kf[6],qr[3],C0,0,0,0),   P1[10],P1[11],P1[12],P1[13], pw3[0]=PKW(P1,8), pw3[1]=PKW(P1,10), pw3); \
    VRD(7); SBAR(); GAPA(C1=__builtin_amdgcn_mfma_f32_32x32x16_bf16(kf[7],qr[3],C1,0,0,0),   P1[14],P1[15],0.f,0.f,       pw3[2]=PKW(P1,12),pw3[3]=PKW(P1,14), pw3); \
    l_reg+=sacc; \
    if(GK){DMA_K((t)+3,sl_cur);} if(GV){DMA_V((t)+1,sl_next);} \
    CMASK(C0,C1,t); \
    { float a=MX3(C0[0],C0[1],C1[0]),b=MX3(C0[2],C0[3],C1[1]); a=MX3(a,C1[2],C1[3]); \
      _Pragma("unroll") for(int r=4;r<16;r+=4){a=MX3(a,C0[r],C0[r+1]);b=MX3(b,C0[r+2],C0[r+3]);a=MX3(a,C1[r],C1[r+1]);b=MX3(b,C1[r+2],C1[r+3]);} \
      float rm=__builtin_fmaxf(a,b); { auto rr=__builtin_amdgcn_permlane32_swap(__float_as_uint(rm),__float_as_uint(rm),false,false); rm=__builtin_fmaxf(__uint_as_float(rr[0]),__uint_as_float(rr[1])); } \
      resc=false; \
      if(__builtin_expect(__any(rm>(float)THRL),0)){ const float dl=__builtin_fmaxf(rm,0.f); mhat+=dl; \
        _Pragma("unroll") for(int r=0;r<16;++r){C0[r]-=dl;C1[r]-=dl;} \
        _Pragma("unroll") for(int r=0;r<16;++r)negm[r]=-mhat; asm volatile("":"+v"(negm)); \
        const float f=__builtin_amdgcn_exp2f(-dl); l_reg*=f; if(hi==0)wsf[r32]=f; resc=true; } } \
    SBAR(); \
    GAPB(o[0]=__builtin_amdgcn_mfma_f32_32x32x16_bf16(PAF(0),VFR(0),o[0],0,0,0), C0,0); \
    GAPB(o[1]=__builtin_amdgcn_mfma_f32_32x32x16_bf16(PAF(0),VFR(4),o[1],0,0,0), C0,4); \
    KRD(GL,0); GAPB(o[0]=__builtin_amdgcn_mfma_f32_32x32x16_bf16(PAF(1),VFR(1),o[0],0,0,0), C0,8); \
    KRD(GL,1); GAPB(o[1]=__builtin_amdgcn_mfma_f32_32x32x16_bf16(PAF(1),VFR(5),o[1],0,0,0), C0,12); \
    KRD(GL,2); GAPB(o[0]=__builtin_amdgcn_mfma_f32_32x32x16_bf16(PAF(2),VFR(2),o[0],0,0,0), C1,0); \
    KRD(GL,3); GAPB(o[1]=__builtin_amdgcn_mfma_f32_32x32x16_bf16(PAF(2),VFR(6),o[1],0,0,0), C1,4); \
    GAPB(o[0]=__builtin_amdgcn_mfma_f32_32x32x16_bf16(PAF(3),VFR(3),o[0],0,0,0), C1,8); \
    GAPB(o[1]=__builtin_amdgcn_mfma_f32_32x32x16_bf16(PAF(3),VFR(7),o[1],0,0,0), C1,12); \
    }while(0)
  int t=1;
  #undef CMASK
  #define CMASK(P0,P1,t) do{}while(0)
  for(;t+5<NT;t+=2){
    STEP(pB0,pB1,pA0,pA1,t,true,true,true);     WAIT_BAR(2); RESC(); ROT();
    STEP(pA0,pA1,pB0,pB1,t+1,true,true,true);   WAIT_BAR(2); RESC(); ROT();
  }
  #undef CMASK
  #define CMASK(P0,P1,t) do{}while(0)
  #define ENDW(tt) do{ if((tt)+3<NT){WAIT_BAR(2);} else if((tt)+2<NT){WAIT_BAR(1);} else {WAIT_BAR(0);} }while(0)
  for(;t+1<NT;t+=2){
    STEP(pB0,pB1,pA0,pA1,t,(t+3<NT),(t+1<NT),(t+1<NT));       ENDW(t);   RESC(); ROT();
    STEP(pA0,pA1,pB0,pB1,t+1,(t+4<NT),(t+2<NT),(t+2<NT));     ENDW(t+1); RESC(); ROT();
  }
  STEP(pB0,pB1,pA0,pA1,NT-1,false,false,false); RESC();
  { float sacc=pB0[0]+pB0[1]; _Pragma("unroll") for(int r=2;r<16;++r)sacc+=pB0[r]; _Pragma("unroll") for(int r=0;r<16;++r)sacc+=pB1[r]; l_reg+=sacc;
    pw0=(u32x4){PKW(pB0,0),PKW(pB0,2),PKW(pB0,4),PKW(pB0,6)};pw1=(u32x4){PKW(pB0,8),PKW(pB0,10),PKW(pB0,12),PKW(pB0,14)};pw2=(u32x4){PKW(pB1,0),PKW(pB1,2),PKW(pB1,4),PKW(pB1,6)};pw3=(u32x4){PKW(pB1,8),PKW(pB1,10),PKW(pB1,12),PKW(pB1,14)};
    SBAR(); pv(o,vb0+sl_cur,PAF(0),PAF(1),PAF(2),PAF(3)); }
  #undef PKW
  #undef PAF
  #undef VFR
  #undef PIN
  #undef MX3
  #undef GAPA
  #undef GAPB
  #undef EX
  #undef VRD
  #undef KRD
  #undef STEP
  #undef ENDW
  {auto rr=__builtin_amdgcn_permlane32_swap(__float_as_uint(l_reg),__float_as_uint(l_reg),false,false);l_reg=__uint_as_float(rr[0])+__uint_as_float(rr[1]);}
  if(hi==0)wsf[32+r32]=l_reg;asm volatile("s_waitcnt lgkmcnt(0)":::"memory");
  float rli[16];
  #pragma unroll
  for(int r=0;r<16;++r)rli[r]=__builtin_amdgcn_rcpf(wsf[32+crow(r,hi)]);
  bf16*Ow=O+((long)b*SEQQ+q0+wid*QBLK)*OPITCH+h*D; const bf16*Gw=Gt+((long)b*SEQQ+q0+wid*QBLK)*GPITCH+h*D;
  { bf16*stg=(bf16*)(shm+LDS_OST)+wid*2048;
    #pragma unroll
    for(int r=0;r<16;++r){const int orow=crow(r,hi);
      #pragma unroll
      for(int d0=0;d0<2;++d0)stg[orow*64+d0*32+r32]=__float2bfloat16(o[d0][r]*rli[r]);}
    asm volatile("s_waitcnt lgkmcnt(0)":::"memory");
    #pragma unroll
    for(int i=0;i<4;++i){const int row=i*8+(lane>>3),ch=lane&7; const u32x4 v=*(const u32x4*)(stg+row*64+ch*8); const u32x4 gv=*(const u32x4*)(Gw+(long)row*GPITCH+ch*8); u32x4 w;
      w.x=pk2(bflo(v.x)*silu_f(bflo(gv.x)),bfhi(v.x)*silu_f(bfhi(gv.x))); w.y=pk2(bflo(v.y)*silu_f(bflo(gv.y)),bfhi(v.y)*silu_f(bfhi(gv.y)));
      w.z=pk2(bflo(v.z)*silu_f(bflo(gv.z)),bfhi(v.z)*silu_f(bfhi(gv.z))); w.w=pk2(bflo(v.w)*silu_f(bflo(gv.w)),bfhi(v.w)*silu_f(bfhi(gv.w)));
      ATTN_STORE16(Ow+(long)row*OPITCH+ch*8,w);} }
  asm volatile("s_waitcnt lgkmcnt(0)\n\ts_barrier":::"memory");
  #undef DMA_K
  #undef DMA_V
  #undef CMASK
  #undef START
  #undef RESC
  #undef ROT
}
constexpr int ATTN_LDS_BYTES=LDS_BYTES;
#undef SBAR
#undef WAIT_BAR
}

struct Args { const float* in[32]; float* out; unsigned char* ws; int ph_lo, ph_hi, li, pad; };
constexpr int CW_NAQ = 2048;
constexpr int NA_UNITS = 4096 + 256;
DI void na_queue(const Args& args, gu32* ctl, int lane, int pass) {
    unsigned char* ws = args.ws; const bf16_t* PROJ = (const bf16_t*)(ws + WS_PROJ);
    const AttnP P{PROJ, PROJ, (const bf16_t*)(ws + WS_VT0), PROJ, (bf16_t*)(ws + WS_YMIX), args.in[20]};
    for (;;) {
        unsigned u = 0; if (lane == 0) u = __hip_atomic_fetch_add(ctl + CW_NAQ + 64 * pass, 1u, RLX_AGENT);
        u = (unsigned)__builtin_amdgcn_readfirstlane((int)u);
        if (u >= (unsigned)NA_UNITS) break;
        if (u < 4096u) attn_unit<0>((int)u, P, lane); else attn_unit<1>((int)u - 4096, P, lane);
    }
}
DI void phase3(const Args& args, LAS unsigned char* lds, int tid, int wave, int lane, int G, int pass) {
    unsigned char* ws = args.ws; gu32* ctl = (gu32*)(ws + WS_CTL);
    if (wave < 4) for (int cu = blockIdx.x; cu < 256; cu += G)
        s5_scan_unit(cu * 4 + wave, (const bf16_t*)(ws + WS_PROJ), (const bf16_t*)(ws + WS_W16), (const float*)(ws + WS_L16), (bf16_t*)(ws + WS_CARRY0), (bf16_t*)(ws + WS_CARRY1), lane);
    na_queue(args, ctl, lane, pass);
}
DI void phase4(const Args& args, LAS unsigned char* lds, int tid, int wave, int lane, int G) {
    unsigned char* ws = args.ws; gu32* ctl = (gu32*)(ws + WS_CTL);
    constexpr int NIT = 32 * 4 * 17;
    const int i0 = (int)(((long)blockIdx.x * NIT) / G), i1 = (int)(((long)(blockIdx.x + 1) * NIT) / G);
    int gcur = -1;
    for (int it = i0; it < i1; ++it) {
        const int g = it / 68, b = (it % 68) / 17, s = it % 17;
        if (g != gcur) { __syncthreads(); for (int e = tid; e < 1024; e += NTHREADS) ((LAS v4u*)lds)[e] = ((const v4u*)(ws + WS_KT))[(size_t)g * 1024 + e]; gcur = g; __syncthreads(); }
        s5_out_item(g, b, s, (const bf16_t*)(ws + WS_PROJ), (const bf16_t*)(ws + WS_WC), (const bf16_t*)(ws + WS_CARRY0), (const bf16_t*)(ws + WS_CARRY1), args.in[17], (bf16_t*)(ws + WS_YPRE), lds, wave, lane);
    }
    na_queue(args, ctl, lane, 0);
}
DI LruP make_lrup(const Args& args) { unsigned char* ws = args.ws;
    return LruP{(const bf16_t*)(ws + WS_PROJ), args.in[23], args.in[24], args.in[25], args.in[27], args.in[29], (const bf16_t*)(ws + WS_LRUWT), (f32x2_t*)(ws + WS_LSUM), (bf16_t*)(ws + WS_YMIX)}; }
DI void phase9(const Args& args, LAS unsigned char* lds, int tid, int wave, int lane, int G) {
    unsigned char* ws = args.ws; const LruP lp = make_lrup(args);
    for (int it = blockIdx.x; it < NB * LRU_NCH * 8; it += G) lru_item<false>(it, lp, lds, tid, wave, lane);
    const int gw = blockIdx.x * NWAVES + wave, NGW = G * NWAVES;
    for (int r = gw; r < MROWS; r += NGW) qkprep_row(r, (const bf16_t*)(ws + WS_PROJ), args.in[30], args.in[31], (const float*)(ws + WS_ROPE), (bf16_t*)(ws + WS_QP), (bf16_t*)(ws + WS_KP), lane);
}
DI void phase10(const Args& args, LAS unsigned char* lds, int tid, int wave, int lane, int G) {
    unsigned char* ws = args.ws;
    const LruP lp = make_lrup(args);
    for (int it = blockIdx.x; it < NB * 32 * 8; it += G) lru_item<true>(it, lp, lds, tid, wave, lane);
    __syncthreads();
    const int bx = blockIdx.x, vcu = (G % 8 == 0) ? (bx % 8) * (G / 8) + bx / 8 : bx;
    typedef gqa_body::bf16 abf;
    for (int u = vcu; u < 512; u += G) {
        const int qb = u & 15, hq = (u >> 4) & 7, b = u >> 7;
        gqa_body::attn_unit<8>(b, hq, qb, (const abf*)(ws + WS_QP), (const abf*)(ws + WS_KP), (const abf*)(ws + WS_VT1), (abf*)(ws + WS_YMIX) + 512, (const abf*)(ws + WS_PROJ) + 1792, (char*)lds);
    }
}

constexpr int RING_BYTES = 131072, LDSCTL_OFF = RING_BYTES, MISC_OFF = LDSCTL_OFF + 320, LDS_BYTES = 147456;
constexpr int CW_BAR = 4096;
constexpr int N_PHASES = 13;
constexpr bool kSP2 = true, kALIGN = true;

DI void p0_adaln(LAS unsigned char* lds, const float* c, const float* cctx, const float* ada_w, const float* ada_b, float* MOD, int tid, int wave, int lane, int G) {
    LAS float* sl = (LAS float*)lds;
    LAS float* red = (LAS float*)(lds + 5 * 1024 * 4);
    if ((int)blockIdx.x >= 192) return;
    for (int e = tid; e < 5 * 1024; e += NTHREADS) { const int r = e >> 10, k = e & 1023; const float x = r < 4 ? c[r * 1024 + k] : cctx[k]; sl[e] = silu_f(x); }
    __syncthreads();
    for (int item = blockIdx.x; item < 192; item += G) {
        const int i = item / 96, cb = item % 96, col = cb * 32 + (lane & 31), kh = lane >> 5;
        const float* W = ada_w + (size_t)i * 1024 * 3072 + col;
        float acc[5] = {0.f, 0.f, 0.f, 0.f, 0.f};
#pragma unroll 8
        for (int kk = 0; kk < 64; ++kk) { const int k = wave * 128 + 2 * kk + kh; const float w = W[(size_t)k * 3072];
#pragma unroll
            for (int r = 0; r < 5; ++r) acc[r] += sl[r * 1024 + k] * w; }
#pragma unroll
        for (int r = 0; r < 5; ++r) { acc[r] += __shfl_xor(acc[r], 32); if (lane < 32) red[(wave * 5 + r) * 32 + lane] = acc[r]; }
        __syncthreads();
        if (tid < 160) { const int r = tid >> 5, cl = tid & 31; float s = ada_b[i * 3072 + cb * 32 + cl];
#pragma unroll
            for (int w = 0; w < 8; ++w) s += red[(w * 5 + r) * 32 + cl];
            MOD[(i * 5 + r) * 3072 + cb * 32 + cl] = s; }
        __syncthreads();
    }
}
DI void p0_transpose_item(const float* W, int K, int N, bf16_t* WT, int row_off, LAS float* scr, int item, int lane) {
    const int nblk = N / 32, kb = item / nblk, nb = item % nblk, k0 = 64 * kb, n0 = 32 * nb;
#pragma unroll 8
    for (int i = 0; i < 32; ++i) { const int kk = 2 * i + (lane >> 5); scr[kk * 33 + (lane & 31)] = W[(size_t)(k0 + kk) * N + n0 + (lane & 31)]; }
    LDS_WAIT(); asm volatile("" ::: "memory");
    const int c = lane & 7;
#pragma unroll
    for (int j = 0; j < 4; ++j) { const int n = (lane >> 3) + 8 * j; const LAS float* s = scr + (8 * c) * 33 + n;
        v4u o; o.x = pk2(s[0 * 33], s[1 * 33]); o.y = pk2(s[2 * 33], s[3 * 33]); o.z = pk2(s[4 * 33], s[5 * 33]); o.w = pk2(s[6 * 33], s[7 * 33]);
        *(v4u*)(WT + (size_t)(row_off + n0 + n) * K + k0 + 8 * c) = o; }
    LDS_WAIT(); asm volatile("" ::: "memory");
}
struct TrJob { const float* W; int K, N; bf16_t* WT; int row_off; int items; };

DI void load_row16(const float* src, int lane, float (&v)[16]) {
#pragma unroll
    for (int j = 0; j < 4; ++j) { const f32x4_t t = *(const f32x4_t*)(src + j * 256 + lane * 4); v[4 * j] = t[0]; v[4 * j + 1] = t[1]; v[4 * j + 2] = t[2]; v[4 * j + 3] = t[3]; }
}
DI float row_rinv(const float (&v)[16]) {
    float ss = 0.f;
#pragma unroll
    for (int j = 0; j < 16; ++j) ss += v[j] * v[j];
    ss = wave_sum(ss);
    return rsqrtf(ss * (1.f / DM) + EPSN);
}
DI void store_modnorm(const float (&v)[16], float rinv, const float* g, const float* m, bf16_t* dst, int lane) {
#pragma unroll
    for (int j = 0; j < 4; ++j) { const int col = j * 256 + lane * 4;
        const f32x4_t gg = *(const f32x4_t*)(g + col), sc = *(const f32x4_t*)(m + 1024 + col), sh = *(const f32x4_t*)(m + col);
        float y[4];
#pragma unroll
        for (int e = 0; e < 4; ++e) y[e] = v[4 * j + e] * rinv * gg[e] * (1.f + sc[e]) + sh[e];
        v2u o; o.x = pk2(y[0], y[1]); o.y = pk2(y[2], y[3]); *(v2u*)(dst + col) = o; }
}

__global__ void __launch_bounds__(NTHREADS, 2) mega(Args args) {
    extern __shared__ __attribute__((aligned(16))) unsigned char lds_raw[];
    LAS unsigned char* lds = (LAS unsigned char*)lds_raw;
    volatile LAS unsigned* MISC = (volatile LAS unsigned*)(lds + MISC_OFF);
    const int tid = threadIdx.x, lane = tid & 63, wave = __builtin_amdgcn_readfirstlane(tid >> 6);
    const int G = gridDim.x;
    unsigned char* ws = args.ws;
    gu32* ctl = (gu32*)(ws + WS_CTL);
    for (int u = tid; u < (LDS_BYTES - LDSCTL_OFF) / 4; u += NTHREADS) ((LAS unsigned*)(lds + LDSCTL_OFF))[u] = 0u;
    __syncthreads();
    XcdBarrier bar = xcd_barrier_post((unsigned*)(ctl + CW_BAR) + args.li * XCD_BAR_WORDS, MISC + 8);
    const int lo = args.ph_lo, hi = args.ph_hi;
#define IN(k) (lo <= (k) && (k) < hi)
#ifndef PROBE_REP
#define PROBE_REP 0
#endif
#define PHASE_LOOP(k) for (int rep_ = 0, nrep_ = IN(k) ? 1 + ((PROBE_REP >> (k)) & 1) : 0; rep_ < nrep_; (++rep_ < nrep_) ? xcd_barrier(bar) : (void)0)
#define SEAM(k) do { if (IN(k) && IN((k) + 1)) xcd_barrier(bar); } while (0)

    const float* x = args.in[0]; const float* cvec = args.in[1]; const float* ctxin = args.in[2]; const float* cctx = args.in[3];
    const float* ada_w = args.in[4]; const float* ada_b = args.in[5]; const float* pre_g = args.in[6]; const float* post_g = args.in[7];
    float* out = args.out;
    float* MOD = (float*)(ws + WS_MOD);
    bf16_t* XN = (bf16_t*)(ws + WS_XN); bf16_t* YMIX = (bf16_t*)(ws + WS_YMIX); bf16_t* PROJ = (bf16_t*)(ws + WS_PROJ); float* OUTF = (float*)(ws + WS_PROJ);
    bf16_t* YPRE = (bf16_t*)(ws + WS_YPRE);
    const int gw = blockIdx.x * NWAVES + wave, NGW = G * NWAVES;

    PHASE_LOOP(0) {
        p0_adaln(lds, cvec, cctx, ada_w, ada_b, MOD, tid, wave, lane, G);
        __syncthreads();
        LAS float* scr = (LAS float*)(lds + 32768 + wave * 8704);
        const TrJob jobs[5] = {
            {args.in[8], 1024, 3072, (bf16_t*)(ws + WS_WIN0T), 0, 16 * 96}, {args.in[9], 1024, 1024, (bf16_t*)(ws + WS_WOUT0T), 0, 16 * 32},
            {args.in[21], 1024, 2304, (bf16_t*)(ws + WS_WIN1T), 0, 16 * 72}, {args.in[22], 1024, 1024, (bf16_t*)(ws + WS_WOUT1T), 0, 16 * 32},
            {args.in[18], 512, 512, (bf16_t*)(ws + WS_WGLUT), 0, 8 * 16}};
        constexpr int NBIG = 16 * 96 + 16 * 32 + 16 * 72 + 16 * 32 + 8 * 16, NLRU = 32 * 2;
        for (int it = gw; it < NBIG + NLRU; it += NGW) {
            if (it < NBIG) { int r = it;
#pragma unroll
                for (int j = 0; j < 5; ++j) { if (r >= 0 && r < jobs[j].items) p0_transpose_item(jobs[j].W, jobs[j].K, jobs[j].N, jobs[j].WT, 0, scr, r, lane); r -= jobs[j].items; }
            } else { const int q = it - NBIG, mat = q >> 1, sub = q & 1, dir = mat >> 4, gate = (mat >> 3) & 1, blk = mat & 7;
                const float* W = (gate ? args.in[28] : args.in[26]) + (size_t)(dir * 8 + blk) * 4096;
                p0_transpose_item(W, 64, 64, (bf16_t*)(ws + WS_LRUWT), blk * 256 + (dir * 2 + gate) * 64, scr, sub, lane); }
        }
    }
    PHASE_LOOP(0) {
        float* ROPE = (float*)(ws + WS_ROPE);
        for (int e = blockIdx.x * NTHREADS + tid; e < SEQ * 32; e += G * NTHREADS) { const int t = e >> 5, i = e & 31, f = i & 15; const float pos = (float)(i < 16 ? (t >> 6) : (t & 63));
            const float inv = (float)exp(-log(10000.0) * (double)(2 * f) / 32.0); const float ang = pos * inv; ROPE[2 * e] = cosf(ang); ROPE[2 * e + 1] = sinf(ang); }
    }
    PHASE_LOOP(0) {
        for (int it = G - 1 - (int)blockIdx.x; it < 64; it += G)
            s5_tables_block(it, args.in[10], args.in[11], args.in[12], args.in[13], args.in[14], args.in[15], args.in[16], (bf16_t*)(ws + WS_W16), (bf16_t*)(ws + WS_WC), (bf16_t*)(ws + WS_KT), (float*)(ws + WS_L16), lds, tid);
    }
    SEAM(0);
    PHASE_LOOP(1) {
        for (int r = gw; r < MROWS; r += NGW) {
            const float* src = r < NLAT ? x + (size_t)r * DM : ctxin + (size_t)(r - NLAT) * DM;
            float v[16]; load_row16(src, lane, v);
            store_modnorm(v, row_rinv(v), pre_g, MOD + (r < NLAT ? (r >> 12) : 4) * 3072, XN + (size_t)r * DM, lane);
        }
    }
    SEAM(1);
    PHASE_LOOP(2) {
        pg8::Gemm g{XN, (const bf16_t*)(ws + WS_WIN0T), MROWS, N0, DM}; pg8::StaticOrder S; S.init(MROWS, N0, G, (int)blockIdx.x);
        pg8::EpiProj E{PROJ, N0, (bf16_t*)(ws + WS_VT0), 2048, 2560, 512, false};
        pg8::gemm_phase<pg8::EpiProj, pg8::StaticOrder, kALIGN, kSP2>(lds, g, S, E);
    }
    SEAM(2);
    PHASE_LOOP(3) { phase3(args, lds, tid, wave, lane, G, rep_); }
    SEAM(3);
    PHASE_LOOP(4) { phase4(args, lds, tid, wave, lane, G); }
    SEAM(4);
    PHASE_LOOP(5) {
        pg8::Gemm g{YPRE, (const bf16_t*)(ws + WS_WGLUT), MROWS, 512, 512}; pg8::StaticOrder S; S.init(MROWS, 512, G, (int)blockIdx.x);
        pg8::EpiGlu E{YPRE, PROJ, args.in[19], YMIX};
        pg8::gemm_phase<pg8::EpiGlu, pg8::StaticOrder, kALIGN, kSP2>(lds, g, S, E);
    }
    SEAM(5);
    PHASE_LOOP(6) {
        pg8::Gemm g{YMIX, (const bf16_t*)(ws + WS_WOUT0T), MROWS, DM, DM}; pg8::StaticOrder S; S.init(MROWS, DM, G, (int)blockIdx.x);
        pg8::EpiF32 E{OUTF, DM};
        pg8::gemm_phase<pg8::EpiF32, pg8::StaticOrder, kALIGN, kSP2>(lds, g, S, E);
    }
    SEAM(6);
    PHASE_LOOP(7) {
        for (int r = gw; r < MROWS; r += NGW) {
            const int mrow = r < NLAT ? (r >> 12) : 4;
            const float* hin = r < NLAT ? x + (size_t)r * DM : ctxin + (size_t)(r - NLAT) * DM;
            float v[16], h[16]; load_row16(OUTF + (size_t)r * DM, lane, v); load_row16(hin, lane, h);
            const float rinv = row_rinv(v); const float* gt = MOD + mrow * 3072 + 2048;
#pragma unroll
            for (int j = 0; j < 4; ++j) { const int col = j * 256 + lane * 4; const f32x4_t pg = *(const f32x4_t*)(post_g + col), gg = *(const f32x4_t*)(gt + col);
#pragma unroll
                for (int e = 0; e < 4; ++e) h[4 * j + e] += gg[e] * (v[4 * j + e] * rinv * pg[e]);
                if (r < NLAT) *(f32x4_t*)(out + (size_t)r * DM + col) = (f32x4_t){h[4 * j], h[4 * j + 1], h[4 * j + 2], h[4 * j + 3]}; }
            store_modnorm(h, row_rinv(h), pre_g + DM, MOD + (5 + mrow) * 3072, XN + (size_t)r * DM, lane);
        }
    }
    SEAM(7);
    PHASE_LOOP(8) {
        pg8::Gemm g{XN, (const bf16_t*)(ws + WS_WIN1T), MROWS, N1, DM}; pg8::StaticOrder S; S.init(MROWS, N1, G, (int)blockIdx.x);
        pg8::EpiProj E{PROJ, N1, (bf16_t*)(ws + WS_VT1), 1664, 1792, 128, true};
        pg8::gemm_phase<pg8::EpiProj, pg8::StaticOrder, kALIGN, kSP2>(lds, g, S, E);
    }
    SEAM(8);
    PHASE_LOOP(9) { phase9(args, lds, tid, wave, lane, G); }
    SEAM(9);
    PHASE_LOOP(10) { phase10(args, lds, tid, wave, lane, G); }
    SEAM(10);
    PHASE_LOOP(11) {
        pg8::Gemm g{YMIX, (const bf16_t*)(ws + WS_WOUT1T), NLAT, DM, DM}; pg8::StaticOrder S; S.init(NLAT, DM, G, (int)blockIdx.x);
        pg8::EpiF32 E{OUTF, DM};
        pg8::gemm_phase<pg8::EpiF32, pg8::StaticOrder, kALIGN, kSP2>(lds, g, S, E);
    }
    SEAM(11);
    PHASE_LOOP(12) {
        for (int r = gw; r < NLAT; r += NGW) {
            float v[16], h[16]; load_row16(OUTF + (size_t)r * DM, lane, v); load_row16(out + (size_t)r * DM, lane, h);
            const float rinv = row_rinv(v); const float* gt = MOD + (5 + (r >> 12)) * 3072 + 2048;
#pragma unroll
            for (int j = 0; j < 4; ++j) { const int col = j * 256 + lane * 4; const f32x4_t pg = *(const f32x4_t*)(post_g + DM + col), gg = *(const f32x4_t*)(gt + col);
                f32x4_t o;
#pragma unroll
                for (int e = 0; e < 4; ++e) o[e] = h[4 * j + e] + gg[e] * (v[4 * j + e] * rinv * pg[e]);
                *(f32x4_t*)(out + (size_t)r * DM + col) = o; }
        }
    }
#undef IN
#undef SEAM
}
__global__ void k_adaln(const float* c, const float* cctx, const float* ada_w, const float* ada_b, float* mod) {
    const int idx = blockIdx.x * blockDim.x + threadIdx.x;
    if (idx >= 2 * 5 * 3072) return;
    const int col = idx % 3072, r = (idx / 3072) % 5, i = idx / (3072 * 5);
    const float* cv = r < 4 ? c + r * 1024 : cctx;
    const float* W = ada_w + (size_t)i * 1024 * 3072;
    float acc = 0.f;
    for (int k = 0; k < 1024; ++k) acc += silu_f(cv[k]) * W[(size_t)k * 3072 + col];
    mod[idx] = acc + ada_b[i * 3072 + col];
}

__global__ void k_prenorm(const float* lat, const float* ctx, const float* g, const float* mod  , bf16_t* XN) {
    const int r = blockIdx.x * 4 + (threadIdx.x >> 6), lane = threadIdx.x & 63;
    if (r >= MROWS) return;
    const float* src = r < NLAT ? lat + (size_t)r * DM : ctx + (size_t)(r - NLAT) * DM;
    const float* m = mod + (r < NLAT ? (r >> 12) : 4) * 3072;
    float v[16]; float ss = 0.f;
#pragma unroll
    for (int j = 0; j < 4; ++j) { const float4 t = *(const float4*)(src + j * 256 + lane * 4); v[4 * j] = t.x; v[4 * j + 1] = t.y; v[4 * j + 2] = t.z; v[4 * j + 3] = t.w; }
#pragma unroll
    for (int j = 0; j < 16; ++j) ss += v[j] * v[j];
    ss = wave_sum(ss);
    const float rinv = rsqrtf(ss * (1.f / DM) + EPSN);
#pragma unroll
    for (int j = 0; j < 4; ++j)
#pragma unroll
        for (int e = 0; e < 4; ++e) { const int col = j * 256 + lane * 4 + e; const float y = v[4 * j + e] * rinv * g[col] * (1.f + m[1024 + col]) + m[col]; XN[(size_t)r * DM + col] = f2bf(y); }
}

__global__ void k_postnorm(const float* hlat, const float* hctx, const float* OUT, const float* pg, const float* mod, float* olat, float* octx, int nrows) {
    const int r = blockIdx.x * 4 + (threadIdx.x >> 6), lane = threadIdx.x & 63;
    if (r >= nrows) return;
    const float* hin = r < NLAT ? hlat + (size_t)r * DM : hctx + (size_t)(r - NLAT) * DM;
    float* ho = r < NLAT ? olat + (size_t)r * DM : octx + (size_t)(r - NLAT) * DM;
    const float* m = mod + (r < NLAT ? (r >> 12) : 4) * 3072 + 2048;
    const float* src = OUT + (size_t)r * DM;
    float v[16]; float ss = 0.f;
#pragma unroll
    for (int j = 0; j < 4; ++j) { const float4 t = *(const float4*)(src + j * 256 + lane * 4); v[4 * j] = t.x; v[4 * j + 1] = t.y; v[4 * j + 2] = t.z; v[4 * j + 3] = t.w; }
#pragma unroll
    for (int j = 0; j < 16; ++j) ss += v[j] * v[j];
    ss = wave_sum(ss);
    const float rinv = rsqrtf(ss * (1.f / DM) + EPSN);
#pragma unroll
    for (int j = 0; j < 4; ++j)
#pragma unroll
        for (int e = 0; e < 4; ++e) { const int col = j * 256 + lane * 4 + e; ho[col] = hin[col] + m[col] * (v[4 * j + e] * rinv * pg[col]); }
}

enum { GM_PROJ0 = 0, GM_PROJ1 = 1, GM_GLU = 2, GM_F32 = 3 };
struct GemmEpi { bf16_t* P; bf16_t* VT; const bf16_t* YPRE; const bf16_t* PROJ; const float* bglu; bf16_t* YMIX; float* OUT; };
template <int MODE> __global__ void __launch_bounds__(256) k_gemm(const bf16_t* A, const float* W, int M, int N, int K, GemmEpi e) {
    const int tx = threadIdx.x & 15, ty = threadIdx.x >> 4;
    const int c0 = blockIdx.x * 64 + tx * 4, r0 = blockIdx.y * 64 + ty * 4;
    float acc[4][4] = {};
    for (int k = 0; k < K; ++k) {
        const float4 w = *(const float4*)(W + (size_t)k * N + c0);
        const float wv[4] = {rbf(w.x), rbf(w.y), rbf(w.z), rbf(w.w)};
#pragma unroll
        for (int i = 0; i < 4; ++i) { const float a = bf2f(A[(size_t)(r0 + i) * K + k]);
#pragma unroll
            for (int j = 0; j < 4; ++j) acc[i][j] += a * wv[j]; }
    }
#pragma unroll
    for (int i = 0; i < 4; ++i)
#pragma unroll
        for (int j = 0; j < 4; ++j) {
            const int r = r0 + i, c = c0 + j; const float v = acc[i][j];
            if (MODE == GM_PROJ0) { e.P[(size_t)r * N0 + c] = f2bf(v);
                if (c >= 2048 && c < 2560) { const int hd = c - 2048; e.VT[((size_t)(row_batch(r) * 8) * 64 + hd) * POSN + row_pos(r)] = f2bf(v); } }
            else if (MODE == GM_PROJ1) { e.P[(size_t)r * N1 + c] = f2bf(v);
                if (c >= 1664 && c < 1792) { const int hd = c - 1664; e.VT[((size_t)(row_batch(r) * 2) * 64 + hd) * POSN + row_pos(r)] = f2bf(v); } }
            else if (MODE == GM_GLU) { const float y = bf2f(e.YPRE[(size_t)r * 512 + c]); const float ga = bf2f(e.PROJ[(size_t)r * N0 + 512 + c]);
                e.YMIX[(size_t)r * DM + c] = f2bf(y * sigmoid_f(v + e.bglu[c]) * silu_f(ga)); }
            else e.OUT[(size_t)r * N + c] = v;
        }
}

__global__ void __launch_bounds__(64) k_s5_scan(const bf16_t* PROJ, const float* lam_re, const float* lam_im, const float* log_dt, const float* b_re, const float* b_im,
                                                 const float* c_re, const float* c_im, float* YS) {
    const int p = threadIdx.x, id = blockIdx.x, dir = id & 1, g = (id >> 1) & 31, b = id >> 6;
    const int gi = (dir * 32 + g);
    const double lre = lam_re[gi * 64 + p], lim = lam_im[gi * 64 + p], dt = exp((double)log_dt[gi]);
    const double mag = exp(lre * dt); const float ar = (float)(mag * cos(lim * dt)), ai = (float)(mag * sin(lim * dt));
    const double nr = mag * cos(lim * dt) - 1.0, ni = mag * sin(lim * dt), den = lre * lre + lim * lim;
    const float cfr = (float)((nr * lre + ni * lim) / den), cfi = (float)((ni * lre - nr * lim) / den);
    float bbr[16], bbi[16], cr[16], ci[16];
#pragma unroll
    for (int h = 0; h < 16; ++h) { const float br = b_re[(gi * 64 + p) * 16 + h], bi = b_im[(gi * 64 + p) * 16 + h]; bbr[h] = cfr * br - cfi * bi; bbi[h] = cfr * bi + cfi * br;
        cr[h] = c_re[(gi * 16 + h) * 64 + p]; ci[h] = c_im[(gi * 16 + h) * 64 + p]; }
    float hr = 0.f, hi = 0.f;
    float* ys = YS + (size_t)dir * MROWS * 512;
    for (int pos = 0; pos < POSN; ++pos) {
        int row;
        if (dir == 0) row = pos_row(b, pos); else row = pos < LC ? NLAT + b * LC + (LC - 1 - pos) : b * SEQ + (SEQ - 1 - (pos - LC));
        const bf16_t* up = PROJ + (size_t)row * N0 + g * 16;
        float bur = 0.f, bui = 0.f;
#pragma unroll
        for (int h = 0; h < 16; ++h) { const float u = bf2f(up[h]); bur += bbr[h] * u; bui += bbi[h] * u; }
        const float nhr = ar * hr - ai * hi + bur, nhi = ar * hi + ai * hr + bui; hr = nhr; hi = nhi;
        float mine = 0.f;
#pragma unroll
        for (int h = 0; h < 16; ++h) { const float y = wave_sum(cr[h] * hr - ci[h] * hi); if (p == h) mine = y; }
        if (p < 16) ys[(size_t)row * 512 + g * 16 + p] = mine;
    }
}
__global__ void k_s5_finish(const bf16_t* PROJ, const float* YS, const float* dsk, bf16_t* YPRE) {
    const size_t idx = (size_t)blockIdx.x * blockDim.x + threadIdx.x; if (idx >= (size_t)MROWS * 512) return;
    const int ch = idx & 511; const size_t r = idx >> 9;
    const float y = dsk[ch] * bf2f(PROJ[r * N0 + ch]) + YS[idx] + YS[(size_t)MROWS * 512 + idx];
    YPRE[idx] = f2bf(gelu_tanh(y));
}

__global__ void __launch_bounds__(256) k_na_attn(const bf16_t* PROJ, const float* relb, bf16_t* YMIX) {
    const int wv = blockIdx.x * 4 + (threadIdx.x >> 6), lane = threadIdx.x & 63;
    if (wv >= MROWS * 8) return;
    const int h = wv & 7, r = wv >> 3, b = row_batch(r);
    const float q = bf2f(PROJ[(size_t)r * N0 + 1024 + h * 64 + lane]);
    float m = -INFINITY, l = 0.f, o = 0.f;
    if (r < NLAT) {
        const int t = r & 4095, qr = t >> 6, qc = t & 63;
        const int rs = min(max(qr - 4, 0), 56), cs = min(max(qc - 8, 0), 48);
        for (int kr = rs; kr < rs + 8; ++kr)
            for (int kc = cs; kc < cs + 16; ++kc) {
                const size_t kro = (size_t)(b * SEQ + kr * 64 + kc) * N0;
                float s = wave_sum(q * bf2f(PROJ[kro + 1536 + h * 64 + lane])) * 0.125f + relb[(h * 15 + (kr - qr + 7)) * 31 + (kc - qc + 15)];
                const float mn = fmaxf(m, s), al = __expf(m - mn), pp = __expf(s - mn);
                l = l * al + pp; o = o * al + pp * bf2f(PROJ[kro + 2048 + h * 64 + lane]); m = mn;
            }
    }
    for (int c = 0; c < LC; ++c) {
        const size_t kro = (size_t)(NLAT + b * LC + c) * N0;
        const float s = wave_sum(q * bf2f(PROJ[kro + 1536 + h * 64 + lane])) * 0.125f;
        const float mn = fmaxf(m, s), al = __expf(m - mn), pp = __expf(s - mn);
        l = l * al + pp; o = o * al + pp * bf2f(PROJ[kro + 2048 + h * 64 + lane]); m = mn;
    }
    const float gb = bf2f(PROJ[(size_t)r * N0 + 2560 + h * 64 + lane]);
    YMIX[(size_t)r * DM + 512 + h * 64 + lane] = f2bf(o / l * silu_f(gb));
}

__global__ void __launch_bounds__(64) k_lru(const bf16_t* P1, const float* conv_w, const float* conv_b, const float* lam, const float* w_a, const float* b_a,
                                            const float* w_x, const float* b_x, float* HS, bf16_t* YMIX) {
    __shared__ float xs[64];
    const int j = threadIdx.x, nb = blockIdx.x & 7, b = blockIdx.x >> 3, ch = nb * 64 + j;
    const float cw0 = conv_w[0 * 512 + ch], cw1 = conv_w[1 * 512 + ch], cw2 = conv_w[2 * 512 + ch], cw3 = conv_w[3 * 512 + ch], cb = conv_b[ch];
    for (int dir = 0; dir < 2; ++dir) {
        float wa[64], wx[64];
#pragma unroll
        for (int i = 0; i < 64; ++i) { wa[i] = w_a[((dir * 8 + nb) * 64 + i) * 64 + j]; wx[i] = w_x[((dir * 8 + nb) * 64 + i) * 64 + j]; }
        const float ba = b_a[dir * 512 + ch], bx = b_x[dir * 512 + ch];
        const float lm = lam[dir * 512 + ch]; const float sp = (-lm > 20.f) ? -lm : log1pf(__expf(-lm));
        float hst = 0.f;
        for (int pos = 0; pos < POSN; ++pos) {
            int s0, sl, t;
            if (pos < LC) { s0 = NLAT + b * LC; sl = LC; t = dir == 0 ? pos : LC - 1 - pos; }
            else { s0 = b * SEQ; sl = SEQ; t = dir == 0 ? pos - LC : SEQ - 1 - (pos - LC); }
            float xm1 = 0.f, x0, xp1 = 0.f, xp2 = 0.f;
            x0 = bf2f(P1[(size_t)(s0 + t) * N1 + ch]);
            if (t - 1 >= 0) xm1 = bf2f(P1[(size_t)(s0 + t - 1) * N1 + ch]);
            if (t + 1 < sl) xp1 = bf2f(P1[(size_t)(s0 + t + 1) * N1 + ch]);
            if (t + 2 < sl) xp2 = bf2f(P1[(size_t)(s0 + t + 2) * N1 + ch]);
            const float xc = cw0 * xm1 + cw1 * x0 + cw2 * xp1 + cw3 * xp2 + cb;
            __syncthreads(); xs[j] = xc; __syncthreads();
            float ga = ba, gx = bx;
#pragma unroll
            for (int i = 0; i < 64; ++i) { const float xi = xs[i]; ga += xi * wa[i]; gx += xi * wx[i]; }
            const float gr = sigmoid_f(ga), gi = sigmoid_f(gx);
            const float log_a = -8.f * gr * sp; const float a = __expf(log_a); const float mult = sqrtf(fmaxf(-expm1f(2.f * log_a), 0.f));
            hst = a * hst + mult * gi * xc;
            if (pos >= LC) { const size_t rr = (size_t)(s0 + t);
                if (dir == 0) HS[rr * 512 + ch] = hst;
                else { const float gc = bf2f(P1[rr * N1 + 512 + ch]); YMIX[rr * DM + ch] = f2bf((HS[rr * 512 + ch] + hst) * silu_f(gc)); } }
        }
    }
}

__global__ void __launch_bounds__(256) k_qkprep(const bf16_t* P1, const float* qn, const float* kn, bf16_t* QP, bf16_t* KP) {
    const int wv = blockIdx.x * 4 + (threadIdx.x >> 6), lane = threadIdx.x & 63;
    if (wv >= MROWS * 10) return;
    const int slot = wv % 10, r = wv / 10, b = row_batch(r);
    if (slot < 8 && r >= NLAT) return;
    const int col0 = slot < 8 ? 1024 + slot * 64 : 1536 + (slot - 8) * 64;
    const float x = bf2f(P1[(size_t)r * N1 + col0 + lane]);
    const float ss = wave_sum(x * x);
    float y = x * rsqrtf(ss * (1.f / 64.f) + EPSN) * (slot < 8 ? qn[lane] : kn[lane]);
    if (r < NLAT) {
        const int t = r & 4095, i = lane >> 1, f = i & 15; const float pos = (float)(i < 16 ? (t >> 6) : (t & 63));
        const float inv = (float)exp(-log(10000.0) * (double)(2 * f) / 32.0);
        const float ang = pos * inv; const float cs = cosf(ang), sn = sinf(ang);
        const float pr = __shfl_xor(y, 1);
        y = (lane & 1) ? (pr * sn + y * cs) : (y * cs - pr * sn);
    }
    if (slot < 8) QP[((size_t)(b * 8 + slot) * SEQ + (r & 4095)) * 64 + lane] = f2bf(y * (0.125f * LOG2E));
    else KP[((size_t)(b * 2 + (slot - 8)) * POSN + row_pos(r)) * 64 + lane] = f2bf(y);
}

__global__ void __launch_bounds__(256) k_gqa(const bf16_t* QP, const bf16_t* KP, const bf16_t* P1, bf16_t* YMIX) {
    const int wv = blockIdx.x * 4 + (threadIdx.x >> 6), lane = threadIdx.x & 63;
    if (wv >= NLAT * 8) return;
    const int hq = wv & 7, r = wv >> 3, b = r >> 12, t = r & 4095, kvh = hq >> 2;
    const float q = bf2f(QP[((size_t)(b * 8 + hq) * SEQ + t) * 64 + lane]);
    const bf16_t* kp = KP + (size_t)(b * 2 + kvh) * POSN * 64;
    float m = -INFINITY, l = 0.f, o = 0.f;
    for (int pos = 0; pos < POSN; ++pos) {
        const float s = wave_sum(q * bf2f(kp[(size_t)pos * 64 + lane]));
        const float v = bf2f(P1[(size_t)pos_row(b, pos) * N1 + 1664 + kvh * 64 + lane]);
        const float mn = fmaxf(m, s), al = exp2f(m - mn), pp = exp2f(s - mn);
        l = l * al + pp; o = o * al + pp * v; m = mn;
    }
    const float gd = bf2f(P1[(size_t)r * N1 + 1792 + hq * 64 + lane]);
    YMIX[(size_t)r * DM + 512 + hq * 64 + lane] = f2bf(o / l * silu_f(gd));
}

static int g_grid = 0;
static void launch_mega(Args a, int lo, int hi, int li, hipStream_t stream) {
    a.ph_lo = lo; a.ph_hi = hi; a.li = li;
    hipLaunchKernelGGL(mega, dim3(g_grid), dim3(NTHREADS), LDS_BYTES, stream, a);
    const hipError_t le = hipPeekAtLastError();
    if (le != hipSuccess) fprintf(stderr, "kernel_launch: mega[%d,%d) failed: %s\n", lo, hi, hipGetErrorName(le));
}
extern "C" void kernel_launch(void* const* d_in, const int* in_sizes, int n_in, void* d_out, int out_size, void* d_ws, size_t ws_size, hipStream_t stream) {
    if (g_grid == 0) {
        int dev = 0, cus = 0;
        if (hipGetDevice(&dev) != hipSuccess || hipDeviceGetAttribute(&cus, hipDeviceAttributeMultiprocessorCount, dev) != hipSuccess) { fprintf(stderr, "kernel_launch: device query failed\n"); g_grid = -1; return; }
        if (hipFuncSetAttribute((const void*)mega, hipFuncAttributeMaxDynamicSharedMemorySize, LDS_BYTES) != hipSuccess) { fprintf(stderr, "kernel_launch: hipFuncSetAttribute failed\n"); g_grid = -1; return; }
        int per_cu = 0;
        if (hipOccupancyMaxActiveBlocksPerMultiprocessor(&per_cu, (const void*)mega, NTHREADS, LDS_BYTES) != hipSuccess || per_cu < 1) fprintf(stderr, "kernel_launch: occupancy query says %d blocks/CU\n", per_cu);
        (void)hipGetLastError();
        g_grid = cus;
    }
    if (g_grid < 0) return;
    const float* x = (const float*)d_in[0]; const float* c = (const float*)d_in[1]; const float* ctx = (const float*)d_in[2]; const float* cctx = (const float*)d_in[3];
    const float* ada_w = (const float*)d_in[4]; const float* ada_b = (const float*)d_in[5]; const float* pre_g = (const float*)d_in[6]; const float* post_g = (const float*)d_in[7];
    const float* ev_w_in = (const float*)d_in[8]; const float* ev_w_out = (const float*)d_in[9];
    const float* s5_lre = (const float*)d_in[10]; const float* s5_lim = (const float*)d_in[11]; const float* s5_ldt = (const float*)d_in[12];
    const float* s5_bre = (const float*)d_in[13]; const float* s5_bim = (const float*)d_in[14]; const float* s5_cre = (const float*)d_in[15]; const float* s5_cim = (const float*)d_in[16];
    const float* s5_d = (const float*)d_in[17]; const float* s5_wglu = (const float*)d_in[18]; const float* s5_bglu = (const float*)d_in[19]; const float* relb = (const float*)d_in[20];
    const float* od_w_in = (const float*)d_in[21]; const float* od_w_out = (const float*)d_in[22]; const float* conv_w = (const float*)d_in[23]; const float* conv_b = (const float*)d_in[24];
    const float* lru_lam = (const float*)d_in[25]; const float* w_a = (const float*)d_in[26]; const float* b_a = (const float*)d_in[27]; const float* w_x = (const float*)d_in[28]; const float* b_x = (const float*)d_in[29];
    const float* qn = (const float*)d_in[30]; const float* kn = (const float*)d_in[31];
    char* ws = (char*)d_ws; float* out = (float*)d_out;
    float* MOD = (float*)(ws + WS_MOD); float* HC1 = (float*)(ws + WS_HC1);
    bf16_t* XN = (bf16_t*)(ws + WS_XN); bf16_t* YMIX = (bf16_t*)(ws + WS_YMIX); bf16_t* PROJ = (bf16_t*)(ws + WS_PROJ); float* OUTF = (float*)(ws + WS_PROJ);
    bf16_t* VT0 = (bf16_t*)(ws + WS_VT0); bf16_t* YPRE = (bf16_t*)(ws + WS_YPRE); bf16_t* QP = (bf16_t*)(ws + WS_QP); bf16_t* KP = (bf16_t*)(ws + WS_KP); bf16_t* VT1 = (bf16_t*)(ws + WS_VT1);
    float* YS = (float*)(ws + WS_YS); float* HS = (float*)(ws + WS_HS);
    (void)x; (void)c; (void)ctx; (void)cctx; (void)ada_w; (void)ada_b; (void)pre_g; (void)post_g; (void)ev_w_in; (void)ev_w_out; (void)s5_wglu; (void)od_w_in; (void)od_w_out; (void)MOD; (void)HC1; (void)XN; (void)OUTF; (void)VT0; (void)VT1; (void)out;

    if (hipMemsetAsync(ws + WS_CTL, 0, CTL_ZERO_BYTES, stream) != hipSuccess) { fprintf(stderr, "kernel_launch: memset failed\n"); return; }
    Args a{};
    for (int i = 0; i < 32; ++i) a.in[i] = (const float*)d_in[i];
    a.out = (float*)d_out; a.ws = (unsigned char*)d_ws;

    launch_mega(a, 0, N_PHASES, 0, stream);
    (void)relb; (void)conv_w; (void)conv_b; (void)lru_lam; (void)w_a; (void)b_a; (void)w_x; (void)b_x; (void)HS; (void)qn; (void)kn; (void)QP; (void)KP;
    (void)s5_lre; (void)s5_lim; (void)s5_ldt; (void)s5_bre; (void)s5_bim; (void)s5_cre; (void)s5_cim; (void)s5_d; (void)s5_bglu; (void)YS; (void)YPRE; (void)PROJ; (void)YMIX;
}
```

```cpp
#include <hip/hip_runtime.h>
#include <cstdint>
#include <cstdio>

typedef unsigned short bf16_t;
#define DI __device__ __forceinline__
#define GAS __attribute__((address_space(1)))
#define LAS __attribute__((address_space(3)))
typedef unsigned v4u __attribute__((ext_vector_type(4)));
typedef unsigned v2u __attribute__((ext_vector_type(2)));
typedef float f32x4_t __attribute__((ext_vector_type(4)));
typedef float f32x16_t __attribute__((ext_vector_type(16)));
typedef short bf16x8_t __attribute__((ext_vector_type(8)));
typedef short s16x4_t __attribute__((ext_vector_type(4)));
typedef GAS unsigned gu32;
typedef GAS unsigned long long gu64;
#define RLX_AGENT __ATOMIC_RELAXED, __HIP_MEMORY_SCOPE_AGENT
#define LDS_WAIT() asm volatile("s_waitcnt lgkmcnt(0)" ::: "memory")
#define VM_WAIT() asm volatile("s_waitcnt vmcnt(0)" ::: "memory")

DI float bf2f(bf16_t v) { return __uint_as_float((unsigned)v << 16); }
DI bf16_t f2bf(float f) { unsigned u = __float_as_uint(f); return (bf16_t)((u + 0x7fffu + ((u >> 16) & 1u)) >> 16); }
DI unsigned pk2(float lo, float hi) { return (unsigned)f2bf(lo) | ((unsigned)f2bf(hi) << 16); }
DI float bflo(unsigned w) { return __uint_as_float(w << 16); }
DI float bfhi(unsigned w) { return __uint_as_float(w & 0xffff0000u); }
DI float rbf(float f) { return bf2f(f2bf(f)); }
DI float wave_sum(float v) {
#pragma unroll
    for (int o = 1; o < 64; o <<= 1) v += __shfl_xor(v, o);
    return v;
}
DI float sigmoid_f(float x) { return __builtin_amdgcn_rcpf(1.f + __builtin_amdgcn_exp2f(-1.4426950408889634f * x)); }
DI float silu_f(float x) { return x * sigmoid_f(x); }
DI float gelu_tanh(float x) { const float u = 0.7978845608028654f * (x + 0.044715f * x * x * x); return 0.5f * x * (1.f + tanhf(u)); }
DI float gelu_fast(float x) { const float u = 1.5957691216057308f * (x + 0.044715f * x * x * x); return x * sigmoid_f(u); }

constexpr int NWAVES = 8, NTHREADS = 512;
constexpr int DM = 1024, NB = 4, SEQ = 4096, LC = 256;
constexpr int NLAT = NB * SEQ, NCTX = NB * LC, MROWS = NLAT + NCTX;
constexpr int N0 = 3072, N1 = 2304, POSN = LC + SEQ;
constexpr float EPSN = 1e-6f;
constexpr float LOG2E = 1.4426950408889634f;

constexpr size_t MiB = 1u << 20;
constexpr size_t WS_CTL = 0, CTL_ZERO_BYTES = 1 * MiB;
constexpr size_t WS_MOD = 1 * MiB;
constexpr size_t WS_ROPE = 2 * MiB;
constexpr size_t WS_L16 = 3 * MiB;
constexpr size_t WS_WIN0T = 4 * MiB;
constexpr size_t WS_WOUT0T = 10 * MiB;
constexpr size_t WS_WIN1T = 12 * MiB;
constexpr size_t WS_WOUT1T = 17 * MiB;
constexpr size_t WS_WGLUT = 19 * MiB;
constexpr size_t WS_LRUWT = 19 * MiB + 512 * 1024;
constexpr size_t WS_W16 = 20 * MiB;
constexpr size_t WS_WC = 24 * MiB;
constexpr size_t WS_KT = 28 * MiB;
constexpr size_t WS_LSUM = 29 * MiB;
constexpr size_t WS_XN = 32 * MiB;
constexpr size_t WS_YMIX = 66 * MiB;
constexpr size_t WS_PROJ = 100 * MiB;
constexpr size_t WS_VT0 = 202 * MiB;
constexpr size_t WS_CARRY1 = 219 * MiB;
constexpr size_t WS_YPRE = 228 * MiB;
constexpr size_t WS_QP = 202 * MiB;
constexpr size_t WS_KP = 218 * MiB;
constexpr size_t WS_VT1 = 223 * MiB;
constexpr size_t WS_YS = 32 * MiB;
constexpr size_t WS_HS = 32 * MiB;
constexpr size_t WS_HC1 = 246 * MiB;

DI int row_batch(int r) { return r < NLAT ? (r >> 12) : ((r - NLAT) >> 8); }
DI int row_pos(int r) { return r < NLAT ? LC + (r & 4095) : ((r - NLAT) & 255); }
DI int pos_row(int b, int pos) { return pos < LC ? NLAT + b * LC + pos : b * SEQ + (pos - LC); }

namespace pg8 {
#define PG8_LAS __attribute__((address_space(3)))
typedef unsigned short bf16_t;
typedef short bf16x8 __attribute__((ext_vector_type(8)));
typedef float f32x4 __attribute__((ext_vector_type(4)));
typedef unsigned u32x4 __attribute__((ext_vector_type(4)));
constexpr int BM = 256, BK = 64, HALF = 128, HTB = HALF * BK * 2  , STAGE_BYTES = 8 * HTB, NXCD = 8, WGM = 8;

__host__ __device__ __forceinline__ int lds_byte(int r, int c) { const int st = (r >> 4) * 2 + (c >> 5), rr = r & 15, cc = c & 31, ob = rr * 64 + cc * 2; return st * 1024 + (ob ^ (((ob >> 9) & 1) << 5)); }
__host__ __device__ __forceinline__ void stage_rc(int b, int& R, int& C) { const int st = b / 1024, sb = b % 1024, swz = sb ^ (((sb >> 9) & 1) << 5); R = (st >> 1) * 16 + swz / 64; C = (st & 1) * 32 + (swz % 64) / 2; }
__host__ __device__ __forceinline__ int perm32(int rho) { const int n = rho >> 4, i = rho & 15; return 8 * (i >> 2) + 4 * n + (i & 3); }

struct Unit { int pm, pn; };
struct Gemm { const bf16_t* A; const bf16_t* Bt; int M, N, K; };

struct StaticOrder {
    int nM, nN, nwg, G, c;
    __host__ __device__ void init(int M, int N, int G_, int c_) { nM = M / BM; nN = N / BM; nwg = nM * nN; G = G_; c = c_; }
    __host__ __device__ bool next(int i, Unit& u) const {
        const long L = (long)i * G + c; if (L >= nwg) return false;
        int wgid = (int)L; { const int q = nwg / NXCD, r = nwg % NXCD, xcd = wgid % NXCD, off = wgid / NXCD; wgid = (xcd < r ? xcd * (q + 1) : r * (q + 1) + (xcd - r) * q) + off; }
        const int nig = WGM * nN, gid = wgid / nig, fm = gid * WGM, gsz = (nM - fm) < WGM ? (nM - fm) : WGM;
        u.pm = fm + ((wgid % nig) % gsz); u.pn = (wgid % nig) / gsz; return true;
    }
    __device__ __forceinline__ void a_ready(const Unit&) const {}
    __device__ __forceinline__ void done(const Unit&) const {}
};

__device__ __forceinline__ unsigned cvt_pk_bf16(float lo, float hi) { unsigned r; asm volatile("v_cvt_pk_bf16_f32 %0, %1, %2" : "=v"(r) : "v"(lo), "v"(hi)); return r; }

struct EpiProj {
    static constexpr bool PERM = true, AFTER_DRAIN = false;
    bf16_t* P; int ldc; bf16_t* VT; int vt_lo, vt_hi, vt_w; bool vrow;
    __device__ __forceinline__ void operator()(const f32x4 (&acc)[2][2][4][2], const Unit& u, int wr, int wc, int fr, int fq) const {
        const int row0 = u.pm * BM + wr * 64 + fr, colt = u.pn * BM + wc * 32 + 8 * fq;
#pragma unroll
        for (int ai = 0; ai < 2; ++ai)
#pragma unroll
            for (int m = 0; m < 4; ++m) { const int r = row0 + ai * HALF + m * 16; bf16_t* rowp = P + (size_t)r * ldc + colt;
#pragma unroll
                for (int bj = 0; bj < 2; ++bj) { const f32x4 v0 = acc[ai][bj][m][0], v1 = acc[ai][bj][m][1];
                    u32x4 w; w.x = cvt_pk_bf16(v0[0], v0[1]); w.y = cvt_pk_bf16(v0[2], v0[3]); w.z = cvt_pk_bf16(v1[0], v1[1]); w.w = cvt_pk_bf16(v1[2], v1[3]);
                    *(u32x4*)(rowp + bj * HALF) = w;
                    const int c0 = colt + bj * HALF;
                    if (c0 >= vt_lo && c0 < vt_hi && vrow) {
                        const int hd = c0 - vt_lo; *(u32x4*)(VT + ((size_t)(row_batch(r) * (vt_w >> 6) + (hd >> 6)) * POSN + row_pos(r)) * 64 + (hd & 63)) = w;
                    } else if (c0 >= vt_lo && c0 < vt_hi) {
                        bf16_t* vp = VT + ((size_t)row_batch(r) * vt_w + (c0 - vt_lo)) * POSN + row_pos(r);
                        vp[0 * POSN] = (bf16_t)(w.x & 0xffffu); vp[1 * POSN] = (bf16_t)(w.x >> 16); vp[2 * POSN] = (bf16_t)(w.y & 0xffffu); vp[3 * POSN] = (bf16_t)(w.y >> 16);
                        vp[4 * POSN] = (bf16_t)(w.z & 0xffffu); vp[5 * POSN] = (bf16_t)(w.z >> 16); vp[6 * POSN] = (bf16_t)(w.w & 0xffffu); vp[7 * POSN] = (bf16_t)(w.w >> 16);
                    } } }
    }
};
struct EpiGlu {
    static constexpr bool PERM = true, AFTER_DRAIN = false;
    const bf16_t* YPRE; const bf16_t* PROJ; const float* bglu; bf16_t* YMIX;
    __device__ __forceinline__ void operator()(const f32x4 (&acc)[2][2][4][2], const Unit& u, int wr, int wc, int fr, int fq) const {
        const int row0 = u.pm * BM + wr * 64 + fr, colt = u.pn * BM + wc * 32 + 8 * fq;
#pragma unroll
        for (int bj = 0; bj < 2; ++bj) { const int c0 = colt + bj * HALF;
            const f32x4 b0 = *(const f32x4*)(bglu + c0), b1 = *(const f32x4*)(bglu + c0 + 4);
#pragma unroll
            for (int ai = 0; ai < 2; ++ai)
#pragma unroll
                for (int m = 0; m < 4; ++m) { const int r = row0 + ai * HALF + m * 16;
                    const u32x4 yv = *(const u32x4*)(YPRE + (size_t)r * 512 + c0), gv = *(const u32x4*)(PROJ + (size_t)r * N0 + 512 + c0);
                    const f32x4 a0 = acc[ai][bj][m][0] + b0, a1 = acc[ai][bj][m][1] + b1;
                    float o[8];
                    o[0] = bflo(yv.x) * sigmoid_f(a0[0]) * silu_f(bflo(gv.x)); o[1] = bfhi(yv.x) * sigmoid_f(a0[1]) * silu_f(bfhi(gv.x));
                    o[2] = bflo(yv.y) * sigmoid_f(a0[2]) * silu_f(bflo(gv.y)); o[3] = bfhi(yv.y) * sigmoid_f(a0[3]) * silu_f(bfhi(gv.y));
                    o[4] = bflo(yv.z) * sigmoid_f(a1[0]) * silu_f(bflo(gv.z)); o[5] = bfhi(yv.z) * sigmoid_f(a1[1]) * silu_f(bfhi(gv.z));
                    o[6] = bflo(yv.w) * sigmoid_f(a1[2]) * silu_f(bflo(gv.w)); o[7] = bfhi(yv.w) * sigmoid_f(a1[3]) * silu_f(bfhi(gv.w));
                    u32x4 w; w.x = cvt_pk_bf16(o[0], o[1]); w.y = cvt_pk_bf16(o[2], o[3]); w.z = cvt_pk_bf16(o[4], o[5]); w.w = cvt_pk_bf16(o[6], o[7]);
                    *(u32x4*)(YMIX + (size_t)r * DM + c0) = w; } }
    }
};
struct EpiF32 {
    static constexpr bool PERM = false, AFTER_DRAIN = false;
    float* O; int ldc;
    __device__ __forceinline__ void operator()(const f32x4 (&acc)[2][2][4][2], const Unit& u, int wr, int wc, int fr, int fq) const {
        const int row0 = u.pm * BM + wr * 64 + fr, col0 = u.pn * BM + wc * 32 + 4 * fq;
#pragma unroll
        for (int ai = 0; ai < 2; ++ai)
#pragma unroll
            for (int m = 0; m < 4; ++m) { float* rowp = O + (size_t)(row0 + ai * HALF + m * 16) * ldc + col0;
#pragma unroll
                for (int bj = 0; bj < 2; ++bj)
#pragma unroll
                    for (int n = 0; n < 2; ++n) *(f32x4*)(rowp + bj * HALF + n * 16) = acc[ai][bj][m][n]; }
    }
};
template <class Epi, class Sched, bool ALIGN_EPI = false, bool SP2 = false>
__device__ __forceinline__ void gemm_phase(PG8_LAS unsigned char* lds, const Gemm g, const Sched& S, const Epi& E) {
    const int tid = threadIdx.x, wid = __builtin_amdgcn_readfirstlane(tid >> 6), lane = tid & 63, wr = wid >> 2, wc = wid & 3, fr = lane & 15, fq = lane >> 4;
    const int K = g.K, nt = K / BK;
    unsigned voffA[2], voffB[2];
#pragma unroll
    for (int i = 0; i < 2; ++i) { int R, C; stage_rc(tid * 16 + i * 8192, R, C); const int Rb = Epi::PERM ? ((R & ~31) + perm32(R & 31)) : R;
        voffA[i] = (unsigned)(R * K + C) * 2u; voffB[i] = (unsigned)(Rb * K + C) * 2u; }
    const size_t kstep = (size_t)(BK * 2);
    const size_t hstep = (size_t)HALF * K * 2;
    const size_t tstep = 2 * hstep;
    const unsigned ldsw = (unsigned)wid * 1024u;
    const int aoff = lds_byte(wr * 64 + fr, fq * 8), boff = lds_byte(wc * 32 + fr, fq * 8);
#define PG8_SA(b, h) (((b) * 2 + (h)) * HTB)
#define PG8_SB(b, h) ((4 + (b) * 2 + (h)) * HTB)
#define PG8_STAGE(bufoff, gbase, voff) do { _Pragma("unroll") for (int _i = 0; _i < 2; ++_i) \
        __builtin_amdgcn_global_load_lds((const unsigned*)((const char*)(gbase) + (voff)[_i]), (PG8_LAS unsigned*)(lds + (bufoff) + ldsw + _i * 8192), 16, 0, 0); } while (0)
#define PG8_LDA(dst, b, h) do { _Pragma("unroll") for (int m = 0; m < 4; ++m) _Pragma("unroll") for (int k = 0; k < 2; ++k) dst[m][k] = *(const PG8_LAS bf16x8*)(lds + PG8_SA(b, h) + aoff + m * 2048 + k * 1024); } while (0)
#define PG8_LDB(dst, b, h) do { _Pragma("unroll") for (int n = 0; n < 2; ++n) _Pragma("unroll") for (int k = 0; k < 2; ++k) dst[n][k] = *(const PG8_LAS bf16x8*)(lds + PG8_SB(b, h) + boff + n * 2048 + k * 1024); } while (0)
#define PG8_MMA(ai, bj, At, Bt) do { __builtin_amdgcn_s_setprio(1); _Pragma("unroll") for (int m = 0; m < 4; ++m) _Pragma("unroll") for (int n = 0; n < 2; ++n) _Pragma("unroll") for (int k = 0; k < 2; ++k) \
        acc[ai][bj][m][n] = __builtin_amdgcn_mfma_f32_16x16x32_bf16(Bt[n][k], At[m][k], acc[ai][bj][m][n], 0, 0, 0); __builtin_amdgcn_s_setprio(0); } while (0)
#define PG8_WAIT_V(n) asm volatile("s_waitcnt vmcnt(" #n ")" ::: "memory")
#define PG8_WAIT_L(n) asm volatile("s_waitcnt lgkmcnt(" #n ")" ::: "memory")
#define PG8_BAR __builtin_amdgcn_s_barrier()
#define PG8_SCHED __builtin_amdgcn_sched_barrier(0)
    Unit cur, nxt; int ui = 0;
    if (!S.next(0, cur)) return;
    f32x4 acc[2][2][4][2];
#pragma unroll
    for (int a = 0; a < 2; ++a)
#pragma unroll
        for (int b = 0; b < 2; ++b)
#pragma unroll
            for (int m = 0; m < 4; ++m)
#pragma unroll
                for (int n = 0; n < 2; ++n) acc[a][b][m][n] = (f32x4){0.f, 0.f, 0.f, 0.f};
    bf16x8 At[4][2], B0[2][2], B1[2][2];
    const char* cA = (const char*)g.A + (size_t)cur.pm * tstep; const char* cB = (const char*)g.Bt + (size_t)cur.pn * tstep;
    S.a_ready(cur);
    if constexpr (SP2) {
        PG8_STAGE(PG8_SB(0, 0), cB, voffB); PG8_STAGE(PG8_SB(0, 1), cB + hstep, voffB); PG8_STAGE(PG8_SA(0, 0), cA, voffA); PG8_STAGE(PG8_SA(0, 1), cA + hstep, voffA);
        if (wr == 1) PG8_BAR;
        PG8_WAIT_V(2); PG8_BAR;
        PG8_STAGE(PG8_SB(1, 0), cB + kstep, voffB); PG8_STAGE(PG8_SA(1, 0), cA + kstep, voffA); PG8_STAGE(PG8_SB(1, 1), cB + hstep + kstep, voffB);
        PG8_WAIT_V(6); PG8_BAR;
    } else {
        PG8_STAGE(PG8_SB(0, 0), cB, voffB); PG8_STAGE(PG8_SA(0, 0), cA, voffA); PG8_STAGE(PG8_SB(0, 1), cB + hstep, voffB); PG8_STAGE(PG8_SA(0, 1), cA + hstep, voffA);
        if (wr == 1) PG8_BAR;
        PG8_WAIT_V(4); PG8_BAR;
        PG8_STAGE(PG8_SB(1, 0), cB + kstep, voffB); PG8_STAGE(PG8_SA(1, 0), cA + kstep, voffA); PG8_STAGE(PG8_SB(1, 1), cB + hstep + kstep, voffB);
        PG8_WAIT_V(6); PG8_BAR;
    }
    for (;;) {
        const bool has_next = S.next(ui + 1, nxt);
        const char* nA = has_next ? (const char*)g.A + (size_t)nxt.pm * tstep : cA; const char* nB = has_next ? (const char*)g.Bt + (size_t)nxt.pn * tstep : cB;
        for (int t = 0; t < nt; t += 2) {
            const bool last = (t == nt - 2);
            const char* a1 = cA + (size_t)(t + 1) * kstep;
            const char* a2 = last ? nA : cA + (size_t)(t + 2) * kstep; const char* b2 = last ? nB : cB + (size_t)(t + 2) * kstep;
            const char* a3 = a2 + kstep; const char* b3 = b2 + kstep;
            if (last && has_next) S.a_ready(nxt);
            if constexpr (SP2) {
            PG8_LDB(B0, 0, 0); PG8_LDB(B1, 0, 1); PG8_SCHED; PG8_LDA(At, 0, 0); PG8_STAGE(PG8_SA(1, 1), a1 + hstep, voffA);
            PG8_WAIT_V(8); PG8_WAIT_L(0); PG8_BAR; PG8_MMA(0, 0, At, B0); PG8_MMA(0, 1, At, B1); PG8_BAR; PG8_SCHED;
            PG8_LDA(At, 0, 1); PG8_STAGE(PG8_SB(0, 0), b2, voffB); PG8_STAGE(PG8_SB(0, 1), b2 + hstep, voffB); PG8_STAGE(PG8_SA(0, 0), a2, voffA);
            PG8_WAIT_V(8); PG8_WAIT_L(0); PG8_BAR; PG8_MMA(1, 0, At, B0); PG8_MMA(1, 1, At, B1); PG8_BAR; PG8_SCHED;
            PG8_LDB(B0, 1, 0); PG8_LDB(B1, 1, 1); PG8_SCHED; PG8_LDA(At, 1, 0); PG8_STAGE(PG8_SA(0, 1), a2 + hstep, voffA);
            PG8_WAIT_V(8); PG8_WAIT_L(0); PG8_BAR; PG8_MMA(0, 0, At, B0); PG8_MMA(0, 1, At, B1); PG8_BAR; PG8_SCHED;
            PG8_LDA(At, 1, 1); PG8_STAGE(PG8_SB(1, 0), b3, voffB); PG8_STAGE(PG8_SB(1, 1), b3 + hstep, voffB); PG8_STAGE(PG8_SA(1, 0), a3, voffA);
            PG8_WAIT_V(8); PG8_WAIT_L(0); PG8_BAR; PG8_MMA(1, 0, At, B0); PG8_MMA(1, 1, At, B1); PG8_BAR; PG8_SCHED;
            } else {
            PG8_LDB(B0, 0, 0); PG8_SCHED; PG8_LDA(At, 0, 0); PG8_STAGE(PG8_SA(1, 1), a1 + hstep, voffA);
            PG8_WAIT_L(8); PG8_BAR; PG8_WAIT_L(0); PG8_MMA(0, 0, At, B0); PG8_BAR; PG8_SCHED;
            PG8_LDB(B1, 0, 1); PG8_STAGE(PG8_SB(0, 0), b2, voffB);
            PG8_BAR; PG8_WAIT_L(0); PG8_MMA(0, 1, At, B1); PG8_BAR;
            PG8_LDA(At, 0, 1); PG8_STAGE(PG8_SA(0, 0), a2, voffA);
            PG8_BAR; PG8_WAIT_L(0); PG8_MMA(1, 0, At, B0); PG8_BAR; PG8_SCHED;
            PG8_STAGE(PG8_SB(0, 1), b2 + hstep, voffB);
            PG8_WAIT_V(6); PG8_BAR; PG8_MMA(1, 1, At, B1); PG8_BAR;
            PG8_LDB(B0, 1, 0); PG8_SCHED; PG8_LDA(At, 1, 0); PG8_STAGE(PG8_SA(0, 1), a2 + hstep, voffA);
            PG8_WAIT_L(8); PG8_BAR; PG8_WAIT_L(0); PG8_MMA(0, 0, At, B0); PG8_BAR; PG8_SCHED;
            PG8_LDB(B1, 1, 1); PG8_STAGE(PG8_SB(1, 0), b3, voffB);
            PG8_BAR; PG8_WAIT_L(0); PG8_MMA(0, 1, At, B1); PG8_BAR;
            PG8_LDA(At, 1, 1); PG8_STAGE(PG8_SA(1, 0), a3, voffA);
            PG8_BAR; PG8_WAIT_L(0); PG8_MMA(1, 0, At, B0); PG8_BAR; PG8_SCHED;
            PG8_STAGE(PG8_SB(1, 1), b3 + hstep, voffB);
            PG8_WAIT_V(6); PG8_BAR; PG8_MMA(1, 1, At, B1); PG8_BAR;
            }
        }
        if constexpr (ALIGN_EPI) { if (wr == 0) PG8_BAR; }
        if constexpr (!Epi::AFTER_DRAIN) { E(acc, cur, wr, wc, fr, fq); S.done(cur); }
        if (!has_next) break;
#pragma unroll
        for (int a = 0; a < 2; ++a)
#pragma unroll
            for (int b = 0; b < 2; ++b)
#pragma unroll
                for (int m = 0; m < 4; ++m)
#pragma unroll
                    for (int n = 0; n < 2; ++n) acc[a][b][m][n] = (f32x4){0.f, 0.f, 0.f, 0.f};
        cur = nxt; cA = nA; cB = nB; ++ui;
        if constexpr (ALIGN_EPI) { if (wr == 1) PG8_BAR; }
    }
    PG8_WAIT_V(0);
    if constexpr (!ALIGN_EPI) { if (wr == 0) PG8_BAR; }
    PG8_BAR;
    if constexpr (Epi::AFTER_DRAIN) { E.fused(acc, cur, wr, wc, fr, fq, lds, wid, lane); S.done(cur); }
#undef PG8_SA
#undef PG8_SB
#undef PG8_STAGE
#undef PG8_LDA
#undef PG8_LDB
#undef PG8_MMA
#undef PG8_WAIT_V
#undef PG8_WAIT_L
#undef PG8_BAR
#undef PG8_SCHED
}
}
#define XB_TMO      128
#define XB_XCNT(j)  (256  + 64 * (j))
#define XB_XSUB(j)  (1280 + 64 * (j))
#define XB_XGEN(j)  (2304 + 64 * (j))
#define XB_TOP      3328
#define XB_TOPGEN   3392
#define XCD_BAR_WORDS 3456
#define XB_SPIN_CAP (1u << 18)

__device__ __forceinline__ unsigned xb_ld(unsigned* p)              { return __hip_atomic_load(p, __ATOMIC_RELAXED, __HIP_MEMORY_SCOPE_AGENT); }
__device__ __forceinline__ unsigned xb_add(unsigned* p, unsigned v) { return __hip_atomic_fetch_add(p, v, __ATOMIC_RELAXED, __HIP_MEMORY_SCOPE_AGENT); }
__device__ __forceinline__ unsigned xb_xcc_id() { return (unsigned)__builtin_amdgcn_s_getreg((3 << 11) | 20) & 0xFu; }
#define XB_SPIN(cond, bar) do { unsigned _sp = 0; while (cond) { __builtin_amdgcn_s_sleep(1); \
    if ((++_sp & 255u) == 0u) { if (xb_ld(&(bar)[XB_TMO])) break; if (_sp > XB_SPIN_CAP) { atomicAdd(&(bar)[XB_TMO], 1u); break; } } } } while (0)

struct XcdBarrier {
    unsigned* bar; unsigned x;
    volatile LAS unsigned* st;
};

__device__ __forceinline__ XcdBarrier xcd_barrier_post(unsigned* bar, volatile LAS unsigned* st) {
    XcdBarrier b; b.bar = bar; b.x = xb_xcc_id(); b.st = st;
    if (threadIdx.x == 0) (void)xb_add(&bar[XB_XCNT(b.x)], 1u);
    return b;
}
__device__ __forceinline__ void xcd_barrier_complete(unsigned* bar, unsigned x, unsigned& nloc, unsigned& nx) {
    const unsigned G = gridDim.x * gridDim.y * gridDim.z;
    unsigned sum, cnt, mine, sp = 0u;
    for (;;) {
        sum = 0u; cnt = 0u; mine = 0u;
#pragma unroll
        for (unsigned j = 0; j < 16; ++j) { const unsigned c = xb_ld(&bar[XB_XCNT(j)]); sum += c; cnt += (c > 0u) ? 1u : 0u; mine = (j == x) ? c : mine; }
        if (sum == G) break;
        __builtin_amdgcn_s_sleep(1);
        if ((++sp & 255u) == 0u) { if (xb_ld(&bar[XB_TMO])) break; if (sp > XB_SPIN_CAP) { atomicAdd(&bar[XB_TMO], 1u); break; } }
    }
    nloc = mine > 0u ? mine : 1u; nx = cnt > 0u ? cnt : 1u;
}

__device__ __forceinline__ void xcd_barrier(const XcdBarrier& b) {
    asm volatile("s_waitcnt vmcnt(0)" ::: "memory");
    __syncthreads();
    if (threadIdx.x == 0) {
        unsigned* bar = b.bar;
        __builtin_amdgcn_s_waitcnt(0);
        unsigned nloc = b.st[0], nx = b.st[1];
        if (nloc == 0u) { xcd_barrier_complete(bar, b.x, nloc, nx); b.st[0] = nloc; b.st[1] = nx; }
        const unsigned old = xb_add(&bar[XB_XSUB(b.x)], 1u);
        const unsigned gen = old / nloc;
        if (old + 1u == (gen + 1u) * nloc) {
            __builtin_amdgcn_fence(__ATOMIC_RELEASE, "agent");
            asm volatile("s_waitcnt vmcnt(0)" ::: "memory");
            const unsigned og = xb_add(&bar[XB_TOP], 1u);
            const unsigned tg = og / nx;
            if (og + 1u == (tg + 1u) * nx) xb_add(&bar[XB_TOPGEN], 1u);
            else XB_SPIN(xb_ld(&bar[XB_TOPGEN]) == tg, bar);
            __builtin_amdgcn_fence(__ATOMIC_ACQUIRE, "agent");
            xb_add(&bar[XB_XGEN(b.x)], 1u);
            asm volatile("s_waitcnt vmcnt(0)" ::: "memory");
        } else {
            XB_SPIN(xb_ld(&bar[XB_XGEN(b.x)]) == gen, bar);
            __builtin_amdgcn_fence(__ATOMIC_ACQUIRE, "agent");
            asm volatile("s_waitcnt vmcnt(0)" ::: "memory");
        }
    }
    __syncthreads();
}

DI int crow16(int reg, int hf) { return (reg & 3) + 8 * (reg >> 2) + 4 * hf; }
DI unsigned cvtpk(float lo, float hi) { typedef float f2 __attribute__((ext_vector_type(2))); typedef __bf16 b2 __attribute__((ext_vector_type(2))); f2 v = {lo, hi}; b2 b = __builtin_convertvector(v, b2); return __builtin_bit_cast(unsigned, b); }
struct AttnP { const bf16_t* Q; const bf16_t* K; const bf16_t* VT; const bf16_t* Gt; bf16_t* Y; const float* relb; };

template <int MODE> DI void attn_unit(int unit, const AttnP& P, int lane) {
    const int ql = lane & 31, hf = lane >> 5;
    int b, h, kvh, qrow, NT, rp = 0, ci = 0, rs0 = 0, c0 = 0, qr = 0, qc = 0, rsq = 0, csq = 0;
    if (MODE == 0) { ci = unit & 3; rp = (unit >> 2) & 31; h = (unit >> 7) & 7; b = unit >> 10; kvh = h;
        qr = 2 * rp + (ql >> 4); qc = 16 * ci + (ql & 15); qrow = b * SEQ + qr * 64 + qc;
        rs0 = min(max(2 * rp - 4, 0), 56); const int rs1 = min(max(2 * rp - 3, 0), 56); NT = 8 + (rs1 + 8 - rs0);
        c0 = min(max(16 * ci - 8, 0), 32); rsq = min(max(qr - 4, 0), 56); csq = min(max(qc - 8, 0), 48);
    } else if (MODE == 1) { const int qt = unit & 7; h = (unit >> 3) & 7; b = unit >> 6; kvh = h; qrow = NLAT + b * LC + 32 * qt + ql; NT = 8; }
    else { const int qt = unit & 127; h = (unit >> 7) & 7; b = unit >> 10; kvh = h >> 2; qrow = b * SEQ + 32 * qt + ql; NT = POSN / 32; }
    const bf16_t* qp; const bf16_t* kb; size_t kpitch; const bf16_t* vt; const bf16_t* gp; bf16_t* yp;
    if (MODE == 2) { qp = P.Q + ((size_t)(b * 8 + h) * SEQ + (qrow - b * SEQ)) * 64; kb = P.K + (size_t)(b * 2 + kvh) * POSN * 64; kpitch = 64;
        vt = P.VT + (size_t)(b * 2 + kvh) * 64 * POSN; gp = P.Gt + (size_t)qrow * N1 + 1792 + h * 64; }
    else { qp = P.Q + (size_t)qrow * N0 + 1024 + h * 64; kb = P.K + 1536 + h * 64; kpitch = N0; vt = P.VT + (size_t)(b * 8 + h) * 64 * POSN; gp = P.Gt + (size_t)qrow * N0 + 2560 + h * 64; }
    yp = P.Y + (size_t)qrow * DM + 512 + h * 64;
    bf16x8_t qf[4];
#pragma unroll
    for (int ks = 0; ks < 4; ++ks) qf[ks] = *(const bf16x8_t*)(qp + 16 * ks + 8 * hf);
    const bf16_t* vt0 = vt + (size_t)ql * POSN + 4 * hf;
    f32x16_t o0 = {}, o1 = {};
    float m = -1e30f, l = 0.f;
    auto tile_krow = [&](int t) -> int { if (MODE == 2) return 32 * t + ql; if (t < 8) return NLAT + b * LC + 32 * t + ql; return b * SEQ + (rs0 + t - 8) * 64 + c0 + ql; };
    auto tile_pos0 = [&](int t) -> int { if (MODE == 2) return 32 * t; if (t < 8) return 32 * t; return LC + (rs0 + t - 8) * 64 + c0; };
    bf16x8_t kn[4];
    { const bf16_t* kp = kb + (size_t)tile_krow(0) * kpitch + 8 * hf;
#pragma unroll
      for (int ks = 0; ks < 4; ++ks) kn[ks] = *(const bf16x8_t*)(kp + 16 * ks); }
#pragma unroll 1
    for (int t = 0; t < NT; ++t) {
        bf16x8_t kf[4];
#pragma unroll
        for (int ks = 0; ks < 4; ++ks) kf[ks] = kn[ks];
        if (t + 1 < NT) { const bf16_t* kp = kb + (size_t)tile_krow(t + 1) * kpitch + 8 * hf;
#pragma unroll
            for (int ks = 0; ks < 4; ++ks) kn[ks] = *(const bf16x8_t*)(kp + 16 * ks); }
        const bf16_t* vp = vt0 + tile_pos0(t);
        s16x4_t va[2][2][2];
#pragma unroll
        for (int dt = 0; dt < 2; ++dt)
#pragma unroll
            for (int s = 0; s < 2; ++s) { va[dt][s][0] = *(const s16x4_t*)(vp + (size_t)dt * 32 * POSN + 16 * s); va[dt][s][1] = *(const s16x4_t*)(vp + (size_t)dt * 32 * POSN + 16 * s + 8); }
        f32x16_t sc = {};
#pragma unroll
        for (int ks = 0; ks < 4; ++ks) sc = __builtin_amdgcn_mfma_f32_32x32x16_bf16(kf[ks], qf[ks], sc, 0, 0, 0);
        float xs[16];
        if (MODE == 0 && t >= 8) {
            const int kr = rs0 + t - 8; const bool row_ok = (kr >= rsq) && (kr < rsq + 8);
            const float* rb = P.relb + (h * 15 + (kr - qr + 7)) * 31 + (15 - qc);
#pragma unroll
            for (int r = 0; r < 16; ++r) { const int kc = c0 + crow16(r, hf); const bool ok = row_ok && (kc >= csq) && (kc < csq + 16);
                const float bias = ok ? rb[kc] : 0.f; xs[r] = ok ? (sc[r] * 0.125f + bias) * LOG2E : -1e30f; }
        } else {
#pragma unroll
            for (int r = 0; r < 16; ++r) xs[r] = (MODE == 2) ? sc[r] : sc[r] * (0.125f * LOG2E);
        }
        float tm = xs[0];
#pragma unroll
        for (int r = 1; r < 16; ++r) tm = fmaxf(tm, xs[r]);
        tm = fmaxf(tm, __shfl_xor(tm, 32));
        const float mn = fmaxf(m, tm), al = __builtin_amdgcn_exp2f(m - mn);
        float ps = 0.f;
#pragma unroll
        for (int r = 0; r < 16; ++r) { xs[r] = __builtin_amdgcn_exp2f(xs[r] - mn); ps += xs[r]; }
        l = l * al + ps; m = mn;
#pragma unroll
        for (int r = 0; r < 16; ++r) { o0[r] *= al; o1[r] *= al; }
        bf16x8_t pf[2];
#pragma unroll
        for (int s = 0; s < 2; ++s) { v4u w; w.x = cvtpk(xs[8 * s], xs[8 * s + 1]); w.y = cvtpk(xs[8 * s + 2], xs[8 * s + 3]); w.z = cvtpk(xs[8 * s + 4], xs[8 * s + 5]); w.w = cvtpk(xs[8 * s + 6], xs[8 * s + 7]);
            pf[s] = __builtin_bit_cast(bf16x8_t, w); }
#pragma unroll
        for (int s = 0; s < 2; ++s) {
            const bf16x8_t a0 = __builtin_shufflevector(va[0][s][0], va[0][s][1], 0, 1, 2, 3, 4, 5, 6, 7);
            const bf16x8_t a1 = __builtin_shufflevector(va[1][s][0], va[1][s][1], 0, 1, 2, 3, 4, 5, 6, 7);
            o0 = __builtin_amdgcn_mfma_f32_32x32x16_bf16(a0, pf[s], o0, 0, 0, 0);
            o1 = __builtin_amdgcn_mfma_f32_32x32x16_bf16(a1, pf[s], o1, 0, 0, 0);
        }
    }
    l += __shfl_xor(l, 32);
    const float rl = 1.f / l;
#pragma unroll
    for (int dt = 0; dt < 2; ++dt)
#pragma unroll
        for (int rg = 0; rg < 4; ++rg) { const int d = 32 * dt + 8 * rg + 4 * hf;
            const v2u gv = *(const v2u*)(gp + d);
            const float g0 = silu_f(bflo(gv.x)), g1 = silu_f(bfhi(gv.x)), g2 = silu_f(bflo(gv.y)), g3 = silu_f(bfhi(gv.y));
            const f32x16_t& oo = dt ? o1 : o0;
            v2u w; w.x = pk2(oo[4 * rg] * rl * g0, oo[4 * rg + 1] * rl * g1); w.y = pk2(oo[4 * rg + 2] * rl * g2, oo[4 * rg + 3] * rl * g3);
            *(v2u*)(yp + d) = w; }
}

constexpr int LRU_NCH = 34;
typedef float f32x2_t __attribute__((ext_vector_type(2)));
struct LruP { const bf16_t* P1; const float* conv_w; const float* conv_b; const float* lam; const float* b_a; const float* b_x; const bf16_t* WT; f32x2_t* LSUM; bf16_t* YMIX; };

template <bool PASS2> DI void lru_item(int item, const LruP& p, LAS unsigned char* lds, int tid, int wave, int lane) {
    LAS bf16_t* XA = (LAS bf16_t*)lds;
    LAS float* XF = (LAS float*)(lds + 18432);
    LAS float* CW = (LAS float*)(lds + 18432 + 33280);
    LAS f32x2_t* SEG = (LAS f32x2_t*)(lds + 18432 + 33280 + 1280);
    LAS f32x2_t* CS = (LAS f32x2_t*)(lds + 18432 + 33280 + 1280 + 4096);
    LAS float* CC = (LAS float*)(lds + 18432 + 33280 + 1280 + 4096 + 34816);
    int nb, cidx, b;
    if (PASS2) { nb = item & 7; cidx = 2 + ((item >> 3) & 31); b = item >> 8; } else { nb = item & 7; cidx = (item >> 3) % LRU_NCH; b = (item >> 3) / LRU_NCH; }
    const int s0 = cidx < 2 ? NLAT + b * LC : b * SEQ, sl = cidx < 2 ? LC : SEQ, t0 = cidx < 2 ? cidx * 128 : (cidx - 2) * 128;
    const int n = lane & 15, q = lane >> 4;
    __syncthreads();
    if (tid < 320) CW[tid] = tid < 256 ? p.conv_w[(tid >> 6) * 512 + nb * 64 + (tid & 63)] : p.conv_b[nb * 64 + (tid & 63)];
    if (PASS2) { for (int e = tid; e < 2 * LRU_NCH * 64; e += NTHREADS) { const int ch = e & 63, cc = (e >> 6) % LRU_NCH, dir = (e >> 6) / LRU_NCH; CS[e] = p.LSUM[((size_t)(b * LRU_NCH + cc) * 2 + dir) * 512 + nb * 64 + ch]; } }
    __syncthreads();
    {
        const int tl = tid >> 2, cg = tid & 3;
        float xv[4][16];
#pragma unroll
        for (int j = 0; j < 4; ++j) { const int tt = t0 + tl + j - 1; const bool ok = tt >= 0 && tt < sl;
            v4u w0 = {0u, 0u, 0u, 0u}, w1 = {0u, 0u, 0u, 0u};
            if (ok) { const bf16_t* src = p.P1 + (size_t)(s0 + tt) * N1 + nb * 64 + cg * 16; w0 = *(const v4u*)src; w1 = *(const v4u*)(src + 8); }
            xv[j][0] = bflo(w0.x); xv[j][1] = bfhi(w0.x); xv[j][2] = bflo(w0.y); xv[j][3] = bfhi(w0.y); xv[j][4] = bflo(w0.z); xv[j][5] = bfhi(w0.z); xv[j][6] = bflo(w0.w); xv[j][7] = bfhi(w0.w);
            xv[j][8] = bflo(w1.x); xv[j][9] = bfhi(w1.x); xv[j][10] = bflo(w1.y); xv[j][11] = bfhi(w1.y); xv[j][12] = bflo(w1.z); xv[j][13] = bfhi(w1.z); xv[j][14] = bflo(w1.w); xv[j][15] = bfhi(w1.w); }
#pragma unroll
        for (int e = 0; e < 16; ++e) { const int c = cg * 16 + e;
            const float xc = CW[c] * xv[0][e] + CW[64 + c] * xv[1][e] + CW[128 + c] * xv[2][e] + CW[192 + c] * xv[3][e] + CW[256 + c];
            XF[tl * 65 + c] = xc; XA[tl * 72 + c] = f2bf(xc); }
    }
    __syncthreads();
    bf16x8_t af[2];
#pragma unroll
    for (int ks = 0; ks < 2; ++ks) af[ks] = *(const LAS bf16x8_t*)(XA + (wave * 16 + n) * 72 + 32 * ks + 8 * q);
    float hsum[4][4];
#pragma unroll
    for (int c4 = 0; c4 < 4; ++c4)
#pragma unroll
        for (int r = 0; r < 4; ++r) hsum[c4][r] = 0.f;
#pragma unroll 1
    for (int dir = 0; dir < 2; ++dir) {
        f32x4_t acc[8];
#pragma unroll
        for (int nt = 0; nt < 8; ++nt) { acc[nt] = (f32x4_t){0.f, 0.f, 0.f, 0.f};
            const bf16_t* wrow = p.WT + (size_t)(nb * 256 + (dir * 2 + (nt >> 2)) * 64 + (nt & 3) * 16 + n) * 64 + 8 * q;
#pragma unroll
            for (int ks = 0; ks < 2; ++ks) { const bf16x8_t bfr = *(const bf16x8_t*)(wrow + 32 * ks); acc[nt] = __builtin_amdgcn_mfma_f32_16x16x32_bf16(af[ks], bfr, acc[nt], 0, 0, 0); } }
        float a[4][4], bt[4][4];
#pragma unroll
        for (int c4 = 0; c4 < 4; ++c4) { const int ch = nb * 64 + c4 * 16 + n;
            const float ba = p.b_a[dir * 512 + ch], bx = p.b_x[dir * 512 + ch], lm = p.lam[dir * 512 + ch]; const float sp = log1pf(__expf(-lm));
#pragma unroll
            for (int r = 0; r < 4; ++r) { const float gr = sigmoid_f(acc[c4][r] + ba), gi = sigmoid_f(acc[c4 + 4][r] + bx);
                const float log_a = -8.f * gr * sp; const float av = __builtin_amdgcn_exp2f(log_a * LOG2E); a[c4][r] = av;
                const float x2 = 2.f * log_a;
                const float ser = -x2 * (1.f + x2 * (0.5f + x2 * (0.16666667f + x2 * (0.041666668f + x2 * 0.0083333338f))));
                const float om = x2 > -0.5f ? ser : 1.f - av * av;
                const float mult = __builtin_amdgcn_sqrtf(fmaxf(om, 0.f));
                bt[c4][r] = mult * gi * XF[(wave * 16 + 4 * q + r) * 65 + c4 * 16 + n]; } }
        float Pq[4], Sq[4];
#pragma unroll
        for (int c4 = 0; c4 < 4; ++c4) { float P = 1.f, S = 0.f;
#pragma unroll
            for (int rr = 0; rr < 4; ++rr) { const int r = dir == 0 ? rr : 3 - rr; S = a[c4][r] * S + bt[c4][r]; P *= a[c4][r]; }
            Pq[c4] = P; Sq[c4] = S; }
        float Pin[4], Sin[4];
#pragma unroll
        for (int c4 = 0; c4 < 4; ++c4) { float P = 1.f, S = 0.f, Pw = 1.f, Sw = 0.f;
#pragma unroll
            for (int kk = 0; kk < 4; ++kk) { const int k = dir == 0 ? kk : 3 - kk;
                const float pk = __shfl(Pq[c4], n + 16 * k), sk = __shfl(Sq[c4], n + 16 * k);
                const bool before = dir == 0 ? (k < q) : (k > q);
                if (before) { S = pk * S + sk; P *= pk; }
                Sw = pk * Sw + sk; Pw *= pk; }
            Pin[c4] = P; Sin[c4] = S;
            if (q == 0) SEG[wave * 64 + c4 * 16 + n] = (f32x2_t){Pw, Sw}; }
        __syncthreads();
        if (!PASS2) {
            if (tid < 64) { float P = 1.f, S = 0.f;
#pragma unroll
                for (int ww = 0; ww < 8; ++ww) { const int w = dir == 0 ? ww : 7 - ww; const f32x2_t s = SEG[w * 64 + tid]; S = s[0] * S + s[1]; P *= s[0]; }
                p.LSUM[((size_t)(b * LRU_NCH + cidx) * 2 + dir) * 512 + nb * 64 + tid] = (f32x2_t){P, S}; }
            __syncthreads();
        } else {
            if (tid < 64) {
                float S = 0.f;
                if (dir == 0) { for (int cc = 0; cc < cidx; ++cc) { const f32x2_t s = CS[(0 * LRU_NCH + cc) * 64 + tid]; S = s[0] * S + s[1]; } }
                else { for (int cc = 1; cc >= 0; --cc) { const f32x2_t s = CS[(1 * LRU_NCH + cc) * 64 + tid]; S = s[0] * S + s[1]; }
                       for (int cc = LRU_NCH - 1; cc > cidx; --cc) { const f32x2_t s = CS[(1 * LRU_NCH + cc) * 64 + tid]; S = s[0] * S + s[1]; } }
                CC[dir * 64 + tid] = S; }
            __syncthreads();
#pragma unroll
            for (int c4 = 0; c4 < 4; ++c4) { float h = CC[dir * 64 + c4 * 16 + n];
                for (int ww = 0; ww < 8; ++ww) { const int w = dir == 0 ? ww : 7 - ww; const bool before = dir == 0 ? (w < wave) : (w > wave);
                    if (before) { const f32x2_t s = SEG[w * 64 + c4 * 16 + n]; h = s[0] * h + s[1]; } }
                h = Pin[c4] * h + Sin[c4];
#pragma unroll
                for (int rr = 0; rr < 4; ++rr) { const int r = dir == 0 ? rr : 3 - rr; h = a[c4][r] * h + bt[c4][r]; hsum[c4][r] += h; } }
            __syncthreads();
        }
    }
    if (PASS2) {
#pragma unroll
        for (int c4 = 0; c4 < 4; ++c4)
#pragma unroll
            for (int r = 0; r < 4; ++r) { const size_t row = (size_t)(s0 + t0 + wave * 16 + 4 * q + r); const int ch = nb * 64 + c4 * 16 + n;
                const float gc = bf2f(p.P1[row * N1 + 512 + ch]); p.YMIX[row * DM + ch] = f2bf(hsum[c4][r] * silu_f(gc)); }
    }
}

DI void qkprep_row(int r, const bf16_t* P1, const float* qn, const float* kn, const float* ROPE, bf16_t* QP, bf16_t* KP, int lane) {
    const int b = row_batch(r); const bool lat = r < NLAT; const int t = r & 4095;
    float cs = 1.f, sn = 0.f;
    if (lat) { const f32x2_t cv = *(const f32x2_t*)(ROPE + ((size_t)t * 32 + (lane >> 1)) * 2); cs = cv[0]; sn = cv[1]; }
    const float wq = qn[lane], wk = kn[lane];
#pragma unroll 2
    for (int slot = lat ? 0 : 8; slot < 10; ++slot) {
        const int col0 = slot < 8 ? 1024 + slot * 64 : 1536 + (slot - 8) * 64;
        const float x = bf2f(P1[(size_t)r * N1 + col0 + lane]);
        const float ss = wave_sum(x * x);
        float y = x * rsqrtf(ss * (1.f / 64.f) + EPSN) * (slot < 8 ? wq : wk);
        if (lat) { const float pr = __shfl_xor(y, 1); y = (lane & 1) ? (pr * sn + y * cs) : (y * cs - pr * sn); }
        if (slot < 8) QP[((size_t)(b * 8 + slot) * SEQ + t) * 64 + lane] = f2bf(y * (0.125f * LOG2E));
        else KP[((size_t)(b * 2 + (slot - 8)) * POSN + row_pos(r)) * 64 + lane] = f2bf(y);
    }
}

constexpr size_t WS_CARRY0 = 246 * MiB;
constexpr int S5_NCOL = 272;

DI void s5_lambar_pow(double lre, double lim, double dt, int e, double& pr, double& pi) { const double mag = exp(lre * dt * e), ang = lim * dt * e; pr = mag * cos(ang); pi = mag * sin(ang); }
typedef double f64x2_t __attribute__((ext_vector_type(2)));
DI void s5_tables_block(int gd, const float* lam_re, const float* lam_im, const float* log_dt, const float* b_re, const float* b_im, const float* c_re, const float* c_im,
                        bf16_t* W16, bf16_t* WC, bf16_t* KT, float* L16, LAS unsigned char* lds, int tid) {
    const int g = gd >> 1, dir = gd & 1, gi = dir * 32 + g;
    LAS f64x2_t* POW = (LAS f64x2_t*)lds;
    LAS f64x2_t* PC = POW + 17 * 64;
    __syncthreads();
    const double dt = exp((double)log_dt[gi]);
    for (int idx = tid; idx < 17 * 64; idx += NTHREADS) { const int e = idx >> 6, p = idx & 63;
        const double lre = lam_re[gi * 64 + p], lim = lam_im[gi * 64 + p];
        double pr, pi, l1r, l1i; s5_lambar_pow(lre, lim, dt, e, pr, pi); s5_lambar_pow(lre, lim, dt, 1, l1r, l1i);
        const double nr = l1r - 1.0, ni = l1i, den = lre * lre + lim * lim, cfr = (nr * lre + ni * lim) / den, cfi = (ni * lre - nr * lim) / den;
        POW[idx] = (f64x2_t){pr, pi}; PC[idx] = (f64x2_t){pr * cfr - pi * cfi, pr * cfi + pi * cfr};
        if (e == 16) { L16[((g * 2 + dir) * 64 + p) * 2] = (float)pr; L16[((g * 2 + dir) * 64 + p) * 2 + 1] = (float)pi; } }
    __syncthreads();
    for (int idx = tid; idx < 128 * 256; idx += NTHREADS) { const int row = idx >> 8, k = idx & 255, p = row >> 1, c = row & 1, tp = k >> 4, hi = k & 15;
        const f64x2_t z = PC[(dir == 0 ? 15 - tp : tp) * 64 + p]; const double br = b_re[(gi * 64 + p) * 16 + hi], bi = b_im[(gi * 64 + p) * 16 + hi];
        W16[(size_t)(gd * 128 + row) * 256 + k] = f2bf((float)(c == 0 ? z[0] * br - z[1] * bi : z[0] * bi + z[1] * br)); }
    for (int idx = tid; idx < 256 * 128; idx += NTHREADS) { const int row = idx >> 7, k = idx & 127, p = k >> 1, c = k & 1, t = row >> 4, ho = row & 15;
        const f64x2_t z = POW[((dir == 0 ? t : 15 - t) + 1) * 64 + p]; const double cr = c_re[(gi * 16 + ho) * 64 + p], ci = c_im[(gi * 16 + ho) * 64 + p];
        WC[(size_t)(gd * 256 + row) * 128 + k] = f2bf((float)(c == 0 ? cr * z[0] - ci * z[1] : -(cr * z[1] + ci * z[0]))); }
    for (int idx = tid; idx < 4096; idx += NTHREADS) { const int tau = idx >> 8, ho = (idx >> 4) & 15, hi = idx & 15;
        double acc = 0.0;
        for (int p = 0; p < 64; ++p) { const f64x2_t z = PC[tau * 64 + p]; const double cr = c_re[(gi * 16 + ho) * 64 + p], ci = c_im[(gi * 16 + ho) * 64 + p];
            const double ar = cr * z[0] - ci * z[1], ai = cr * z[1] + ci * z[0];
            acc += ar * (double)b_re[(gi * 64 + p) * 16 + hi] - ai * (double)b_im[(gi * 64 + p) * 16 + hi]; }
        KT[(size_t)gd * 4096 + idx] = f2bf((float)acc); }
}

DI int s5_tile_row0(int b, int s) { return s == 0 ? NLAT + b * LC : b * SEQ + (s - 1) * 256; }
DI void cmul(float ar, float ai, float br, float bi, float& cr, float& ci) { cr = ar * br - ai * bi; ci = ar * bi + ai * br; }

DI void s5_scan_unit(int cu, int m, const bf16_t* PROJ, const bf16_t* W16, const float* L16, bf16_t* CARRY0, bf16_t* CARRY1, int lane) {
    const int dir = cu & 1, b = (cu >> 1) & 3, g = cu >> 3;
    const int n = lane & 15, q = lane >> 4;
    bf16x8_t wf[8];
#pragma unroll
    for (int ks = 0; ks < 8; ++ks) wf[ks] = *(const bf16x8_t*)(W16 + ((size_t)(g * 2 + dir) * 128 + m * 16 + n) * 256 + 32 * ks + 8 * q);
    float Lr[2][5], Li[2][5];
    float Lnr[2], Lni[2];
    float cr[2], ci[2];
#pragma unroll
    for (int st = 0; st < 2; ++st) { const int p = 8 * m + 2 * q + st;
        Lr[st][0] = L16[((g * 2 + dir) * 64 + p) * 2]; Li[st][0] = L16[((g * 2 + dir) * 64 + p) * 2 + 1];
#pragma unroll
        for (int k = 1; k < 5; ++k) cmul(Lr[st][k - 1], Li[st][k - 1], Lr[st][k - 1], Li[st][k - 1], Lr[st][k], Li[st][k]);
        float rr = 1.f, ri = 0.f;
#pragma unroll
        for (int k = 0; k < 5; ++k) if ((n + 1) & (1 << k)) { float tr, ti; cmul(rr, ri, Lr[st][k], Li[st][k], tr, ti); rr = tr; ri = ti; }
        Lnr[st] = rr; Lni[st] = ri; cr[st] = 0.f; ci[st] = 0.f; }
    bf16_t* CARRY = (dir == 0 ? CARRY0 : CARRY1) + (size_t)(b * 32 + g) * S5_NCOL * 128;
    const int jcol = dir == 0 ? n : 15 - n;
    bf16x8_t un[8];
    { const bf16_t* ub = PROJ + (size_t)(s5_tile_row0(b, 0) + jcol * 16 + (q >> 1)) * N0 + g * 16 + 8 * (q & 1);
#pragma unroll
      for (int ks = 0; ks < 8; ++ks) un[ks] = *(const bf16x8_t*)(ub + (size_t)(2 * ks) * N0); }
#pragma unroll 1
    for (int it = 0; it < 17; ++it) {
        const int s = it == 0 ? 0 : (dir == 0 ? it : 17 - it);
        bf16x8_t uf[8];
#pragma unroll
        for (int ks = 0; ks < 8; ++ks) uf[ks] = un[ks];
        if (it + 1 < 17) { const int sn = dir == 0 ? it + 1 : 16 - it;
            const bf16_t* ub = PROJ + (size_t)(s5_tile_row0(b, sn) + jcol * 16 + (q >> 1)) * N0 + g * 16 + 8 * (q & 1);
#pragma unroll
            for (int ks = 0; ks < 8; ++ks) un[ks] = *(const bf16x8_t*)(ub + (size_t)(2 * ks) * N0); }
        f32x4_t acc = {0.f, 0.f, 0.f, 0.f};
#pragma unroll
        for (int ks = 0; ks < 8; ++ks) acc = __builtin_amdgcn_mfma_f32_16x16x32_bf16(wf[ks], uf[ks], acc, 0, 0, 0);
        float hin[4];
#pragma unroll
        for (int st = 0; st < 2; ++st) {
            float xr = acc[2 * st], xi = acc[2 * st + 1];
#pragma unroll
            for (int k = 0; k < 4; ++k) { const int d = 1 << k; const float yr = __shfl_up(xr, d, 16), yi = __shfl_up(xi, d, 16);
                if (n >= d) { float tr, ti; cmul(Lr[st][k], Li[st][k], yr, yi, tr, ti); xr += tr; xi += ti; } }
            float tr, ti; cmul(Lnr[st], Lni[st], cr[st], ci[st], tr, ti);
            const float Hr = xr + tr, Hi = xi + ti;
            const float pr = __shfl_up(Hr, 1, 16), pi = __shfl_up(Hi, 1, 16);
            hin[2 * st] = n == 0 ? cr[st] : pr; hin[2 * st + 1] = n == 0 ? ci[st] : pi;
            cr[st] = __shfl(Hr, (lane & 48) | 15); ci[st] = __shfl(Hi, (lane & 48) | 15);
        }
        v2u w; w.x = pk2(hin[0], hin[1]); w.y = pk2(hin[2], hin[3]);
        *(v2u*)(CARRY + (size_t)(s * 16 + jcol) * 128 + m * 16 + 4 * q) = w;
    }
}

DI void s5_out_item(int g, int b, int s, const bf16_t* PROJ, const bf16_t* WC, const bf16_t* CARRY0, const bf16_t* CARRY1, const float* dsk, bf16_t* YPRE, LAS unsigned char* lds, int wave, int lane) {
    const int n = lane & 15, q = lane >> 4;
    const int row0 = s5_tile_row0(b, s);
    const bf16_t* ub = PROJ + (size_t)(row0 + n * 16 + (q >> 1)) * N0 + g * 16 + 8 * (q & 1);
    bf16x8_t uf[8];
#pragma unroll
    for (int ks = 0; ks < 8; ++ks) uf[ks] = *(const bf16x8_t*)(ub + (size_t)(2 * ks) * N0);
    bf16x8_t cf[2][4];
#pragma unroll
    for (int dir = 0; dir < 2; ++dir)
#pragma unroll
        for (int ks = 0; ks < 4; ++ks) cf[dir][ks] = *(const bf16x8_t*)((dir == 0 ? CARRY0 : CARRY1) + ((size_t)(b * 32 + g) * S5_NCOL + s * 16 + n) * 128 + 32 * ks + 8 * q);
    const LAS bf16_t* KTl = (const LAS bf16_t*)lds;
#pragma unroll
    for (int m2 = 0; m2 < 2; ++m2) {
        const int mt = 2 * wave + m2;
        f32x4_t acc = {0.f, 0.f, 0.f, 0.f};
#pragma unroll
        for (int dir = 0; dir < 2; ++dir) {
            const bf16_t* wc = WC + ((size_t)(g * 2 + dir) * 256 + mt * 16 + n) * 128 + 8 * q;
#pragma unroll
            for (int ks = 0; ks < 4; ++ks) { const bf16x8_t a = *(const bf16x8_t*)(wc + 32 * ks); acc = __builtin_amdgcn_mfma_f32_16x16x32_bf16(a, cf[dir][ks], acc, 0, 0, 0); }
#pragma unroll
            for (int ks = 0; ks < 8; ++ks) {
                const bool need = dir == 0 ? (2 * ks <= mt) : (2 * ks + 1 >= mt);
                if (need) { const int tp = 2 * ks + (q >> 1), tau = dir == 0 ? mt - tp : tp - mt;
                    bf16x8_t a = {0, 0, 0, 0, 0, 0, 0, 0};
                    if (tau >= 0) a = *(const LAS bf16x8_t*)(KTl + ((dir * 16 + tau) * 16 + n) * 16 + 8 * (q & 1));
                    acc = __builtin_amdgcn_mfma_f32_16x16x32_bf16(a, uf[ks], acc, 0, 0, 0); }
            }
        }
        const size_t tok = (size_t)(row0 + n * 16 + mt);
        const v2u uu = *(const v2u*)(PROJ + tok * N0 + g * 16 + 4 * q);
        const f32x4_t dd = *(const f32x4_t*)(dsk + g * 16 + 4 * q);
        const float y0 = gelu_fast(acc[0] + dd[0] * bflo(uu.x)), y1 = gelu_fast(acc[1] + dd[1] * bfhi(uu.x)), y2 = gelu_fast(acc[2] + dd[2] * bflo(uu.y)), y3 = gelu_fast(acc[3] + dd[3] * bfhi(uu.y));
        v2u w; w.x = pk2(y0, y1); w.y = pk2(y2, y3);
        *(v2u*)(YPRE + tok * 512 + g * 16 + 4 * q) = w;
    }
}

#include <hip/hip_bf16.h>
namespace gqa_body {
using bf16=__hip_bfloat16;
using bf16x8=__attribute__((ext_vector_type(8)))short;
using s16x4=__attribute__((ext_vector_type(4)))short;
using f32x16=__attribute__((ext_vector_type(16)))float;
using u32x4=__attribute__((ext_vector_type(4)))unsigned;
constexpr int NHEAD=8,SEQQ=4096,SKV=4352,D=64,QPITCH=64,KPITCH=64,VPITCH=64,OPITCH=1024,GPITCH=2304;
constexpr int NW=8,QBLK=32,QB=QBLK*NW,KVBLK=64,NQB=SEQQ/QB,NTILES=SKV/KVBLK;
constexpr int ATTN_UNIT_ROWS=QB;
__device__ __forceinline__ int crow(int r,int hi){return (r&3)+8*(r>>2)+4*hi;}
#define SBAR() __builtin_amdgcn_sched_barrier(0)
constexpr int NSLOT=3, SLOTB=8192;
constexpr int LDS_K=0, LDS_V=NSLOT*SLOTB, LDS_WS=2*NSLOT*SLOTB, LDS_OST=LDS_WS+NW*64*4, LDS_BYTES=LDS_OST+NW*4096;
constexpr float C2=0.125f*1.4426950408889634f;
__device__ __forceinline__ void glds16(const void*gsrc,unsigned lds_dst){unsigned keep;
  asm volatile("s_mov_b32 %0, m0\n\ts_mov_b32 m0, %2\n\ts_nop 0\n\tglobal_load_lds_dwordx4 %1, off\n\ts_mov_b32 m0, %0":"=&s"(keep):"v"(gsrc),"s"(lds_dst):"memory");}
__device__ __forceinline__ float max3f(float a,float b,float c){float r;asm("v_max3_f32 %0, %1, %2, %3":"=v"(r):"v"(a),"v"(b),"v"(c));return r;}
__device__ __forceinline__ float max2f(float a,float b){float r;asm("v_max_f32_e32 %0, %1, %2":"=v"(r):"v"(a),"v"(b));return r;}
__device__ __forceinline__ float fadd_s(float a,float b){float r;asm("v_add_f32_e32 %0, %1, %2":"=v"(r):"v"(a),"v"(b));return r;}
__device__ __forceinline__ float fsub_s(float a,float b){float r;asm("v_sub_f32_e32 %0, %1, %2":"=v"(r):"v"(a),"v"(b));return r;}
typedef float f32x2_t __attribute__((ext_vector_type(2))); typedef __bf16 bf16x2_t __attribute__((ext_vector_type(2)));
__device__ __forceinline__ unsigned cvtpk_s(float lo,float hi){f32x2_t v={lo,hi};bf16x2_t b=__builtin_convertvector(v,bf16x2_t);return __builtin_bit_cast(unsigned,b);}
#define WAIT_BAR(N) asm volatile("s_waitcnt vmcnt(" #N ") lgkmcnt(0)\n\ts_barrier":::"memory")

__device__ __forceinline__ void qkt(f32x16&p0,f32x16&p1,const char*Kslot,const bf16x8*qr,const f32x16&negm,int r32,int hi){
  const char*kb=Kslot+hi*1024+r32*16;
  #pragma unroll
  for(int d0=0;d0<4;++d0){
    const bf16x8 b0=*reinterpret_cast<const bf16x8*>(kb+d0*2048);
    const bf16x8 b1=*reinterpret_cast<const bf16x8*>(kb+d0*2048+512);
    if(d0==0){p0=__builtin_amdgcn_mfma_f32_32x32x16_bf16(b0,qr[0],negm,0,0,0);p1=__builtin_amdgcn_mfma_f32_32x32x16_bf16(b1,qr[0],negm,0,0,0);}
    else{p0=__builtin_amdgcn_mfma_f32_32x32x16_bf16(b0,qr[d0],p0,0,0,0);p1=__builtin_amdgcn_mfma_f32_32x32x16_bf16(b1,qr[d0],p1,0,0,0);}}
}
typedef __attribute__((address_space(3))) const char* lds_cptr;
typedef short v4i16_t __attribute__((ext_vector_type(4)));
__device__ __forceinline__ void kload8(bf16x8*kf,lds_cptr kp){
  kf[0]=*(const __attribute__((address_space(3))) bf16x8*)(kp);      kf[1]=*(const __attribute__((address_space(3))) bf16x8*)(kp+512);
  kf[2]=*(const __attribute__((address_space(3))) bf16x8*)(kp+2048); kf[3]=*(const __attribute__((address_space(3))) bf16x8*)(kp+2560);
  kf[4]=*(const __attribute__((address_space(3))) bf16x8*)(kp+4096); kf[5]=*(const __attribute__((address_space(3))) bf16x8*)(kp+4608);
  kf[6]=*(const __attribute__((address_space(3))) bf16x8*)(kp+6144); kf[7]=*(const __attribute__((address_space(3))) bf16x8*)(kp+6656);
}
__device__ __forceinline__ void kload2(bf16x8*kf,lds_cptr kp,int j){ kf[2*j]=*(const __attribute__((address_space(3))) bf16x8*)(kp+j*2048); kf[2*j+1]=*(const __attribute__((address_space(3))) bf16x8*)(kp+j*2048+512); }
__device__ __forceinline__ s16x4 vtr(lds_cptr p){ return __builtin_bit_cast(s16x4,__builtin_amdgcn_ds_read_tr16_b64_v4i16((__attribute__((address_space(3))) v4i16_t*)p)); }
__device__ __forceinline__ float rowmax(const f32x16&p0,const f32x16&p1){
  float a=max3f(p0[0],p0[1],p1[0]),b=max3f(p0[2],p0[3],p1[1]);a=max3f(a,p1[2],p1[3]);
  #pragma unroll
  for(int r=4;r<16;r+=4){a=max3f(a,p0[r],p0[r+1]);b=max3f(b,p0[r+2],p0[r+3]);a=max3f(a,p1[r],p1[r+1]);b=max3f(b,p1[r+2],p1[r+3]);}
  const float m=max2f(a,b);
  auto rr=__builtin_amdgcn_permlane32_swap(__float_as_uint(m),__float_as_uint(m),false,false);
  return max2f(__uint_as_float(rr[0]),__uint_as_float(rr[1]));
}
__device__ __forceinline__ void pv(f32x16*o,int vb,bf16x8 pa0,bf16x8 pa1,bf16x8 pa2,bf16x8 pa3){
  #pragma unroll
  for(int d0=0;d0<2;++d0){s16x4 lo[4],hi[4];
    #pragma unroll
    for(int ks=0;ks<4;++ks){
      asm volatile("ds_read_b64_tr_b16 %0,%1 offset:%c2":"=&v"(lo[ks]):"v"(vb),"i"(d0*4096+ks*1024):"memory");
      asm volatile("ds_read_b64_tr_b16 %0,%1 offset:%c2":"=&v"(hi[ks]):"v"(vb),"i"(d0*4096+ks*1024+512):"memory");}
    asm volatile("s_waitcnt lgkmcnt(0)":::"memory");SBAR();
    #define PK(k) (bf16x8){lo[k][0],lo[k][1],lo[k][2],lo[k][3],hi[k][0],hi[k][1],hi[k][2],hi[k][3]}
    o[d0]=__builtin_amdgcn_mfma_f32_32x32x16_bf16(pa0,PK(0),o[d0],0,0,0);
    o[d0]=__builtin_amdgcn_mfma_f32_32x32x16_bf16(pa1,PK(1),o[d0],0,0,0);
    o[d0]=__builtin_amdgcn_mfma_f32_32x32x16_bf16(pa2,PK(2),o[d0],0,0,0);
    o[d0]=__builtin_amdgcn_mfma_f32_32x32x16_bf16(pa3,PK(3),o[d0],0,0,0);
    #undef PK
  }
}

#ifndef ATTN_STORE16
#define ATTN_STORE16(p,v) (*(u32x4*)(p)=(v))
#endif
template<int THRL> __device__ __forceinline__ void attn_unit(int b,int h,int qb,const bf16*Q,const bf16*__restrict__ K,const bf16*__restrict__ V,bf16*O,const bf16*Gt,char*shm){
  const int tid=threadIdx.x,lane=tid&63,r32=lane&31,hi=lane>>5; const int wid=__builtin_amdgcn_readfirstlane(tid>>6);
  const int q0=qb*QB;
  const bf16*Qw=Q+((long)(b*NHEAD+h)*SEQQ+q0+wid*QBLK)*QPITCH;
  const bf16*Kh=K+(long)(b*2+(h>>2))*SKV*KPITCH,*Vh=V+(long)(b*2+(h>>2))*SKV*VPITCH;
  const unsigned lds0=(unsigned)(uintptr_t)shm;
  float*wsf=(float*)(shm+LDS_WS)+wid*64;
  const bf16*ksrc=Kh+(long)lane*KPITCH+wid*8;
  const bf16*vsrc=Vh+(long)(16*(wid&3)+(lane>>2))*VPITCH+(wid>>2)*32+(lane&3)*8;
  const unsigned kdst=lds0+LDS_K+wid*1024, vdst=lds0+LDS_V+wid*1024;
  #define DMA_K(t,slot) glds16(ksrc+(long)(t)*KVBLK*KPITCH,(unsigned)__builtin_amdgcn_readfirstlane(kdst+(slot)))
  #define DMA_V(t,slot) glds16(vsrc+(long)(t)*KVBLK*VPITCH,(unsigned)__builtin_amdgcn_readfirstlane(vdst+(slot)))
  const int vb0=(int)(lds0+LDS_V)+((lane>>4)&1)*32+(lane&3)*8+(4*hi+((lane&15)>>2))*64;
  const char*Kbase=shm+LDS_K; bf16x8 kf[8];
  const lds_cptr shm3=(lds_cptr)shm; const lds_cptr kp0=shm3+LDS_K+hi*1024+r32*16; const lds_cptr vp0=shm3+LDS_V+((lane>>4)&1)*32+(lane&3)*8+(4*hi+((lane&15)>>2))*64;
  constexpr int NT=NTILES;
  DMA_K(0,0);DMA_V(0,0);DMA_K(1,SLOTB);
  bf16x8 qr[4];
  #pragma unroll
  for(int d0=0;d0<4;++d0)qr[d0]=*reinterpret_cast<const bf16x8*>(&Qw[(long)r32*QPITCH+d0*16+hi*8]);
  float mhat=0.f,l_reg=0.f;f32x16 o[2];o[0]=f32x16{};o[1]=f32x16{};f32x16 negm=f32x16{};asm volatile("":"+v"(negm));
  #define CMASK(P0,P1,t) do{}while(0)
  bool resc=false;
  #define START(P0,P1) do{ const float rm=rowmax(P0,P1); resc=false; \
    { const float dl=rm; mhat=fadd_s(mhat,dl); \
      _Pragma("unroll") for(int r=0;r<16;++r){P0[r]=fsub_s(P0[r],dl);P1[r]=fsub_s(P1[r],dl);} \
      _Pragma("unroll") for(int r=0;r<16;++r)negm[r]=-mhat; asm volatile("":"+v"(negm)); } \
    _Pragma("unroll") for(int r=0;r<16;++r)P0[r]=__builtin_amdgcn_exp2f(P0[r]); }while(0)
  #define RESC() do{ if(resc){ asm volatile("s_waitcnt lgkmcnt(0)":::"memory"); \
      _Pragma("unroll") for(int d_=0;d_<2;++d_) _Pragma("unroll") for(int r=0;r<16;++r)o[d_][r]*=wsf[crow(r,hi)]; } }while(0)
  f32x16 pA0,pA1,pB0,pB1;
  int sl_prev=0,sl_cur=0,sl_next=SLOTB;
  #define ROT() do{sl_prev=sl_cur;sl_cur=sl_next;sl_next=(sl_next==(NSLOT-1)*SLOTB)?0:sl_next+SLOTB;}while(0)
  DMA_K(2,2*SLOTB);
  WAIT_BAR(3);
  qkt(pA0,pA1,Kbase,qr,negm,r32,hi);asm volatile("s_nop 15\n\ts_nop 7":"+v"(pA0),"+v"(pA1));CMASK(pA0,pA1,0);
  START(pA0,pA1);
  _Pragma("unroll") for(int r=0;r<16;++r)pA1[r]=__builtin_amdgcn_exp2f(pA1[r]);
  WAIT_BAR(0);
  DMA_K(3,0);DMA_V(1,SLOTB);
  ROT();
  kload8(kf,kp0+sl_cur);
  WAIT_BAR(2);
  s16x4 vlo[8],vhi[8]; u32x4 pw0,pw1,pw2,pw3;
  #define PKW(P,B) cvtpk_s(P[B],P[B+1])
  #define PAF(k) __builtin_bit_cast(bf16x8,pw##k)
  #define VFR(i) (bf16x8){vlo[i][0],vlo[i][1],vlo[i][2],vlo[i][3],vhi[i][0],vhi[i][1],vhi[i][2],vhi[i][3]}
  #define PIN(x) asm volatile("":"+v"(x))
  #define MX3(a,b,c) __builtin_fmaxf(__builtin_fmaxf((a),(b)),(c))
  #define GAPA(MF,A0,A1,A2,A3,W0,W1,PW) do{ MF; sacc+=A0; sacc+=A1; sacc+=A2; sacc+=A3; PIN(sacc); W0; W1; PIN(PW); SBAR(); }while(0)
  #define EX(v) __builtin_amdgcn_exp2f(v)
  #define GAPB(MF,X,B) do{ MF; X[B]=EX(X[B]); X[B+1]=EX(X[B+1]); X[B+2]=EX(X[B+2]); X[B+3]=EX(X[B+3]); PIN(X); SBAR(); }while(0)
  #define VRD(i) do{ vlo[i]=vtr(vp_+(((i)>>2)*4096+((i)&3)*1024)); vhi[i]=vtr(vp_+(((i)>>2)*4096+((i)&3)*1024+512)); }while(0)
  #define KRD(G,j) do{ if(G){ kload2(kf,kp0+sl_next,j); SBAR(); } }while(0)
  #define STEP(C0,C1,P0,P1,t,GK,GV,GL) do{ SBAR(); \
    const lds_cptr vp_=vp0+sl_prev; \
    VRD(0); SBAR(); float sacc=(P0[0]+P0[1]); \
    GAPA(C0=__builtin_amdgcn_mfma_f32_32x32x16_bf16(kf[0],qr[0],negm,0,0,0), P0[2],P0[3],P0[4],P0[5],     pw0[0]=PKW(P0,0), pw0[1]=PKW(P0,2), pw0); \
    VRD(4); SBAR(); GAPA(C1=__builtin_amdgcn_mfma_f32_32x32x16_bf16(kf[1],qr[0],negm,0,0,0), P0[6],P0[7],P0[8],P0[9],     pw0[2]=PKW(P0,4), pw0[3]=PKW(P0,6), pw0); \
    VRD(1); SBAR(); GAPA(C0=__builtin_amdgcn_mfma_f32_32x32x16_bf16(kf[2],qr[1],C0,0,0,0),   P0[10],P0[11],P0[12],P0[13], pw1[0]=PKW(P0,8), pw1[1]=PKW(P0,10), pw1); \
    VRD(5); SBAR(); GAPA(C1=__builtin_amdgcn_mfma_f32_32x32x16_bf16(kf[3],qr[1],C1,0,0,0),   P0[14],P0[15],P1[0],P1[1],   pw1[2]=PKW(P0,12),pw1[3]=PKW(P0,14), pw1); \
    VRD(2); SBAR(); GAPA(C0=__builtin_amdgcn_mfma_f32_32x32x16_bf16(kf[4],qr[2],C0,0,0,0),   P1[2],P1[3],P1[4],P1[5],     pw2[0]=PKW(P1,0), pw2[1]=PKW(P1,2), pw2); \
    VRD(6); SBAR(); GAPA(C1=__builtin_amdgcn_mfma_f32_32x32x16_bf16(kf[5],qr[2],C1,0,0,0),   P1[6],P1[7],P1[8],P1[9],     pw2[2]=PKW(P1,4), pw2[3]=PKW(P1,6), pw2); \
    VRD(3); SBAR(); GAPA(C0=__builtin_amdgcn_mfma_f32_32x32x16_bf16(kf[6],qr[3],C0,0,0,0),   P1[10],P1[11],P1[12],P1[13], pw3[0]=PKW(P1,8), pw3[1]=PKW(P1,10), pw3); \
    VRD(7); SBAR(); GAPA(C1=__builtin_amdgcn_mfma_f32_32x32x16_bf16(kf[7],qr[3],C1,0,0,0),   P1[14],P1[15],0.f,0.f,       pw3[2]=PKW(P1,12),pw3[3]=PKW(P1,14), pw3); \
    l_reg+=sacc; \
    if(GK){DMA_K((t)+3,sl_cur);} if(GV){DMA_V((t)+1,sl_next);} \
    CMASK(C0,C1,t); \
    { float a=MX3(C0[0],C0[1],C1[0]),b=MX3(C0[2],C0[3],C1[1]); a=MX3(a,C1[2],C1[3]); \
      _Pragma("unroll") for(int r=4;r<16;r+=4){a=MX3(a,C0[r],C0[r+1]);b=MX3(b,C0[r+2],C0[r+3]);a=MX3(a,C1[r],C1[r+1]);b=MX3(b,C1[r+2],C1[r+3]);} \
      float rm=__builtin_fmaxf(a,b); { auto rr=__builtin_amdgcn_permlane32_swap(__float_as_uint(rm),__float_as_uint(rm),false,false); rm=__builtin_fmaxf(__uint_as_float(rr[0]),__uint_as_float(rr[1])); } \
      resc=false; \
      if(__builtin_expect(__any(rm>(float)THRL),0)){ const float dl=__builtin_fmaxf(rm,0.f); mhat+=dl; \
        _Pragma("unroll") for(int r=0;r<16;++r){C0[r]-=dl;C1[r]-=dl;} \
        _Pragma("unroll") for(int r=0;r<16;++r)negm[r]=-mhat; asm volatile("":"+v"(negm)); \
        const float f=__builtin_amdgcn_exp2f(-dl); l_reg*=f; if(hi==0)wsf[r32]=f; resc=true; } } \
    SBAR(); \
    GAPB(o[0]=__builtin_amdgcn_mfma_f32_32x32x16_bf16(PAF(0),VFR(0),o[0],0,0,0), C0,0); \
    GAPB(o[1]=__builtin_amdgcn_mfma_f32_32x32x16_bf16(PAF(0),VFR(4),o[1],0,0,0), C0,4); \
    KRD(GL,0); GAPB(o[0]=__builtin_amdgcn_mfma_f32_32x32x16_bf16(PAF(1),VFR(1),o[0],0,0,0), C0,8); \
    KRD(GL,1); GAPB(o[1]=__builtin_amdgcn_mfma_f32_32x32x16_bf16(PAF(1),VFR(5),o[1],0,0,0), C0,12); \
    KRD(GL,2); GAPB(o[0]=__builtin_amdgcn_mfma_f32_32x32x16_bf16(PAF(2),VFR(2),o[0],0,0,0), C1,0); \
    KRD(GL,3); GAPB(o[1]=__builtin_amdgcn_mfma_f32_32x32x16_bf16(PAF(2),VFR(6),o[1],0,0,0), C1,4); \
    GAPB(o[0]=__builtin_amdgcn_mfma_f32_32x32x16_bf16(PAF(3),VFR(3),o[0],0,0,0), C1,8); \
    GAPB(o[1]=__builtin_amdgcn_mfma_f32_32x32x16_bf16(PAF(3),VFR(7),o[1],0,0,0), C1,12); \
    }while(0)
  int t=1;
  #undef CMASK
  #define CMASK(P0,P1,t) do{}while(0)
  for(;t+5<NT;t+=2){
    STEP(pB0,pB1,pA0,pA1,t,true,true,true);     WAIT_BAR(2); RESC(); ROT();
    STEP(pA0,pA1,pB0,pB1,t+1,true,true,true);   WAIT_BAR(2); RESC(); ROT();
  }
  #undef CMASK
  #define CMASK(P0,P1,t) do{}while(0)
  #define ENDW(tt) do{ if((tt)+3<NT){WAIT_BAR(2);} else if((tt)+2<NT){WAIT_BAR(1);} else {WAIT_BAR(0);} }while(0)
  for(;t+1<NT;t+=2){
    STEP(pB0,pB1,pA0,pA1,t,(t+3<NT),(t+1<NT),(t+1<NT));       ENDW(t);   RESC(); ROT();
    STEP(pA0,pA1,pB0,pB1,t+1,(t+4<NT),(t+2<NT),(t+2<NT));     ENDW(t+1); RESC(); ROT();
  }
  STEP(pB0,pB1,pA0,pA1,NT-1,false,false,false); RESC();
  { float sacc=pB0[0]+pB0[1]; _Pragma("unroll") for(int r=2;r<16;++r)sacc+=pB0[r]; _Pragma("unroll") for(int r=0;r<16;++r)sacc+=pB1[r]; l_reg+=sacc;
    pw0=(u32x4){PKW(pB0,0),PKW(pB0,2),PKW(pB0,4),PKW(pB0,6)};pw1=(u32x4){PKW(pB0,8),PKW(pB0,10),PKW(pB0,12),PKW(pB0,14)};pw2=(u32x4){PKW(pB1,0),PKW(pB1,2),PKW(pB1,4),PKW(pB1,6)};pw3=(u32x4){PKW(pB1,8),PKW(pB1,10),PKW(pB1,12),PKW(pB1,14)};
    SBAR(); pv(o,vb0+sl_cur,PAF(0),PAF(1),PAF(2),PAF(3)); }
  #undef PKW
  #undef PAF
  #undef VFR
  #undef PIN
  #undef MX3
  #undef GAPA
  #undef GAPB
  #undef EX
  #undef VRD
  #undef KRD
  #undef STEP
  #undef ENDW
  {auto rr=__builtin_amdgcn_permlane32_swap(__float_as_uint(l_reg),__float_as_uint(l_reg),false,false);l_reg=__uint_as_float(rr[0])+__uint_as_float(rr[1]);}
  if(hi==0)wsf[32+r32]=l_reg;asm volatile("s_waitcnt lgkmcnt(0)":::"memory");
  float rli[16];
  #pragma unroll
  for(int r=0;r<16;++r)rli[r]=__builtin_amdgcn_rcpf(wsf[32+crow(r,hi)]);
  bf16*Ow=O+((long)b*SEQQ+q0+wid*QBLK)*OPITCH+h*D; const bf16*Gw=Gt+((long)b*SEQQ+q0+wid*QBLK)*GPITCH+h*D;
  { bf16*stg=(bf16*)(shm+LDS_OST)+wid*2048;
    #pragma unroll
    for(int r=0;r<16;++r){const int orow=crow(r,hi);
      #pragma unroll
      for(int d0=0;d0<2;++d0)stg[orow*64+d0*32+r32]=__float2bfloat16(o[d0][r]*rli[r]);}
    asm volatile("s_waitcnt lgkmcnt(0)":::"memory");
    #pragma unroll
    for(int i=0;i<4;++i){const int row=i*8+(lane>>3),ch=lane&7; const u32x4 v=*(const u32x4*)(stg+row*64+ch*8); const u32x4 gv=*(const u32x4*)(Gw+(long)row*GPITCH+ch*8); u32x4 w;
      w.x=pk2(bflo(v.x)*silu_f(bflo(gv.x)),bfhi(v.x)*silu_f(bfhi(gv.x))); w.y=pk2(bflo(v.y)*silu_f(bflo(gv.y)),bfhi(v.y)*silu_f(bfhi(gv.y)));
      w.z=pk2(bflo(v.z)*silu_f(bflo(gv.z)),bfhi(v.z)*silu_f(bfhi(gv.z))); w.w=pk2(bflo(v.w)*silu_f(bflo(gv.w)),bfhi(v.w)*silu_f(bfhi(gv.w)));
      ATTN_STORE16(Ow+(long)row*OPITCH+ch*8,w);} }
  asm volatile("s_waitcnt lgkmcnt(0)\n\ts_barrier":::"memory");
  #undef DMA_K
  #undef DMA_V
  #undef CMASK
  #undef START
  #undef RESC
  #undef ROT
}
constexpr int ATTN_LDS_BYTES=LDS_BYTES;
#undef SBAR
#undef WAIT_BAR
}

typedef short v4i16_t __attribute__((ext_vector_type(4)));
DI s16x4_t vtr16(const LAS unsigned char* p) { return __builtin_bit_cast(s16x4_t, __builtin_amdgcn_ds_read_tr16_b64_v4i16((LAS v4i16_t*)p)); }

struct NaState { f32x16_t o0, o1; float m, l; };
template <bool MASK> DI void na_tile(NaState& st, const bf16x8_t (&qf)[4], const LAS unsigned char* Kb, const LAS unsigned char* Vb, int koff, int lane,
                                     int kr, int qr, int qc, int rsq, int csq, const LAS float* BIAS) {
    const int ql = lane & 31, hf = lane >> 5, row = koff + ql;
    f32x16_t sc = {};
#pragma unroll
    for (int ks = 0; ks < 4; ++ks) { const bf16x8_t kf = *(const LAS bf16x8_t*)(Kb + row * 128 + (((2 * ks + hf) ^ (row & 7)) << 4)); sc = __builtin_amdgcn_mfma_f32_32x32x16_bf16(kf, qf[ks], sc, 0, 0, 0); }
    const LAS unsigned char* vp = Vb + ((lane >> 4) & 1) * 32 + (lane & 3) * 8 + (koff + 4 * hf + ((lane & 15) >> 2)) * 64;
    s16x4_t vl[2][2], vh[2][2];
#pragma unroll
    for (int dt = 0; dt < 2; ++dt)
#pragma unroll
        for (int s = 0; s < 2; ++s) { vl[dt][s] = vtr16(vp + dt * 4096 + s * 1024); vh[dt][s] = vtr16(vp + dt * 4096 + s * 1024 + 512); }
    float xs[16];
    if (MASK) {
        const bool row_ok = (kr >= rsq) && (kr < rsq + 8);
        const LAS float* rb = BIAS + (kr - qr + 7) * 31 + (15 - qc);
#pragma unroll
        for (int r = 0; r < 16; ++r) { const int kc = koff + crow16(r, hf); const bool ok = row_ok && (kc >= csq) && (kc < csq + 16);
            const float bias = ok ? rb[kc] : 0.f; xs[r] = ok ? (sc[r] * 0.125f + bias) * LOG2E : -1e30f; }
    } else {
#pragma unroll
        for (int r = 0; r < 16; ++r) xs[r] = sc[r] * (0.125f * LOG2E);
    }
    float tm = xs[0];
#pragma unroll
    for (int r = 1; r < 16; ++r) tm = fmaxf(tm, xs[r]);
    tm = fmaxf(tm, __shfl_xor(tm, 32));
    const float mn = fmaxf(st.m, tm), al = __builtin_amdgcn_exp2f(st.m - mn);
    float ps = 0.f;
#pragma unroll
    for (int r = 0; r < 16; ++r) { xs[r] = __builtin_amdgcn_exp2f(xs[r] - mn); ps += xs[r]; }
    st.l = st.l * al + ps; st.m = mn;
#pragma unroll
    for (int r = 0; r < 16; ++r) { st.o0[r] *= al; st.o1[r] *= al; }
#pragma unroll
    for (int s = 0; s < 2; ++s) { v4u w; w.x = cvtpk(xs[8 * s], xs[8 * s + 1]); w.y = cvtpk(xs[8 * s + 2], xs[8 * s + 3]); w.z = cvtpk(xs[8 * s + 4], xs[8 * s + 5]); w.w = cvtpk(xs[8 * s + 6], xs[8 * s + 7]);
        const bf16x8_t pf = __builtin_bit_cast(bf16x8_t, w);
        const bf16x8_t a0 = __builtin_shufflevector(vl[0][s], vh[0][s], 0, 1, 2, 3, 4, 5, 6, 7), a1 = __builtin_shufflevector(vl[1][s], vh[1][s], 0, 1, 2, 3, 4, 5, 6, 7);
        st.o0 = __builtin_amdgcn_mfma_f32_32x32x16_bf16(a0, pf, st.o0, 0, 0, 0);
        st.o1 = __builtin_amdgcn_mfma_f32_32x32x16_bf16(a1, pf, st.o1, 0, 0, 0); }
}

constexpr int NA_BLOCK_UNITS = 512 + 32;
DI void na_block_unit(int unit, const bf16_t* PROJ, const float* relb, bf16_t* YMIX, LAS unsigned char* lds, int tid, int wave, int lane) {
    LAS unsigned char* KB = lds; LAS unsigned char* VB = lds + 16384; LAS float* BIAS = (LAS float*)(lds + 32768);
    const bool lat = unit < 512;
    int b, h, R = 0;
    if (lat) { R = unit & 15; h = (unit >> 4) & 7; b = unit >> 7; } else { const int u = unit - 512; h = u & 7; b = u >> 3; }
    const int ql = lane & 31, hf = lane >> 5;
    int qrow, qr = 0, qc = 0, rsq = 0, csq = 0, c0 = 0, rlo = 0, rhi = 0, rsA = 0, nsteps = 4;
    if (lat) { const int rp = 2 * R + (wave >> 2), ci = wave & 3; qr = 2 * rp + (ql >> 4); qc = 16 * ci + (ql & 15); qrow = b * SEQ + qr * 64 + qc;
        rsq = min(max(qr - 4, 0), 56); csq = min(max(qc - 8, 0), 48); c0 = min(max(16 * ci - 8, 0), 32);
        rlo = min(max(2 * rp - 4, 0), 56); rhi = min(max(2 * rp - 3, 0), 56) + 8;
        rsA = min(max(4 * R - 4, 0), 56); const int rsB = min(max(4 * R - 1, 0), 56); nsteps = 4 + (rsB + 8 - rsA);
    } else qrow = NLAT + b * LC + 32 * wave + ql;
    __syncthreads();
    if (lat) for (int e = tid; e < 465; e += NTHREADS) BIAS[e] = relb[h * 465 + e];
    bf16x8_t qf[4];
    { const bf16_t* qp = PROJ + (size_t)qrow * N0 + 1024 + h * 64 + 8 * hf;
#pragma unroll
      for (int ks = 0; ks < 4; ++ks) qf[ks] = *(const bf16x8_t*)(qp + 16 * ks); }
    NaState st; st.o0 = (f32x16_t){}; st.o1 = (f32x16_t){}; st.m = -1e30f; st.l = 0.f;
    const int srow = tid >> 3, sch = tid & 7;
    const int kdst = srow * 128 + ((sch ^ (srow & 7)) << 4), vdst = (sch >> 2) * 4096 + srow * 64 + (sch & 3) * 16;
    auto step_row0 = [&](int s) -> int { return s < 4 ? NLAT + b * LC + 64 * s : b * SEQ + (rsA + s - 4) * 64; };
    v4u kreg, vreg;
    { const bf16_t* src = PROJ + (size_t)(step_row0(0) + srow) * N0 + h * 64 + sch * 8; kreg = *(const v4u*)(src + 1536); vreg = *(const v4u*)(src + 2048); }
#pragma unroll 1
    for (int s = 0; s < nsteps; ++s) {
        LAS unsigned char* kb = KB + (s & 1) * 8192; LAS unsigned char* vb = VB + (s & 1) * 8192;
        *(LAS v4u*)(kb + kdst) = kreg; *(LAS v4u*)(vb + vdst) = vreg;
        __syncthreads();
        if (s + 1 < nsteps) { const bf16_t* src = PROJ + (size_t)(step_row0(s + 1) + srow) * N0 + h * 64 + sch * 8; kreg = *(const v4u*)(src + 1536); vreg = *(const v4u*)(src + 2048); }
        if (s < 4) { na_tile<false>(st, qf, kb, vb, 0, lane, 0, 0, 0, 0, 0, BIAS); na_tile<false>(st, qf, kb, vb, 32, lane, 0, 0, 0, 0, 0, BIAS); }
        else { const int kr = rsA + s - 4; if (kr >= rlo && kr < rhi) na_tile<true>(st, qf, kb, vb, c0, lane, kr, qr, qc, rsq, csq, BIAS); }
    }
    st.l += __shfl_xor(st.l, 32);
    const float rl = 1.f / st.l;
    const bf16_t* gp = PROJ + (size_t)qrow * N0 + 2560 + h * 64; bf16_t* yp = YMIX + (size_t)qrow * DM + 512 + h * 64;
#pragma unroll
    for (int dt = 0; dt < 2; ++dt)
#pragma unroll
        for (int rg = 0; rg < 4; ++rg) { const int d = 32 * dt + 8 * rg + 4 * hf;
            const v2u gv = *(const v2u*)(gp + d);
            const float g0 = silu_f(bflo(gv.x)), g1 = silu_f(bfhi(gv.x)), g2 = silu_f(bflo(gv.y)), g3 = silu_f(bfhi(gv.y));
            const f32x16_t& oo = dt ? st.o1 : st.o0;
            v2u w; w.x = pk2(oo[4 * rg] * rl * g0, oo[4 * rg + 1] * rl * g1); w.y = pk2(oo[4 * rg + 2] * rl * g2, oo[4 * rg + 3] * rl * g3);
            *(v2u*)(yp + d) = w; }
}

struct Args { const float* in[32]; float* out; unsigned char* ws; int ph_lo, ph_hi, li, pad; };
DI void phase3(const Args& args, LAS unsigned char* lds, int tid, int wave, int lane, int G, int pass) {
    unsigned char* ws = args.ws;
    for (int cu = blockIdx.x; cu < 256; cu += G)
        s5_scan_unit(cu, wave, (const bf16_t*)(ws + WS_PROJ), (const bf16_t*)(ws + WS_W16), (const float*)(ws + WS_L16), (bf16_t*)(ws + WS_CARRY0), (bf16_t*)(ws + WS_CARRY1), lane);
    for (int u = blockIdx.x; u < NA_BLOCK_UNITS; u += G) na_block_unit(u, (const bf16_t*)(ws + WS_PROJ), args.in[20], (bf16_t*)(ws + WS_YMIX), lds, tid, wave, lane);
}
DI void phase4(const Args& args, LAS unsigned char* lds, int tid, int wave, int lane, int G) {
    unsigned char* ws = args.ws;
    constexpr int NIT = 32 * 4 * 17;
    const int i0 = (int)(((long)blockIdx.x * NIT) / G), i1 = (int)(((long)(blockIdx.x + 1) * NIT) / G);
    int gcur = -1;
    for (int it = i0; it < i1; ++it) {
        const int g = it / 68, b = (it % 68) / 17, s = it % 17;
        if (g != gcur) { __syncthreads(); for (int e = tid; e < 1024; e += NTHREADS) ((LAS v4u*)lds)[e] = ((const v4u*)(ws + WS_KT))[(size_t)g * 1024 + e]; gcur = g; __syncthreads(); }
        s5_out_item(g, b, s, (const bf16_t*)(ws + WS_PROJ), (const bf16_t*)(ws + WS_WC), (const bf16_t*)(ws + WS_CARRY0), (const bf16_t*)(ws + WS_CARRY1), args.in[17], (bf16_t*)(ws + WS_YPRE), lds, wave, lane);
    }
}
DI LruP make_lrup(const Args& args) { unsigned char* ws = args.ws;
    return LruP{(const bf16_t*)(ws + WS_PROJ), args.in[23], args.in[24], args.in[25], args.in[27], args.in[29], (const bf16_t*)(ws + WS_LRUWT), (f32x2_t*)(ws + WS_LSUM), (bf16_t*)(ws + WS_YMIX)}; }
DI void phase9(const Args& args, LAS unsigned char* lds, int tid, int wave, int lane, int G) {
    unsigned char* ws = args.ws; const LruP lp = make_lrup(args);
    for (int it = blockIdx.x; it < NB * LRU_NCH * 8; it += G) lru_item<false>(it, lp, lds, tid, wave, lane);
    const int gw = blockIdx.x * NWAVES + wave, NGW = G * NWAVES;
    for (int r = gw; r < MROWS; r += NGW) qkprep_row(r, (const bf16_t*)(ws + WS_PROJ), args.in[30], args.in[31], (const float*)(ws + WS_ROPE), (bf16_t*)(ws + WS_QP), (bf16_t*)(ws + WS_KP), lane);
}
DI void phase10(const Args& args, LAS unsigned char* lds, int tid, int wave, int lane, int G) {
    unsigned char* ws = args.ws;
    const LruP lp = make_lrup(args);
    for (int it = blockIdx.x; it < NB * 32 * 8; it += G) lru_item<true>(it, lp, lds, tid, wave, lane);
    __syncthreads();
    const int bx = blockIdx.x, vcu = (G % 8 == 0) ? (bx % 8) * (G / 8) + bx / 8 : bx;
    typedef gqa_body::bf16 abf;
    for (int u = vcu; u < 512; u += G) {
        const int qb = u & 15, hq = (u >> 4) & 7, b = u >> 7;
        gqa_body::attn_unit<8>(b, hq, qb, (const abf*)(ws + WS_QP), (const abf*)(ws + WS_KP), (const abf*)(ws + WS_VT1), (abf*)(ws + WS_YMIX) + 512, (const abf*)(ws + WS_PROJ) + 1792, (char*)lds);
    }
}

constexpr int RING_BYTES = 131072, LDSCTL_OFF = RING_BYTES, MISC_OFF = LDSCTL_OFF + 320, LDS_BYTES = 147456;
constexpr int CW_BAR = 4096;
constexpr int N_PHASES = 13;
constexpr bool kSP2 = true, kALIGN = true;

DI void p0_adaln(LAS unsigned char* lds, const float* c, const float* cctx, const float* ada_w, const float* ada_b, float* MOD, int tid, int wave, int lane, int G) {
    LAS float* sl = (LAS float*)lds;
    LAS float* red = (LAS float*)(lds + 5 * 1024 * 4);
    if ((int)blockIdx.x >= 192) return;
    for (int e = tid; e < 5 * 1024; e += NTHREADS) { const int r = e >> 10, k = e & 1023; const float x = r < 4 ? c[r * 1024 + k] : cctx[k]; sl[e] = silu_f(x); }
    __syncthreads();
    for (int item = blockIdx.x; item < 192; item += G) {
        const int i = item / 96, cb = item % 96, col = cb * 32 + (lane & 31), kh = lane >> 5;
        const float* W = ada_w + (size_t)i * 1024 * 3072 + col;
        float acc[5] = {0.f, 0.f, 0.f, 0.f, 0.f};
#pragma unroll 8
        for (int kk = 0; kk < 64; ++kk) { const int k = wave * 128 + 2 * kk + kh; const float w = W[(size_t)k * 3072];
#pragma unroll
            for (int r = 0; r < 5; ++r) acc[r] += sl[r * 1024 + k] * w; }
#pragma unroll
        for (int r = 0; r < 5; ++r) { acc[r] += __shfl_xor(acc[r], 32); if (lane < 32) red[(wave * 5 + r) * 32 + lane] = acc[r]; }
        __syncthreads();
        if (tid < 160) { const int r = tid >> 5, cl = tid & 31; float s = ada_b[i * 3072 + cb * 32 + cl];
#pragma unroll
            for (int w = 0; w < 8; ++w) s += red[(w * 5 + r) * 32 + cl];
            MOD[(i * 5 + r) * 3072 + cb * 32 + cl] = s; }
        __syncthreads();
    }
}
DI void p0_transpose_item(const float* W, int K, int N, bf16_t* WT, int row_off, LAS float* scr, int item, int lane) {
    const int nblk = N / 32, kb = item / nblk, nb = item % nblk, k0 = 64 * kb, n0 = 32 * nb;
#pragma unroll 8
    for (int i = 0; i < 32; ++i) { const int kk = 2 * i + (lane >> 5); scr[kk * 33 + (lane & 31)] = W[(size_t)(k0 + kk) * N + n0 + (lane & 31)]; }
    LDS_WAIT(); asm volatile("" ::: "memory");
    const int c = lane & 7;
#pragma unroll
    for (int j = 0; j < 4; ++j) { const int n = (lane >> 3) + 8 * j; const LAS float* s = scr + (8 * c) * 33 + n;
        v4u o; o.x = pk2(s[0 * 33], s[1 * 33]); o.y = pk2(s[2 * 33], s[3 * 33]); o.z = pk2(s[4 * 33], s[5 * 33]); o.w = pk2(s[6 * 33], s[7 * 33]);
        *(v4u*)(WT + (size_t)(row_off + n0 + n) * K + k0 + 8 * c) = o; }
    LDS_WAIT(); asm volatile("" ::: "memory");
}
struct TrJob { const float* W; int K, N; bf16_t* WT; int row_off; int items; };

DI void load_row16(const float* src, int lane, float (&v)[16]) {
#pragma unroll
    for (int j = 0; j < 4; ++j) { const f32x4_t t = *(const f32x4_t*)(src + j * 256 + lane * 4); v[4 * j] = t[0]; v[4 * j + 1] = t[1]; v[4 * j + 2] = t[2]; v[4 * j + 3] = t[3]; }
}
DI float row_rinv(const float (&v)[16]) {
    float ss = 0.f;
#pragma unroll
    for (int j = 0; j < 16; ++j) ss += v[j] * v[j];
    ss = wave_sum(ss);
    return rsqrtf(ss * (1.f / DM) + EPSN);
}
DI void store_modnorm(const float (&v)[16], float rinv, const float* g, const float* m, bf16_t* dst, int lane) {
#pragma unroll
    for (int j = 0; j < 4; ++j) { const int col = j * 256 + lane * 4;
        const f32x4_t gg = *(const f32x4_t*)(g + col), sc = *(const f32x4_t*)(m + 1024 + col), sh = *(const f32x4_t*)(m + col);
        float y[4];
#pragma unroll
        for (int e = 0; e < 4; ++e) y[e] = v[4 * j + e] * rinv * gg[e] * (1.f + sc[e]) + sh[e];
        v2u o; o.x = pk2(y[0], y[1]); o.y = pk2(y[2], y[3]); *(v2u*)(dst + col) = o; }
}

__global__ void __launch_bounds__(NTHREADS, 2) mega(Args args) {
    extern __shared__ __attribute__((aligned(16))) unsigned char lds_raw[];
    LAS unsigned char* lds = (LAS unsigned char*)lds_raw;
    volatile LAS unsigned* MISC = (volatile LAS unsigned*)(lds + MISC_OFF);
    const int tid = threadIdx.x, lane = tid & 63, wave = __builtin_amdgcn_readfirstlane(tid >> 6);
    const int G = gridDim.x;
    unsigned char* ws = args.ws;
    gu32* ctl = (gu32*)(ws + WS_CTL);
    for (int u = tid; u < (LDS_BYTES - LDSCTL_OFF) / 4; u += NTHREADS) ((LAS unsigned*)(lds + LDSCTL_OFF))[u] = 0u;
    __syncthreads();
    XcdBarrier bar = xcd_barrier_post((unsigned*)(ctl + CW_BAR) + args.li * XCD_BAR_WORDS, MISC + 8);
    const int lo = args.ph_lo, hi = args.ph_hi;
#define IN(k) (lo <= (k) && (k) < hi)
#ifndef PROBE_REP
#define PROBE_REP 0
#endif
#define PHASE_LOOP(k) for (int rep_ = 0, nrep_ = IN(k) ? 1 + ((PROBE_REP >> (k)) & 1) : 0; rep_ < nrep_; (++rep_ < nrep_) ? xcd_barrier(bar) : (void)0)
#define SEAM(k) do { if (IN(k) && IN((k) + 1)) xcd_barrier(bar); } while (0)

    const float* x = args.in[0]; const float* cvec = args.in[1]; const float* ctxin = args.in[2]; const float* cctx = args.in[3];
    const float* ada_w = args.in[4]; const float* ada_b = args.in[5]; const float* pre_g = args.in[6]; const float* post_g = args.in[7];
    float* out = args.out;
    float* MOD = (float*)(ws + WS_MOD);
    bf16_t* XN = (bf16_t*)(ws + WS_XN); bf16_t* YMIX = (bf16_t*)(ws + WS_YMIX); bf16_t* PROJ = (bf16_t*)(ws + WS_PROJ); float* OUTF = (float*)(ws + WS_PROJ);
    bf16_t* YPRE = (bf16_t*)(ws + WS_YPRE);
    const int gw = blockIdx.x * NWAVES + wave, NGW = G * NWAVES;

    PHASE_LOOP(0) {
        p0_adaln(lds, cvec, cctx, ada_w, ada_b, MOD, tid, wave, lane, G);
        __syncthreads();
        LAS float* scr = (LAS float*)(lds + 32768 + wave * 8704);
        const TrJob jobs[5] = {
            {args.in[8], 1024, 3072, (bf16_t*)(ws + WS_WIN0T), 0, 16 * 96}, {args.in[9], 1024, 1024, (bf16_t*)(ws + WS_WOUT0T), 0, 16 * 32},
            {args.in[21], 1024, 2304, (bf16_t*)(ws + WS_WIN1T), 0, 16 * 72}, {args.in[22], 1024, 1024, (bf16_t*)(ws + WS_WOUT1T), 0, 16 * 32},
            {args.in[18], 512, 512, (bf16_t*)(ws + WS_WGLUT), 0, 8 * 16}};
        constexpr int NBIG = 16 * 96 + 16 * 32 + 16 * 72 + 16 * 32 + 8 * 16, NLRU = 32 * 2;
        for (int it = gw; it < NBIG + NLRU; it += NGW) {
            if (it < NBIG) { int r = it;
#pragma unroll
                for (int j = 0; j < 5; ++j) { if (r >= 0 && r < jobs[j].items) p0_transpose_item(jobs[j].W, jobs[j].K, jobs[j].N, jobs[j].WT, 0, scr, r, lane); r -= jobs[j].items; }
            } else { const int q = it - NBIG, mat = q >> 1, sub = q & 1, dir = mat >> 4, gate = (mat >> 3) & 1, blk = mat & 7;
                const float* W = (gate ? args.in[28] : args.in[26]) + (size_t)(dir * 8 + blk) * 4096;
                p0_transpose_item(W, 64, 64, (bf16_t*)(ws + WS_LRUWT), blk * 256 + (dir * 2 + gate) * 64, scr, sub, lane); }
        }
    }
    PHASE_LOOP(0) {
        float* ROPE = (float*)(ws + WS_ROPE);
        for (int e = blockIdx.x * NTHREADS + tid; e < SEQ * 32; e += G * NTHREADS) { const int t = e >> 5, i = e & 31, f = i & 15; const float pos = (float)(i < 16 ? (t >> 6) : (t & 63));
            const float inv = (float)exp(-log(10000.0) * (double)(2 * f) / 32.0); const float ang = pos * inv; ROPE[2 * e] = cosf(ang); ROPE[2 * e + 1] = sinf(ang); }
    }
    PHASE_LOOP(0) {
        for (int it = G - 1 - (int)blockIdx.x; it < 64; it += G)
            s5_tables_block(it, args.in[10], args.in[11], args.in[12], args.in[13], args.in[14], args.in[15], args.in[16], (bf16_t*)(ws + WS_W16), (bf16_t*)(ws + WS_WC), (bf16_t*)(ws + WS_KT), (float*)(ws + WS_L16), lds, tid);
    }
    SEAM(0);
    PHASE_LOOP(1) {
        for (int r = gw; r < MROWS; r += NGW) {
            const float* src = r < NLAT ? x + (size_t)r * DM : ctxin + (size_t)(r - NLAT) * DM;
            float v[16]; load_row16(src, lane, v);
            store_modnorm(v, row_rinv(v), pre_g, MOD + (r < NLAT ? (r >> 12) : 4) * 3072, XN + (size_t)r * DM, lane);
        }
    }
    SEAM(1);
    PHASE_LOOP(2) {
        pg8::Gemm g{XN, (const bf16_t*)(ws + WS_WIN0T), MROWS, N0, DM}; pg8::StaticOrder S; S.init(MROWS, N0, G, (int)blockIdx.x);
        pg8::EpiProj E{PROJ, N0, nullptr, 1 << 30, 1 << 30, 512, false};
        pg8::gemm_phase<pg8::EpiProj, pg8::StaticOrder, kALIGN, kSP2>(lds, g, S, E);
    }
    SEAM(2);
    PHASE_LOOP(3) { phase3(args, lds, tid, wave, lane, G, rep_); }
    SEAM(3);
    PHASE_LOOP(4) { phase4(args, lds, tid, wave, lane, G); }
    SEAM(4);
    PHASE_LOOP(5) {
        pg8::Gemm g{YPRE, (const bf16_t*)(ws + WS_WGLUT), MROWS, 512, 512}; pg8::StaticOrder S; S.init(MROWS, 512, G, (int)blockIdx.x);
        pg8::EpiGlu E{YPRE, PROJ, args.in[19], YMIX};
        pg8::gemm_phase<pg8::EpiGlu, pg8::StaticOrder, kALIGN, kSP2>(lds, g, S, E);
    }
    SEAM(5);
    PHASE_LOOP(6) {
        pg8::Gemm g{YMIX, (const bf16_t*)(ws + WS_WOUT0T), MROWS, DM, DM}; pg8::StaticOrder S; S.init(MROWS, DM, G, (int)blockIdx.x);
        pg8::EpiF32 E{OUTF, DM};
        pg8::gemm_phase<pg8::EpiF32, pg8::StaticOrder, kALIGN, kSP2>(lds, g, S, E);
    }
    SEAM(6);
    PHASE_LOOP(7) {
        for (int r = gw; r < MROWS; r += NGW) {
            const int mrow = r < NLAT ? (r >> 12) : 4;
            const float* hin = r < NLAT ? x + (size_t)r * DM : ctxin + (size_t)(r - NLAT) * DM;
            float v[16], h[16]; load_row16(OUTF + (size_t)r * DM, lane, v); load_row16(hin, lane, h);
            const float rinv = row_rinv(v); const float* gt = MOD + mrow * 3072 + 2048;
#pragma unroll
            for (int j = 0; j < 4; ++j) { const int col = j * 256 + lane * 4; const f32x4_t pg = *(const f32x4_t*)(post_g + col), gg = *(const f32x4_t*)(gt + col);
#pragma unroll
                for (int e = 0; e < 4; ++e) h[4 * j + e] += gg[e] * (v[4 * j + e] * rinv * pg[e]);
                if (r < NLAT) *(f32x4_t*)(out + (size_t)r * DM + col) = (f32x4_t){h[4 * j], h[4 * j + 1], h[4 * j + 2], h[4 * j + 3]}; }
            store_modnorm(h, row_rinv(h), pre_g + DM, MOD + (5 + mrow) * 3072, XN + (size_t)r * DM, lane);
        }
    }
    SEAM(7);
    PHASE_LOOP(8) {
        pg8::Gemm g{XN, (const bf16_t*)(ws + WS_WIN1T), MROWS, N1, DM}; pg8::StaticOrder S; S.init(MROWS, N1, G, (int)blockIdx.x);
        pg8::EpiProj E{PROJ, N1, (bf16_t*)(ws + WS_VT1), 1664, 1792, 128, true};
        pg8::gemm_phase<pg8::EpiProj, pg8::StaticOrder, kALIGN, kSP2>(lds, g, S, E);
    }
    SEAM(8);
    PHASE_LOOP(9) { phase9(args, lds, tid, wave, lane, G); }
    SEAM(9);
    PHASE_LOOP(10) { phase10(args, lds, tid, wave, lane, G); }
    SEAM(10);
    PHASE_LOOP(11) {
        pg8::Gemm g{YMIX, (const bf16_t*)(ws + WS_WOUT1T), NLAT, DM, DM}; pg8::StaticOrder S; S.init(NLAT, DM, G, (int)blockIdx.x);
        pg8::EpiF32 E{OUTF, DM};
        pg8::gemm_phase<pg8::EpiF32, pg8::StaticOrder, kALIGN, kSP2>(lds, g, S, E);
    }
    SEAM(11);
    PHASE_LOOP(12) {
        for (int r = gw; r < NLAT; r += NGW) {
            float v[16], h[16]; load_row16(OUTF + (size_t)r * DM, lane, v); load_row16(out + (size_t)r * DM, lane, h);
            const float rinv = row_rinv(v); const float* gt = MOD + (5 + (r >> 12)) * 3072 + 2048;
#pragma unroll
            for (int j = 0; j < 4; ++j) { const int col = j * 256 + lane * 4; const f32x4_t pg = *(const f32x4_t*)(post_g + DM + col), gg = *(const f32x4_t*)(gt + col);
                f32x4_t o;
#pragma unroll
                for (int e = 0; e < 4; ++e) o[e] = h[4 * j + e] + gg[e] * (v[4 * j + e] * rinv * pg[e]);
                *(f32x4_t*)(out + (size_t)r * DM + col) = o; }
        }
    }
#undef IN
#undef SEAM
}
__global__ void k_adaln(const float* c, const float* cctx, const float* ada_w, const float* ada_b, float* mod) {
    const int idx = blockIdx.x * blockDim.x + threadIdx.x;
    if (idx >= 2 * 5 * 3072) return;
    const int col = idx % 3072, r = (idx / 3072) % 5, i = idx / (3072 * 5);
    const float* cv = r < 4 ? c + r * 1024 : cctx;
    const float* W = ada_w + (size_t)i * 1024 * 3072;
    float acc = 0.f;
    for (int k = 0; k < 1024; ++k) acc += silu_f(cv[k]) * W[(size_t)k * 3072 + col];
    mod[idx] = acc + ada_b[i * 3072 + col];
}

__global__ void k_prenorm(const float* lat, const float* ctx, const float* g, const float* mod  , bf16_t* XN) {
    const int r = blockIdx.x * 4 + (threadIdx.x >> 6), lane = threadIdx.x & 63;
    if (r >= MROWS) return;
    const float* src = r < NLAT ? lat + (size_t)r * DM : ctx + (size_t)(r - NLAT) * DM;
    const float* m = mod + (r < NLAT ? (r >> 12) : 4) * 3072;
    float v[16]; float ss = 0.f;
#pragma unroll
    for (int j = 0; j < 4; ++j) { const float4 t = *(const float4*)(src + j * 256 + lane * 4); v[4 * j] = t.x; v[4 * j + 1] = t.y; v[4 * j + 2] = t.z; v[4 * j + 3] = t.w; }
#pragma unroll
    for (int j = 0; j < 16; ++j) ss += v[j] * v[j];
    ss = wave_sum(ss);
    const float rinv = rsqrtf(ss * (1.f / DM) + EPSN);
#pragma unroll
    for (int j = 0; j < 4; ++j)
#pragma unroll
        for (int e = 0; e < 4; ++e) { const int col = j * 256 + lane * 4 + e; const float y = v[4 * j + e] * rinv * g[col] * (1.f + m[1024 + col]) + m[col]; XN[(size_t)r * DM + col] = f2bf(y); }
}

__global__ void k_postnorm(const float* hlat, const float* hctx, const float* OUT, const float* pg, const float* mod, float* olat, float* octx, int nrows) {
    const int r = blockIdx.x * 4 + (threadIdx.x >> 6), lane = threadIdx.x & 63;
    if (r >= nrows) return;
    const float* hin = r < NLAT ? hlat + (size_t)r * DM : hctx + (size_t)(r - NLAT) * DM;
    float* ho = r < NLAT ? olat + (size_t)r * DM : octx + (size_t)(r - NLAT) * DM;
    const float* m = mod + (r < NLAT ? (r >> 12) : 4) * 3072 + 2048;
    const float* src = OUT + (size_t)r * DM;
    float v[16]; float ss = 0.f;
#pragma unroll
    for (int j = 0; j < 4; ++j) { const float4 t = *(const float4*)(src + j * 256 + lane * 4); v[4 * j] = t.x; v[4 * j + 1] = t.y; v[4 * j + 2] = t.z; v[4 * j + 3] = t.w; }
#pragma unroll
    for (int j = 0; j < 16; ++j) ss += v[j] * v[j];
    ss = wave_sum(ss);
    const float rinv = rsqrtf(ss * (1.f / DM) + EPSN);
#pragma unroll
    for (int j = 0; j < 4; ++j)
#pragma unroll
        for (int e = 0; e < 4; ++e) { const int col = j * 256 + lane * 4 + e; ho[col] = hin[col] + m[col] * (v[4 * j + e] * rinv * pg[col]); }
}

enum { GM_PROJ0 = 0, GM_PROJ1 = 1, GM_GLU = 2, GM_F32 = 3 };
struct GemmEpi { bf16_t* P; bf16_t* VT; const bf16_t* YPRE; const bf16_t* PROJ; const float* bglu; bf16_t* YMIX; float* OUT; };
template <int MODE> __global__ void __launch_bounds__(256) k_gemm(const bf16_t* A, const float* W, int M, int N, int K, GemmEpi e) {
    const int tx = threadIdx.x & 15, ty = threadIdx.x >> 4;
    const int c0 = blockIdx.x * 64 + tx * 4, r0 = blockIdx.y * 64 + ty * 4;
    float acc[4][4] = {};
    for (int k = 0; k < K; ++k) {
        const float4 w = *(const float4*)(W + (size_t)k * N + c0);
        const float wv[4] = {rbf(w.x), rbf(w.y), rbf(w.z), rbf(w.w)};
#pragma unroll
        for (int i = 0; i < 4; ++i) { const float a = bf2f(A[(size_t)(r0 + i) * K + k]);
#pragma unroll
            for (int j = 0; j < 4; ++j) acc[i][j] += a * wv[j]; }
    }
#pragma unroll
    for (int i = 0; i < 4; ++i)
#pragma unroll
        for (int j = 0; j < 4; ++j) {
            const int r = r0 + i, c = c0 + j; const float v = acc[i][j];
            if (MODE == GM_PROJ0) { e.P[(size_t)r * N0 + c] = f2bf(v);
                if (c >= 2048 && c < 2560) { const int hd = c - 2048; e.VT[((size_t)(row_batch(r) * 8) * 64 + hd) * POSN + row_pos(r)] = f2bf(v); } }
            else if (MODE == GM_PROJ1) { e.P[(size_t)r * N1 + c] = f2bf(v);
                if (c >= 1664 && c < 1792) { const int hd = c - 1664; e.VT[((size_t)(row_batch(r) * 2) * 64 + hd) * POSN + row_pos(r)] = f2bf(v); } }
            else if (MODE == GM_GLU) { const float y = bf2f(e.YPRE[(size_t)r * 512 + c]); const float ga = bf2f(e.PROJ[(size_t)r * N0 + 512 + c]);
                e.YMIX[(size_t)r * DM + c] = f2bf(y * sigmoid_f(v + e.bglu[c]) * silu_f(ga)); }
            else e.OUT[(size_t)r * N + c] = v;
        }
}

__global__ void __launch_bounds__(64) k_s5_scan(const bf16_t* PROJ, const float* lam_re, const float* lam_im, const float* log_dt, const float* b_re, const float* b_im,
                                                 const float* c_re, const float* c_im, float* YS) {
    const int p = threadIdx.x, id = blockIdx.x, dir = id & 1, g = (id >> 1) & 31, b = id >> 6;
    const int gi = (dir * 32 + g);
    const double lre = lam_re[gi * 64 + p], lim = lam_im[gi * 64 + p], dt = exp((double)log_dt[gi]);
    const double mag = exp(lre * dt); const float ar = (float)(mag * cos(lim * dt)), ai = (float)(mag * sin(lim * dt));
    const double nr = mag * cos(lim * dt) - 1.0, ni = mag * sin(lim * dt), den = lre * lre + lim * lim;
    const float cfr = (float)((nr * lre + ni * lim) / den), cfi = (float)((ni * lre - nr * lim) / den);
    float bbr[16], bbi[16], cr[16], ci[16];
#pragma unroll
    for (int h = 0; h < 16; ++h) { const float br = b_re[(gi * 64 + p) * 16 + h], bi = b_im[(gi * 64 + p) * 16 + h]; bbr[h] = cfr * br - cfi * bi; bbi[h] = cfr * bi + cfi * br;
        cr[h] = c_re[(gi * 16 + h) * 64 + p]; ci[h] = c_im[(gi * 16 + h) * 64 + p]; }
    float hr = 0.f, hi = 0.f;
    float* ys = YS + (size_t)dir * MROWS * 512;
    for (int pos = 0; pos < POSN; ++pos) {
        int row;
        if (dir == 0) row = pos_row(b, pos); else row = pos < LC ? NLAT + b * LC + (LC - 1 - pos) : b * SEQ + (SEQ - 1 - (pos - LC));
        const bf16_t* up = PROJ + (size_t)row * N0 + g * 16;
        float bur = 0.f, bui = 0.f;
#pragma unroll
        for (int h = 0; h < 16; ++h) { const float u = bf2f(up[h]); bur += bbr[h] * u; bui += bbi[h] * u; }
        const float nhr = ar * hr - ai * hi + bur, nhi = ar * hi + ai * hr + bui; hr = nhr; hi = nhi;
        float mine = 0.f;
#pragma unroll
        for (int h = 0; h < 16; ++h) { const float y = wave_sum(cr[h] * hr - ci[h] * hi); if (p == h) mine = y; }
        if (p < 16) ys[(size_t)row * 512 + g * 16 + p] = mine;
    }
}
__global__ void k_s5_finish(const bf16_t* PROJ, const float* YS, const float* dsk, bf16_t* YPRE) {
    const size_t idx = (size_t)blockIdx.x * blockDim.x + threadIdx.x; if (idx >= (size_t)MROWS * 512) return;
    const int ch = idx & 511; const size_t r = idx >> 9;
    const float y = dsk[ch] * bf2f(PROJ[r * N0 + ch]) + YS[idx] + YS[(size_t)MROWS * 512 + idx];
    YPRE[idx] = f2bf(gelu_tanh(y));
}

__global__ void __launch_bounds__(256) k_na_attn(const bf16_t* PROJ, const float* relb, bf16_t* YMIX) {
    const int wv = blockIdx.x * 4 + (threadIdx.x >> 6), lane = threadIdx.x & 63;
    if (wv >= MROWS * 8) return;
    const int h = wv & 7, r = wv >> 3, b = row_batch(r);
    const float q = bf2f(PROJ[(size_t)r * N0 + 1024 + h * 64 + lane]);
    float m = -INFINITY, l = 0.f, o = 0.f;
    if (r < NLAT) {
        const int t = r & 4095, qr = t >> 6, qc = t & 63;
        const int rs = min(max(qr - 4, 0), 56), cs = min(max(qc - 8, 0), 48);
        for (int kr = rs; kr < rs + 8; ++kr)
            for (int kc = cs; kc < cs + 16; ++kc) {
                const size_t kro = (size_t)(b * SEQ + kr * 64 + kc) * N0;
                float s = wave_sum(q * bf2f(PROJ[kro + 1536 + h * 64 + lane])) * 0.125f + relb[(h * 15 + (kr - qr + 7)) * 31 + (kc - qc + 15)];
                const float mn = fmaxf(m, s), al = __expf(m - mn), pp = __expf(s - mn);
                l = l * al + pp; o = o * al + pp * bf2f(PROJ[kro + 2048 + h * 64 + lane]); m = mn;
            }
    }
    for (int c = 0; c < LC; ++c) {
        const size_t kro = (size_t)(NLAT + b * LC + c) * N0;
        const float s = wave_sum(q * bf2f(PROJ[kro + 1536 + h * 64 + lane])) * 0.125f;
        const float mn = fmaxf(m, s), al = __expf(m - mn), pp = __expf(s - mn);
        l = l * al + pp; o = o * al + pp * bf2f(PROJ[kro + 2048 + h * 64 + lane]); m = mn;
    }
    const float gb = bf2f(PROJ[(size_t)r * N0 + 2560 + h * 64 + lane]);
    YMIX[(size_t)r * DM + 512 + h * 64 + lane] = f2bf(o / l * silu_f(gb));
}

__global__ void __launch_bounds__(64) k_lru(const bf16_t* P1, const float* conv_w, const float* conv_b, const float* lam, const float* w_a, const float* b_a,
                                            const float* w_x, const float* b_x, float* HS, bf16_t* YMIX) {
    __shared__ float xs[64];
    const int j = threadIdx.x, nb = blockIdx.x & 7, b = blockIdx.x >> 3, ch = nb * 64 + j;
    const float cw0 = conv_w[0 * 512 + ch], cw1 = conv_w[1 * 512 + ch], cw2 = conv_w[2 * 512 + ch], cw3 = conv_w[3 * 512 + ch], cb = conv_b[ch];
    for (int dir = 0; dir < 2; ++dir) {
        float wa[64], wx[64];
#pragma unroll
        for (int i = 0; i < 64; ++i) { wa[i] = w_a[((dir * 8 + nb) * 64 + i) * 64 + j]; wx[i] = w_x[((dir * 8 + nb) * 64 + i) * 64 + j]; }
        const float ba = b_a[dir * 512 + ch], bx = b_x[dir * 512 + ch];
        const float lm = lam[dir * 512 + ch]; const float sp = (-lm > 20.f) ? -lm : log1pf(__expf(-lm));
        float hst = 0.f;
        for (int pos = 0; pos < POSN; ++pos) {
            int s0, sl, t;
            if (pos < LC) { s0 = NLAT + b * LC; sl = LC; t = dir == 0 ? pos : LC - 1 - pos; }
            else { s0 = b * SEQ; sl = SEQ; t = dir == 0 ? pos - LC : SEQ - 1 - (pos - LC); }
            float xm1 = 0.f, x0, xp1 = 0.f, xp2 = 0.f;
            x0 = bf2f(P1[(size_t)(s0 + t) * N1 + ch]);
            if (t - 1 >= 0) xm1 = bf2f(P1[(size_t)(s0 + t - 1) * N1 + ch]);
            if (t + 1 < sl) xp1 = bf2f(P1[(size_t)(s0 + t + 1) * N1 + ch]);
            if (t + 2 < sl) xp2 = bf2f(P1[(size_t)(s0 + t + 2) * N1 + ch]);
            const float xc = cw0 * xm1 + cw1 * x0 + cw2 * xp1 + cw3 * xp2 + cb;
            __syncthreads(); xs[j] = xc; __syncthreads();
            float ga = ba, gx = bx;
#pragma unroll
            for (int i = 0; i < 64; ++i) { const float xi = xs[i]; ga += xi * wa[i]; gx += xi * wx[i]; }
            const float gr = sigmoid_f(ga), gi = sigmoid_f(gx);
            const float log_a = -8.f * gr * sp; const float a = __expf(log_a); const float mult = sqrtf(fmaxf(-expm1f(2.f * log_a), 0.f));
            hst = a * hst + mult * gi * xc;
            if (pos >= LC) { const size_t rr = (size_t)(s0 + t);
                if (dir == 0) HS[rr * 512 + ch] = hst;
                else { const float gc = bf2f(P1[rr * N1 + 512 + ch]); YMIX[rr * DM + ch] = f2bf((HS[rr * 512 + ch] + hst) * silu_f(gc)); } }
        }
    }
}

__global__ void __launch_bounds__(256) k_qkprep(const bf16_t* P1, const float* qn, const float* kn, bf16_t* QP, bf16_t* KP) {
    const int wv = blockIdx.x * 4 + (threadIdx.x >> 6), lane = threadIdx.x & 63;
    if (wv >= MROWS * 10) return;
    const int slot = wv % 10, r = wv / 10, b = row_batch(r);
    if (slot < 8 && r >= NLAT) return;
    const int col0 = slot < 8 ? 1024 + slot * 64 : 1536 + (slot - 8) * 64;
    const float x = bf2f(P1[(size_t)r * N1 + col0 + lane]);
    const float ss = wave_sum(x * x);
    float y = x * rsqrtf(ss * (1.f / 64.f) + EPSN) * (slot < 8 ? qn[lane] : kn[lane]);
    if (r < NLAT) {
        const int t = r & 4095, i = lane >> 1, f = i & 15; const float pos = (float)(i < 16 ? (t >> 6) : (t & 63));
        const float inv = (float)exp(-log(10000.0) * (double)(2 * f) / 32.0);
        const float ang = pos * inv; const float cs = cosf(ang), sn = sinf(ang);
        const float pr = __shfl_xor(y, 1);
        y = (lane & 1) ? (pr * sn + y * cs) : (y * cs - pr * sn);
    }
    if (slot < 8) QP[((size_t)(b * 8 + slot) * SEQ + (r & 4095)) * 64 + lane] = f2bf(y * (0.125f * LOG2E));
    else KP[((size_t)(b * 2 + (slot - 8)) * POSN + row_pos(r)) * 64 + lane] = f2bf(y);
}

__global__ void __launch_bounds__(256) k_gqa(const bf16_t* QP, const bf16_t* KP, const bf16_t* P1, bf16_t* YMIX) {
    const int wv = blockIdx.x * 4 + (threadIdx.x >> 6), lane = threadIdx.x & 63;
    if (wv >= NLAT * 8) return;
    const int hq = wv & 7, r = wv >> 3, b = r >> 12, t = r & 4095, kvh = hq >> 2;
    const float q = bf2f(QP[((size_t)(b * 8 + hq) * SEQ + t) * 64 + lane]);
    const bf16_t* kp = KP + (size_t)(b * 2 + kvh) * POSN * 64;
    float m = -INFINITY, l = 0.f, o = 0.f;
    for (int pos = 0; pos < POSN; ++pos) {
        const float s = wave_sum(q * bf2f(kp[(size_t)pos * 64 + lane]));
        const float v = bf2f(P1[(size_t)pos_row(b, pos) * N1 + 1664 + kvh * 64 + lane]);
        const float mn = fmaxf(m, s), al = exp2f(m - mn), pp = exp2f(s - mn);
        l = l * al + pp; o = o * al + pp * v; m = mn;
    }
    const float gd = bf2f(P1[(size_t)r * N1 + 1792 + hq * 64 + lane]);
    YMIX[(size_t)r * DM + 512 + hq * 64 + lane] = f2bf(o / l * silu_f(gd));
}

static int g_grid = 0;
static void launch_mega(Args a, int lo, int hi, int li, hipStream_t stream) {
    a.ph_lo = lo; a.ph_hi = hi; a.li = li;
    hipLaunchKernelGGL(mega, dim3(g_grid), dim3(NTHREADS), LDS_BYTES, stream, a);
    const hipError_t le = hipPeekAtLastError();
    if (le != hipSuccess) fprintf(stderr, "kernel_launch: mega[%d,%d) failed: %s\n", lo, hi, hipGetErrorName(le));
}
extern "C" void kernel_launch(void* const* d_in, const int* in_sizes, int n_in, void* d_out, int out_size, void* d_ws, size_t ws_size, hipStream_t stream) {
    if (g_grid == 0) {
        int dev = 0, cus = 0;
        if (hipGetDevice(&dev) != hipSuccess || hipDeviceGetAttribute(&cus, hipDeviceAttributeMultiprocessorCount, dev) != hipSuccess) { fprintf(stderr, "kernel_launch: device query failed\n"); g_grid = -1; return; }
        if (hipFuncSetAttribute((const void*)mega, hipFuncAttributeMaxDynamicSharedMemorySize, LDS_BYTES) != hipSuccess) { fprintf(stderr, "kernel_launch: hipFuncSetAttribute failed\n"); g_grid = -1; return; }
        int per_cu = 0;
        if (hipOccupancyMaxActiveBlocksPerMultiprocessor(&per_cu, (const void*)mega, NTHREADS, LDS_BYTES) != hipSuccess || per_cu < 1) fprintf(stderr, "kernel_launch: occupancy query says %d blocks/CU\n", per_cu);
        (void)hipGetLastError();
        g_grid = cus;
    }
    if (g_grid < 0) return;
    const float* x = (const float*)d_in[0]; const float* c = (const float*)d_in[1]; const float* ctx = (const float*)d_in[2]; const float* cctx = (const float*)d_in[3];
    const float* ada_w = (const float*)d_in[4]; const float* ada_b = (const float*)d_in[5]; const float* pre_g = (const float*)d_in[6]; const float* post_g = (const float*)d_in[7];
    const float* ev_w_in = (const float*)d_in[8]; const float* ev_w_out = (const float*)d_in[9];
    const float* s5_lre = (const float*)d_in[10]; const float* s5_lim = (const float*)d_in[11]; const float* s5_ldt = (const float*)d_in[12];
    const float* s5_bre = (const float*)d_in[13]; const float* s5_bim = (const float*)d_in[14]; const float* s5_cre = (const float*)d_in[15]; const float* s5_cim = (const float*)d_in[16];
    const float* s5_d = (const float*)d_in[17]; const float* s5_wglu = (const float*)d_in[18]; const float* s5_bglu = (const float*)d_in[19]; const float* relb = (const float*)d_in[20];
    const float* od_w_in = (const float*)d_in[21]; const float* od_w_out = (const float*)d_in[22]; const float* conv_w = (const float*)d_in[23]; const float* conv_b = (const float*)d_in[24];
    const float* lru_lam = (const float*)d_in[25]; const float* w_a = (const float*)d_in[26]; const float* b_a = (const float*)d_in[27]; const float* w_x = (const float*)d_in[28]; const float* b_x = (const float*)d_in[29];
    const float* qn = (const float*)d_in[30]; const float* kn = (const float*)d_in[31];
    char* ws = (char*)d_ws; float* out = (float*)d_out;
    float* MOD = (float*)(ws + WS_MOD); float* HC1 = (float*)(ws + WS_HC1);
    bf16_t* XN = (bf16_t*)(ws + WS_XN); bf16_t* YMIX = (bf16_t*)(ws + WS_YMIX); bf16_t* PROJ = (bf16_t*)(ws + WS_PROJ); float* OUTF = (float*)(ws + WS_PROJ);
    bf16_t* VT0 = (bf16_t*)(ws + WS_VT0); bf16_t* YPRE = (bf16_t*)(ws + WS_YPRE); bf16_t* QP = (bf16_t*)(ws + WS_QP); bf16_t* KP = (bf16_t*)(ws + WS_KP); bf16_t* VT1 = (bf16_t*)(ws + WS_VT1);
    float* YS = (float*)(ws + WS_YS); float* HS = (float*)(ws + WS_HS);
    (void)x; (void)c; (void)ctx; (void)cctx; (void)ada_w; (void)ada_b; (void)pre_g; (void)post_g; (void)ev_w_in; (void)ev_w_out; (void)s5_wglu; (void)od_w_in; (void)od_w_out; (void)MOD; (void)HC1; (void)XN; (void)OUTF; (void)VT0; (void)VT1; (void)out;

    if (hipMemsetAsync(ws + WS_CTL, 0, CTL_ZERO_BYTES, stream) != hipSuccess) { fprintf(stderr, "kernel_launch: memset failed\n"); return; }
    Args a{};
    for (int i = 0; i < 32; ++i) a.in[i] = (const float*)d_in[i];
    a.out = (float*)d_out; a.ws = (unsigned char*)d_ws;

    launch_mega(a, 0, N_PHASES, 0, stream);
    (void)relb; (void)conv_w; (void)conv_b; (void)lru_lam; (void)w_a; (void)b_a; (void)w_x; (void)b_x; (void)HS; (void)qn; (void)kn; (void)QP; (void)KP;
    (void)s5_lre; (void)s5_lim; (void)s5_ldt; (void)s5_bre; (void)s5_bim; (void)s5_cre; (void)s5_cim; (void)s5_d; (void)s5_bglu; (void)YS; (void)YPRE; (void)PROJ; (void)YMIX;
}
```

```cpp
#include <hip/hip_runtime.h>
#include <cstdint>
#include <cstdio>

typedef unsigned short bf16_t;
#define DI __device__ __forceinline__
#define GAS __attribute__((address_space(1)))
#define LAS __attribute__((address_space(3)))
typedef unsigned v4u __attribute__((ext_vector_type(4)));
typedef unsigned v2u __attribute__((ext_vector_type(2)));
typedef float f32x4_t __attribute__((ext_vector_type(4)));
typedef float f32x16_t __attribute__((ext_vector_type(16)));
typedef short bf16x8_t __attribute__((ext_vector_type(8)));
typedef short s16x4_t __attribute__((ext_vector_type(4)));
typedef GAS unsigned gu32;
typedef GAS unsigned long long gu64;
#define RLX_AGENT __ATOMIC_RELAXED, __HIP_MEMORY_SCOPE_AGENT
#define LDS_WAIT() asm volatile("s_waitcnt lgkmcnt(0)" ::: "memory")
#define VM_WAIT() asm volatile("s_waitcnt vmcnt(0)" ::: "memory")

DI float bf2f(bf16_t v) { return __uint_as_float((unsigned)v << 16); }
DI bf16_t f2bf(float f) { unsigned u = __float_as_uint(f); return (bf16_t)((u + 0x7fffu + ((u >> 16) & 1u)) >> 16); }
DI unsigned pk2(float lo, float hi) { return (unsigned)f2bf(lo) | ((unsigned)f2bf(hi) << 16); }
DI float bflo(unsigned w) { return __uint_as_float(w << 16); }
DI float bfhi(unsigned w) { return __uint_as_float(w & 0xffff0000u); }
DI float rbf(float f) { return bf2f(f2bf(f)); }
DI float wave_sum(float v) {
#pragma unroll
    for (int o = 1; o < 64; o <<= 1) v += __shfl_xor(v, o);
    return v;
}
DI float sigmoid_f(float x) { return __builtin_amdgcn_rcpf(1.f + __builtin_amdgcn_exp2f(-1.4426950408889634f * x)); }
DI float silu_f(float x) { return x * sigmoid_f(x); }
DI float gelu_tanh(float x) { const float u = 0.7978845608028654f * (x + 0.044715f * x * x * x); return 0.5f * x * (1.f + tanhf(u)); }
DI float gelu_fast(float x) { const float u = 1.5957691216057308f * (x + 0.044715f * x * x * x); return x * sigmoid_f(u); }

constexpr int NWAVES = 8, NTHREADS = 512;
constexpr int DM = 1024, NB = 4, SEQ = 4096, LC = 256;
constexpr int NLAT = NB * SEQ, NCTX = NB * LC, MROWS = NLAT + NCTX;
constexpr int N0 = 3072, N1 = 2304, POSN = LC + SEQ;
constexpr float EPSN = 1e-6f;
constexpr float LOG2E = 1.4426950408889634f;

constexpr size_t MiB = 1u << 20;
constexpr size_t WS_CTL = 0, CTL_ZERO_BYTES = 1 * MiB;
constexpr size_t WS_MOD = 1 * MiB;
constexpr size_t WS_ROPE = 2 * MiB;
constexpr size_t WS_L16 = 3 * MiB;
constexpr size_t WS_WIN0T = 4 * MiB;
constexpr size_t WS_WOUT0T = 10 * MiB;
constexpr size_t WS_WIN1T = 12 * MiB;
constexpr size_t WS_WOUT1T = 17 * MiB;
constexpr size_t WS_WGLUT = 19 * MiB;
constexpr size_t WS_LRUWT = 19 * MiB + 512 * 1024;
constexpr size_t WS_W16 = 20 * MiB;
constexpr size_t WS_WC = 24 * MiB;
constexpr size_t WS_KT = 28 * MiB;
constexpr size_t WS_LSUM = 29 * MiB;
constexpr size_t WS_XN = 32 * MiB;
constexpr size_t WS_YMIX = 66 * MiB;
constexpr size_t WS_PROJ = 100 * MiB;
constexpr size_t WS_VT0 = 202 * MiB;
constexpr size_t WS_CARRY1 = 219 * MiB;
constexpr size_t WS_YPRE = 228 * MiB;
constexpr size_t WS_QP = 202 * MiB;
constexpr size_t WS_KP = 218 * MiB;
constexpr size_t WS_VT1 = 223 * MiB;
constexpr size_t WS_YS = 32 * MiB;
constexpr size_t WS_HS = 32 * MiB;
constexpr size_t WS_HC1 = 246 * MiB;

DI int row_batch(int r) { return r < NLAT ? (r >> 12) : ((r - NLAT) >> 8); }
DI int row_pos(int r) { return r < NLAT ? LC + (r & 4095) : ((r - NLAT) & 255); }
DI int pos_row(int b, int pos) { return pos < LC ? NLAT + b * LC + pos : b * SEQ + (pos - LC); }

namespace pg8 {
#define PG8_LAS __attribute__((address_space(3)))
typedef unsigned short bf16_t;
typedef short bf16x8 __attribute__((ext_vector_type(8)));
typedef float f32x4 __attribute__((ext_vector_type(4)));
typedef unsigned u32x4 __attribute__((ext_vector_type(4)));
constexpr int BM = 256, BK = 64, HALF = 128, HTB = HALF * BK * 2  , STAGE_BYTES = 8 * HTB, NXCD = 8, WGM = 8;

__host__ __device__ __forceinline__ int lds_byte(int r, int c) { const int st = (r >> 4) * 2 + (c >> 5), rr = r & 15, cc = c & 31, ob = rr * 64 + cc * 2; return st * 1024 + (ob ^ (((ob >> 9) & 1) << 5)); }
__host__ __device__ __forceinline__ void stage_rc(int b, int& R, int& C) { const int st = b / 1024, sb = b % 1024, swz = sb ^ (((sb >> 9) & 1) << 5); R = (st >> 1) * 16 + swz / 64; C = (st & 1) * 32 + (swz % 64) / 2; }
__host__ __device__ __forceinline__ int perm32(int rho) { const int n = rho >> 4, i = rho & 15; return 8 * (i >> 2) + 4 * n + (i & 3); }

struct Unit { int pm, pn; };
struct Gemm { const bf16_t* A; const bf16_t* Bt; int M, N, K; };

struct StaticOrder {
    int nM, nN, nwg, G, c;
    __host__ __device__ void init(int M, int N, int G_, int c_) { nM = M / BM; nN = N / BM; nwg = nM * nN; G = G_; c = c_; }
    __host__ __device__ bool next(int i, Unit& u) const {
        const long L = (long)i * G + c; if (L >= nwg) return false;
        int wgid = (int)L; { const int q = nwg / NXCD, r = nwg % NXCD, xcd = wgid % NXCD, off = wgid / NXCD; wgid = (xcd < r ? xcd * (q + 1) : r * (q + 1) + (xcd - r) * q) + off; }
        const int nig = WGM * nN, gid = wgid / nig, fm = gid * WGM, gsz = (nM - fm) < WGM ? (nM - fm) : WGM;
        u.pm = fm + ((wgid % nig) % gsz); u.pn = (wgid % nig) / gsz; return true;
    }
    __device__ __forceinline__ void a_ready(const Unit&) const {}
    __device__ __forceinline__ void done(const Unit&) const {}
};

__device__ __forceinline__ unsigned cvt_pk_bf16(float lo, float hi) { unsigned r; asm volatile("v_cvt_pk_bf16_f32 %0, %1, %2" : "=v"(r) : "v"(lo), "v"(hi)); return r; }

struct EpiProj {
    static constexpr bool PERM = true, AFTER_DRAIN = false;
    bf16_t* P; int ldc; bf16_t* VT; int vt_lo, vt_hi, vt_w; bool vrow;
    __device__ __forceinline__ void operator()(const f32x4 (&acc)[2][2][4][2], const Unit& u, int wr, int wc, int fr, int fq) const {
        const int row0 = u.pm * BM + wr * 64 + fr, colt = u.pn * BM + wc * 32 + 8 * fq;
#pragma unroll
        for (int ai = 0; ai < 2; ++ai)
#pragma unroll
            for (int m = 0; m < 4; ++m) { const int r = row0 + ai * HALF + m * 16; bf16_t* rowp = P + (size_t)r * ldc + colt;
#pragma unroll
                for (int bj = 0; bj < 2; ++bj) { const f32x4 v0 = acc[ai][bj][m][0], v1 = acc[ai][bj][m][1];
                    u32x4 w; w.x = cvt_pk_bf16(v0[0], v0[1]); w.y = cvt_pk_bf16(v0[2], v0[3]); w.z = cvt_pk_bf16(v1[0], v1[1]); w.w = cvt_pk_bf16(v1[2], v1[3]);
                    *(u32x4*)(rowp + bj * HALF) = w;
                    const int c0 = colt + bj * HALF;
                    if (c0 >= vt_lo && c0 < vt_hi && vrow) {
                        const int hd = c0 - vt_lo; *(u32x4*)(VT + ((size_t)(row_batch(r) * (vt_w >> 6) + (hd >> 6)) * POSN + row_pos(r)) * 64 + (hd & 63)) = w;
                    } else if (c0 >= vt_lo && c0 < vt_hi) {
                        bf16_t* vp = VT + ((size_t)row_batch(r) * vt_w + (c0 - vt_lo)) * POSN + row_pos(r);
                        vp[0 * POSN] = (bf16_t)(w.x & 0xffffu); vp[1 * POSN] = (bf16_t)(w.x >> 16); vp[2 * POSN] = (bf16_t)(w.y & 0xffffu); vp[3 * POSN] = (bf16_t)(w.y >> 16);
                        vp[4 * POSN] = (bf16_t)(w.z & 0xffffu); vp[5 * POSN] = (bf16_t)(w.z >> 16); vp[6 * POSN] = (bf16_t)(w.w & 0xffffu); vp[7 * POSN] = (bf16_t)(w.w >> 16);
                    } } }
    }
};
struct EpiGlu {
    static constexpr bool PERM = true, AFTER_DRAIN = false;
    const bf16_t* YPRE; const bf16_t* PROJ; const float* bglu; bf16_t* YMIX;
    __device__ __forceinline__ void operator()(const f32x4 (&acc)[2][2][4][2], const Unit& u, int wr, int wc, int fr, int fq) const {
        const int row0 = u.pm * BM + wr * 64 + fr, colt = u.pn * BM + wc * 32 + 8 * fq;
#pragma unroll
        for (int bj = 0; bj < 2; ++bj) { const int c0 = colt + bj * HALF;
            const f32x4 b0 = *(const f32x4*)(bglu + c0), b1 = *(const f32x4*)(bglu + c0 + 4);
#pragma unroll
            for (int ai = 0; ai < 2; ++ai)
#pragma unroll
                for (int m = 0; m < 4; ++m) { const int r = row0 + ai * HALF + m * 16;
                    const u32x4 yv = *(const u32x4*)(YPRE + (size_t)r * 512 + c0), gv = *(const u32x4*)(PROJ + (size_t)r * N0 + 512 + c0);
                    const f32x4 a0 = acc[ai][bj][m][0] + b0, a1 = acc[ai][bj][m][1] + b1;
                    float o[8];
                    o[0] = bflo(yv.x) * sigmoid_f(a0[0]) * silu_f(bflo(gv.x)); o[1] = bfhi(yv.x) * sigmoid_f(a0[1]) * silu_f(bfhi(gv.x));
                    o[2] = bflo(yv.y) * sigmoid_f(a0[2]) * silu_f(bflo(gv.y)); o[3] = bfhi(yv.y) * sigmoid_f(a0[3]) * silu_f(bfhi(gv.y));
                    o[4] = bflo(yv.z) * sigmoid_f(a1[0]) * silu_f(bflo(gv.z)); o[5] = bfhi(yv.z) * sigmoid_f(a1[1]) * silu_f(bfhi(gv.z));
                    o[6] = bflo(yv.w) * sigmoid_f(a1[2]) * silu_f(bflo(gv.w)); o[7] = bfhi(yv.w) * sigmoid_f(a1[3]) * silu_f(bfhi(gv.w));
                    u32x4 w; w.x = cvt_pk_bf16(o[0], o[1]); w.y = cvt_pk_bf16(o[2], o[3]); w.z = cvt_pk_bf16(o[4], o[5]); w.w = cvt_pk_bf16(o[6], o[7]);
                    *(u32x4*)(YMIX + (size_t)r * DM + c0) = w; } }
    }
};
struct EpiF32 {
    static constexpr bool PERM = false, AFTER_DRAIN = false;
    float* O; int ldc;
    __device__ __forceinline__ void operator()(const f32x4 (&acc)[2][2][4][2], const Unit& u, int wr, int wc, int fr, int fq) const {
        const int row0 = u.pm * BM + wr * 64 + fr, col0 = u.pn * BM + wc * 32 + 4 * fq;
#pragma unroll
        for (int ai = 0; ai < 2; ++ai)
#pragma unroll
            for (int m = 0; m < 4; ++m) { float* rowp = O + (size_t)(row0 + ai * HALF + m * 16) * ldc + col0;
#pragma unroll
                for (int bj = 0; bj < 2; ++bj)
#pragma unroll
                    for (int n = 0; n < 2; ++n) *(f32x4*)(rowp + bj * HALF + n * 16) = acc[ai][bj][m][n]; }
    }
};
template <class Epi, class Sched, bool ALIGN_EPI = false, bool SP2 = false>
__device__ __forceinline__ void gemm_phase(PG8_LAS unsigned char* lds, const Gemm g, const Sched& S, const Epi& E) {
    const int tid = threadIdx.x, wid = __builtin_amdgcn_readfirstlane(tid >> 6), lane = tid & 63, wr = wid >> 2, wc = wid & 3, fr = lane & 15, fq = lane >> 4;
    const int K = g.K, nt = K / BK;
    unsigned voffA[2], voffB[2];
#pragma unroll
    for (int i = 0; i < 2; ++i) { int R, C; stage_rc(tid * 16 + i * 8192, R, C); const int Rb = Epi::PERM ? ((R & ~31) + perm32(R & 31)) : R;
        voffA[i] = (unsigned)(R * K + C) * 2u; voffB[i] = (unsigned)(Rb * K + C) * 2u; }
    const size_t kstep = (size_t)(BK * 2);
    const size_t hstep = (size_t)HALF * K * 2;
    const size_t tstep = 2 * hstep;
    const unsigned ldsw = (unsigned)wid * 1024u;
    const int aoff = lds_byte(wr * 64 + fr, fq * 8), boff = lds_byte(wc * 32 + fr, fq * 8);
#define PG8_SA(b, h) (((b) * 2 + (h)) * HTB)
#define PG8_SB(b, h) ((4 + (b) * 2 + (h)) * HTB)
#define PG8_STAGE(bufoff, gbase, voff) do { _Pragma("unroll") for (int _i = 0; _i < 2; ++_i) \
        __builtin_amdgcn_global_load_lds((const unsigned*)((const char*)(gbase) + (voff)[_i]), (PG8_LAS unsigned*)(lds + (bufoff) + ldsw + _i * 8192), 16, 0, 0); } while (0)
#define PG8_LDA(dst, b, h) do { _Pragma("unroll") for (int m = 0; m < 4; ++m) _Pragma("unroll") for (int k = 0; k < 2; ++k) dst[m][k] = *(const PG8_LAS bf16x8*)(lds + PG8_SA(b, h) + aoff + m * 2048 + k * 1024); } while (0)
#define PG8_LDB(dst, b, h) do { _Pragma("unroll") for (int n = 0; n < 2; ++n) _Pragma("unroll") for (int k = 0; k < 2; ++k) dst[n][k] = *(const PG8_LAS bf16x8*)(lds + PG8_SB(b, h) + boff + n * 2048 + k * 1024); } while (0)
#define PG8_MMA(ai, bj, At, Bt) do { __builtin_amdgcn_s_setprio(1); _Pragma("unroll") for (int m = 0; m < 4; ++m) _Pragma("unroll") for (int n = 0; n < 2; ++n) _Pragma("unroll") for (int k = 0; k < 2; ++k) \
        acc[ai][bj][m][n] = __builtin_amdgcn_mfma_f32_16x16x32_bf16(Bt[n][k], At[m][k], acc[ai][bj][m][n], 0, 0, 0); __builtin_amdgcn_s_setprio(0); } while (0)
#define PG8_WAIT_V(n) asm volatile("s_waitcnt vmcnt(" #n ")" ::: "memory")
#define PG8_WAIT_L(n) asm volatile("s_waitcnt lgkmcnt(" #n ")" ::: "memory")
#define PG8_BAR __builtin_amdgcn_s_barrier()
#define PG8_SCHED __builtin_amdgcn_sched_barrier(0)
    Unit cur, nxt; int ui = 0;
    if (!S.next(0, cur)) return;
    f32x4 acc[2][2][4][2];
#pragma unroll
    for (int a = 0; a < 2; ++a)
#pragma unroll
        for (int b = 0; b < 2; ++b)
#pragma unroll
            for (int m = 0; m < 4; ++m)
#pragma unroll
                for (int n = 0; n < 2; ++n) acc[a][b][m][n] = (f32x4){0.f, 0.f, 0.f, 0.f};
    bf16x8 At[4][2], B0[2][2], B1[2][2];
    const char* cA = (const char*)g.A + (size_t)cur.pm * tstep; const char* cB = (const char*)g.Bt + (size_t)cur.pn * tstep;
    S.a_ready(cur);
    if constexpr (SP2) {
        PG8_STAGE(PG8_SB(0, 0), cB, voffB); PG8_STAGE(PG8_SB(0, 1), cB + hstep, voffB); PG8_STAGE(PG8_SA(0, 0), cA, voffA); PG8_STAGE(PG8_SA(0, 1), cA + hstep, voffA);
        if (wr == 1) PG8_BAR;
        PG8_WAIT_V(2); PG8_BAR;
        PG8_STAGE(PG8_SB(1, 0), cB + kstep, voffB); PG8_STAGE(PG8_SA(1, 0), cA + kstep, voffA); PG8_STAGE(PG8_SB(1, 1), cB + hstep + kstep, voffB);
        PG8_WAIT_V(6); PG8_BAR;
    } else {
        PG8_STAGE(PG8_SB(0, 0), cB, voffB); PG8_STAGE(PG8_SA(0, 0), cA, voffA); PG8_STAGE(PG8_SB(0, 1), cB + hstep, voffB); PG8_STAGE(PG8_SA(0, 1), cA + hstep, voffA);
        if (wr == 1) PG8_BAR;
        PG8_WAIT_V(4); PG8_BAR;
        PG8_STAGE(PG8_SB(1, 0), cB + kstep, voffB); PG8_STAGE(PG8_SA(1, 0), cA + kstep, voffA); PG8_STAGE(PG8_SB(1, 1), cB + hstep + kstep, voffB);
        PG8_WAIT_V(6); PG8_BAR;
    }
    for (;;) {
        const bool has_next = S.next(ui + 1, nxt);
        const char* nA = has_next ? (const char*)g.A + (size_t)nxt.pm * tstep : cA; const char* nB = has_next ? (const char*)g.Bt + (size_t)nxt.pn * tstep : cB;
        for (int t = 0; t < nt; t += 2) {
            const bool last = (t == nt - 2);
            const char* a1 = cA + (size_t)(t + 1) * kstep;
            const char* a2 = last ? nA : cA + (size_t)(t + 2) * kstep; const char* b2 = last ? nB : cB + (size_t)(t + 2) * kstep;
            const char* a3 = a2 + kstep; const char* b3 = b2 + kstep;
            if (last && has_next) S.a_ready(nxt);
            if constexpr (SP2) {
            PG8_LDB(B0, 0, 0); PG8_LDB(B1, 0, 1); PG8_SCHED; PG8_LDA(At, 0, 0); PG8_STAGE(PG8_SA(1, 1), a1 + hstep, voffA);
            PG8_WAIT_V(8); PG8_WAIT_L(0); PG8_BAR; PG8_MMA(0, 0, At, B0); PG8_MMA(0, 1, At, B1); PG8_BAR; PG8_SCHED;
            PG8_LDA(At, 0, 1); PG8_STAGE(PG8_SB(0, 0), b2, voffB); PG8_STAGE(PG8_SB(0, 1), b2 + hstep, voffB); PG8_STAGE(PG8_SA(0, 0), a2, voffA);
            PG8_WAIT_V(8); PG8_WAIT_L(0); PG8_BAR; PG8_MMA(1, 0, At, B0); PG8_MMA(1, 1, At, B1); PG8_BAR; PG8_SCHED;
            PG8_LDB(B0, 1, 0); PG8_LDB(B1, 1, 1); PG8_SCHED; PG8_LDA(At, 1, 0); PG8_STAGE(PG8_SA(0, 1), a2 + hstep, voffA);
            PG8_WAIT_V(8); PG8_WAIT_L(0); PG8_BAR; PG8_MMA(0, 0, At, B0); PG8_MMA(0, 1, At, B1); PG8_BAR; PG8_SCHED;
            PG8_LDA(At, 1, 1); PG8_STAGE(PG8_SB(1, 0), b3, voffB); PG8_STAGE(PG8_SB(1, 1), b3 + hstep, voffB); PG8_STAGE(PG8_SA(1, 0), a3, voffA);
            PG8_WAIT_V(8); PG8_WAIT_L(0); PG8_BAR; PG8_MMA(1, 0, At, B0); PG8_MMA(1, 1, At, B1); PG8_BAR; PG8_SCHED;
            } else {
            PG8_LDB(B0, 0, 0); PG8_SCHED; PG8_LDA(At, 0, 0); PG8_STAGE(PG8_SA(1, 1), a1 + hstep, voffA);
            PG8_WAIT_L(8); PG8_BAR; PG8_WAIT_L(0); PG8_MMA(0, 0, At, B0); PG8_BAR; PG8_SCHED;
            PG8_LDB(B1, 0, 1); PG8_STAGE(PG8_SB(0, 0), b2, voffB);
            PG8_BAR; PG8_WAIT_L(0); PG8_MMA(0, 1, At, B1); PG8_BAR;
            PG8_LDA(At, 0, 1); PG8_STAGE(PG8_SA(0, 0), a2, voffA);
            PG8_BAR; PG8_WAIT_L(0); PG8_MMA(1, 0, At, B0); PG8_BAR; PG8_SCHED;
            PG8_STAGE(PG8_SB(0, 1), b2 + hstep, voffB);
            PG8_WAIT_V(6); PG8_BAR; PG8_MMA(1, 1, At, B1); PG8_BAR;
            PG8_LDB(B0, 1, 0); PG8_SCHED; PG8_LDA(At, 1, 0); PG8_STAGE(PG8_SA(0, 1), a2 + hstep, voffA);
            PG8_WAIT_L(8); PG8_BAR; PG8_WAIT_L(0); PG8_MMA(0, 0, At, B0); PG8_BAR; PG8_SCHED;
            PG8_LDB(B1, 1, 1); PG8_STAGE(PG8_SB(1, 0), b3, voffB);
            PG8_BAR; PG8_WAIT_L(0); PG8_MMA(0, 1, At, B1); PG8_BAR;
            PG8_LDA(At, 1, 1); PG8_STAGE(PG8_SA(1, 0), a3, voffA);
            PG8_BAR; PG8_WAIT_L(0); PG8_MMA(1, 0, At, B0); PG8_BAR; PG8_SCHED;
            PG8_STAGE(PG8_SB(1, 1), b3 + hstep, voffB);
            PG8_WAIT_V(6); PG8_BAR; PG8_MMA(1, 1, At, B1); PG8_BAR;
            }
        }
        if constexpr (ALIGN_EPI) { if (wr == 0) PG8_BAR; }
        if constexpr (!Epi::AFTER_DRAIN) { E(acc, cur, wr, wc, fr, fq); S.done(cur); }
        if (!has_next) break;
#pragma unroll
        for (int a = 0; a < 2; ++a)
#pragma unroll
            for (int b = 0; b < 2; ++b)
#pragma unroll
                for (int m = 0; m < 4; ++m)
#pragma unroll
                    for (int n = 0; n < 2; ++n) acc[a][b][m][n] = (f32x4){0.f, 0.f, 0.f, 0.f};
        cur = nxt; cA = nA; cB = nB; ++ui;
        if constexpr (ALIGN_EPI) { if (wr == 1) PG8_BAR; }
    }
    PG8_WAIT_V(0);
    if constexpr (!ALIGN_EPI) { if (wr == 0) PG8_BAR; }
    PG8_BAR;
    if constexpr (Epi::AFTER_DRAIN) { E.fused(acc, cur, wr, wc, fr, fq, lds, wid, lane); S.done(cur); }
#undef PG8_SA
#undef PG8_SB
#undef PG8_STAGE
#undef PG8_LDA
#undef PG8_LDB
#undef PG8_MMA
#undef PG8_WAIT_V
#undef PG8_WAIT_L
#undef PG8_BAR
#undef PG8_SCHED
}
}
#define XB_TMO      128
#define XB_XCNT(j)  (256  + 64 * (j))
#define XB_XSUB(j)  (1280 + 64 * (j))
#define XB_XGEN(j)  (2304 + 64 * (j))
#define XB_TOP      3328
#define XB_TOPGEN   3392
#define XCD_BAR_WORDS 3456
#define XB_SPIN_CAP (1u << 18)

__device__ __forceinline__ unsigned xb_ld(unsigned* p)              { return __hip_atomic_load(p, __ATOMIC_RELAXED, __HIP_MEMORY_SCOPE_AGENT); }
__device__ __forceinline__ unsigned xb_add(unsigned* p, unsigned v) { return __hip_atomic_fetch_add(p, v, __ATOMIC_RELAXED, __HIP_MEMORY_SCOPE_AGENT); }
__device__ __forceinline__ unsigned xb_xcc_id() { return (unsigned)__builtin_amdgcn_s_getreg((3 << 11) | 20) & 0xFu; }
#define XB_SPIN(cond, bar) do { unsigned _sp = 0; while (cond) { __builtin_amdgcn_s_sleep(1); \
    if ((++_sp & 255u) == 0u) { if (xb_ld(&(bar)[XB_TMO])) break; if (_sp > XB_SPIN_CAP) { atomicAdd(&(bar)[XB_TMO], 1u); break; } } } } while (0)

struct XcdBarrier {
    unsigned* bar; unsigned x;
    volatile LAS unsigned* st;
};

__device__ __forceinline__ XcdBarrier xcd_barrier_post(unsigned* bar, volatile LAS unsigned* st) {
    XcdBarrier b; b.bar = bar; b.x = xb_xcc_id(); b.st = st;
    if (threadIdx.x == 0) (void)xb_add(&bar[XB_XCNT(b.x)], 1u);
    return b;
}
__device__ __forceinline__ void xcd_barrier_complete(unsigned* bar, unsigned x, unsigned& nloc, unsigned& nx) {
    const unsigned G = gridDim.x * gridDim.y * gridDim.z;
    unsigned sum, cnt, mine, sp = 0u;
    for (;;) {
        sum = 0u; cnt = 0u; mine = 0u;
#pragma unroll
        for (unsigned j = 0; j < 16; ++j) { const unsigned c = xb_ld(&bar[XB_XCNT(j)]); sum += c; cnt += (c > 0u) ? 1u : 0u; mine = (j == x) ? c : mine; }
        if (sum == G) break;
        __builtin_amdgcn_s_sleep(1);
        if ((++sp & 255u) == 0u) { if (xb_ld(&bar[XB_TMO])) break; if (sp > XB_SPIN_CAP) { atomicAdd(&bar[XB_TMO], 1u); break; } }
    }
    nloc = mine > 0u ? mine : 1u; nx = cnt > 0u ? cnt : 1u;
}

__device__ __forceinline__ void xcd_barrier(const XcdBarrier& b) {
    asm volatile("s_waitcnt vmcnt(0)" ::: "memory");
    __syncthreads();
    if (threadIdx.x == 0) {
        unsigned* bar = b.bar;
        __builtin_amdgcn_s_waitcnt(0);
        unsigned nloc = b.st[0], nx = b.st[1];
        if (nloc == 0u) { xcd_barrier_complete(bar, b.x, nloc, nx); b.st[0] = nloc; b.st[1] = nx; }
        const unsigned old = xb_add(&bar[XB_XSUB(b.x)], 1u);
        const unsigned gen = old / nloc;
        if (old + 1u == (gen + 1u) * nloc) {
            __builtin_amdgcn_fence(__ATOMIC_RELEASE, "agent");
            asm volatile("s_waitcnt vmcnt(0)" ::: "memory");
            const unsigned og = xb_add(&bar[XB_TOP], 1u);
            const unsigned tg = og / nx;
            if (og + 1u == (tg + 1u) * nx) xb_add(&bar[XB_TOPGEN], 1u);
            else XB_SPIN(xb_ld(&bar[XB_TOPGEN]) == tg, bar);
            __builtin_amdgcn_fence(__ATOMIC_ACQUIRE, "agent");
            xb_add(&bar[XB_XGEN(b.x)], 1u);
            asm volatile("s_waitcnt vmcnt(0)" ::: "memory");
        } else {
            XB_SPIN(xb_ld(&bar[XB_XGEN(b.x)]) == gen, bar);
            __builtin_amdgcn_fence(__ATOMIC_ACQUIRE, "agent");
            asm volatile("s_waitcnt vmcnt(0)" ::: "memory");
        }
    }
    __syncthreads();
}

DI int crow16(int reg, int hf) { return (reg & 3) + 8 * (reg >> 2) + 4 * hf; }
DI unsigned cvtpk(float lo, float hi) { typedef float f2 __attribute__((ext_vector_type(2))); typedef __bf16 b2 __attribute__((ext_vector_type(2))); f2 v = {lo, hi}; b2 b = __builtin_convertvector(v, b2); return __builtin_bit_cast(unsigned, b); }
struct AttnP { const bf16_t* Q; const bf16_t* K; const bf16_t* VT; const bf16_t* Gt; bf16_t* Y; const float* relb; };

template <int MODE> DI void attn_unit(int unit, const AttnP& P, int lane) {
    const int ql = lane & 31, hf = lane >> 5;
    int b, h, kvh, qrow, NT, rp = 0, ci = 0, rs0 = 0, c0 = 0, qr = 0, qc = 0, rsq = 0, csq = 0;
    if (MODE == 0) { ci = unit & 3; rp = (unit >> 2) & 31; h = (unit >> 7) & 7; b = unit >> 10; kvh = h;
        qr = 2 * rp + (ql >> 4); qc = 16 * ci + (ql & 15); qrow = b * SEQ + qr * 64 + qc;
        rs0 = min(max(2 * rp - 4, 0), 56); const int rs1 = min(max(2 * rp - 3, 0), 56); NT = 8 + (rs1 + 8 - rs0);
        c0 = min(max(16 * ci - 8, 0), 32); rsq = min(max(qr - 4, 0), 56); csq = min(max(qc - 8, 0), 48);
    } else if (MODE == 1) { const int qt = unit & 7; h = (unit >> 3) & 7; b = unit >> 6; kvh = h; qrow = NLAT + b * LC + 32 * qt + ql; NT = 8; }
    else { const int qt = unit & 127; h = (unit >> 7) & 7; b = unit >> 10; kvh = h >> 2; qrow = b * SEQ + 32 * qt + ql; NT = POSN / 32; }
    const bf16_t* qp; const bf16_t* kb; size_t kpitch; const bf16_t* vt; const bf16_t* gp; bf16_t* yp;
    if (MODE == 2) { qp = P.Q + ((size_t)(b * 8 + h) * SEQ + (qrow - b * SEQ)) * 64; kb = P.K + (size_t)(b * 2 + kvh) * POSN * 64; kpitch = 64;
        vt = P.VT + (size_t)(b * 2 + kvh) * 64 * POSN; gp = P.Gt + (size_t)qrow * N1 + 1792 + h * 64; }
    else { qp = P.Q + (size_t)qrow * N0 + 1024 + h * 64; kb = P.K + 1536 + h * 64; kpitch = N0; vt = P.VT + (size_t)(b * 8 + h) * 64 * POSN; gp = P.Gt + (size_t)qrow * N0 + 2560 + h * 64; }
    yp = P.Y + (size_t)qrow * DM + 512 + h * 64;
    bf16x8_t qf[4];
#pragma unroll
    for (int ks = 0; ks < 4; ++ks) qf[ks] = *(const bf16x8_t*)(qp + 16 * ks + 8 * hf);
    const bf16_t* vt0 = vt + (size_t)ql * POSN + 4 * hf;
    f32x16_t o0 = {}, o1 = {};
    float m = -1e30f, l = 0.f;
    auto tile_krow = [&](int t) -> int { if (MODE == 2) return 32 * t + ql; if (t < 8) return NLAT + b * LC + 32 * t + ql; return b * SEQ + (rs0 + t - 8) * 64 + c0 + ql; };
    auto tile_pos0 = [&](int t) -> int { if (MODE == 2) return 32 * t; if (t < 8) return 32 * t; return LC + (rs0 + t - 8) * 64 + c0; };
    bf16x8_t kn[4];
    { const bf16_t* kp = kb + (size_t)tile_krow(0) * kpitch + 8 * hf;
#pragma unroll
      for (int ks = 0; ks < 4; ++ks) kn[ks] = *(const bf16x8_t*)(kp + 16 * ks); }
#pragma unroll 1
    for (int t = 0; t < NT; ++t) {
        bf16x8_t kf[4];
#pragma unroll
        for (int ks = 0; ks < 4; ++ks) kf[ks] = kn[ks];
        if (t + 1 < NT) { const bf16_t* kp = kb + (size_t)tile_krow(t + 1) * kpitch + 8 * hf;
#pragma unroll
            for (int ks = 0; ks < 4; ++ks) kn[ks] = *(const bf16x8_t*)(kp + 16 * ks); }
        const bf16_t* vp = vt0 + tile_pos0(t);
        s16x4_t va[2][2][2];
#pragma unroll
        for (int dt = 0; dt < 2; ++dt)
#pragma unroll
            for (int s = 0; s < 2; ++s) { va[dt][s][0] = *(const s16x4_t*)(vp + (size_t)dt * 32 * POSN + 16 * s); va[dt][s][1] = *(const s16x4_t*)(vp + (size_t)dt * 32 * POSN + 16 * s + 8); }
        f32x16_t sc = {};
#pragma unroll
        for (int ks = 0; ks < 4; ++ks) sc = __builtin_amdgcn_mfma_f32_32x32x16_bf16(kf[ks], qf[ks], sc, 0, 0, 0);
        float xs[16];
        if (MODE == 0 && t >= 8) {
            const int kr = rs0 + t - 8; const bool row_ok = (kr >= rsq) && (kr < rsq + 8);
            const float* rb = P.relb + (h * 15 + (kr - qr + 7)) * 31 + (15 - qc);
#pragma unroll
            for (int r = 0; r < 16; ++r) { const int kc = c0 + crow16(r, hf); const bool ok = row_ok && (kc >= csq) && (kc < csq + 16);
                const float bias = ok ? rb[kc] : 0.f; xs[r] = ok ? (sc[r] * 0.125f + bias) * LOG2E : -1e30f; }
        } else {
#pragma unroll
            for (int r = 0; r < 16; ++r) xs[r] = (MODE == 2) ? sc[r] : sc[r] * (0.125f * LOG2E);
        }
        float tm = xs[0];
#pragma unroll
        for (int r = 1; r < 16; ++r) tm = fmaxf(tm, xs[r]);
        tm = fmaxf(tm, __shfl_xor(tm, 32));
        const float mn = fmaxf(m, tm), al = __builtin_amdgcn_exp2f(m - mn);
        float ps = 0.f;
#pragma unroll
        for (int r = 0; r < 16; ++r) { xs[r] = __builtin_amdgcn_exp2f(xs[r] - mn); ps += xs[r]; }
        l = l * al + ps; m = mn;
#pragma unroll
        for (int r = 0; r < 16; ++r) { o0[r] *= al; o1[r] *= al; }
        bf16x8_t pf[2];
#pragma unroll
        for (int s = 0; s < 2; ++s) { v4u w; w.x = cvtpk(xs[8 * s], xs[8 * s + 1]); w.y = cvtpk(xs[8 * s + 2], xs[8 * s + 3]); w.z = cvtpk(xs[8 * s + 4], xs[8 * s + 5]); w.w = cvtpk(xs[8 * s + 6], xs[8 * s + 7]);
            pf[s] = __builtin_bit_cast(bf16x8_t, w); }
#pragma unroll
        for (int s = 0; s < 2; ++s) {
            const bf16x8_t a0 = __builtin_shufflevector(va[0][s][0], va[0][s][1], 0, 1, 2, 3, 4, 5, 6, 7);
            const bf16x8_t a1 = __builtin_shufflevector(va[1][s][0], va[1][s][1], 0, 1, 2, 3, 4, 5, 6, 7);
            o0 = __builtin_amdgcn_mfma_f32_32x32x16_bf16(a0, pf[s], o0, 0, 0, 0);
            o1 = __builtin_amdgcn_mfma_f32_32x32x16_bf16(a1, pf[s], o1, 0, 0, 0);
        }
    }
    l += __shfl_xor(l, 32);
    const float rl = 1.f / l;
#pragma unroll
    for (int dt = 0; dt < 2; ++dt)
#pragma unroll
        for (int rg = 0; rg < 4; ++rg) { const int d = 32 * dt + 8 * rg + 4 * hf;
            const v2u gv = *(const v2u*)(gp + d);
            const float g0 = silu_f(bflo(gv.x)), g1 = silu_f(bfhi(gv.x)), g2 = silu_f(bflo(gv.y)), g3 = silu_f(bfhi(gv.y));
            const f32x16_t& oo = dt ? o1 : o0;
            v2u w; w.x = pk2(oo[4 * rg] * rl * g0, oo[4 * rg + 1] * rl * g1); w.y = pk2(oo[4 * rg + 2] * rl * g2, oo[4 * rg + 3] * rl * g3);
            *(v2u*)(yp + d) = w; }
}

typedef float f32x2_t __attribute__((ext_vector_type(2)));
constexpr int LRU_NCOL = 272;
struct LruP { const bf16_t* P1; const float* conv_w; const float* conv_b; const float* lam; const float* b_a; const float* b_x; const bf16_t* WT; f32x2_t* SUM16; bf16_t* YMIX; };
constexpr int LRU_WTL = 0, LRU_CWL = 36864, LRU_BAX = LRU_CWL + 1280, LRU_XW = LRU_BAX + 1536, LRU_CARRY = LRU_XW + 8 * 4160, LRU_FOLD = LRU_CARRY + 16384;

DI void lru_setup(int nb, const LruP& p, LAS unsigned char* lds, int tid) {
    __syncthreads();
    for (int e = tid; e < 256 * 8; e += NTHREADS) { const int row = e >> 3, ch = e & 7; *(LAS v4u*)(lds + LRU_WTL + row * 144 + ch * 16) = *(const v4u*)(p.WT + (size_t)(nb * 256 + row) * 64 + ch * 8); }
    LAS float* CW = (LAS float*)(lds + LRU_CWL); LAS float* BAX = (LAS float*)(lds + LRU_BAX);
    if (tid < 320) CW[tid] = tid < 256 ? p.conv_w[(tid >> 6) * 512 + nb * 64 + (tid & 63)] : p.conv_b[nb * 64 + (tid & 63)];
    if (tid < 128) { const int dir = tid >> 6, ch = tid & 63; BAX[(dir * 3 + 0) * 64 + ch] = p.b_a[dir * 512 + nb * 64 + ch]; BAX[(dir * 3 + 1) * 64 + ch] = p.b_x[dir * 512 + nb * 64 + ch];
        BAX[(dir * 3 + 2) * 64 + ch] = log1pf(__expf(-p.lam[dir * 512 + nb * 64 + ch])); }
    __syncthreads();
}

template <bool PASS2> DI void lru_micro(int b, int col, int nb, int ci, const LruP& p, LAS unsigned char* lds, int wave, int lane) {
    const int n = lane & 15, q = lane >> 4;
    const int s0 = col < 16 ? NLAT + b * LC : b * SEQ, sl = col < 16 ? LC : SEQ, t0 = col < 16 ? col * 16 : (col - 16) * 16;
    LAS float* CW = (LAS float*)(lds + LRU_CWL); LAS float* BAX = (LAS float*)(lds + LRU_BAX); LAS float* XW = (LAS float*)(lds + LRU_XW + wave * 4160);
    v4u xr[4][2];
#pragma unroll
    for (int j = 0; j < 4; ++j) { const int tt = t0 + n + j - 1; const bool ok = tt >= 0 && tt < sl;
#pragma unroll
        for (int ks = 0; ks < 2; ++ks) { xr[j][ks] = (v4u){0u, 0u, 0u, 0u}; if (ok) xr[j][ks] = *(const v4u*)(p.P1 + (size_t)(s0 + tt) * N1 + nb * 64 + 32 * ks + 8 * q); } }
    bf16x8_t af[2];
#pragma unroll
    for (int ks = 0; ks < 2; ++ks) { const int c = 32 * ks + 8 * q;
        float xc[8];
        const f32x4_t bb0 = *(const LAS f32x4_t*)(CW + 256 + c), bb1 = *(const LAS f32x4_t*)(CW + 256 + c + 4);
#pragma unroll
        for (int e = 0; e < 4; ++e) { xc[e] = bb0[e]; xc[4 + e] = bb1[e]; }
#pragma unroll
        for (int j = 0; j < 4; ++j) { const f32x4_t w0 = *(const LAS f32x4_t*)(CW + j * 64 + c), w1 = *(const LAS f32x4_t*)(CW + j * 64 + c + 4); const v4u xx = xr[j][ks];
            xc[0] += w0[0] * bflo(xx.x); xc[1] += w0[1] * bfhi(xx.x); xc[2] += w0[2] * bflo(xx.y); xc[3] += w0[3] * bfhi(xx.y);
            xc[4] += w1[0] * bflo(xx.z); xc[5] += w1[1] * bfhi(xx.z); xc[6] += w1[2] * bflo(xx.w); xc[7] += w1[3] * bfhi(xx.w); }
        v4u w; w.x = pk2(xc[0], xc[1]); w.y = pk2(xc[2], xc[3]); w.z = pk2(xc[4], xc[5]); w.w = pk2(xc[6], xc[7]); af[ks] = __builtin_bit_cast(bf16x8_t, w);
#pragma unroll
        for (int e = 0; e < 8; ++e) XW[n * 65 + c + e] = xc[e]; }
    float hsum[4][4];
#pragma unroll
    for (int c4 = 0; c4 < 4; ++c4)
#pragma unroll
        for (int r = 0; r < 4; ++r) hsum[c4][r] = 0.f;
#pragma unroll 1
    for (int dir = 0; dir < 2; ++dir) {
        f32x4_t acc[8];
#pragma unroll
        for (int nt = 0; nt < 8; ++nt) { acc[nt] = (f32x4_t){0.f, 0.f, 0.f, 0.f};
            const LAS unsigned char* wrow = lds + LRU_WTL + ((dir * 2 + (nt >> 2)) * 64 + (nt & 3) * 16 + n) * 144 + 16 * q;
#pragma unroll
            for (int ks = 0; ks < 2; ++ks) { const bf16x8_t bfr = *(const LAS bf16x8_t*)(wrow + 64 * ks); acc[nt] = __builtin_amdgcn_mfma_f32_16x16x32_bf16(af[ks], bfr, acc[nt], 0, 0, 0); } }
        float a[4][4], bt[4][4];
#pragma unroll
        for (int c4 = 0; c4 < 4; ++c4) { const int ch = c4 * 16 + n;
            const float ba = BAX[(dir * 3 + 0) * 64 + ch], bx = BAX[(dir * 3 + 1) * 64 + ch], sp = BAX[(dir * 3 + 2) * 64 + ch];
#pragma unroll
            for (int r = 0; r < 4; ++r) { const float gr = sigmoid_f(acc[c4][r] + ba), gi = sigmoid_f(acc[c4 + 4][r] + bx);
                const float log_a = -8.f * gr * sp; const float av = __builtin_amdgcn_exp2f(log_a * LOG2E); a[c4][r] = av;
                const float x2 = 2.f * log_a;
                const float ser = -x2 * (1.f + x2 * (0.5f + x2 * (0.16666667f + x2 * (0.041666668f + x2 * 0.0083333338f))));
                const float om = x2 > -0.5f ? ser : 1.f - av * av;
                bt[c4][r] = __builtin_amdgcn_sqrtf(fmaxf(om, 0.f)) * gi * XW[(4 * q + r) * 65 + ch]; } }
        float Pq[4], Sq[4];
#pragma unroll
        for (int c4 = 0; c4 < 4; ++c4) { float P = 1.f, S = 0.f;
#pragma unroll
            for (int rr = 0; rr < 4; ++rr) { const int r = dir == 0 ? rr : 3 - rr; S = a[c4][r] * S + bt[c4][r]; P *= a[c4][r]; }
            Pq[c4] = P; Sq[c4] = S; }
        float Pin[4], Sin[4];
#pragma unroll
        for (int c4 = 0; c4 < 4; ++c4) { float P = 1.f, S = 0.f, Pw = 1.f, Sw = 0.f;
#pragma unroll
            for (int kk = 0; kk < 4; ++kk) { const int k = dir == 0 ? kk : 3 - kk;
                const float pk = __shfl(Pq[c4], n + 16 * k), sk = __shfl(Sq[c4], n + 16 * k);
                const bool before = dir == 0 ? (k < q) : (k > q);
                if (before) { S = pk * S + sk; P *= pk; }
                Sw = pk * Sw + sk; Pw *= pk; }
            Pin[c4] = P; Sin[c4] = S;
            if (!PASS2 && q == 0) p.SUM16[((size_t)((b * 8 + nb) * LRU_NCOL + col) * 2 + dir) * 64 + c4 * 16 + n] = (f32x2_t){Pw, Sw}; }
        if (PASS2) {
            const LAS float* CARRYL = (const LAS float*)(lds + LRU_CARRY);
#pragma unroll
            for (int c4 = 0; c4 < 4; ++c4) { float h = CARRYL[(dir * 32 + ci) * 64 + c4 * 16 + n];
                h = Pin[c4] * h + Sin[c4];
#pragma unroll
                for (int rr = 0; rr < 4; ++rr) { const int r = dir == 0 ? rr : 3 - rr; h = a[c4][r] * h + bt[c4][r]; hsum[c4][r] += h; } }
        }
    }
    if (PASS2) {
        asm volatile("s_waitcnt lgkmcnt(0)" ::: "memory");
#pragma unroll
        for (int c4 = 0; c4 < 4; ++c4)
#pragma unroll
            for (int r = 0; r < 4; ++r) XW[(4 * q + r) * 65 + c4 * 16 + n] = hsum[c4][r];
        asm volatile("s_waitcnt lgkmcnt(0)" ::: "memory");
        const int tk = lane >> 2, cg = lane & 3; const size_t row = (size_t)(s0 + t0 + tk);
        const bf16_t* gp = p.P1 + row * N1 + 512 + nb * 64 + cg * 16;
        const v4u g0 = *(const v4u*)gp, g1 = *(const v4u*)(gp + 8);
        float y[16];
#pragma unroll
        for (int e = 0; e < 16; ++e) y[e] = XW[tk * 65 + cg * 16 + e];
        v4u o0, o1;
        o0.x = pk2(y[0] * silu_f(bflo(g0.x)), y[1] * silu_f(bfhi(g0.x))); o0.y = pk2(y[2] * silu_f(bflo(g0.y)), y[3] * silu_f(bfhi(g0.y)));
        o0.z = pk2(y[4] * silu_f(bflo(g0.z)), y[5] * silu_f(bfhi(g0.z))); o0.w = pk2(y[6] * silu_f(bflo(g0.w)), y[7] * silu_f(bfhi(g0.w)));
        o1.x = pk2(y[8] * silu_f(bflo(g1.x)), y[9] * silu_f(bfhi(g1.x))); o1.y = pk2(y[10] * silu_f(bflo(g1.y)), y[11] * silu_f(bfhi(g1.y)));
        o1.z = pk2(y[12] * silu_f(bflo(g1.z)), y[13] * silu_f(bfhi(g1.z))); o1.w = pk2(y[14] * silu_f(bflo(g1.w)), y[15] * silu_f(bfhi(g1.w)));
        bf16_t* yp = p.YMIX + row * DM + nb * 64 + cg * 16;
        *(v4u*)yp = o0; *(v4u*)(yp + 8) = o1;
    }
    asm volatile("s_waitcnt lgkmcnt(0)" ::: "memory");
}

DI int lru_order_col(int dir, int k) { return dir == 0 ? k : (k < 16 ? 15 - k : 16 + (271 - k)); }

DI void lru_block(int blk, bool pass2, const LruP& p, LAS unsigned char* lds, int tid, int wave, int lane) {
    const int nb = blk & 7, b = (blk >> 3) & 3, cr = blk >> 5;
    lru_setup(nb, p, lds, tid);
    if (!pass2) {
        for (int i = wave; i < 34; i += NWAVES) { const int col = i < 32 ? 16 + 32 * cr + i : 2 * cr + (i - 32); lru_micro<false>(b, col, nb, 0, p, lds, wave, lane); }
        return;
    }
    LAS float* CARRYL = (LAS float*)(lds + LRU_CARRY); LAS f32x2_t* FOLD = (LAS f32x2_t*)(lds + LRU_FOLD);
    const int chain = tid & 127, part = tid >> 7, dir = chain >> 6, ch = chain & 63;
    const f32x2_t* SB = p.SUM16 + (size_t)(b * 8 + nb) * LRU_NCOL * 128 + dir * 64 + ch;
    const int kfirst = dir == 0 ? 16 + 32 * cr : 240 - 32 * cr;
    { const int k0 = (kfirst * part) >> 2, k1 = (kfirst * (part + 1)) >> 2;
      float P = 1.f, S = 0.f;
#pragma unroll 4
      for (int k = k0; k < k1; ++k) { const f32x2_t s = SB[(size_t)lru_order_col(dir, k) * 128]; S = s[0] * S + s[1]; P *= s[0]; }
      FOLD[part * 128 + chain] = (f32x2_t){P, S}; }
    __syncthreads();
    if (part == 0) { float S = 0.f;
#pragma unroll
        for (int pp = 0; pp < 4; ++pp) { const f32x2_t s = FOLD[pp * 128 + chain]; S = s[0] * S + s[1]; }
        for (int i = 0; i < 32; ++i) { const int col = lru_order_col(dir, kfirst + i), ci = col - (16 + 32 * cr);
            CARRYL[(dir * 32 + ci) * 64 + ch] = S; const f32x2_t s = SB[(size_t)col * 128]; S = s[0] * S + s[1]; } }
    __syncthreads();
    for (int i = wave; i < 32; i += NWAVES) lru_micro<true>(b, 16 + 32 * cr + i, nb, i, p, lds, wave, lane);
}

DI float row16_sum(float v) {
    v += __builtin_bit_cast(float, __builtin_amdgcn_update_dpp(0, __builtin_bit_cast(int, v), 0xB1, 0xf, 0xf, false));
    v += __builtin_bit_cast(float, __builtin_amdgcn_update_dpp(0, __builtin_bit_cast(int, v), 0x4E, 0xf, 0xf, false));
    v += __builtin_bit_cast(float, __builtin_amdgcn_update_dpp(0, __builtin_bit_cast(int, v), 0x141, 0xf, 0xf, false));
    v += __builtin_bit_cast(float, __builtin_amdgcn_update_dpp(0, __builtin_bit_cast(int, v), 0x140, 0xf, 0xf, false));
    return v;
}
DI void qkprep_row(int r, const bf16_t* P1, const float* qn, const float* kn, const float* ROPE, bf16_t* QP, bf16_t* KP, int lane) {
    const int b = row_batch(r); const bool lat = r < NLAT; const int t = r & 4095, l16 = lane & 15, hh = lane >> 4;
    f32x4_t cs = {1.f, 0.f, 1.f, 0.f};
    if (lat) cs = *(const f32x4_t*)(ROPE + ((size_t)t * 32 + 2 * l16) * 2);
    const f32x4_t wq = *(const f32x4_t*)(qn + 4 * l16), wk = *(const f32x4_t*)(kn + 4 * l16);
#pragma unroll
    for (int hg = 0; hg < 3; ++hg) {
        if (hg < 2 && !lat) continue;
        const int slot = hg < 2 ? hg * 4 + hh : 8 + (hh & 1);
        const int col0 = slot < 8 ? 1024 + slot * 64 : 1536 + (slot - 8) * 64;
        const v2u xx = *(const v2u*)(P1 + (size_t)r * N1 + col0 + 4 * l16);
        float x[4] = {bflo(xx.x), bfhi(xx.x), bflo(xx.y), bfhi(xx.y)};
        const float ss = row16_sum(x[0] * x[0] + x[1] * x[1] + x[2] * x[2] + x[3] * x[3]);
        const float rinv = rsqrtf(ss * (1.f / 64.f) + EPSN);
        const f32x4_t w = hg < 2 ? wq : wk;
#pragma unroll
        for (int e = 0; e < 4; ++e) x[e] *= rinv * w[e];
        const float y0 = x[0] * cs[0] - x[1] * cs[1], y1 = x[0] * cs[1] + x[1] * cs[0], y2 = x[2] * cs[2] - x[3] * cs[3], y3 = x[2] * cs[3] + x[3] * cs[2];
        if (hg < 2) { const float sc = 0.125f * LOG2E; v2u o; o.x = pk2(y0 * sc, y1 * sc); o.y = pk2(y2 * sc, y3 * sc); *(v2u*)(QP + ((size_t)(b * 8 + slot) * SEQ + t) * 64 + 4 * l16) = o; }
        else if (hh < 2) { v2u o; o.x = pk2(y0, y1); o.y = pk2(y2, y3); *(v2u*)(KP + ((size_t)(b * 2 + (slot - 8)) * POSN + row_pos(r)) * 64 + 4 * l16) = o; }
    }
}

constexpr size_t WS_CARRY0 = 246 * MiB;
constexpr int S5_NCOL = 272;

DI void s5_lambar_pow(double lre, double lim, double dt, int e, double& pr, double& pi) { const double mag = exp(lre * dt * e), ang = lim * dt * e; pr = mag * cos(ang); pi = mag * sin(ang); }
typedef double f64x2_t __attribute__((ext_vector_type(2)));
DI void s5_tables_block(int gd, const float* lam_re, const float* lam_im, const float* log_dt, const float* b_re, const float* b_im, const float* c_re, const float* c_im,
                        bf16_t* W16, bf16_t* WC, bf16_t* KT, float* L16, LAS unsigned char* lds, int tid) {
    const int g = gd >> 1, dir = gd & 1, gi = dir * 32 + g;
    LAS f64x2_t* POW = (LAS f64x2_t*)lds;
    LAS f64x2_t* PC = POW + 17 * 64;
    __syncthreads();
    const double dt = exp((double)log_dt[gi]);
    for (int idx = tid; idx < 17 * 64; idx += NTHREADS) { const int e = idx >> 6, p = idx & 63;
        const double lre = lam_re[gi * 64 + p], lim = lam_im[gi * 64 + p];
        double pr, pi, l1r, l1i; s5_lambar_pow(lre, lim, dt, e, pr, pi); s5_lambar_pow(lre, lim, dt, 1, l1r, l1i);
        const double nr = l1r - 1.0, ni = l1i, den = lre * lre + lim * lim, cfr = (nr * lre + ni * lim) / den, cfi = (ni * lre - nr * lim) / den;
        POW[idx] = (f64x2_t){pr, pi}; PC[idx] = (f64x2_t){pr * cfr - pi * cfi, pr * cfi + pi * cfr};
        if (e == 16) { L16[((g * 2 + dir) * 64 + p) * 2] = (float)pr; L16[((g * 2 + dir) * 64 + p) * 2 + 1] = (float)pi; } }
    __syncthreads();
    for (int idx = tid; idx < 128 * 256; idx += NTHREADS) { const int row = idx >> 8, k = idx & 255, p = row >> 1, c = row & 1, tp = k >> 4, hi = k & 15;
        const f64x2_t z = PC[(dir == 0 ? 15 - tp : tp) * 64 + p]; const double br = b_re[(gi * 64 + p) * 16 + hi], bi = b_im[(gi * 64 + p) * 16 + hi];
        W16[(size_t)(gd * 128 + row) * 256 + k] = f2bf((float)(c == 0 ? z[0] * br - z[1] * bi : z[0] * bi + z[1] * br)); }
    for (int idx = tid; idx < 256 * 128; idx += NTHREADS) { const int row = idx >> 7, k = idx & 127, p = k >> 1, c = k & 1, t = row >> 4, ho = row & 15;
        const f64x2_t z = POW[((dir == 0 ? t : 15 - t) + 1) * 64 + p]; const double cr = c_re[(gi * 16 + ho) * 64 + p], ci = c_im[(gi * 16 + ho) * 64 + p];
        WC[(size_t)(gd * 256 + row) * 128 + k] = f2bf((float)(c == 0 ? cr * z[0] - ci * z[1] : -(cr * z[1] + ci * z[0]))); }
    for (int idx = tid; idx < 4096; idx += NTHREADS) { const int tau = idx >> 8, ho = (idx >> 4) & 15, hi = idx & 15;
        double acc = 0.0;
        for (int p = 0; p < 64; ++p) { const f64x2_t z = PC[tau * 64 + p]; const double cr = c_re[(gi * 16 + ho) * 64 + p], ci = c_im[(gi * 16 + ho) * 64 + p];
            const double ar = cr * z[0] - ci * z[1], ai = cr * z[1] + ci * z[0];
            acc += ar * (double)b_re[(gi * 64 + p) * 16 + hi] - ai * (double)b_im[(gi * 64 + p) * 16 + hi]; }
        KT[(size_t)gd * 4096 + idx] = f2bf((float)acc); }
}

DI int s5_tile_row0(int b, int s) { return s == 0 ? NLAT + b * LC : b * SEQ + (s - 1) * 256; }
DI void cmul(float ar, float ai, float br, float bi, float& cr, float& ci) { cr = ar * br - ai * bi; ci = ar * bi + ai * br; }

DI void s5_scan_unit(int cu, int m, const bf16_t* PROJ, const bf16_t* W16, const float* L16, bf16_t* CARRY0, bf16_t* CARRY1, int lane) {
    const int dir = cu & 1, b = (cu >> 1) & 3, g = cu >> 3;
    const int n = lane & 15, q = lane >> 4;
    bf16x8_t wf[8];
#pragma unroll
    for (int ks = 0; ks < 8; ++ks) wf[ks] = *(const bf16x8_t*)(W16 + ((size_t)(g * 2 + dir) * 128 + m * 16 + n) * 256 + 32 * ks + 8 * q);
    float Lr[2][5], Li[2][5];
    float Lnr[2], Lni[2];
    float cr[2], ci[2];
#pragma unroll
    for (int st = 0; st < 2; ++st) { const int p = 8 * m + 2 * q + st;
        Lr[st][0] = L16[((g * 2 + dir) * 64 + p) * 2]; Li[st][0] = L16[((g * 2 + dir) * 64 + p) * 2 + 1];
#pragma unroll
        for (int k = 1; k < 5; ++k) cmul(Lr[st][k - 1], Li[st][k - 1], Lr[st][k - 1], Li[st][k - 1], Lr[st][k], Li[st][k]);
        float rr = 1.f, ri = 0.f;
#pragma unroll
        for (int k = 0; k < 5; ++k) if ((n + 1) & (1 << k)) { float tr, ti; cmul(rr, ri, Lr[st][k], Li[st][k], tr, ti); rr = tr; ri = ti; }
        Lnr[st] = rr; Lni[st] = ri; cr[st] = 0.f; ci[st] = 0.f; }
    bf16_t* CARRY = (dir == 0 ? CARRY0 : CARRY1) + (size_t)(b * 32 + g) * S5_NCOL * 128;
    const int jcol = dir == 0 ? n : 15 - n;
    bf16x8_t un[8];
    { const bf16_t* ub = PROJ + (size_t)(s5_tile_row0(b, 0) + jcol * 16 + (q >> 1)) * N0 + g * 16 + 8 * (q & 1);
#pragma unroll
      for (int ks = 0; ks < 8; ++ks) un[ks] = *(const bf16x8_t*)(ub + (size_t)(2 * ks) * N0); }
#pragma unroll 1
    for (int it = 0; it < 17; ++it) {
        const int s = it == 0 ? 0 : (dir == 0 ? it : 17 - it);
        bf16x8_t uf[8];
#pragma unroll
        for (int ks = 0; ks < 8; ++ks) uf[ks] = un[ks];
        if (it + 1 < 17) { const int sn = dir == 0 ? it + 1 : 16 - it;
            const bf16_t* ub = PROJ + (size_t)(s5_tile_row0(b, sn) + jcol * 16 + (q >> 1)) * N0 + g * 16 + 8 * (q & 1);
#pragma unroll
            for (int ks = 0; ks < 8; ++ks) un[ks] = *(const bf16x8_t*)(ub + (size_t)(2 * ks) * N0); }
        f32x4_t acc = {0.f, 0.f, 0.f, 0.f};
#pragma unroll
        for (int ks = 0; ks < 8; ++ks) acc = __builtin_amdgcn_mfma_f32_16x16x32_bf16(wf[ks], uf[ks], acc, 0, 0, 0);
        float hin[4];
#pragma unroll
        for (int st = 0; st < 2; ++st) {
            float xr = acc[2 * st], xi = acc[2 * st + 1];
#pragma unroll
            for (int k = 0; k < 4; ++k) { const int d = 1 << k; const float yr = __shfl_up(xr, d, 16), yi = __shfl_up(xi, d, 16);
                if (n >= d) { float tr, ti; cmul(Lr[st][k], Li[st][k], yr, yi, tr, ti); xr += tr; xi += ti; } }
            float tr, ti; cmul(Lnr[st], Lni[st], cr[st], ci[st], tr, ti);
            const float Hr = xr + tr, Hi = xi + ti;
            const float pr = __shfl_up(Hr, 1, 16), pi = __shfl_up(Hi, 1, 16);
            hin[2 * st] = n == 0 ? cr[st] : pr; hin[2 * st + 1] = n == 0 ? ci[st] : pi;
            cr[st] = __shfl(Hr, (lane & 48) | 15); ci[st] = __shfl(Hi, (lane & 48) | 15);
        }
        v2u w; w.x = pk2(hin[0], hin[1]); w.y = pk2(hin[2], hin[3]);
        *(v2u*)(CARRY + (size_t)(s * 16 + jcol) * 128 + m * 16 + 4 * q) = w;
    }
}

DI void s5_out_item(int g, int b, int s, const bf16_t* PROJ, const bf16_t* WC, const bf16_t* CARRY0, const bf16_t* CARRY1, const float* dsk, bf16_t* YPRE, LAS unsigned char* lds, int wave, int lane) {
    const int n = lane & 15, q = lane >> 4;
    const int row0 = s5_tile_row0(b, s);
    const bf16_t* ub = PROJ + (size_t)(row0 + n * 16 + (q >> 1)) * N0 + g * 16 + 8 * (q & 1);
    bf16x8_t uf[8];
#pragma unroll
    for (int ks = 0; ks < 8; ++ks) uf[ks] = *(const bf16x8_t*)(ub + (size_t)(2 * ks) * N0);
    bf16x8_t cf[2][4];
#pragma unroll
    for (int dir = 0; dir < 2; ++dir)
#pragma unroll
        for (int ks = 0; ks < 4; ++ks) cf[dir][ks] = *(const bf16x8_t*)((dir == 0 ? CARRY0 : CARRY1) + ((size_t)(b * 32 + g) * S5_NCOL + s * 16 + n) * 128 + 32 * ks + 8 * q);
    const LAS bf16_t* KTl = (const LAS bf16_t*)lds;
#pragma unroll
    for (int m2 = 0; m2 < 2; ++m2) {
        const int mt = 2 * wave + m2;
        f32x4_t acc = {0.f, 0.f, 0.f, 0.f};
#pragma unroll
        for (int dir = 0; dir < 2; ++dir) {
            const bf16_t* wc = WC + ((size_t)(g * 2 + dir) * 256 + mt * 16 + n) * 128 + 8 * q;
#pragma unroll
            for (int ks = 0; ks < 4; ++ks) { const bf16x8_t a = *(const bf16x8_t*)(wc + 32 * ks); acc = __builtin_amdgcn_mfma_f32_16x16x32_bf16(a, cf[dir][ks], acc, 0, 0, 0); }
#pragma unroll
            for (int ks = 0; ks < 8; ++ks) {
                const bool need = dir == 0 ? (2 * ks <= mt) : (2 * ks + 1 >= mt);
                if (need) { const int tp = 2 * ks + (q >> 1), tau = dir == 0 ? mt - tp : tp - mt;
                    bf16x8_t a = {0, 0, 0, 0, 0, 0, 0, 0};
                    if (tau >= 0) a = *(const LAS bf16x8_t*)(KTl + ((dir * 16 + tau) * 16 + n) * 16 + 8 * (q & 1));
                    acc = __builtin_amdgcn_mfma_f32_16x16x32_bf16(a, uf[ks], acc, 0, 0, 0); }
            }
        }
        const size_t tok = (size_t)(row0 + n * 16 + mt);
        const v2u uu = *(const v2u*)(PROJ + tok * N0 + g * 16 + 4 * q);
        const f32x4_t dd = *(const f32x4_t*)(dsk + g * 16 + 4 * q);
        const float y0 = gelu_fast(acc[0] + dd[0] * bflo(uu.x)), y1 = gelu_fast(acc[1] + dd[1] * bfhi(uu.x)), y2 = gelu_fast(acc[2] + dd[2] * bflo(uu.y)), y3 = gelu_fast(acc[3] + dd[3] * bfhi(uu.y));
        v2u w; w.x = pk2(y0, y1); w.y = pk2(y2, y3);
        *(v2u*)(YPRE + tok * 512 + g * 16 + 4 * q) = w;
    }
}

#include <hip/hip_bf16.h>
namespace gqa_body {
using bf16=__hip_bfloat16;
using bf16x8=__attribute__((ext_vector_type(8)))short;
using s16x4=__attribute__((ext_vector_type(4)))short;
using f32x16=__attribute__((ext_vector_type(16)))float;
using u32x4=__attribute__((ext_vector_type(4)))unsigned;
constexpr int NHEAD=8,SEQQ=4096,SKV=4352,D=64,QPITCH=64,KPITCH=64,VPITCH=64,OPITCH=1024,GPITCH=2304;
constexpr int NW=8,QBLK=32,QB=QBLK*NW,KVBLK=64,NQB=SEQQ/QB,NTILES=SKV/KVBLK;
constexpr int ATTN_UNIT_ROWS=QB;
__device__ __forceinline__ int crow(int r,int hi){return (r&3)+8*(r>>2)+4*hi;}
#define SBAR() __builtin_amdgcn_sched_barrier(0)
constexpr int NSLOT=3, SLOTB=8192;
constexpr int LDS_K=0, LDS_V=NSLOT*SLOTB, LDS_WS=2*NSLOT*SLOTB, LDS_OST=LDS_WS+NW*64*4, LDS_BYTES=LDS_OST+NW*4096;
constexpr float C2=0.125f*1.4426950408889634f;
__device__ __forceinline__ void glds16(const void*gsrc,unsigned lds_dst){unsigned keep;
  asm volatile("s_mov_b32 %0, m0\n\ts_mov_b32 m0, %2\n\ts_nop 0\n\tglobal_load_lds_dwordx4 %1, off\n\ts_mov_b32 m0, %0":"=&s"(keep):"v"(gsrc),"s"(lds_dst):"memory");}
__device__ __forceinline__ float max3f(float a,float b,float c){float r;asm("v_max3_f32 %0, %1, %2, %3":"=v"(r):"v"(a),"v"(b),"v"(c));return r;}
__device__ __forceinline__ float max2f(float a,float b){float r;asm("v_max_f32_e32 %0, %1, %2":"=v"(r):"v"(a),"v"(b));return r;}
__device__ __forceinline__ float fadd_s(float a,float b){float r;asm("v_add_f32_e32 %0, %1, %2":"=v"(r):"v"(a),"v"(b));return r;}
__device__ __forceinline__ float fsub_s(float a,float b){float r;asm("v_sub_f32_e32 %0, %1, %2":"=v"(r):"v"(a),"v"(b));return r;}
typedef float f32x2_t __attribute__((ext_vector_type(2))); typedef __bf16 bf16x2_t __attribute__((ext_vector_type(2)));
__device__ __forceinline__ unsigned cvtpk_s(float lo,float hi){f32x2_t v={lo,hi};bf16x2_t b=__builtin_convertvector(v,bf16x2_t);return __builtin_bit_cast(unsigned,b);}
#define WAIT_BAR(N) asm volatile("s_waitcnt vmcnt(" #N ") lgkmcnt(0)\n\ts_barrier":::"memory")

__device__ __forceinline__ void qkt(f32x16&p0,f32x16&p1,const char*Kslot,const bf16x8*qr,const f32x16&negm,int r32,int hi){
  const char*kb=Kslot+hi*1024+r32*16;
  #pragma unroll
  for(int d0=0;d0<4;++d0){
    const bf16x8 b0=*reinterpret_cast<const bf16x8*>(kb+d0*2048);
    const bf16x8 b1=*reinterpret_cast<const bf16x8*>(kb+d0*2048+512);
    if(d0==0){p0=__builtin_amdgcn_mfma_f32_32x32x16_bf16(b0,qr[0],negm,0,0,0);p1=__builtin_amdgcn_mfma_f32_32x32x16_bf16(b1,qr[0],negm,0,0,0);}
    else{p0=__builtin_amdgcn_mfma_f32_32x32x16_bf16(b0,qr[d0],p0,0,0,0);p1=__builtin_amdgcn_mfma_f32_32x32x16_bf16(b1,qr[d0],p1,0,0,0);}}
}
typedef __attribute__((address_space(3))) const char* lds_cptr;
typedef short v4i16_t __attribute__((ext_vector_type(4)));
__device__ __forceinline__ void kload8(bf16x8*kf,lds_cptr kp){
  kf[0]=*(const __attribute__((address_space(3))) bf16x8*)(kp);      kf[1]=*(const __attribute__((address_space(3))) bf16x8*)(kp+512);
  kf[2]=*(const __attribute__((address_space(3))) bf16x8*)(kp+2048); kf[3]=*(const __attribute__((address_space(3))) bf16x8*)(kp+2560);
  kf[4]=*(const __attribute__((address_space(3))) bf16x8*)(kp+4096); kf[5]=*(const __attribute__((address_space(3))) bf16x8*)(kp+4608);
  kf[6]=*(const __attribute__((address_space(3))) bf16x8*)(kp+6144); kf[7]=*(const __attribute__((address_space(3))) bf16x8*)(kp+6656);
}
__device__ __forceinline__ void kload2(bf16x8*kf,lds_cptr kp,int j){ kf[2*j]=*(const __attribute__((address_space(3))) bf16x8*)(kp+j*2048); kf[2*j+1]=*(const __attribute__((address_space(3))) bf16x8*)(kp+j*2048+512); }
__device__ __forceinline__ s16x4 vtr(lds_cptr p){ return __builtin_bit_cast(s16x4,__builtin_amdgcn_ds_read_tr16_b64_v4i16((__attribute__((address_space(3))) v4i16_t*)p)); }
__device__ __forceinline__ float rowmax(const f32x16&p0,const f32x16&p1){
  float a=max3f(p0[0],p0[1],p1[0]),b=max3f(p0[2],p0[3],p1[1]);a=max3f(a,p1[2],p1[3]);
  #pragma unroll
  for(int r=4;r<16;r+=4){a=max3f(a,p0[r],p0[r+1]);b=max3f(b,p0[r+2],p0[r+3]);a=max3f(a,p1[r],p1[r+1]);b=max3f(b,p1[r+2],p1[r+3]);}
  const float m=max2f(a,b);
  auto rr=__builtin_amdgcn_permlane32_swap(__float_as_uint(m),__float_as_uint(m),false,false);
  return max2f(__uint_as_float(rr[0]),__uint_as_float(rr[1]));
}
__device__ __forceinline__ void pv(f32x16*o,int vb,bf16x8 pa0,bf16x8 pa1,bf16x8 pa2,bf16x8 pa3){
  #pragma unroll
  for(int d0=0;d0<2;++d0){s16x4 lo[4],hi[4];
    #pragma unroll
    for(int ks=0;ks<4;++ks){
      asm volatile("ds_read_b64_tr_b16 %0,%1 offset:%c2":"=&v"(lo[ks]):"v"(vb),"i"(d0*4096+ks*1024):"memory");
      asm volatile("ds_read_b64_tr_b16 %0,%1 offset:%c2":"=&v"(hi[ks]):"v"(vb),"i"(d0*4096+ks*1024+512):"memory");}
    asm volatile("s_waitcnt lgkmcnt(0)":::"memory");SBAR();
    #define PK(k) (bf16x8){lo[k][0],lo[k][1],lo[k][2],lo[k][3],hi[k][0],hi[k][1],hi[k][2],hi[k][3]}
    o[d0]=__builtin_amdgcn_mfma_f32_32x32x16_bf16(pa0,PK(0),o[d0],0,0,0);
    o[d0]=__builtin_amdgcn_mfma_f32_32x32x16_bf16(pa1,PK(1),o[d0],0,0,0);
    o[d0]=__builtin_amdgcn_mfma_f32_32x32x16_bf16(pa2,PK(2),o[d0],0,0,0);
    o[d0]=__builtin_amdgcn_mfma_f32_32x32x16_bf16(pa3,PK(3),o[d0],0,0,0);
    #undef PK
  }
}

#ifndef ATTN_STORE16
#define ATTN_STORE16(p,v) (*(u32x4*)(p)=(v))
#endif
template<int THRL> __device__ __forceinline__ void attn_unit(int b,int h,int qb,const bf16*Q,const bf16*__restrict__ K,const bf16*__restrict__ V,bf16*O,const bf16*Gt,char*shm){
  const int tid=threadIdx.x,lane=tid&63,r32=lane&31,hi=lane>>5; const int wid=__builtin_amdgcn_readfirstlane(tid>>6);
  const int q0=qb*QB;
  const bf16*Qw=Q+((long)(b*NHEAD+h)*SEQQ+q0+wid*QBLK)*QPITCH;
  const bf16*Kh=K+(long)(b*2+(h>>2))*SKV*KPITCH,*Vh=V+(long)(b*2+(h>>2))*SKV*VPITCH;
  const unsigned lds0=(unsigned)(uintptr_t)shm;
  float*wsf=(float*)(shm+LDS_WS)+wid*64;
  const bf16*ksrc=Kh+(long)lane*KPITCH+wid*8;
  const bf16*vsrc=Vh+(long)(16*(wid&3)+(lane>>2))*VPITCH+(wid>>2)*32+(lane&3)*8;
  const unsigned kdst=lds0+LDS_K+wid*1024, vdst=lds0+LDS_V+wid*1024;
  #define DMA_K(t,slot) glds16(ksrc+(long)(t)*KVBLK*KPITCH,(unsigned)__builtin_amdgcn_readfirstlane(kdst+(slot)))
  #define DMA_V(t,slot) glds16(vsrc+(long)(t)*KVBLK*VPITCH,(unsigned)__builtin_amdgcn_readfirstlane(vdst+(slot)))
  const int vb0=(int)(lds0+LDS_V)+((lane>>4)&1)*32+(lane&3)*8+(4*hi+((lane&15)>>2))*64;
  const char*Kbase=shm+LDS_K; bf16x8 kf[8];
  const lds_cptr shm3=(lds_cptr)shm; const lds_cptr kp0=shm3+LDS_K+hi*1024+r32*16; const lds_cptr vp0=shm3+LDS_V+((lane>>4)&1)*32+(lane&3)*8+(4*hi+((lane&15)>>2))*64;
  constexpr int NT=NTILES;
  DMA_K(0,0);DMA_V(0,0);DMA_K(1,SLOTB);
  bf16x8 qr[4];
  #pragma unroll
  for(int d0=0;d0<4;++d0)qr[d0]=*reinterpret_cast<const bf16x8*>(&Qw[(long)r32*QPITCH+d0*16+hi*8]);
  float mhat=0.f,l_reg=0.f;f32x16 o[2];o[0]=f32x16{};o[1]=f32x16{};f32x16 negm=f32x16{};asm volatile("":"+v"(negm));
  #define CMASK(P0,P1,t) do{}while(0)
  bool resc=false;
  #define START(P0,P1) do{ const float rm=rowmax(P0,P1); resc=false; \
    { const float dl=rm; mhat=fadd_s(mhat,dl); \
      _Pragma("unroll") for(int r=0;r<16;++r){P0[r]=fsub_s(P0[r],dl);P1[r]=fsub_s(P1[r],dl);} \
      _Pragma("unroll") for(int r=0;r<16;++r)negm[r]=-mhat; asm volatile("":"+v"(negm)); } \
    _Pragma("unroll") for(int r=0;r<16;++r)P0[r]=__builtin_amdgcn_exp2f(P0[r]); }while(0)
  #define RESC() do{ if(resc){ asm volatile("s_waitcnt lgkmcnt(0)":::"memory"); \
      _Pragma("unroll") for(int d_=0;d_<2;++d_) _Pragma("unroll") for(int r=0;r<16;++r)o[d_][r]*=wsf[crow(r,hi)]; } }while(0)
  f32x16 pA0,pA1,pB0,pB1;
  int sl_prev=0,sl_cur=0,sl_next=SLOTB;
  #define ROT() do{sl_prev=sl_cur;sl_cur=sl_next;sl_next=(sl_next==(NSLOT-1)*SLOTB)?0:sl_next+SLOTB;}while(0)
  DMA_K(2,2*SLOTB);
  WAIT_BAR(3);
  qkt(pA0,pA1,Kbase,qr,negm,r32,hi);asm volatile("s_nop 15\n\ts_nop 7":"+v"(pA0),"+v"(pA1));CMASK(pA0,pA1,0);
  START(pA0,pA1);
  _Pragma("unroll") for(int r=0;r<16;++r)pA1[r]=__builtin_amdgcn_exp2f(pA1[r]);
  WAIT_BAR(0);
  DMA_K(3,0);DMA_V(1,SLOTB);
  ROT();
  kload8(kf,kp0+sl_cur);
  WAIT_BAR(2);
  s16x4 vlo[8],vhi[8]; u32x4 pw0,pw1,pw2,pw3;
  #define PKW(P,B) cvtpk_s(P[B],P[B+1])
  #define PAF(k) __builtin_bit_cast(bf16x8,pw##k)
  #define VFR(i) (bf16x8){vlo[i][0],vlo[i][1],vlo[i][2],vlo[i][3],vhi[i][0],vhi[i][1],vhi[i][2],vhi[i][3]}
  #define PIN(x) asm volatile("":"+v"(x))
  #define MX3(a,b,c) __builtin_fmaxf(__builtin_fmaxf((a),(b)),(c))
  #define GAPA(MF,A0,A1,A2,A3,W0,W1,PW) do{ MF; sacc+=A0; sacc+=A1; sacc+=A2; sacc+=A3; PIN(sacc); W0; W1; PIN(PW); SBAR(); }while(0)
  #define EX(v) __builtin_amdgcn_exp2f(v)
  #define GAPB(MF,X,B) do{ MF; X[B]=EX(X[B]); X[B+1]=EX(X[B+1]); X[B+2]=EX(X[B+2]); X[B+3]=EX(X[B+3]); PIN(X); SBAR(); }while(0)
  #define VRD(i) do{ vlo[i]=vtr(vp_+(((i)>>2)*4096+((i)&3)*1024)); vhi[i]=vtr(vp_+(((i)>>2)*4096+((i)&3)*1024+512)); }while(0)
  #define KRD(G,j) do{ if(G){ kload2(kf,kp0+sl_next,j); SBAR(); } }while(0)
  #define STEP(C0,C1,P0,P1,t,GK,GV,GL) do{ SBAR(); \
    const lds_cptr vp_=vp0+sl_prev; \
    VRD(0); SBAR(); float sacc=(P0[0]+P0[1]); \
    GAPA(C0=__builtin_amdgcn_mfma_f32_32x32x16_bf16(kf[0],qr[0],negm,0,0,0), P0[2],P0[3],P0[4],P0[5],     pw0[0]=PKW(P0,0), pw0[1]=PKW(P0,2), pw0); \
    VRD(4); SBAR(); GAPA(C1=__builtin_amdgcn_mfma_f32_32x32x16_bf16(kf[1],qr[0],negm,0,0,0), P0[6],P0[7],P0[8],P0[9],     pw0[2]=PKW(P0,4), pw0[3]=PKW(P0,6), pw0); \
    VRD(1); SBAR(); GAPA(C0=__builtin_amdgcn_mfma_f32_32x32x16_bf16(kf[2],qr[1],C0,0,0,0),   P0[10],P0[11],P0[12],P0[13], pw1[0]=PKW(P0,8), pw1[1]=PKW(P0,10), pw1); \
    VRD(5); SBAR(); GAPA(C1=__builtin_amdgcn_mfma_f32_32x32x16_bf16(kf[3],qr[1],C1,0,0,0),   P0[14],P0[15],P1[0],P1[1],   pw1[2]=PKW(P0,12),pw1[3]=PKW(P0,14), pw1); \
    VRD(2); SBAR(); GAPA(C0=__builtin_amdgcn_mfma_f32_32x32x16_bf16(kf[4],qr[2],C0,0,0,0),   P1[2],P1[3],P1[4],P1[5],     pw2[0]=PKW(P1,0), pw2[1]=PKW(P1,2), pw2); \
    VRD(6); SBAR(); GAPA(C1=__builtin_amdgcn_mfma_f32_32x32x16_bf16(kf[5],qr[2],C1,0,0,0),   P1[6],P1[7],P1[8],P1[9],     pw2[2]=PKW(P1,4), pw2[3]=PKW(P1,6), pw2); \
    VRD(3); SBAR(); GAPA(C0=__builtin_amdgcn_mfma_f32_32x32x16_bf16(kf[6],qr[3],C0,0,0,0),   P1[10],P1[11],P1[12],P1[13], pw3[0]=PKW(P1,8), pw3[1]=PKW(P1,10), pw3); \
    VRD(7); SBAR(); GAPA(C1=__builtin_amdgcn_mfma_f32_32x32x16_bf16(kf[7],qr[3],C1,0,0,0),   P1[14],P1[15],0.f,0.f,       pw3[2]=PKW(P1,12),pw3[3]=PKW(P1,14), pw3); \
    l_reg+=sacc; \
    if(GK){DMA_K((t)+3,sl_cur);} if(GV){DMA_V((t)+1,sl_next);} \
    CMASK(C0,C1,t); \
    { float a=MX3(C0[0],C0[1],C1[0]),b=MX3(C0[2],C0[3],C1[1]); a=MX3(a,C1[2],C1[3]); \
      _Pragma("unroll") for(int r=4;r<16;r+=4){a=MX3(a,C0[r],C0[r+1]);b=MX3(b,C0[r+2],C0[r+3]);a=MX3(a,C1[r],C1[r+1]);b=MX3(b,C1[r+2],C1[r+3]);} \
      float rm=__builtin_fmaxf(a,b); { auto rr=__builtin_amdgcn_permlane32_swap(__float_as_uint(rm),__float_as_uint(rm),false,false); rm=__builtin_fmaxf(__uint_as_float(rr[0]),__uint_as_float(rr[1])); } \
      resc=false; \
      if(__builtin_expect(__any(rm>(float)THRL),0)){ const float dl=__builtin_fmaxf(rm,0.f); mhat+=dl; \
        _Pragma("unroll") for(int r=0;r<16;++r){C0[r]-=dl;C1[r]-=dl;} \
        _Pragma("unroll") for(int r=0;r<16;++r)negm[r]=-mhat; asm volatile("":"+v"(negm)); \
        const float f=__builtin_amdgcn_exp2f(-dl); l_reg*=f; if(hi==0)wsf[r32]=f; resc=true; } } \
    SBAR(); \
    GAPB(o[0]=__builtin_amdgcn_mfma_f32_32x32x16_bf16(PAF(0),VFR(0),o[0],0,0,0), C0,0); \
    GAPB(o[1]=__builtin_amdgcn_mfma_f32_32x32x16_bf16(PAF(0),VFR(4),o[1],0,0,0), C0,4); \
    KRD(GL,0); GAPB(o[0]=__builtin_amdgcn_mfma_f32_32x32x16_bf16(PAF(1),VFR(1),o[0],0,0,0), C0,8); \
    KRD(GL,1); GAPB(o[1]=__builtin_amdgcn_mfma_f32_32x32x16_bf16(PAF(1),VFR(5),o[1],0,0,0), C0,12); \
    KRD(GL,2); GAPB(o[0]=__builtin_amdgcn_mfma_f32_32x32x16_bf16(PAF(2),VFR(2),o[0],0,0,0), C1,0); \
    KRD(GL,3); GAPB(o[1]=__builtin_amdgcn_mfma_f32_32x32x16_bf16(PAF(2),VFR(6),o[1],0,0,0), C1,4); \
    GAPB(o[0]=__builtin_amdgcn_mfma_f32_32x32x16_bf16(PAF(3),VFR(3),o[0],0,0,0), C1,8); \
    GAPB(o[1]=__builtin_amdgcn_mfma_f32_32x32x16_bf16(PAF(3),VFR(7),o[1],0,0,0), C1,12); \
    }while(0)
  int t=1;
  #undef CMASK
  #define CMASK(P0,P1,t) do{}while(0)
  for(;t+5<NT;t+=2){
    STEP(pB0,pB1,pA0,pA1,t,true,true,true);     WAIT_BAR(2); RESC(); ROT();
    STEP(pA0,pA1,pB0,pB1,t+1,true,true,true);   WAIT_BAR(2); RESC(); ROT();
  }
  #undef CMASK
  #define CMASK(P0,P1,t) do{}while(0)
  #define ENDW(tt) do{ if((tt)+3<NT){WAIT_BAR(2);} else if((tt)+2<NT){WAIT_BAR(1);} else {WAIT_BAR(0);} }while(0)
  for(;t+1<NT;t+=2){
    STEP(pB0,pB1,pA0,pA1,t,(t+3<NT),(t+1<NT),(t+1<NT));       ENDW(t);   RESC(); ROT();
    STEP(pA0,pA1,pB0,pB1,t+1,(t+4<NT),(t+2<NT),(t+2<NT));     ENDW(t+1); RESC(); ROT();
  }
  STEP(pB0,pB1,pA0,pA1,NT-1,false,false,false); RESC();
  { float sacc=pB0[0]+pB0[1]; _Pragma("unroll") for(int r=2;r<16;++r)sacc+=pB0[r]; _Pragma("unroll") for(int r=0;r<16;++r)sacc+=pB1[r]; l_reg+=sacc;
    pw0=(u32x4){PKW(pB0,0),PKW(pB0,2),PKW(pB0,4),PKW(pB0,6)};pw1=(u32x4){PKW(pB0,8),PKW(pB0,10),PKW(pB0,12),PKW(pB0,14)};pw2=(u32x4){PKW(pB1,0),PKW(pB1,2),PKW(pB1,4),PKW(pB1,6)};pw3=(u32x4){PKW(pB1,8),PKW(pB1,10),PKW(pB1,12),PKW(pB1,14)};
    SBAR(); pv(o,vb0+sl_cur,PAF(0),PAF(1),PAF(2),PAF(3)); }
  #undef PKW
  #undef PAF
  #undef VFR
  #undef PIN
  #undef MX3
  #undef GAPA
  #undef GAPB
  #undef EX
  #undef VRD
  #undef KRD
  #undef STEP
  #undef ENDW
  {auto rr=__builtin_amdgcn_permlane32_swap(__float_as_uint(l_reg),__float_as_uint(l_reg),false,false);l_reg=__uint_as_float(rr[0])+__uint_as_float(rr[1]);}
  if(hi==0)wsf[32+r32]=l_reg;asm volatile("s_waitcnt lgkmcnt(0)":::"memory");
  float rli[16];
  #pragma unroll
  for(int r=0;r<16;++r)rli[r]=__builtin_amdgcn_rcpf(wsf[32+crow(r,hi)]);
  bf16*Ow=O+((long)b*SEQQ+q0+wid*QBLK)*OPITCH+h*D; const bf16*Gw=Gt+((long)b*SEQQ+q0+wid*QBLK)*GPITCH+h*D;
  { bf16*stg=(bf16*)(shm+LDS_OST)+wid*2048;
    #pragma unroll
    for(int r=0;r<16;++r){const int orow=crow(r,hi);
      #pragma unroll
      for(int d0=0;d0<2;++d0)stg[orow*64+d0*32+r32]=__float2bfloat16(o[d0][r]*rli[r]);}
    asm volatile("s_waitcnt lgkmcnt(0)":::"memory");
    #pragma unroll
    for(int i=0;i<4;++i){const int row=i*8+(lane>>3),ch=lane&7; const u32x4 v=*(const u32x4*)(stg+row*64+ch*8); const u32x4 gv=*(const u32x4*)(Gw+(long)row*GPITCH+ch*8); u32x4 w;
      w.x=pk2(bflo(v.x)*silu_f(bflo(gv.x)),bfhi(v.x)*silu_f(bfhi(gv.x))); w.y=pk2(bflo(v.y)*silu_f(bflo(gv.y)),bfhi(v.y)*silu_f(bfhi(gv.y)));
      w.z=pk2(bflo(v.z)*silu_f(bflo(gv.z)),bfhi(v.z)*silu_f(bfhi(gv.z))); w.w=pk2(bflo(v.w)*silu_f(bflo(gv.w)),bfhi(v.w)*silu_f(bfhi(gv.w)));
      ATTN_STORE16(Ow+(long)row*OPITCH+ch*8,w);} }
  asm volatile("s_waitcnt lgkmcnt(0)\n\ts_barrier":::"memory");
  #undef DMA_K
  #undef DMA_V
  #undef CMASK
  #undef START
  #undef RESC
  #undef ROT
}
constexpr int ATTN_LDS_BYTES=LDS_BYTES;
#undef SBAR
#undef WAIT_BAR
}

typedef short v4i16_t __attribute__((ext_vector_type(4)));
DI s16x4_t vtr16(const LAS unsigned char* p) { return __builtin_bit_cast(s16x4_t, __builtin_amdgcn_ds_read_tr16_b64_v4i16((LAS v4i16_t*)p)); }

struct NaState { f32x16_t o0, o1; float m, l; };
template <bool MASK> DI void na_tile(NaState& st, const bf16x8_t (&qf)[4], const LAS unsigned char* Kb, const LAS unsigned char* Vb, int koff, int lane,
                                     int kr, int qr, int qc, int rsq, int csq, const LAS float* BIAS) {
    const int ql = lane & 31, hf = lane >> 5, row = koff + ql;
    f32x16_t sc = {};
#pragma unroll
    for (int ks = 0; ks < 4; ++ks) { const bf16x8_t kf = *(const LAS bf16x8_t*)(Kb + row * 128 + (((2 * ks + hf) ^ (row & 7)) << 4)); sc = __builtin_amdgcn_mfma_f32_32x32x16_bf16(kf, qf[ks], sc, 0, 0, 0); }
    const LAS unsigned char* vp = Vb + ((lane >> 4) & 1) * 32 + (lane & 3) * 8 + (koff + 4 * hf + ((lane & 15) >> 2)) * 64;
    s16x4_t vl[2][2], vh[2][2];
#pragma unroll
    for (int dt = 0; dt < 2; ++dt)
#pragma unroll
        for (int s = 0; s < 2; ++s) { vl[dt][s] = vtr16(vp + dt * 4096 + s * 1024); vh[dt][s] = vtr16(vp + dt * 4096 + s * 1024 + 512); }
    float xs[16];
    if (MASK) {
        const bool row_ok = (kr >= rsq) && (kr < rsq + 8);
        const LAS float* rb = BIAS + (kr - qr + 7) * 31 + (15 - qc);
#pragma unroll
        for (int r = 0; r < 16; ++r) { const int kc = koff + crow16(r, hf); const bool ok = row_ok && (kc >= csq) && (kc < csq + 16);
            const float bias = ok ? rb[kc] : 0.f; xs[r] = ok ? (sc[r] * 0.125f + bias) * LOG2E : -1e30f; }
    } else {
#pragma unroll
        for (int r = 0; r < 16; ++r) xs[r] = sc[r] * (0.125f * LOG2E);
    }
    float tm = xs[0];
#pragma unroll
    for (int r = 1; r < 16; ++r) tm = fmaxf(tm, xs[r]);
    tm = fmaxf(tm, __shfl_xor(tm, 32));
    const float mn = fmaxf(st.m, tm), al = __builtin_amdgcn_exp2f(st.m - mn);
    float ps = 0.f;
#pragma unroll
    for (int r = 0; r < 16; ++r) { xs[r] = __builtin_amdgcn_exp2f(xs[r] - mn); ps += xs[r]; }
    st.l = st.l * al + ps; st.m = mn;
#pragma unroll
    for (int r = 0; r < 16; ++r) { st.o0[r] *= al; st.o1[r] *= al; }
#pragma unroll
    for (int s = 0; s < 2; ++s) { v4u w; w.x = cvtpk(xs[8 * s], xs[8 * s + 1]); w.y = cvtpk(xs[8 * s + 2], xs[8 * s + 3]); w.z = cvtpk(xs[8 * s + 4], xs[8 * s + 5]); w.w = cvtpk(xs[8 * s + 6], xs[8 * s + 7]);
        const bf16x8_t pf = __builtin_bit_cast(bf16x8_t, w);
        const bf16x8_t a0 = __builtin_shufflevector(vl[0][s], vh[0][s], 0, 1, 2, 3, 4, 5, 6, 7), a1 = __builtin_shufflevector(vl[1][s], vh[1][s], 0, 1, 2, 3, 4, 5, 6, 7);
        st.o0 = __builtin_amdgcn_mfma_f32_32x32x16_bf16(a0, pf, st.o0, 0, 0, 0);
        st.o1 = __builtin_amdgcn_mfma_f32_32x32x16_bf16(a1, pf, st.o1, 0, 0, 0); }
}

constexpr int NA_BLOCK_UNITS = 512 + 32;
DI void na_block_unit(int unit, const bf16_t* PROJ, const float* relb, bf16_t* YMIX, LAS unsigned char* lds, int tid, int wave, int lane) {
    LAS unsigned char* KB = lds; LAS unsigned char* VB = lds + 16384; LAS float* BIAS = (LAS float*)(lds + 32768);
    const bool lat = unit < 512;
    int b, h, R = 0;
    if (lat) { R = unit & 15; h = (unit >> 4) & 7; b = unit >> 7; } else { const int u = unit - 512; h = u & 7; b = u >> 3; }
    const int ql = lane & 31, hf = lane >> 5;
    int qrow, qr = 0, qc = 0, rsq = 0, csq = 0, c0 = 0, rlo = 0, rhi = 0, rsA = 0, nsteps = 4;
    if (lat) { const int rp = 2 * R + (wave >> 2), ci = wave & 3; qr = 2 * rp + (ql >> 4); qc = 16 * ci + (ql & 15); qrow = b * SEQ + qr * 64 + qc;
        rsq = min(max(qr - 4, 0), 56); csq = min(max(qc - 8, 0), 48); c0 = min(max(16 * ci - 8, 0), 32);
        rlo = min(max(2 * rp - 4, 0), 56); rhi = min(max(2 * rp - 3, 0), 56) + 8;
        rsA = min(max(4 * R - 4, 0), 56); const int rsB = min(max(4 * R - 1, 0), 56); nsteps = 4 + (rsB + 8 - rsA);
    } else qrow = NLAT + b * LC + 32 * wave + ql;
    __syncthreads();
    if (lat) for (int e = tid; e < 465; e += NTHREADS) BIAS[e] = relb[h * 465 + e];
    bf16x8_t qf[4];
    { const bf16_t* qp = PROJ + (size_t)qrow * N0 + 1024 + h * 64 + 8 * hf;
#pragma unroll
      for (int ks = 0; ks < 4; ++ks) qf[ks] = *(const bf16x8_t*)(qp + 16 * ks); }
    NaState st; st.o0 = (f32x16_t){}; st.o1 = (f32x16_t){}; st.m = -1e30f; st.l = 0.f;
    const int srow = tid >> 3, sch = tid & 7;
    const int kdst = srow * 128 + ((sch ^ (srow & 7)) << 4), vdst = (sch >> 2) * 4096 + srow * 64 + (sch & 3) * 16;
    auto step_row0 = [&](int s) -> int { return s < 4 ? NLAT + b * LC + 64 * s : b * SEQ + (rsA + s - 4) * 64; };
    v4u kreg, vreg;
    { const bf16_t* src = PROJ + (size_t)(step_row0(0) + srow) * N0 + h * 64 + sch * 8; kreg = *(const v4u*)(src + 1536); vreg = *(const v4u*)(src + 2048); }
#pragma unroll 1
    for (int s = 0; s < nsteps; ++s) {
        LAS unsigned char* kb = KB + (s & 1) * 8192; LAS unsigned char* vb = VB + (s & 1) * 8192;
        *(LAS v4u*)(kb + kdst) = kreg; *(LAS v4u*)(vb + vdst) = vreg;
        __syncthreads();
        if (s + 1 < nsteps) { const bf16_t* src = PROJ + (size_t)(step_row0(s + 1) + srow) * N0 + h * 64 + sch * 8; kreg = *(const v4u*)(src + 1536); vreg = *(const v4u*)(src + 2048); }
        if (s < 4) { na_tile<false>(st, qf, kb, vb, 0, lane, 0, 0, 0, 0, 0, BIAS); na_tile<false>(st, qf, kb, vb, 32, lane, 0, 0, 0, 0, 0, BIAS); }
        else { const int kr = rsA + s - 4; if (kr >= rlo && kr < rhi) na_tile<true>(st, qf, kb, vb, c0, lane, kr, qr, qc, rsq, csq, BIAS); }
    }
    st.l += __shfl_xor(st.l, 32);
    const float rl = 1.f / st.l;
    const bf16_t* gp = PROJ + (size_t)qrow * N0 + 2560 + h * 64; bf16_t* yp = YMIX + (size_t)qrow * DM + 512 + h * 64;
#pragma unroll
    for (int dt = 0; dt < 2; ++dt)
#pragma unroll
        for (int rg = 0; rg < 4; ++rg) { const int d = 32 * dt + 8 * rg + 4 * hf;
            const v2u gv = *(const v2u*)(gp + d);
            const float g0 = silu_f(bflo(gv.x)), g1 = silu_f(bfhi(gv.x)), g2 = silu_f(bflo(gv.y)), g3 = silu_f(bfhi(gv.y));
            const f32x16_t& oo = dt ? st.o1 : st.o0;
            v2u w; w.x = pk2(oo[4 * rg] * rl * g0, oo[4 * rg + 1] * rl * g1); w.y = pk2(oo[4 * rg + 2] * rl * g2, oo[4 * rg + 3] * rl * g3);
            *(v2u*)(yp + d) = w; }
}

struct Args { const float* in[32]; float* out; unsigned char* ws; int ph_lo, ph_hi, li, pad; };
DI void phase3(const Args& args, LAS unsigned char* lds, int tid, int wave, int lane, int G, int pass) {
    unsigned char* ws = args.ws;
    for (int cu = blockIdx.x; cu < 256; cu += G)
        s5_scan_unit(cu, wave, (const bf16_t*)(ws + WS_PROJ), (const bf16_t*)(ws + WS_W16), (const float*)(ws + WS_L16), (bf16_t*)(ws + WS_CARRY0), (bf16_t*)(ws + WS_CARRY1), lane);
    for (int u = blockIdx.x; u < NA_BLOCK_UNITS; u += G) na_block_unit(u, (const bf16_t*)(ws + WS_PROJ), args.in[20], (bf16_t*)(ws + WS_YMIX), lds, tid, wave, lane);
}
DI void phase4(const Args& args, LAS unsigned char* lds, int tid, int wave, int lane, int G) {
    unsigned char* ws = args.ws;
    constexpr int NIT = 32 * 4 * 17;
    const int i0 = (int)(((long)blockIdx.x * NIT) / G), i1 = (int)(((long)(blockIdx.x + 1) * NIT) / G);
    int gcur = -1;
    for (int it = i0; it < i1; ++it) {
        const int g = it / 68, b = (it % 68) / 17, s = it % 17;
        if (g != gcur) { __syncthreads(); for (int e = tid; e < 1024; e += NTHREADS) ((LAS v4u*)lds)[e] = ((const v4u*)(ws + WS_KT))[(size_t)g * 1024 + e]; gcur = g; __syncthreads(); }
        s5_out_item(g, b, s, (const bf16_t*)(ws + WS_PROJ), (const bf16_t*)(ws + WS_WC), (const bf16_t*)(ws + WS_CARRY0), (const bf16_t*)(ws + WS_CARRY1), args.in[17], (bf16_t*)(ws + WS_YPRE), lds, wave, lane);
    }
}
DI LruP make_lrup(const Args& args) { unsigned char* ws = args.ws;
    return LruP{(const bf16_t*)(ws + WS_PROJ), args.in[23], args.in[24], args.in[25], args.in[27], args.in[29], (const bf16_t*)(ws + WS_LRUWT), (f32x2_t*)(ws + WS_CARRY0), (bf16_t*)(ws + WS_YMIX)}; }
DI void phase9(const Args& args, LAS unsigned char* lds, int tid, int wave, int lane, int G) {
    unsigned char* ws = args.ws; const LruP lp = make_lrup(args);
    for (int blk = blockIdx.x; blk < 256; blk += G) lru_block(blk, false, lp, lds, tid, wave, lane);
    const int gw = blockIdx.x * NWAVES + wave, NGW = G * NWAVES;
    for (int r = gw; r < MROWS; r += NGW) qkprep_row(r, (const bf16_t*)(ws + WS_PROJ), args.in[30], args.in[31], (const float*)(ws + WS_ROPE), (bf16_t*)(ws + WS_QP), (bf16_t*)(ws + WS_KP), lane);
}
DI void phase10(const Args& args, LAS unsigned char* lds, int tid, int wave, int lane, int G) {
    unsigned char* ws = args.ws;
    const LruP lp = make_lrup(args);
    for (int blk = blockIdx.x; blk < 256; blk += G) lru_block(blk, true, lp, lds, tid, wave, lane);
    __syncthreads();
    const int bx = blockIdx.x, vcu = (G % 8 == 0) ? (bx % 8) * (G / 8) + bx / 8 : bx;
    typedef gqa_body::bf16 abf;
    for (int u = vcu; u < 512; u += G) {
        const int qb = u & 15, hq = (u >> 4) & 7, b = u >> 7;
        gqa_body::attn_unit<8>(b, hq, qb, (const abf*)(ws + WS_QP), (const abf*)(ws + WS_KP), (const abf*)(ws + WS_VT1), (abf*)(ws + WS_YMIX) + 512, (const abf*)(ws + WS_PROJ) + 1792, (char*)lds);
    }
}

constexpr int RING_BYTES = 131072, LDSCTL_OFF = RING_BYTES, MISC_OFF = LDSCTL_OFF + 320, LDS_BYTES = 147456;
constexpr int CW_BAR = 4096;
constexpr int N_PHASES = 13;
constexpr bool kSP2 = true, kALIGN = true;

DI void p0_adaln(LAS unsigned char* lds, const float* c, const float* cctx, const float* ada_w, const float* ada_b, float* MOD, int tid, int wave, int lane, int G) {
    LAS float* sl = (LAS float*)lds;
    LAS float* red = (LAS float*)(lds + 5 * 1024 * 4);
    if ((int)blockIdx.x >= 192) return;
    for (int e = tid; e < 5 * 1024; e += NTHREADS) { const int r = e >> 10, k = e & 1023; const float x = r < 4 ? c[r * 1024 + k] : cctx[k]; sl[e] = silu_f(x); }
    __syncthreads();
    for (int item = blockIdx.x; item < 192; item += G) {
        const int i = item / 96, cb = item % 96, col = cb * 32 + (lane & 31), kh = lane >> 5;
        const float* W = ada_w + (size_t)i * 1024 * 3072 + col;
        float acc[5] = {0.f, 0.f, 0.f, 0.f, 0.f};
#pragma unroll 8
        for (int kk = 0; kk < 64; ++kk) { const int k = wave * 128 + 2 * kk + kh; const float w = W[(size_t)k * 3072];
#pragma unroll
            for (int r = 0; r < 5; ++r) acc[r] += sl[r * 1024 + k] * w; }
#pragma unroll
        for (int r = 0; r < 5; ++r) { acc[r] += __shfl_xor(acc[r], 32); if (lane < 32) red[(wave * 5 + r) * 32 + lane] = acc[r]; }
        __syncthreads();
        if (tid < 160) { const int r = tid >> 5, cl = tid & 31; float s = ada_b[i * 3072 + cb * 32 + cl];
#pragma unroll
            for (int w = 0; w < 8; ++w) s += red[(w * 5 + r) * 32 + cl];
            MOD[(i * 5 + r) * 3072 + cb * 32 + cl] = s; }
        __syncthreads();
    }
}
DI void p0_transpose_item(const float* W, int K, int N, bf16_t* WT, int row_off, LAS float* scr, int item, int lane) {
    const int nblk = N / 32, kb = item / nblk, nb = item % nblk, k0 = 64 * kb, n0 = 32 * nb;
#pragma unroll 8
    for (int i = 0; i < 32; ++i) { const int kk = 2 * i + (lane >> 5); scr[kk * 33 + (lane & 31)] = W[(size_t)(k0 + kk) * N + n0 + (lane & 31)]; }
    LDS_WAIT(); asm volatile("" ::: "memory");
    const int c = lane & 7;
#pragma unroll
    for (int j = 0; j < 4; ++j) { const int n = (lane >> 3) + 8 * j; const LAS float* s = scr + (8 * c) * 33 + n;
        v4u o; o.x = pk2(s[0 * 33], s[1 * 33]); o.y = pk2(s[2 * 33], s[3 * 33]); o.z = pk2(s[4 * 33], s[5 * 33]); o.w = pk2(s[6 * 33], s[7 * 33]);
        *(v4u*)(WT + (size_t)(row_off + n0 + n) * K + k0 + 8 * c) = o; }
    LDS_WAIT(); asm volatile("" ::: "memory");
}
struct TrJob { const float* W; int K, N; bf16_t* WT; int row_off; int items; };

DI void load_row16(const float* src, int lane, float (&v)[16]) {
#pragma unroll
    for (int j = 0; j < 4; ++j) { const f32x4_t t = *(const f32x4_t*)(src + j * 256 + lane * 4); v[4 * j] = t[0]; v[4 * j + 1] = t[1]; v[4 * j + 2] = t[2]; v[4 * j + 3] = t[3]; }
}
DI float row_rinv(const float (&v)[16]) {
    float ss = 0.f;
#pragma unroll
    for (int j = 0; j < 16; ++j) ss += v[j] * v[j];
    ss = wave_sum(ss);
    return rsqrtf(ss * (1.f / DM) + EPSN);
}
DI void store_modnorm(const float (&v)[16], float rinv, const float* g, const float* m, bf16_t* dst, int lane) {
#pragma unroll
    for (int j = 0; j < 4; ++j) { const int col = j * 256 + lane * 4;
        const f32x4_t gg = *(const f32x4_t*)(g + col), sc = *(const f32x4_t*)(m + 1024 + col), sh = *(const f32x4_t*)(m + col);
        float y[4];
#pragma unroll
        for (int e = 0; e < 4; ++e) y[e] = v[4 * j + e] * rinv * gg[e] * (1.f + sc[e]) + sh[e];
        v2u o; o.x = pk2(y[0], y[1]); o.y = pk2(y[2], y[3]); *(v2u*)(dst + col) = o; }
}

__global__ void __launch_bounds__(NTHREADS, 2) mega(Args args) {
    extern __shared__ __attribute__((aligned(16))) unsigned char lds_raw[];
    LAS unsigned char* lds = (LAS unsigned char*)lds_raw;
    volatile LAS unsigned* MISC = (volatile LAS unsigned*)(lds + MISC_OFF);
    const int tid = threadIdx.x, lane = tid & 63, wave = __builtin_amdgcn_readfirstlane(tid >> 6);
    const int G = gridDim.x;
    unsigned char* ws = args.ws;
    gu32* ctl = (gu32*)(ws + WS_CTL);
    for (int u = tid; u < (LDS_BYTES - LDSCTL_OFF) / 4; u += NTHREADS) ((LAS unsigned*)(lds + LDSCTL_OFF))[u] = 0u;
    __syncthreads();
    XcdBarrier bar = xcd_barrier_post((unsigned*)(ctl + CW_BAR) + args.li * XCD_BAR_WORDS, MISC + 8);
    const int lo = args.ph_lo, hi = args.ph_hi;
#define IN(k) (lo <= (k) && (k) < hi)
#ifndef PROBE_REP
#define PROBE_REP 0
#endif
#define PHASE_LOOP(k) for (int rep_ = 0, nrep_ = IN(k) ? 1 + ((PROBE_REP >> (k)) & 1) : 0; rep_ < nrep_; (++rep_ < nrep_) ? xcd_barrier(bar) : (void)0)
#define SEAM(k) do { if (IN(k) && IN((k) + 1)) xcd_barrier(bar); } while (0)

    const float* x = args.in[0]; const float* cvec = args.in[1]; const float* ctxin = args.in[2]; const float* cctx = args.in[3];
    const float* ada_w = args.in[4]; const float* ada_b = args.in[5]; const float* pre_g = args.in[6]; const float* post_g = args.in[7];
    float* out = args.out;
    float* MOD = (float*)(ws + WS_MOD);
    bf16_t* XN = (bf16_t*)(ws + WS_XN); bf16_t* YMIX = (bf16_t*)(ws + WS_YMIX); bf16_t* PROJ = (bf16_t*)(ws + WS_PROJ); float* OUTF = (float*)(ws + WS_PROJ);
    bf16_t* YPRE = (bf16_t*)(ws + WS_YPRE);
    const int gw = blockIdx.x * NWAVES + wave, NGW = G * NWAVES;

    PHASE_LOOP(0) {
        p0_adaln(lds, cvec, cctx, ada_w, ada_b, MOD, tid, wave, lane, G);
        __syncthreads();
        LAS float* scr = (LAS float*)(lds + 32768 + wave * 8704);
        const TrJob jobs[5] = {
            {args.in[8], 1024, 3072, (bf16_t*)(ws + WS_WIN0T), 0, 16 * 96}, {args.in[9], 1024, 1024, (bf16_t*)(ws + WS_WOUT0T), 0, 16 * 32},
            {args.in[21], 1024, 2304, (bf16_t*)(ws + WS_WIN1T), 0, 16 * 72}, {args.in[22], 1024, 1024, (bf16_t*)(ws + WS_WOUT1T), 0, 16 * 32},
            {args.in[18], 512, 512, (bf16_t*)(ws + WS_WGLUT), 0, 8 * 16}};
        constexpr int NBIG = 16 * 96 + 16 * 32 + 16 * 72 + 16 * 32 + 8 * 16, NLRU = 32 * 2;
        for (int it = gw; it < NBIG + NLRU; it += NGW) {
            if (it < NBIG) { int r = it;
#pragma unroll
                for (int j = 0; j < 5; ++j) { if (r >= 0 && r < jobs[j].items) p0_transpose_item(jobs[j].W, jobs[j].K, jobs[j].N, jobs[j].WT, 0, scr, r, lane); r -= jobs[j].items; }
            } else { const int q = it - NBIG, mat = q >> 1, sub = q & 1, dir = mat >> 4, gate = (mat >> 3) & 1, blk = mat & 7;
                const float* W = (gate ? args.in[28] : args.in[26]) + (size_t)(dir * 8 + blk) * 4096;
                p0_transpose_item(W, 64, 64, (bf16_t*)(ws + WS_LRUWT), blk * 256 + (dir * 2 + gate) * 64, scr, sub, lane); }
        }
    }
    PHASE_LOOP(0) {
        float* ROPE = (float*)(ws + WS_ROPE);
        for (int e = blockIdx.x * NTHREADS + tid; e < SEQ * 32; e += G * NTHREADS) { const int t = e >> 5, i = e & 31, f = i & 15; const float pos = (float)(i < 16 ? (t >> 6) : (t & 63));
            const float inv = (float)exp(-log(10000.0) * (double)(2 * f) / 32.0); const float ang = pos * inv; ROPE[2 * e] = cosf(ang); ROPE[2 * e + 1] = sinf(ang); }
    }
    PHASE_LOOP(0) {
        for (int it = G - 1 - (int)blockIdx.x; it < 64; it += G)
            s5_tables_block(it, args.in[10], args.in[11], args.in[12], args.in[13], args.in[14], args.in[15], args.in[16], (bf16_t*)(ws + WS_W16), (bf16_t*)(ws + WS_WC), (bf16_t*)(ws + WS_KT), (float*)(ws + WS_L16), lds, tid);
    }
    SEAM(0);
    PHASE_LOOP(1) {
        for (int r = gw; r < MROWS; r += NGW) {
            const float* src = r < NLAT ? x + (size_t)r * DM : ctxin + (size_t)(r - NLAT) * DM;
            float v[16]; load_row16(src, lane, v);
            store_modnorm(v, row_rinv(v), pre_g, MOD + (r < NLAT ? (r >> 12) : 4) * 3072, XN + (size_t)r * DM, lane);
        }
    }
    SEAM(1);
    PHASE_LOOP(2) {
        pg8::Gemm g{XN, (const bf16_t*)(ws + WS_WIN0T), MROWS, N0, DM}; pg8::StaticOrder S; S.init(MROWS, N0, G, (int)blockIdx.x);
        pg8::EpiProj E{PROJ, N0, nullptr, 1 << 30, 1 << 30, 512, false};
        pg8::gemm_phase<pg8::EpiProj, pg8::StaticOrder, kALIGN, kSP2>(lds, g, S, E);
    }
    SEAM(2);
    PHASE_LOOP(3) { phase3(args, lds, tid, wave, lane, G, rep_); }
    SEAM(3);
    PHASE_LOOP(4) { phase4(args, lds, tid, wave, lane, G); }
    SEAM(4);
    PHASE_LOOP(5) {
        pg8::Gemm g{YPRE, (const bf16_t*)(ws + WS_WGLUT), MROWS, 512, 512}; pg8::StaticOrder S; S.init(MROWS, 512, G, (int)blockIdx.x);
        pg8::EpiGlu E{YPRE, PROJ, args.in[19], YMIX};
        pg8::gemm_phase<pg8::EpiGlu, pg8::StaticOrder, kALIGN, kSP2>(lds, g, S, E);
    }
    SEAM(5);
    PHASE_LOOP(6) {
        pg8::Gemm g{YMIX, (const bf16_t*)(ws + WS_WOUT0T), MROWS, DM, DM}; pg8::StaticOrder S; S.init(MROWS, DM, G, (int)blockIdx.x);
        pg8::EpiF32 E{OUTF, DM};
        pg8::gemm_phase<pg8::EpiF32, pg8::StaticOrder, kALIGN, kSP2>(lds, g, S, E);
    }
    SEAM(6);
    PHASE_LOOP(7) {
        for (int r = gw; r < MROWS; r += NGW) {
            const int mrow = r < NLAT ? (r >> 12) : 4;
            const float* hin = r < NLAT ? x + (size_t)r * DM : ctxin + (size_t)(r - NLAT) * DM;
            float v[16], h[16]; load_row16(OUTF + (size_t)r * DM, lane, v); load_row16(hin, lane, h);
            const float rinv = row_rinv(v); const float* gt = MOD + mrow * 3072 + 2048;
#pragma unroll
            for (int j = 0; j < 4; ++j) { const int col = j * 256 + lane * 4; const f32x4_t pg = *(const f32x4_t*)(post_g + col), gg = *(const f32x4_t*)(gt + col);
#pragma unroll
                for (int e = 0; e < 4; ++e) h[4 * j + e] += gg[e] * (v[4 * j + e] * rinv * pg[e]);
                if (r < NLAT) *(f32x4_t*)(out + (size_t)r * DM + col) = (f32x4_t){h[4 * j], h[4 * j + 1], h[4 * j + 2], h[4 * j + 3]}; }
            store_modnorm(h, row_rinv(h), pre_g + DM, MOD + (5 + mrow) * 3072, XN + (size_t)r * DM, lane);
        }
    }
    SEAM(7);
    PHASE_LOOP(8) {
        pg8::Gemm g{XN, (const bf16_t*)(ws + WS_WIN1T), MROWS, N1, DM}; pg8::StaticOrder S; S.init(MROWS, N1, G, (int)blockIdx.x);
        pg8::EpiProj E{PROJ, N1, (bf16_t*)(ws + WS_VT1), 1664, 1792, 128, true};
        pg8::gemm_phase<pg8::EpiProj, pg8::StaticOrder, kALIGN, kSP2>(lds, g, S, E);
    }
    SEAM(8);
    PHASE_LOOP(9) { phase9(args, lds, tid, wave, lane, G); }
    SEAM(9);
    PHASE_LOOP(10) { phase10(args, lds, tid, wave, lane, G); }
    SEAM(10);
    PHASE_LOOP(11) {
        pg8::Gemm g{YMIX, (const bf16_t*)(ws + WS_WOUT1T), NLAT, DM, DM}; pg8::StaticOrder S; S.init(NLAT, DM, G, (int)blockIdx.x);
        pg8::EpiF32 E{OUTF, DM};
        pg8::gemm_phase<pg8::EpiF32, pg8::StaticOrder, kALIGN, kSP2>(lds, g, S, E);
    }
    SEAM(11);
    PHASE_LOOP(12) {
        for (int r = gw; r < NLAT; r += NGW) {
            float v[16], h[16]; load_row16(OUTF + (size_t)r * DM, lane, v); load_row16(out + (size_t)r * DM, lane, h);
            const float rinv = row_rinv(v); const float* gt = MOD + (5 + (r >> 12)) * 3072 + 2048;
#pragma unroll
            for (int j = 0; j < 4; ++j) { const int col = j * 256 + lane * 4; const f32x4_t pg = *(const f32x4_t*)(post_g + DM + col), gg = *(const f32x4_t*)(gt + col);
                f32x4_t o;
#pragma unroll
                for (int e = 0; e < 4; ++e) o[e] = h[4 * j + e] + gg[e] * (v[4 * j + e] * rinv * pg[e]);
                *(f32x4_t*)(out + (size_t)r * DM + col) = o; }
        }
    }
#undef IN
#undef SEAM
}
__global__ void k_adaln(const float* c, const float* cctx, const float* ada_w, const float* ada_b, float* mod) {
    const int idx = blockIdx.x * blockDim.x + threadIdx.x;
    if (idx >= 2 * 5 * 3072) return;
    const int col = idx % 3072, r = (idx / 3072) % 5, i = idx / (3072 * 5);
    const float* cv = r < 4 ? c + r * 1024 : cctx;
    const float* W = ada_w + (size_t)i * 1024 * 3072;
    float acc = 0.f;
    for (int k = 0; k < 1024; ++k) acc += silu_f(cv[k]) * W[(size_t)k * 3072 + col];
    mod[idx] = acc + ada_b[i * 3072 + col];
}

__global__ void k_prenorm(const float* lat, const float* ctx, const float* g, const float* mod  , bf16_t* XN) {
    const int r = blockIdx.x * 4 + (threadIdx.x >> 6), lane = threadIdx.x & 63;
    if (r >= MROWS) return;
    const float* src = r < NLAT ? lat + (size_t)r * DM : ctx + (size_t)(r - NLAT) * DM;
    const float* m = mod + (r < NLAT ? (r >> 12) : 4) * 3072;
    float v[16]; float ss = 0.f;
#pragma unroll
    for (int j = 0; j < 4; ++j) { const float4 t = *(const float4*)(src + j * 256 + lane * 4); v[4 * j] = t.x; v[4 * j + 1] = t.y; v[4 * j + 2] = t.z; v[4 * j + 3] = t.w; }
#pragma unroll
    for (int j = 0; j < 16; ++j) ss += v[j] * v[j];
    ss = wave_sum(ss);
    const float rinv = rsqrtf(ss * (1.f / DM) + EPSN);
#pragma unroll
    for (int j = 0; j < 4; ++j)
#pragma unroll
        for (int e = 0; e < 4; ++e) { const int col = j * 256 + lane * 4 + e; const float y = v[4 * j + e] * rinv * g[col] * (1.f + m[1024 + col]) + m[col]; XN[(size_t)r * DM + col] = f2bf(y); }
}

__global__ void k_postnorm(const float* hlat, const float* hctx, const float* OUT, const float* pg, const float* mod, float* olat, float* octx, int nrows) {
    const int r = blockIdx.x * 4 + (threadIdx.x >> 6), lane = threadIdx.x & 63;
    if (r >= nrows) return;
    const float* hin = r < NLAT ? hlat + (size_t)r * DM : hctx + (size_t)(r - NLAT) * DM;
    float* ho = r < NLAT ? olat + (size_t)r * DM : octx + (size_t)(r - NLAT) * DM;
    const float* m = mod + (r < NLAT ? (r >> 12) : 4) * 3072 + 2048;
    const float* src = OUT + (size_t)r * DM;
    float v[16]; float ss = 0.f;
#pragma unroll
    for (int j = 0; j < 4; ++j) { const float4 t = *(const float4*)(src + j * 256 + lane * 4); v[4 * j] = t.x; v[4 * j + 1] = t.y; v[4 * j + 2] = t.z; v[4 * j + 3] = t.w; }
#pragma unroll
    for (int j = 0; j < 16; ++j) ss += v[j] * v[j];
    ss = wave_sum(ss);
    const float rinv = rsqrtf(ss * (1.f / DM) + EPSN);
#pragma unroll
    for (int j = 0; j < 4; ++j)
#pragma unroll
        for (int e = 0; e < 4; ++e) { const int col = j * 256 + lane * 4 + e; ho[col] = hin[col] + m[col] * (v[4 * j + e] * rinv * pg[col]); }
}

enum { GM_PROJ0 = 0, GM_PROJ1 = 1, GM_GLU = 2, GM_F32 = 3 };
struct GemmEpi { bf16_t* P; bf16_t* VT; const bf16_t* YPRE; const bf16_t* PROJ; const float* bglu; bf16_t* YMIX; float* OUT; };
template <int MODE> __global__ void __launch_bounds__(256) k_gemm(const bf16_t* A, const float* W, int M, int N, int K, GemmEpi e) {
    const int tx = threadIdx.x & 15, ty = threadIdx.x >> 4;
    const int c0 = blockIdx.x * 64 + tx * 4, r0 = blockIdx.y * 64 + ty * 4;
    float acc[4][4] = {};
    for (int k = 0; k < K; ++k) {
        const float4 w = *(const float4*)(W + (size_t)k * N + c0);
        const float wv[4] = {rbf(w.x), rbf(w.y), rbf(w.z), rbf(w.w)};
#pragma unroll
        for (int i = 0; i < 4; ++i) { const float a = bf2f(A[(size_t)(r0 + i) * K + k]);
#pragma unroll
            for (int j = 0; j < 4; ++j) acc[i][j] += a * wv[j]; }
    }
#pragma unroll
    for (int i = 0; i < 4; ++i)
#pragma unroll
        for (int j = 0; j < 4; ++j) {
            const int r = r0 + i, c = c0 + j; const float v = acc[i][j];
            if (MODE == GM_PROJ0) { e.P[(size_t)r * N0 + c] = f2bf(v);
                if (c >= 2048 && c < 2560) { const int hd = c - 2048; e.VT[((size_t)(row_batch(r) * 8) * 64 + hd) * POSN + row_pos(r)] = f2bf(v); } }
            else if (MODE == GM_PROJ1) { e.P[(size_t)r * N1 + c] = f2bf(v);
                if (c >= 1664 && c < 1792) { const int hd = c - 1664; e.VT[((size_t)(row_batch(r) * 2) * 64 + hd) * POSN + row_pos(r)] = f2bf(v); } }
            else if (MODE == GM_GLU) { const float y = bf2f(e.YPRE[(size_t)r * 512 + c]); const float ga = bf2f(e.PROJ[(size_t)r * N0 + 512 + c]);
                e.YMIX[(size_t)r * DM + c] = f2bf(y * sigmoid_f(v + e.bglu[c]) * silu_f(ga)); }
            else e.OUT[(size_t)r * N + c] = v;
        }
}

__global__ void __launch_bounds__(64) k_s5_scan(const bf16_t* PROJ, const float* lam_re, const float* lam_im, const float* log_dt, const float* b_re, const float* b_im,
                                                 const float* c_re, const float* c_im, float* YS) {
    const int p = threadIdx.x, id = blockIdx.x, dir = id & 1, g = (id >> 1) & 31, b = id >> 6;
    const int gi = (dir * 32 + g);
    const double lre = lam_re[gi * 64 + p], lim = lam_im[gi * 64 + p], dt = exp((double)log_dt[gi]);
    const double mag = exp(lre * dt); const float ar = (float)(mag * cos(lim * dt)), ai = (float)(mag * sin(lim * dt));
    const double nr = mag * cos(lim * dt) - 1.0, ni = mag * sin(lim * dt), den = lre * lre + lim * lim;
    const float cfr = (float)((nr * lre + ni * lim) / den), cfi = (float)((ni * lre - nr * lim) / den);
    float bbr[16], bbi[16], cr[16], ci[16];
#pragma unroll
    for (int h = 0; h < 16; ++h) { const float br = b_re[(gi * 64 + p) * 16 + h], bi = b_im[(gi * 64 + p) * 16 + h]; bbr[h] = cfr * br - cfi * bi; bbi[h] = cfr * bi + cfi * br;
        cr[h] = c_re[(gi * 16 + h) * 64 + p]; ci[h] = c_im[(gi * 16 + h) * 64 + p]; }
    float hr = 0.f, hi = 0.f;
    float* ys = YS + (size_t)dir * MROWS * 512;
    for (int pos = 0; pos < POSN; ++pos) {
        int row;
        if (dir == 0) row = pos_row(b, pos); else row = pos < LC ? NLAT + b * LC + (LC - 1 - pos) : b * SEQ + (SEQ - 1 - (pos - LC));
        const bf16_t* up = PROJ + (size_t)row * N0 + g * 16;
        float bur = 0.f, bui = 0.f;
#pragma unroll
        for (int h = 0; h < 16; ++h) { const float u = bf2f(up[h]); bur += bbr[h] * u; bui += bbi[h] * u; }
        const float nhr = ar * hr - ai * hi + bur, nhi = ar * hi + ai * hr + bui; hr = nhr; hi = nhi;
        float mine = 0.f;
#pragma unroll
        for (int h = 0; h < 16; ++h) { const float y = wave_sum(cr[h] * hr - ci[h] * hi); if (p == h) mine = y; }
        if (p < 16) ys[(size_t)row * 512 + g * 16 + p] = mine;
    }
}
__global__ void k_s5_finish(const bf16_t* PROJ, const float* YS, const float* dsk, bf16_t* YPRE) {
    const size_t idx = (size_t)blockIdx.x * blockDim.x + threadIdx.x; if (idx >= (size_t)MROWS * 512) return;
    const int ch = idx & 511; const size_t r = idx >> 9;
    const float y = dsk[ch] * bf2f(PROJ[r * N0 + ch]) + YS[idx] + YS[(size_t)MROWS * 512 + idx];
    YPRE[idx] = f2bf(gelu_tanh(y));
}

__global__ void __launch_bounds__(256) k_na_attn(const bf16_t* PROJ, const float* relb, bf16_t* YMIX) {
    const int wv = blockIdx.x * 4 + (threadIdx.x >> 6), lane = threadIdx.x & 63;
    if (wv >= MROWS * 8) return;
    const int h = wv & 7, r = wv >> 3, b = row_batch(r);
    const float q = bf2f(PROJ[(size_t)r * N0 + 1024 + h * 64 + lane]);
    float m = -INFINITY, l = 0.f, o = 0.f;
    if (r < NLAT) {
        const int t = r & 4095, qr = t >> 6, qc = t & 63;
        const int rs = min(max(qr - 4, 0), 56), cs = min(max(qc - 8, 0), 48);
        for (int kr = rs; kr < rs + 8; ++kr)
            for (int kc = cs; kc < cs + 16; ++kc) {
                const size_t kro = (size_t)(b * SEQ + kr * 64 + kc) * N0;
                float s = wave_sum(q * bf2f(PROJ[kro + 1536 + h * 64 + lane])) * 0.125f + relb[(h * 15 + (kr - qr + 7)) * 31 + (kc - qc + 15)];
                const float mn = fmaxf(m, s), al = __expf(m - mn), pp = __expf(s - mn);
                l = l * al + pp; o = o * al + pp * bf2f(PROJ[kro + 2048 + h * 64 + lane]); m = mn;
            }
    }
    for (int c = 0; c < LC; ++c) {
        const size_t kro = (size_t)(NLAT + b * LC + c) * N0;
        const float s = wave_sum(q * bf2f(PROJ[kro + 1536 + h * 64 + lane])) * 0.125f;
        const float mn = fmaxf(m, s), al = __expf(m - mn), pp = __expf(s - mn);
        l = l * al + pp; o = o * al + pp * bf2f(PROJ[kro + 2048 + h * 64 + lane]); m = mn;
    }
    const float gb = bf2f(PROJ[(size_t)r * N0 + 2560 + h * 64 + lane]);
    YMIX[(size_t)r * DM + 512 + h * 64 + lane] = f2bf(o / l * silu_f(gb));
}

__global__ void __launch_bounds__(64) k_lru(const bf16_t* P1, const float* conv_w, const float* conv_b, const float* lam, const float* w_a, const float* b_a,
                                            const float* w_x, const float* b_x, float* HS, bf16_t* YMIX) {
    __shared__ float xs[64];
    const int j = threadIdx.x, nb = blockIdx.x & 7, b = blockIdx.x >> 3, ch = nb * 64 + j;
    const float cw0 = conv_w[0 * 512 + ch], cw1 = conv_w[1 * 512 + ch], cw2 = conv_w[2 * 512 + ch], cw3 = conv_w[3 * 512 + ch], cb = conv_b[ch];
    for (int dir = 0; dir < 2; ++dir) {
        float wa[64], wx[64];
#pragma unroll
        for (int i = 0; i < 64; ++i) { wa[i] = w_a[((dir * 8 + nb) * 64 + i) * 64 + j]; wx[i] = w_x[((dir * 8 + nb) * 64 + i) * 64 + j]; }
        const float ba = b_a[dir * 512 + ch], bx = b_x[dir * 512 + ch];
        const float lm = lam[dir * 512 + ch]; const float sp = (-lm > 20.f) ? -lm : log1pf(__expf(-lm));
        float hst = 0.f;
        for (int pos = 0; pos < POSN; ++pos) {
            int s0, sl, t;
            if (pos < LC) { s0 = NLAT + b * LC; sl = LC; t = dir == 0 ? pos : LC - 1 - pos; }
            else { s0 = b * SEQ; sl = SEQ; t = dir == 0 ? pos - LC : SEQ - 1 - (pos - LC); }
            float xm1 = 0.f, x0, xp1 = 0.f, xp2 = 0.f;
            x0 = bf2f(P1[(size_t)(s0 + t) * N1 + ch]);
            if (t - 1 >= 0) xm1 = bf2f(P1[(size_t)(s0 + t - 1) * N1 + ch]);
            if (t + 1 < sl) xp1 = bf2f(P1[(size_t)(s0 + t + 1) * N1 + ch]);
            if (t + 2 < sl) xp2 = bf2f(P1[(size_t)(s0 + t + 2) * N1 + ch]);
            const float xc = cw0 * xm1 + cw1 * x0 + cw2 * xp1 + cw3 * xp2 + cb;
            __syncthreads(); xs[j] = xc; __syncthreads();
            float ga = ba, gx = bx;
#pragma unroll
            for (int i = 0; i < 64; ++i) { const float xi = xs[i]; ga += xi * wa[i]; gx += xi * wx[i]; }
            const float gr = sigmoid_f(ga), gi = sigmoid_f(gx);
            const float log_a = -8.f * gr * sp; const float a = __expf(log_a); const float mult = sqrtf(fmaxf(-expm1f(2.f * log_a), 0.f));
            hst = a * hst + mult * gi * xc;
            if (pos >= LC) { const size_t rr = (size_t)(s0 + t);
                if (dir == 0) HS[rr * 512 + ch] = hst;
                else { const float gc = bf2f(P1[rr * N1 + 512 + ch]); YMIX[rr * DM + ch] = f2bf((HS[rr * 512 + ch] + hst) * silu_f(gc)); } }
        }
    }
}

__global__ void __launch_bounds__(256) k_qkprep(const bf16_t* P1, const float* qn, const float* kn, bf16_t* QP, bf16_t* KP) {
    const int wv = blockIdx.x * 4 + (threadIdx.x >> 6), lane = threadIdx.x & 63;
    if (wv >= MROWS * 10) return;
    const int slot = wv % 10, r = wv / 10, b = row_batch(r);
    if (slot < 8 && r >= NLAT) return;
    const int col0 = slot < 8 ? 1024 + slot * 64 : 1536 + (slot - 8) * 64;
    const float x = bf2f(P1[(size_t)r * N1 + col0 + lane]);
    const float ss = wave_sum(x * x);
    float y = x * rsqrtf(ss * (1.f / 64.f) + EPSN) * (slot < 8 ? qn[lane] : kn[lane]);
    if (r < NLAT) {
        const int t = r & 4095, i = lane >> 1, f = i & 15; const float pos = (float)(i < 16 ? (t >> 6) : (t & 63));
        const float inv = (float)exp(-log(10000.0) * (double)(2 * f) / 32.0);
        const float ang = pos * inv; const float cs = cosf(ang), sn = sinf(ang);
        const float pr = __shfl_xor(y, 1);
        y = (lane & 1) ? (pr * sn + y * cs) : (y * cs - pr * sn);
    }
    if (slot < 8) QP[((size_t)(b * 8 + slot) * SEQ + (r & 4095)) * 64 + lane] = f2bf(y * (0.125f * LOG2E));
    else KP[((size_t)(b * 2 + (slot - 8)) * POSN + row_pos(r)) * 64 + lane] = f2bf(y);
}

__global__ void __launch_bounds__(256) k_gqa(const bf16_t* QP, const bf16_t* KP, const bf16_t* P1, bf16_t* YMIX) {
    const int wv = blockIdx.x * 4 + (threadIdx.x >> 6), lane = threadIdx.x & 63;
    if (wv >= NLAT * 8) return;
    const int hq = wv & 7, r = wv >> 3, b = r >> 12, t = r & 4095, kvh = hq >> 2;
    const float q = bf2f(QP[((size_t)(b * 8 + hq) * SEQ + t) * 64 + lane]);
    const bf16_t* kp = KP + (size_t)(b * 2 + kvh) * POSN * 64;
    float m = -INFINITY, l = 0.f, o = 0.f;
    for (int pos = 0; pos < POSN; ++pos) {
        const float s = wave_sum(q * bf2f(kp[(size_t)pos * 64 + lane]));
        const float v = bf2f(P1[(size_t)pos_row(b, pos) * N1 + 1664 + kvh * 64 + lane]);
        const float mn = fmaxf(m, s), al = exp2f(m - mn), pp = exp2f(s - mn);
        l = l * al + pp; o = o * al + pp * v; m = mn;
    }
    const float gd = bf2f(P1[(size_t)r * N1 + 1792 + hq * 64 + lane]);
    YMIX[(size_t)r * DM + 512 + hq * 64 + lane] = f2bf(o / l * silu_f(gd));
}

static int g_grid = 0;
static void launch_mega(Args a, int lo, int hi, int li, hipStream_t stream) {
    a.ph_lo = lo; a.ph_hi = hi; a.li = li;
    hipLaunchKernelGGL(mega, dim3(g_grid), dim3(NTHREADS), LDS_BYTES, stream, a);
    const hipError_t le = hipPeekAtLastError();
    if (le != hipSuccess) fprintf(stderr, "kernel_launch: mega[%d,%d) failed: %s\n", lo, hi, hipGetErrorName(le));
}
extern "C" void kernel_launch(void* const* d_in, const int* in_sizes, int n_in, void* d_out, int out_size, void* d_ws, size_t ws_size, hipStream_t stream) {
    if (g_grid == 0) {
        int dev = 0, cus = 0;
        if (hipGetDevice(&dev) != hipSuccess || hipDeviceGetAttribute(&cus, hipDeviceAttributeMultiprocessorCount, dev) != hipSuccess) { fprintf(stderr, "kernel_launch: device query failed\n"); g_grid = -1; return; }
        if (hipFuncSetAttribute((const void*)mega, hipFuncAttributeMaxDynamicSharedMemorySize, LDS_BYTES) != hipSuccess) { fprintf(stderr, "kernel_launch: hipFuncSetAttribute failed\n"); g_grid = -1; return; }
        int per_cu = 0;
        if (hipOccupancyMaxActiveBlocksPerMultiprocessor(&per_cu, (const void*)mega, NTHREADS, LDS_BYTES) != hipSuccess || per_cu < 1) fprintf(stderr, "kernel_launch: occupancy query says %d blocks/CU\n", per_cu);
        (void)hipGetLastError();
        g_grid = cus;
    }
    if (g_grid < 0) return;
    const float* x = (const float*)d_in[0]; const float* c = (const float*)d_in[1]; const float* ctx = (const float*)d_in[2]; const float* cctx = (const float*)d_in[3];
    const float* ada_w = (const float*)d_in[4]; const float* ada_b = (const float*)d_in[5]; const float* pre_g = (const float*)d_in[6]; const float* post_g = (const float*)d_in[7];
    const float* ev_w_in = (const float*)d_in[8]; const float* ev_w_out = (const float*)d_in[9];
    const float* s5_lre = (const float*)d_in[10]; const float* s5_lim = (const float*)d_in[11]; const float* s5_ldt = (const float*)d_in[12];
    const float* s5_bre = (const float*)d_in[13]; const float* s5_bim = (const float*)d_in[14]; const float* s5_cre = (const float*)d_in[15]; const float* s5_cim = (const float*)d_in[16];
    const float* s5_d = (const float*)d_in[17]; const float* s5_wglu = (const float*)d_in[18]; const float* s5_bglu = (const float*)d_in[19]; const float* relb = (const float*)d_in[20];
    const float* od_w_in = (const float*)d_in[21]; const float* od_w_out = (const float*)d_in[22]; const float* conv_w = (const float*)d_in[23]; const float* conv_b = (const float*)d_in[24];
    const float* lru_lam = (const float*)d_in[25]; const float* w_a = (const float*)d_in[26]; const float* b_a = (const float*)d_in[27]; const float* w_x = (const float*)d_in[28]; const float* b_x = (const float*)d_in[29];
    const float* qn = (const float*)d_in[30]; const float* kn = (const float*)d_in[31];
    char* ws = (char*)d_ws; float* out = (float*)d_out;
    float* MOD = (float*)(ws + WS_MOD); float* HC1 = (float*)(ws + WS_HC1);
    bf16_t* XN = (bf16_t*)(ws + WS_XN); bf16_t* YMIX = (bf16_t*)(ws + WS_YMIX); bf16_t* PROJ = (bf16_t*)(ws + WS_PROJ); float* OUTF = (float*)(ws + WS_PROJ);
    bf16_t* VT0 = (bf16_t*)(ws + WS_VT0); bf16_t* YPRE = (bf16_t*)(ws + WS_YPRE); bf16_t* QP = (bf16_t*)(ws + WS_QP); bf16_t* KP = (bf16_t*)(ws + WS_KP); bf16_t* VT1 = (bf16_t*)(ws + WS_VT1);
    float* YS = (float*)(ws + WS_YS); float* HS = (float*)(ws + WS_HS);
    (void)x; (void)c; (void)ctx; (void)cctx; (void)ada_w; (void)ada_b; (void)pre_g; (void)post_g; (void)ev_w_in; (void)ev_w_out; (void)s5_wglu; (void)od_w_in; (void)od_w_out; (void)MOD; (void)HC1; (void)XN; (void)OUTF; (void)VT0; (void)VT1; (void)out;

    if (hipMemsetAsync(ws + WS_CTL, 0, CTL_ZERO_BYTES, stream) != hipSuccess) { fprintf(stderr, "kernel_launch: memset failed\n"); return; }
    Args a{};
    for (int i = 0; i < 32; ++i) a.in[i] = (const float*)d_in[i];
    a.out = (float*)d_out; a.ws = (unsigned char*)d_ws;

    launch_mega(a, 0, N_PHASES, 0, stream);
    (void)relb; (void)conv_w; (void)conv_b; (void)lru_lam; (void)w_a; (void)b_a; (void)w_x; (void)b_x; (void)HS; (void)qn; (void)kn; (void)QP; (void)KP;
    (void)s5_lre; (void)s5_lim; (void)s5_ldt; (void)s5_bre; (void)s5_bim; (void)s5_cre; (void)s5_cim; (void)s5_d; (void)s5_bglu; (void)YS; (void)YPRE; (void)PROJ; (void)YMIX;
}
```

```cpp
#include <hip/hip_runtime.h>
#include <cstdint>
#include <cstdio>

typedef unsigned short bf16_t;
#define DI __device__ __forceinline__
#define GAS __attribute__((address_space(1)))
#define LAS __attribute__((address_space(3)))
typedef unsigned v4u __attribute__((ext_vector_type(4)));
typedef unsigned v2u __attribute__((ext_vector_type(2)));
typedef float f32x4_t __attribute__((ext_vector_type(4)));
typedef float f32x16_t __attribute__((ext_vector_type(16)));
typedef short bf16x8_t __attribute__((ext_vector_type(8)));
typedef short s16x4_t __attribute__((ext_vector_type(4)));
typedef GAS unsigned gu32;
typedef GAS unsigned long long gu64;
#define RLX_AGENT __ATOMIC_RELAXED, __HIP_MEMORY_SCOPE_AGENT
#define LDS_WAIT() asm volatile("s_waitcnt lgkmcnt(0)" ::: "memory")
#define VM_WAIT() asm volatile("s_waitcnt vmcnt(0)" ::: "memory")

DI float bf2f(bf16_t v) { return __uint_as_float((unsigned)v << 16); }
DI bf16_t f2bf(float f) { unsigned u = __float_as_uint(f); return (bf16_t)((u + 0x7fffu + ((u >> 16) & 1u)) >> 16); }
DI unsigned pk2(float lo, float hi) { return (unsigned)f2bf(lo) | ((unsigned)f2bf(hi) << 16); }
DI float bflo(unsigned w) { return __uint_as_float(w << 16); }
DI float bfhi(unsigned w) { return __uint_as_float(w & 0xffff0000u); }
DI float rbf(float f) { return bf2f(f2bf(f)); }
DI float wave_sum(float v) {
#pragma unroll
    for (int o = 1; o < 64; o <<= 1) v += __shfl_xor(v, o);
    return v;
}
DI float sigmoid_f(float x) { return __builtin_amdgcn_rcpf(1.f + __builtin_amdgcn_exp2f(-1.4426950408889634f * x)); }
DI float silu_f(float x) { return x * sigmoid_f(x); }
DI float gelu_tanh(float x) { const float u = 0.7978845608028654f * (x + 0.044715f * x * x * x); return 0.5f * x * (1.f + tanhf(u)); }
DI float gelu_fast(float x) { const float u = 1.5957691216057308f * (x + 0.044715f * x * x * x); return x * sigmoid_f(u); }

constexpr int NWAVES = 8, NTHREADS = 512;
constexpr int DM = 1024, NB = 4, SEQ = 4096, LC = 256;
constexpr int NLAT = NB * SEQ, NCTX = NB * LC, MROWS = NLAT + NCTX;
constexpr int N0 = 3072, N1 = 2304, POSN = LC + SEQ;
constexpr float EPSN = 1e-6f;
constexpr float LOG2E = 1.4426950408889634f;

constexpr size_t MiB = 1u << 20;
constexpr size_t WS_CTL = 0, CTL_ZERO_BYTES = 1 * MiB;
constexpr size_t WS_MOD = 1 * MiB;
constexpr size_t WS_ROPE = 2 * MiB;
constexpr size_t WS_L16 = 3 * MiB;
constexpr size_t WS_WIN0T = 4 * MiB;
constexpr size_t WS_WOUT0T = 10 * MiB;
constexpr size_t WS_WIN1T = 12 * MiB;
constexpr size_t WS_WOUT1T = 17 * MiB;
constexpr size_t WS_WGLUT = 19 * MiB;
constexpr size_t WS_LRUWT = 19 * MiB + 512 * 1024;
constexpr size_t WS_W16 = 20 * MiB;
constexpr size_t WS_WC = 24 * MiB;
constexpr size_t WS_KT = 28 * MiB;
constexpr size_t WS_LSUM = 29 * MiB;
constexpr size_t WS_XN = 32 * MiB;
constexpr size_t WS_YMIX = 66 * MiB;
constexpr size_t WS_PROJ = 100 * MiB;
constexpr size_t WS_VT0 = 202 * MiB;
constexpr size_t WS_CARRY1 = 219 * MiB;
constexpr size_t WS_YPRE = 228 * MiB;
constexpr size_t WS_QP = 202 * MiB;
constexpr size_t WS_KP = 218 * MiB;
constexpr size_t WS_VT1 = 223 * MiB;
constexpr size_t WS_YS = 32 * MiB;
constexpr size_t WS_HS = 32 * MiB;
constexpr size_t WS_HC1 = 246 * MiB;

DI int row_batch(int r) { return r < NLAT ? (r >> 12) : ((r - NLAT) >> 8); }
DI int row_pos(int r) { return r < NLAT ? LC + (r & 4095) : ((r - NLAT) & 255); }
DI int pos_row(int b, int pos) { return pos < LC ? NLAT + b * LC + pos : b * SEQ + (pos - LC); }

namespace pg8 {
#define PG8_LAS __attribute__((address_space(3)))
typedef unsigned short bf16_t;
typedef short bf16x8 __attribute__((ext_vector_type(8)));
typedef float f32x4 __attribute__((ext_vector_type(4)));
typedef unsigned u32x4 __attribute__((ext_vector_type(4)));
constexpr int BM = 256, BK = 64, HALF = 128, HTB = HALF * BK * 2  , STAGE_BYTES = 8 * HTB, NXCD = 8, WGM = 8;

__host__ __device__ __forceinline__ int lds_byte(int r, int c) { const int st = (r >> 4) * 2 + (c >> 5), rr = r & 15, cc = c & 31, ob = rr * 64 + cc * 2; return st * 1024 + (ob ^ (((ob >> 9) & 1) << 5)); }
__host__ __device__ __forceinline__ void stage_rc(int b, int& R, int& C) { const int st = b / 1024, sb = b % 1024, swz = sb ^ (((sb >> 9) & 1) << 5); R = (st >> 1) * 16 + swz / 64; C = (st & 1) * 32 + (swz % 64) / 2; }
__host__ __device__ __forceinline__ int perm32(int rho) { const int n = rho >> 4, i = rho & 15; return 8 * (i >> 2) + 4 * n + (i & 3); }

struct Unit { int pm, pn; };
struct Gemm { const bf16_t* A; const bf16_t* Bt; int M, N, K; };

struct StaticOrder {
    int nM, nN, nwg, G, c;
    __host__ __device__ void init(int M, int N, int G_, int c_) { nM = M / BM; nN = N / BM; nwg = nM * nN; G = G_; c = c_; }
    __host__ __device__ bool next(int i, Unit& u) const {
        const long L = (long)i * G + c; if (L >= nwg) return false;
        int wgid = (int)L; { const int q = nwg / NXCD, r = nwg % NXCD, xcd = wgid % NXCD, off = wgid / NXCD; wgid = (xcd < r ? xcd * (q + 1) : r * (q + 1) + (xcd - r) * q) + off; }
        const int nig = WGM * nN, gid = wgid / nig, fm = gid * WGM, gsz = (nM - fm) < WGM ? (nM - fm) : WGM;
        u.pm = fm + ((wgid % nig) % gsz); u.pn = (wgid % nig) / gsz; return true;
    }
    __device__ __forceinline__ void a_ready(const Unit&) const {}
    __device__ __forceinline__ void done(const Unit&) const {}
};

__device__ __forceinline__ unsigned cvt_pk_bf16(float lo, float hi) { unsigned r; asm volatile("v_cvt_pk_bf16_f32 %0, %1, %2" : "=v"(r) : "v"(lo), "v"(hi)); return r; }

struct EpiProj {
    static constexpr bool PERM = true, AFTER_DRAIN = false;
    bf16_t* P; int ldc; bf16_t* VT; int vt_lo, vt_hi, vt_w; bool vrow;
    __device__ __forceinline__ void operator()(const f32x4 (&acc)[2][2][4][2], const Unit& u, int wr, int wc, int fr, int fq) const {
        const int row0 = u.pm * BM + wr * 64 + fr, colt = u.pn * BM + wc * 32 + 8 * fq;
#pragma unroll
        for (int ai = 0; ai < 2; ++ai)
#pragma unroll
            for (int m = 0; m < 4; ++m) { const int r = row0 + ai * HALF + m * 16; bf16_t* rowp = P + (size_t)r * ldc + colt;
#pragma unroll
                for (int bj = 0; bj < 2; ++bj) { const f32x4 v0 = acc[ai][bj][m][0], v1 = acc[ai][bj][m][1];
                    u32x4 w; w.x = cvt_pk_bf16(v0[0], v0[1]); w.y = cvt_pk_bf16(v0[2], v0[3]); w.z = cvt_pk_bf16(v1[0], v1[1]); w.w = cvt_pk_bf16(v1[2], v1[3]);
                    *(u32x4*)(rowp + bj * HALF) = w;
                    const int c0 = colt + bj * HALF;
                    if (c0 >= vt_lo && c0 < vt_hi && vrow) {
                        const int hd = c0 - vt_lo; *(u32x4*)(VT + ((size_t)(row_batch(r) * (vt_w >> 6) + (hd >> 6)) * POSN + row_pos(r)) * 64 + (hd & 63)) = w;
                    } else if (c0 >= vt_lo && c0 < vt_hi) {
                        bf16_t* vp = VT + ((size_t)row_batch(r) * vt_w + (c0 - vt_lo)) * POSN + row_pos(r);
                        vp[0 * POSN] = (bf16_t)(w.x & 0xffffu); vp[1 * POSN] = (bf16_t)(w.x >> 16); vp[2 * POSN] = (bf16_t)(w.y & 0xffffu); vp[3 * POSN] = (bf16_t)(w.y >> 16);
                        vp[4 * POSN] = (bf16_t)(w.z & 0xffffu); vp[5 * POSN] = (bf16_t)(w.z >> 16); vp[6 * POSN] = (bf16_t)(w.w & 0xffffu); vp[7 * POSN] = (bf16_t)(w.w >> 16);
                    } } }
    }
};
struct EpiGlu {
    static constexpr bool PERM = true, AFTER_DRAIN = false;
    const bf16_t* YPRE; const bf16_t* PROJ; const float* bglu; bf16_t* YMIX;
    __device__ __forceinline__ void operator()(const f32x4 (&acc)[2][2][4][2], const Unit& u, int wr, int wc, int fr, int fq) const {
        const int row0 = u.pm * BM + wr * 64 + fr, colt = u.pn * BM + wc * 32 + 8 * fq;
#pragma unroll
        for (int bj = 0; bj < 2; ++bj) { const int c0 = colt + bj * HALF;
            const f32x4 b0 = *(const f32x4*)(bglu + c0), b1 = *(const f32x4*)(bglu + c0 + 4);
#pragma unroll
            for (int ai = 0; ai < 2; ++ai)
#pragma unroll
                for (int m = 0; m < 4; ++m) { const int r = row0 + ai * HALF + m * 16;
                    const u32x4 yv = *(const u32x4*)(YPRE + (size_t)r * 512 + c0), gv = *(const u32x4*)(PROJ + (size_t)r * N0 + 512 + c0);
                    const f32x4 a0 = acc[ai][bj][m][0] + b0, a1 = acc[ai][bj][m][1] + b1;
                    float o[8];
                    o[0] = bflo(yv.x) * sigmoid_f(a0[0]) * silu_f(bflo(gv.x)); o[1] = bfhi(yv.x) * sigmoid_f(a0[1]) * silu_f(bfhi(gv.x));
                    o[2] = bflo(yv.y) * sigmoid_f(a0[2]) * silu_f(bflo(gv.y)); o[3] = bfhi(yv.y) * sigmoid_f(a0[3]) * silu_f(bfhi(gv.y));
                    o[4] = bflo(yv.z) * sigmoid_f(a1[0]) * silu_f(bflo(gv.z)); o[5] = bfhi(yv.z) * sigmoid_f(a1[1]) * silu_f(bfhi(gv.z));
                    o[6] = bflo(yv.w) * sigmoid_f(a1[2]) * silu_f(bflo(gv.w)); o[7] = bfhi(yv.w) * sigmoid_f(a1[3]) * silu_f(bfhi(gv.w));
                    u32x4 w; w.x = cvt_pk_bf16(o[0], o[1]); w.y = cvt_pk_bf16(o[2], o[3]); w.z = cvt_pk_bf16(o[4], o[5]); w.w = cvt_pk_bf16(o[6], o[7]);
                    *(u32x4*)(YMIX + (size_t)r * DM + c0) = w; } }
    }
};
struct EpiF32 {
    static constexpr bool PERM = false, AFTER_DRAIN = false;
    float* O; int ldc;
    __device__ __forceinline__ void operator()(const f32x4 (&acc)[2][2][4][2], const Unit& u, int wr, int wc, int fr, int fq) const {
        const int row0 = u.pm * BM + wr * 64 + fr, col0 = u.pn * BM + wc * 32 + 4 * fq;
#pragma unroll
        for (int ai = 0; ai < 2; ++ai)
#pragma unroll
            for (int m = 0; m < 4; ++m) { float* rowp = O + (size_t)(row0 + ai * HALF + m * 16) * ldc + col0;
#pragma unroll
                for (int bj = 0; bj < 2; ++bj)
#pragma unroll
                    for (int n = 0; n < 2; ++n) *(f32x4*)(rowp + bj * HALF + n * 16) = acc[ai][bj][m][n]; }
    }
};
template <class Epi, class Sched, bool ALIGN_EPI = false, bool SP2 = false>
__device__ __forceinline__ void gemm_phase(PG8_LAS unsigned char* lds, const Gemm g, const Sched& S, const Epi& E) {
    const int tid = threadIdx.x, wid = __builtin_amdgcn_readfirstlane(tid >> 6), lane = tid & 63, wr = wid >> 2, wc = wid & 3, fr = lane & 15, fq = lane >> 4;
    const int K = g.K, nt = K / BK;
    unsigned voffA[2], voffB[2];
#pragma unroll
    for (int i = 0; i < 2; ++i) { int R, C; stage_rc(tid * 16 + i * 8192, R, C); const int Rb = Epi::PERM ? ((R & ~31) + perm32(R & 31)) : R;
        voffA[i] = (unsigned)(R * K + C) * 2u; voffB[i] = (unsigned)(Rb * K + C) * 2u; }
    const size_t kstep = (size_t)(BK * 2);
    const size_t hstep = (size_t)HALF * K * 2;
    const size_t tstep = 2 * hstep;
    const unsigned ldsw = (unsigned)wid * 1024u;
    const int aoff = lds_byte(wr * 64 + fr, fq * 8), boff = lds_byte(wc * 32 + fr, fq * 8);
#define PG8_SA(b, h) (((b) * 2 + (h)) * HTB)
#define PG8_SB(b, h) ((4 + (b) * 2 + (h)) * HTB)
#define PG8_STAGE(bufoff, gbase, voff) do { _Pragma("unroll") for (int _i = 0; _i < 2; ++_i) \
        __builtin_amdgcn_global_load_lds((const unsigned*)((const char*)(gbase) + (voff)[_i]), (PG8_LAS unsigned*)(lds + (bufoff) + ldsw + _i * 8192), 16, 0, 0); } while (0)
#define PG8_LDA(dst, b, h) do { _Pragma("unroll") for (int m = 0; m < 4; ++m) _Pragma("unroll") for (int k = 0; k < 2; ++k) dst[m][k] = *(const PG8_LAS bf16x8*)(lds + PG8_SA(b, h) + aoff + m * 2048 + k * 1024); } while (0)
#define PG8_LDB(dst, b, h) do { _Pragma("unroll") for (int n = 0; n < 2; ++n) _Pragma("unroll") for (int k = 0; k < 2; ++k) dst[n][k] = *(const PG8_LAS bf16x8*)(lds + PG8_SB(b, h) + boff + n * 2048 + k * 1024); } while (0)
#define PG8_MMA(ai, bj, At, Bt) do { __builtin_amdgcn_s_setprio(1); _Pragma("unroll") for (int m = 0; m < 4; ++m) _Pragma("unroll") for (int n = 0; n < 2; ++n) _Pragma("unroll") for (int k = 0; k < 2; ++k) \
        acc[ai][bj][m][n] = __builtin_amdgcn_mfma_f32_16x16x32_bf16(Bt[n][k], At[m][k], acc[ai][bj][m][n], 0, 0, 0); __builtin_amdgcn_s_setprio(0); } while (0)
#define PG8_WAIT_V(n) asm volatile("s_waitcnt vmcnt(" #n ")" ::: "memory")
#define PG8_WAIT_L(n) asm volatile("s_waitcnt lgkmcnt(" #n ")" ::: "memory")
#define PG8_BAR __builtin_amdgcn_s_barrier()
#define PG8_SCHED __builtin_amdgcn_sched_barrier(0)
    Unit cur, nxt; int ui = 0;
    if (!S.next(0, cur)) return;
    f32x4 acc[2][2][4][2];
#pragma unroll
    for (int a = 0; a < 2; ++a)
#pragma unroll
        for (int b = 0; b < 2; ++b)
#pragma unroll
            for (int m = 0; m < 4; ++m)
#pragma unroll
                for (int n = 0; n < 2; ++n) acc[a][b][m][n] = (f32x4){0.f, 0.f, 0.f, 0.f};
    bf16x8 At[4][2], B0[2][2], B1[2][2];
    const char* cA = (const char*)g.A + (size_t)cur.pm * tstep; const char* cB = (const char*)g.Bt + (size_t)cur.pn * tstep;
    S.a_ready(cur);
    if constexpr (SP2) {
        PG8_STAGE(PG8_SB(0, 0), cB, voffB); PG8_STAGE(PG8_SB(0, 1), cB + hstep, voffB); PG8_STAGE(PG8_SA(0, 0), cA, voffA); PG8_STAGE(PG8_SA(0, 1), cA + hstep, voffA);
        if (wr == 1) PG8_BAR;
        PG8_WAIT_V(2); PG8_BAR;
        PG8_STAGE(PG8_SB(1, 0), cB + kstep, voffB); PG8_STAGE(PG8_SA(1, 0), cA + kstep, voffA); PG8_STAGE(PG8_SB(1, 1), cB + hstep + kstep, voffB);
        PG8_WAIT_V(6); PG8_BAR;
    } else {
        PG8_STAGE(PG8_SB(0, 0), cB, voffB); PG8_STAGE(PG8_SA(0, 0), cA, voffA); PG8_STAGE(PG8_SB(0, 1), cB + hstep, voffB); PG8_STAGE(PG8_SA(0, 1), cA + hstep, voffA);
        if (wr == 1) PG8_BAR;
        PG8_WAIT_V(4); PG8_BAR;
        PG8_STAGE(PG8_SB(1, 0), cB + kstep, voffB); PG8_STAGE(PG8_SA(1, 0), cA + kstep, voffA); PG8_STAGE(PG8_SB(1, 1), cB + hstep + kstep, voffB);
        PG8_WAIT_V(6); PG8_BAR;
    }
    for (;;) {
        const bool has_next = S.next(ui + 1, nxt);
        const char* nA = has_next ? (const char*)g.A + (size_t)nxt.pm * tstep : cA; const char* nB = has_next ? (const char*)g.Bt + (size_t)nxt.pn * tstep : cB;
        for (int t = 0; t < nt; t += 2) {
            const bool last = (t == nt - 2);
            const char* a1 = cA + (size_t)(t + 1) * kstep;
            const char* a2 = last ? nA : cA + (size_t)(t + 2) * kstep; const char* b2 = last ? nB : cB + (size_t)(t + 2) * kstep;
            const char* a3 = a2 + kstep; const char* b3 = b2 + kstep;
            if (last && has_next) S.a_ready(nxt);
            if constexpr (SP2) {
            PG8_LDB(B0, 0, 0); PG8_LDB(B1, 0, 1); PG8_SCHED; PG8_LDA(At, 0, 0); PG8_STAGE(PG8_SA(1, 1), a1 + hstep, voffA);
            PG8_WAIT_V(8); PG8_WAIT_L(0); PG8_BAR; PG8_MMA(0, 0, At, B0); PG8_MMA(0, 1, At, B1); PG8_BAR; PG8_SCHED;
            PG8_LDA(At, 0, 1); PG8_STAGE(PG8_SB(0, 0), b2, voffB); PG8_STAGE(PG8_SB(0, 1), b2 + hstep, voffB); PG8_STAGE(PG8_SA(0, 0), a2, voffA);
            PG8_WAIT_V(8); PG8_WAIT_L(0); PG8_BAR; PG8_MMA(1, 0, At, B0); PG8_MMA(1, 1, At, B1); PG8_BAR; PG8_SCHED;
            PG8_LDB(B0, 1, 0); PG8_LDB(B1, 1, 1); PG8_SCHED; PG8_LDA(At, 1, 0); PG8_STAGE(PG8_SA(0, 1), a2 + hstep, voffA);
            PG8_WAIT_V(8); PG8_WAIT_L(0); PG8_BAR; PG8_MMA(0, 0, At, B0); PG8_MMA(0, 1, At, B1); PG8_BAR; PG8_SCHED;
            PG8_LDA(At, 1, 1); PG8_STAGE(PG8_SB(1, 0), b3, voffB); PG8_STAGE(PG8_SB(1, 1), b3 + hstep, voffB); PG8_STAGE(PG8_SA(1, 0), a3, voffA);
            PG8_WAIT_V(8); PG8_WAIT_L(0); PG8_BAR; PG8_MMA(1, 0, At, B0); PG8_MMA(1, 1, At, B1); PG8_BAR; PG8_SCHED;
            } else {
            PG8_LDB(B0, 0, 0); PG8_SCHED; PG8_LDA(At, 0, 0); PG8_STAGE(PG8_SA(1, 1), a1 + hstep, voffA);
            PG8_WAIT_L(8); PG8_BAR; PG8_WAIT_L(0); PG8_MMA(0, 0, At, B0); PG8_BAR; PG8_SCHED;
            PG8_LDB(B1, 0, 1); PG8_STAGE(PG8_SB(0, 0), b2, voffB);
            PG8_BAR; PG8_WAIT_L(0); PG8_MMA(0, 1, At, B1); PG8_BAR;
            PG8_LDA(At, 0, 1); PG8_STAGE(PG8_SA(0, 0), a2, voffA);
            PG8_BAR; PG8_WAIT_L(0); PG8_MMA(1, 0, At, B0); PG8_BAR; PG8_SCHED;
            PG8_STAGE(PG8_SB(0, 1), b2 + hstep, voffB);
            PG8_WAIT_V(6); PG8_BAR; PG8_MMA(1, 1, At, B1); PG8_BAR;
            PG8_LDB(B0, 1, 0); PG8_SCHED; PG8_LDA(At, 1, 0); PG8_STAGE(PG8_SA(0, 1), a2 + hstep, voffA);
            PG8_WAIT_L(8); PG8_BAR; PG8_WAIT_L(0); PG8_MMA(0, 0, At, B0); PG8_BAR; PG8_SCHED;
            PG8_LDB(B1, 1, 1); PG8_STAGE(PG8_SB(1, 0), b3, voffB);
            PG8_BAR; PG8_WAIT_L(0); PG8_MMA(0, 1, At, B1); PG8_BAR;
            PG8_LDA(At, 1, 1); PG8_STAGE(PG8_SA(1, 0), a3, voffA);
            PG8_BAR; PG8_WAIT_L(0); PG8_MMA(1, 0, At, B0); PG8_BAR; PG8_SCHED;
            PG8_STAGE(PG8_SB(1, 1), b3 + hstep, voffB);
            PG8_WAIT_V(6); PG8_BAR; PG8_MMA(1, 1, At, B1); PG8_BAR;
            }
        }
        if constexpr (ALIGN_EPI) { if (wr == 0) PG8_BAR; }
        if constexpr (!Epi::AFTER_DRAIN) { E(acc, cur, wr, wc, fr, fq); S.done(cur); }
        if (!has_next) break;
#pragma unroll
        for (int a = 0; a < 2; ++a)
#pragma unroll
            for (int b = 0; b < 2; ++b)
#pragma unroll
                for (int m = 0; m < 4; ++m)
#pragma unroll
                    for (int n = 0; n < 2; ++n) acc[a][b][m][n] = (f32x4){0.f, 0.f, 0.f, 0.f};
        cur = nxt; cA = nA; cB = nB; ++ui;
        if constexpr (ALIGN_EPI) { if (wr == 1) PG8_BAR; }
    }
    PG8_WAIT_V(0);
    if constexpr (!ALIGN_EPI) { if (wr == 0) PG8_BAR; }
    PG8_BAR;
    if constexpr (Epi::AFTER_DRAIN) { E.fused(acc, cur, wr, wc, fr, fq, lds, wid, lane); S.done(cur); }
#undef PG8_SA
#undef PG8_SB
#undef PG8_STAGE
#undef PG8_LDA
#undef PG8_LDB
#undef PG8_MMA
#undef PG8_WAIT_V
#undef PG8_WAIT_L
#undef PG8_BAR
#undef PG8_SCHED
}
}
#define XB_TMO      128
#define XB_XCNT(j)  (256  + 64 * (j))
#define XB_XSUB(j)  (1280 + 64 * (j))
#define XB_XGEN(j)  (2304 + 64 * (j))
#define XB_TOP      3328
#define XB_TOPGEN   3392
#define XCD_BAR_WORDS 3456
#define XB_SPIN_CAP (1u << 18)

__device__ __forceinline__ unsigned xb_ld(unsigned* p)              { return __hip_atomic_load(p, __ATOMIC_RELAXED, __HIP_MEMORY_SCOPE_AGENT); }
__device__ __forceinline__ unsigned xb_add(unsigned* p, unsigned v) { return __hip_atomic_fetch_add(p, v, __ATOMIC_RELAXED, __HIP_MEMORY_SCOPE_AGENT); }
__device__ __forceinline__ unsigned xb_xcc_id() { return (unsigned)__builtin_amdgcn_s_getreg((3 << 11) | 20) & 0xFu; }
#define XB_SPIN(cond, bar) do { unsigned _sp = 0; while (cond) { __builtin_amdgcn_s_sleep(1); \
    if ((++_sp & 255u) == 0u) { if (xb_ld(&(bar)[XB_TMO])) break; if (_sp > XB_SPIN_CAP) { atomicAdd(&(bar)[XB_TMO], 1u); break; } } } } while (0)

struct XcdBarrier {
    unsigned* bar; unsigned x;
    volatile LAS unsigned* st;
};

__device__ __forceinline__ XcdBarrier xcd_barrier_post(unsigned* bar, volatile LAS unsigned* st) {
    XcdBarrier b; b.bar = bar; b.x = xb_xcc_id(); b.st = st;
    if (threadIdx.x == 0) (void)xb_add(&bar[XB_XCNT(b.x)], 1u);
    return b;
}
__device__ __forceinline__ void xcd_barrier_complete(unsigned* bar, unsigned x, unsigned& nloc, unsigned& nx) {
    const unsigned G = gridDim.x * gridDim.y * gridDim.z;
    unsigned sum, cnt, mine, sp = 0u;
    for (;;) {
        sum = 0u; cnt = 0u; mine = 0u;
#pragma unroll
        for (unsigned j = 0; j < 16; ++j) { const unsigned c = xb_ld(&bar[XB_XCNT(j)]); sum += c; cnt += (c > 0u) ? 1u : 0u; mine = (j == x) ? c : mine; }
        if (sum == G) break;
        __builtin_amdgcn_s_sleep(1);
        if ((++sp & 255u) == 0u) { if (xb_ld(&bar[XB_TMO])) break; if (sp > XB_SPIN_CAP) { atomicAdd(&bar[XB_TMO], 1u); break; } }
    }
    nloc = mine > 0u ? mine : 1u; nx = cnt > 0u ? cnt : 1u;
}

__device__ __forceinline__ void xcd_barrier(const XcdBarrier& b) {
    asm volatile("s_waitcnt vmcnt(0)" ::: "memory");
    __syncthreads();
    if (threadIdx.x == 0) {
        unsigned* bar = b.bar;
        __builtin_amdgcn_s_waitcnt(0);
        unsigned nloc = b.st[0], nx = b.st[1];
        if (nloc == 0u) { xcd_barrier_complete(bar, b.x, nloc, nx); b.st[0] = nloc; b.st[1] = nx; }
        const unsigned old = xb_add(&bar[XB_XSUB(b.x)], 1u);
        const unsigned gen = old / nloc;
        if (old + 1u == (gen + 1u) * nloc) {
            __builtin_amdgcn_fence(__ATOMIC_RELEASE, "agent");
            asm volatile("s_waitcnt vmcnt(0)" ::: "memory");
            const unsigned og = xb_add(&bar[XB_TOP], 1u);
            const unsigned tg = og / nx;
            if (og + 1u == (tg + 1u) * nx) xb_add(&bar[XB_TOPGEN], 1u);
            else XB_SPIN(xb_ld(&bar[XB_TOPGEN]) == tg, bar);
            __builtin_amdgcn_fence(__ATOMIC_ACQUIRE, "agent");
            xb_add(&bar[XB_XGEN(b.x)], 1u);
            asm volatile("s_waitcnt vmcnt(0)" ::: "memory");
        } else {
            XB_SPIN(xb_ld(&bar[XB_XGEN(b.x)]) == gen, bar);
            __builtin_amdgcn_fence(__ATOMIC_ACQUIRE, "agent");
            asm volatile("s_waitcnt vmcnt(0)" ::: "memory");
        }
    }
    __syncthreads();
}

DI int crow16(int reg, int hf) { return (reg & 3) + 8 * (reg >> 2) + 4 * hf; }
DI unsigned cvtpk(float lo, float hi) { typedef float f2 __attribute__((ext_vector_type(2))); typedef __bf16 b2 __attribute__((ext_vector_type(2))); f2 v = {lo, hi}; b2 b = __builtin_convertvector(v, b2); return __builtin_bit_cast(unsigned, b); }
struct AttnP { const bf16_t* Q; const bf16_t* K; const bf16_t* VT; const bf16_t* Gt; bf16_t* Y; const float* relb; };

template <int MODE> DI void attn_unit(int unit, const AttnP& P, int lane) {
    const int ql = lane & 31, hf = lane >> 5;
    int b, h, kvh, qrow, NT, rp = 0, ci = 0, rs0 = 0, c0 = 0, qr = 0, qc = 0, rsq = 0, csq = 0;
    if (MODE == 0) { ci = unit & 3; rp = (unit >> 2) & 31; h = (unit >> 7) & 7; b = unit >> 10; kvh = h;
        qr = 2 * rp + (ql >> 4); qc = 16 * ci + (ql & 15); qrow = b * SEQ + qr * 64 + qc;
        rs0 = min(max(2 * rp - 4, 0), 56); const int rs1 = min(max(2 * rp - 3, 0), 56); NT = 8 + (rs1 + 8 - rs0);
        c0 = min(max(16 * ci - 8, 0), 32); rsq = min(max(qr - 4, 0), 56); csq = min(max(qc - 8, 0), 48);
    } else if (MODE == 1) { const int qt = unit & 7; h = (unit >> 3) & 7; b = unit >> 6; kvh = h; qrow = NLAT + b * LC + 32 * qt + ql; NT = 8; }
    else { const int qt = unit & 127; h = (unit >> 7) & 7; b = unit >> 10; kvh = h >> 2; qrow = b * SEQ + 32 * qt + ql; NT = POSN / 32; }
    const bf16_t* qp; const bf16_t* kb; size_t kpitch; const bf16_t* vt; const bf16_t* gp; bf16_t* yp;
    if (MODE == 2) { qp = P.Q + ((size_t)(b * 8 + h) * SEQ + (qrow - b * SEQ)) * 64; kb = P.K + (size_t)(b * 2 + kvh) * POSN * 64; kpitch = 64;
        vt = P.VT + (size_t)(b * 2 + kvh) * 64 * POSN; gp = P.Gt + (size_t)qrow * N1 + 1792 + h * 64; }
    else { qp = P.Q + (size_t)qrow * N0 + 1024 + h * 64; kb = P.K + 1536 + h * 64; kpitch = N0; vt = P.VT + (size_t)(b * 8 + h) * 64 * POSN; gp = P.Gt + (size_t)qrow * N0 + 2560 + h * 64; }
    yp = P.Y + (size_t)qrow * DM + 512 + h * 64;
    bf16x8_t qf[4];
#pragma unroll
    for (int ks = 0; ks < 4; ++ks) qf[ks] = *(const bf16x8_t*)(qp + 16 * ks + 8 * hf);
    const bf16_t* vt0 = vt + (size_t)ql * POSN + 4 * hf;
    f32x16_t o0 = {}, o1 = {};
    float m = -1e30f, l = 0.f;
    auto tile_krow = [&](int t) -> int { if (MODE == 2) return 32 * t + ql; if (t < 8) return NLAT + b * LC + 32 * t + ql; return b * SEQ + (rs0 + t - 8) * 64 + c0 + ql; };
    auto tile_pos0 = [&](int t) -> int { if (MODE == 2) return 32 * t; if (t < 8) return 32 * t; return LC + (rs0 + t - 8) * 64 + c0; };
    bf16x8_t kn[4];
    { const bf16_t* kp = kb + (size_t)tile_krow(0) * kpitch + 8 * hf;
#pragma unroll
      for (int ks = 0; ks < 4; ++ks) kn[ks] = *(const bf16x8_t*)(kp + 16 * ks); }
#pragma unroll 1
    for (int t = 0; t < NT; ++t) {
        bf16x8_t kf[4];
#pragma unroll
        for (int ks = 0; ks < 4; ++ks) kf[ks] = kn[ks];
        if (t + 1 < NT) { const bf16_t* kp = kb + (size_t)tile_krow(t + 1) * kpitch + 8 * hf;
#pragma unroll
            for (int ks = 0; ks < 4; ++ks) kn[ks] = *(const bf16x8_t*)(kp + 16 * ks); }
        const bf16_t* vp = vt0 + tile_pos0(t);
        s16x4_t va[2][2][2];
#pragma unroll
        for (int dt = 0; dt < 2; ++dt)
#pragma unroll
            for (int s = 0; s < 2; ++s) { va[dt][s][0] = *(const s16x4_t*)(vp + (size_t)dt * 32 * POSN + 16 * s); va[dt][s][1] = *(const s16x4_t*)(vp + (size_t)dt * 32 * POSN + 16 * s + 8); }
        f32x16_t sc = {};
#pragma unroll
        for (int ks = 0; ks < 4; ++ks) sc = __builtin_amdgcn_mfma_f32_32x32x16_bf16(kf[ks], qf[ks], sc, 0, 0, 0);
        float xs[16];
        if (MODE == 0 && t >= 8) {
            const int kr = rs0 + t - 8; const bool row_ok = (kr >= rsq) && (kr < rsq + 8);
            const float* rb = P.relb + (h * 15 + (kr - qr + 7)) * 31 + (15 - qc);
#pragma unroll
            for (int r = 0; r < 16; ++r) { const int kc = c0 + crow16(r, hf); const bool ok = row_ok && (kc >= csq) && (kc < csq + 16);
                const float bias = ok ? rb[kc] : 0.f; xs[r] = ok ? (sc[r] * 0.125f + bias) * LOG2E : -1e30f; }
        } else {
#pragma unroll
            for (int r = 0; r < 16; ++r) xs[r] = (MODE == 2) ? sc[r] : sc[r] * (0.125f * LOG2E);
        }
        float tm = xs[0];
#pragma unroll
        for (int r = 1; r < 16; ++r) tm = fmaxf(tm, xs[r]);
        tm = fmaxf(tm, __shfl_xor(tm, 32));
        const float mn = fmaxf(m, tm), al = __builtin_amdgcn_exp2f(m - mn);
        float ps = 0.f;
#pragma unroll
        for (int r = 0; r < 16; ++r) { xs[r] = __builtin_amdgcn_exp2f(xs[r] - mn); ps += xs[r]; }
        l = l * al + ps; m = mn;
#pragma unroll
        for (int r = 0; r < 16; ++r) { o0[r] *= al; o1[r] *= al; }
        bf16x8_t pf[2];
#pragma unroll
        for (int s = 0; s < 2; ++s) { v4u w; w.x = cvtpk(xs[8 * s], xs[8 * s + 1]); w.y = cvtpk(xs[8 * s + 2], xs[8 * s + 3]); w.z = cvtpk(xs[8 * s + 4], xs[8 * s + 5]); w.w = cvtpk(xs[8 * s + 6], xs[8 * s + 7]);
            pf[s] = __builtin_bit_cast(bf16x8_t, w); }
#pragma unroll
        for (int s = 0; s < 2; ++s) {
            const bf16x8_t a0 = __builtin_shufflevector(va[0][s][0], va[0][s][1], 0, 1, 2, 3, 4, 5, 6, 7);
            const bf16x8_t a1 = __builtin_shufflevector(va[1][s][0], va[1][s][1], 0, 1, 2, 3, 4, 5, 6, 7);
            o0 = __builtin_amdgcn_mfma_f32_32x32x16_bf16(a0, pf[s], o0, 0, 0, 0);
            o1 = __builtin_amdgcn_mfma_f32_32x32x16_bf16(a1, pf[s], o1, 0, 0, 0);
        }
    }
    l += __shfl_xor(l, 32);
    const float rl = 1.f / l;
#pragma unroll
    for (int dt = 0; dt < 2; ++dt)
#pragma unroll
        for (int rg = 0; rg < 4; ++rg) { const int d = 32 * dt + 8 * rg + 4 * hf;
            const v2u gv = *(const v2u*)(gp + d);
            const float g0 = silu_f(bflo(gv.x)), g1 = silu_f(bfhi(gv.x)), g2 = silu_f(bflo(gv.y)), g3 = silu_f(bfhi(gv.y));
            const f32x16_t& oo = dt ? o1 : o0;
            v2u w; w.x = pk2(oo[4 * rg] * rl * g0, oo[4 * rg + 1] * rl * g1); w.y = pk2(oo[4 * rg + 2] * rl * g2, oo[4 * rg + 3] * rl * g3);
            *(v2u*)(yp + d) = w; }
}

typedef float f32x2_t __attribute__((ext_vector_type(2)));
constexpr int LRU_NCOL = 272;
struct LruP { const bf16_t* P1; const float* conv_w; const float* conv_b; const float* lam; const float* b_a; const float* b_x; const bf16_t* WT; f32x2_t* SUM16; bf16_t* YMIX; };
constexpr int LRU_WTL = 0, LRU_CWL = 36864, LRU_BAX = LRU_CWL + 1280, LRU_XW = LRU_BAX + 1536, LRU_CARRY = LRU_XW + 8 * 4160, LRU_FOLD = LRU_CARRY + 16384;

DI void lru_setup(int nb, const LruP& p, LAS unsigned char* lds, int tid) {
    __syncthreads();
    for (int e = tid; e < 256 * 8; e += NTHREADS) { const int row = e >> 3, ch = e & 7; *(LAS v4u*)(lds + LRU_WTL + row * 144 + ch * 16) = *(const v4u*)(p.WT + (size_t)(nb * 256 + row) * 64 + ch * 8); }
    LAS float* CW = (LAS float*)(lds + LRU_CWL); LAS float* BAX = (LAS float*)(lds + LRU_BAX);
    if (tid < 320) CW[tid] = tid < 256 ? p.conv_w[(tid >> 6) * 512 + nb * 64 + (tid & 63)] : p.conv_b[nb * 64 + (tid & 63)];
    if (tid < 128) { const int dir = tid >> 6, ch = tid & 63; BAX[(dir * 3 + 0) * 64 + ch] = p.b_a[dir * 512 + nb * 64 + ch]; BAX[(dir * 3 + 1) * 64 + ch] = p.b_x[dir * 512 + nb * 64 + ch];
        BAX[(dir * 3 + 2) * 64 + ch] = log1pf(__expf(-p.lam[dir * 512 + nb * 64 + ch])); }
    __syncthreads();
}

template <bool PASS2> DI void lru_micro(int b, int col, int nb, int ci, const LruP& p, LAS unsigned char* lds, int wave, int lane) {
    const int n = lane & 15, q = lane >> 4;
    const int s0 = col < 16 ? NLAT + b * LC : b * SEQ, sl = col < 16 ? LC : SEQ, t0 = col < 16 ? col * 16 : (col - 16) * 16;
    LAS float* CW = (LAS float*)(lds + LRU_CWL); LAS float* BAX = (LAS float*)(lds + LRU_BAX); LAS float* XW = (LAS float*)(lds + LRU_XW + wave * 4160);
    v4u xr[4][2];
#pragma unroll
    for (int j = 0; j < 4; ++j) { const int tt = t0 + n + j - 1; const bool ok = tt >= 0 && tt < sl;
#pragma unroll
        for (int ks = 0; ks < 2; ++ks) { xr[j][ks] = (v4u){0u, 0u, 0u, 0u}; if (ok) xr[j][ks] = *(const v4u*)(p.P1 + (size_t)(s0 + tt) * N1 + nb * 64 + 32 * ks + 8 * q); } }
    bf16x8_t af[2];
#pragma unroll
    for (int ks = 0; ks < 2; ++ks) { const int c = 32 * ks + 8 * q;
        float xc[8];
        const f32x4_t bb0 = *(const LAS f32x4_t*)(CW + 256 + c), bb1 = *(const LAS f32x4_t*)(CW + 256 + c + 4);
#pragma unroll
        for (int e = 0; e < 4; ++e) { xc[e] = bb0[e]; xc[4 + e] = bb1[e]; }
#pragma unroll
        for (int j = 0; j < 4; ++j) { const f32x4_t w0 = *(const LAS f32x4_t*)(CW + j * 64 + c), w1 = *(const LAS f32x4_t*)(CW + j * 64 + c + 4); const v4u xx = xr[j][ks];
            xc[0] += w0[0] * bflo(xx.x); xc[1] += w0[1] * bfhi(xx.x); xc[2] += w0[2] * bflo(xx.y); xc[3] += w0[3] * bfhi(xx.y);
            xc[4] += w1[0] * bflo(xx.z); xc[5] += w1[1] * bfhi(xx.z); xc[6] += w1[2] * bflo(xx.w); xc[7] += w1[3] * bfhi(xx.w); }
        v4u w; w.x = pk2(xc[0], xc[1]); w.y = pk2(xc[2], xc[3]); w.z = pk2(xc[4], xc[5]); w.w = pk2(xc[6], xc[7]); af[ks] = __builtin_bit_cast(bf16x8_t, w);
#pragma unroll
        for (int e = 0; e < 8; ++e) XW[n * 65 + c + e] = xc[e]; }
    float hsum[4][4];
#pragma unroll
    for (int c4 = 0; c4 < 4; ++c4)
#pragma unroll
        for (int r = 0; r < 4; ++r) hsum[c4][r] = 0.f;
#pragma unroll 1
    for (int dir = 0; dir < 2; ++dir) {
        f32x4_t acc[8];
#pragma unroll
        for (int nt = 0; nt < 8; ++nt) { acc[nt] = (f32x4_t){0.f, 0.f, 0.f, 0.f};
            const LAS unsigned char* wrow = lds + LRU_WTL + ((dir * 2 + (nt >> 2)) * 64 + (nt & 3) * 16 + n) * 144 + 16 * q;
#pragma unroll
            for (int ks = 0; ks < 2; ++ks) { const bf16x8_t bfr = *(const LAS bf16x8_t*)(wrow + 64 * ks); acc[nt] = __builtin_amdgcn_mfma_f32_16x16x32_bf16(af[ks], bfr, acc[nt], 0, 0, 0); } }
        float a[4][4], bt[4][4];
#pragma unroll
        for (int c4 = 0; c4 < 4; ++c4) { const int ch = c4 * 16 + n;
            const float ba = BAX[(dir * 3 + 0) * 64 + ch], bx = BAX[(dir * 3 + 1) * 64 + ch], sp = BAX[(dir * 3 + 2) * 64 + ch];
#pragma unroll
            for (int r = 0; r < 4; ++r) { const float gr = sigmoid_f(acc[c4][r] + ba), gi = sigmoid_f(acc[c4 + 4][r] + bx);
                const float log_a = -8.f * gr * sp; const float av = __builtin_amdgcn_exp2f(log_a * LOG2E); a[c4][r] = av;
                const float x2 = 2.f * log_a;
                const float ser = -x2 * (1.f + x2 * (0.5f + x2 * (0.16666667f + x2 * (0.041666668f + x2 * 0.0083333338f))));
                const float om = x2 > -0.5f ? ser : 1.f - av * av;
                bt[c4][r] = __builtin_amdgcn_sqrtf(fmaxf(om, 0.f)) * gi * XW[(4 * q + r) * 65 + ch]; } }
        float Pq[4], Sq[4];
#pragma unroll
        for (int c4 = 0; c4 < 4; ++c4) { float P = 1.f, S = 0.f;
#pragma unroll
            for (int rr = 0; rr < 4; ++rr) { const int r = dir == 0 ? rr : 3 - rr; S = a[c4][r] * S + bt[c4][r]; P *= a[c4][r]; }
            Pq[c4] = P; Sq[c4] = S; }
        float Pin[4], Sin[4];
#pragma unroll
        for (int c4 = 0; c4 < 4; ++c4) { float P = 1.f, S = 0.f, Pw = 1.f, Sw = 0.f;
#pragma unroll
            for (int kk = 0; kk < 4; ++kk) { const int k = dir == 0 ? kk : 3 - kk;
                const float pk = __shfl(Pq[c4], n + 16 * k), sk = __shfl(Sq[c4], n + 16 * k);
                const bool before = dir == 0 ? (k < q) : (k > q);
                if (before) { S = pk * S + sk; P *= pk; }
                Sw = pk * Sw + sk; Pw *= pk; }
            Pin[c4] = P; Sin[c4] = S;
            if (!PASS2 && q == 0) p.SUM16[((size_t)((b * 8 + nb) * LRU_NCOL + col) * 2 + dir) * 64 + c4 * 16 + n] = (f32x2_t){Pw, Sw}; }
        if (PASS2) {
            const LAS float* CARRYL = (const LAS float*)(lds + LRU_CARRY);
#pragma unroll
            for (int c4 = 0; c4 < 4; ++c4) { float h = CARRYL[(dir * 32 + ci) * 64 + c4 * 16 + n];
                h = Pin[c4] * h + Sin[c4];
#pragma unroll
                for (int rr = 0; rr < 4; ++rr) { const int r = dir == 0 ? rr : 3 - rr; h = a[c4][r] * h + bt[c4][r]; hsum[c4][r] += h; } }
        }
    }
    if (PASS2) {
        asm volatile("s_waitcnt lgkmcnt(0)" ::: "memory");
#pragma unroll
        for (int c4 = 0; c4 < 4; ++c4)
#pragma unroll
            for (int r = 0; r < 4; ++r) XW[(4 * q + r) * 65 + c4 * 16 + n] = hsum[c4][r];
        asm volatile("s_waitcnt lgkmcnt(0)" ::: "memory");
        const int tk = lane >> 2, cg = lane & 3; const size_t row = (size_t)(s0 + t0 + tk);
        const bf16_t* gp = p.P1 + row * N1 + 512 + nb * 64 + cg * 16;
        const v4u g0 = *(const v4u*)gp, g1 = *(const v4u*)(gp + 8);
        float y[16];
#pragma unroll
        for (int e = 0; e < 16; ++e) y[e] = XW[tk * 65 + cg * 16 + e];
        v4u o0, o1;
        o0.x = pk2(y[0] * silu_f(bflo(g0.x)), y[1] * silu_f(bfhi(g0.x))); o0.y = pk2(y[2] * silu_f(bflo(g0.y)), y[3] * silu_f(bfhi(g0.y)));
        o0.z = pk2(y[4] * silu_f(bflo(g0.z)), y[5] * silu_f(bfhi(g0.z))); o0.w = pk2(y[6] * silu_f(bflo(g0.w)), y[7] * silu_f(bfhi(g0.w)));
        o1.x = pk2(y[8] * silu_f(bflo(g1.x)), y[9] * silu_f(bfhi(g1.x))); o1.y = pk2(y[10] * silu_f(bflo(g1.y)), y[11] * silu_f(bfhi(g1.y)));
        o1.z = pk2(y[12] * silu_f(bflo(g1.z)), y[13] * silu_f(bfhi(g1.z))); o1.w = pk2(y[14] * silu_f(bflo(g1.w)), y[15] * silu_f(bfhi(g1.w)));
        bf16_t* yp = p.YMIX + row * DM + nb * 64 + cg * 16;
        *(v4u*)yp = o0; *(v4u*)(yp + 8) = o1;
    }
    asm volatile("s_waitcnt lgkmcnt(0)" ::: "memory");
}

DI int lru_order_col(int dir, int k) { return dir == 0 ? k : (k < 16 ? 15 - k : 16 + (271 - k)); }

DI void lru_block(int blk, bool pass2, const LruP& p, LAS unsigned char* lds, int tid, int wave, int lane) {
    const int nb = blk & 7, b = (blk >> 3) & 3, cr = blk >> 5;
    lru_setup(nb, p, lds, tid);
    if (!pass2) {
        for (int i = wave; i < 34; i += NWAVES) { const int col = i < 32 ? 16 + 32 * cr + i : 2 * cr + (i - 32); lru_micro<false>(b, col, nb, 0, p, lds, wave, lane); }
        return;
    }
    LAS float* CARRYL = (LAS float*)(lds + LRU_CARRY); LAS f32x2_t* FOLD = (LAS f32x2_t*)(lds + LRU_FOLD);
    const int chain = tid & 127, part = tid >> 7, dir = chain >> 6, ch = chain & 63;
    const f32x2_t* SB = p.SUM16 + (size_t)(b * 8 + nb) * LRU_NCOL * 128 + dir * 64 + ch;
    const int kfirst = dir == 0 ? 16 + 32 * cr : 240 - 32 * cr;
    { const int k0 = (kfirst * part) >> 2, k1 = (kfirst * (part + 1)) >> 2;
      float P = 1.f, S = 0.f;
#pragma unroll 4
      for (int k = k0; k < k1; ++k) { const f32x2_t s = SB[(size_t)lru_order_col(dir, k) * 128]; S = s[0] * S + s[1]; P *= s[0]; }
      FOLD[part * 128 + chain] = (f32x2_t){P, S}; }
    __syncthreads();
    if (part == 0) { float S = 0.f;
#pragma unroll
        for (int pp = 0; pp < 4; ++pp) { const f32x2_t s = FOLD[pp * 128 + chain]; S = s[0] * S + s[1]; }
        for (int i = 0; i < 32; ++i) { const int col = lru_order_col(dir, kfirst + i), ci = col - (16 + 32 * cr);
            CARRYL[(dir * 32 + ci) * 64 + ch] = S; const f32x2_t s = SB[(size_t)col * 128]; S = s[0] * S + s[1]; } }
    __syncthreads();
    for (int i = wave; i < 32; i += NWAVES) lru_micro<true>(b, 16 + 32 * cr + i, nb, i, p, lds, wave, lane);
}

DI float row16_sum(float v) {
    v += __builtin_bit_cast(float, __builtin_amdgcn_update_dpp(0, __builtin_bit_cast(int, v), 0xB1, 0xf, 0xf, false));
    v += __builtin_bit_cast(float, __builtin_amdgcn_update_dpp(0, __builtin_bit_cast(int, v), 0x4E, 0xf, 0xf, false));
    v += __builtin_bit_cast(float, __builtin_amdgcn_update_dpp(0, __builtin_bit_cast(int, v), 0x141, 0xf, 0xf, false));
    v += __builtin_bit_cast(float, __builtin_amdgcn_update_dpp(0, __builtin_bit_cast(int, v), 0x140, 0xf, 0xf, false));
    return v;
}
DI void qkprep_row(int r, const bf16_t* P1, const float* qn, const float* kn, const float* ROPE, bf16_t* QP, bf16_t* KP, int lane) {
    const int b = row_batch(r); const bool lat = r < NLAT; const int t = r & 4095, l16 = lane & 15, hh = lane >> 4;
    f32x4_t cs = {1.f, 0.f, 1.f, 0.f};
    if (lat) cs = *(const f32x4_t*)(ROPE + ((size_t)t * 32 + 2 * l16) * 2);
    const f32x4_t wq = *(const f32x4_t*)(qn + 4 * l16), wk = *(const f32x4_t*)(kn + 4 * l16);
#pragma unroll
    for (int hg = 0; hg < 3; ++hg) {
        if (hg < 2 && !lat) continue;
        const int slot = hg < 2 ? hg * 4 + hh : 8 + (hh & 1);
        const int col0 = slot < 8 ? 1024 + slot * 64 : 1536 + (slot - 8) * 64;
        const v2u xx = *(const v2u*)(P1 + (size_t)r * N1 + col0 + 4 * l16);
        float x[4] = {bflo(xx.x), bfhi(xx.x), bflo(xx.y), bfhi(xx.y)};
        const float ss = row16_sum(x[0] * x[0] + x[1] * x[1] + x[2] * x[2] + x[3] * x[3]);
        const float rinv = rsqrtf(ss * (1.f / 64.f) + EPSN);
        const f32x4_t w = hg < 2 ? wq : wk;
#pragma unroll
        for (int e = 0; e < 4; ++e) x[e] *= rinv * w[e];
        const float y0 = x[0] * cs[0] - x[1] * cs[1], y1 = x[0] * cs[1] + x[1] * cs[0], y2 = x[2] * cs[2] - x[3] * cs[3], y3 = x[2] * cs[3] + x[3] * cs[2];
        if (hg < 2) { const float sc = 0.125f * LOG2E; v2u o; o.x = pk2(y0 * sc, y1 * sc); o.y = pk2(y2 * sc, y3 * sc); *(v2u*)(QP + ((size_t)(b * 8 + slot) * SEQ + t) * 64 + 4 * l16) = o; }
        else if (hh < 2) { v2u o; o.x = pk2(y0, y1); o.y = pk2(y2, y3); *(v2u*)(KP + ((size_t)(b * 2 + (slot - 8)) * POSN + row_pos(r)) * 64 + 4 * l16) = o; }
    }
}

constexpr size_t WS_CARRY0 = 246 * MiB;
constexpr int S5_NCOL = 272;

DI void s5_lambar_pow(double lre, double lim, double dt, int e, double& pr, double& pi) { const double mag = exp(lre * dt * e), ang = lim * dt * e; pr = mag * cos(ang); pi = mag * sin(ang); }
typedef double f64x2_t __attribute__((ext_vector_type(2)));
DI void s5_tables_block(int item, const float* lam_re, const float* lam_im, const float* log_dt, const float* b_re, const float* b_im, const float* c_re, const float* c_im,
                        bf16_t* W16, bf16_t* WC, bf16_t* KT, float* L16, LAS unsigned char* lds, int tid) {
    const int part = item & 3, gd = item >> 2, g = gd >> 1, dir = gd & 1, gi = dir * 32 + g;
    LAS f64x2_t* POW = (LAS f64x2_t*)lds;
    LAS f64x2_t* PC = POW + 17 * 64;
    __syncthreads();
    if (tid < 64) { const int p = tid;
        const double dt = exp((double)log_dt[gi]), lre = lam_re[gi * 64 + p], lim = lam_im[gi * 64 + p];
        double l1r, l1i; s5_lambar_pow(lre, lim, dt, 1, l1r, l1i);
        const double nr = l1r - 1.0, ni = l1i, den = lre * lre + lim * lim, cfr = (nr * lre + ni * lim) / den, cfi = (ni * lre - nr * lim) / den;
        double pr = 1.0, pi = 0.0;
        for (int e = 0; e <= 16; ++e) { POW[e * 64 + p] = (f64x2_t){pr, pi}; PC[e * 64 + p] = (f64x2_t){pr * cfr - pi * cfi, pr * cfi + pi * cfr};
            if (e == 16 && part == 0) { L16[((g * 2 + dir) * 64 + p) * 2] = (float)pr; L16[((g * 2 + dir) * 64 + p) * 2 + 1] = (float)pi; }
            const double tr = pr * l1r - pi * l1i, ti = pr * l1i + pi * l1r; pr = tr; pi = ti; } }
    __syncthreads();
    for (int idx = tid; idx < 32 * 256; idx += NTHREADS) { const int row = 32 * part + (idx >> 8), k = idx & 255, p = row >> 1, c = row & 1, tp = k >> 4, hi = k & 15;
        const f64x2_t z = PC[(dir == 0 ? 15 - tp : tp) * 64 + p]; const double br = b_re[(gi * 64 + p) * 16 + hi], bi = b_im[(gi * 64 + p) * 16 + hi];
        W16[(size_t)(gd * 128 + row) * 256 + k] = f2bf((float)(c == 0 ? z[0] * br - z[1] * bi : z[0] * bi + z[1] * br)); }
    for (int idx = tid; idx < 64 * 128; idx += NTHREADS) { const int row = 64 * part + (idx >> 7), k = idx & 127, p = k >> 1, c = k & 1, t = row >> 4, ho = row & 15;
        const f64x2_t z = POW[((dir == 0 ? t : 15 - t) + 1) * 64 + p]; const double cr = c_re[(gi * 16 + ho) * 64 + p], ci = c_im[(gi * 16 + ho) * 64 + p];
        WC[(size_t)(gd * 256 + row) * 128 + k] = f2bf((float)(c == 0 ? cr * z[0] - ci * z[1] : -(cr * z[1] + ci * z[0]))); }
    for (int idx = tid; idx < 1024; idx += NTHREADS) { const int e = 1024 * part + idx, tau = e >> 8, ho = (e >> 4) & 15, hi = e & 15;
        double acc = 0.0;
#pragma unroll 4
        for (int p = 0; p < 64; ++p) { const f64x2_t z = PC[tau * 64 + p]; const double cr = c_re[(gi * 16 + ho) * 64 + p], ci = c_im[(gi * 16 + ho) * 64 + p];
            const double ar = cr * z[0] - ci * z[1], ai = cr * z[1] + ci * z[0];
            acc += ar * (double)b_re[(gi * 64 + p) * 16 + hi] - ai * (double)b_im[(gi * 64 + p) * 16 + hi]; }
        KT[(size_t)gd * 4096 + e] = f2bf((float)acc); }
}

DI int s5_tile_row0(int b, int s) { return s == 0 ? NLAT + b * LC : b * SEQ + (s - 1) * 256; }
DI void cmul(float ar, float ai, float br, float bi, float& cr, float& ci) { cr = ar * br - ai * bi; ci = ar * bi + ai * br; }

DI void s5_scan_unit(int cu, int m, const bf16_t* PROJ, const bf16_t* W16, const float* L16, bf16_t* CARRY0, bf16_t* CARRY1, int lane) {
    const int dir = cu & 1, b = (cu >> 1) & 3, g = cu >> 3;
    const int n = lane & 15, q = lane >> 4;
    bf16x8_t wf[8];
#pragma unroll
    for (int ks = 0; ks < 8; ++ks) wf[ks] = *(const bf16x8_t*)(W16 + ((size_t)(g * 2 + dir) * 128 + m * 16 + n) * 256 + 32 * ks + 8 * q);
    float Lr[2][5], Li[2][5];
    float Lnr[2], Lni[2];
    float cr[2], ci[2];
#pragma unroll
    for (int st = 0; st < 2; ++st) { const int p = 8 * m + 2 * q + st;
        Lr[st][0] = L16[((g * 2 + dir) * 64 + p) * 2]; Li[st][0] = L16[((g * 2 + dir) * 64 + p) * 2 + 1];
#pragma unroll
        for (int k = 1; k < 5; ++k) cmul(Lr[st][k - 1], Li[st][k - 1], Lr[st][k - 1], Li[st][k - 1], Lr[st][k], Li[st][k]);
        float rr = 1.f, ri = 0.f;
#pragma unroll
        for (int k = 0; k < 5; ++k) if ((n + 1) & (1 << k)) { float tr, ti; cmul(rr, ri, Lr[st][k], Li[st][k], tr, ti); rr = tr; ri = ti; }
        Lnr[st] = rr; Lni[st] = ri; cr[st] = 0.f; ci[st] = 0.f; }
    bf16_t* CARRY = (dir == 0 ? CARRY0 : CARRY1) + (size_t)(b * 32 + g) * S5_NCOL * 128;
    const int jcol = dir == 0 ? n : 15 - n;
    bf16x8_t un[8];
    { const bf16_t* ub = PROJ + (size_t)(s5_tile_row0(b, 0) + jcol * 16 + (q >> 1)) * N0 + g * 16 + 8 * (q & 1);
#pragma unroll
      for (int ks = 0; ks < 8; ++ks) un[ks] = *(const bf16x8_t*)(ub + (size_t)(2 * ks) * N0); }
#pragma unroll 1
    for (int it = 0; it < 17; ++it) {
        const int s = it == 0 ? 0 : (dir == 0 ? it : 17 - it);
        bf16x8_t uf[8];
#pragma unroll
        for (int ks = 0; ks < 8; ++ks) uf[ks] = un[ks];
        if (it + 1 < 17) { const int sn = dir == 0 ? it + 1 : 16 - it;
            const bf16_t* ub = PROJ + (size_t)(s5_tile_row0(b, sn) + jcol * 16 + (q >> 1)) * N0 + g * 16 + 8 * (q & 1);
#pragma unroll
            for (int ks = 0; ks < 8; ++ks) un[ks] = *(const bf16x8_t*)(ub + (size_t)(2 * ks) * N0); }
        f32x4_t acc = {0.f, 0.f, 0.f, 0.f};
#pragma unroll
        for (int ks = 0; ks < 8; ++ks) acc = __builtin_amdgcn_mfma_f32_16x16x32_bf16(wf[ks], uf[ks], acc, 0, 0, 0);
        float hin[4];
#pragma unroll
        for (int st = 0; st < 2; ++st) {
            float xr = acc[2 * st], xi = acc[2 * st + 1];
#pragma unroll
            for (int k = 0; k < 4; ++k) { const int d = 1 << k; const float yr = __shfl_up(xr, d, 16), yi = __shfl_up(xi, d, 16);
                if (n >= d) { float tr, ti; cmul(Lr[st][k], Li[st][k], yr, yi, tr, ti); xr += tr; xi += ti; } }
            float tr, ti; cmul(Lnr[st], Lni[st], cr[st], ci[st], tr, ti);
            const float Hr = xr + tr, Hi = xi + ti;
            const float pr = __shfl_up(Hr, 1, 16), pi = __shfl_up(Hi, 1, 16);
            hin[2 * st] = n == 0 ? cr[st] : pr; hin[2 * st + 1] = n == 0 ? ci[st] : pi;
            cr[st] = __shfl(Hr, (lane & 48) | 15); ci[st] = __shfl(Hi, (lane & 48) | 15);
        }
        v2u w; w.x = pk2(hin[0], hin[1]); w.y = pk2(hin[2], hin[3]);
        *(v2u*)(CARRY + (size_t)(s * 16 + jcol) * 128 + m * 16 + 4 * q) = w;
    }
}

DI void s5_out_item(int g, int b, int s, const bf16_t* PROJ, const bf16_t* WC, const bf16_t* CARRY0, const bf16_t* CARRY1, const float* dsk, bf16_t* YPRE, LAS unsigned char* lds, int wave, int lane) {
    const int n = lane & 15, q = lane >> 4;
    const int row0 = s5_tile_row0(b, s);
    const bf16_t* ub = PROJ + (size_t)(row0 + n * 16 + (q >> 1)) * N0 + g * 16 + 8 * (q & 1);
    bf16x8_t uf[8];
#pragma unroll
    for (int ks = 0; ks < 8; ++ks) uf[ks] = *(const bf16x8_t*)(ub + (size_t)(2 * ks) * N0);
    bf16x8_t cf[2][4];
#pragma unroll
    for (int dir = 0; dir < 2; ++dir)
#pragma unroll
        for (int ks = 0; ks < 4; ++ks) cf[dir][ks] = *(const bf16x8_t*)((dir == 0 ? CARRY0 : CARRY1) + ((size_t)(b * 32 + g) * S5_NCOL + s * 16 + n) * 128 + 32 * ks + 8 * q);
    const LAS bf16_t* KTl = (const LAS bf16_t*)lds;
#pragma unroll
    for (int m2 = 0; m2 < 2; ++m2) {
        const int mt = 2 * wave + m2;
        f32x4_t acc = {0.f, 0.f, 0.f, 0.f};
#pragma unroll
        for (int dir = 0; dir < 2; ++dir) {
            const bf16_t* wc = WC + ((size_t)(g * 2 + dir) * 256 + mt * 16 + n) * 128 + 8 * q;
#pragma unroll
            for (int ks = 0; ks < 4; ++ks) { const bf16x8_t a = *(const bf16x8_t*)(wc + 32 * ks); acc = __builtin_amdgcn_mfma_f32_16x16x32_bf16(a, cf[dir][ks], acc, 0, 0, 0); }
#pragma unroll
            for (int ks = 0; ks < 8; ++ks) {
                const bool need = dir == 0 ? (2 * ks <= mt) : (2 * ks + 1 >= mt);
                if (need) { const int tp = 2 * ks + (q >> 1), tau = dir == 0 ? mt - tp : tp - mt;
                    bf16x8_t a = {0, 0, 0, 0, 0, 0, 0, 0};
                    if (tau >= 0) a = *(const LAS bf16x8_t*)(KTl + ((dir * 16 + tau) * 16 + n) * 16 + 8 * (q & 1));
                    acc = __builtin_amdgcn_mfma_f32_16x16x32_bf16(a, uf[ks], acc, 0, 0, 0); }
            }
        }
        const size_t tok = (size_t)(row0 + n * 16 + mt);
        const v2u uu = *(const v2u*)(PROJ + tok * N0 + g * 16 + 4 * q);
        const f32x4_t dd = *(const f32x4_t*)(dsk + g * 16 + 4 * q);
        const float y0 = gelu_fast(acc[0] + dd[0] * bflo(uu.x)), y1 = gelu_fast(acc[1] + dd[1] * bfhi(uu.x)), y2 = gelu_fast(acc[2] + dd[2] * bflo(uu.y)), y3 = gelu_fast(acc[3] + dd[3] * bfhi(uu.y));
        v2u w; w.x = pk2(y0, y1); w.y = pk2(y2, y3);
        *(v2u*)(YPRE + tok * 512 + g * 16 + 4 * q) = w;
    }
}

#include <hip/hip_bf16.h>
namespace gqa_body {
using bf16=__hip_bfloat16;
using bf16x8=__attribute__((ext_vector_type(8)))short;
using s16x4=__attribute__((ext_vector_type(4)))short;
using f32x16=__attribute__((ext_vector_type(16)))float;
using u32x4=__attribute__((ext_vector_type(4)))unsigned;
constexpr int NHEAD=8,SEQQ=4096,SKV=4352,D=64,QPITCH=64,KPITCH=64,VPITCH=64,OPITCH=1024,GPITCH=2304;
constexpr int NW=8,QBLK=32,QB=QBLK*NW,KVBLK=64,NQB=SEQQ/QB,NTILES=SKV/KVBLK;
constexpr int ATTN_UNIT_ROWS=QB;
__device__ __forceinline__ int crow(int r,int hi){return (r&3)+8*(r>>2)+4*hi;}
#define SBAR() __builtin_amdgcn_sched_barrier(0)
constexpr int NSLOT=3, SLOTB=8192;
constexpr int LDS_K=0, LDS_V=NSLOT*SLOTB, LDS_WS=2*NSLOT*SLOTB, LDS_OST=LDS_WS+NW*64*4, LDS_BYTES=LDS_OST+NW*4096;
constexpr float C2=0.125f*1.4426950408889634f;
__device__ __forceinline__ void glds16(const void*gsrc,unsigned lds_dst){unsigned keep;
  asm volatile("s_mov_b32 %0, m0\n\ts_mov_b32 m0, %2\n\ts_nop 0\n\tglobal_load_lds_dwordx4 %1, off\n\ts_mov_b32 m0, %0":"=&s"(keep):"v"(gsrc),"s"(lds_dst):"memory");}
__device__ __forceinline__ float max3f(float a,float b,float c){float r;asm("v_max3_f32 %0, %1, %2, %3":"=v"(r):"v"(a),"v"(b),"v"(c));return r;}
__device__ __forceinline__ float max2f(float a,float b){float r;asm("v_max_f32_e32 %0, %1, %2":"=v"(r):"v"(a),"v"(b));return r;}
__device__ __forceinline__ float fadd_s(float a,float b){float r;asm("v_add_f32_e32 %0, %1, %2":"=v"(r):"v"(a),"v"(b));return r;}
__device__ __forceinline__ float fsub_s(float a,float b){float r;asm("v_sub_f32_e32 %0, %1, %2":"=v"(r):"v"(a),"v"(b));return r;}
typedef float f32x2_t __attribute__((ext_vector_type(2))); typedef __bf16 bf16x2_t __attribute__((ext_vector_type(2)));
__device__ __forceinline__ unsigned cvtpk_s(float lo,float hi){f32x2_t v={lo,hi};bf16x2_t b=__builtin_convertvector(v,bf16x2_t);return __builtin_bit_cast(unsigned,b);}
#define WAIT_BAR(N) asm volatile("s_waitcnt vmcnt(" #N ") lgkmcnt(0)\n\ts_barrier":::"memory")

__device__ __forceinline__ void qkt(f32x16&p0,f32x16&p1,const char*Kslot,const bf16x8*qr,const f32x16&negm,int r32,int hi){
  const char*kb=Kslot+hi*1024+r32*16;
  #pragma unroll
  for(int d0=0;d0<4;++d0){
    const bf16x8 b0=*reinterpret_cast<const bf16x8*>(kb+d0*2048);
    const bf16x8 b1=*reinterpret_cast<const bf16x8*>(kb+d0*2048+512);
    if(d0==0){p0=__builtin_amdgcn_mfma_f32_32x32x16_bf16(b0,qr[0],negm,0,0,0);p1=__builtin_amdgcn_mfma_f32_32x32x16_bf16(b1,qr[0],negm,0,0,0);}
    else{p0=__builtin_amdgcn_mfma_f32_32x32x16_bf16(b0,qr[d0],p0,0,0,0);p1=__builtin_amdgcn_mfma_f32_32x32x16_bf16(b1,qr[d0],p1,0,0,0);}}
}
typedef __attribute__((address_space(3))) const char* lds_cptr;
typedef short v4i16_t __attribute__((ext_vector_type(4)));
__device__ __forceinline__ void kload8(bf16x8*kf,lds_cptr kp){
  kf[0]=*(const __attribute__((address_space(3))) bf16x8*)(kp);      kf[1]=*(const __attribute__((address_space(3))) bf16x8*)(kp+512);
  kf[2]=*(const __attribute__((address_space(3))) bf16x8*)(kp+2048); kf[3]=*(const __attribute__((address_space(3))) bf16x8*)(kp+2560);
  kf[4]=*(const __attribute__((address_space(3))) bf16x8*)(kp+4096); kf[5]=*(const __attribute__((address_space(3))) bf16x8*)(kp+4608);
  kf[6]=*(const __attribute__((address_space(3))) bf16x8*)(kp+6144); kf[7]=*(const __attribute__((address_space(3))) bf16x8*)(kp+6656);
}
__device__ __forceinline__ void kload2(bf16x8*kf,lds_cptr kp,int j){ kf[2*j]=*(const __attribute__((address_space(3))) bf16x8*)(kp+j*2048); kf[2*j+1]=*(const __attribute__((address_space(3))) bf16x8*)(kp+j*2048+512); }
__device__ __forceinline__ s16x4 vtr(lds_cptr p){ return __builtin_bit_cast(s16x4,__builtin_amdgcn_ds_read_tr16_b64_v4i16((__attribute__((address_space(3))) v4i16_t*)p)); }
__device__ __forceinline__ float rowmax(const f32x16&p0,const f32x16&p1){
  float a=max3f(p0[0],p0[1],p1[0]),b=max3f(p0[2],p0[3],p1[1]);a=max3f(a,p1[2],p1[3]);
  #pragma unroll
  for(int r=4;r<16;r+=4){a=max3f(a,p0[r],p0[r+1]);b=max3f(b,p0[r+2],p0[r+3]);a=max3f(a,p1[r],p1[r+1]);b=max3f(b,p1[r+2],p1[r+3]);}
  const float m=max2f(a,b);
  auto rr=__builtin_amdgcn_permlane32_swap(__float_as_uint(m),__float_as_uint(m),false,false);
  return max2f(__uint_as_float(rr[0]),__uint_as_float(rr[1]));
}
__device__ __forceinline__ void pv(f32x16*o,int vb,bf16x8 pa0,bf16x8 pa1,bf16x8 pa2,bf16x8 pa3){
  #pragma unroll
  for(int d0=0;d0<2;++d0){s16x4 lo[4],hi[4];
    #pragma unroll
    for(int ks=0;ks<4;++ks){
      asm volatile("ds_read_b64_tr_b16 %0,%1 offset:%c2":"=&v"(lo[ks]):"v"(vb),"i"(d0*4096+ks*1024):"memory");
      asm volatile("ds_read_b64_tr_b16 %0,%1 offset:%c2":"=&v"(hi[ks]):"v"(vb),"i"(d0*4096+ks*1024+512):"memory");}
    asm volatile("s_waitcnt lgkmcnt(0)":::"memory");SBAR();
    #define PK(k) (bf16x8){lo[k][0],lo[k][1],lo[k][2],lo[k][3],hi[k][0],hi[k][1],hi[k][2],hi[k][3]}
    o[d0]=__builtin_amdgcn_mfma_f32_32x32x16_bf16(pa0,PK(0),o[d0],0,0,0);
    o[d0]=__builtin_amdgcn_mfma_f32_32x32x16_bf16(pa1,PK(1),o[d0],0,0,0);
    o[d0]=__builtin_amdgcn_mfma_f32_32x32x16_bf16(pa2,PK(2),o[d0],0,0,0);
    o[d0]=__builtin_amdgcn_mfma_f32_32x32x16_bf16(pa3,PK(3),o[d0],0,0,0);
    #undef PK
  }
}

#ifndef ATTN_STORE16
#define ATTN_STORE16(p,v) (*(u32x4*)(p)=(v))
#endif
template<int THRL> __device__ __forceinline__ void attn_unit(int b,int h,int qb,const bf16*Q,const bf16*__restrict__ K,const bf16*__restrict__ V,bf16*O,const bf16*Gt,char*shm){
  const int tid=threadIdx.x,lane=tid&63,r32=lane&31,hi=lane>>5; const int wid=__builtin_amdgcn_readfirstlane(tid>>6);
  const int q0=qb*QB;
  const bf16*Qw=Q+((long)(b*NHEAD+h)*SEQQ+q0+wid*QBLK)*QPITCH;
  const bf16*Kh=K+(long)(b*2+(h>>2))*SKV*KPITCH,*Vh=V+(long)(b*2+(h>>2))*SKV*VPITCH;
  const unsigned lds0=(unsigned)(uintptr_t)shm;
  float*wsf=(float*)(shm+LDS_WS)+wid*64;
  const bf16*ksrc=Kh+(long)lane*KPITCH+wid*8;
  const bf16*vsrc=Vh+(long)(16*(wid&3)+(lane>>2))*VPITCH+(wid>>2)*32+(lane&3)*8;
  const unsigned kdst=lds0+LDS_K+wid*1024, vdst=lds0+LDS_V+wid*1024;
  #define DMA_K(t,slot) glds16(ksrc+(long)(t)*KVBLK*KPITCH,(unsigned)__builtin_amdgcn_readfirstlane(kdst+(slot)))
  #define DMA_V(t,slot) glds16(vsrc+(long)(t)*KVBLK*VPITCH,(unsigned)__builtin_amdgcn_readfirstlane(vdst+(slot)))
  const int vb0=(int)(lds0+LDS_V)+((lane>>4)&1)*32+(lane&3)*8+(4*hi+((lane&15)>>2))*64;
  const char*Kbase=shm+LDS_K; bf16x8 kf[8];
  const lds_cptr shm3=(lds_cptr)shm; const lds_cptr kp0=shm3+LDS_K+hi*1024+r32*16; const lds_cptr vp0=shm3+LDS_V+((lane>>4)&1)*32+(lane&3)*8+(4*hi+((lane&15)>>2))*64;
  constexpr int NT=NTILES;
  DMA_K(0,0);DMA_V(0,0);DMA_K(1,SLOTB);
  bf16x8 qr[4];
  #pragma unroll
  for(int d0=0;d0<4;++d0)qr[d0]=*reinterpret_cast<const bf16x8*>(&Qw[(long)r32*QPITCH+d0*16+hi*8]);
  float mhat=0.f,l_reg=0.f;f32x16 o[2];o[0]=f32x16{};o[1]=f32x16{};f32x16 negm=f32x16{};asm volatile("":"+v"(negm));
  #define CMASK(P0,P1,t) do{}while(0)
  bool resc=false;
  #define START(P0,P1) do{ const float rm=rowmax(P0,P1); resc=false; \
    { const float dl=rm; mhat=fadd_s(mhat,dl); \
      _Pragma("unroll") for(int r=0;r<16;++r){P0[r]=fsub_s(P0[r],dl);P1[r]=fsub_s(P1[r],dl);} \
      _Pragma("unroll") for(int r=0;r<16;++r)negm[r]=-mhat; asm volatile("":"+v"(negm)); } \
    _Pragma("unroll") for(int r=0;r<16;++r)P0[r]=__builtin_amdgcn_exp2f(P0[r]); }while(0)
  #define RESC() do{ if(resc){ asm volatile("s_waitcnt lgkmcnt(0)":::"memory"); \
      _Pragma("unroll") for(int d_=0;d_<2;++d_) _Pragma("unroll") for(int r=0;r<16;++r)o[d_][r]*=wsf[crow(r,hi)]; } }while(0)
  f32x16 pA0,pA1,pB0,pB1;
  int sl_prev=0,sl_cur=0,sl_next=SLOTB;
  #define ROT() do{sl_prev=sl_cur;sl_cur=sl_next;sl_next=(sl_next==(NSLOT-1)*SLOTB)?0:sl_next+SLOTB;}while(0)
  DMA_K(2,2*SLOTB);
  WAIT_BAR(3);
  qkt(pA0,pA1,Kbase,qr,negm,r32,hi);asm volatile("s_nop 15\n\ts_nop 7":"+v"(pA0),"+v"(pA1));CMASK(pA0,pA1,0);
  START(pA0,pA1);
  _Pragma("unroll") for(int r=0;r<16;++r)pA1[r]=__builtin_amdgcn_exp2f(pA1[r]);
  WAIT_BAR(0);
  DMA_K(3,0);DMA_V(1,SLOTB);
  ROT();
  kload8(kf,kp0+sl_cur);
  WAIT_BAR(2);
  s16x4 vlo[8],vhi[8]; u32x4 pw0,pw1,pw2,pw3;
  #define PKW(P,B) cvtpk_s(P[B],P[B+1])
  #define PAF(k) __builtin_bit_cast(bf16x8,pw##k)
  #define VFR(i) (bf16x8){vlo[i][0],vlo[i][1],vlo[i][2],vlo[i][3],vhi[i][0],vhi[i][1],vhi[i][2],vhi[i][3]}
  #define PIN(x) asm volatile("":"+v"(x))
  #define MX3(a,b,c) __builtin_fmaxf(__builtin_fmaxf((a),(b)),(c))
  #define GAPA(MF,A0,A1,A2,A3,W0,W1,PW) do{ MF; sacc+=A0; sacc+=A1; sacc+=A2; sacc+=A3; PIN(sacc); W0; W1; PIN(PW); SBAR(); }while(0)
  #define EX(v) __builtin_amdgcn_exp2f(v)
  #define GAPB(MF,X,B) do{ MF; X[B]=EX(X[B]); X[B+1]=EX(X[B+1]); X[B+2]=EX(X[B+2]); X[B+3]=EX(X[B+3]); PIN(X); SBAR(); }while(0)
  #define VRD(i) do{ vlo[i]=vtr(vp_+(((i)>>2)*4096+((i)&3)*1024)); vhi[i]=vtr(vp_+(((i)>>2)*4096+((i)&3)*1024+512)); }while(0)
  #define KRD(G,j) do{ if(G){ kload2(kf,kp0+sl_next,j); SBAR(); } }while(0)
  #define STEP(C0,C1,P0,P1,t,GK,GV,GL) do{ SBAR(); \
    const lds_cptr vp_=vp0+sl_prev; \
    VRD(0); SBAR(); float sacc=(P0[0]+P0[1]); \
    GAPA(C0=__builtin_amdgcn_mfma_f32_32x32x16_bf16(kf[0],qr[0],negm,0,0,0), P0[2],P0[3],P0[4],P0[5],     pw0[0]=PKW(P0,0), pw0[1]=PKW(P0,2), pw0); \
    VRD(4); SBAR(); GAPA(C1=__builtin_amdgcn_mfma_f32_32x32x16_bf16(kf[1],qr[0],negm,0,0,0), P0[6],P0[7],P0[8],P0[9],     pw0[2]=PKW(P0,4), pw0[3]=PKW(P0,6), pw0); \
    VRD(1); SBAR(); GAPA(C0=__builtin_amdgcn_mfma_f32_32x32x16_bf16(kf[2],qr[1],C0,0,0,0),   P0[10],P0[11],P0[12],P0[13], pw1[0]=PKW(P0,8), pw1[1]=PKW(P0,10), pw1); \
    VRD(5); SBAR(); GAPA(C1=__builtin_amdgcn_mfma_f32_32x32x16_bf16(kf[3],qr[1],C1,0,0,0),   P0[14],P0[15],P1[0],P1[1],   pw1[2]=PKW(P0,12),pw1[3]=PKW(P0,14), pw1); \
    VRD(2); SBAR(); GAPA(C0=__builtin_amdgcn_mfma_f32_32x32x16_bf16(kf[4],qr[2],C0,0,0,0),   P1[2],P1[3],P1[4],P1[5],     pw2[0]=PKW(P1,0), pw2[1]=PKW(P1,2), pw2); \
    VRD(6); SBAR(); GAPA(C1=__builtin_amdgcn_mfma_f32_32x32x16_bf16(kf[5],qr[2],C1,0,0,0),   P1[6],P1[7],P1[8],P1[9],     pw2[2]=PKW(P1,4), pw2[3]=PKW(P1,6), pw2); \
    VRD(3); SBAR(); GAPA(C0=__builtin_amdgcn_mfma_f32_32x32x16_bf16(kf[6],qr[3],C0,0,0,0),   P1[10],P1[11],P1[12],P1[13], pw3[0]=PKW(P1,8), pw3[1]=PKW(P1,10), pw3); \
    VRD(7); SBAR(); GAPA(C1=__builtin_amdgcn_mfma_f32_32x32x16_bf16(kf[7],qr[3],C1,0,0,0),   P1[14],P1[15],0.f,0.f,       pw3[2]=PKW(P1,12),pw3[3]=PKW(P1,14), pw3); \
    l_reg+=sacc; \
    if(GK){DMA_K((t)+3,sl_cur);} if(GV){DMA_V((t)+1,sl_next);} \
    CMASK(C0,C1,t); \
    { float a=MX3(C0[0],C0[1],C1[0]),b=MX3(C0[2],C0[3],C1[1]); a=MX3(a,C1[2],C1[3]); \
      _Pragma("unroll") for(int r=4;r<16;r+=4){a=MX3(a,C0[r],C0[r+1]);b=MX3(b,C0[r+2],C0[r+3]);a=MX3(a,C1[r],C1[r+1]);b=MX3(b,C1[r+2],C1[r+3]);} \
      float rm=__builtin_fmaxf(a,b); { auto rr=__builtin_amdgcn_permlane32_swap(__float_as_uint(rm),__float_as_uint(rm),false,false); rm=__builtin_fmaxf(__uint_as_float(rr[0]),__uint_as_float(rr[1])); } \
      resc=false; \
      if(__builtin_expect(__any(rm>(float)THRL),0)){ const float dl=__builtin_fmaxf(rm,0.f); mhat+=dl; \
        _Pragma("unroll") for(int r=0;r<16;++r){C0[r]-=dl;C1[r]-=dl;} \
        _Pragma("unroll") for(int r=0;r<16;++r)negm[r]=-mhat; asm volatile("":"+v"(negm)); \
        const float f=__builtin_amdgcn_exp2f(-dl); l_reg*=f; if(hi==0)wsf[r32]=f; resc=true; } } \
    SBAR(); \
    GAPB(o[0]=__builtin_amdgcn_mfma_f32_32x32x16_bf16(PAF(0),VFR(0),o[0],0,0,0), C0,0); \
    GAPB(o[1]=__builtin_amdgcn_mfma_f32_32x32x16_bf16(PAF(0),VFR(4),o[1],0,0,0), C0,4); \
    KRD(GL,0); GAPB(o[0]=__builtin_amdgcn_mfma_f32_32x32x16_bf16(PAF(1),VFR(1),o[0],0,0,0), C0,8); \
    KRD(GL,1); GAPB(o[1]=__builtin_amdgcn_mfma_f32_32x32x16_bf16(PAF(1),VFR(5),o[1],0,0,0), C0,12); \
    KRD(GL,2); GAPB(o[0]=__builtin_amdgcn_mfma_f32_32x32x16_bf16(PAF(2),VFR(2),o[0],0,0,0), C1,0); \
    KRD(GL,3); GAPB(o[1]=__builtin_amdgcn_mfma_f32_32x32x16_bf16(PAF(2),VFR(6),o[1],0,0,0), C1,4); \
    GAPB(o[0]=__builtin_amdgcn_mfma_f32_32x32x16_bf16(PAF(3),VFR(3),o[0],0,0,0), C1,8); \
    GAPB(o[1]=__builtin_amdgcn_mfma_f32_32x32x16_bf16(PAF(3),VFR(7),o[1],0,0,0), C1,12); \
    }while(0)
  int t=1;
  #undef CMASK
  #define CMASK(P0,P1,t) do{}while(0)
  for(;t+5<NT;t+=2){
    STEP(pB0,pB1,pA0,pA1,t,true,true,true);     WAIT_BAR(2); RESC(); ROT();
    STEP(pA0,pA1,pB0,pB1,t+1,true,true,true);   WAIT_BAR(2); RESC(); ROT();
  }
  #undef CMASK
  #define CMASK(P0,P1,t) do{}while(0)
  #define ENDW(tt) do{ if((tt)+3<NT){WAIT_BAR(2);} else if((tt)+2<NT){WAIT_BAR(1);} else {WAIT_BAR(0);} }while(0)
  for(;t+1<NT;t+=2){
    STEP(pB0,pB1,pA0,pA1,t,(t+3<NT),(t+1<NT),(t+1<NT));       ENDW(t);   RESC(); ROT();
    STEP(pA0,pA1,pB0,pB1,t+1,(t+4<NT),(t+2<NT),(t+2<NT));     ENDW(t+1); RESC(); ROT();
  }
  STEP(pB0,pB1,pA0,pA1,NT-1,false,false,false); RESC();
  { float sacc=pB0[0]+pB0[1]; _Pragma("unroll") for(int r=2;r<16;++r)sacc+=pB0[r]; _Pragma("unroll") for(int r=0;r<16;++r)sacc+=pB1[r]; l_reg+=sacc;
    pw0=(u32x4){PKW(pB0,0),PKW(pB0,2),PKW(pB0,4),PKW(pB0,6)};pw1=(u32x4){PKW(pB0,8),PKW(pB0,10),PKW(pB0,12),PKW(pB0,14)};pw2=(u32x4){PKW(pB1,0),PKW(pB1,2),PKW(pB1,4),PKW(pB1,6)};pw3=(u32x4){PKW(pB1,8),PKW(pB1,10),PKW(pB1,12),PKW(pB1,14)};
    SBAR(); pv(o,vb0+sl_cur,PAF(0),PAF(1),PAF(2),PAF(3)); }
  #undef PKW
  #undef PAF
  #undef VFR
  #undef PIN
  #undef MX3
  #undef GAPA
  #undef GAPB
  #undef EX
  #undef VRD
  #undef KRD
  #undef STEP
  #undef ENDW
  {auto rr=__builtin_amdgcn_permlane32_swap(__float_as_uint(l_reg),__float_as_uint(l_reg),false,false);l_reg=__uint_as_float(rr[0])+__uint_as_float(rr[1]);}
  if(hi==0)wsf[32+r32]=l_reg;asm volatile("s_waitcnt lgkmcnt(0)":::"memory");
  float rli[16];
  #pragma unroll
  for(int r=0;r<16;++r)rli[r]=__builtin_amdgcn_rcpf(wsf[32+crow(r,hi)]);
  bf16*Ow=O+((long)b*SEQQ+q0+wid*QBLK)*OPITCH+h*D; const bf16*Gw=Gt+((long)b*SEQQ+q0+wid*QBLK)*GPITCH+h*D;
  { bf16*stg=(bf16*)(shm+LDS_OST)+wid*2048;
    #pragma unroll
    for(int r=0;r<16;++r){const int orow=crow(r,hi);
      #pragma unroll
      for(int d0=0;d0<2;++d0)stg[orow*64+d0*32+r32]=__float2bfloat16(o[d0][r]*rli[r]);}
    asm volatile("s_waitcnt lgkmcnt(0)":::"memory");
    #pragma unroll
    for(int i=0;i<4;++i){const int row=i*8+(lane>>3),ch=lane&7; const u32x4 v=*(const u32x4*)(stg+row*64+ch*8); const u32x4 gv=*(const u32x4*)(Gw+(long)row*GPITCH+ch*8); u32x4 w;
      w.x=pk2(bflo(v.x)*silu_f(bflo(gv.x)),bfhi(v.x)*silu_f(bfhi(gv.x))); w.y=pk2(bflo(v.y)*silu_f(bflo(gv.y)),bfhi(v.y)*silu_f(bfhi(gv.y)));
      w.z=pk2(bflo(v.z)*silu_f(bflo(gv.z)),bfhi(v.z)*silu_f(bfhi(gv.z))); w.w=pk2(bflo(v.w)*silu_f(bflo(gv.w)),bfhi(v.w)*silu_f(bfhi(gv.w)));
      ATTN_STORE16(Ow+(long)row*OPITCH+ch*8,w);} }
  asm volatile("s_waitcnt lgkmcnt(0)\n\ts_barrier":::"memory");
  #undef DMA_K
  #undef DMA_V
  #undef CMASK
  #undef START
  #undef RESC
  #undef ROT
}
constexpr int ATTN_LDS_BYTES=LDS_BYTES;
#undef SBAR
#undef WAIT_BAR
}

typedef short v4i16_t __attribute__((ext_vector_type(4)));
DI s16x4_t vtr16(const LAS unsigned char* p) { return __builtin_bit_cast(s16x4_t, __builtin_amdgcn_ds_read_tr16_b64_v4i16((LAS v4i16_t*)p)); }

struct NaState { f32x16_t o0, o1; float m, l; };
template <bool MASK> DI void na_tile(NaState& st, const bf16x8_t (&qf)[4], const LAS unsigned char* Kb, const LAS unsigned char* Vb, int koff, int lane,
                                     int kr, int qr, int qc, int rsq, int csq, const LAS float* BIAS) {
    const int ql = lane & 31, hf = lane >> 5, row = koff + ql;
    f32x16_t sc = {};
#pragma unroll
    for (int ks = 0; ks < 4; ++ks) { const bf16x8_t kf = *(const LAS bf16x8_t*)(Kb + row * 128 + (((2 * ks + hf) ^ (row & 7)) << 4)); sc = __builtin_amdgcn_mfma_f32_32x32x16_bf16(kf, qf[ks], sc, 0, 0, 0); }
    const LAS unsigned char* vp = Vb + ((lane >> 4) & 1) * 32 + (lane & 3) * 8 + (koff + 4 * hf + ((lane & 15) >> 2)) * 64;
    s16x4_t vl[2][2], vh[2][2];
#pragma unroll
    for (int dt = 0; dt < 2; ++dt)
#pragma unroll
        for (int s = 0; s < 2; ++s) { vl[dt][s] = vtr16(vp + dt * 4096 + s * 1024); vh[dt][s] = vtr16(vp + dt * 4096 + s * 1024 + 512); }
    float xs[16];
    if (MASK) {
        const bool row_ok = (kr >= rsq) && (kr < rsq + 8);
        const LAS float* rb = BIAS + (kr - qr + 7) * 31 + (15 - qc);
#pragma unroll
        for (int r = 0; r < 16; ++r) { const int kc = koff + crow16(r, hf); const bool ok = row_ok && (kc >= csq) && (kc < csq + 16);
            const float bias = ok ? rb[kc] : 0.f; xs[r] = ok ? (sc[r] * 0.125f + bias) * LOG2E : -1e30f; }
    } else {
#pragma unroll
        for (int r = 0; r < 16; ++r) xs[r] = sc[r] * (0.125f * LOG2E);
    }
    float tm = xs[0];
#pragma unroll
    for (int r = 1; r < 16; ++r) tm = fmaxf(tm, xs[r]);
    tm = fmaxf(tm, __shfl_xor(tm, 32));
    const float mn = fmaxf(st.m, tm), al = __builtin_amdgcn_exp2f(st.m - mn);
    float ps = 0.f;
#pragma unroll
    for (int r = 0; r < 16; ++r) { xs[r] = __builtin_amdgcn_exp2f(xs[r] - mn); ps += xs[r]; }
    st.l = st.l * al + ps; st.m = mn;
#pragma unroll
    for (int r = 0; r < 16; ++r) { st.o0[r] *= al; st.o1[r] *= al; }
#pragma unroll
    for (int s = 0; s < 2; ++s) { v4u w; w.x = cvtpk(xs[8 * s], xs[8 * s + 1]); w.y = cvtpk(xs[8 * s + 2], xs[8 * s + 3]); w.z = cvtpk(xs[8 * s + 4], xs[8 * s + 5]); w.w = cvtpk(xs[8 * s + 6], xs[8 * s + 7]);
        const bf16x8_t pf = __builtin_bit_cast(bf16x8_t, w);
        const bf16x8_t a0 = __builtin_shufflevector(vl[0][s], vh[0][s], 0, 1, 2, 3, 4, 5, 6, 7), a1 = __builtin_shufflevector(vl[1][s], vh[1][s], 0, 1, 2, 3, 4, 5, 6, 7);
        st.o0 = __builtin_amdgcn_mfma_f32_32x32x16_bf16(a0, pf, st.o0, 0, 0, 0);
        st.o1 = __builtin_amdgcn_mfma_f32_32x32x16_bf16(a1, pf, st.o1, 0, 0, 0); }
}

constexpr int NA_BLOCK_UNITS = 512 + 32;
DI void na_block_unit(int unit, const bf16_t* PROJ, const float* relb, bf16_t* YMIX, LAS unsigned char* lds, int tid, int wave, int lane) {
    LAS unsigned char* KB = lds; LAS unsigned char* VB = lds + 16384; LAS float* BIAS = (LAS float*)(lds + 32768);
    const bool lat = unit < 512;
    int b, h, R = 0;
    if (lat) { R = unit & 15; h = (unit >> 4) & 7; b = unit >> 7; } else { const int u = unit - 512; h = u & 7; b = u >> 3; }
    const int ql = lane & 31, hf = lane >> 5;
    int qrow, qr = 0, qc = 0, rsq = 0, csq = 0, c0 = 0, rlo = 0, rhi = 0, rsA = 0, nsteps = 4;
    if (lat) { const int rp = 2 * R + (wave >> 2), ci = wave & 3; qr = 2 * rp + (ql >> 4); qc = 16 * ci + (ql & 15); qrow = b * SEQ + qr * 64 + qc;
        rsq = min(max(qr - 4, 0), 56); csq = min(max(qc - 8, 0), 48); c0 = min(max(16 * ci - 8, 0), 32);
        rlo = min(max(2 * rp - 4, 0), 56); rhi = min(max(2 * rp - 3, 0), 56) + 8;
        rsA = min(max(4 * R - 4, 0), 56); const int rsB = min(max(4 * R - 1, 0), 56); nsteps = 4 + (rsB + 8 - rsA);
    } else qrow = NLAT + b * LC + 32 * wave + ql;
    __syncthreads();
    if (lat) for (int e = tid; e < 465; e += NTHREADS) BIAS[e] = relb[h * 465 + e];
    bf16x8_t qf[4];
    { const bf16_t* qp = PROJ + (size_t)qrow * N0 + 1024 + h * 64 + 8 * hf;
#pragma unroll
      for (int ks = 0; ks < 4; ++ks) qf[ks] = *(const bf16x8_t*)(qp + 16 * ks); }
    NaState st; st.o0 = (f32x16_t){}; st.o1 = (f32x16_t){}; st.m = -1e30f; st.l = 0.f;
    const int srow = tid >> 3, sch = tid & 7;
    const int kdst = srow * 128 + ((sch ^ (srow & 7)) << 4), vdst = (sch >> 2) * 4096 + srow * 64 + (sch & 3) * 16;
    auto step_row0 = [&](int s) -> int { return s < 4 ? NLAT + b * LC + 64 * s : b * SEQ + (rsA + s - 4) * 64; };
    v4u kreg, vreg;
    { const bf16_t* src = PROJ + (size_t)(step_row0(0) + srow) * N0 + h * 64 + sch * 8; kreg = *(const v4u*)(src + 1536); vreg = *(const v4u*)(src + 2048); }
#pragma unroll 1
    for (int s = 0; s < nsteps; ++s) {
        LAS unsigned char* kb = KB + (s & 1) * 8192; LAS unsigned char* vb = VB + (s & 1) * 8192;
        *(LAS v4u*)(kb + kdst) = kreg; *(LAS v4u*)(vb + vdst) = vreg;
        __syncthreads();
        if (s + 1 < nsteps) { const bf16_t* src = PROJ + (size_t)(step_row0(s + 1) + srow) * N0 + h * 64 + sch * 8; kreg = *(const v4u*)(src + 1536); vreg = *(const v4u*)(src + 2048); }
        if (s < 4) { na_tile<false>(st, qf, kb, vb, 0, lane, 0, 0, 0, 0, 0, BIAS); na_tile<false>(st, qf, kb, vb, 32, lane, 0, 0, 0, 0, 0, BIAS); }
        else { const int kr = rsA + s - 4; if (kr >= rlo && kr < rhi) na_tile<true>(st, qf, kb, vb, c0, lane, kr, qr, qc, rsq, csq, BIAS); }
    }
    st.l += __shfl_xor(st.l, 32);
    const float rl = 1.f / st.l;
    const bf16_t* gp = PROJ + (size_t)qrow * N0 + 2560 + h * 64; bf16_t* yp = YMIX + (size_t)qrow * DM + 512 + h * 64;
#pragma unroll
    for (int dt = 0; dt < 2; ++dt)
#pragma unroll
        for (int rg = 0; rg < 4; ++rg) { const int d = 32 * dt + 8 * rg + 4 * hf;
            const v2u gv = *(const v2u*)(gp + d);
            const float g0 = silu_f(bflo(gv.x)), g1 = silu_f(bfhi(gv.x)), g2 = silu_f(bflo(gv.y)), g3 = silu_f(bfhi(gv.y));
            const f32x16_t& oo = dt ? st.o1 : st.o0;
            v2u w; w.x = pk2(oo[4 * rg] * rl * g0, oo[4 * rg + 1] * rl * g1); w.y = pk2(oo[4 * rg + 2] * rl * g2, oo[4 * rg + 3] * rl * g3);
            *(v2u*)(yp + d) = w; }
}

struct Args { const float* in[32]; float* out; unsigned char* ws; int ph_lo, ph_hi, li, pad; };
DI void phase3(const Args& args, LAS unsigned char* lds, int tid, int wave, int lane, int G, int pass) {
    unsigned char* ws = args.ws;
    for (int cu = blockIdx.x; cu < 256; cu += G)
        s5_scan_unit(cu, wave, (const bf16_t*)(ws + WS_PROJ), (const bf16_t*)(ws + WS_W16), (const float*)(ws + WS_L16), (bf16_t*)(ws + WS_CARRY0), (bf16_t*)(ws + WS_CARRY1), lane);
    for (int u = blockIdx.x; u < NA_BLOCK_UNITS; u += G) na_block_unit(u, (const bf16_t*)(ws + WS_PROJ), args.in[20], (bf16_t*)(ws + WS_YMIX), lds, tid, wave, lane);
}
DI void phase4(const Args& args, LAS unsigned char* lds, int tid, int wave, int lane, int G) {
    unsigned char* ws = args.ws;
    constexpr int NIT = 32 * 4 * 17;
    const int i0 = (int)(((long)blockIdx.x * NIT) / G), i1 = (int)(((long)(blockIdx.x + 1) * NIT) / G);
    int gcur = -1;
    for (int it = i0; it < i1; ++it) {
        const int g = it / 68, b = (it % 68) / 17, s = it % 17;
        if (g != gcur) { __syncthreads(); for (int e = tid; e < 1024; e += NTHREADS) ((LAS v4u*)lds)[e] = ((const v4u*)(ws + WS_KT))[(size_t)g * 1024 + e]; gcur = g; __syncthreads(); }
        s5_out_item(g, b, s, (const bf16_t*)(ws + WS_PROJ), (const bf16_t*)(ws + WS_WC), (const bf16_t*)(ws + WS_CARRY0), (const bf16_t*)(ws + WS_CARRY1), args.in[17], (bf16_t*)(ws + WS_YPRE), lds, wave, lane);
    }
}
DI LruP make_lrup(const Args& args) { unsigned char* ws = args.ws;
    return LruP{(const bf16_t*)(ws + WS_PROJ), args.in[23], args.in[24], args.in[25], args.in[27], args.in[29], (const bf16_t*)(ws + WS_LRUWT), (f32x2_t*)(ws + WS_CARRY0), (bf16_t*)(ws + WS_YMIX)}; }
DI void phase9(const Args& args, LAS unsigned char* lds, int tid, int wave, int lane, int G) {
    unsigned char* ws = args.ws; const LruP lp = make_lrup(args);
    for (int blk = blockIdx.x; blk < 256; blk += G) lru_block(blk, false, lp, lds, tid, wave, lane);
    const int gw = blockIdx.x * NWAVES + wave, NGW = G * NWAVES;
    for (int r = gw; r < MROWS; r += NGW) qkprep_row(r, (const bf16_t*)(ws + WS_PROJ), args.in[30], args.in[31], (const float*)(ws + WS_ROPE), (bf16_t*)(ws + WS_QP), (bf16_t*)(ws + WS_KP), lane);
}
DI void phase10(const Args& args, LAS unsigned char* lds, int tid, int wave, int lane, int G) {
    unsigned char* ws = args.ws;
    const LruP lp = make_lrup(args);
    for (int blk = blockIdx.x; blk < 256; blk += G) lru_block(blk, true, lp, lds, tid, wave, lane);
    __syncthreads();
    const int bx = blockIdx.x, vcu = (G % 8 == 0) ? (bx % 8) * (G / 8) + bx / 8 : bx;
    typedef gqa_body::bf16 abf;
    for (int u = vcu; u < 512; u += G) {
        const int qb = u & 15, hq = (u >> 4) & 7, b = u >> 7;
        gqa_body::attn_unit<8>(b, hq, qb, (const abf*)(ws + WS_QP), (const abf*)(ws + WS_KP), (const abf*)(ws + WS_VT1), (abf*)(ws + WS_YMIX) + 512, (const abf*)(ws + WS_PROJ) + 1792, (char*)lds);
    }
}

constexpr int RING_BYTES = 131072, LDSCTL_OFF = RING_BYTES, MISC_OFF = LDSCTL_OFF + 320, LDS_BYTES = 147456;
constexpr int CW_BAR = 4096;
constexpr int N_PHASES = 13;
constexpr bool kSP2 = true, kALIGN = true;

DI void p0_adaln(LAS unsigned char* lds, const float* c, const float* cctx, const float* ada_w, const float* ada_b, float* MOD, int tid, int wave, int lane, int G) {
    LAS float* sl = (LAS float*)lds;
    LAS float* red = (LAS float*)(lds + 5 * 1024 * 4);
    if ((int)blockIdx.x >= 192) return;
    for (int e = tid; e < 5 * 1024; e += NTHREADS) { const int r = e >> 10, k = e & 1023; const float x = r < 4 ? c[r * 1024 + k] : cctx[k]; sl[e] = silu_f(x); }
    __syncthreads();
    for (int item = blockIdx.x; item < 192; item += G) {
        const int i = item / 96, cb = item % 96, col = cb * 32 + (lane & 31), kh = lane >> 5;
        const float* W = ada_w + (size_t)i * 1024 * 3072 + col;
        float acc[5] = {0.f, 0.f, 0.f, 0.f, 0.f};
#pragma unroll 8
        for (int kk = 0; kk < 64; ++kk) { const int k = wave * 128 + 2 * kk + kh; const float w = W[(size_t)k * 3072];
#pragma unroll
            for (int r = 0; r < 5; ++r) acc[r] += sl[r * 1024 + k] * w; }
#pragma unroll
        for (int r = 0; r < 5; ++r) { acc[r] += __shfl_xor(acc[r], 32); if (lane < 32) red[(wave * 5 + r) * 32 + lane] = acc[r]; }
        __syncthreads();
        if (tid < 160) { const int r = tid >> 5, cl = tid & 31; float s = ada_b[i * 3072 + cb * 32 + cl];
#pragma unroll
            for (int w = 0; w < 8; ++w) s += red[(w * 5 + r) * 32 + cl];
            MOD[(i * 5 + r) * 3072 + cb * 32 + cl] = s; }
        __syncthreads();
    }
}
DI void p0_transpose_item(const float* W, int K, int N, bf16_t* WT, int row_off, LAS float* scr, int item, int lane) {
    const int nblk = N / 32, kb = item / nblk, nb = item % nblk, k0 = 64 * kb, n0 = 32 * nb;
#pragma unroll 8
    for (int i = 0; i < 32; ++i) { const int kk = 2 * i + (lane >> 5); scr[kk * 33 + (lane & 31)] = W[(size_t)(k0 + kk) * N + n0 + (lane & 31)]; }
    LDS_WAIT(); asm volatile("" ::: "memory");
    const int c = lane & 7;
#pragma unroll
    for (int j = 0; j < 4; ++j) { const int n = (lane >> 3) + 8 * j; const LAS float* s = scr + (8 * c) * 33 + n;
        v4u o; o.x = pk2(s[0 * 33], s[1 * 33]); o.y = pk2(s[2 * 33], s[3 * 33]); o.z = pk2(s[4 * 33], s[5 * 33]); o.w = pk2(s[6 * 33], s[7 * 33]);
        *(v4u*)(WT + (size_t)(row_off + n0 + n) * K + k0 + 8 * c) = o; }
    LDS_WAIT(); asm volatile("" ::: "memory");
}

DI void load_row16(const float* src, int lane, float (&v)[16]) {
#pragma unroll
    for (int j = 0; j < 4; ++j) { const f32x4_t t = *(const f32x4_t*)(src + j * 256 + lane * 4); v[4 * j] = t[0]; v[4 * j + 1] = t[1]; v[4 * j + 2] = t[2]; v[4 * j + 3] = t[3]; }
}
DI float row_rinv(const float (&v)[16]) {
    float ss = 0.f;
#pragma unroll
    for (int j = 0; j < 16; ++j) ss += v[j] * v[j];
    ss = wave_sum(ss);
    return rsqrtf(ss * (1.f / DM) + EPSN);
}
DI void store_modnorm(const float (&v)[16], float rinv, const float* g, const float* m, bf16_t* dst, int lane) {
#pragma unroll
    for (int j = 0; j < 4; ++j) { const int col = j * 256 + lane * 4;
        const f32x4_t gg = *(const f32x4_t*)(g + col), sc = *(const f32x4_t*)(m + 1024 + col), sh = *(const f32x4_t*)(m + col);
        float y[4];
#pragma unroll
        for (int e = 0; e < 4; ++e) y[e] = v[4 * j + e] * rinv * gg[e] * (1.f + sc[e]) + sh[e];
        v2u o; o.x = pk2(y[0], y[1]); o.y = pk2(y[2], y[3]); *(v2u*)(dst + col) = o; }
}

__global__ void __launch_bounds__(NTHREADS, 2) mega(Args args) {
    extern __shared__ __attribute__((aligned(16))) unsigned char lds_raw[];
    LAS unsigned char* lds = (LAS unsigned char*)lds_raw;
    volatile LAS unsigned* MISC = (volatile LAS unsigned*)(lds + MISC_OFF);
    const int tid = threadIdx.x, lane = tid & 63, wave = __builtin_amdgcn_readfirstlane(tid >> 6);
    const int G = gridDim.x;
    unsigned char* ws = args.ws;
    gu32* ctl = (gu32*)(ws + WS_CTL);
    for (int u = tid; u < (LDS_BYTES - LDSCTL_OFF) / 4; u += NTHREADS) ((LAS unsigned*)(lds + LDSCTL_OFF))[u] = 0u;
    __syncthreads();
    XcdBarrier bar = xcd_barrier_post((unsigned*)(ctl + CW_BAR) + args.li * XCD_BAR_WORDS, MISC + 8);
    const int lo = args.ph_lo, hi = args.ph_hi;
#define IN(k) (lo <= (k) && (k) < hi)
#ifndef PROBE_REP
#define PROBE_REP 0
#endif
#define PHASE_LOOP(k) for (int rep_ = 0, nrep_ = IN(k) ? 1 + ((PROBE_REP >> (k)) & 1) : 0; rep_ < nrep_; (++rep_ < nrep_) ? xcd_barrier(bar) : (void)0)
#define SEAM(k) do { if (IN(k) && IN((k) + 1)) xcd_barrier(bar); } while (0)

    const float* x = args.in[0]; const float* cvec = args.in[1]; const float* ctxin = args.in[2]; const float* cctx = args.in[3];
    const float* ada_w = args.in[4]; const float* ada_b = args.in[5]; const float* pre_g = args.in[6]; const float* post_g = args.in[7];
    float* out = args.out;
    float* MOD = (float*)(ws + WS_MOD);
    bf16_t* XN = (bf16_t*)(ws + WS_XN); bf16_t* YMIX = (bf16_t*)(ws + WS_YMIX); bf16_t* PROJ = (bf16_t*)(ws + WS_PROJ); float* OUTF = (float*)(ws + WS_PROJ);
    bf16_t* YPRE = (bf16_t*)(ws + WS_YPRE);
    const int gw = blockIdx.x * NWAVES + wave, NGW = G * NWAVES;

    PHASE_LOOP(0) {
        p0_adaln(lds, cvec, cctx, ada_w, ada_b, MOD, tid, wave, lane, G);
        for (int it = G - 1 - (int)blockIdx.x; it < 256; it += G)
            s5_tables_block(it, args.in[10], args.in[11], args.in[12], args.in[13], args.in[14], args.in[15], args.in[16], (bf16_t*)(ws + WS_W16), (bf16_t*)(ws + WS_WC), (bf16_t*)(ws + WS_KT), (float*)(ws + WS_L16), lds, tid);
    }
    SEAM(0);
    PHASE_LOOP(1) {
        for (int r = gw; r < MROWS; r += NGW) {
            const float* src = r < NLAT ? x + (size_t)r * DM : ctxin + (size_t)(r - NLAT) * DM;
            float v[16]; load_row16(src, lane, v);
            store_modnorm(v, row_rinv(v), pre_g, MOD + (r < NLAT ? (r >> 12) : 4) * 3072, XN + (size_t)r * DM, lane);
        }
        LAS float* scr = (LAS float*)(lds + 32768 + wave * 8704);
        constexpr int I0 = 16 * 96, I1 = 16 * 32, I2 = 16 * 72, I3 = 16 * 32, I4 = 8 * 16, NBIG = I0 + I1 + I2 + I3 + I4, NLRU = 32 * 2;
        for (int it = gw; it < NBIG + NLRU; it += NGW) {
            int r = it;
            if (r < I0) { p0_transpose_item(args.in[8], 1024, 3072, (bf16_t*)(ws + WS_WIN0T), 0, scr, r, lane); continue; } r -= I0;
            if (r < I1) { p0_transpose_item(args.in[9], 1024, 1024, (bf16_t*)(ws + WS_WOUT0T), 0, scr, r, lane); continue; } r -= I1;
            if (r < I2) { p0_transpose_item(args.in[21], 1024, 2304, (bf16_t*)(ws + WS_WIN1T), 0, scr, r, lane); continue; } r -= I2;
            if (r < I3) { p0_transpose_item(args.in[22], 1024, 1024, (bf16_t*)(ws + WS_WOUT1T), 0, scr, r, lane); continue; } r -= I3;
            if (r < I4) { p0_transpose_item(args.in[18], 512, 512, (bf16_t*)(ws + WS_WGLUT), 0, scr, r, lane); continue; } r -= I4;
            { const int mat = r >> 1, sub = r & 1, dir = mat >> 4, gate = (mat >> 3) & 1, blk = mat & 7;
              const float* W = (gate ? args.in[28] : args.in[26]) + (size_t)(dir * 8 + blk) * 4096;
              p0_transpose_item(W, 64, 64, (bf16_t*)(ws + WS_LRUWT), blk * 256 + (dir * 2 + gate) * 64, scr, sub, lane); }
        }
        float* ROPE = (float*)(ws + WS_ROPE);
        for (int e = blockIdx.x * NTHREADS + tid; e < SEQ * 32; e += G * NTHREADS) { const int t = e >> 5, i = e & 31, f = i & 15; const float pos = (float)(i < 16 ? (t >> 6) : (t & 63));
            const float inv = (float)exp(-log(10000.0) * (double)(2 * f) / 32.0); const float ang = pos * inv; ROPE[2 * e] = cosf(ang); ROPE[2 * e + 1] = sinf(ang); }
    }
    SEAM(1);
    PHASE_LOOP(2) {
        pg8::Gemm g{XN, (const bf16_t*)(ws + WS_WIN0T), MROWS, N0, DM}; pg8::StaticOrder S; S.init(MROWS, N0, G, (int)blockIdx.x);
        pg8::EpiProj E{PROJ, N0, nullptr, 1 << 30, 1 << 30, 512, false};
        pg8::gemm_phase<pg8::EpiProj, pg8::StaticOrder, kALIGN, kSP2>(lds, g, S, E);
    }
    SEAM(2);
    PHASE_LOOP(3) { phase3(args, lds, tid, wave, lane, G, rep_); }
    SEAM(3);
    PHASE_LOOP(4) { phase4(args, lds, tid, wave, lane, G); }
    SEAM(4);
    PHASE_LOOP(5) {
        pg8::Gemm g{YPRE, (const bf16_t*)(ws + WS_WGLUT), MROWS, 512, 512}; pg8::StaticOrder S; S.init(MROWS, 512, G, (int)blockIdx.x);
        pg8::EpiGlu E{YPRE, PROJ, args.in[19], YMIX};
        pg8::gemm_phase<pg8::EpiGlu, pg8::StaticOrder, kALIGN, kSP2>(lds, g, S, E);
    }
    SEAM(5);
    PHASE_LOOP(6) {
        pg8::Gemm g{YMIX, (const bf16_t*)(ws + WS_WOUT0T), MROWS, DM, DM}; pg8::StaticOrder S; S.init(MROWS, DM, G, (int)blockIdx.x);
        pg8::EpiF32 E{OUTF, DM};
        pg8::gemm_phase<pg8::EpiF32, pg8::StaticOrder, kALIGN, kSP2>(lds, g, S, E);
    }
    SEAM(6);
    PHASE_LOOP(7) {
        for (int r = gw; r < MROWS; r += NGW) {
            const int mrow = r < NLAT ? (r >> 12) : 4;
            const float* hin = r < NLAT ? x + (size_t)r * DM : ctxin + (size_t)(r - NLAT) * DM;
            float v[16], h[16]; load_row16(OUTF + (size_t)r * DM, lane, v); load_row16(hin, lane, h);
            const float rinv = row_rinv(v); const float* gt = MOD + mrow * 3072 + 2048;
#pragma unroll
            for (int j = 0; j < 4; ++j) { const int col = j * 256 + lane * 4; const f32x4_t pg = *(const f32x4_t*)(post_g + col), gg = *(const f32x4_t*)(gt + col);
#pragma unroll
                for (int e = 0; e < 4; ++e) h[4 * j + e] += gg[e] * (v[4 * j + e] * rinv * pg[e]);
                if (r < NLAT) *(f32x4_t*)(out + (size_t)r * DM + col) = (f32x4_t){h[4 * j], h[4 * j + 1], h[4 * j + 2], h[4 * j + 3]}; }
            store_modnorm(h, row_rinv(h), pre_g + DM, MOD + (5 + mrow) * 3072, XN + (size_t)r * DM, lane);
        }
    }
    SEAM(7);
    PHASE_LOOP(8) {
        pg8::Gemm g{XN, (const bf16_t*)(ws + WS_WIN1T), MROWS, N1, DM}; pg8::StaticOrder S; S.init(MROWS, N1, G, (int)blockIdx.x);
        pg8::EpiProj E{PROJ, N1, (bf16_t*)(ws + WS_VT1), 1664, 1792, 128, true};
        pg8::gemm_phase<pg8::EpiProj, pg8::StaticOrder, kALIGN, kSP2>(lds, g, S, E);
    }
    SEAM(8);
    PHASE_LOOP(9) { phase9(args, lds, tid, wave, lane, G); }
    SEAM(9);
    PHASE_LOOP(10) { phase10(args, lds, tid, wave, lane, G); }
    SEAM(10);
    PHASE_LOOP(11) {
        pg8::Gemm g{YMIX, (const bf16_t*)(ws + WS_WOUT1T), NLAT, DM, DM}; pg8::StaticOrder S; S.init(NLAT, DM, G, (int)blockIdx.x);
        pg8::EpiF32 E{OUTF, DM};
        pg8::gemm_phase<pg8::EpiF32, pg8::StaticOrder, kALIGN, kSP2>(lds, g, S, E);
    }
    SEAM(11);
    PHASE_LOOP(12) {
        for (int r = gw; r < NLAT; r += NGW) {
            float v[16], h[16]; load_row16(OUTF + (size_t)r * DM, lane, v); load_row16(out + (size_t)r * DM, lane, h);
            const float rinv = row_rinv(v); const float* gt = MOD + (5 + (r >> 12)) * 3072 + 2048;
#pragma unroll
            for (int j = 0; j < 4; ++j) { const int col = j * 256 + lane * 4; const f32x4_t pg = *(const f32x4_t*)(post_g + DM + col), gg = *(const f32x4_t*)(gt + col);
                f32x4_t o;
#pragma unroll
                for (int e = 0; e < 4; ++e) o[e] = h[4 * j + e] + gg[e] * (v[4 * j + e] * rinv * pg[e]);
                *(f32x4_t*)(out + (size_t)r * DM + col) = o; }
        }
    }
#undef IN
#undef SEAM
}
__global__ void k_adaln(const float* c, const float* cctx, const float* ada_w, const float* ada_b, float* mod) {
    const int idx = blockIdx.x * blockDim.x + threadIdx.x;
    if (idx >= 2 * 5 * 3072) return;
    const int col = idx % 3072, r = (idx / 3072) % 5, i = idx / (3072 * 5);
    const float* cv = r < 4 ? c + r * 1024 : cctx;
    const float* W = ada_w + (size_t)i * 1024 * 3072;
    float acc = 0.f;
    for (int k = 0; k < 1024; ++k) acc += silu_f(cv[k]) * W[(size_t)k * 3072 + col];
    mod[idx] = acc + ada_b[i * 3072 + col];
}

__global__ void k_prenorm(const float* lat, const float* ctx, const float* g, const float* mod  , bf16_t* XN) {
    const int r = blockIdx.x * 4 + (threadIdx.x >> 6), lane = threadIdx.x & 63;
    if (r >= MROWS) return;
    const float* src = r < NLAT ? lat + (size_t)r * DM : ctx + (size_t)(r - NLAT) * DM;
    const float* m = mod + (r < NLAT ? (r >> 12) : 4) * 3072;
    float v[16]; float ss = 0.f;
#pragma unroll
    for (int j = 0; j < 4; ++j) { const float4 t = *(const float4*)(src + j * 256 + lane * 4); v[4 * j] = t.x; v[4 * j + 1] = t.y; v[4 * j + 2] = t.z; v[4 * j + 3] = t.w; }
#pragma unroll
    for (int j = 0; j < 16; ++j) ss += v[j] * v[j];
    ss = wave_sum(ss);
    const float rinv = rsqrtf(ss * (1.f / DM) + EPSN);
#pragma unroll
    for (int j = 0; j < 4; ++j)
#pragma unroll
        for (int e = 0; e < 4; ++e) { const int col = j * 256 + lane * 4 + e; const float y = v[4 * j + e] * rinv * g[col] * (1.f + m[1024 + col]) + m[col]; XN[(size_t)r * DM + col] = f2bf(y); }
}

__global__ void k_postnorm(const float* hlat, const float* hctx, const float* OUT, const float* pg, const float* mod, float* olat, float* octx, int nrows) {
    const int r = blockIdx.x * 4 + (threadIdx.x >> 6), lane = threadIdx.x & 63;
    if (r >= nrows) return;
    const float* hin = r < NLAT ? hlat + (size_t)r * DM : hctx + (size_t)(r - NLAT) * DM;
    float* ho = r < NLAT ? olat + (size_t)r * DM : octx + (size_t)(r - NLAT) * DM;
    const float* m = mod + (r < NLAT ? (r >> 12) : 4) * 3072 + 2048;
    const float* src = OUT + (size_t)r * DM;
    float v[16]; float ss = 0.f;
#pragma unroll
    for (int j = 0; j < 4; ++j) { const float4 t = *(const float4*)(src + j * 256 + lane * 4); v[4 * j] = t.x; v[4 * j + 1] = t.y; v[4 * j + 2] = t.z; v[4 * j + 3] = t.w; }
#pragma unroll
    for (int j = 0; j < 16; ++j) ss += v[j] * v[j];
    ss = wave_sum(ss);
    const float rinv = rsqrtf(ss * (1.f / DM) + EPSN);
#pragma unroll
    for (int j = 0; j < 4; ++j)
#pragma unroll
        for (int e = 0; e < 4; ++e) { const int col = j * 256 + lane * 4 + e; ho[col] = hin[col] + m[col] * (v[4 * j + e] * rinv * pg[col]); }
}

enum { GM_PROJ0 = 0, GM_PROJ1 = 1, GM_GLU = 2, GM_F32 = 3 };
struct GemmEpi { bf16_t* P; bf16_t* VT; const bf16_t* YPRE; const bf16_t* PROJ; const float* bglu; bf16_t* YMIX; float* OUT; };
template <int MODE> __global__ void __launch_bounds__(256) k_gemm(const bf16_t* A, const float* W, int M, int N, int K, GemmEpi e) {
    const int tx = threadIdx.x & 15, ty = threadIdx.x >> 4;
    const int c0 = blockIdx.x * 64 + tx * 4, r0 = blockIdx.y * 64 + ty * 4;
    float acc[4][4] = {};
    for (int k = 0; k < K; ++k) {
        const float4 w = *(const float4*)(W + (size_t)k * N + c0);
        const float wv[4] = {rbf(w.x), rbf(w.y), rbf(w.z), rbf(w.w)};
#pragma unroll
        for (int i = 0; i < 4; ++i) { const float a = bf2f(A[(size_t)(r0 + i) * K + k]);
#pragma unroll
            for (int j = 0; j < 4; ++j) acc[i][j] += a * wv[j]; }
    }
#pragma unroll
    for (int i = 0; i < 4; ++i)
#pragma unroll
        for (int j = 0; j < 4; ++j) {
            const int r = r0 + i, c = c0 + j; const float v = acc[i][j];
            if (MODE == GM_PROJ0) { e.P[(size_t)r * N0 + c] = f2bf(v);
                if (c >= 2048 && c < 2560) { const int hd = c - 2048; e.VT[((size_t)(row_batch(r) * 8) * 64 + hd) * POSN + row_pos(r)] = f2bf(v); } }
            else if (MODE == GM_PROJ1) { e.P[(size_t)r * N1 + c] = f2bf(v);
                if (c >= 1664 && c < 1792) { const int hd = c - 1664; e.VT[((size_t)(row_batch(r) * 2) * 64 + hd) * POSN + row_pos(r)] = f2bf(v); } }
            else if (MODE == GM_GLU) { const float y = bf2f(e.YPRE[(size_t)r * 512 + c]); const float ga = bf2f(e.PROJ[(size_t)r * N0 + 512 + c]);
                e.YMIX[(size_t)r * DM + c] = f2bf(y * sigmoid_f(v + e.bglu[c]) * silu_f(ga)); }
            else e.OUT[(size_t)r * N + c] = v;
        }
}

__global__ void __launch_bounds__(64) k_s5_scan(const bf16_t* PROJ, const float* lam_re, const float* lam_im, const float* log_dt, const float* b_re, const float* b_im,
                                                 const float* c_re, const float* c_im, float* YS) {
    const int p = threadIdx.x, id = blockIdx.x, dir = id & 1, g = (id >> 1) & 31, b = id >> 6;
    const int gi = (dir * 32 + g);
    const double lre = lam_re[gi * 64 + p], lim = lam_im[gi * 64 + p], dt = exp((double)log_dt[gi]);
    const double mag = exp(lre * dt); const float ar = (float)(mag * cos(lim * dt)), ai = (float)(mag * sin(lim * dt));
    const double nr = mag * cos(lim * dt) - 1.0, ni = mag * sin(lim * dt), den = lre * lre + lim * lim;
    const float cfr = (float)((nr * lre + ni * lim) / den), cfi = (float)((ni * lre - nr * lim) / den);
    float bbr[16], bbi[16], cr[16], ci[16];
#pragma unroll
    for (int h = 0; h < 16; ++h) { const float br = b_re[(gi * 64 + p) * 16 + h], bi = b_im[(gi * 64 + p) * 16 + h]; bbr[h] = cfr * br - cfi * bi; bbi[h] = cfr * bi + cfi * br;
        cr[h] = c_re[(gi * 16 + h) * 64 + p]; ci[h] = c_im[(gi * 16 + h) * 64 + p]; }
    float hr = 0.f, hi = 0.f;
    float* ys = YS + (size_t)dir * MROWS * 512;
    for (int pos = 0; pos < POSN; ++pos) {
        int row;
        if (dir == 0) row = pos_row(b, pos); else row = pos < LC ? NLAT + b * LC + (LC - 1 - pos) : b * SEQ + (SEQ - 1 - (pos - LC));
        const bf16_t* up = PROJ + (size_t)row * N0 + g * 16;
        float bur = 0.f, bui = 0.f;
#pragma unroll
        for (int h = 0; h < 16; ++h) { const float u = bf2f(up[h]); bur += bbr[h] * u; bui += bbi[h] * u; }
        const float nhr = ar * hr - ai * hi + bur, nhi = ar * hi + ai * hr + bui; hr = nhr; hi = nhi;
        float mine = 0.f;
#pragma unroll
        for (int h = 0; h < 16; ++h) { const float y = wave_sum(cr[h] * hr - ci[h] * hi); if (p == h) mine = y; }
        if (p < 16) ys[(size_t)row * 512 + g * 16 + p] = mine;
    }
}
__global__ void k_s5_finish(const bf16_t* PROJ, const float* YS, const float* dsk, bf16_t* YPRE) {
    const size_t idx = (size_t)blockIdx.x * blockDim.x + threadIdx.x; if (idx >= (size_t)MROWS * 512) return;
    const int ch = idx & 511; const size_t r = idx >> 9;
    const float y = dsk[ch] * bf2f(PROJ[r * N0 + ch]) + YS[idx] + YS[(size_t)MROWS * 512 + idx];
    YPRE[idx] = f2bf(gelu_tanh(y));
}

__global__ void __launch_bounds__(256) k_na_attn(const bf16_t* PROJ, const float* relb, bf16_t* YMIX) {
    const int wv = blockIdx.x * 4 + (threadIdx.x >> 6), lane = threadIdx.x & 63;
    if (wv >= MROWS * 8) return;
    const int h = wv & 7, r = wv >> 3, b = row_batch(r);
    const float q = bf2f(PROJ[(size_t)r * N0 + 1024 + h * 64 + lane]);
    float m = -INFINITY, l = 0.f, o = 0.f;
    if (r < NLAT) {
        const int t = r & 4095, qr = t >> 6, qc = t & 63;
        const int rs = min(max(qr - 4, 0), 56), cs = min(max(qc - 8, 0), 48);
        for (int kr = rs; kr < rs + 8; ++kr)
            for (int kc = cs; kc < cs + 16; ++kc) {
                const size_t kro = (size_t)(b * SEQ + kr * 64 + kc) * N0;
                float s = wave_sum(q * bf2f(PROJ[kro + 1536 + h * 64 + lane])) * 0.125f + relb[(h * 15 + (kr - qr + 7)) * 31 + (kc - qc + 15)];
                const float mn = fmaxf(m, s), al = __expf(m - mn), pp = __expf(s - mn);
                l = l * al + pp; o = o * al + pp * bf2f(PROJ[kro + 2048 + h * 64 + lane]); m = mn;
            }
    }
    for (int c = 0; c < LC; ++c) {
        const size_t kro = (size_t)(NLAT + b * LC + c) * N0;
        const float s = wave_sum(q * bf2f(PROJ[kro + 1536 + h * 64 + lane])) * 0.125f;
        const float mn = fmaxf(m, s), al = __expf(m - mn), pp = __expf(s - mn);
        l = l * al + pp; o = o * al + pp * bf2f(PROJ[kro + 2048 + h * 64 + lane]); m = mn;
    }
    const float gb = bf2f(PROJ[(size_t)r * N0 + 2560 + h * 64 + lane]);
    YMIX[(size_t)r * DM + 512 + h * 64 + lane] = f2bf(o / l * silu_f(gb));
}

__global__ void __launch_bounds__(64) k_lru(const bf16_t* P1, const float* conv_w, const float* conv_b, const float* lam, const float* w_a, const float* b_a,
                                            const float* w_x, const float* b_x, float* HS, bf16_t* YMIX) {
    __shared__ float xs[64];
    const int j = threadIdx.x, nb = blockIdx.x & 7, b = blockIdx.x >> 3, ch = nb * 64 + j;
    const float cw0 = conv_w[0 * 512 + ch], cw1 = conv_w[1 * 512 + ch], cw2 = conv_w[2 * 512 + ch], cw3 = conv_w[3 * 512 + ch], cb = conv_b[ch];
    for (int dir = 0; dir < 2; ++dir) {
        float wa[64], wx[64];
#pragma unroll
        for (int i = 0; i < 64; ++i) { wa[i] = w_a[((dir * 8 + nb) * 64 + i) * 64 + j]; wx[i] = w_x[((dir * 8 + nb) * 64 + i) * 64 + j]; }
        const float ba = b_a[dir * 512 + ch], bx = b_x[dir * 512 + ch];
        const float lm = lam[dir * 512 + ch]; const float sp = (-lm > 20.f) ? -lm : log1pf(__expf(-lm));
        float hst = 0.f;
        for (int pos = 0; pos < POSN; ++pos) {
            int s0, sl, t;
            if (pos < LC) { s0 = NLAT + b * LC; sl = LC; t = dir == 0 ? pos : LC - 1 - pos; }
            else { s0 = b * SEQ; sl = SEQ; t = dir == 0 ? pos - LC : SEQ - 1 - (pos - LC); }
            float xm1 = 0.f, x0, xp1 = 0.f, xp2 = 0.f;
            x0 = bf2f(P1[(size_t)(s0 + t) * N1 + ch]);
            if (t - 1 >= 0) xm1 = bf2f(P1[(size_t)(s0 + t - 1) * N1 + ch]);
            if (t + 1 < sl) xp1 = bf2f(P1[(size_t)(s0 + t + 1) * N1 + ch]);
            if (t + 2 < sl) xp2 = bf2f(P1[(size_t)(s0 + t + 2) * N1 + ch]);
            const float xc = cw0 * xm1 + cw1 * x0 + cw2 * xp1 + cw3 * xp2 + cb;
            __syncthreads(); xs[j] = xc; __syncthreads();
            float ga = ba, gx = bx;
#pragma unroll
            for (int i = 0; i < 64; ++i) { const float xi = xs[i]; ga += xi * wa[i]; gx += xi * wx[i]; }
            const float gr = sigmoid_f(ga), gi = sigmoid_f(gx);
            const float log_a = -8.f * gr * sp; const float a = __expf(log_a); const float mult = sqrtf(fmaxf(-expm1f(2.f * log_a), 0.f));
            hst = a * hst + mult * gi * xc;
            if (pos >= LC) { const size_t rr = (size_t)(s0 + t);
                if (dir == 0) HS[rr * 512 + ch] = hst;
                else { const float gc = bf2f(P1[rr * N1 + 512 + ch]); YMIX[rr * DM + ch] = f2bf((HS[rr * 512 + ch] + hst) * silu_f(gc)); } }
        }
    }
}

__global__ void __launch_bounds__(256) k_qkprep(const bf16_t* P1, const float* qn, const float* kn, bf16_t* QP, bf16_t* KP) {
    const int wv = blockIdx.x * 4 + (threadIdx.x >> 6), lane = threadIdx.x & 63;
    if (wv >= MROWS * 10) return;
    const int slot = wv % 10, r = wv / 10, b = row_batch(r);
    if (slot < 8 && r >= NLAT) return;
    const int col0 = slot < 8 ? 1024 + slot * 64 : 1536 + (slot - 8) * 64;
    const float x = bf2f(P1[(size_t)r * N1 + col0 + lane]);
    const float ss = wave_sum(x * x);
    float y = x * rsqrtf(ss * (1.f / 64.f) + EPSN) * (slot < 8 ? qn[lane] : kn[lane]);
    if (r < NLAT) {
        const int t = r & 4095, i = lane >> 1, f = i & 15; const float pos = (float)(i < 16 ? (t >> 6) : (t & 63));
        const float inv = (float)exp(-log(10000.0) * (double)(2 * f) / 32.0);
        const float ang = pos * inv; const float cs = cosf(ang), sn = sinf(ang);
        const float pr = __shfl_xor(y, 1);
        y = (lane & 1) ? (pr * sn + y * cs) : (y * cs - pr * sn);
    }
    if (slot < 8) QP[((size_t)(b * 8 + slot) * SEQ + (r & 4095)) * 64 + lane] = f2bf(y * (0.125f * LOG2E));
    else KP[((size_t)(b * 2 + (slot - 8)) * POSN + row_pos(r)) * 64 + lane] = f2bf(y);
}

__global__ void __launch_bounds__(256) k_gqa(const bf16_t* QP, const bf16_t* KP, const bf16_t* P1, bf16_t* YMIX) {
    const int wv = blockIdx.x * 4 + (threadIdx.x >> 6), lane = threadIdx.x & 63;
    if (wv >= NLAT * 8) return;
    const int hq = wv & 7, r = wv >> 3, b = r >> 12, t = r & 4095, kvh = hq >> 2;
    const float q = bf2f(QP[((size_t)(b * 8 + hq) * SEQ + t) * 64 + lane]);
    const bf16_t* kp = KP + (size_t)(b * 2 + kvh) * POSN * 64;
    float m = -INFINITY, l = 0.f, o = 0.f;
    for (int pos = 0; pos < POSN; ++pos) {
        const float s = wave_sum(q * bf2f(kp[(size_t)pos * 64 + lane]));
        const float v = bf2f(P1[(size_t)pos_row(b, pos) * N1 + 1664 + kvh * 64 + lane]);
        const float mn = fmaxf(m, s), al = exp2f(m - mn), pp = exp2f(s - mn);
        l = l * al + pp; o = o * al + pp * v; m = mn;
    }
    const float gd = bf2f(P1[(size_t)r * N1 + 1792 + hq * 64 + lane]);
    YMIX[(size_t)r * DM + 512 + hq * 64 + lane] = f2bf(o / l * silu_f(gd));
}

static int g_grid = 0;
static void launch_mega(Args a, int lo, int hi, int li, hipStream_t stream) {
    a.ph_lo = lo; a.ph_hi = hi; a.li = li;
    hipLaunchKernelGGL(mega, dim3(g_grid), dim3(NTHREADS), LDS_BYTES, stream, a);
    const hipError_t le = hipPeekAtLastError();
    if (le != hipSuccess) fprintf(stderr, "kernel_launch: mega[%d,%d) failed: %s\n", lo, hi, hipGetErrorName(le));
}
extern "C" void kernel_launch(void* const* d_in, const int* in_sizes, int n_in, void* d_out, int out_size, void* d_ws, size_t ws_size, hipStream_t stream) {
    if (g_grid == 0) {
        int dev = 0, cus = 0;
        if (hipGetDevice(&dev) != hipSuccess || hipDeviceGetAttribute(&cus, hipDeviceAttributeMultiprocessorCount, dev) != hipSuccess) { fprintf(stderr, "kernel_launch: device query failed\n"); g_grid = -1; return; }
        if (hipFuncSetAttribute((const void*)mega, hipFuncAttributeMaxDynamicSharedMemorySize, LDS_BYTES) != hipSuccess) { fprintf(stderr, "kernel_launch: hipFuncSetAttribute failed\n"); g_grid = -1; return; }
        int per_cu = 0;
        if (hipOccupancyMaxActiveBlocksPerMultiprocessor(&per_cu, (const void*)mega, NTHREADS, LDS_BYTES) != hipSuccess || per_cu < 1) fprintf(stderr, "kernel_launch: occupancy query says %d blocks/CU\n", per_cu);
        (void)hipGetLastError();
        g_grid = cus;
    }
    if (g_grid < 0) return;
    const float* x = (const float*)d_in[0]; const float* c = (const float*)d_in[1]; const float* ctx = (const float*)d_in[2]; const float* cctx = (const float*)d_in[3];
    const float* ada_w = (const float*)d_in[4]; const float* ada_b = (const float*)d_in[5]; const float* pre_g = (const float*)d_in[6]; const float* post_g = (const float*)d_in[7];
    const float* ev_w_in = (const float*)d_in[8]; const float* ev_w_out = (const float*)d_in[9];
    const float* s5_lre = (const float*)d_in[10]; const float* s5_lim = (const float*)d_in[11]; const float* s5_ldt = (const float*)d_in[12];
    const float* s5_bre = (const float*)d_in[13]; const float* s5_bim = (const float*)d_in[14]; const float* s5_cre = (const float*)d_in[15]; const float* s5_cim = (const float*)d_in[16];
    const float* s5_d = (const float*)d_in[17]; const float* s5_wglu = (const float*)d_in[18]; const float* s5_bglu = (const float*)d_in[19]; const float* relb = (const float*)d_in[20];
    const float* od_w_in = (const float*)d_in[21]; const float* od_w_out = (const float*)d_in[22]; const float* conv_w = (const float*)d_in[23]; const float* conv_b = (const float*)d_in[24];
    const float* lru_lam = (const float*)d_in[25]; const float* w_a = (const float*)d_in[26]; const float* b_a = (const float*)d_in[27]; const float* w_x = (const float*)d_in[28]; const float* b_x = (const float*)d_in[29];
    const float* qn = (const float*)d_in[30]; const float* kn = (const float*)d_in[31];
    char* ws = (char*)d_ws; float* out = (float*)d_out;
    float* MOD = (float*)(ws + WS_MOD); float* HC1 = (float*)(ws + WS_HC1);
    bf16_t* XN = (bf16_t*)(ws + WS_XN); bf16_t* YMIX = (bf16_t*)(ws + WS_YMIX); bf16_t* PROJ = (bf16_t*)(ws + WS_PROJ); float* OUTF = (float*)(ws + WS_PROJ);
    bf16_t* VT0 = (bf16_t*)(ws + WS_VT0); bf16_t* YPRE = (bf16_t*)(ws + WS_YPRE); bf16_t* QP = (bf16_t*)(ws + WS_QP); bf16_t* KP = (bf16_t*)(ws + WS_KP); bf16_t* VT1 = (bf16_t*)(ws + WS_VT1);
    float* YS = (float*)(ws + WS_YS); float* HS = (float*)(ws + WS_HS);
    (void)x; (void)c; (void)ctx; (void)cctx; (void)ada_w; (void)ada_b; (void)pre_g; (void)post_g; (void)ev_w_in; (void)ev_w_out; (void)s5_wglu; (void)od_w_in; (void)od_w_out; (void)MOD; (void)HC1; (void)XN; (void)OUTF; (void)VT0; (void)VT1; (void)out;

    if (hipMemsetAsync(ws + WS_CTL, 0, CTL_ZERO_BYTES, stream) != hipSuccess) { fprintf(stderr, "kernel_launch: memset failed\n"); return; }
    Args a{};
    for (int i = 0; i < 32; ++i) a.in[i] = (const float*)d_in[i];
    a.out = (float*)d_out; a.ws = (unsigned char*)d_ws;

    launch_mega(a, 0, N_PHASES, 0, stream);
    (void)relb; (void)conv_w; (void)conv_b; (void)lru_lam; (void)w_a; (void)b_a; (void)w_x; (void)b_x; (void)HS; (void)qn; (void)kn; (void)QP; (void)KP;
    (void)s5_lre; (void)s5_lim; (void)s5_ldt; (void)s5_bre; (void)s5_bim; (void)s5_cre; (void)s5_cim; (void)s5_d; (void)s5_bglu; (void)YS; (void)YPRE; (void)PROJ; (void)YMIX;
}
```

```cpp
#include <hip/hip_runtime.h>
#include <cstdint>
#include <cstdio>

typedef unsigned short bf16_t;
#define DI __device__ __forceinline__
#define GAS __attribute__((address_space(1)))
#define LAS __attribute__((address_space(3)))
typedef unsigned v4u __attribute__((ext_vector_type(4)));
typedef unsigned v2u __attribute__((ext_vector_type(2)));
typedef float f32x4_t __attribute__((ext_vector_type(4)));
typedef float f32x16_t __attribute__((ext_vector_type(16)));
typedef short bf16x8_t __attribute__((ext_vector_type(8)));
typedef short s16x4_t __attribute__((ext_vector_type(4)));
typedef GAS unsigned gu32;
typedef GAS unsigned long long gu64;
#define RLX_AGENT __ATOMIC_RELAXED, __HIP_MEMORY_SCOPE_AGENT
#define LDS_WAIT() asm volatile("s_waitcnt lgkmcnt(0)" ::: "memory")
#define VM_WAIT() asm volatile("s_waitcnt vmcnt(0)" ::: "memory")

DI float bf2f(bf16_t v) { return __uint_as_float((unsigned)v << 16); }
DI bf16_t f2bf(float f) { unsigned u = __float_as_uint(f); return (bf16_t)((u + 0x7fffu + ((u >> 16) & 1u)) >> 16); }
DI unsigned pk2(float lo, float hi) { return (unsigned)f2bf(lo) | ((unsigned)f2bf(hi) << 16); }
DI float bflo(unsigned w) { return __uint_as_float(w << 16); }
DI float bfhi(unsigned w) { return __uint_as_float(w & 0xffff0000u); }
DI float rbf(float f) { return bf2f(f2bf(f)); }
DI float wave_sum(float v) {
#pragma unroll
    for (int o = 1; o < 64; o <<= 1) v += __shfl_xor(v, o);
    return v;
}
DI float sigmoid_f(float x) { return __builtin_amdgcn_rcpf(1.f + __builtin_amdgcn_exp2f(-1.4426950408889634f * x)); }
DI float silu_f(float x) { return x * sigmoid_f(x); }
DI float gelu_tanh(float x) { const float u = 0.7978845608028654f * (x + 0.044715f * x * x * x); return 0.5f * x * (1.f + tanhf(u)); }
DI float gelu_fast(float x) { const float u = 1.5957691216057308f * (x + 0.044715f * x * x * x); return x * sigmoid_f(u); }

constexpr int NWAVES = 8, NTHREADS = 512;
constexpr int DM = 1024, NB = 4, SEQ = 4096, LC = 256;
constexpr int NLAT = NB * SEQ, NCTX = NB * LC, MROWS = NLAT + NCTX;
constexpr int N0 = 3072, N1 = 2304, POSN = LC + SEQ;
constexpr float EPSN = 1e-6f;
constexpr float LOG2E = 1.4426950408889634f;

constexpr size_t MiB = 1u << 20;
constexpr size_t WS_CTL = 0, CTL_ZERO_BYTES = 1 * MiB;
constexpr size_t WS_MOD = 1 * MiB;
constexpr size_t WS_ROPE = 2 * MiB;
constexpr size_t WS_L16 = 3 * MiB;
constexpr size_t WS_WIN0T = 4 * MiB;
constexpr size_t WS_WOUT0T = 10 * MiB;
constexpr size_t WS_WIN1T = 12 * MiB;
constexpr size_t WS_WOUT1T = 17 * MiB;
constexpr size_t WS_WGLUT = 19 * MiB;
constexpr size_t WS_LRUWT = 19 * MiB + 512 * 1024;
constexpr size_t WS_W16 = 20 * MiB;
constexpr size_t WS_WC = 24 * MiB;
constexpr size_t WS_KT = 28 * MiB;
constexpr size_t WS_LSUM = 29 * MiB;
constexpr size_t WS_XN = 32 * MiB;
constexpr size_t WS_YMIX = 66 * MiB;
constexpr size_t WS_PROJ = 100 * MiB;
constexpr size_t WS_VT0 = 202 * MiB;
constexpr size_t WS_UG = 202 * MiB;
constexpr size_t WS_CARRY1 = 219 * MiB;
constexpr size_t WS_YPRE = 228 * MiB;
constexpr size_t WS_QP = 202 * MiB;
constexpr size_t WS_KP = 218 * MiB;
constexpr size_t WS_VT1 = 223 * MiB;
constexpr size_t WS_YS = 32 * MiB;
constexpr size_t WS_HS = 32 * MiB;
constexpr size_t WS_HC1 = 246 * MiB;

DI int row_batch(int r) { return r < NLAT ? (r >> 12) : ((r - NLAT) >> 8); }
DI int row_pos(int r) { return r < NLAT ? LC + (r & 4095) : ((r - NLAT) & 255); }
DI int pos_row(int b, int pos) { return pos < LC ? NLAT + b * LC + pos : b * SEQ + (pos - LC); }

namespace pg8 {
#define PG8_LAS __attribute__((address_space(3)))
typedef unsigned short bf16_t;
typedef short bf16x8 __attribute__((ext_vector_type(8)));
typedef float f32x4 __attribute__((ext_vector_type(4)));
typedef unsigned u32x4 __attribute__((ext_vector_type(4)));
constexpr int BM = 256, BK = 64, HALF = 128, HTB = HALF * BK * 2  , STAGE_BYTES = 8 * HTB, NXCD = 8, WGM = 8;

__host__ __device__ __forceinline__ int lds_byte(int r, int c) { const int st = (r >> 4) * 2 + (c >> 5), rr = r & 15, cc = c & 31, ob = rr * 64 + cc * 2; return st * 1024 + (ob ^ (((ob >> 9) & 1) << 5)); }
__host__ __device__ __forceinline__ void stage_rc(int b, int& R, int& C) { const int st = b / 1024, sb = b % 1024, swz = sb ^ (((sb >> 9) & 1) << 5); R = (st >> 1) * 16 + swz / 64; C = (st & 1) * 32 + (swz % 64) / 2; }
__host__ __device__ __forceinline__ int perm32(int rho) { const int n = rho >> 4, i = rho & 15; return 8 * (i >> 2) + 4 * n + (i & 3); }

struct Unit { int pm, pn; };
struct Gemm { const bf16_t* A; const bf16_t* Bt; int M, N, K; int a_gmajor; };

struct StaticOrder {
    int nM, nN, nwg, G, c;
    __host__ __device__ void init(int M, int N, int G_, int c_) { nM = M / BM; nN = N / BM; nwg = nM * nN; G = G_; c = c_; }
    __host__ __device__ bool next(int i, Unit& u) const {
        const long L = (long)i * G + c; if (L >= nwg) return false;
        int wgid = (int)L; { const int q = nwg / NXCD, r = nwg % NXCD, xcd = wgid % NXCD, off = wgid / NXCD; wgid = (xcd < r ? xcd * (q + 1) : r * (q + 1) + (xcd - r) * q) + off; }
        const int nig = WGM * nN, gid = wgid / nig, fm = gid * WGM, gsz = (nM - fm) < WGM ? (nM - fm) : WGM;
        u.pm = fm + ((wgid % nig) % gsz); u.pn = (wgid % nig) / gsz; return true;
    }
    __device__ __forceinline__ void a_ready(const Unit&) const {}
    __device__ __forceinline__ void done(const Unit&) const {}
};

__device__ __forceinline__ unsigned cvt_pk_bf16(float lo, float hi) { unsigned r; asm volatile("v_cvt_pk_bf16_f32 %0, %1, %2" : "=v"(r) : "v"(lo), "v"(hi)); return r; }

struct EpiProj {
    static constexpr bool PERM = true, AFTER_DRAIN = false;
    bf16_t* P; int ldc; bf16_t* VT; int vt_lo, vt_hi, vt_w; bool vrow; bf16_t* UG; int ug_hi;
    __device__ __forceinline__ void operator()(const f32x4 (&acc)[2][2][4][2], const Unit& u, int wr, int wc, int fr, int fq) const {
        const int row0 = u.pm * BM + wr * 64 + fr, colt = u.pn * BM + wc * 32 + 8 * fq;
#pragma unroll
        for (int ai = 0; ai < 2; ++ai)
#pragma unroll
            for (int m = 0; m < 4; ++m) { const int r = row0 + ai * HALF + m * 16; bf16_t* rowp = P + (size_t)r * ldc + colt;
#pragma unroll
                for (int bj = 0; bj < 2; ++bj) { const f32x4 v0 = acc[ai][bj][m][0], v1 = acc[ai][bj][m][1];
                    u32x4 w; w.x = cvt_pk_bf16(v0[0], v0[1]); w.y = cvt_pk_bf16(v0[2], v0[3]); w.z = cvt_pk_bf16(v1[0], v1[1]); w.w = cvt_pk_bf16(v1[2], v1[3]);
                    const int c0 = colt + bj * HALF;
                    if (c0 < ug_hi) *(u32x4*)(UG + ((size_t)(c0 >> 4) * MROWS + r) * 16 + (c0 & 15)) = w; else *(u32x4*)(rowp + bj * HALF) = w;
                    if (c0 >= vt_lo && c0 < vt_hi && vrow) {
                        const int hd = c0 - vt_lo; *(u32x4*)(VT + ((size_t)(row_batch(r) * (vt_w >> 6) + (hd >> 6)) * POSN + row_pos(r)) * 64 + (hd & 63)) = w;
                    } else if (c0 >= vt_lo && c0 < vt_hi) {
                        bf16_t* vp = VT + ((size_t)row_batch(r) * vt_w + (c0 - vt_lo)) * POSN + row_pos(r);
                        vp[0 * POSN] = (bf16_t)(w.x & 0xffffu); vp[1 * POSN] = (bf16_t)(w.x >> 16); vp[2 * POSN] = (bf16_t)(w.y & 0xffffu); vp[3 * POSN] = (bf16_t)(w.y >> 16);
                        vp[4 * POSN] = (bf16_t)(w.z & 0xffffu); vp[5 * POSN] = (bf16_t)(w.z >> 16); vp[6 * POSN] = (bf16_t)(w.w & 0xffffu); vp[7 * POSN] = (bf16_t)(w.w >> 16);
                    } } }
    }
};
struct EpiGlu {
    static constexpr bool PERM = true, AFTER_DRAIN = false;
    const bf16_t* YPRE; const bf16_t* PROJ; const float* bglu; bf16_t* YMIX;
    __device__ __forceinline__ void operator()(const f32x4 (&acc)[2][2][4][2], const Unit& u, int wr, int wc, int fr, int fq) const {
        const int row0 = u.pm * BM + wr * 64 + fr, colt = u.pn * BM + wc * 32 + 8 * fq;
#pragma unroll
        for (int bj = 0; bj < 2; ++bj) { const int c0 = colt + bj * HALF;
            const f32x4 b0 = *(const f32x4*)(bglu + c0), b1 = *(const f32x4*)(bglu + c0 + 4);
#pragma unroll
            for (int ai = 0; ai < 2; ++ai)
#pragma unroll
                for (int m = 0; m < 4; ++m) { const int r = row0 + ai * HALF + m * 16;
                    const u32x4 yv = *(const u32x4*)(YPRE + ((size_t)(c0 >> 4) * MROWS + r) * 16 + (c0 & 15)), gv = *(const u32x4*)(PROJ + (size_t)r * N0 + 512 + c0);
                    const f32x4 a0 = acc[ai][bj][m][0] + b0, a1 = acc[ai][bj][m][1] + b1;
                    float o[8];
                    o[0] = bflo(yv.x) * sigmoid_f(a0[0]) * silu_f(bflo(gv.x)); o[1] = bfhi(yv.x) * sigmoid_f(a0[1]) * silu_f(bfhi(gv.x));
                    o[2] = bflo(yv.y) * sigmoid_f(a0[2]) * silu_f(bflo(gv.y)); o[3] = bfhi(yv.y) * sigmoid_f(a0[3]) * silu_f(bfhi(gv.y));
                    o[4] = bflo(yv.z) * sigmoid_f(a1[0]) * silu_f(bflo(gv.z)); o[5] = bfhi(yv.z) * sigmoid_f(a1[1]) * silu_f(bfhi(gv.z));
                    o[6] = bflo(yv.w) * sigmoid_f(a1[2]) * silu_f(bflo(gv.w)); o[7] = bfhi(yv.w) * sigmoid_f(a1[3]) * silu_f(bfhi(gv.w));
                    u32x4 w; w.x = cvt_pk_bf16(o[0], o[1]); w.y = cvt_pk_bf16(o[2], o[3]); w.z = cvt_pk_bf16(o[4], o[5]); w.w = cvt_pk_bf16(o[6], o[7]);
                    *(u32x4*)(YMIX + (size_t)r * DM + c0) = w; } }
    }
};
struct EpiF32 {
    static constexpr bool PERM = false, AFTER_DRAIN = false;
    float* O; int ldc;
    __device__ __forceinline__ void operator()(const f32x4 (&acc)[2][2][4][2], const Unit& u, int wr, int wc, int fr, int fq) const {
        const int row0 = u.pm * BM + wr * 64 + fr, col0 = u.pn * BM + wc * 32 + 4 * fq;
#pragma unroll
        for (int ai = 0; ai < 2; ++ai)
#pragma unroll
            for (int m = 0; m < 4; ++m) { float* rowp = O + (size_t)(row0 + ai * HALF + m * 16) * ldc + col0;
#pragma unroll
                for (int bj = 0; bj < 2; ++bj)
#pragma unroll
                    for (int n = 0; n < 2; ++n) *(f32x4*)(rowp + bj * HALF + n * 16) = acc[ai][bj][m][n]; }
    }
};
template <class Epi, class Sched, bool ALIGN_EPI = false, bool SP2 = false>
__device__ __forceinline__ void gemm_phase(PG8_LAS unsigned char* lds, const Gemm g, const Sched& S, const Epi& E) {
    const int tid = threadIdx.x, wid = __builtin_amdgcn_readfirstlane(tid >> 6), lane = tid & 63, wr = wid >> 2, wc = wid & 3, fr = lane & 15, fq = lane >> 4;
    const int K = g.K, nt = K / BK;
    unsigned voffA[2], voffB[2];
#pragma unroll
    for (int i = 0; i < 2; ++i) { int R, C; stage_rc(tid * 16 + i * 8192, R, C); const int Rb = Epi::PERM ? ((R & ~31) + perm32(R & 31)) : R;
        voffA[i] = g.a_gmajor ? (unsigned)(((C >> 4) * g.M + R) * 16 + (C & 15)) * 2u : (unsigned)(R * K + C) * 2u; voffB[i] = (unsigned)(Rb * K + C) * 2u; }
    const size_t kstep = (size_t)(BK * 2);
    const size_t hstep = (size_t)HALF * K * 2;
    const size_t tstep = 2 * hstep;
    const size_t kstepA = g.a_gmajor ? (size_t)(BK / 16) * g.M * 32 : kstep, hstepA = g.a_gmajor ? (size_t)HALF * 32 : hstep, tstepA = 2 * hstepA;
    const unsigned ldsw = (unsigned)wid * 1024u;
    const int aoff = lds_byte(wr * 64 + fr, fq * 8), boff = lds_byte(wc * 32 + fr, fq * 8);
#define PG8_SA(b, h) (((b) * 2 + (h)) * HTB)
#define PG8_SB(b, h) ((4 + (b) * 2 + (h)) * HTB)
#define PG8_STAGE(bufoff, gbase, voff) do { _Pragma("unroll") for (int _i = 0; _i < 2; ++_i) \
        __builtin_amdgcn_global_load_lds((const unsigned*)((const char*)(gbase) + (voff)[_i]), (PG8_LAS unsigned*)(lds + (bufoff) + ldsw + _i * 8192), 16, 0, 0); } while (0)
#define PG8_LDA(dst, b, h) do { _Pragma("unroll") for (int m = 0; m < 4; ++m) _Pragma("unroll") for (int k = 0; k < 2; ++k) dst[m][k] = *(const PG8_LAS bf16x8*)(lds + PG8_SA(b, h) + aoff + m * 2048 + k * 1024); } while (0)
#define PG8_LDB(dst, b, h) do { _Pragma("unroll") for (int n = 0; n < 2; ++n) _Pragma("unroll") for (int k = 0; k < 2; ++k) dst[n][k] = *(const PG8_LAS bf16x8*)(lds + PG8_SB(b, h) + boff + n * 2048 + k * 1024); } while (0)
#define PG8_MMA(ai, bj, At, Bt) do { __builtin_amdgcn_s_setprio(1); _Pragma("unroll") for (int m = 0; m < 4; ++m) _Pragma("unroll") for (int n = 0; n < 2; ++n) _Pragma("unroll") for (int k = 0; k < 2; ++k) \
        acc[ai][bj][m][n] = __builtin_amdgcn_mfma_f32_16x16x32_bf16(Bt[n][k], At[m][k], acc[ai][bj][m][n], 0, 0, 0); __builtin_amdgcn_s_setprio(0); } while (0)
#define PG8_WAIT_V(n) asm volatile("s_waitcnt vmcnt(" #n ")" ::: "memory")
#define PG8_WAIT_L(n) asm volatile("s_waitcnt lgkmcnt(" #n ")" ::: "memory")
#define PG8_BAR __builtin_amdgcn_s_barrier()
#define PG8_SCHED __builtin_amdgcn_sched_barrier(0)
    Unit cur, nxt; int ui = 0;
    if (!S.next(0, cur)) return;
    f32x4 acc[2][2][4][2];
#pragma unroll
    for (int a = 0; a < 2; ++a)
#pragma unroll
        for (int b = 0; b < 2; ++b)
#pragma unroll
            for (int m = 0; m < 4; ++m)
#pragma unroll
                for (int n = 0; n < 2; ++n) acc[a][b][m][n] = (f32x4){0.f, 0.f, 0.f, 0.f};
    bf16x8 At[4][2], B0[2][2], B1[2][2];
    const char* cA = (const char*)g.A + (size_t)cur.pm * tstepA; const char* cB = (const char*)g.Bt + (size_t)cur.pn * tstep;
    S.a_ready(cur);
    if constexpr (SP2) {
        PG8_STAGE(PG8_SB(0, 0), cB, voffB); PG8_STAGE(PG8_SB(0, 1), cB + hstep, voffB); PG8_STAGE(PG8_SA(0, 0), cA, voffA); PG8_STAGE(PG8_SA(0, 1), cA + hstepA, voffA);
        if (wr == 1) PG8_BAR;
        PG8_WAIT_V(2); PG8_BAR;
        PG8_STAGE(PG8_SB(1, 0), cB + kstep, voffB); PG8_STAGE(PG8_SA(1, 0), cA + kstepA, voffA); PG8_STAGE(PG8_SB(1, 1), cB + hstep + kstep, voffB);
        PG8_WAIT_V(6); PG8_BAR;
    } else {
        PG8_STAGE(PG8_SB(0, 0), cB, voffB); PG8_STAGE(PG8_SA(0, 0), cA, voffA); PG8_STAGE(PG8_SB(0, 1), cB + hstep, voffB); PG8_STAGE(PG8_SA(0, 1), cA + hstepA, voffA);
        if (wr == 1) PG8_BAR;
        PG8_WAIT_V(4); PG8_BAR;
        PG8_STAGE(PG8_SB(1, 0), cB + kstep, voffB); PG8_STAGE(PG8_SA(1, 0), cA + kstepA, voffA); PG8_STAGE(PG8_SB(1, 1), cB + hstep + kstep, voffB);
        PG8_WAIT_V(6); PG8_BAR;
    }
    for (;;) {
        const bool has_next = S.next(ui + 1, nxt);
        const char* nA = has_next ? (const char*)g.A + (size_t)nxt.pm * tstepA : cA; const char* nB = has_next ? (const char*)g.Bt + (size_t)nxt.pn * tstep : cB;
        for (int t = 0; t < nt; t += 2) {
            const bool last = (t == nt - 2);
            const char* a1 = cA + (size_t)(t + 1) * kstepA;
            const char* a2 = last ? nA : cA + (size_t)(t + 2) * kstepA; const char* b2 = last ? nB : cB + (size_t)(t + 2) * kstep;
            const char* a3 = a2 + kstepA; const char* b3 = b2 + kstep;
            if (last && has_next) S.a_ready(nxt);
            if constexpr (SP2) {
            PG8_LDB(B0, 0, 0); PG8_LDB(B1, 0, 1); PG8_SCHED; PG8_LDA(At, 0, 0); PG8_STAGE(PG8_SA(1, 1), a1 + hstepA, voffA);
            PG8_WAIT_V(8); PG8_WAIT_L(0); PG8_BAR; PG8_MMA(0, 0, At, B0); PG8_MMA(0, 1, At, B1); PG8_BAR; PG8_SCHED;
            PG8_LDA(At, 0, 1); PG8_STAGE(PG8_SB(0, 0), b2, voffB); PG8_STAGE(PG8_SB(0, 1), b2 + hstep, voffB); PG8_STAGE(PG8_SA(0, 0), a2, voffA);
            PG8_WAIT_V(8); PG8_WAIT_L(0); PG8_BAR; PG8_MMA(1, 0, At, B0); PG8_MMA(1, 1, At, B1); PG8_BAR; PG8_SCHED;
            PG8_LDB(B0, 1, 0); PG8_LDB(B1, 1, 1); PG8_SCHED; PG8_LDA(At, 1, 0); PG8_STAGE(PG8_SA(0, 1), a2 + hstepA, voffA);
            PG8_WAIT_V(8); PG8_WAIT_L(0); PG8_BAR; PG8_MMA(0, 0, At, B0); PG8_MMA(0, 1, At, B1); PG8_BAR; PG8_SCHED;
            PG8_LDA(At, 1, 1); PG8_STAGE(PG8_SB(1, 0), b3, voffB); PG8_STAGE(PG8_SB(1, 1), b3 + hstep, voffB); PG8_STAGE(PG8_SA(1, 0), a3, voffA);
            PG8_WAIT_V(8); PG8_WAIT_L(0); PG8_BAR; PG8_MMA(1, 0, At, B0); PG8_MMA(1, 1, At, B1); PG8_BAR; PG8_SCHED;
            } else {
            PG8_LDB(B0, 0, 0); PG8_SCHED; PG8_LDA(At, 0, 0); PG8_STAGE(PG8_SA(1, 1), a1 + hstepA, voffA);
            PG8_WAIT_L(8); PG8_BAR; PG8_WAIT_L(0); PG8_MMA(0, 0, At, B0); PG8_BAR; PG8_SCHED;
            PG8_LDB(B1, 0, 1); PG8_STAGE(PG8_SB(0, 0), b2, voffB);
            PG8_BAR; PG8_WAIT_L(0); PG8_MMA(0, 1, At, B1); PG8_BAR;
            PG8_LDA(At, 0, 1); PG8_STAGE(PG8_SA(0, 0), a2, voffA);
            PG8_BAR; PG8_WAIT_L(0); PG8_MMA(1, 0, At, B0); PG8_BAR; PG8_SCHED;
            PG8_STAGE(PG8_SB(0, 1), b2 + hstep, voffB);
            PG8_WAIT_V(6); PG8_BAR; PG8_MMA(1, 1, At, B1); PG8_BAR;
            PG8_LDB(B0, 1, 0); PG8_SCHED; PG8_LDA(At, 1, 0); PG8_STAGE(PG8_SA(0, 1), a2 + hstepA, voffA);
            PG8_WAIT_L(8); PG8_BAR; PG8_WAIT_L(0); PG8_MMA(0, 0, At, B0); PG8_BAR; PG8_SCHED;
            PG8_LDB(B1, 1, 1); PG8_STAGE(PG8_SB(1, 0), b3, voffB);
            PG8_BAR; PG8_WAIT_L(0); PG8_MMA(0, 1, At, B1); PG8_BAR;
            PG8_LDA(At, 1, 1); PG8_STAGE(PG8_SA(1, 0), a3, voffA);
            PG8_BAR; PG8_WAIT_L(0); PG8_MMA(1, 0, At, B0); PG8_BAR; PG8_SCHED;
            PG8_STAGE(PG8_SB(1, 1), b3 + hstep, voffB);
            PG8_WAIT_V(6); PG8_BAR; PG8_MMA(1, 1, At, B1); PG8_BAR;
            }
        }
        if constexpr (ALIGN_EPI) { if (wr == 0) PG8_BAR; }
        if constexpr (!Epi::AFTER_DRAIN) { E(acc, cur, wr, wc, fr, fq); S.done(cur); }
        if (!has_next) break;
#pragma unroll
        for (int a = 0; a < 2; ++a)
#pragma unroll
            for (int b = 0; b < 2; ++b)
#pragma unroll
                for (int m = 0; m < 4; ++m)
#pragma unroll
                    for (int n = 0; n < 2; ++n) acc[a][b][m][n] = (f32x4){0.f, 0.f, 0.f, 0.f};
        cur = nxt; cA = nA; cB = nB; ++ui;
        if constexpr (ALIGN_EPI) { if (wr == 1) PG8_BAR; }
    }
    PG8_WAIT_V(0);
    if constexpr (!ALIGN_EPI) { if (wr == 0) PG8_BAR; }
    PG8_BAR;
    if constexpr (Epi::AFTER_DRAIN) { E.fused(acc, cur, wr, wc, fr, fq, lds, wid, lane); S.done(cur); }
#undef PG8_SA
#undef PG8_SB
#undef PG8_STAGE
#undef PG8_LDA
#undef PG8_LDB
#undef PG8_MMA
#undef PG8_WAIT_V
#undef PG8_WAIT_L
#undef PG8_BAR
#undef PG8_SCHED
}
}
#define XB_TMO      128
#define XB_XCNT(j)  (256  + 64 * (j))
#define XB_XSUB(j)  (1280 + 64 * (j))
#define XB_XGEN(j)  (2304 + 64 * (j))
#define XB_TOP      3328
#define XB_TOPGEN   3392
#define XCD_BAR_WORDS 3456
#define XB_SPIN_CAP (1u << 18)

__device__ __forceinline__ unsigned xb_ld(unsigned* p)              { return __hip_atomic_load(p, __ATOMIC_RELAXED, __HIP_MEMORY_SCOPE_AGENT); }
__device__ __forceinline__ unsigned xb_add(unsigned* p, unsigned v) { return __hip_atomic_fetch_add(p, v, __ATOMIC_RELAXED, __HIP_MEMORY_SCOPE_AGENT); }
__device__ __forceinline__ unsigned xb_xcc_id() { return (unsigned)__builtin_amdgcn_s_getreg((3 << 11) | 20) & 0xFu; }
#define XB_SPIN(cond, bar) do { unsigned _sp = 0; while (cond) { __builtin_amdgcn_s_sleep(1); \
    if ((++_sp & 255u) == 0u) { if (xb_ld(&(bar)[XB_TMO])) break; if (_sp > XB_SPIN_CAP) { atomicAdd(&(bar)[XB_TMO], 1u); break; } } } } while (0)

struct XcdBarrier {
    unsigned* bar; unsigned x;
    volatile LAS unsigned* st;
};

__device__ __forceinline__ XcdBarrier xcd_barrier_post(unsigned* bar, volatile LAS unsigned* st) {
    XcdBarrier b; b.bar = bar; b.x = xb_xcc_id(); b.st = st;
    if (threadIdx.x == 0) (void)xb_add(&bar[XB_XCNT(b.x)], 1u);
    return b;
}
__device__ __forceinline__ void xcd_barrier_complete(unsigned* bar, unsigned x, unsigned& nloc, unsigned& nx) {
    const unsigned G = gridDim.x * gridDim.y * gridDim.z;
    unsigned sum, cnt, mine, sp = 0u;
    for (;;) {
        sum = 0u; cnt = 0u; mine = 0u;
#pragma unroll
        for (unsigned j = 0; j < 16; ++j) { const unsigned c = xb_ld(&bar[XB_XCNT(j)]); sum += c; cnt += (c > 0u) ? 1u : 0u; mine = (j == x) ? c : mine; }
        if (sum == G) break;
        __builtin_amdgcn_s_sleep(1);
        if ((++sp & 255u) == 0u) { if (xb_ld(&bar[XB_TMO])) break; if (sp > XB_SPIN_CAP) { atomicAdd(&bar[XB_TMO], 1u); break; } }
    }
    nloc = mine > 0u ? mine : 1u; nx = cnt > 0u ? cnt : 1u;
}

__device__ __forceinline__ void xcd_barrier(const XcdBarrier& b) {
    asm volatile("s_waitcnt vmcnt(0)" ::: "memory");
    __syncthreads();
    if (threadIdx.x == 0) {
        unsigned* bar = b.bar;
        __builtin_amdgcn_s_waitcnt(0);
        unsigned nloc = b.st[0], nx = b.st[1];
        if (nloc == 0u) { xcd_barrier_complete(bar, b.x, nloc, nx); b.st[0] = nloc; b.st[1] = nx; }
        const unsigned old = xb_add(&bar[XB_XSUB(b.x)], 1u);
        const unsigned gen = old / nloc;
        if (old + 1u == (gen + 1u) * nloc) {
            __builtin_amdgcn_fence(__ATOMIC_RELEASE, "agent");
            asm volatile("s_waitcnt vmcnt(0)" ::: "memory");
            const unsigned og = xb_add(&bar[XB_TOP], 1u);
            const unsigned tg = og / nx;
            if (og + 1u == (tg + 1u) * nx) xb_add(&bar[XB_TOPGEN], 1u);
            else XB_SPIN(xb_ld(&bar[XB_TOPGEN]) == tg, bar);
            __builtin_amdgcn_fence(__ATOMIC_ACQUIRE, "agent");
            xb_add(&bar[XB_XGEN(b.x)], 1u);
            asm volatile("s_waitcnt vmcnt(0)" ::: "memory");
        } else {
            XB_SPIN(xb_ld(&bar[XB_XGEN(b.x)]) == gen, bar);
            __builtin_amdgcn_fence(__ATOMIC_ACQUIRE, "agent");
            asm volatile("s_waitcnt vmcnt(0)" ::: "memory");
        }
    }
    __syncthreads();
}

DI int crow16(int reg, int hf) { return (reg & 3) + 8 * (reg >> 2) + 4 * hf; }
DI unsigned cvtpk(float lo, float hi) { typedef float f2 __attribute__((ext_vector_type(2))); typedef __bf16 b2 __attribute__((ext_vector_type(2))); f2 v = {lo, hi}; b2 b = __builtin_convertvector(v, b2); return __builtin_bit_cast(unsigned, b); }
struct AttnP { const bf16_t* Q; const bf16_t* K; const bf16_t* VT; const bf16_t* Gt; bf16_t* Y; const float* relb; };

template <int MODE> DI void attn_unit(int unit, const AttnP& P, int lane) {
    const int ql = lane & 31, hf = lane >> 5;
    int b, h, kvh, qrow, NT, rp = 0, ci = 0, rs0 = 0, c0 = 0, qr = 0, qc = 0, rsq = 0, csq = 0;
    if (MODE == 0) { ci = unit & 3; rp = (unit >> 2) & 31; h = (unit >> 7) & 7; b = unit >> 10; kvh = h;
        qr = 2 * rp + (ql >> 4); qc = 16 * ci + (ql & 15); qrow = b * SEQ + qr * 64 + qc;
        rs0 = min(max(2 * rp - 4, 0), 56); const int rs1 = min(max(2 * rp - 3, 0), 56); NT = 8 + (rs1 + 8 - rs0);
        c0 = min(max(16 * ci - 8, 0), 32); rsq = min(max(qr - 4, 0), 56); csq = min(max(qc - 8, 0), 48);
    } else if (MODE == 1) { const int qt = unit & 7; h = (unit >> 3) & 7; b = unit >> 6; kvh = h; qrow = NLAT + b * LC + 32 * qt + ql; NT = 8; }
    else { const int qt = unit & 127; h = (unit >> 7) & 7; b = unit >> 10; kvh = h >> 2; qrow = b * SEQ + 32 * qt + ql; NT = POSN / 32; }
    const bf16_t* qp; const bf16_t* kb; size_t kpitch; const bf16_t* vt; const bf16_t* gp; bf16_t* yp;
    if (MODE == 2) { qp = P.Q + ((size_t)(b * 8 + h) * SEQ + (qrow - b * SEQ)) * 64; kb = P.K + (size_t)(b * 2 + kvh) * POSN * 64; kpitch = 64;
        vt = P.VT + (size_t)(b * 2 + kvh) * 64 * POSN; gp = P.Gt + (size_t)qrow * N1 + 1792 + h * 64; }
    else { qp = P.Q + (size_t)qrow * N0 + 1024 + h * 64; kb = P.K + 1536 + h * 64; kpitch = N0; vt = P.VT + (size_t)(b * 8 + h) * 64 * POSN; gp = P.Gt + (size_t)qrow * N0 + 2560 + h * 64; }
    yp = P.Y + (size_t)qrow * DM + 512 + h * 64;
    bf16x8_t qf[4];
#pragma unroll
    for (int ks = 0; ks < 4; ++ks) qf[ks] = *(const bf16x8_t*)(qp + 16 * ks + 8 * hf);
    const bf16_t* vt0 = vt + (size_t)ql * POSN + 4 * hf;
    f32x16_t o0 = {}, o1 = {};
    float m = -1e30f, l = 0.f;
    auto tile_krow = [&](int t) -> int { if (MODE == 2) return 32 * t + ql; if (t < 8) return NLAT + b * LC + 32 * t + ql; return b * SEQ + (rs0 + t - 8) * 64 + c0 + ql; };
    auto tile_pos0 = [&](int t) -> int { if (MODE == 2) return 32 * t; if (t < 8) return 32 * t; return LC + (rs0 + t - 8) * 64 + c0; };
    bf16x8_t kn[4];
    { const bf16_t* kp = kb + (size_t)tile_krow(0) * kpitch + 8 * hf;
#pragma unroll
      for (int ks = 0; ks < 4; ++ks) kn[ks] = *(const bf16x8_t*)(kp + 16 * ks); }
#pragma unroll 1
    for (int t = 0; t < NT; ++t) {
        bf16x8_t kf[4];
#pragma unroll
        for (int ks = 0; ks < 4; ++ks) kf[ks] = kn[ks];
        if (t + 1 < NT) { const bf16_t* kp = kb + (size_t)tile_krow(t + 1) * kpitch + 8 * hf;
#pragma unroll
            for (int ks = 0; ks < 4; ++ks) kn[ks] = *(const bf16x8_t*)(kp + 16 * ks); }
        const bf16_t* vp = vt0 + tile_pos0(t);
        s16x4_t va[2][2][2];
#pragma unroll
        for (int dt = 0; dt < 2; ++dt)
#pragma unroll
            for (int s = 0; s < 2; ++s) { va[dt][s][0] = *(const s16x4_t*)(vp + (size_t)dt * 32 * POSN + 16 * s); va[dt][s][1] = *(const s16x4_t*)(vp + (size_t)dt * 32 * POSN + 16 * s + 8); }
        f32x16_t sc = {};
#pragma unroll
        for (int ks = 0; ks < 4; ++ks) sc = __builtin_amdgcn_mfma_f32_32x32x16_bf16(kf[ks], qf[ks], sc, 0, 0, 0);
        float xs[16];
        if (MODE == 0 && t >= 8) {
            const int kr = rs0 + t - 8; const bool row_ok = (kr >= rsq) && (kr < rsq + 8);
            const float* rb = P.relb + (h * 15 + (kr - qr + 7)) * 31 + (15 - qc);
#pragma unroll
            for (int r = 0; r < 16; ++r) { const int kc = c0 + crow16(r, hf); const bool ok = row_ok && (kc >= csq) && (kc < csq + 16);
                const float bias = ok ? rb[kc] : 0.f; xs[r] = ok ? (sc[r] * 0.125f + bias) * LOG2E : -1e30f; }
        } else {
#pragma unroll
            for (int r = 0; r < 16; ++r) xs[r] = (MODE == 2) ? sc[r] : sc[r] * (0.125f * LOG2E);
        }
        float tm = xs[0];
#pragma unroll
        for (int r = 1; r < 16; ++r) tm = fmaxf(tm, xs[r]);
        tm = fmaxf(tm, __shfl_xor(tm, 32));
        const float mn = fmaxf(m, tm), al = __builtin_amdgcn_exp2f(m - mn);
        float ps = 0.f;
#pragma unroll
        for (int r = 0; r < 16; ++r) { xs[r] = __builtin_amdgcn_exp2f(xs[r] - mn); ps += xs[r]; }
        l = l * al + ps; m = mn;
#pragma unroll
        for (int r = 0; r < 16; ++r) { o0[r] *= al; o1[r] *= al; }
        bf16x8_t pf[2];
#pragma unroll
        for (int s = 0; s < 2; ++s) { v4u w; w.x = cvtpk(xs[8 * s], xs[8 * s + 1]); w.y = cvtpk(xs[8 * s + 2], xs[8 * s + 3]); w.z = cvtpk(xs[8 * s + 4], xs[8 * s + 5]); w.w = cvtpk(xs[8 * s + 6], xs[8 * s + 7]);
            pf[s] = __builtin_bit_cast(bf16x8_t, w); }
#pragma unroll
        for (int s = 0; s < 2; ++s) {
            const bf16x8_t a0 = __builtin_shufflevector(va[0][s][0], va[0][s][1], 0, 1, 2, 3, 4, 5, 6, 7);
            const bf16x8_t a1 = __builtin_shufflevector(va[1][s][0], va[1][s][1], 0, 1, 2, 3, 4, 5, 6, 7);
            o0 = __builtin_amdgcn_mfma_f32_32x32x16_bf16(a0, pf[s], o0, 0, 0, 0);
            o1 = __builtin_amdgcn_mfma_f32_32x32x16_bf16(a1, pf[s], o1, 0, 0, 0);
        }
    }
    l += __shfl_xor(l, 32);
    const float rl = 1.f / l;
#pragma unroll
    for (int dt = 0; dt < 2; ++dt)
#pragma unroll
        for (int rg = 0; rg < 4; ++rg) { const int d = 32 * dt + 8 * rg + 4 * hf;
            const v2u gv = *(const v2u*)(gp + d);
            const float g0 = silu_f(bflo(gv.x)), g1 = silu_f(bfhi(gv.x)), g2 = silu_f(bflo(gv.y)), g3 = silu_f(bfhi(gv.y));
            const f32x16_t& oo = dt ? o1 : o0;
            v2u w; w.x = pk2(oo[4 * rg] * rl * g0, oo[4 * rg + 1] * rl * g1); w.y = pk2(oo[4 * rg + 2] * rl * g2, oo[4 * rg + 3] * rl * g3);
            *(v2u*)(yp + d) = w; }
}

typedef float f32x2_t __attribute__((ext_vector_type(2)));
constexpr int LRU_NCOL = 272;
struct LruP { const bf16_t* P1; const float* conv_w; const float* conv_b; const float* lam; const float* b_a; const float* b_x; const bf16_t* WT; f32x2_t* SUM16; bf16_t* YMIX; };
constexpr int LRU_WTL = 0, LRU_CWL = 36864, LRU_BAX = LRU_CWL + 1280, LRU_XW = LRU_BAX + 1536, LRU_CARRY = LRU_XW + 8 * 4160, LRU_FOLD = LRU_CARRY + 16384;

DI void lru_setup(int nb, const LruP& p, LAS unsigned char* lds, int tid) {
    __syncthreads();
    for (int e = tid; e < 256 * 8; e += NTHREADS) { const int row = e >> 3, ch = e & 7; *(LAS v4u*)(lds + LRU_WTL + row * 144 + ch * 16) = *(const v4u*)(p.WT + (size_t)(nb * 256 + row) * 64 + ch * 8); }
    LAS float* CW = (LAS float*)(lds + LRU_CWL); LAS float* BAX = (LAS float*)(lds + LRU_BAX);
    if (tid < 320) CW[tid] = tid < 256 ? p.conv_w[(tid >> 6) * 512 + nb * 64 + (tid & 63)] : p.conv_b[nb * 64 + (tid & 63)];
    if (tid < 128) { const int dir = tid >> 6, ch = tid & 63; BAX[(dir * 3 + 0) * 64 + ch] = p.b_a[dir * 512 + nb * 64 + ch]; BAX[(dir * 3 + 1) * 64 + ch] = p.b_x[dir * 512 + nb * 64 + ch];
        BAX[(dir * 3 + 2) * 64 + ch] = log1pf(__expf(-p.lam[dir * 512 + nb * 64 + ch])); }
    __syncthreads();
}

template <bool PASS2> DI void lru_micro(int b, int col, int nb, int ci, const LruP& p, LAS unsigned char* lds, int wave, int lane) {
    const int n = lane & 15, q = lane >> 4;
    const int s0 = col < 16 ? NLAT + b * LC : b * SEQ, sl = col < 16 ? LC : SEQ, t0 = col < 16 ? col * 16 : (col - 16) * 16;
    LAS float* CW = (LAS float*)(lds + LRU_CWL); LAS float* BAX = (LAS float*)(lds + LRU_BAX); LAS float* XW = (LAS float*)(lds + LRU_XW + wave * 4160);
    v4u xr[4][2];
#pragma unroll
    for (int j = 0; j < 4; ++j) { const int tt = t0 + n + j - 1; const bool ok = tt >= 0 && tt < sl;
#pragma unroll
        for (int ks = 0; ks < 2; ++ks) { xr[j][ks] = (v4u){0u, 0u, 0u, 0u}; if (ok) xr[j][ks] = *(const v4u*)(p.P1 + (size_t)(s0 + tt) * N1 + nb * 64 + 32 * ks + 8 * q); } }
    bf16x8_t af[2];
#pragma unroll
    for (int ks = 0; ks < 2; ++ks) { const int c = 32 * ks + 8 * q;
        float xc[8];
        const f32x4_t bb0 = *(const LAS f32x4_t*)(CW + 256 + c), bb1 = *(const LAS f32x4_t*)(CW + 256 + c + 4);
#pragma unroll
        for (int e = 0; e < 4; ++e) { xc[e] = bb0[e]; xc[4 + e] = bb1[e]; }
#pragma unroll
        for (int j = 0; j < 4; ++j) { const f32x4_t w0 = *(const LAS f32x4_t*)(CW + j * 64 + c), w1 = *(const LAS f32x4_t*)(CW + j * 64 + c + 4); const v4u xx = xr[j][ks];
            xc[0] += w0[0] * bflo(xx.x); xc[1] += w0[1] * bfhi(xx.x); xc[2] += w0[2] * bflo(xx.y); xc[3] += w0[3] * bfhi(xx.y);
            xc[4] += w1[0] * bflo(xx.z); xc[5] += w1[1] * bfhi(xx.z); xc[6] += w1[2] * bflo(xx.w); xc[7] += w1[3] * bfhi(xx.w); }
        v4u w; w.x = pk2(xc[0], xc[1]); w.y = pk2(xc[2], xc[3]); w.z = pk2(xc[4], xc[5]); w.w = pk2(xc[6], xc[7]); af[ks] = __builtin_bit_cast(bf16x8_t, w);
#pragma unroll
        for (int e = 0; e < 8; ++e) XW[n * 65 + c + e] = xc[e]; }
    float hsum[4][4];
#pragma unroll
    for (int c4 = 0; c4 < 4; ++c4)
#pragma unroll
        for (int r = 0; r < 4; ++r) hsum[c4][r] = 0.f;
#pragma unroll 1
    for (int dir = 0; dir < 2; ++dir) {
        f32x4_t acc[8];
#pragma unroll
        for (int nt = 0; nt < 8; ++nt) { acc[nt] = (f32x4_t){0.f, 0.f, 0.f, 0.f};
            const LAS unsigned char* wrow = lds + LRU_WTL + ((dir * 2 + (nt >> 2)) * 64 + (nt & 3) * 16 + n) * 144 + 16 * q;
#pragma unroll
            for (int ks = 0; ks < 2; ++ks) { const bf16x8_t bfr = *(const LAS bf16x8_t*)(wrow + 64 * ks); acc[nt] = __builtin_amdgcn_mfma_f32_16x16x32_bf16(af[ks], bfr, acc[nt], 0, 0, 0); } }
        float a[4][4], bt[4][4];
#pragma unroll
        for (int c4 = 0; c4 < 4; ++c4) { const int ch = c4 * 16 + n;
            const float ba = BAX[(dir * 3 + 0) * 64 + ch], bx = BAX[(dir * 3 + 1) * 64 + ch], sp = BAX[(dir * 3 + 2) * 64 + ch];
#pragma unroll
            for (int r = 0; r < 4; ++r) { const float gr = sigmoid_f(acc[c4][r] + ba), gi = sigmoid_f(acc[c4 + 4][r] + bx);
                const float log_a = -8.f * gr * sp; const float av = __builtin_amdgcn_exp2f(log_a * LOG2E); a[c4][r] = av;
                const float x2 = 2.f * log_a;
                const float ser = -x2 * (1.f + x2 * (0.5f + x2 * (0.16666667f + x2 * (0.041666668f + x2 * 0.0083333338f))));
                const float om = x2 > -0.5f ? ser : 1.f - av * av;
                bt[c4][r] = __builtin_amdgcn_sqrtf(fmaxf(om, 0.f)) * gi * XW[(4 * q + r) * 65 + ch]; } }
        float Pq[4], Sq[4];
#pragma unroll
        for (int c4 = 0; c4 < 4; ++c4) { float P = 1.f, S = 0.f;
#pragma unroll
            for (int rr = 0; rr < 4; ++rr) { const int r = dir == 0 ? rr : 3 - rr; S = a[c4][r] * S + bt[c4][r]; P *= a[c4][r]; }
            Pq[c4] = P; Sq[c4] = S; }
        float Pin[4], Sin[4];
#pragma unroll
        for (int c4 = 0; c4 < 4; ++c4) { float P = 1.f, S = 0.f, Pw = 1.f, Sw = 0.f;
#pragma unroll
            for (int kk = 0; kk < 4; ++kk) { const int k = dir == 0 ? kk : 3 - kk;
                const float pk = __shfl(Pq[c4], n + 16 * k), sk = __shfl(Sq[c4], n + 16 * k);
                const bool before = dir == 0 ? (k < q) : (k > q);
                if (before) { S = pk * S + sk; P *= pk; }
                Sw = pk * Sw + sk; Pw *= pk; }
            Pin[c4] = P; Sin[c4] = S;
            if (!PASS2 && q == 0) p.SUM16[((size_t)((b * 8 + nb) * LRU_NCOL + col) * 2 + dir) * 64 + c4 * 16 + n] = (f32x2_t){Pw, Sw}; }
        if (PASS2) {
            const LAS float* CARRYL = (const LAS float*)(lds + LRU_CARRY);
#pragma unroll
            for (int c4 = 0; c4 < 4; ++c4) { float h = CARRYL[(dir * 32 + ci) * 64 + c4 * 16 + n];
                h = Pin[c4] * h + Sin[c4];
#pragma unroll
                for (int rr = 0; rr < 4; ++rr) { const int r = dir == 0 ? rr : 3 - rr; h = a[c4][r] * h + bt[c4][r]; hsum[c4][r] += h; } }
        }
    }
    if (PASS2) {
        asm volatile("s_waitcnt lgkmcnt(0)" ::: "memory");
#pragma unroll
        for (int c4 = 0; c4 < 4; ++c4)
#pragma unroll
            for (int r = 0; r < 4; ++r) XW[(4 * q + r) * 65 + c4 * 16 + n] = hsum[c4][r];
        asm volatile("s_waitcnt lgkmcnt(0)" ::: "memory");
        const int tk = lane >> 2, cg = lane & 3; const size_t row = (size_t)(s0 + t0 + tk);
        const bf16_t* gp = p.P1 + row * N1 + 512 + nb * 64 + cg * 16;
        const v4u g0 = *(const v4u*)gp, g1 = *(const v4u*)(gp + 8);
        float y[16];
#pragma unroll
        for (int e = 0; e < 16; ++e) y[e] = XW[tk * 65 + cg * 16 + e];
        v4u o0, o1;
        o0.x = pk2(y[0] * silu_f(bflo(g0.x)), y[1] * silu_f(bfhi(g0.x))); o0.y = pk2(y[2] * silu_f(bflo(g0.y)), y[3] * silu_f(bfhi(g0.y)));
        o0.z = pk2(y[4] * silu_f(bflo(g0.z)), y[5] * silu_f(bfhi(g0.z))); o0.w = pk2(y[6] * silu_f(bflo(g0.w)), y[7] * silu_f(bfhi(g0.w)));
        o1.x = pk2(y[8] * silu_f(bflo(g1.x)), y[9] * silu_f(bfhi(g1.x))); o1.y = pk2(y[10] * silu_f(bflo(g1.y)), y[11] * silu_f(bfhi(g1.y)));
        o1.z = pk2(y[12] * silu_f(bflo(g1.z)), y[13] * silu_f(bfhi(g1.z))); o1.w = pk2(y[14] * silu_f(bflo(g1.w)), y[15] * silu_f(bfhi(g1.w)));
        bf16_t* yp = p.YMIX + row * DM + nb * 64 + cg * 16;
        *(v4u*)yp = o0; *(v4u*)(yp + 8) = o1;
    }
    asm volatile("s_waitcnt lgkmcnt(0)" ::: "memory");
}

DI int lru_order_col(int dir, int k) { return dir == 0 ? k : (k < 16 ? 15 - k : 16 + (271 - k)); }

DI void lru_block(int blk, bool pass2, const LruP& p, LAS unsigned char* lds, int tid, int wave, int lane) {
    const int nb = blk & 7, b = (blk >> 3) & 3, cr = blk >> 5;
    lru_setup(nb, p, lds, tid);
    if (!pass2) {
        for (int i = wave; i < 34; i += NWAVES) { const int col = i < 32 ? 16 + 32 * cr + i : 2 * cr + (i - 32); lru_micro<false>(b, col, nb, 0, p, lds, wave, lane); }
        return;
    }
    LAS float* CARRYL = (LAS float*)(lds + LRU_CARRY); LAS f32x2_t* FOLD = (LAS f32x2_t*)(lds + LRU_FOLD);
    const int chain = tid & 127, part = tid >> 7, dir = chain >> 6, ch = chain & 63;
    const f32x2_t* SB = p.SUM16 + (size_t)(b * 8 + nb) * LRU_NCOL * 128 + dir * 64 + ch;
    const int kfirst = dir == 0 ? 16 + 32 * cr : 240 - 32 * cr;
    { const int k0 = (kfirst * part) >> 2, k1 = (kfirst * (part + 1)) >> 2;
      float P = 1.f, S = 0.f;
#pragma unroll 4
      for (int k = k0; k < k1; ++k) { const f32x2_t s = SB[(size_t)lru_order_col(dir, k) * 128]; S = s[0] * S + s[1]; P *= s[0]; }
      FOLD[part * 128 + chain] = (f32x2_t){P, S}; }
    __syncthreads();
    if (part == 0) { float S = 0.f;
#pragma unroll
        for (int pp = 0; pp < 4; ++pp) { const f32x2_t s = FOLD[pp * 128 + chain]; S = s[0] * S + s[1]; }
        for (int i = 0; i < 32; ++i) { const int col = lru_order_col(dir, kfirst + i), ci = col - (16 + 32 * cr);
            CARRYL[(dir * 32 + ci) * 64 + ch] = S; const f32x2_t s = SB[(size_t)col * 128]; S = s[0] * S + s[1]; } }
    __syncthreads();
    for (int i = wave; i < 32; i += NWAVES) lru_micro<true>(b, 16 + 32 * cr + i, nb, i, p, lds, wave, lane);
}

DI float row16_sum(float v) {
    v += __builtin_bit_cast(float, __builtin_amdgcn_update_dpp(0, __builtin_bit_cast(int, v), 0xB1, 0xf, 0xf, false));
    v += __builtin_bit_cast(float, __builtin_amdgcn_update_dpp(0, __builtin_bit_cast(int, v), 0x4E, 0xf, 0xf, false));
    v += __builtin_bit_cast(float, __builtin_amdgcn_update_dpp(0, __builtin_bit_cast(int, v), 0x141, 0xf, 0xf, false));
    v += __builtin_bit_cast(float, __builtin_amdgcn_update_dpp(0, __builtin_bit_cast(int, v), 0x140, 0xf, 0xf, false));
    return v;
}
DI void qkprep_row(int r, const bf16_t* P1, const float* qn, const float* kn, const float* ROPE, bf16_t* QP, bf16_t* KP, int lane) {
    const int b = row_batch(r); const bool lat = r < NLAT; const int t = r & 4095, l16 = lane & 15, hh = lane >> 4;
    f32x4_t cs = {1.f, 0.f, 1.f, 0.f};
    if (lat) cs = *(const f32x4_t*)(ROPE + ((size_t)t * 32 + 2 * l16) * 2);
    const f32x4_t wq = *(const f32x4_t*)(qn + 4 * l16), wk = *(const f32x4_t*)(kn + 4 * l16);
#pragma unroll
    for (int hg = 0; hg < 3; ++hg) {
        if (hg < 2 && !lat) continue;
        const int slot = hg < 2 ? hg * 4 + hh : 8 + (hh & 1);
        const int col0 = slot < 8 ? 1024 + slot * 64 : 1536 + (slot - 8) * 64;
        const v2u xx = *(const v2u*)(P1 + (size_t)r * N1 + col0 + 4 * l16);
        float x[4] = {bflo(xx.x), bfhi(xx.x), bflo(xx.y), bfhi(xx.y)};
        const float ss = row16_sum(x[0] * x[0] + x[1] * x[1] + x[2] * x[2] + x[3] * x[3]);
        const float rinv = rsqrtf(ss * (1.f / 64.f) + EPSN);
        const f32x4_t w = hg < 2 ? wq : wk;
#pragma unroll
        for (int e = 0; e < 4; ++e) x[e] *= rinv * w[e];
        const float y0 = x[0] * cs[0] - x[1] * cs[1], y1 = x[0] * cs[1] + x[1] * cs[0], y2 = x[2] * cs[2] - x[3] * cs[3], y3 = x[2] * cs[3] + x[3] * cs[2];
        if (hg < 2) { const float sc = 0.125f * LOG2E; v2u o; o.x = pk2(y0 * sc, y1 * sc); o.y = pk2(y2 * sc, y3 * sc); *(v2u*)(QP + ((size_t)(b * 8 + slot) * SEQ + t) * 64 + 4 * l16) = o; }
        else if (hh < 2) { v2u o; o.x = pk2(y0, y1); o.y = pk2(y2, y3); *(v2u*)(KP + ((size_t)(b * 2 + (slot - 8)) * POSN + row_pos(r)) * 64 + 4 * l16) = o; }
    }
}

constexpr size_t WS_CARRY0 = 246 * MiB;
constexpr int S5_NCOL = 272;

DI void s5_lambar_pow(double lre, double lim, double dt, int e, double& pr, double& pi) { const double mag = exp(lre * dt * e), ang = lim * dt * e; pr = mag * cos(ang); pi = mag * sin(ang); }
typedef double f64x2_t __attribute__((ext_vector_type(2)));
DI void s5_tables_block(int item, const float* lam_re, const float* lam_im, const float* log_dt, const float* b_re, const float* b_im, const float* c_re, const float* c_im,
                        bf16_t* W16, bf16_t* WC, bf16_t* KT, float* L16, LAS unsigned char* lds, int tid) {
    const int part = item & 3, gd = item >> 2, g = gd >> 1, dir = gd & 1, gi = dir * 32 + g;
    LAS f64x2_t* POW = (LAS f64x2_t*)lds;
    LAS f64x2_t* PC = POW + 17 * 64;
    __syncthreads();
    if (tid < 64) { const int p = tid;
        const double dt = exp((double)log_dt[gi]), lre = lam_re[gi * 64 + p], lim = lam_im[gi * 64 + p];
        double l1r, l1i; s5_lambar_pow(lre, lim, dt, 1, l1r, l1i);
        const double nr = l1r - 1.0, ni = l1i, den = lre * lre + lim * lim, cfr = (nr * lre + ni * lim) / den, cfi = (ni * lre - nr * lim) / den;
        double pr = 1.0, pi = 0.0;
        for (int e = 0; e <= 16; ++e) { POW[e * 64 + p] = (f64x2_t){pr, pi}; PC[e * 64 + p] = (f64x2_t){pr * cfr - pi * cfi, pr * cfi + pi * cfr};
            if (e == 16 && part == 0) { L16[((g * 2 + dir) * 64 + p) * 2] = (float)pr; L16[((g * 2 + dir) * 64 + p) * 2 + 1] = (float)pi; }
            const double tr = pr * l1r - pi * l1i, ti = pr * l1i + pi * l1r; pr = tr; pi = ti; } }
    __syncthreads();
    for (int idx = tid; idx < 32 * 256; idx += NTHREADS) { const int row = 32 * part + (idx >> 8), k = idx & 255, p = row >> 1, c = row & 1, tp = k >> 4, hi = k & 15;
        const f64x2_t z = PC[(dir == 0 ? 15 - tp : tp) * 64 + p]; const double br = b_re[(gi * 64 + p) * 16 + hi], bi = b_im[(gi * 64 + p) * 16 + hi];
        W16[(size_t)(gd * 128 + row) * 256 + k] = f2bf((float)(c == 0 ? z[0] * br - z[1] * bi : z[0] * bi + z[1] * br)); }
    for (int idx = tid; idx < 64 * 128; idx += NTHREADS) { const int row = 64 * part + (idx >> 7), k = idx & 127, p = k >> 1, c = k & 1, t = row >> 4, ho = row & 15;
        const f64x2_t z = POW[((dir == 0 ? t : 15 - t) + 1) * 64 + p]; const double cr = c_re[(gi * 16 + ho) * 64 + p], ci = c_im[(gi * 16 + ho) * 64 + p];
        WC[(size_t)(gd * 256 + row) * 128 + k] = f2bf((float)(c == 0 ? cr * z[0] - ci * z[1] : -(cr * z[1] + ci * z[0]))); }
    for (int idx = tid; idx < 1024; idx += NTHREADS) { const int e = 1024 * part + idx, tau = e >> 8, ho = (e >> 4) & 15, hi = e & 15;
        double acc = 0.0;
#pragma unroll 4
        for (int p = 0; p < 64; ++p) { const f64x2_t z = PC[tau * 64 + p]; const double cr = c_re[(gi * 16 + ho) * 64 + p], ci = c_im[(gi * 16 + ho) * 64 + p];
            const double ar = cr * z[0] - ci * z[1], ai = cr * z[1] + ci * z[0];
            acc += ar * (double)b_re[(gi * 64 + p) * 16 + hi] - ai * (double)b_im[(gi * 64 + p) * 16 + hi]; }
        KT[(size_t)gd * 4096 + e] = f2bf((float)acc); }
}

DI int s5_tile_row0(int b, int s) { return s == 0 ? NLAT + b * LC : b * SEQ + (s - 1) * 256; }
DI void cmul(float ar, float ai, float br, float bi, float& cr, float& ci) { cr = ar * br - ai * bi; ci = ar * bi + ai * br; }

DI void s5_scan_unit(int cu, int m, const bf16_t* UG, const bf16_t* W16, const float* L16, bf16_t* CARRY0, bf16_t* CARRY1, int lane) {
    const int dir = cu & 1, b = (cu >> 1) & 3, g = cu >> 3;
    const int n = lane & 15, q = lane >> 4;
    bf16x8_t wf[8];
#pragma unroll
    for (int ks = 0; ks < 8; ++ks) wf[ks] = *(const bf16x8_t*)(W16 + ((size_t)(g * 2 + dir) * 128 + m * 16 + n) * 256 + 32 * ks + 8 * q);
    float Lr[2][5], Li[2][5];
    float Lnr[2], Lni[2];
    float cr[2], ci[2];
#pragma unroll
    for (int st = 0; st < 2; ++st) { const int p = 8 * m + 2 * q + st;
        Lr[st][0] = L16[((g * 2 + dir) * 64 + p) * 2]; Li[st][0] = L16[((g * 2 + dir) * 64 + p) * 2 + 1];
#pragma unroll
        for (int k = 1; k < 5; ++k) cmul(Lr[st][k - 1], Li[st][k - 1], Lr[st][k - 1], Li[st][k - 1], Lr[st][k], Li[st][k]);
        float rr = 1.f, ri = 0.f;
#pragma unroll
        for (int k = 0; k < 5; ++k) if ((n + 1) & (1 << k)) { float tr, ti; cmul(rr, ri, Lr[st][k], Li[st][k], tr, ti); rr = tr; ri = ti; }
        Lnr[st] = rr; Lni[st] = ri; cr[st] = 0.f; ci[st] = 0.f; }
    bf16_t* CARRY = (dir == 0 ? CARRY0 : CARRY1) + (size_t)(b * 32 + g) * S5_NCOL * 128;
    const int jcol = dir == 0 ? n : 15 - n;
    bf16x8_t un[8];
    { const bf16_t* ub = UG + ((size_t)g * MROWS + s5_tile_row0(b, 0) + jcol * 16 + (q >> 1)) * 16 + 8 * (q & 1);
#pragma unroll
      for (int ks = 0; ks < 8; ++ks) un[ks] = *(const bf16x8_t*)(ub + (2 * ks) * 16); }
#pragma unroll 1
    for (int it = 0; it < 17; ++it) {
        const int s = it == 0 ? 0 : (dir == 0 ? it : 17 - it);
        bf16x8_t uf[8];
#pragma unroll
        for (int ks = 0; ks < 8; ++ks) uf[ks] = un[ks];
        if (it + 1 < 17) { const int sn = dir == 0 ? it + 1 : 16 - it;
            const bf16_t* ub = UG + ((size_t)g * MROWS + s5_tile_row0(b, sn) + jcol * 16 + (q >> 1)) * 16 + 8 * (q & 1);
#pragma unroll
            for (int ks = 0; ks < 8; ++ks) un[ks] = *(const bf16x8_t*)(ub + (2 * ks) * 16); }
        f32x4_t acc = {0.f, 0.f, 0.f, 0.f};
#pragma unroll
        for (int ks = 0; ks < 8; ++ks) acc = __builtin_amdgcn_mfma_f32_16x16x32_bf16(wf[ks], uf[ks], acc, 0, 0, 0);
        float hin[4];
#pragma unroll
        for (int st = 0; st < 2; ++st) {
            float xr = acc[2 * st], xi = acc[2 * st + 1];
#pragma unroll
            for (int k = 0; k < 4; ++k) { const int d = 1 << k; const float yr = __shfl_up(xr, d, 16), yi = __shfl_up(xi, d, 16);
                if (n >= d) { float tr, ti; cmul(Lr[st][k], Li[st][k], yr, yi, tr, ti); xr += tr; xi += ti; } }
            float tr, ti; cmul(Lnr[st], Lni[st], cr[st], ci[st], tr, ti);
            const float Hr = xr + tr, Hi = xi + ti;
            const float pr = __shfl_up(Hr, 1, 16), pi = __shfl_up(Hi, 1, 16);
            hin[2 * st] = n == 0 ? cr[st] : pr; hin[2 * st + 1] = n == 0 ? ci[st] : pi;
            cr[st] = __shfl(Hr, (lane & 48) | 15); ci[st] = __shfl(Hi, (lane & 48) | 15);
        }
        v2u w; w.x = pk2(hin[0], hin[1]); w.y = pk2(hin[2], hin[3]);
        *(v2u*)(CARRY + (size_t)(s * 16 + jcol) * 128 + m * 16 + 4 * q) = w;
    }
}

DI void s5_out_item(int g, int b, int s, const bf16_t* UG, const bf16_t* WC, const bf16_t* CARRY0, const bf16_t* CARRY1, const float* dsk, bf16_t* YPRE, LAS unsigned char* lds, int wave, int lane) {
    const int n = lane & 15, q = lane >> 4;
    const int row0 = s5_tile_row0(b, s);
    const bf16_t* ub = UG + ((size_t)g * MROWS + row0 + n * 16 + (q >> 1)) * 16 + 8 * (q & 1);
    bf16x8_t uf[8];
#pragma unroll
    for (int ks = 0; ks < 8; ++ks) uf[ks] = *(const bf16x8_t*)(ub + (2 * ks) * 16);
    bf16x8_t cf[2][4];
#pragma unroll
    for (int dir = 0; dir < 2; ++dir)
#pragma unroll
        for (int ks = 0; ks < 4; ++ks) cf[dir][ks] = *(const bf16x8_t*)((dir == 0 ? CARRY0 : CARRY1) + ((size_t)(b * 32 + g) * S5_NCOL + s * 16 + n) * 128 + 32 * ks + 8 * q);
    const LAS bf16_t* KTl = (const LAS bf16_t*)lds;
#pragma unroll
    for (int m2 = 0; m2 < 2; ++m2) {
        const int mt = 2 * wave + m2;
        f32x4_t acc = {0.f, 0.f, 0.f, 0.f};
#pragma unroll
        for (int dir = 0; dir < 2; ++dir) {
            const bf16_t* wc = WC + ((size_t)(g * 2 + dir) * 256 + mt * 16 + n) * 128 + 8 * q;
#pragma unroll
            for (int ks = 0; ks < 4; ++ks) { const bf16x8_t a = *(const bf16x8_t*)(wc + 32 * ks); acc = __builtin_amdgcn_mfma_f32_16x16x32_bf16(a, cf[dir][ks], acc, 0, 0, 0); }
#pragma unroll
            for (int ks = 0; ks < 8; ++ks) {
                const bool need = dir == 0 ? (2 * ks <= mt) : (2 * ks + 1 >= mt);
                if (need) { const int tp = 2 * ks + (q >> 1), tau = dir == 0 ? mt - tp : tp - mt;
                    bf16x8_t a = {0, 0, 0, 0, 0, 0, 0, 0};
                    if (tau >= 0) a = *(const LAS bf16x8_t*)(KTl + ((dir * 16 + tau) * 16 + n) * 16 + 8 * (q & 1));
                    acc = __builtin_amdgcn_mfma_f32_16x16x32_bf16(a, uf[ks], acc, 0, 0, 0); }
            }
        }
        const size_t tok = (size_t)(row0 + n * 16 + mt);
        const v2u uu = *(const v2u*)(UG + ((size_t)g * MROWS + tok) * 16 + 4 * q);
        const f32x4_t dd = *(const f32x4_t*)(dsk + g * 16 + 4 * q);
        const float y0 = gelu_fast(acc[0] + dd[0] * bflo(uu.x)), y1 = gelu_fast(acc[1] + dd[1] * bfhi(uu.x)), y2 = gelu_fast(acc[2] + dd[2] * bflo(uu.y)), y3 = gelu_fast(acc[3] + dd[3] * bfhi(uu.y));
        v2u w; w.x = pk2(y0, y1); w.y = pk2(y2, y3);
        *(v2u*)(YPRE + ((size_t)g * MROWS + tok) * 16 + 4 * q) = w;
    }
}

#include <hip/hip_bf16.h>
namespace gqa_body {
using bf16=__hip_bfloat16;
using bf16x8=__attribute__((ext_vector_type(8)))short;
using s16x4=__attribute__((ext_vector_type(4)))short;
using f32x16=__attribute__((ext_vector_type(16)))float;
using u32x4=__attribute__((ext_vector_type(4)))unsigned;
constexpr int NHEAD=8,SEQQ=4096,SKV=4352,D=64,QPITCH=64,KPITCH=64,VPITCH=64,OPITCH=1024,GPITCH=2304;
constexpr int NW=8,QBLK=32,QB=QBLK*NW,KVBLK=64,NQB=SEQQ/QB,NTILES=SKV/KVBLK;
constexpr int ATTN_UNIT_ROWS=QB;
__device__ __forceinline__ int crow(int r,int hi){return (r&3)+8*(r>>2)+4*hi;}
#define SBAR() __builtin_amdgcn_sched_barrier(0)
constexpr int NSLOT=3, SLOTB=8192;
constexpr int LDS_K=0, LDS_V=NSLOT*SLOTB, LDS_WS=2*NSLOT*SLOTB, LDS_OST=LDS_WS+NW*64*4, LDS_BYTES=LDS_OST+NW*4096;
constexpr float C2=0.125f*1.4426950408889634f;
__device__ __forceinline__ void glds16(const void*gsrc,unsigned lds_dst){unsigned keep;
  asm volatile("s_mov_b32 %0, m0\n\ts_mov_b32 m0, %2\n\ts_nop 0\n\tglobal_load_lds_dwordx4 %1, off\n\ts_mov_b32 m0, %0":"=&s"(keep):"v"(gsrc),"s"(lds_dst):"memory");}
__device__ __forceinline__ float max3f(float a,float b,float c){float r;asm("v_max3_f32 %0, %1, %2, %3":"=v"(r):"v"(a),"v"(b),"v"(c));return r;}
__device__ __forceinline__ float max2f(float a,float b){float r;asm("v_max_f32_e32 %0, %1, %2":"=v"(r):"v"(a),"v"(b));return r;}
__device__ __forceinline__ float fadd_s(float a,float b){float r;asm("v_add_f32_e32 %0, %1, %2":"=v"(r):"v"(a),"v"(b));return r;}
__device__ __forceinline__ float fsub_s(float a,float b){float r;asm("v_sub_f32_e32 %0, %1, %2":"=v"(r):"v"(a),"v"(b));return r;}
typedef float f32x2_t __attribute__((ext_vector_type(2))); typedef __bf16 bf16x2_t __attribute__((ext_vector_type(2)));
__device__ __forceinline__ unsigned cvtpk_s(float lo,float hi){f32x2_t v={lo,hi};bf16x2_t b=__builtin_convertvector(v,bf16x2_t);return __builtin_bit_cast(unsigned,b);}
#define WAIT_BAR(N) asm volatile("s_waitcnt vmcnt(" #N ") lgkmcnt(0)\n\ts_barrier":::"memory")

__device__ __forceinline__ void qkt(f32x16&p0,f32x16&p1,const char*Kslot,const bf16x8*qr,const f32x16&negm,int r32,int hi){
  const char*kb=Kslot+hi*1024+r32*16;
  #pragma unroll
  for(int d0=0;d0<4;++d0){
    const bf16x8 b0=*reinterpret_cast<const bf16x8*>(kb+d0*2048);
    const bf16x8 b1=*reinterpret_cast<const bf16x8*>(kb+d0*2048+512);
    if(d0==0){p0=__builtin_amdgcn_mfma_f32_32x32x16_bf16(b0,qr[0],negm,0,0,0);p1=__builtin_amdgcn_mfma_f32_32x32x16_bf16(b1,qr[0],negm,0,0,0);}
    else{p0=__builtin_amdgcn_mfma_f32_32x32x16_bf16(b0,qr[d0],p0,0,0,0);p1=__builtin_amdgcn_mfma_f32_32x32x16_bf16(b1,qr[d0],p1,0,0,0);}}
}
typedef __attribute__((address_space(3))) const char* lds_cptr;
typedef short v4i16_t __attribute__((ext_vector_type(4)));
__device__ __forceinline__ void kload8(bf16x8*kf,lds_cptr kp){
  kf[0]=*(const __attribute__((address_space(3))) bf16x8*)(kp);      kf[1]=*(const __attribute__((address_space(3))) bf16x8*)(kp+512);
  kf[2]=*(const __attribute__((address_space(3))) bf16x8*)(kp+2048); kf[3]=*(const __attribute__((address_space(3))) bf16x8*)(kp+2560);
  kf[4]=*(const __attribute__((address_space(3))) bf16x8*)(kp+4096); kf[5]=*(const __attribute__((address_space(3))) bf16x8*)(kp+4608);
  kf[6]=*(const __attribute__((address_space(3))) bf16x8*)(kp+6144); kf[7]=*(const __attribute__((address_space(3))) bf16x8*)(kp+6656);
}
__device__ __forceinline__ void kload2(bf16x8*kf,lds_cptr kp,int j){ kf[2*j]=*(const __attribute__((address_space(3))) bf16x8*)(kp+j*2048); kf[2*j+1]=*(const __attribute__((address_space(3))) bf16x8*)(kp+j*2048+512); }
__device__ __forceinline__ s16x4 vtr(lds_cptr p){ return __builtin_bit_cast(s16x4,__builtin_amdgcn_ds_read_tr16_b64_v4i16((__attribute__((address_space(3))) v4i16_t*)p)); }
__device__ __forceinline__ float rowmax(const f32x16&p0,const f32x16&p1){
  float a=max3f(p0[0],p0[1],p1[0]),b=max3f(p0[2],p0[3],p1[1]);a=max3f(a,p1[2],p1[3]);
  #pragma unroll
  for(int r=4;r<16;r+=4){a=max3f(a,p0[r],p0[r+1]);b=max3f(b,p0[r+2],p0[r+3]);a=max3f(a,p1[r],p1[r+1]);b=max3f(b,p1[r+2],p1[r+3]);}
  const float m=max2f(a,b);
  auto rr=__builtin_amdgcn_permlane32_swap(__float_as_uint(m),__float_as_uint(m),false,false);
  return max2f(__uint_as_float(rr[0]),__uint_as_float(rr[1]));
}
__device__ __forceinline__ void pv(f32x16*o,int vb,bf16x8 pa0,bf16x8 pa1,bf16x8 pa2,bf16x8 pa3){
  #pragma unroll
  for(int d0=0;d0<2;++d0){s16x4 lo[4],hi[4];
    #pragma unroll
    for(int ks=0;ks<4;++ks){
      asm volatile("ds_read_b64_tr_b16 %0,%1 offset:%c2":"=&v"(lo[ks]):"v"(vb),"i"(d0*4096+ks*1024):"memory");
      asm volatile("ds_read_b64_tr_b16 %0,%1 offset:%c2":"=&v"(hi[ks]):"v"(vb),"i"(d0*4096+ks*1024+512):"memory");}
    asm volatile("s_waitcnt lgkmcnt(0)":::"memory");SBAR();
    #define PK(k) (bf16x8){lo[k][0],lo[k][1],lo[k][2],lo[k][3],hi[k][0],hi[k][1],hi[k][2],hi[k][3]}
    o[d0]=__builtin_amdgcn_mfma_f32_32x32x16_bf16(pa0,PK(0),o[d0],0,0,0);
    o[d0]=__builtin_amdgcn_mfma_f32_32x32x16_bf16(pa1,PK(1),o[d0],0,0,0);
    o[d0]=__builtin_amdgcn_mfma_f32_32x32x16_bf16(pa2,PK(2),o[d0],0,0,0);
    o[d0]=__builtin_amdgcn_mfma_f32_32x32x16_bf16(pa3,PK(3),o[d0],0,0,0);
    #undef PK
  }
}

#ifndef ATTN_STORE16
#define ATTN_STORE16(p,v) (*(u32x4*)(p)=(v))
#endif
template<int THRL> __device__ __forceinline__ void attn_unit(int b,int h,int qb,const bf16*Q,const bf16*__restrict__ K,const bf16*__restrict__ V,bf16*O,const bf16*Gt,char*shm){
  const int tid=threadIdx.x,lane=tid&63,r32=lane&31,hi=lane>>5; const int wid=__builtin_amdgcn_readfirstlane(tid>>6);
  const int q0=qb*QB;
  const bf16*Qw=Q+((long)(b*NHEAD+h)*SEQQ+q0+wid*QBLK)*QPITCH;
  const bf16*Kh=K+(long)(b*2+(h>>2))*SKV*KPITCH,*Vh=V+(long)(b*2+(h>>2))*SKV*VPITCH;
  const unsigned lds0=(unsigned)(uintptr_t)shm;
  float*wsf=(float*)(shm+LDS_WS)+wid*64;
  const bf16*ksrc=Kh+(long)lane*KPITCH+wid*8;
  const bf16*vsrc=Vh+(long)(16*(wid&3)+(lane>>2))*VPITCH+(wid>>2)*32+(lane&3)*8;
  const unsigned kdst=lds0+LDS_K+wid*1024, vdst=lds0+LDS_V+wid*1024;
  #define DMA_K(t,slot) glds16(ksrc+(long)(t)*KVBLK*KPITCH,(unsigned)__builtin_amdgcn_readfirstlane(kdst+(slot)))
  #define DMA_V(t,slot) glds16(vsrc+(long)(t)*KVBLK*VPITCH,(unsigned)__builtin_amdgcn_readfirstlane(vdst+(slot)))
  const int vb0=(int)(lds0+LDS_V)+((lane>>4)&1)*32+(lane&3)*8+(4*hi+((lane&15)>>2))*64;
  const char*Kbase=shm+LDS_K; bf16x8 kf[8];
  const lds_cptr shm3=(lds_cptr)shm; const lds_cptr kp0=shm3+LDS_K+hi*1024+r32*16; const lds_cptr vp0=shm3+LDS_V+((lane>>4)&1)*32+(lane&3)*8+(4*hi+((lane&15)>>2))*64;
  constexpr int NT=NTILES;
  DMA_K(0,0);DMA_V(0,0);DMA_K(1,SLOTB);
  bf16x8 qr[4];
  #pragma unroll
  for(int d0=0;d0<4;++d0)qr[d0]=*reinterpret_cast<const bf16x8*>(&Qw[(long)r32*QPITCH+d0*16+hi*8]);
  float mhat=0.f,l_reg=0.f;f32x16 o[2];o[0]=f32x16{};o[1]=f32x16{};f32x16 negm=f32x16{};asm volatile("":"+v"(negm));
  #define CMASK(P0,P1,t) do{}while(0)
  bool resc=false;
  #define START(P0,P1) do{ const float rm=rowmax(P0,P1); resc=false; \
    { const float dl=rm; mhat=fadd_s(mhat,dl); \
      _Pragma("unroll") for(int r=0;r<16;++r){P0[r]=fsub_s(P0[r],dl);P1[r]=fsub_s(P1[r],dl);} \
      _Pragma("unroll") for(int r=0;r<16;++r)negm[r]=-mhat; asm volatile("":"+v"(negm)); } \
    _Pragma("unroll") for(int r=0;r<16;++r)P0[r]=__builtin_amdgcn_exp2f(P0[r]); }while(0)
  #define RESC() do{ if(resc){ asm volatile("s_waitcnt lgkmcnt(0)":::"memory"); \
      _Pragma("unroll") for(int d_=0;d_<2;++d_) _Pragma("unroll") for(int r=0;r<16;++r)o[d_][r]*=wsf[crow(r,hi)]; } }while(0)
  f32x16 pA0,pA1,pB0,pB1;
  int sl_prev=0,sl_cur=0,sl_next=SLOTB;
  #define ROT() do{sl_prev=sl_cur;sl_cur=sl_next;sl_next=(sl_next==(NSLOT-1)*SLOTB)?0:sl_next+SLOTB;}while(0)
  DMA_K(2,2*SLOTB);
  WAIT_BAR(3);
  qkt(pA0,pA1,Kbase,qr,negm,r32,hi);asm volatile("s_nop 15\n\ts_nop 7":"+v"(pA0),"+v"(pA1));CMASK(pA0,pA1,0);
  START(pA0,pA1);
  _Pragma("unroll") for(int r=0;r<16;++r)pA1[r]=__builtin_amdgcn_exp2f(pA1[r]);
  WAIT_BAR(0);
  DMA_K(3,0);DMA_V(1,SLOTB);
  ROT();
  kload8(kf,kp0+sl_cur);
  WAIT_BAR(2);
  s16x4 vlo[8],vhi[8]; u32x4 pw0,pw1,pw2,pw3;
  #define PKW(P,B) cvtpk_s(P[B],P[B+1])
  #define PAF(k) __builtin_bit_cast(bf16x8,pw##k)
  #define VFR(i) (bf16x8){vlo[i][0],vlo[i][1],vlo[i][2],vlo[i][3],vhi[i][0],vhi[i][1],vhi[i][2],vhi[i][3]}
  #define PIN(x) asm volatile("":"+v"(x))
  #define MX3(a,b,c) __builtin_fmaxf(__builtin_fmaxf((a),(b)),(c))
  #define GAPA(MF,A0,A1,A2,A3,W0,W1,PW) do{ MF; sacc+=A0; sacc+=A1; sacc+=A2; sacc+=A3; PIN(sacc); W0; W1; PIN(PW); SBAR(); }while(0)
  #define EX(v) __builtin_amdgcn_exp2f(v)
  #define GAPB(MF,X,B) do{ MF; X[B]=EX(X[B]); X[B+1]=EX(X[B+1]); X[B+2]=EX(X[B+2]); X[B+3]=EX(X[B+3]); PIN(X); SBAR(); }while(0)
  #define VRD(i) do{ vlo[i]=vtr(vp_+(((i)>>2)*4096+((i)&3)*1024)); vhi[i]=vtr(vp_+(((i)>>2)*4096+((i)&3)*1024+512)); }while(0)
  #define KRD(G,j) do{ if(G){ kload2(kf,kp0+sl_next,j); SBAR(); } }while(0)
  #define STEP(C0,C1,P0,P1,t,GK,GV,GL) do{ SBAR(); \
    const lds_cptr vp_=vp0+sl_prev; \
    VRD(0); SBAR(); float sacc=(P0[0]+P0[1]); \
    GAPA(C0=__builtin_amdgcn_mfma_f32_32x32x16_bf16(kf[0],qr[0],negm,0,0,0), P0[2],P0[3],P0[4],P0[5],     pw0[0]=PKW(P0,0), pw0[1]=PKW(P0,2), pw0); \
    VRD(4); SBAR(); GAPA(C1=__builtin_amdgcn_mfma_f32_32x32x16_bf16(kf[1],qr[0],negm,0,0,0), P0[6],P0[7],P0[8],P0[9],     pw0[2]=PKW(P0,4), pw0[3]=PKW(P0,6), pw0); \
    VRD(1); SBAR(); GAPA(C0=__builtin_amdgcn_mfma_f32_32x32x16_bf16(kf[2],qr[1],C0,0,0,0),   P0[10],P0[11],P0[12],P0[13], pw1[0]=PKW(P0,8), pw1[1]=PKW(P0,10), pw1); \
    VRD(5); SBAR(); GAPA(C1=__builtin_amdgcn_mfma_f32_32x32x16_bf16(kf[3],qr[1],C1,0,0,0),   P0[14],P0[15],P1[0],P1[1],   pw1[2]=PKW(P0,12),pw1[3]=PKW(P0,14), pw1); \
    VRD(2); SBAR(); GAPA(C0=__builtin_amdgcn_mfma_f32_32x32x16_bf16(kf[4],qr[2],C0,0,0,0),   P1[2],P1[3],P1[4],P1[5],     pw2[0]=PKW(P1,0), pw2[1]=PKW(P1,2), pw2); \
    VRD(6); SBAR(); GAPA(C1=__builtin_amdgcn_mfma_f32_32x32x16_bf16(kf[5],qr[2],C1,0,0,0),   P1[6],P1[7],P1[8],P1[9],     pw2[2]=PKW(P1,4), pw2[3]=PKW(P1,6), pw2); \
    VRD(3); SBAR(); GAPA(C0=__builtin_amdgcn_mfma_f32_32x32x16_bf16(kf[6],qr[3],C0,0,0,0),   P1[10],P1[11],P1[12],P1[13], pw3[0]=PKW(P1,8), pw3[1]=PKW(P1,10), pw3); \
    VRD(7); SBAR(); GAPA(C1=__builtin_amdgcn_mfma_f32_32x32x16_bf16(kf[7],qr[3],C1,0,0,0),   P1[14],P1[15],0.f,0.f,       pw3[2]=PKW(P1,12),pw3[3]=PKW(P1,14), pw3); \
    l_reg+=sacc; \
    if(GK){DMA_K((t)+3,sl_cur);} if(GV){DMA_V((t)+1,sl_next);} \
    CMASK(C0,C1,t); \
    { float a=MX3(C0[0],C0[1],C1[0]),b=MX3(C0[2],C0[3],C1[1]); a=MX3(a,C1[2],C1[3]); \
      _Pragma("unroll") for(int r=4;r<16;r+=4){a=MX3(a,C0[r],C0[r+1]);b=MX3(b,C0[r+2],C0[r+3]);a=MX3(a,C1[r],C1[r+1]);b=MX3(b,C1[r+2],C1[r+3]);} \
      float rm=__builtin_fmaxf(a,b); { auto rr=__builtin_amdgcn_permlane32_swap(__float_as_uint(rm),__float_as_uint(rm),false,false); rm=__builtin_fmaxf(__uint_as_float(rr[0]),__uint_as_float(rr[1])); } \
      resc=false; \
      if(__builtin_expect(__any(rm>(float)THRL),0)){ const float dl=__builtin_fmaxf(rm,0.f); mhat+=dl; \
        _Pragma("unroll") for(int r=0;r<16;++r){C0[r]-=dl;C1[r]-=dl;} \
        _Pragma("unroll") for(int r=0;r<16;++r)negm[r]=-mhat; asm volatile("":"+v"(negm)); \
        const float f=__builtin_amdgcn_exp2f(-dl); l_reg*=f; if(hi==0)wsf[r32]=f; resc=true; } } \
    SBAR(); \
    GAPB(o[0]=__builtin_amdgcn_mfma_f32_32x32x16_bf16(PAF(0),VFR(0),o[0],0,0,0), C0,0); \
    GAPB(o[1]=__builtin_amdgcn_mfma_f32_32x32x16_bf16(PAF(0),VFR(4),o[1],0,0,0), C0,4); \
    KRD(GL,0); GAPB(o[0]=__builtin_amdgcn_mfma_f32_32x32x16_bf16(PAF(1),VFR(1),o[0],0,0,0), C0,8); \
    KRD(GL,1); GAPB(o[1]=__builtin_amdgcn_mfma_f32_32x32x16_bf16(PAF(1),VFR(5),o[1],0,0,0), C0,12); \
    KRD(GL,2); GAPB(o[0]=__builtin_amdgcn_mfma_f32_32x32x16_bf16(PAF(2),VFR(2),o[0],0,0,0), C1,0); \
    KRD(GL,3); GAPB(o[1]=__builtin_amdgcn_mfma_f32_32x32x16_bf16(PAF(2),VFR(6),o[1],0,0,0), C1,4); \
    GAPB(o[0]=__builtin_amdgcn_mfma_f32_32x32x16_bf16(PAF(3),VFR(3),o[0],0,0,0), C1,8); \
    GAPB(o[1]=__builtin_amdgcn_mfma_f32_32x32x16_bf16(PAF(3),VFR(7),o[1],0,0,0), C1,12); \
    }while(0)
  int t=1;
  #undef CMASK
  #define CMASK(P0,P1,t) do{}while(0)
  for(;t+5<NT;t+=2){
    STEP(pB0,pB1,pA0,pA1,t,true,true,true);     WAIT_BAR(2); RESC(); ROT();
    STEP(pA0,pA1,pB0,pB1,t+1,true,true,true);   WAIT_BAR(2); RESC(); ROT();
  }
  #undef CMASK
  #define CMASK(P0,P1,t) do{}while(0)
  #define ENDW(tt) do{ if((tt)+3<NT){WAIT_BAR(2);} else if((tt)+2<NT){WAIT_BAR(1);} else {WAIT_BAR(0);} }while(0)
  for(;t+1<NT;t+=2){
    STEP(pB0,pB1,pA0,pA1,t,(t+3<NT),(t+1<NT),(t+1<NT));       ENDW(t);   RESC(); ROT();
    STEP(pA0,pA1,pB0,pB1,t+1,(t+4<NT),(t+2<NT),(t+2<NT));     ENDW(t+1); RESC(); ROT();
  }
  STEP(pB0,pB1,pA0,pA1,NT-1,false,false,false); RESC();
  { float sacc=pB0[0]+pB0[1]; _Pragma("unroll") for(int r=2;r<16;++r)sacc+=pB0[r]; _Pragma("unroll") for(int r=0;r<16;++r)sacc+=pB1[r]; l_reg+=sacc;
    pw0=(u32x4){PKW(pB0,0),PKW(pB0,2),PKW(pB0,4),PKW(pB0,6)};pw1=(u32x4){PKW(pB0,8),PKW(pB0,10),PKW(pB0,12),PKW(pB0,14)};pw2=(u32x4){PKW(pB1,0),PKW(pB1,2),PKW(pB1,4),PKW(pB1,6)};pw3=(u32x4){PKW(pB1,8),PKW(pB1,10),PKW(pB1,12),PKW(pB1,14)};
    SBAR(); pv(o,vb0+sl_cur,PAF(0),PAF(1),PAF(2),PAF(3)); }
  #undef PKW
  #undef PAF
  #undef VFR
  #undef PIN
  #undef MX3
  #undef GAPA
  #undef GAPB
  #undef EX
  #undef VRD
  #undef KRD
  #undef STEP
  #undef ENDW
  {auto rr=__builtin_amdgcn_permlane32_swap(__float_as_uint(l_reg),__float_as_uint(l_reg),false,false);l_reg=__uint_as_float(rr[0])+__uint_as_float(rr[1]);}
  if(hi==0)wsf[32+r32]=l_reg;asm volatile("s_waitcnt lgkmcnt(0)":::"memory");
  float rli[16];
  #pragma unroll
  for(int r=0;r<16;++r)rli[r]=__builtin_amdgcn_rcpf(wsf[32+crow(r,hi)]);
  bf16*Ow=O+((long)b*SEQQ+q0+wid*QBLK)*OPITCH+h*D; const bf16*Gw=Gt+((long)b*SEQQ+q0+wid*QBLK)*GPITCH+h*D;
  { bf16*stg=(bf16*)(shm+LDS_OST)+wid*2048;
    #pragma unroll
    for(int r=0;r<16;++r){const int orow=crow(r,hi);
      #pragma unroll
      for(int d0=0;d0<2;++d0)stg[orow*64+d0*32+r32]=__float2bfloat16(o[d0][r]*rli[r]);}
    asm volatile("s_waitcnt lgkmcnt(0)":::"memory");
    #pragma unroll
    for(int i=0;i<4;++i){const int row=i*8+(lane>>3),ch=lane&7; const u32x4 v=*(const u32x4*)(stg+row*64+ch*8); const u32x4 gv=*(const u32x4*)(Gw+(long)row*GPITCH+ch*8); u32x4 w;
      w.x=pk2(bflo(v.x)*silu_f(bflo(gv.x)),bfhi(v.x)*silu_f(bfhi(gv.x))); w.y=pk2(bflo(v.y)*silu_f(bflo(gv.y)),bfhi(v.y)*silu_f(bfhi(gv.y)));
      w.z=pk2(bflo(v.z)*silu_f(bflo(gv.z)),bfhi(v.z)*silu_f(bfhi(gv.z))); w.w=pk2(bflo(v.w)*silu_f(bflo(gv.w)),bfhi(v.w)*silu_f(bfhi(gv.w)));
      ATTN_STORE16(Ow+(long)row*OPITCH+ch*8,w);} }
  asm volatile("s_waitcnt lgkmcnt(0)\n\ts_barrier":::"memory");
  #undef DMA_K
  #undef DMA_V
  #undef CMASK
  #undef START
  #undef RESC
  #undef ROT
}
constexpr int ATTN_LDS_BYTES=LDS_BYTES;
#undef SBAR
#undef WAIT_BAR
}

typedef short v4i16_t __attribute__((ext_vector_type(4)));
DI s16x4_t vtr16(const LAS unsigned char* p) { return __builtin_bit_cast(s16x4_t, __builtin_amdgcn_ds_read_tr16_b64_v4i16((LAS v4i16_t*)p)); }

struct NaState { f32x16_t o0, o1; float m, l; };
template <bool MASK> DI void na_tile(NaState& st, const bf16x8_t (&qf)[4], const LAS unsigned char* Kb, const LAS unsigned char* Vb, int koff, int lane,
                                     int kr, int qr, int qc, int rsq, int csq, const LAS float* BIAS) {
    const int ql = lane & 31, hf = lane >> 5, row = koff + ql;
    f32x16_t sc = {};
#pragma unroll
    for (int ks = 0; ks < 4; ++ks) { const bf16x8_t kf = *(const LAS bf16x8_t*)(Kb + row * 128 + (((2 * ks + hf) ^ (row & 7)) << 4)); sc = __builtin_amdgcn_mfma_f32_32x32x16_bf16(kf, qf[ks], sc, 0, 0, 0); }
    const LAS unsigned char* vp = Vb + ((lane >> 4) & 1) * 32 + (lane & 3) * 8 + (koff + 4 * hf + ((lane & 15) >> 2)) * 64;
    s16x4_t vl[2][2], vh[2][2];
#pragma unroll
    for (int dt = 0; dt < 2; ++dt)
#pragma unroll
        for (int s = 0; s < 2; ++s) { vl[dt][s] = vtr16(vp + dt * 4096 + s * 1024); vh[dt][s] = vtr16(vp + dt * 4096 + s * 1024 + 512); }
    float xs[16];
    if (MASK) {
        const bool row_ok = (kr >= rsq) && (kr < rsq + 8);
        const LAS float* rb = BIAS + (kr - qr + 7) * 31 + (15 - qc);
#pragma unroll
        for (int r = 0; r < 16; ++r) { const int kc = koff + crow16(r, hf); const bool ok = row_ok && (kc >= csq) && (kc < csq + 16);
            const float bias = ok ? rb[kc] : 0.f; xs[r] = ok ? (sc[r] * 0.125f + bias) * LOG2E : -1e30f; }
    } else {
#pragma unroll
        for (int r = 0; r < 16; ++r) xs[r] = sc[r] * (0.125f * LOG2E);
    }
    float tm = xs[0];
#pragma unroll
    for (int r = 1; r < 16; ++r) tm = fmaxf(tm, xs[r]);
    tm = fmaxf(tm, __shfl_xor(tm, 32));
    const float mn = fmaxf(st.m, tm), al = __builtin_amdgcn_exp2f(st.m - mn);
    float ps = 0.f;
#pragma unroll
    for (int r = 0; r < 16; ++r) { xs[r] = __builtin_amdgcn_exp2f(xs[r] - mn); ps += xs[r]; }
    st.l = st.l * al + ps; st.m = mn;
#pragma unroll
    for (int r = 0; r < 16; ++r) { st.o0[r] *= al; st.o1[r] *= al; }
#pragma unroll
    for (int s = 0; s < 2; ++s) { v4u w; w.x = cvtpk(xs[8 * s], xs[8 * s + 1]); w.y = cvtpk(xs[8 * s + 2], xs[8 * s + 3]); w.z = cvtpk(xs[8 * s + 4], xs[8 * s + 5]); w.w = cvtpk(xs[8 * s + 6], xs[8 * s + 7]);
        const bf16x8_t pf = __builtin_bit_cast(bf16x8_t, w);
        const bf16x8_t a0 = __builtin_shufflevector(vl[0][s], vh[0][s], 0, 1, 2, 3, 4, 5, 6, 7), a1 = __builtin_shufflevector(vl[1][s], vh[1][s], 0, 1, 2, 3, 4, 5, 6, 7);
        st.o0 = __builtin_amdgcn_mfma_f32_32x32x16_bf16(a0, pf, st.o0, 0, 0, 0);
        st.o1 = __builtin_amdgcn_mfma_f32_32x32x16_bf16(a1, pf, st.o1, 0, 0, 0); }
}

constexpr int NA_BLOCK_UNITS = 512 + 32;
DI void na_block_unit(int unit, const bf16_t* PROJ, const float* relb, bf16_t* YMIX, LAS unsigned char* lds, int tid, int wave, int lane) {
    LAS unsigned char* KB = lds; LAS unsigned char* VB = lds + 16384; LAS float* BIAS = (LAS float*)(lds + 32768);
    const bool lat = unit < 512;
    int b, h, R = 0;
    if (lat) { R = unit & 15; h = (unit >> 4) & 7; b = unit >> 7; } else { const int u = unit - 512; h = u & 7; b = u >> 3; }
    const int ql = lane & 31, hf = lane >> 5;
    int qrow, qr = 0, qc = 0, rsq = 0, csq = 0, c0 = 0, rlo = 0, rhi = 0, rsA = 0, nsteps = 4;
    if (lat) { const int rp = 2 * R + (wave >> 2), ci = wave & 3; qr = 2 * rp + (ql >> 4); qc = 16 * ci + (ql & 15); qrow = b * SEQ + qr * 64 + qc;
        rsq = min(max(qr - 4, 0), 56); csq = min(max(qc - 8, 0), 48); c0 = min(max(16 * ci - 8, 0), 32);
        rlo = min(max(2 * rp - 4, 0), 56); rhi = min(max(2 * rp - 3, 0), 56) + 8;
        rsA = min(max(4 * R - 4, 0), 56); const int rsB = min(max(4 * R - 1, 0), 56); nsteps = 4 + (rsB + 8 - rsA);
    } else qrow = NLAT + b * LC + 32 * wave + ql;
    __syncthreads();
    if (lat) for (int e = tid; e < 465; e += NTHREADS) BIAS[e] = relb[h * 465 + e];
    bf16x8_t qf[4];
    { const bf16_t* qp = PROJ + (size_t)qrow * N0 + 1024 + h * 64 + 8 * hf;
#pragma unroll
      for (int ks = 0; ks < 4; ++ks) qf[ks] = *(const bf16x8_t*)(qp + 16 * ks); }
    NaState st; st.o0 = (f32x16_t){}; st.o1 = (f32x16_t){}; st.m = -1e30f; st.l = 0.f;
    const int srow = tid >> 3, sch = tid & 7;
    const int kdst = srow * 128 + ((sch ^ (srow & 7)) << 4), vdst = (sch >> 2) * 4096 + srow * 64 + (sch & 3) * 16;
    auto step_row0 = [&](int s) -> int { return s < 4 ? NLAT + b * LC + 64 * s : b * SEQ + (rsA + s - 4) * 64; };
    v4u kreg, vreg;
    { const bf16_t* src = PROJ + (size_t)(step_row0(0) + srow) * N0 + h * 64 + sch * 8; kreg = *(const v4u*)(src + 1536); vreg = *(const v4u*)(src + 2048); }
#pragma unroll 1
    for (int s = 0; s < nsteps; ++s) {
        LAS unsigned char* kb = KB + (s & 1) * 8192; LAS unsigned char* vb = VB + (s & 1) * 8192;
        *(LAS v4u*)(kb + kdst) = kreg; *(LAS v4u*)(vb + vdst) = vreg;
        __syncthreads();
        if (s + 1 < nsteps) { const bf16_t* src = PROJ + (size_t)(step_row0(s + 1) + srow) * N0 + h * 64 + sch * 8; kreg = *(const v4u*)(src + 1536); vreg = *(const v4u*)(src + 2048); }
        if (s < 4) { na_tile<false>(st, qf, kb, vb, 0, lane, 0, 0, 0, 0, 0, BIAS); na_tile<false>(st, qf, kb, vb, 32, lane, 0, 0, 0, 0, 0, BIAS); }
        else { const int kr = rsA + s - 4; if (kr >= rlo && kr < rhi) na_tile<true>(st, qf, kb, vb, c0, lane, kr, qr, qc, rsq, csq, BIAS); }
    }
    st.l += __shfl_xor(st.l, 32);
    const float rl = 1.f / st.l;
    const bf16_t* gp = PROJ + (size_t)qrow * N0 + 2560 + h * 64; bf16_t* yp = YMIX + (size_t)qrow * DM + 512 + h * 64;
#pragma unroll
    for (int dt = 0; dt < 2; ++dt)
#pragma unroll
        for (int rg = 0; rg < 4; ++rg) { const int d = 32 * dt + 8 * rg + 4 * hf;
            const v2u gv = *(const v2u*)(gp + d);
            const float g0 = silu_f(bflo(gv.x)), g1 = silu_f(bfhi(gv.x)), g2 = silu_f(bflo(gv.y)), g3 = silu_f(bfhi(gv.y));
            const f32x16_t& oo = dt ? st.o1 : st.o0;
            v2u w; w.x = pk2(oo[4 * rg] * rl * g0, oo[4 * rg + 1] * rl * g1); w.y = pk2(oo[4 * rg + 2] * rl * g2, oo[4 * rg + 3] * rl * g3);
            *(v2u*)(yp + d) = w; }
}

struct Args { const float* in[32]; float* out; unsigned char* ws; int ph_lo, ph_hi, li, pad; };
DI void phase3(const Args& args, LAS unsigned char* lds, int tid, int wave, int lane, int G, int pass) {
    unsigned char* ws = args.ws;
    for (int cu = blockIdx.x; cu < 256; cu += G)
        s5_scan_unit(cu, wave, (const bf16_t*)(ws + WS_UG), (const bf16_t*)(ws + WS_W16), (const float*)(ws + WS_L16), (bf16_t*)(ws + WS_CARRY0), (bf16_t*)(ws + WS_CARRY1), lane);
    for (int u = blockIdx.x; u < NA_BLOCK_UNITS; u += G) na_block_unit(u, (const bf16_t*)(ws + WS_PROJ), args.in[20], (bf16_t*)(ws + WS_YMIX), lds, tid, wave, lane);
}
DI void phase4(const Args& args, LAS unsigned char* lds, int tid, int wave, int lane, int G) {
    unsigned char* ws = args.ws;
    constexpr int NIT = 32 * 4 * 17;
    const int i0 = (int)(((long)blockIdx.x * NIT) / G), i1 = (int)(((long)(blockIdx.x + 1) * NIT) / G);
    int gcur = -1;
    for (int it = i0; it < i1; ++it) {
        const int g = it / 68, b = (it % 68) / 17, s = it % 17;
        if (g != gcur) { __syncthreads(); for (int e = tid; e < 1024; e += NTHREADS) ((LAS v4u*)lds)[e] = ((const v4u*)(ws + WS_KT))[(size_t)g * 1024 + e]; gcur = g; __syncthreads(); }
        s5_out_item(g, b, s, (const bf16_t*)(ws + WS_UG), (const bf16_t*)(ws + WS_WC), (const bf16_t*)(ws + WS_CARRY0), (const bf16_t*)(ws + WS_CARRY1), args.in[17], (bf16_t*)(ws + WS_YPRE), lds, wave, lane);
    }
}
DI LruP make_lrup(const Args& args) { unsigned char* ws = args.ws;
    return LruP{(const bf16_t*)(ws + WS_PROJ), args.in[23], args.in[24], args.in[25], args.in[27], args.in[29], (const bf16_t*)(ws + WS_LRUWT), (f32x2_t*)(ws + WS_CARRY0), (bf16_t*)(ws + WS_YMIX)}; }
DI void phase9(const Args& args, LAS unsigned char* lds, int tid, int wave, int lane, int G) {
    unsigned char* ws = args.ws; const LruP lp = make_lrup(args);
    for (int blk = blockIdx.x; blk < 256; blk += G) lru_block(blk, false, lp, lds, tid, wave, lane);
    const int gw = blockIdx.x * NWAVES + wave, NGW = G * NWAVES;
    for (int r = gw; r < MROWS; r += NGW) qkprep_row(r, (const bf16_t*)(ws + WS_PROJ), args.in[30], args.in[31], (const float*)(ws + WS_ROPE), (bf16_t*)(ws + WS_QP), (bf16_t*)(ws + WS_KP), lane);
}
DI void phase10(const Args& args, LAS unsigned char* lds, int tid, int wave, int lane, int G) {
    unsigned char* ws = args.ws;
    const LruP lp = make_lrup(args);
    for (int blk = blockIdx.x; blk < 256; blk += G) lru_block(blk, true, lp, lds, tid, wave, lane);
    __syncthreads();
    const int bx = blockIdx.x, vcu = (G % 8 == 0) ? (bx % 8) * (G / 8) + bx / 8 : bx;
    typedef gqa_body::bf16 abf;
    for (int u = vcu; u < 512; u += G) {
        const int qb = u & 15, hq = (u >> 4) & 7, b = u >> 7;
        gqa_body::attn_unit<8>(b, hq, qb, (const abf*)(ws + WS_QP), (const abf*)(ws + WS_KP), (const abf*)(ws + WS_VT1), (abf*)(ws + WS_YMIX) + 512, (const abf*)(ws + WS_PROJ) + 1792, (char*)lds);
    }
}

constexpr int RING_BYTES = 131072, LDSCTL_OFF = RING_BYTES, MISC_OFF = LDSCTL_OFF + 320, LDS_BYTES = 147456;
constexpr int CW_BAR = 4096;
constexpr int N_PHASES = 13;
constexpr bool kSP2 = true, kALIGN = true;

DI void p0_adaln(LAS unsigned char* lds, const float* c, const float* cctx, const float* ada_w, const float* ada_b, float* MOD, int tid, int wave, int lane, int G) {
    LAS float* sl = (LAS float*)lds;
    LAS float* red = (LAS float*)(lds + 5 * 1024 * 4);
    if ((int)blockIdx.x >= 192) return;
    for (int e = tid; e < 5 * 1024; e += NTHREADS) { const int r = e >> 10, k = e & 1023; const float x = r < 4 ? c[r * 1024 + k] : cctx[k]; sl[e] = silu_f(x); }
    __syncthreads();
    for (int item = blockIdx.x; item < 192; item += G) {
        const int i = item / 96, cb = item % 96, col = cb * 32 + (lane & 31), kh = lane >> 5;
        const float* W = ada_w + (size_t)i * 1024 * 3072 + col;
        float acc[5] = {0.f, 0.f, 0.f, 0.f, 0.f};
#pragma unroll 8
        for (int kk = 0; kk < 64; ++kk) { const int k = wave * 128 + 2 * kk + kh; const float w = W[(size_t)k * 3072];
#pragma unroll
            for (int r = 0; r < 5; ++r) acc[r] += sl[r * 1024 + k] * w; }
#pragma unroll
        for (int r = 0; r < 5; ++r) { acc[r] += __shfl_xor(acc[r], 32); if (lane < 32) red[(wave * 5 + r) * 32 + lane] = acc[r]; }
        __syncthreads();
        if (tid < 160) { const int r = tid >> 5, cl = tid & 31; float s = ada_b[i * 3072 + cb * 32 + cl];
#pragma unroll
            for (int w = 0; w < 8; ++w) s += red[(w * 5 + r) * 32 + cl];
            MOD[(i * 5 + r) * 3072 + cb * 32 + cl] = s; }
        __syncthreads();
    }
}
DI void p0_transpose_item(const float* W, int K, int N, bf16_t* WT, int row_off, LAS float* scr, int item, int lane) {
    const int nblk = N / 32, kb = item / nblk, nb = item % nblk, k0 = 64 * kb, n0 = 32 * nb;
#pragma unroll 8
    for (int i = 0; i < 32; ++i) { const int kk = 2 * i + (lane >> 5); scr[kk * 33 + (lane & 31)] = W[(size_t)(k0 + kk) * N + n0 + (lane & 31)]; }
    LDS_WAIT(); asm volatile("" ::: "memory");
    const int c = lane & 7;
#pragma unroll
    for (int j = 0; j < 4; ++j) { const int n = (lane >> 3) + 8 * j; const LAS float* s = scr + (8 * c) * 33 + n;
        v4u o; o.x = pk2(s[0 * 33], s[1 * 33]); o.y = pk2(s[2 * 33], s[3 * 33]); o.z = pk2(s[4 * 33], s[5 * 33]); o.w = pk2(s[6 * 33], s[7 * 33]);
        *(v4u*)(WT + (size_t)(row_off + n0 + n) * K + k0 + 8 * c) = o; }
    LDS_WAIT(); asm volatile("" ::: "memory");
}

DI void load_row16(const float* src, int lane, float (&v)[16]) {
#pragma unroll
    for (int j = 0; j < 4; ++j) { const f32x4_t t = *(const f32x4_t*)(src + j * 256 + lane * 4); v[4 * j] = t[0]; v[4 * j + 1] = t[1]; v[4 * j + 2] = t[2]; v[4 * j + 3] = t[3]; }
}
DI float row_rinv(const float (&v)[16]) {
    float ss = 0.f;
#pragma unroll
    for (int j = 0; j < 16; ++j) ss += v[j] * v[j];
    ss = wave_sum(ss);
    return rsqrtf(ss * (1.f / DM) + EPSN);
}
DI void store_modnorm(const float (&v)[16], float rinv, const float* g, const float* m, bf16_t* dst, int lane) {
#pragma unroll
    for (int j = 0; j < 4; ++j) { const int col = j * 256 + lane * 4;
        const f32x4_t gg = *(const f32x4_t*)(g + col), sc = *(const f32x4_t*)(m + 1024 + col), sh = *(const f32x4_t*)(m + col);
        float y[4];
#pragma unroll
        for (int e = 0; e < 4; ++e) y[e] = v[4 * j + e] * rinv * gg[e] * (1.f + sc[e]) + sh[e];
        v2u o; o.x = pk2(y[0], y[1]); o.y = pk2(y[2], y[3]); *(v2u*)(dst + col) = o; }
}

__global__ void __launch_bounds__(NTHREADS, 2) mega(Args args) {
    extern __shared__ __attribute__((aligned(16))) unsigned char lds_raw[];
    LAS unsigned char* lds = (LAS unsigned char*)lds_raw;
    volatile LAS unsigned* MISC = (volatile LAS unsigned*)(lds + MISC_OFF);
    const int tid = threadIdx.x, lane = tid & 63, wave = __builtin_amdgcn_readfirstlane(tid >> 6);
    const int G = gridDim.x;
    unsigned char* ws = args.ws;
    gu32* ctl = (gu32*)(ws + WS_CTL);
    for (int u = tid; u < (LDS_BYTES - LDSCTL_OFF) / 4; u += NTHREADS) ((LAS unsigned*)(lds + LDSCTL_OFF))[u] = 0u;
    __syncthreads();
    XcdBarrier bar = xcd_barrier_post((unsigned*)(ctl + CW_BAR) + args.li * XCD_BAR_WORDS, MISC + 8);
    const int lo = args.ph_lo, hi = args.ph_hi;
#define IN(k) (lo <= (k) && (k) < hi)
#ifndef PROBE_REP
#define PROBE_REP 0
#endif
#define PHASE_LOOP(k) for (int rep_ = 0, nrep_ = IN(k) ? 1 + ((PROBE_REP >> (k)) & 1) : 0; rep_ < nrep_; (++rep_ < nrep_) ? xcd_barrier(bar) : (void)0)
#define SEAM(k) do { if (IN(k) && IN((k) + 1)) xcd_barrier(bar); } while (0)

    const float* x = args.in[0]; const float* cvec = args.in[1]; const float* ctxin = args.in[2]; const float* cctx = args.in[3];
    const float* ada_w = args.in[4]; const float* ada_b = args.in[5]; const float* pre_g = args.in[6]; const float* post_g = args.in[7];
    float* out = args.out;
    float* MOD = (float*)(ws + WS_MOD);
    bf16_t* XN = (bf16_t*)(ws + WS_XN); bf16_t* YMIX = (bf16_t*)(ws + WS_YMIX); bf16_t* PROJ = (bf16_t*)(ws + WS_PROJ); float* OUTF = (float*)(ws + WS_PROJ);
    bf16_t* YPRE = (bf16_t*)(ws + WS_YPRE);
    const int gw = blockIdx.x * NWAVES + wave, NGW = G * NWAVES;

    PHASE_LOOP(0) {
        p0_adaln(lds, cvec, cctx, ada_w, ada_b, MOD, tid, wave, lane, G);
        for (int it = G - 1 - (int)blockIdx.x; it < 256; it += G)
            s5_tables_block(it, args.in[10], args.in[11], args.in[12], args.in[13], args.in[14], args.in[15], args.in[16], (bf16_t*)(ws + WS_W16), (bf16_t*)(ws + WS_WC), (bf16_t*)(ws + WS_KT), (float*)(ws + WS_L16), lds, tid);
    }
    SEAM(0);
    PHASE_LOOP(1) {
        for (int r = gw; r < MROWS; r += NGW) {
            const float* src = r < NLAT ? x + (size_t)r * DM : ctxin + (size_t)(r - NLAT) * DM;
            float v[16]; load_row16(src, lane, v);
            store_modnorm(v, row_rinv(v), pre_g, MOD + (r < NLAT ? (r >> 12) : 4) * 3072, XN + (size_t)r * DM, lane);
        }
        LAS float* scr = (LAS float*)(lds + 32768 + wave * 8704);
        constexpr int I0 = 16 * 96, I1 = 16 * 32, I2 = 16 * 72, I3 = 16 * 32, I4 = 8 * 16, NBIG = I0 + I1 + I2 + I3 + I4, NLRU = 32 * 2;
        for (int it = gw; it < NBIG + NLRU; it += NGW) {
            int r = it;
            if (r < I0) { p0_transpose_item(args.in[8], 1024, 3072, (bf16_t*)(ws + WS_WIN0T), 0, scr, r, lane); continue; } r -= I0;
            if (r < I1) { p0_transpose_item(args.in[9], 1024, 1024, (bf16_t*)(ws + WS_WOUT0T), 0, scr, r, lane); continue; } r -= I1;
            if (r < I2) { p0_transpose_item(args.in[21], 1024, 2304, (bf16_t*)(ws + WS_WIN1T), 0, scr, r, lane); continue; } r -= I2;
            if (r < I3) { p0_transpose_item(args.in[22], 1024, 1024, (bf16_t*)(ws + WS_WOUT1T), 0, scr, r, lane); continue; } r -= I3;
            if (r < I4) { p0_transpose_item(args.in[18], 512, 512, (bf16_t*)(ws + WS_WGLUT), 0, scr, r, lane); continue; } r -= I4;
            { const int mat = r >> 1, sub = r & 1, dir = mat >> 4, gate = (mat >> 3) & 1, blk = mat & 7;
              const float* W = (gate ? args.in[28] : args.in[26]) + (size_t)(dir * 8 + blk) * 4096;
              p0_transpose_item(W, 64, 64, (bf16_t*)(ws + WS_LRUWT), blk * 256 + (dir * 2 + gate) * 64, scr, sub, lane); }
        }
        float* ROPE = (float*)(ws + WS_ROPE);
        for (int e = blockIdx.x * NTHREADS + tid; e < SEQ * 32; e += G * NTHREADS) { const int t = e >> 5, i = e & 31, f = i & 15; const float pos = (float)(i < 16 ? (t >> 6) : (t & 63));
            const float inv = (float)exp(-log(10000.0) * (double)(2 * f) / 32.0); const float ang = pos * inv; ROPE[2 * e] = cosf(ang); ROPE[2 * e + 1] = sinf(ang); }
    }
    SEAM(1);
    PHASE_LOOP(2) {
        pg8::Gemm g{XN, (const bf16_t*)(ws + WS_WIN0T), MROWS, N0, DM}; pg8::StaticOrder S; S.init(MROWS, N0, G, (int)blockIdx.x);
        pg8::EpiProj E{PROJ, N0, nullptr, 1 << 30, 1 << 30, 512, false, (bf16_t*)(ws + WS_UG), 512};
        pg8::gemm_phase<pg8::EpiProj, pg8::StaticOrder, kALIGN, kSP2>(lds, g, S, E);
    }
    SEAM(2);
    PHASE_LOOP(3) { phase3(args, lds, tid, wave, lane, G, rep_); }
    SEAM(3);
    PHASE_LOOP(4) { phase4(args, lds, tid, wave, lane, G); }
    SEAM(4);
    PHASE_LOOP(5) {
        pg8::Gemm g{YPRE, (const bf16_t*)(ws + WS_WGLUT), MROWS, 512, 512, 1};   pg8::StaticOrder S; S.init(MROWS, 512, G, (int)blockIdx.x);
        pg8::EpiGlu E{YPRE, PROJ, args.in[19], YMIX};
        pg8::gemm_phase<pg8::EpiGlu, pg8::StaticOrder, kALIGN, kSP2>(lds, g, S, E);
    }
    SEAM(5);
    PHASE_LOOP(6) {
        pg8::Gemm g{YMIX, (const bf16_t*)(ws + WS_WOUT0T), MROWS, DM, DM}; pg8::StaticOrder S; S.init(MROWS, DM, G, (int)blockIdx.x);
        pg8::EpiF32 E{OUTF, DM};
        pg8::gemm_phase<pg8::EpiF32, pg8::StaticOrder, kALIGN, kSP2>(lds, g, S, E);
    }
    SEAM(6);
    PHASE_LOOP(7) {
        for (int r = gw; r < MROWS; r += NGW) {
            const int mrow = r < NLAT ? (r >> 12) : 4;
            const float* hin = r < NLAT ? x + (size_t)r * DM : ctxin + (size_t)(r - NLAT) * DM;
            float v[16], h[16]; load_row16(OUTF + (size_t)r * DM, lane, v); load_row16(hin, lane, h);
            const float rinv = row_rinv(v); const float* gt = MOD + mrow * 3072 + 2048;
#pragma unroll
            for (int j = 0; j < 4; ++j) { const int col = j * 256 + lane * 4; const f32x4_t pg = *(const f32x4_t*)(post_g + col), gg = *(const f32x4_t*)(gt + col);
#pragma unroll
                for (int e = 0; e < 4; ++e) h[4 * j + e] += gg[e] * (v[4 * j + e] * rinv * pg[e]);
                if (r < NLAT) *(f32x4_t*)(out + (size_t)r * DM + col) = (f32x4_t){h[4 * j], h[4 * j + 1], h[4 * j + 2], h[4 * j + 3]}; }
            store_modnorm(h, row_rinv(h), pre_g + DM, MOD + (5 + mrow) * 3072, XN + (size_t)r * DM, lane);
        }
    }
    SEAM(7);
    PHASE_LOOP(8) {
        pg8::Gemm g{XN, (const bf16_t*)(ws + WS_WIN1T), MROWS, N1, DM}; pg8::StaticOrder S; S.init(MROWS, N1, G, (int)blockIdx.x);
        pg8::EpiProj E{PROJ, N1, (bf16_t*)(ws + WS_VT1), 1664, 1792, 128, true, nullptr, 0};
        pg8::gemm_phase<pg8::EpiProj, pg8::StaticOrder, kALIGN, kSP2>(lds, g, S, E);
    }
    SEAM(8);
    PHASE_LOOP(9) { phase9(args, lds, tid, wave, lane, G); }
    SEAM(9);
    PHASE_LOOP(10) { phase10(args, lds, tid, wave, lane, G); }
    SEAM(10);
    PHASE_LOOP(11) {
        pg8::Gemm g{YMIX, (const bf16_t*)(ws + WS_WOUT1T), NLAT, DM, DM}; pg8::StaticOrder S; S.init(NLAT, DM, G, (int)blockIdx.x);
        pg8::EpiF32 E{OUTF, DM};
        pg8::gemm_phase<pg8::EpiF32, pg8::StaticOrder, kALIGN, kSP2>(lds, g, S, E);
    }
    SEAM(11);
    PHASE_LOOP(12) {
        for (int r = gw; r < NLAT; r += NGW) {
            float v[16], h[16]; load_row16(OUTF + (size_t)r * DM, lane, v); load_row16(out + (size_t)r * DM, lane, h);
            const float rinv = row_rinv(v); const float* gt = MOD + (5 + (r >> 12)) * 3072 + 2048;
#pragma unroll
            for (int j = 0; j < 4; ++j) { const int col = j * 256 + lane * 4; const f32x4_t pg = *(const f32x4_t*)(post_g + DM + col), gg = *(const f32x4_t*)(gt + col);
                f32x4_t o;
#pragma unroll
                for (int e = 0; e < 4; ++e) o[e] = h[4 * j + e] + gg[e] * (v[4 * j + e] * rinv * pg[e]);
                *(f32x4_t*)(out + (size_t)r * DM + col) = o; }
        }
    }
#undef IN
#undef SEAM
}
__global__ void k_adaln(const float* c, const float* cctx, const float* ada_w, const float* ada_b, float* mod) {
    const int idx = blockIdx.x * blockDim.x + threadIdx.x;
    if (idx >= 2 * 5 * 3072) return;
    const int col = idx % 3072, r = (idx / 3072) % 5, i = idx / (3072 * 5);
    const float* cv = r < 4 ? c + r * 1024 : cctx;
    const float* W = ada_w + (size_t)i * 1024 * 3072;
    float acc = 0.f;
    for (int k = 0; k < 1024; ++k) acc += silu_f(cv[k]) * W[(size_t)k * 3072 + col];
    mod[idx] = acc + ada_b[i * 3072 + col];
}

__global__ void k_prenorm(const float* lat, const float* ctx, const float* g, const float* mod  , bf16_t* XN) {
    const int r = blockIdx.x * 4 + (threadIdx.x >> 6), lane = threadIdx.x & 63;
    if (r >= MROWS) return;
    const float* src = r < NLAT ? lat + (size_t)r * DM : ctx + (size_t)(r - NLAT) * DM;
    const float* m = mod + (r < NLAT ? (r >> 12) : 4) * 3072;
    float v[16]; float ss = 0.f;
#pragma unroll
    for (int j = 0; j < 4; ++j) { const float4 t = *(const float4*)(src + j * 256 + lane * 4); v[4 * j] = t.x; v[4 * j + 1] = t.y; v[4 * j + 2] = t.z; v[4 * j + 3] = t.w; }
#pragma unroll
    for (int j = 0; j < 16; ++j) ss += v[j] * v[j];
    ss = wave_sum(ss);
    const float rinv = rsqrtf(ss * (1.f / DM) + EPSN);
#pragma unroll
    for (int j = 0; j < 4; ++j)
#pragma unroll
        for (int e = 0; e < 4; ++e) { const int col = j * 256 + lane * 4 + e; const float y = v[4 * j + e] * rinv * g[col] * (1.f + m[1024 + col]) + m[col]; XN[(size_t)r * DM + col] = f2bf(y); }
}

__global__ void k_postnorm(const float* hlat, const float* hctx, const float* OUT, const float* pg, const float* mod, float* olat, float* octx, int nrows) {
    const int r = blockIdx.x * 4 + (threadIdx.x >> 6), lane = threadIdx.x & 63;
    if (r >= nrows) return;
    const float* hin = r < NLAT ? hlat + (size_t)r * DM : hctx + (size_t)(r - NLAT) * DM;
    float* ho = r < NLAT ? olat + (size_t)r * DM : octx + (size_t)(r - NLAT) * DM;
    const float* m = mod + (r < NLAT ? (r >> 12) : 4) * 3072 + 2048;
    const float* src = OUT + (size_t)r * DM;
    float v[16]; float ss = 0.f;
#pragma unroll
    for (int j = 0; j < 4; ++j) { const float4 t = *(const float4*)(src + j * 256 + lane * 4); v[4 * j] = t.x; v[4 * j + 1] = t.y; v[4 * j + 2] = t.z; v[4 * j + 3] = t.w; }
#pragma unroll
    for (int j = 0; j < 16; ++j) ss += v[j] * v[j];
    ss = wave_sum(ss);
    const float rinv = rsqrtf(ss * (1.f / DM) + EPSN);
#pragma unroll
    for (int j = 0; j < 4; ++j)
#pragma unroll
        for (int e = 0; e < 4; ++e) { const int col = j * 256 + lane * 4 + e; ho[col] = hin[col] + m[col] * (v[4 * j + e] * rinv * pg[col]); }
}

enum { GM_PROJ0 = 0, GM_PROJ1 = 1, GM_GLU = 2, GM_F32 = 3 };
struct GemmEpi { bf16_t* P; bf16_t* VT; const bf16_t* YPRE; const bf16_t* PROJ; const float* bglu; bf16_t* YMIX; float* OUT; };
template <int MODE> __global__ void __launch_bounds__(256) k_gemm(const bf16_t* A, const float* W, int M, int N, int K, GemmEpi e) {
    const int tx = threadIdx.x & 15, ty = threadIdx.x >> 4;
    const int c0 = blockIdx.x * 64 + tx * 4, r0 = blockIdx.y * 64 + ty * 4;
    float acc[4][4] = {};
    for (int k = 0; k < K; ++k) {
        const float4 w = *(const float4*)(W + (size_t)k * N + c0);
        const float wv[4] = {rbf(w.x), rbf(w.y), rbf(w.z), rbf(w.w)};
#pragma unroll
        for (int i = 0; i < 4; ++i) { const float a = bf2f(A[(size_t)(r0 + i) * K + k]);
#pragma unroll
            for (int j = 0; j < 4; ++j) acc[i][j] += a * wv[j]; }
    }
#pragma unroll
    for (int i = 0; i < 4; ++i)
#pragma unroll
        for (int j = 0; j < 4; ++j) {
            const int r = r0 + i, c = c0 + j; const float v = acc[i][j];
            if (MODE == GM_PROJ0) { e.P[(size_t)r * N0 + c] = f2bf(v);
                if (c >= 2048 && c < 2560) { const int hd = c - 2048; e.VT[((size_t)(row_batch(r) * 8) * 64 + hd) * POSN + row_pos(r)] = f2bf(v); } }
            else if (MODE == GM_PROJ1) { e.P[(size_t)r * N1 + c] = f2bf(v);
                if (c >= 1664 && c < 1792) { const int hd = c - 1664; e.VT[((size_t)(row_batch(r) * 2) * 64 + hd) * POSN + row_pos(r)] = f2bf(v); } }
            else if (MODE == GM_GLU) { const float y = bf2f(e.YPRE[(size_t)r * 512 + c]); const float ga = bf2f(e.PROJ[(size_t)r * N0 + 512 + c]);
                e.YMIX[(size_t)r * DM + c] = f2bf(y * sigmoid_f(v + e.bglu[c]) * silu_f(ga)); }
            else e.OUT[(size_t)r * N + c] = v;
        }
}

__global__ void __launch_bounds__(64) k_s5_scan(const bf16_t* PROJ, const float* lam_re, const float* lam_im, const float* log_dt, const float* b_re, const float* b_im,
                                                 const float* c_re, const float* c_im, float* YS) {
    const int p = threadIdx.x, id = blockIdx.x, dir = id & 1, g = (id >> 1) & 31, b = id >> 6;
    const int gi = (dir * 32 + g);
    const double lre = lam_re[gi * 64 + p], lim = lam_im[gi * 64 + p], dt = exp((double)log_dt[gi]);
    const double mag = exp(lre * dt); const float ar = (float)(mag * cos(lim * dt)), ai = (float)(mag * sin(lim * dt));
    const double nr = mag * cos(lim * dt) - 1.0, ni = mag * sin(lim * dt), den = lre * lre + lim * lim;
    const float cfr = (float)((nr * lre + ni * lim) / den), cfi = (float)((ni * lre - nr * lim) / den);
    float bbr[16], bbi[16], cr[16], ci[16];
#pragma unroll
    for (int h = 0; h < 16; ++h) { const float br = b_re[(gi * 64 + p) * 16 + h], bi = b_im[(gi * 64 + p) * 16 + h]; bbr[h] = cfr * br - cfi * bi; bbi[h] = cfr * bi + cfi * br;
        cr[h] = c_re[(gi * 16 + h) * 64 + p]; ci[h] = c_im[(gi * 16 + h) * 64 + p]; }
    float hr = 0.f, hi = 0.f;
    float* ys = YS + (size_t)dir * MROWS * 512;
    for (int pos = 0; pos < POSN; ++pos) {
        int row;
        if (dir == 0) row = pos_row(b, pos); else row = pos < LC ? NLAT + b * LC + (LC - 1 - pos) : b * SEQ + (SEQ - 1 - (pos - LC));
        const bf16_t* up = PROJ + (size_t)row * N0 + g * 16;
        float bur = 0.f, bui = 0.f;
#pragma unroll
        for (int h = 0; h < 16; ++h) { const float u = bf2f(up[h]); bur += bbr[h] * u; bui += bbi[h] * u; }
        const float nhr = ar * hr - ai * hi + bur, nhi = ar * hi + ai * hr + bui; hr = nhr; hi = nhi;
        float mine = 0.f;
#pragma unroll
        for (int h = 0; h < 16; ++h) { const float y = wave_sum(cr[h] * hr - ci[h] * hi); if (p == h) mine = y; }
        if (p < 16) ys[(size_t)row * 512 + g * 16 + p] = mine;
    }
}
__global__ void k_s5_finish(const bf16_t* PROJ, const float* YS, const float* dsk, bf16_t* YPRE) {
    const size_t idx = (size_t)blockIdx.x * blockDim.x + threadIdx.x; if (idx >= (size_t)MROWS * 512) return;
    const int ch = idx & 511; const size_t r = idx >> 9;
    const float y = dsk[ch] * bf2f(PROJ[r * N0 + ch]) + YS[idx] + YS[(size_t)MROWS * 512 + idx];
    YPRE[idx] = f2bf(gelu_tanh(y));
}

__global__ void __launch_bounds__(256) k_na_attn(const bf16_t* PROJ, const float* relb, bf16_t* YMIX) {
    const int wv = blockIdx.x * 4 + (threadIdx.x >> 6), lane = threadIdx.x & 63;
    if (wv >= MROWS * 8) return;
    const int h = wv & 7, r = wv >> 3, b = row_batch(r);
    const float q = bf2f(PROJ[(size_t)r * N0 + 1024 + h * 64 + lane]);
    float m = -INFINITY, l = 0.f, o = 0.f;
    if (r < NLAT) {
        const int t = r & 4095, qr = t >> 6, qc = t & 63;
        const int rs = min(max(qr - 4, 0), 56), cs = min(max(qc - 8, 0), 48);
        for (int kr = rs; kr < rs + 8; ++kr)
            for (int kc = cs; kc < cs + 16; ++kc) {
                const size_t kro = (size_t)(b * SEQ + kr * 64 + kc) * N0;
                float s = wave_sum(q * bf2f(PROJ[kro + 1536 + h * 64 + lane])) * 0.125f + relb[(h * 15 + (kr - qr + 7)) * 31 + (kc - qc + 15)];
                const float mn = fmaxf(m, s), al = __expf(m - mn), pp = __expf(s - mn);
                l = l * al + pp; o = o * al + pp * bf2f(PROJ[kro + 2048 + h * 64 + lane]); m = mn;
            }
    }
    for (int c = 0; c < LC; ++c) {
        const size_t kro = (size_t)(NLAT + b * LC + c) * N0;
        const float s = wave_sum(q * bf2f(PROJ[kro + 1536 + h * 64 + lane])) * 0.125f;
        const float mn = fmaxf(m, s), al = __expf(m - mn), pp = __expf(s - mn);
        l = l * al + pp; o = o * al + pp * bf2f(PROJ[kro + 2048 + h * 64 + lane]); m = mn;
    }
    const float gb = bf2f(PROJ[(size_t)r * N0 + 2560 + h * 64 + lane]);
    YMIX[(size_t)r * DM + 512 + h * 64 + lane] = f2bf(o / l * silu_f(gb));
}

__global__ void __launch_bounds__(64) k_lru(const bf16_t* P1, const float* conv_w, const float* conv_b, const float* lam, const float* w_a, const float* b_a,
                                            const float* w_x, const float* b_x, float* HS, bf16_t* YMIX) {
    __shared__ float xs[64];
    const int j = threadIdx.x, nb = blockIdx.x & 7, b = blockIdx.x >> 3, ch = nb * 64 + j;
    const float cw0 = conv_w[0 * 512 + ch], cw1 = conv_w[1 * 512 + ch], cw2 = conv_w[2 * 512 + ch], cw3 = conv_w[3 * 512 + ch], cb = conv_b[ch];
    for (int dir = 0; dir < 2; ++dir) {
        float wa[64], wx[64];
#pragma unroll
        for (int i = 0; i < 64; ++i) { wa[i] = w_a[((dir * 8 + nb) * 64 + i) * 64 + j]; wx[i] = w_x[((dir * 8 + nb) * 64 + i) * 64 + j]; }
        const float ba = b_a[dir * 512 + ch], bx = b_x[dir * 512 + ch];
        const float lm = lam[dir * 512 + ch]; const float sp = (-lm > 20.f) ? -lm : log1pf(__expf(-lm));
        float hst = 0.f;
        for (int pos = 0; pos < POSN; ++pos) {
            int s0, sl, t;
            if (pos < LC) { s0 = NLAT + b * LC; sl = LC; t = dir == 0 ? pos : LC - 1 - pos; }
            else { s0 = b * SEQ; sl = SEQ; t = dir == 0 ? pos - LC : SEQ - 1 - (pos - LC); }
            float xm1 = 0.f, x0, xp1 = 0.f, xp2 = 0.f;
            x0 = bf2f(P1[(size_t)(s0 + t) * N1 + ch]);
            if (t - 1 >= 0) xm1 = bf2f(P1[(size_t)(s0 + t - 1) * N1 + ch]);
            if (t + 1 < sl) xp1 = bf2f(P1[(size_t)(s0 + t + 1) * N1 + ch]);
            if (t + 2 < sl) xp2 = bf2f(P1[(size_t)(s0 + t + 2) * N1 + ch]);
            const float xc = cw0 * xm1 + cw1 * x0 + cw2 * xp1 + cw3 * xp2 + cb;
            __syncthreads(); xs[j] = xc; __syncthreads();
            float ga = ba, gx = bx;
#pragma unroll
            for (int i = 0; i < 64; ++i) { const float xi = xs[i]; ga += xi * wa[i]; gx += xi * wx[i]; }
            const float gr = sigmoid_f(ga), gi = sigmoid_f(gx);
            const float log_a = -8.f * gr * sp; const float a = __expf(log_a); const float mult = sqrtf(fmaxf(-expm1f(2.f * log_a), 0.f));
            hst = a * hst + mult * gi * xc;
            if (pos >= LC) { const size_t rr = (size_t)(s0 + t);
                if (dir == 0) HS[rr * 512 + ch] = hst;
                else { const float gc = bf2f(P1[rr * N1 + 512 + ch]); YMIX[rr * DM + ch] = f2bf((HS[rr * 512 + ch] + hst) * silu_f(gc)); } }
        }
    }
}

__global__ void __launch_bounds__(256) k_qkprep(const bf16_t* P1, const float* qn, const float* kn, bf16_t* QP, bf16_t* KP) {
    const int wv = blockIdx.x * 4 + (threadIdx.x >> 6), lane = threadIdx.x & 63;
    if (wv >= MROWS * 10) return;
    const int slot = wv % 10, r = wv / 10, b = row_batch(r);
    if (slot < 8 && r >= NLAT) return;
    const int col0 = slot < 8 ? 1024 + slot * 64 : 1536 + (slot - 8) * 64;
    const float x = bf2f(P1[(size_t)r * N1 + col0 + lane]);
    const float ss = wave_sum(x * x);
    float y = x * rsqrtf(ss * (1.f / 64.f) + EPSN) * (slot < 8 ? qn[lane] : kn[lane]);
    if (r < NLAT) {
        const int t = r & 4095, i = lane >> 1, f = i & 15; const float pos = (float)(i < 16 ? (t >> 6) : (t & 63));
        const float inv = (float)exp(-log(10000.0) * (double)(2 * f) / 32.0);
        const float ang = pos * inv; const float cs = cosf(ang), sn = sinf(ang);
        const float pr = __shfl_xor(y, 1);
        y = (lane & 1) ? (pr * sn + y * cs) : (y * cs - pr * sn);
    }
    if (slot < 8) QP[((size_t)(b * 8 + slot) * SEQ + (r & 4095)) * 64 + lane] = f2bf(y * (0.125f * LOG2E));
    else KP[((size_t)(b * 2 + (slot - 8)) * POSN + row_pos(r)) * 64 + lane] = f2bf(y);
}

__global__ void __launch_bounds__(256) k_gqa(const bf16_t* QP, const bf16_t* KP, const bf16_t* P1, bf16_t* YMIX) {
    const int wv = blockIdx.x * 4 + (threadIdx.x >> 6), lane = threadIdx.x & 63;
    if (wv >= NLAT * 8) return;
    const int hq = wv & 7, r = wv >> 3, b = r >> 12, t = r & 4095, kvh = hq >> 2;
    const float q = bf2f(QP[((size_t)(b * 8 + hq) * SEQ + t) * 64 + lane]);
    const bf16_t* kp = KP + (size_t)(b * 2 + kvh) * POSN * 64;
    float m = -INFINITY, l = 0.f, o = 0.f;
    for (int pos = 0; pos < POSN; ++pos) {
        const float s = wave_sum(q * bf2f(kp[(size_t)pos * 64 + lane]));
        const float v = bf2f(P1[(size_t)pos_row(b, pos) * N1 + 1664 + kvh * 64 + lane]);
        const float mn = fmaxf(m, s), al = exp2f(m - mn), pp = exp2f(s - mn);
        l = l * al + pp; o = o * al + pp * v; m = mn;
    }
    const float gd = bf2f(P1[(size_t)r * N1 + 1792 + hq * 64 + lane]);
    YMIX[(size_t)r * DM + 512 + hq * 64 + lane] = f2bf(o / l * silu_f(gd));
}

static int g_grid = 0;
static void launch_mega(Args a, int lo, int hi, int li, hipStream_t stream) {
    a.ph_lo = lo; a.ph_hi = hi; a.li = li;
    hipLaunchKernelGGL(mega, dim3(g_grid), dim3(NTHREADS), LDS_BYTES, stream, a);
    const hipError_t le = hipPeekAtLastError();
    if (le != hipSuccess) fprintf(stderr, "kernel_launch: mega[%d,%d) failed: %s\n", lo, hi, hipGetErrorName(le));
}
extern "C" void kernel_launch(void* const* d_in, const int* in_sizes, int n_in, void* d_out, int out_size, void* d_ws, size_t ws_size, hipStream_t stream) {
    if (g_grid == 0) {
        int dev = 0, cus = 0;
        if (hipGetDevice(&dev) != hipSuccess || hipDeviceGetAttribute(&cus, hipDeviceAttributeMultiprocessorCount, dev) != hipSuccess) { fprintf(stderr, "kernel_launch: device query failed\n"); g_grid = -1; return; }
        if (hipFuncSetAttribute((const void*)mega, hipFuncAttributeMaxDynamicSharedMemorySize, LDS_BYTES) != hipSuccess) { fprintf(stderr, "kernel_launch: hipFuncSetAttribute failed\n"); g_grid = -1; return; }
        int per_cu = 0;
        if (hipOccupancyMaxActiveBlocksPerMultiprocessor(&per_cu, (const void*)mega, NTHREADS, LDS_BYTES) != hipSuccess || per_cu < 1) fprintf(stderr, "kernel_launch: occupancy query says %d blocks/CU\n", per_cu);
        (void)hipGetLastError();
        g_grid = cus;
    }
    if (g_grid < 0) return;
    const float* x = (const float*)d_in[0]; const float* c = (const float*)d_in[1]; const float* ctx = (const float*)d_in[2]; const float* cctx = (const float*)d_in[3];
    const float* ada_w = (const float*)d_in[4]; const float* ada_b = (const float*)d_in[5]; const float* pre_g = (const float*)d_in[6]; const float* post_g = (const float*)d_in[7];
    const float* ev_w_in = (const float*)d_in[8]; const float* ev_w_out = (const float*)d_in[9];
    const float* s5_lre = (const float*)d_in[10]; const float* s5_lim = (const float*)d_in[11]; const float* s5_ldt = (const float*)d_in[12];
    const float* s5_bre = (const float*)d_in[13]; const float* s5_bim = (const float*)d_in[14]; const float* s5_cre = (const float*)d_in[15]; const float* s5_cim = (const float*)d_in[16];
    const float* s5_d = (const float*)d_in[17]; const float* s5_wglu = (const float*)d_in[18]; const float* s5_bglu = (const float*)d_in[19]; const float* relb = (const float*)d_in[20];
    const float* od_w_in = (const float*)d_in[21]; const float* od_w_out = (const float*)d_in[22]; const float* conv_w = (const float*)d_in[23]; const float* conv_b = (const float*)d_in[24];
    const float* lru_lam = (const float*)d_in[25]; const float* w_a = (const float*)d_in[26]; const float* b_a = (const float*)d_in[27]; const float* w_x = (const float*)d_in[28]; const float* b_x = (const float*)d_in[29];
    const float* qn = (const float*)d_in[30]; const float* kn = (const float*)d_in[31];
    char* ws = (char*)d_ws; float* out = (float*)d_out;
    float* MOD = (float*)(ws + WS_MOD); float* HC1 = (float*)(ws + WS_HC1);
    bf16_t* XN = (bf16_t*)(ws + WS_XN); bf16_t* YMIX = (bf16_t*)(ws + WS_YMIX); bf16_t* PROJ = (bf16_t*)(ws + WS_PROJ); float* OUTF = (float*)(ws + WS_PROJ);
    bf16_t* VT0 = (bf16_t*)(ws + WS_VT0); bf16_t* YPRE = (bf16_t*)(ws + WS_YPRE); bf16_t* QP = (bf16_t*)(ws + WS_QP); bf16_t* KP = (bf16_t*)(ws + WS_KP); bf16_t* VT1 = (bf16_t*)(ws + WS_VT1);
    float* YS = (float*)(ws + WS_YS); float* HS = (float*)(ws + WS_HS);
    (void)x; (void)c; (void)ctx; (void)cctx; (void)ada_w; (void)ada_b; (void)pre_g; (void)post_g; (void)ev_w_in; (void)ev_w_out; (void)s5_wglu; (void)od_w_in; (void)od_w_out; (void)MOD; (void)HC1; (void)XN; (void)OUTF; (void)VT0; (void)VT1; (void)out;

    if (hipMemsetAsync(ws + WS_CTL, 0, CTL_ZERO_BYTES, stream) != hipSuccess) { fprintf(stderr, "kernel_launch: memset failed\n"); return; }
    Args a{};
    for (int i = 0; i < 32; ++i) a.in[i] = (const float*)d_in[i];
    a.out = (float*)d_out; a.ws = (unsigned char*)d_ws;

    launch_mega(a, 0, N_PHASES, 0, stream);
    (void)relb; (void)conv_w; (void)conv_b; (void)lru_lam; (void)w_a; (void)b_a; (void)w_x; (void)b_x; (void)HS; (void)qn; (void)kn; (void)QP; (void)KP;
    (void)s5_lre; (void)s5_lim; (void)s5_ldt; (void)s5_bre; (void)s5_bim; (void)s5_cre; (void)s5_cim; (void)s5_d; (void)s5_bglu; (void)YS; (void)YPRE; (void)PROJ; (void)YMIX;
}
```

```cpp
#include <hip/hip_runtime.h>
#include <cstdint>
#include <cstdio>

typedef unsigned short bf16_t;
#define DI __device__ __forceinline__
#define GAS __attribute__((address_space(1)))
#define LAS __attribute__((address_space(3)))
typedef unsigned v4u __attribute__((ext_vector_type(4)));
typedef unsigned v2u __attribute__((ext_vector_type(2)));
typedef float f32x4_t __attribute__((ext_vector_type(4)));
typedef float f32x16_t __attribute__((ext_vector_type(16)));
typedef short bf16x8_t __attribute__((ext_vector_type(8)));
typedef short s16x4_t __attribute__((ext_vector_type(4)));
typedef GAS unsigned gu32;
typedef GAS unsigned long long gu64;
#define RLX_AGENT __ATOMIC_RELAXED, __HIP_MEMORY_SCOPE_AGENT
#define LDS_WAIT() asm volatile("s_waitcnt lgkmcnt(0)" ::: "memory")
#define VM_WAIT() asm volatile("s_waitcnt vmcnt(0)" ::: "memory")

DI float bf2f(bf16_t v) { return __uint_as_float((unsigned)v << 16); }
DI bf16_t f2bf(float f) { unsigned u = __float_as_uint(f); return (bf16_t)((u + 0x7fffu + ((u >> 16) & 1u)) >> 16); }
DI unsigned pk2(float lo, float hi) { return (unsigned)f2bf(lo) | ((unsigned)f2bf(hi) << 16); }
DI float bflo(unsigned w) { return __uint_as_float(w << 16); }
DI float bfhi(unsigned w) { return __uint_as_float(w & 0xffff0000u); }
DI float rbf(float f) { return bf2f(f2bf(f)); }
DI float wave_sum(float v) {
#pragma unroll
    for (int o = 1; o < 64; o <<= 1) v += __shfl_xor(v, o);
    return v;
}
DI float sigmoid_f(float x) { return __builtin_amdgcn_rcpf(1.f + __builtin_amdgcn_exp2f(-1.4426950408889634f * x)); }
DI float silu_f(float x) { return x * sigmoid_f(x); }
DI float gelu_tanh(float x) { const float u = 0.7978845608028654f * (x + 0.044715f * x * x * x); return 0.5f * x * (1.f + tanhf(u)); }
DI float gelu_fast(float x) { const float u = 1.5957691216057308f * (x + 0.044715f * x * x * x); return x * sigmoid_f(u); }

constexpr int NWAVES = 8, NTHREADS = 512;
constexpr int DM = 1024, NB = 4, SEQ = 4096, LC = 256;
constexpr int NLAT = NB * SEQ, NCTX = NB * LC, MROWS = NLAT + NCTX;
constexpr int N0 = 3072, N1 = 2304, POSN = LC + SEQ;
constexpr float EPSN = 1e-6f;
constexpr float LOG2E = 1.4426950408889634f;

constexpr size_t MiB = 1u << 20;
constexpr size_t WS_CTL = 0, CTL_ZERO_BYTES = 1 * MiB;
constexpr size_t WS_MOD = 1 * MiB;
constexpr size_t WS_ROPE = 2 * MiB;
constexpr size_t WS_L16 = 3 * MiB;
constexpr size_t WS_WIN0T = 4 * MiB;
constexpr size_t WS_WOUT0T = 10 * MiB;
constexpr size_t WS_WIN1T = 12 * MiB;
constexpr size_t WS_WOUT1T = 17 * MiB;
constexpr size_t WS_WGLUT = 19 * MiB;
constexpr size_t WS_LRUWT = 19 * MiB + 512 * 1024;
constexpr size_t WS_W16 = 20 * MiB;
constexpr size_t WS_WC = 24 * MiB;
constexpr size_t WS_KT = 28 * MiB;
constexpr size_t WS_LSUM = 29 * MiB;
constexpr size_t WS_XN = 32 * MiB;
constexpr size_t WS_YMIX = 66 * MiB;
constexpr size_t WS_PROJ = 100 * MiB;
constexpr size_t WS_VT0 = 202 * MiB;
constexpr size_t WS_UG = 202 * MiB;
constexpr size_t WS_CARRY1 = 219 * MiB;
constexpr size_t WS_YPRE = 228 * MiB;
constexpr size_t WS_QP = 202 * MiB;
constexpr size_t WS_KP = 218 * MiB;
constexpr size_t WS_VT1 = 223 * MiB;
constexpr size_t WS_YS = 32 * MiB;
constexpr size_t WS_HS = 32 * MiB;
constexpr size_t WS_HC1 = 246 * MiB;

DI int row_batch(int r) { return r < NLAT ? (r >> 12) : ((r - NLAT) >> 8); }
DI int row_pos(int r) { return r < NLAT ? LC + (r & 4095) : ((r - NLAT) & 255); }
DI int pos_row(int b, int pos) { return pos < LC ? NLAT + b * LC + pos : b * SEQ + (pos - LC); }

namespace pg8 {
#define PG8_LAS __attribute__((address_space(3)))
typedef unsigned short bf16_t;
typedef short bf16x8 __attribute__((ext_vector_type(8)));
typedef float f32x4 __attribute__((ext_vector_type(4)));
typedef unsigned u32x4 __attribute__((ext_vector_type(4)));
constexpr int BM = 256, BK = 64, HALF = 128, HTB = HALF * BK * 2  , STAGE_BYTES = 8 * HTB, NXCD = 8, WGM = 8;

__host__ __device__ __forceinline__ int lds_byte(int r, int c) { const int st = (r >> 4) * 2 + (c >> 5), rr = r & 15, cc = c & 31, ob = rr * 64 + cc * 2; return st * 1024 + (ob ^ (((ob >> 9) & 1) << 5)); }
__host__ __device__ __forceinline__ void stage_rc(int b, int& R, int& C) { const int st = b / 1024, sb = b % 1024, swz = sb ^ (((sb >> 9) & 1) << 5); R = (st >> 1) * 16 + swz / 64; C = (st & 1) * 32 + (swz % 64) / 2; }
__host__ __device__ __forceinline__ int perm32(int rho) { const int n = rho >> 4, i = rho & 15; return 8 * (i >> 2) + 4 * n + (i & 3); }

struct Unit { int pm, pn; };
struct Gemm { const bf16_t* A; const bf16_t* Bt; int M, N, K; int a_gmajor; };

struct StaticOrder {
    int nM, nN, nwg, G, c;
    __host__ __device__ void init(int M, int N, int G_, int c_) { nM = M / BM; nN = N / BM; nwg = nM * nN; G = G_; c = c_; }
    __host__ __device__ bool next(int i, Unit& u) const {
        const long L = (long)i * G + c; if (L >= nwg) return false;
        int wgid = (int)L; { const int q = nwg / NXCD, r = nwg % NXCD, xcd = wgid % NXCD, off = wgid / NXCD; wgid = (xcd < r ? xcd * (q + 1) : r * (q + 1) + (xcd - r) * q) + off; }
        const int nig = WGM * nN, gid = wgid / nig, fm = gid * WGM, gsz = (nM - fm) < WGM ? (nM - fm) : WGM;
        u.pm = fm + ((wgid % nig) % gsz); u.pn = (wgid % nig) / gsz; return true;
    }
    __device__ __forceinline__ void a_ready(const Unit&) const {}
    __device__ __forceinline__ void done(const Unit&) const {}
};

__device__ __forceinline__ unsigned cvt_pk_bf16(float lo, float hi) { unsigned r; asm volatile("v_cvt_pk_bf16_f32 %0, %1, %2" : "=v"(r) : "v"(lo), "v"(hi)); return r; }

struct EpiProj {
    static constexpr bool PERM = true, AFTER_DRAIN = false;
    bf16_t* P; int ldc; bf16_t* VT; int vt_lo, vt_hi, vt_w; bool vrow; bf16_t* UG; int ug_hi;
    __device__ __forceinline__ void operator()(const f32x4 (&acc)[2][2][4][2], const Unit& u, int wr, int wc, int fr, int fq) const {
        const int row0 = u.pm * BM + wr * 64 + fr, colt = u.pn * BM + wc * 32 + 8 * fq;
#pragma unroll
        for (int ai = 0; ai < 2; ++ai)
#pragma unroll
            for (int m = 0; m < 4; ++m) { const int r = row0 + ai * HALF + m * 16; bf16_t* rowp = P + (size_t)r * ldc + colt;
#pragma unroll
                for (int bj = 0; bj < 2; ++bj) { const f32x4 v0 = acc[ai][bj][m][0], v1 = acc[ai][bj][m][1];
                    u32x4 w; w.x = cvt_pk_bf16(v0[0], v0[1]); w.y = cvt_pk_bf16(v0[2], v0[3]); w.z = cvt_pk_bf16(v1[0], v1[1]); w.w = cvt_pk_bf16(v1[2], v1[3]);
                    const int c0 = colt + bj * HALF;
                    if (c0 < ug_hi) *(u32x4*)(UG + ((size_t)(c0 >> 4) * MROWS + r) * 16 + (c0 & 15)) = w; else *(u32x4*)(rowp + bj * HALF) = w;
                    if (c0 >= vt_lo && c0 < vt_hi && vrow) {
                        const int hd = c0 - vt_lo; *(u32x4*)(VT + ((size_t)(row_batch(r) * (vt_w >> 6) + (hd >> 6)) * POSN + row_pos(r)) * 64 + (hd & 63)) = w;
                    } else if (c0 >= vt_lo && c0 < vt_hi) {
                        bf16_t* vp = VT + ((size_t)row_batch(r) * vt_w + (c0 - vt_lo)) * POSN + row_pos(r);
                        vp[0 * POSN] = (bf16_t)(w.x & 0xffffu); vp[1 * POSN] = (bf16_t)(w.x >> 16); vp[2 * POSN] = (bf16_t)(w.y & 0xffffu); vp[3 * POSN] = (bf16_t)(w.y >> 16);
                        vp[4 * POSN] = (bf16_t)(w.z & 0xffffu); vp[5 * POSN] = (bf16_t)(w.z >> 16); vp[6 * POSN] = (bf16_t)(w.w & 0xffffu); vp[7 * POSN] = (bf16_t)(w.w >> 16);
                    } } }
    }
};
struct EpiGlu {
    static constexpr bool PERM = true, AFTER_DRAIN = false;
    const bf16_t* YPRE; const bf16_t* PROJ; const float* bglu; bf16_t* YMIX;
    __device__ __forceinline__ void operator()(const f32x4 (&acc)[2][2][4][2], const Unit& u, int wr, int wc, int fr, int fq) const {
        const int row0 = u.pm * BM + wr * 64 + fr, colt = u.pn * BM + wc * 32 + 8 * fq;
#pragma unroll
        for (int bj = 0; bj < 2; ++bj) { const int c0 = colt + bj * HALF;
            const f32x4 b0 = *(const f32x4*)(bglu + c0), b1 = *(const f32x4*)(bglu + c0 + 4);
#pragma unroll
            for (int ai = 0; ai < 2; ++ai)
#pragma unroll
                for (int m = 0; m < 4; ++m) { const int r = row0 + ai * HALF + m * 16;
                    const u32x4 yv = *(const u32x4*)(YPRE + ((size_t)(c0 >> 4) * MROWS + r) * 16 + (c0 & 15)), gv = *(const u32x4*)(PROJ + (size_t)r * N0 + 512 + c0);
                    const f32x4 a0 = acc[ai][bj][m][0] + b0, a1 = acc[ai][bj][m][1] + b1;
                    float o[8];
                    o[0] = bflo(yv.x) * sigmoid_f(a0[0]) * silu_f(bflo(gv.x)); o[1] = bfhi(yv.x) * sigmoid_f(a0[1]) * silu_f(bfhi(gv.x));
                    o[2] = bflo(yv.y) * sigmoid_f(a0[2]) * silu_f(bflo(gv.y)); o[3] = bfhi(yv.y) * sigmoid_f(a0[3]) * silu_f(bfhi(gv.y));
                    o[4] = bflo(yv.z) * sigmoid_f(a1[0]) * silu_f(bflo(gv.z)); o[5] = bfhi(yv.z) * sigmoid_f(a1[1]) * silu_f(bfhi(gv.z));
                    o[6] = bflo(yv.w) * sigmoid_f(a1[2]) * silu_f(bflo(gv.w)); o[7] = bfhi(yv.w) * sigmoid_f(a1[3]) * silu_f(bfhi(gv.w));
                    u32x4 w; w.x = cvt_pk_bf16(o[0], o[1]); w.y = cvt_pk_bf16(o[2], o[3]); w.z = cvt_pk_bf16(o[4], o[5]); w.w = cvt_pk_bf16(o[6], o[7]);
                    *(u32x4*)(YMIX + (size_t)r * DM + c0) = w; } }
    }
};
struct EpiF32 {
    static constexpr bool PERM = false, AFTER_DRAIN = false;
    float* O; int ldc;
    __device__ __forceinline__ void operator()(const f32x4 (&acc)[2][2][4][2], const Unit& u, int wr, int wc, int fr, int fq) const {
        const int row0 = u.pm * BM + wr * 64 + fr, col0 = u.pn * BM + wc * 32 + 4 * fq;
#pragma unroll
        for (int ai = 0; ai < 2; ++ai)
#pragma unroll
            for (int m = 0; m < 4; ++m) { float* rowp = O + (size_t)(row0 + ai * HALF + m * 16) * ldc + col0;
#pragma unroll
                for (int bj = 0; bj < 2; ++bj)
#pragma unroll
                    for (int n = 0; n < 2; ++n) *(f32x4*)(rowp + bj * HALF + n * 16) = acc[ai][bj][m][n]; }
    }
};
template <class Epi, class Sched, bool ALIGN_EPI = false, bool SP2 = false>
__device__ __forceinline__ void gemm_phase(PG8_LAS unsigned char* lds, const Gemm g, const Sched& S, const Epi& E) {
    const int tid = threadIdx.x, wid = __builtin_amdgcn_readfirstlane(tid >> 6), lane = tid & 63, wr = wid >> 2, wc = wid & 3, fr = lane & 15, fq = lane >> 4;
    const int K = g.K, nt = K / BK;
    unsigned voffA[2], voffB[2];
#pragma unroll
    for (int i = 0; i < 2; ++i) { int R, C; stage_rc(tid * 16 + i * 8192, R, C); const int Rb = Epi::PERM ? ((R & ~31) + perm32(R & 31)) : R;
        voffA[i] = g.a_gmajor ? (unsigned)(((C >> 4) * g.M + R) * 16 + (C & 15)) * 2u : (unsigned)(R * K + C) * 2u; voffB[i] = (unsigned)(Rb * K + C) * 2u; }
    const size_t kstep = (size_t)(BK * 2);
    const size_t hstep = (size_t)HALF * K * 2;
    const size_t tstep = 2 * hstep;
    const size_t kstepA = g.a_gmajor ? (size_t)(BK / 16) * g.M * 32 : kstep, hstepA = g.a_gmajor ? (size_t)HALF * 32 : hstep, tstepA = 2 * hstepA;
    const unsigned ldsw = (unsigned)wid * 1024u;
    const int aoff = lds_byte(wr * 64 + fr, fq * 8), boff = lds_byte(wc * 32 + fr, fq * 8);
#define PG8_SA(b, h) (((b) * 2 + (h)) * HTB)
#define PG8_SB(b, h) ((4 + (b) * 2 + (h)) * HTB)
#define PG8_STAGE(bufoff, gbase, voff) do { _Pragma("unroll") for (int _i = 0; _i < 2; ++_i) \
        __builtin_amdgcn_global_load_lds((const unsigned*)((const char*)(gbase) + (voff)[_i]), (PG8_LAS unsigned*)(lds + (bufoff) + ldsw + _i * 8192), 16, 0, 0); } while (0)
#define PG8_LDA(dst, b, h) do { _Pragma("unroll") for (int m = 0; m < 4; ++m) _Pragma("unroll") for (int k = 0; k < 2; ++k) dst[m][k] = *(const PG8_LAS bf16x8*)(lds + PG8_SA(b, h) + aoff + m * 2048 + k * 1024); } while (0)
#define PG8_LDB(dst, b, h) do { _Pragma("unroll") for (int n = 0; n < 2; ++n) _Pragma("unroll") for (int k = 0; k < 2; ++k) dst[n][k] = *(const PG8_LAS bf16x8*)(lds + PG8_SB(b, h) + boff + n * 2048 + k * 1024); } while (0)
#define PG8_MMA(ai, bj, At, Bt) do { __builtin_amdgcn_s_setprio(1); _Pragma("unroll") for (int m = 0; m < 4; ++m) _Pragma("unroll") for (int n = 0; n < 2; ++n) _Pragma("unroll") for (int k = 0; k < 2; ++k) \
        acc[ai][bj][m][n] = __builtin_amdgcn_mfma_f32_16x16x32_bf16(Bt[n][k], At[m][k], acc[ai][bj][m][n], 0, 0, 0); __builtin_amdgcn_s_setprio(0); } while (0)
#define PG8_WAIT_V(n) asm volatile("s_waitcnt vmcnt(" #n ")" ::: "memory")
#define PG8_WAIT_L(n) asm volatile("s_waitcnt lgkmcnt(" #n ")" ::: "memory")
#define PG8_BAR __builtin_amdgcn_s_barrier()
#define PG8_SCHED __builtin_amdgcn_sched_barrier(0)
    Unit cur, nxt; int ui = 0;
    if (!S.next(0, cur)) return;
    f32x4 acc[2][2][4][2];
#pragma unroll
    for (int a = 0; a < 2; ++a)
#pragma unroll
        for (int b = 0; b < 2; ++b)
#pragma unroll
            for (int m = 0; m < 4; ++m)
#pragma unroll
                for (int n = 0; n < 2; ++n) acc[a][b][m][n] = (f32x4){0.f, 0.f, 0.f, 0.f};
    bf16x8 At[4][2], B0[2][2], B1[2][2];
    const char* cA = (const char*)g.A + (size_t)cur.pm * tstepA; const char* cB = (const char*)g.Bt + (size_t)cur.pn * tstep;
    S.a_ready(cur);
    if constexpr (SP2) {
        PG8_STAGE(PG8_SB(0, 0), cB, voffB); PG8_STAGE(PG8_SB(0, 1), cB + hstep, voffB); PG8_STAGE(PG8_SA(0, 0), cA, voffA); PG8_STAGE(PG8_SA(0, 1), cA + hstepA, voffA);
        if (wr == 1) PG8_BAR;
        PG8_WAIT_V(2); PG8_BAR;
        PG8_STAGE(PG8_SB(1, 0), cB + kstep, voffB); PG8_STAGE(PG8_SA(1, 0), cA + kstepA, voffA); PG8_STAGE(PG8_SB(1, 1), cB + hstep + kstep, voffB);
        PG8_WAIT_V(6); PG8_BAR;
    } else {
        PG8_STAGE(PG8_SB(0, 0), cB, voffB); PG8_STAGE(PG8_SA(0, 0), cA, voffA); PG8_STAGE(PG8_SB(0, 1), cB + hstep, voffB); PG8_STAGE(PG8_SA(0, 1), cA + hstepA, voffA);
        if (wr == 1) PG8_BAR;
        PG8_WAIT_V(4); PG8_BAR;
        PG8_STAGE(PG8_SB(1, 0), cB + kstep, voffB); PG8_STAGE(PG8_SA(1, 0), cA + kstepA, voffA); PG8_STAGE(PG8_SB(1, 1), cB + hstep + kstep, voffB);
        PG8_WAIT_V(6); PG8_BAR;
    }
    for (;;) {
        const bool has_next = S.next(ui + 1, nxt);
        const char* nA = has_next ? (const char*)g.A + (size_t)nxt.pm * tstepA : cA; const char* nB = has_next ? (const char*)g.Bt + (size_t)nxt.pn * tstep : cB;
        for (int t = 0; t < nt; t += 2) {
            const bool last = (t == nt - 2);
            const char* a1 = cA + (size_t)(t + 1) * kstepA;
            const char* a2 = last ? nA : cA + (size_t)(t + 2) * kstepA; const char* b2 = last ? nB : cB + (size_t)(t + 2) * kstep;
            const char* a3 = a2 + kstepA; const char* b3 = b2 + kstep;
            if (last && has_next) S.a_ready(nxt);
            if constexpr (SP2) {
            PG8_LDB(B0, 0, 0); PG8_LDB(B1, 0, 1); PG8_SCHED; PG8_LDA(At, 0, 0); PG8_STAGE(PG8_SA(1, 1), a1 + hstepA, voffA);
            PG8_WAIT_V(8); PG8_WAIT_L(0); PG8_BAR; PG8_MMA(0, 0, At, B0); PG8_MMA(0, 1, At, B1); PG8_BAR; PG8_SCHED;
            PG8_LDA(At, 0, 1); PG8_STAGE(PG8_SB(0, 0), b2, voffB); PG8_STAGE(PG8_SB(0, 1), b2 + hstep, voffB); PG8_STAGE(PG8_SA(0, 0), a2, voffA);
            PG8_WAIT_V(8); PG8_WAIT_L(0); PG8_BAR; PG8_MMA(1, 0, At, B0); PG8_MMA(1, 1, At, B1); PG8_BAR; PG8_SCHED;
            PG8_LDB(B0, 1, 0); PG8_LDB(B1, 1, 1); PG8_SCHED; PG8_LDA(At, 1, 0); PG8_STAGE(PG8_SA(0, 1), a2 + hstepA, voffA);
            PG8_WAIT_V(8); PG8_WAIT_L(0); PG8_BAR; PG8_MMA(0, 0, At, B0); PG8_MMA(0, 1, At, B1); PG8_BAR; PG8_SCHED;
            PG8_LDA(At, 1, 1); PG8_STAGE(PG8_SB(1, 0), b3, voffB); PG8_STAGE(PG8_SB(1, 1), b3 + hstep, voffB); PG8_STAGE(PG8_SA(1, 0), a3, voffA);
            PG8_WAIT_V(8); PG8_WAIT_L(0); PG8_BAR; PG8_MMA(1, 0, At, B0); PG8_MMA(1, 1, At, B1); PG8_BAR; PG8_SCHED;
            } else {
            PG8_LDB(B0, 0, 0); PG8_SCHED; PG8_LDA(At, 0, 0); PG8_STAGE(PG8_SA(1, 1), a1 + hstepA, voffA);
            PG8_WAIT_L(8); PG8_BAR; PG8_WAIT_L(0); PG8_MMA(0, 0, At, B0); PG8_BAR; PG8_SCHED;
            PG8_LDB(B1, 0, 1); PG8_STAGE(PG8_SB(0, 0), b2, voffB);
            PG8_BAR; PG8_WAIT_L(0); PG8_MMA(0, 1, At, B1); PG8_BAR;
            PG8_LDA(At, 0, 1); PG8_STAGE(PG8_SA(0, 0), a2, voffA);
            PG8_BAR; PG8_WAIT_L(0); PG8_MMA(1, 0, At, B0); PG8_BAR; PG8_SCHED;
            PG8_STAGE(PG8_SB(0, 1), b2 + hstep, voffB);
            PG8_WAIT_V(6); PG8_BAR; PG8_MMA(1, 1, At, B1); PG8_BAR;
            PG8_LDB(B0, 1, 0); PG8_SCHED; PG8_LDA(At, 1, 0); PG8_STAGE(PG8_SA(0, 1), a2 + hstepA, voffA);
            PG8_WAIT_L(8); PG8_BAR; PG8_WAIT_L(0); PG8_MMA(0, 0, At, B0); PG8_BAR; PG8_SCHED;
            PG8_LDB(B1, 1, 1); PG8_STAGE(PG8_SB(1, 0), b3, voffB);
            PG8_BAR; PG8_WAIT_L(0); PG8_MMA(0, 1, At, B1); PG8_BAR;
            PG8_LDA(At, 1, 1); PG8_STAGE(PG8_SA(1, 0), a3, voffA);
            PG8_BAR; PG8_WAIT_L(0); PG8_MMA(1, 0, At, B0); PG8_BAR; PG8_SCHED;
            PG8_STAGE(PG8_SB(1, 1), b3 + hstep, voffB);
            PG8_WAIT_V(6); PG8_BAR; PG8_MMA(1, 1, At, B1); PG8_BAR;
            }
        }
        if constexpr (ALIGN_EPI) { if (wr == 0) PG8_BAR; }
        if constexpr (!Epi::AFTER_DRAIN) { E(acc, cur, wr, wc, fr, fq); S.done(cur); }
        if (!has_next) break;
#pragma unroll
        for (int a = 0; a < 2; ++a)
#pragma unroll
            for (int b = 0; b < 2; ++b)
#pragma unroll
                for (int m = 0; m < 4; ++m)
#pragma unroll
                    for (int n = 0; n < 2; ++n) acc[a][b][m][n] = (f32x4){0.f, 0.f, 0.f, 0.f};
        cur = nxt; cA = nA; cB = nB; ++ui;
        if constexpr (ALIGN_EPI) { if (wr == 1) PG8_BAR; }
    }
    PG8_WAIT_V(0);
    if constexpr (!ALIGN_EPI) { if (wr == 0) PG8_BAR; }
    PG8_BAR;
    if constexpr (Epi::AFTER_DRAIN) { E.fused(acc, cur, wr, wc, fr, fq, lds, wid, lane); S.done(cur); }
#undef PG8_SA
#undef PG8_SB
#undef PG8_STAGE
#undef PG8_LDA
#undef PG8_LDB
#undef PG8_MMA
#undef PG8_WAIT_V
#undef PG8_WAIT_L
#undef PG8_BAR
#undef PG8_SCHED
}
}
#define XB_TMO      128
#define XB_XCNT(j)  (256  + 64 * (j))
#define XB_XSUB(j)  (1280 + 64 * (j))
#define XB_XGEN(j)  (2304 + 64 * (j))
#define XB_TOP      3328
#define XB_TOPGEN   3392
#define XCD_BAR_WORDS 3456
#define XB_SPIN_CAP (1u << 18)

__device__ __forceinline__ unsigned xb_ld(unsigned* p)              { return __hip_atomic_load(p, __ATOMIC_RELAXED, __HIP_MEMORY_SCOPE_AGENT); }
__device__ __forceinline__ unsigned xb_add(unsigned* p, unsigned v) { return __hip_atomic_fetch_add(p, v, __ATOMIC_RELAXED, __HIP_MEMORY_SCOPE_AGENT); }
__device__ __forceinline__ unsigned xb_xcc_id() { return (unsigned)__builtin_amdgcn_s_getreg((3 << 11) | 20) & 0xFu; }
#define XB_SPIN(cond, bar) do { unsigned _sp = 0; while (cond) { __builtin_amdgcn_s_sleep(1); \
    if ((++_sp & 255u) == 0u) { if (xb_ld(&(bar)[XB_TMO])) break; if (_sp > XB_SPIN_CAP) { atomicAdd(&(bar)[XB_TMO], 1u); break; } } } } while (0)

struct XcdBarrier {
    unsigned* bar; unsigned x;
    volatile LAS unsigned* st;
};

__device__ __forceinline__ XcdBarrier xcd_barrier_post(unsigned* bar, volatile LAS unsigned* st) {
    XcdBarrier b; b.bar = bar; b.x = xb_xcc_id(); b.st = st;
    if (threadIdx.x == 0) (void)xb_add(&bar[XB_XCNT(b.x)], 1u);
    return b;
}
__device__ __forceinline__ void xcd_barrier_complete(unsigned* bar, unsigned x, unsigned& nloc, unsigned& nx) {
    const unsigned G = gridDim.x * gridDim.y * gridDim.z;
    unsigned sum, cnt, mine, sp = 0u;
    for (;;) {
        sum = 0u; cnt = 0u; mine = 0u;
#pragma unroll
        for (unsigned j = 0; j < 16; ++j) { const unsigned c = xb_ld(&bar[XB_XCNT(j)]); sum += c; cnt += (c > 0u) ? 1u : 0u; mine = (j == x) ? c : mine; }
        if (sum == G) break;
        __builtin_amdgcn_s_sleep(1);
        if ((++sp & 255u) == 0u) { if (xb_ld(&bar[XB_TMO])) break; if (sp > XB_SPIN_CAP) { atomicAdd(&bar[XB_TMO], 1u); break; } }
    }
    nloc = mine > 0u ? mine : 1u; nx = cnt > 0u ? cnt : 1u;
}

__device__ __forceinline__ void xcd_barrier(const XcdBarrier& b) {
    asm volatile("s_waitcnt vmcnt(0)" ::: "memory");
    __syncthreads();
    if (threadIdx.x == 0) {
        unsigned* bar = b.bar;
        __builtin_amdgcn_s_waitcnt(0);
        unsigned nloc = b.st[0], nx = b.st[1];
        if (nloc == 0u) { xcd_barrier_complete(bar, b.x, nloc, nx); b.st[0] = nloc; b.st[1] = nx; }
        const unsigned old = xb_add(&bar[XB_XSUB(b.x)], 1u);
        const unsigned gen = old / nloc;
        if (old + 1u == (gen + 1u) * nloc) {
            __builtin_amdgcn_fence(__ATOMIC_RELEASE, "agent");
            asm volatile("s_waitcnt vmcnt(0)" ::: "memory");
            const unsigned og = xb_add(&bar[XB_TOP], 1u);
            const unsigned tg = og / nx;
            if (og + 1u == (tg + 1u) * nx) xb_add(&bar[XB_TOPGEN], 1u);
            else XB_SPIN(xb_ld(&bar[XB_TOPGEN]) == tg, bar);
            __builtin_amdgcn_fence(__ATOMIC_ACQUIRE, "agent");
            xb_add(&bar[XB_XGEN(b.x)], 1u);
            asm volatile("s_waitcnt vmcnt(0)" ::: "memory");
        } else {
            XB_SPIN(xb_ld(&bar[XB_XGEN(b.x)]) == gen, bar);
            __builtin_amdgcn_fence(__ATOMIC_ACQUIRE, "agent");
            asm volatile("s_waitcnt vmcnt(0)" ::: "memory");
        }
    }
    __syncthreads();
}

DI int crow16(int reg, int hf) { return (reg & 3) + 8 * (reg >> 2) + 4 * hf; }
DI unsigned cvtpk(float lo, float hi) { typedef float f2 __attribute__((ext_vector_type(2))); typedef __bf16 b2 __attribute__((ext_vector_type(2))); f2 v = {lo, hi}; b2 b = __builtin_convertvector(v, b2); return __builtin_bit_cast(unsigned, b); }
struct AttnP { const bf16_t* Q; const bf16_t* K; const bf16_t* VT; const bf16_t* Gt; bf16_t* Y; const float* relb; };

template <int MODE> DI void attn_unit(int unit, const AttnP& P, int lane) {
    const int ql = lane & 31, hf = lane >> 5;
    int b, h, kvh, qrow, NT, rp = 0, ci = 0, rs0 = 0, c0 = 0, qr = 0, qc = 0, rsq = 0, csq = 0;
    if (MODE == 0) { ci = unit & 3; rp = (unit >> 2) & 31; h = (unit >> 7) & 7; b = unit >> 10; kvh = h;
        qr = 2 * rp + (ql >> 4); qc = 16 * ci + (ql & 15); qrow = b * SEQ + qr * 64 + qc;
        rs0 = min(max(2 * rp - 4, 0), 56); const int rs1 = min(max(2 * rp - 3, 0), 56); NT = 8 + (rs1 + 8 - rs0);
        c0 = min(max(16 * ci - 8, 0), 32); rsq = min(max(qr - 4, 0), 56); csq = min(max(qc - 8, 0), 48);
    } else if (MODE == 1) { const int qt = unit & 7; h = (unit >> 3) & 7; b = unit >> 6; kvh = h; qrow = NLAT + b * LC + 32 * qt + ql; NT = 8; }
    else { const int qt = unit & 127; h = (unit >> 7) & 7; b = unit >> 10; kvh = h >> 2; qrow = b * SEQ + 32 * qt + ql; NT = POSN / 32; }
    const bf16_t* qp; const bf16_t* kb; size_t kpitch; const bf16_t* vt; const bf16_t* gp; bf16_t* yp;
    if (MODE == 2) { qp = P.Q + ((size_t)(b * 8 + h) * SEQ + (qrow - b * SEQ)) * 64; kb = P.K + (size_t)(b * 2 + kvh) * POSN * 64; kpitch = 64;
        vt = P.VT + (size_t)(b * 2 + kvh) * 64 * POSN; gp = P.Gt + (size_t)qrow * N1 + 1792 + h * 64; }
    else { qp = P.Q + (size_t)qrow * N0 + 1024 + h * 64; kb = P.K + 1536 + h * 64; kpitch = N0; vt = P.VT + (size_t)(b * 8 + h) * 64 * POSN; gp = P.Gt + (size_t)qrow * N0 + 2560 + h * 64; }
    yp = P.Y + (size_t)qrow * DM + 512 + h * 64;
    bf16x8_t qf[4];
#pragma unroll
    for (int ks = 0; ks < 4; ++ks) qf[ks] = *(const bf16x8_t*)(qp + 16 * ks + 8 * hf);
    const bf16_t* vt0 = vt + (size_t)ql * POSN + 4 * hf;
    f32x16_t o0 = {}, o1 = {};
    float m = -1e30f, l = 0.f;
    auto tile_krow = [&](int t) -> int { if (MODE == 2) return 32 * t + ql; if (t < 8) return NLAT + b * LC + 32 * t + ql; return b * SEQ + (rs0 + t - 8) * 64 + c0 + ql; };
    auto tile_pos0 = [&](int t) -> int { if (MODE == 2) return 32 * t; if (t < 8) return 32 * t; return LC + (rs0 + t - 8) * 64 + c0; };
    bf16x8_t kn[4];
    { const bf16_t* kp = kb + (size_t)tile_krow(0) * kpitch + 8 * hf;
#pragma unroll
      for (int ks = 0; ks < 4; ++ks) kn[ks] = *(const bf16x8_t*)(kp + 16 * ks); }
#pragma unroll 1
    for (int t = 0; t < NT; ++t) {
        bf16x8_t kf[4];
#pragma unroll
        for (int ks = 0; ks < 4; ++ks) kf[ks] = kn[ks];
        if (t + 1 < NT) { const bf16_t* kp = kb + (size_t)tile_krow(t + 1) * kpitch + 8 * hf;
#pragma unroll
            for (int ks = 0; ks < 4; ++ks) kn[ks] = *(const bf16x8_t*)(kp + 16 * ks); }
        const bf16_t* vp = vt0 + tile_pos0(t);
        s16x4_t va[2][2][2];
#pragma unroll
        for (int dt = 0; dt < 2; ++dt)
#pragma unroll
            for (int s = 0; s < 2; ++s) { va[dt][s][0] = *(const s16x4_t*)(vp + (size_t)dt * 32 * POSN + 16 * s); va[dt][s][1] = *(const s16x4_t*)(vp + (size_t)dt * 32 * POSN + 16 * s + 8); }
        f32x16_t sc = {};
#pragma unroll
        for (int ks = 0; ks < 4; ++ks) sc = __builtin_amdgcn_mfma_f32_32x32x16_bf16(kf[ks], qf[ks], sc, 0, 0, 0);
        float xs[16];
        if (MODE == 0 && t >= 8) {
            const int kr = rs0 + t - 8; const bool row_ok = (kr >= rsq) && (kr < rsq + 8);
            const float* rb = P.relb + (h * 15 + (kr - qr + 7)) * 31 + (15 - qc);
#pragma unroll
            for (int r = 0; r < 16; ++r) { const int kc = c0 + crow16(r, hf); const bool ok = row_ok && (kc >= csq) && (kc < csq + 16);
                const float bias = ok ? rb[kc] : 0.f; xs[r] = ok ? (sc[r] * 0.125f + bias) * LOG2E : -1e30f; }
        } else {
#pragma unroll
            for (int r = 0; r < 16; ++r) xs[r] = (MODE == 2) ? sc[r] : sc[r] * (0.125f * LOG2E);
        }
        float tm = xs[0];
#pragma unroll
        for (int r = 1; r < 16; ++r) tm = fmaxf(tm, xs[r]);
        tm = fmaxf(tm, __shfl_xor(tm, 32));
        const float mn = fmaxf(m, tm), al = __builtin_amdgcn_exp2f(m - mn);
        float ps = 0.f;
#pragma unroll
        for (int r = 0; r < 16; ++r) { xs[r] = __builtin_amdgcn_exp2f(xs[r] - mn); ps += xs[r]; }
        l = l * al + ps; m = mn;
#pragma unroll
        for (int r = 0; r < 16; ++r) { o0[r] *= al; o1[r] *= al; }
        bf16x8_t pf[2];
#pragma unroll
        for (int s = 0; s < 2; ++s) { v4u w; w.x = cvtpk(xs[8 * s], xs[8 * s + 1]); w.y = cvtpk(xs[8 * s + 2], xs[8 * s + 3]); w.z = cvtpk(xs[8 * s + 4], xs[8 * s + 5]); w.w = cvtpk(xs[8 * s + 6], xs[8 * s + 7]);
            pf[s] = __builtin_bit_cast(bf16x8_t, w); }
#pragma unroll
        for (int s = 0; s < 2; ++s) {
            const bf16x8_t a0 = __builtin_shufflevector(va[0][s][0], va[0][s][1], 0, 1, 2, 3, 4, 5, 6, 7);
            const bf16x8_t a1 = __builtin_shufflevector(va[1][s][0], va[1][s][1], 0, 1, 2, 3, 4, 5, 6, 7);
            o0 = __builtin_amdgcn_mfma_f32_32x32x16_bf16(a0, pf[s], o0, 0, 0, 0);
            o1 = __builtin_amdgcn_mfma_f32_32x32x16_bf16(a1, pf[s], o1, 0, 0, 0);
        }
    }
    l += __shfl_xor(l, 32);
    const float rl = 1.f / l;
#pragma unroll
    for (int dt = 0; dt < 2; ++dt)
#pragma unroll
        for (int rg = 0; rg < 4; ++rg) { const int d = 32 * dt + 8 * rg + 4 * hf;
            const v2u gv = *(const v2u*)(gp + d);
            const float g0 = silu_f(bflo(gv.x)), g1 = silu_f(bfhi(gv.x)), g2 = silu_f(bflo(gv.y)), g3 = silu_f(bfhi(gv.y));
            const f32x16_t& oo = dt ? o1 : o0;
            v2u w; w.x = pk2(oo[4 * rg] * rl * g0, oo[4 * rg + 1] * rl * g1); w.y = pk2(oo[4 * rg + 2] * rl * g2, oo[4 * rg + 3] * rl * g3);
            *(v2u*)(yp + d) = w; }
}

typedef float f32x2_t __attribute__((ext_vector_type(2)));
constexpr int LRU_NCOL = 272;
struct LruP { const bf16_t* P1; const float* conv_w; const float* conv_b; const float* lam; const float* b_a; const float* b_x; const bf16_t* WT; f32x2_t* SUM16; bf16_t* YMIX; };
constexpr int LRU_WTL = 0, LRU_CWL = 36864, LRU_BAX = LRU_CWL + 1280, LRU_XW = LRU_BAX + 1536, LRU_CARRY = LRU_XW + 8 * 4160, LRU_FOLD = LRU_CARRY + 16384;

DI void lru_setup(int nb, const LruP& p, LAS unsigned char* lds, int tid) {
    __syncthreads();
    for (int e = tid; e < 256 * 8; e += NTHREADS) { const int row = e >> 3, ch = e & 7; *(LAS v4u*)(lds + LRU_WTL + row * 144 + ch * 16) = *(const v4u*)(p.WT + (size_t)(nb * 256 + row) * 64 + ch * 8); }
    LAS float* CW = (LAS float*)(lds + LRU_CWL); LAS float* BAX = (LAS float*)(lds + LRU_BAX);
    if (tid < 320) CW[tid] = tid < 256 ? p.conv_w[(tid >> 6) * 512 + nb * 64 + (tid & 63)] : p.conv_b[nb * 64 + (tid & 63)];
    if (tid < 128) { const int dir = tid >> 6, ch = tid & 63; BAX[(dir * 3 + 0) * 64 + ch] = p.b_a[dir * 512 + nb * 64 + ch]; BAX[(dir * 3 + 1) * 64 + ch] = p.b_x[dir * 512 + nb * 64 + ch];
        BAX[(dir * 3 + 2) * 64 + ch] = log1pf(__expf(-p.lam[dir * 512 + nb * 64 + ch])); }
    __syncthreads();
}

template <bool PASS2> DI void lru_micro(int b, int col, int nb, int ci, const LruP& p, LAS unsigned char* lds, int wave, int lane) {
    const int n = lane & 15, q = lane >> 4;
    const int s0 = col < 16 ? NLAT + b * LC : b * SEQ, sl = col < 16 ? LC : SEQ, t0 = col < 16 ? col * 16 : (col - 16) * 16;
    LAS float* CW = (LAS float*)(lds + LRU_CWL); LAS float* BAX = (LAS float*)(lds + LRU_BAX); LAS float* XW = (LAS float*)(lds + LRU_XW + wave * 4160);
    v4u xr[4][2];
#pragma unroll
    for (int j = 0; j < 4; ++j) { const int tt = t0 + n + j - 1; const bool ok = tt >= 0 && tt < sl;
#pragma unroll
        for (int ks = 0; ks < 2; ++ks) { xr[j][ks] = (v4u){0u, 0u, 0u, 0u}; if (ok) xr[j][ks] = *(const v4u*)(p.P1 + (size_t)(s0 + tt) * N1 + nb * 64 + 32 * ks + 8 * q); } }
    bf16x8_t af[2];
#pragma unroll
    for (int ks = 0; ks < 2; ++ks) { const int c = 32 * ks + 8 * q;
        float xc[8];
        const f32x4_t bb0 = *(const LAS f32x4_t*)(CW + 256 + c), bb1 = *(const LAS f32x4_t*)(CW + 256 + c + 4);
#pragma unroll
        for (int e = 0; e < 4; ++e) { xc[e] = bb0[e]; xc[4 + e] = bb1[e]; }
#pragma unroll
        for (int j = 0; j < 4; ++j) { const f32x4_t w0 = *(const LAS f32x4_t*)(CW + j * 64 + c), w1 = *(const LAS f32x4_t*)(CW + j * 64 + c + 4); const v4u xx = xr[j][ks];
            xc[0] += w0[0] * bflo(xx.x); xc[1] += w0[1] * bfhi(xx.x); xc[2] += w0[2] * bflo(xx.y); xc[3] += w0[3] * bfhi(xx.y);
            xc[4] += w1[0] * bflo(xx.z); xc[5] += w1[1] * bfhi(xx.z); xc[6] += w1[2] * bflo(xx.w); xc[7] += w1[3] * bfhi(xx.w); }
        v4u w; w.x = pk2(xc[0], xc[1]); w.y = pk2(xc[2], xc[3]); w.z = pk2(xc[4], xc[5]); w.w = pk2(xc[6], xc[7]); af[ks] = __builtin_bit_cast(bf16x8_t, w);
#pragma unroll
        for (int e = 0; e < 8; ++e) XW[n * 65 + c + e] = xc[e]; }
    float hsum[4][4];
#pragma unroll
    for (int c4 = 0; c4 < 4; ++c4)
#pragma unroll
        for (int r = 0; r < 4; ++r) hsum[c4][r] = 0.f;
#pragma unroll 1
    for (int dir = 0; dir < 2; ++dir) {
        f32x4_t acc[8];
#pragma unroll
        for (int nt = 0; nt < 8; ++nt) { acc[nt] = (f32x4_t){0.f, 0.f, 0.f, 0.f};
            const LAS unsigned char* wrow = lds + LRU_WTL + ((dir * 2 + (nt >> 2)) * 64 + (nt & 3) * 16 + n) * 144 + 16 * q;
#pragma unroll
            for (int ks = 0; ks < 2; ++ks) { const bf16x8_t bfr = *(const LAS bf16x8_t*)(wrow + 64 * ks); acc[nt] = __builtin_amdgcn_mfma_f32_16x16x32_bf16(af[ks], bfr, acc[nt], 0, 0, 0); } }
        float a[4][4], bt[4][4];
#pragma unroll
        for (int c4 = 0; c4 < 4; ++c4) { const int ch = c4 * 16 + n;
            const float ba = BAX[(dir * 3 + 0) * 64 + ch], bx = BAX[(dir * 3 + 1) * 64 + ch], sp = BAX[(dir * 3 + 2) * 64 + ch];
#pragma unroll
            for (int r = 0; r < 4; ++r) { const float gr = sigmoid_f(acc[c4][r] + ba), gi = sigmoid_f(acc[c4 + 4][r] + bx);
                const float log_a = -8.f * gr * sp; const float av = __builtin_amdgcn_exp2f(log_a * LOG2E); a[c4][r] = av;
                const float x2 = 2.f * log_a;
                const float ser = -x2 * (1.f + x2 * (0.5f + x2 * (0.16666667f + x2 * (0.041666668f + x2 * 0.0083333338f))));
                const float om = x2 > -0.5f ? ser : 1.f - av * av;
                bt[c4][r] = __builtin_amdgcn_sqrtf(fmaxf(om, 0.f)) * gi * XW[(4 * q + r) * 65 + ch]; } }
        float Pq[4], Sq[4];
#pragma unroll
        for (int c4 = 0; c4 < 4; ++c4) { float P = 1.f, S = 0.f;
#pragma unroll
            for (int rr = 0; rr < 4; ++rr) { const int r = dir == 0 ? rr : 3 - rr; S = a[c4][r] * S + bt[c4][r]; P *= a[c4][r]; }
            Pq[c4] = P; Sq[c4] = S; }
        float Pin[4], Sin[4];
#pragma unroll
        for (int c4 = 0; c4 < 4; ++c4) { float P = 1.f, S = 0.f, Pw = 1.f, Sw = 0.f;
#pragma unroll
            for (int kk = 0; kk < 4; ++kk) { const int k = dir == 0 ? kk : 3 - kk;
                const float pk = __shfl(Pq[c4], n + 16 * k), sk = __shfl(Sq[c4], n + 16 * k);
                const bool before = dir == 0 ? (k < q) : (k > q);
                if (before) { S = pk * S + sk; P *= pk; }
                Sw = pk * Sw + sk; Pw *= pk; }
            Pin[c4] = P; Sin[c4] = S;
            if (!PASS2 && q == 0) p.SUM16[((size_t)((b * 8 + nb) * LRU_NCOL + col) * 2 + dir) * 64 + c4 * 16 + n] = (f32x2_t){Pw, Sw}; }
        if (PASS2) {
            const LAS float* CARRYL = (const LAS float*)(lds + LRU_CARRY);
#pragma unroll
            for (int c4 = 0; c4 < 4; ++c4) { float h = CARRYL[(dir * 32 + ci) * 64 + c4 * 16 + n];
                h = Pin[c4] * h + Sin[c4];
#pragma unroll
                for (int rr = 0; rr < 4; ++rr) { const int r = dir == 0 ? rr : 3 - rr; h = a[c4][r] * h + bt[c4][r]; hsum[c4][r] += h; } }
        }
    }
    if (PASS2) {
        asm volatile("s_waitcnt lgkmcnt(0)" ::: "memory");
#pragma unroll
        for (int c4 = 0; c4 < 4; ++c4)
#pragma unroll
            for (int r = 0; r < 4; ++r) XW[(4 * q + r) * 65 + c4 * 16 + n] = hsum[c4][r];
        asm volatile("s_waitcnt lgkmcnt(0)" ::: "memory");
        const int tk = lane >> 2, cg = lane & 3; const size_t row = (size_t)(s0 + t0 + tk);
        const bf16_t* gp = p.P1 + row * N1 + 512 + nb * 64 + cg * 16;
        const v4u g0 = *(const v4u*)gp, g1 = *(const v4u*)(gp + 8);
        float y[16];
#pragma unroll
        for (int e = 0; e < 16; ++e) y[e] = XW[tk * 65 + cg * 16 + e];
        v4u o0, o1;
        o0.x = pk2(y[0] * silu_f(bflo(g0.x)), y[1] * silu_f(bfhi(g0.x))); o0.y = pk2(y[2] * silu_f(bflo(g0.y)), y[3] * silu_f(bfhi(g0.y)));
        o0.z = pk2(y[4] * silu_f(bflo(g0.z)), y[5] * silu_f(bfhi(g0.z))); o0.w = pk2(y[6] * silu_f(bflo(g0.w)), y[7] * silu_f(bfhi(g0.w)));
        o1.x = pk2(y[8] * silu_f(bflo(g1.x)), y[9] * silu_f(bfhi(g1.x))); o1.y = pk2(y[10] * silu_f(bflo(g1.y)), y[11] * silu_f(bfhi(g1.y)));
        o1.z = pk2(y[12] * silu_f(bflo(g1.z)), y[13] * silu_f(bfhi(g1.z))); o1.w = pk2(y[14] * silu_f(bflo(g1.w)), y[15] * silu_f(bfhi(g1.w)));
        bf16_t* yp = p.YMIX + row * DM + nb * 64 + cg * 16;
        *(v4u*)yp = o0; *(v4u*)(yp + 8) = o1;
    }
    asm volatile("s_waitcnt lgkmcnt(0)" ::: "memory");
}

DI int lru_order_col(int dir, int k) { return dir == 0 ? k : (k < 16 ? 15 - k : 16 + (271 - k)); }

DI void lru_block(int blk, bool pass2, const LruP& p, LAS unsigned char* lds, int tid, int wave, int lane) {
    const int nb = blk & 7, b = (blk >> 3) & 3, cr = blk >> 5;
    lru_setup(nb, p, lds, tid);
    if (!pass2) {
        for (int i = wave; i < 34; i += NWAVES) { const int col = i < 32 ? 16 + 32 * cr + i : 2 * cr + (i - 32); lru_micro<false>(b, col, nb, 0, p, lds, wave, lane); }
        return;
    }
    LAS float* CARRYL = (LAS float*)(lds + LRU_CARRY); LAS f32x2_t* FOLD = (LAS f32x2_t*)(lds + LRU_FOLD);
    const int chain = tid & 127, part = tid >> 7, dir = chain >> 6, ch = chain & 63;
    const f32x2_t* SB = p.SUM16 + (size_t)(b * 8 + nb) * LRU_NCOL * 128 + dir * 64 + ch;
    const int kfirst = dir == 0 ? 16 + 32 * cr : 240 - 32 * cr;
    { const int k0 = (kfirst * part) >> 2, k1 = (kfirst * (part + 1)) >> 2;
      float P = 1.f, S = 0.f;
#pragma unroll 4
      for (int k = k0; k < k1; ++k) { const f32x2_t s = SB[(size_t)lru_order_col(dir, k) * 128]; S = s[0] * S + s[1]; P *= s[0]; }
      FOLD[part * 128 + chain] = (f32x2_t){P, S}; }
    __syncthreads();
    if (part == 0) { float S = 0.f;
#pragma unroll
        for (int pp = 0; pp < 4; ++pp) { const f32x2_t s = FOLD[pp * 128 + chain]; S = s[0] * S + s[1]; }
        for (int i = 0; i < 32; ++i) { const int col = lru_order_col(dir, kfirst + i), ci = col - (16 + 32 * cr);
            CARRYL[(dir * 32 + ci) * 64 + ch] = S; const f32x2_t s = SB[(size_t)col * 128]; S = s[0] * S + s[1]; } }
    __syncthreads();
    for (int i = wave; i < 32; i += NWAVES) lru_micro<true>(b, 16 + 32 * cr + i, nb, i, p, lds, wave, lane);
}

DI float row16_sum(float v) {
    v += __builtin_bit_cast(float, __builtin_amdgcn_update_dpp(0, __builtin_bit_cast(int, v), 0xB1, 0xf, 0xf, false));
    v += __builtin_bit_cast(float, __builtin_amdgcn_update_dpp(0, __builtin_bit_cast(int, v), 0x4E, 0xf, 0xf, false));
    v += __builtin_bit_cast(float, __builtin_amdgcn_update_dpp(0, __builtin_bit_cast(int, v), 0x141, 0xf, 0xf, false));
    v += __builtin_bit_cast(float, __builtin_amdgcn_update_dpp(0, __builtin_bit_cast(int, v), 0x140, 0xf, 0xf, false));
    return v;
}
DI void qkprep_row(int r, const bf16_t* P1, const float* qn, const float* kn, const float* ROPE, bf16_t* QP, bf16_t* KP, int lane) {
    const int b = row_batch(r); const bool lat = r < NLAT; const int t = r & 4095, l16 = lane & 15, hh = lane >> 4;
    f32x4_t cs = {1.f, 0.f, 1.f, 0.f};
    if (lat) cs = *(const f32x4_t*)(ROPE + ((size_t)t * 32 + 2 * l16) * 2);
    const f32x4_t wq = *(const f32x4_t*)(qn + 4 * l16), wk = *(const f32x4_t*)(kn + 4 * l16);
#pragma unroll
    for (int hg = 0; hg < 3; ++hg) {
        if (hg < 2 && !lat) continue;
        const int slot = hg < 2 ? hg * 4 + hh : 8 + (hh & 1);
        const int col0 = slot < 8 ? 1024 + slot * 64 : 1536 + (slot - 8) * 64;
        const v2u xx = *(const v2u*)(P1 + (size_t)r * N1 + col0 + 4 * l16);
        float x[4] = {bflo(xx.x), bfhi(xx.x), bflo(xx.y), bfhi(xx.y)};
        const float ss = row16_sum(x[0] * x[0] + x[1] * x[1] + x[2] * x[2] + x[3] * x[3]);
        const float rinv = rsqrtf(ss * (1.f / 64.f) + EPSN);
        const f32x4_t w = hg < 2 ? wq : wk;
#pragma unroll
        for (int e = 0; e < 4; ++e) x[e] *= rinv * w[e];
        const float y0 = x[0] * cs[0] - x[1] * cs[1], y1 = x[0] * cs[1] + x[1] * cs[0], y2 = x[2] * cs[2] - x[3] * cs[3], y3 = x[2] * cs[3] + x[3] * cs[2];
        if (hg < 2) { const float sc = 0.125f * LOG2E; v2u o; o.x = pk2(y0 * sc, y1 * sc); o.y = pk2(y2 * sc, y3 * sc); *(v2u*)(QP + ((size_t)(b * 8 + slot) * SEQ + t) * 64 + 4 * l16) = o; }
        else if (hh < 2) { v2u o; o.x = pk2(y0, y1); o.y = pk2(y2, y3); *(v2u*)(KP + ((size_t)(b * 2 + (slot - 8)) * POSN + row_pos(r)) * 64 + 4 * l16) = o; }
    }
}

constexpr size_t WS_CARRY0 = 246 * MiB;
constexpr int S5_NCOL = 272;

DI void s5_lambar_pow(double lre, double lim, double dt, int e, double& pr, double& pi) { const double mag = exp(lre * dt * e), ang = lim * dt * e; pr = mag * cos(ang); pi = mag * sin(ang); }
typedef double f64x2_t __attribute__((ext_vector_type(2)));
DI void s5_tables_block(int item, const float* lam_re, const float* lam_im, const float* log_dt, const float* b_re, const float* b_im, const float* c_re, const float* c_im,
                        bf16_t* W16, bf16_t* WC, bf16_t* KT, float* L16, LAS unsigned char* lds, int tid) {
    const int part = item & 3, gd = item >> 2, g = gd >> 1, dir = gd & 1, gi = dir * 32 + g;
    LAS f64x2_t* POW = (LAS f64x2_t*)lds;
    LAS f64x2_t* PC = POW + 17 * 64;
    __syncthreads();
    if (tid < 64) { const int p = tid;
        const double dt = exp((double)log_dt[gi]), lre = lam_re[gi * 64 + p], lim = lam_im[gi * 64 + p];
        double l1r, l1i; s5_lambar_pow(lre, lim, dt, 1, l1r, l1i);
        const double nr = l1r - 1.0, ni = l1i, den = lre * lre + lim * lim, cfr = (nr * lre + ni * lim) / den, cfi = (ni * lre - nr * lim) / den;
        double pr = 1.0, pi = 0.0;
        for (int e = 0; e <= 16; ++e) { POW[e * 64 + p] = (f64x2_t){pr, pi}; PC[e * 64 + p] = (f64x2_t){pr * cfr - pi * cfi, pr * cfi + pi * cfr};
            if (e == 16 && part == 0) { L16[((g * 2 + dir) * 64 + p) * 2] = (float)pr; L16[((g * 2 + dir) * 64 + p) * 2 + 1] = (float)pi; }
            const double tr = pr * l1r - pi * l1i, ti = pr * l1i + pi * l1r; pr = tr; pi = ti; } }
    __syncthreads();
    for (int idx = tid; idx < 32 * 256; idx += NTHREADS) { const int row = 32 * part + (idx >> 8), k = idx & 255, p = row >> 1, c = row & 1, tp = k >> 4, hi = k & 15;
        const f64x2_t z = PC[(dir == 0 ? 15 - tp : tp) * 64 + p]; const double br = b_re[(gi * 64 + p) * 16 + hi], bi = b_im[(gi * 64 + p) * 16 + hi];
        W16[(size_t)(gd * 128 + row) * 256 + k] = f2bf((float)(c == 0 ? z[0] * br - z[1] * bi : z[0] * bi + z[1] * br)); }
    for (int idx = tid; idx < 64 * 128; idx += NTHREADS) { const int row = 64 * part + (idx >> 7), k = idx & 127, p = k >> 1, c = k & 1, t = row >> 4, ho = row & 15;
        const f64x2_t z = POW[((dir == 0 ? t : 15 - t) + 1) * 64 + p]; const double cr = c_re[(gi * 16 + ho) * 64 + p], ci = c_im[(gi * 16 + ho) * 64 + p];
        WC[(size_t)(gd * 256 + row) * 128 + k] = f2bf((float)(c == 0 ? cr * z[0] - ci * z[1] : -(cr * z[1] + ci * z[0]))); }
    for (int idx = tid; idx < 1024; idx += NTHREADS) { const int e = 1024 * part + idx, tau = e >> 8, ho = (e >> 4) & 15, hi = e & 15;
        double acc = 0.0;
#pragma unroll 4
        for (int p = 0; p < 64; ++p) { const f64x2_t z = PC[tau * 64 + p]; const double cr = c_re[(gi * 16 + ho) * 64 + p], ci = c_im[(gi * 16 + ho) * 64 + p];
            const double ar = cr * z[0] - ci * z[1], ai = cr * z[1] + ci * z[0];
            acc += ar * (double)b_re[(gi * 64 + p) * 16 + hi] - ai * (double)b_im[(gi * 64 + p) * 16 + hi]; }
        KT[(size_t)gd * 4096 + e] = f2bf((float)acc); }
}

DI int s5_tile_row0(int b, int s) { return s == 0 ? NLAT + b * LC : b * SEQ + (s - 1) * 256; }
DI void cmul(float ar, float ai, float br, float bi, float& cr, float& ci) { cr = ar * br - ai * bi; ci = ar * bi + ai * br; }

DI void s5_scan_unit(int cu, int m, const bf16_t* UG, const bf16_t* W16, const float* L16, bf16_t* CARRY0, bf16_t* CARRY1, int lane) {
    const int dir = cu & 1, b = (cu >> 1) & 3, g = cu >> 3;
    const int n = lane & 15, q = lane >> 4;
    bf16x8_t wf[8];
#pragma unroll
    for (int ks = 0; ks < 8; ++ks) wf[ks] = *(const bf16x8_t*)(W16 + ((size_t)(g * 2 + dir) * 128 + m * 16 + n) * 256 + 32 * ks + 8 * q);
    float Lr[2][5], Li[2][5];
    float Lnr[2], Lni[2];
    float cr[2], ci[2];
#pragma unroll
    for (int st = 0; st < 2; ++st) { const int p = 8 * m + 2 * q + st;
        Lr[st][0] = L16[((g * 2 + dir) * 64 + p) * 2]; Li[st][0] = L16[((g * 2 + dir) * 64 + p) * 2 + 1];
#pragma unroll
        for (int k = 1; k < 5; ++k) cmul(Lr[st][k - 1], Li[st][k - 1], Lr[st][k - 1], Li[st][k - 1], Lr[st][k], Li[st][k]);
        float rr = 1.f, ri = 0.f;
#pragma unroll
        for (int k = 0; k < 5; ++k) if ((n + 1) & (1 << k)) { float tr, ti; cmul(rr, ri, Lr[st][k], Li[st][k], tr, ti); rr = tr; ri = ti; }
        Lnr[st] = rr; Lni[st] = ri; cr[st] = 0.f; ci[st] = 0.f; }
    bf16_t* CARRY = (dir == 0 ? CARRY0 : CARRY1) + (size_t)(b * 32 + g) * S5_NCOL * 128;
    const int jcol = dir == 0 ? n : 15 - n;
    bf16x8_t un[8];
    { const bf16_t* ub = UG + ((size_t)g * MROWS + s5_tile_row0(b, 0) + jcol * 16 + (q >> 1)) * 16 + 8 * (q & 1);
#pragma unroll
      for (int ks = 0; ks < 8; ++ks) un[ks] = *(const bf16x8_t*)(ub + (2 * ks) * 16); }
#pragma unroll 1
    for (int it = 0; it < 17; ++it) {
        const int s = it == 0 ? 0 : (dir == 0 ? it : 17 - it);
        bf16x8_t uf[8];
#pragma unroll
        for (int ks = 0; ks < 8; ++ks) uf[ks] = un[ks];
        if (it + 1 < 17) { const int sn = dir == 0 ? it + 1 : 16 - it;
            const bf16_t* ub = UG + ((size_t)g * MROWS + s5_tile_row0(b, sn) + jcol * 16 + (q >> 1)) * 16 + 8 * (q & 1);
#pragma unroll
            for (int ks = 0; ks < 8; ++ks) un[ks] = *(const bf16x8_t*)(ub + (2 * ks) * 16); }
        f32x4_t acc = {0.f, 0.f, 0.f, 0.f};
#pragma unroll
        for (int ks = 0; ks < 8; ++ks) acc = __builtin_amdgcn_mfma_f32_16x16x32_bf16(wf[ks], uf[ks], acc, 0, 0, 0);
        float hin[4];
#pragma unroll
        for (int st = 0; st < 2; ++st) {
            float xr = acc[2 * st], xi = acc[2 * st + 1];
#pragma unroll
            for (int k = 0; k < 4; ++k) { const int d = 1 << k; const float yr = __shfl_up(xr, d, 16), yi = __shfl_up(xi, d, 16);
                if (n >= d) { float tr, ti; cmul(Lr[st][k], Li[st][k], yr, yi, tr, ti); xr += tr; xi += ti; } }
            float tr, ti; cmul(Lnr[st], Lni[st], cr[st], ci[st], tr, ti);
            const float Hr = xr + tr, Hi = xi + ti;
            const float pr = __shfl_up(Hr, 1, 16), pi = __shfl_up(Hi, 1, 16);
            hin[2 * st] = n == 0 ? cr[st] : pr; hin[2 * st + 1] = n == 0 ? ci[st] : pi;
            cr[st] = __shfl(Hr, (lane & 48) | 15); ci[st] = __shfl(Hi, (lane & 48) | 15);
        }
        v2u w; w.x = pk2(hin[0], hin[1]); w.y = pk2(hin[2], hin[3]);
        *(v2u*)(CARRY + (size_t)(s * 16 + jcol) * 128 + m * 16 + 4 * q) = w;
    }
}

DI void s5_load_wc(bf16x8_t (&wc)[2][2][4], int g, const bf16_t* WC, int wave, int lane) {
    const int n = lane & 15, q = lane >> 4;
#pragma unroll
    for (int m2 = 0; m2 < 2; ++m2)
#pragma unroll
        for (int dir = 0; dir < 2; ++dir)
#pragma unroll
            for (int ks = 0; ks < 4; ++ks) wc[m2][dir][ks] = *(const bf16x8_t*)(WC + ((size_t)(g * 2 + dir) * 256 + (2 * wave + m2) * 16 + n) * 128 + 8 * q + 32 * ks);
}
DI void s5_out_item(int g, int b, int s, const bf16_t* UG, const bf16x8_t (&wc)[2][2][4], const bf16_t* CARRY0, const bf16_t* CARRY1, const float* dsk, bf16_t* YPRE, LAS unsigned char* lds, int wave, int lane) {
    const int n = lane & 15, q = lane >> 4;
    const int row0 = s5_tile_row0(b, s);
    const bf16_t* ub = UG + ((size_t)g * MROWS + row0 + n * 16 + (q >> 1)) * 16 + 8 * (q & 1);
    bf16x8_t uf[8];
#pragma unroll
    for (int ks = 0; ks < 8; ++ks) uf[ks] = *(const bf16x8_t*)(ub + (2 * ks) * 16);
    bf16x8_t cf[2][4];
#pragma unroll
    for (int dir = 0; dir < 2; ++dir)
#pragma unroll
        for (int ks = 0; ks < 4; ++ks) cf[dir][ks] = *(const bf16x8_t*)((dir == 0 ? CARRY0 : CARRY1) + ((size_t)(b * 32 + g) * S5_NCOL + s * 16 + n) * 128 + 32 * ks + 8 * q);
    v2u uu[2];
#pragma unroll
    for (int m2 = 0; m2 < 2; ++m2) uu[m2] = *(const v2u*)(UG + ((size_t)g * MROWS + row0 + n * 16 + 2 * wave + m2) * 16 + 4 * q);
    const f32x4_t dd = *(const f32x4_t*)(dsk + g * 16 + 4 * q);
#pragma unroll
    for (int m2 = 0; m2 < 2; ++m2) {
        const int mt = 2 * wave + m2;
        bf16x8_t ta[2][8];
#pragma unroll
        for (int dir = 0; dir < 2; ++dir)
#pragma unroll
            for (int ks = 0; ks < 8; ++ks) { const int tp = 2 * ks + (q >> 1), tau = dir == 0 ? mt - tp : tp - mt;
                const int off = tau >= 0 ? (((dir * 16 + tau) * 16 + n) * 32 + 16 * (q & 1)) : 16384;
                ta[dir][ks] = *(const LAS bf16x8_t*)(lds + off); }
        f32x4_t acc = {0.f, 0.f, 0.f, 0.f};
#pragma unroll
        for (int dir = 0; dir < 2; ++dir) {
#pragma unroll
            for (int ks = 0; ks < 4; ++ks) acc = __builtin_amdgcn_mfma_f32_16x16x32_bf16(wc[m2][dir][ks], cf[dir][ks], acc, 0, 0, 0);
#pragma unroll
            for (int ks = 0; ks < 8; ++ks) acc = __builtin_amdgcn_mfma_f32_16x16x32_bf16(ta[dir][ks], uf[ks], acc, 0, 0, 0);
        }
        const size_t tok = (size_t)(row0 + n * 16 + mt);
        const float y0 = gelu_fast(acc[0] + dd[0] * bflo(uu[m2].x)), y1 = gelu_fast(acc[1] + dd[1] * bfhi(uu[m2].x)), y2 = gelu_fast(acc[2] + dd[2] * bflo(uu[m2].y)), y3 = gelu_fast(acc[3] + dd[3] * bfhi(uu[m2].y));
        v2u w; w.x = pk2(y0, y1); w.y = pk2(y2, y3);
        *(v2u*)(YPRE + ((size_t)g * MROWS + tok) * 16 + 4 * q) = w;
    }
}

#include <hip/hip_bf16.h>
namespace gqa_body {
using bf16=__hip_bfloat16;
using bf16x8=__attribute__((ext_vector_type(8)))short;
using s16x4=__attribute__((ext_vector_type(4)))short;
using f32x16=__attribute__((ext_vector_type(16)))float;
using u32x4=__attribute__((ext_vector_type(4)))unsigned;
constexpr int NHEAD=8,SEQQ=4096,SKV=4352,D=64,QPITCH=64,KPITCH=64,VPITCH=64,OPITCH=1024,GPITCH=2304;
constexpr int NW=8,QBLK=32,QB=QBLK*NW,KVBLK=64,NQB=SEQQ/QB,NTILES=SKV/KVBLK;
constexpr int ATTN_UNIT_ROWS=QB;
__device__ __forceinline__ int crow(int r,int hi){return (r&3)+8*(r>>2)+4*hi;}
#define SBAR() __builtin_amdgcn_sched_barrier(0)
constexpr int NSLOT=3, SLOTB=8192;
constexpr int LDS_K=0, LDS_V=NSLOT*SLOTB, LDS_WS=2*NSLOT*SLOTB, LDS_OST=LDS_WS+NW*64*4, LDS_BYTES=LDS_OST+NW*4096;
constexpr float C2=0.125f*1.4426950408889634f;
__device__ __forceinline__ void glds16(const void*gsrc,unsigned lds_dst){unsigned keep;
  asm volatile("s_mov_b32 %0, m0\n\ts_mov_b32 m0, %2\n\ts_nop 0\n\tglobal_load_lds_dwordx4 %1, off\n\ts_mov_b32 m0, %0":"=&s"(keep):"v"(gsrc),"s"(lds_dst):"memory");}
__device__ __forceinline__ float max3f(float a,float b,float c){float r;asm("v_max3_f32 %0, %1, %2, %3":"=v"(r):"v"(a),"v"(b),"v"(c));return r;}
__device__ __forceinline__ float max2f(float a,float b){float r;asm("v_max_f32_e32 %0, %1, %2":"=v"(r):"v"(a),"v"(b));return r;}
__device__ __forceinline__ float fadd_s(float a,float b){float r;asm("v_add_f32_e32 %0, %1, %2":"=v"(r):"v"(a),"v"(b));return r;}
__device__ __forceinline__ float fsub_s(float a,float b){float r;asm("v_sub_f32_e32 %0, %1, %2":"=v"(r):"v"(a),"v"(b));return r;}
typedef float f32x2_t __attribute__((ext_vector_type(2))); typedef __bf16 bf16x2_t __attribute__((ext_vector_type(2)));
__device__ __forceinline__ unsigned cvtpk_s(float lo,float hi){f32x2_t v={lo,hi};bf16x2_t b=__builtin_convertvector(v,bf16x2_t);return __builtin_bit_cast(unsigned,b);}
#define WAIT_BAR(N) asm volatile("s_waitcnt vmcnt(" #N ") lgkmcnt(0)\n\ts_barrier":::"memory")

__device__ __forceinline__ void qkt(f32x16&p0,f32x16&p1,const char*Kslot,const bf16x8*qr,const f32x16&negm,int r32,int hi){
  const char*kb=Kslot+hi*1024+r32*16;
  #pragma unroll
  for(int d0=0;d0<4;++d0){
    const bf16x8 b0=*reinterpret_cast<const bf16x8*>(kb+d0*2048);
    const bf16x8 b1=*reinterpret_cast<const bf16x8*>(kb+d0*2048+512);
    if(d0==0){p0=__builtin_amdgcn_mfma_f32_32x32x16_bf16(b0,qr[0],negm,0,0,0);p1=__builtin_amdgcn_mfma_f32_32x32x16_bf16(b1,qr[0],negm,0,0,0);}
    else{p0=__builtin_amdgcn_mfma_f32_32x32x16_bf16(b0,qr[d0],p0,0,0,0);p1=__builtin_amdgcn_mfma_f32_32x32x16_bf16(b1,qr[d0],p1,0,0,0);}}
}
typedef __attribute__((address_space(3))) const char* lds_cptr;
typedef short v4i16_t __attribute__((ext_vector_type(4)));
__device__ __forceinline__ void kload8(bf16x8*kf,lds_cptr kp){
  kf[0]=*(const __attribute__((address_space(3))) bf16x8*)(kp);      kf[1]=*(const __attribute__((address_space(3))) bf16x8*)(kp+512);
  kf[2]=*(const __attribute__((address_space(3))) bf16x8*)(kp+2048); kf[3]=*(const __attribute__((address_space(3))) bf16x8*)(kp+2560);
  kf[4]=*(const __attribute__((address_space(3))) bf16x8*)(kp+4096); kf[5]=*(const __attribute__((address_space(3))) bf16x8*)(kp+4608);
  kf[6]=*(const __attribute__((address_space(3))) bf16x8*)(kp+6144); kf[7]=*(const __attribute__((address_space(3))) bf16x8*)(kp+6656);
}
__device__ __forceinline__ void kload2(bf16x8*kf,lds_cptr kp,int j){ kf[2*j]=*(const __attribute__((address_space(3))) bf16x8*)(kp+j*2048); kf[2*j+1]=*(const __attribute__((address_space(3))) bf16x8*)(kp+j*2048+512); }
__device__ __forceinline__ s16x4 vtr(lds_cptr p){ return __builtin_bit_cast(s16x4,__builtin_amdgcn_ds_read_tr16_b64_v4i16((__attribute__((address_space(3))) v4i16_t*)p)); }
__device__ __forceinline__ float rowmax(const f32x16&p0,const f32x16&p1){
  float a=max3f(p0[0],p0[1],p1[0]),b=max3f(p0[2],p0[3],p1[1]);a=max3f(a,p1[2],p1[3]);
  #pragma unroll
  for(int r=4;r<16;r+=4){a=max3f(a,p0[r],p0[r+1]);b=max3f(b,p0[r+2],p0[r+3]);a=max3f(a,p1[r],p1[r+1]);b=max3f(b,p1[r+2],p1[r+3]);}
  const float m=max2f(a,b);
  auto rr=__builtin_amdgcn_permlane32_swap(__float_as_uint(m),__float_as_uint(m),false,false);
  return max2f(__uint_as_float(rr[0]),__uint_as_float(rr[1]));
}
__device__ __forceinline__ void pv(f32x16*o,int vb,bf16x8 pa0,bf16x8 pa1,bf16x8 pa2,bf16x8 pa3){
  #pragma unroll
  for(int d0=0;d0<2;++d0){s16x4 lo[4],hi[4];
    #pragma unroll
    for(int ks=0;ks<4;++ks){
      asm volatile("ds_read_b64_tr_b16 %0,%1 offset:%c2":"=&v"(lo[ks]):"v"(vb),"i"(d0*4096+ks*1024):"memory");
      asm volatile("ds_read_b64_tr_b16 %0,%1 offset:%c2":"=&v"(hi[ks]):"v"(vb),"i"(d0*4096+ks*1024+512):"memory");}
    asm volatile("s_waitcnt lgkmcnt(0)":::"memory");SBAR();
    #define PK(k) (bf16x8){lo[k][0],lo[k][1],lo[k][2],lo[k][3],hi[k][0],hi[k][1],hi[k][2],hi[k][3]}
    o[d0]=__builtin_amdgcn_mfma_f32_32x32x16_bf16(pa0,PK(0),o[d0],0,0,0);
    o[d0]=__builtin_amdgcn_mfma_f32_32x32x16_bf16(pa1,PK(1),o[d0],0,0,0);
    o[d0]=__builtin_amdgcn_mfma_f32_32x32x16_bf16(pa2,PK(2),o[d0],0,0,0);
    o[d0]=__builtin_amdgcn_mfma_f32_32x32x16_bf16(pa3,PK(3),o[d0],0,0,0);
    #undef PK
  }
}

#ifndef ATTN_STORE16
#define ATTN_STORE16(p,v) (*(u32x4*)(p)=(v))
#endif
template<int THRL> __device__ __forceinline__ void attn_unit(int b,int h,int qb,const bf16*Q,const bf16*__restrict__ K,const bf16*__restrict__ V,bf16*O,const bf16*Gt,char*shm){
  const int tid=threadIdx.x,lane=tid&63,r32=lane&31,hi=lane>>5; const int wid=__builtin_amdgcn_readfirstlane(tid>>6);
  const int q0=qb*QB;
  const bf16*Qw=Q+((long)(b*NHEAD+h)*SEQQ+q0+wid*QBLK)*QPITCH;
  const bf16*Kh=K+(long)(b*2+(h>>2))*SKV*KPITCH,*Vh=V+(long)(b*2+(h>>2))*SKV*VPITCH;
  const unsigned lds0=(unsigned)(uintptr_t)shm;
  float*wsf=(float*)(shm+LDS_WS)+wid*64;
  const bf16*ksrc=Kh+(long)lane*KPITCH+wid*8;
  const bf16*vsrc=Vh+(long)(16*(wid&3)+(lane>>2))*VPITCH+(wid>>2)*32+(lane&3)*8;
  const unsigned kdst=lds0+LDS_K+wid*1024, vdst=lds0+LDS_V+wid*1024;
  #define DMA_K(t,slot) glds16(ksrc+(long)(t)*KVBLK*KPITCH,(unsigned)__builtin_amdgcn_readfirstlane(kdst+(slot)))
  #define DMA_V(t,slot) glds16(vsrc+(long)(t)*KVBLK*VPITCH,(unsigned)__builtin_amdgcn_readfirstlane(vdst+(slot)))
  const int vb0=(int)(lds0+LDS_V)+((lane>>4)&1)*32+(lane&3)*8+(4*hi+((lane&15)>>2))*64;
  const char*Kbase=shm+LDS_K; bf16x8 kf[8];
  const lds_cptr shm3=(lds_cptr)shm; const lds_cptr kp0=shm3+LDS_K+hi*1024+r32*16; const lds_cptr vp0=shm3+LDS_V+((lane>>4)&1)*32+(lane&3)*8+(4*hi+((lane&15)>>2))*64;
  constexpr int NT=NTILES;
  DMA_K(0,0);DMA_V(0,0);DMA_K(1,SLOTB);
  bf16x8 qr[4];
  #pragma unroll
  for(int d0=0;d0<4;++d0)qr[d0]=*reinterpret_cast<const bf16x8*>(&Qw[(long)r32*QPITCH+d0*16+hi*8]);
  float mhat=0.f,l_reg=0.f;f32x16 o[2];o[0]=f32x16{};o[1]=f32x16{};f32x16 negm=f32x16{};asm volatile("":"+v"(negm));
  #define CMASK(P0,P1,t) do{}while(0)
  bool resc=false;
  #define START(P0,P1) do{ const float rm=rowmax(P0,P1); resc=false; \
    { const float dl=rm; mhat=fadd_s(mhat,dl); \
      _Pragma("unroll") for(int r=0;r<16;++r){P0[r]=fsub_s(P0[r],dl);P1[r]=fsub_s(P1[r],dl);} \
      _Pragma("unroll") for(int r=0;r<16;++r)negm[r]=-mhat; asm volatile("":"+v"(negm)); } \
    _Pragma("unroll") for(int r=0;r<16;++r)P0[r]=__builtin_amdgcn_exp2f(P0[r]); }while(0)
  #define RESC() do{ if(resc){ asm volatile("s_waitcnt lgkmcnt(0)":::"memory"); \
      _Pragma("unroll") for(int d_=0;d_<2;++d_) _Pragma("unroll") for(int r=0;r<16;++r)o[d_][r]*=wsf[crow(r,hi)]; } }while(0)
  f32x16 pA0,pA1,pB0,pB1;
  int sl_prev=0,sl_cur=0,sl_next=SLOTB;
  #define ROT() do{sl_prev=sl_cur;sl_cur=sl_next;sl_next=(sl_next==(NSLOT-1)*SLOTB)?0:sl_next+SLOTB;}while(0)
  DMA_K(2,2*SLOTB);
  WAIT_BAR(3);
  qkt(pA0,pA1,Kbase,qr,negm,r32,hi);asm volatile("s_nop 15\n\ts_nop 7":"+v"(pA0),"+v"(pA1));CMASK(pA0,pA1,0);
  START(pA0,pA1);
  _Pragma("unroll") for(int r=0;r<16;++r)pA1[r]=__builtin_amdgcn_exp2f(pA1[r]);
  WAIT_BAR(0);
  DMA_K(3,0);DMA_V(1,SLOTB);
  ROT();
  kload8(kf,kp0+sl_cur);
  WAIT_BAR(2);
  s16x4 vlo[8],vhi[8]; u32x4 pw0,pw1,pw2,pw3;
  #define PKW(P,B) cvtpk_s(P[B],P[B+1])
  #define PAF(k) __builtin_bit_cast(bf16x8,pw##k)
  #define VFR(i) (bf16x8){vlo[i][0],vlo[i][1],vlo[i][2],vlo[i][3],vhi[i][0],vhi[i][1],vhi[i][2],vhi[i][3]}
  #define PIN(x) asm volatile("":"+v"(x))
  #define MX3(a,b,c) __builtin_fmaxf(__builtin_fmaxf((a),(b)),(c))
  #define GAPA(MF,A0,A1,A2,A3,W0,W1,PW) do{ MF; sacc+=A0; sacc+=A1; sacc+=A2; sacc+=A3; PIN(sacc); W0; W1; PIN(PW); SBAR(); }while(0)
  #define EX(v) __builtin_amdgcn_exp2f(v)
  #define GAPB(MF,X,B) do{ MF; X[B]=EX(X[B]); X[B+1]=EX(X[B+1]); X[B+2]=EX(X[B+2]); X[B+3]=EX(X[B+3]); PIN(X); SBAR(); }while(0)
  #define VRD(i) do{ vlo[i]=vtr(vp_+(((i)>>2)*4096+((i)&3)*1024)); vhi[i]=vtr(vp_+(((i)>>2)*4096+((i)&3)*1024+512)); }while(0)
  #define KRD(G,j) do{ if(G){ kload2(kf,kp0+sl_next,j); SBAR(); } }while(0)
  #define STEP(C0,C1,P0,P1,t,GK,GV,GL) do{ SBAR(); \
    const lds_cptr vp_=vp0+sl_prev; \
    VRD(0); SBAR(); float sacc=(P0[0]+P0[1]); \
    GAPA(C0=__builtin_amdgcn_mfma_f32_32x32x16_bf16(kf[0],qr[0],negm,0,0,0), P0[2],P0[3],P0[4],P0[5],     pw0[0]=PKW(P0,0), pw0[1]=PKW(P0,2), pw0); \
    VRD(4); SBAR(); GAPA(C1=__builtin_amdgcn_mfma_f32_32x32x16_bf16(kf[1],qr[0],negm,0,0,0), P0[6],P0[7],P0[8],P0[9],     pw0[2]=PKW(P0,4), pw0[3]=PKW(P0,6), pw0); \
    VRD(1); SBAR(); GAPA(C0=__builtin_amdgcn_mfma_f32_32x32x16_bf16(kf[2],qr[1],C0,0,0,0),   P0[10],P0[11],P0[12],P0[13], pw1[0]=PKW(P0,8), pw1[1]=PKW(P0,10), pw1); \
    VRD(5); SBAR(); GAPA(C1=__builtin_amdgcn_mfma_f32_32x32x16_bf16(kf[3],qr[1],C1,0,0,0),   P0[14],P0[15],P1[0],P1[1],   pw1[2]=PKW(P0,12),pw1[3]=PKW(P0,14), pw1); \
    VRD(2); SBAR(); GAPA(C0=__builtin_amdgcn_mfma_f32_32x32x16_bf16(kf[4],qr[2],C0,0,0,0),   P1[2],P1[3],P1[4],P1[5],     pw2[0]=PKW(P1,0), pw2[1]=PKW(P1,2), pw2); \
    VRD(6); SBAR(); GAPA(C1=__builtin_amdgcn_mfma_f32_32x32x16_bf16(kf[5],qr[2],C1,0,0,0),   P1[6],P1[7],P1[8],P1[9],     pw2[2]=PKW(P1,4), pw2[3]=PKW(P1,6), pw2); \
    VRD(3); SBAR(); GAPA(C0=__builtin_amdgcn_mfma_f32_32x32x16_bf16(kf[6],qr[3],C0,0,0,0),   P1[10],P1[11],P1[12],P1[13], pw3[0]=PKW(P1,8), pw3[1]=PKW(P1,10), pw3); \
    VRD(7); SBAR(); GAPA(C1=__builtin_amdgcn_mfma_f32_32x32x16_bf16(kf[7],qr[3],C1,0,0,0),   P1[14],P1[15],0.f,0.f,       pw3[2]=PKW(P1,12),pw3[3]=PKW(P1,14), pw3); \
    l_reg+=sacc; \
    if(GK){DMA_K((t)+3,sl_cur);} if(GV){DMA_V((t)+1,sl_next);} \
    CMASK(C0,C1,t); \
    { float a=MX3(C0[0],C0[1],C1[0]),b=MX3(C0[2],C0[3],C1[1]); a=MX3(a,C1[2],C1[3]); \
      _Pragma("unroll") for(int r=4;r<16;r+=4){a=MX3(a,C0[r],C0[r+1]);b=MX3(b,C0[r+2],C0[r+3]);a=MX3(a,C1[r],C1[r+1]);b=MX3(b,C1[r+2],C1[r+3]);} \
      float rm=__builtin_fmaxf(a,b); { auto rr=__builtin_amdgcn_permlane32_swap(__float_as_uint(rm),__float_as_uint(rm),false,false); rm=__builtin_fmaxf(__uint_as_float(rr[0]),__uint_as_float(rr[1])); } \
      resc=false; \
      if(__builtin_expect(__any(rm>(float)THRL),0)){ const float dl=__builtin_fmaxf(rm,0.f); mhat+=dl; \
        _Pragma("unroll") for(int r=0;r<16;++r){C0[r]-=dl;C1[r]-=dl;} \
        _Pragma("unroll") for(int r=0;r<16;++r)negm[r]=-mhat; asm volatile("":"+v"(negm)); \
        const float f=__builtin_amdgcn_exp2f(-dl); l_reg*=f; if(hi==0)wsf[r32]=f; resc=true; } } \
    SBAR(); \
    GAPB(o[0]=__builtin_amdgcn_mfma_f32_32x32x16_bf16(PAF(0),VFR(0),o[0],0,0,0), C0,0); \
    GAPB(o[1]=__builtin_amdgcn_mfma_f32_32x32x16_bf16(PAF(0),VFR(4),o[1],0,0,0), C0,4); \
    KRD(GL,0); GAPB(o[0]=__builtin_amdgcn_mfma_f32_32x32x16_bf16(PAF(1),VFR(1),o[0],0,0,0), C0,8); \
    KRD(GL,1); GAPB(o[1]=__builtin_amdgcn_mfma_f32_32x32x16_bf16(PAF(1),VFR(5),o[1],0,0,0), C0,12); \
    KRD(GL,2); GAPB(o[0]=__builtin_amdgcn_mfma_f32_32x32x16_bf16(PAF(2),VFR(2),o[0],0,0,0), C1,0); \
    KRD(GL,3); GAPB(o[1]=__builtin_amdgcn_mfma_f32_32x32x16_bf16(PAF(2),VFR(6),o[1],0,0,0), C1,4); \
    GAPB(o[0]=__builtin_amdgcn_mfma_f32_32x32x16_bf16(PAF(3),VFR(3),o[0],0,0,0), C1,8); \
    GAPB(o[1]=__builtin_amdgcn_mfma_f32_32x32x16_bf16(PAF(3),VFR(7),o[1],0,0,0), C1,12); \
    }while(0)
  int t=1;
  #undef CMASK
  #define CMASK(P0,P1,t) do{}while(0)
  for(;t+5<NT;t+=2){
    STEP(pB0,pB1,pA0,pA1,t,true,true,true);     WAIT_BAR(2); RESC(); ROT();
    STEP(pA0,pA1,pB0,pB1,t+1,true,true,true);   WAIT_BAR(2); RESC(); ROT();
  }
  #undef CMASK
  #define CMASK(P0,P1,t) do{}while(0)
  #define ENDW(tt) do{ if((tt)+3<NT){WAIT_BAR(2);} else if((tt)+2<NT){WAIT_BAR(1);} else {WAIT_BAR(0);} }while(0)
  for(;t+1<NT;t+=2){
    STEP(pB0,pB1,pA0,pA1,t,(t+3<NT),(t+1<NT),(t+1<NT));       ENDW(t);   RESC(); ROT();
    STEP(pA0,pA1,pB0,pB1,t+1,(t+4<NT),(t+2<NT),(t+2<NT));     ENDW(t+1); RESC(); ROT();
  }
  STEP(pB0,pB1,pA0,pA1,NT-1,false,false,false); RESC();
  { float sacc=pB0[0]+pB0[1]; _Pragma("unroll") for(int r=2;r<16;++r)sacc+=pB0[r]; _Pragma("unroll") for(int r=0;r<16;++r)sacc+=pB1[r]; l_reg+=sacc;
    pw0=(u32x4){PKW(pB0,0),PKW(pB0,2),PKW(pB0,4),PKW(pB0,6)};pw1=(u32x4){PKW(pB0,8),PKW(pB0,10),PKW(pB0,12),PKW(pB0,14)};pw2=(u32x4){PKW(pB1,0),PKW(pB1,2),PKW(pB1,4),PKW(pB1,6)};pw3=(u32x4){PKW(pB1,8),PKW(pB1,10),PKW(pB1,12),PKW(pB1,14)};
    SBAR(); pv(o,vb0+sl_cur,PAF(0),PAF(1),PAF(2),PAF(3)); }
  #undef PKW
  #undef PAF
  #undef VFR
  #undef PIN
  #undef MX3
  #undef GAPA
  #undef GAPB
  #undef EX
  #undef VRD
  #undef KRD
  #undef STEP
  #undef ENDW
  {auto rr=__builtin_amdgcn_permlane32_swap(__float_as_uint(l_reg),__float_as_uint(l_reg),false,false);l_reg=__uint_as_float(rr[0])+__uint_as_float(rr[1]);}
  if(hi==0)wsf[32+r32]=l_reg;asm volatile("s_waitcnt lgkmcnt(0)":::"memory");
  float rli[16];
  #pragma unroll
  for(int r=0;r<16;++r)rli[r]=__builtin_amdgcn_rcpf(wsf[32+crow(r,hi)]);
  bf16*Ow=O+((long)b*SEQQ+q0+wid*QBLK)*OPITCH+h*D; const bf16*Gw=Gt+((long)b*SEQQ+q0+wid*QBLK)*GPITCH+h*D;
  { bf16*stg=(bf16*)(shm+LDS_OST)+wid*2048;
    #pragma unroll
    for(int r=0;r<16;++r){const int orow=crow(r,hi);
      #pragma unroll
      for(int d0=0;d0<2;++d0)stg[orow*64+d0*32+r32]=__float2bfloat16(o[d0][r]*rli[r]);}
    asm volatile("s_waitcnt lgkmcnt(0)":::"memory");
    #pragma unroll
    for(int i=0;i<4;++i){const int row=i*8+(lane>>3),ch=lane&7; const u32x4 v=*(const u32x4*)(stg+row*64+ch*8); const u32x4 gv=*(const u32x4*)(Gw+(long)row*GPITCH+ch*8); u32x4 w;
      w.x=pk2(bflo(v.x)*silu_f(bflo(gv.x)),bfhi(v.x)*silu_f(bfhi(gv.x))); w.y=pk2(bflo(v.y)*silu_f(bflo(gv.y)),bfhi(v.y)*silu_f(bfhi(gv.y)));
      w.z=pk2(bflo(v.z)*silu_f(bflo(gv.z)),bfhi(v.z)*silu_f(bfhi(gv.z))); w.w=pk2(bflo(v.w)*silu_f(bflo(gv.w)),bfhi(v.w)*silu_f(bfhi(gv.w)));
      ATTN_STORE16(Ow+(long)row*OPITCH+ch*8,w);} }
  asm volatile("s_waitcnt lgkmcnt(0)\n\ts_barrier":::"memory");
  #undef DMA_K
  #undef DMA_V
  #undef CMASK
  #undef START
  #undef RESC
  #undef ROT
}
constexpr int ATTN_LDS_BYTES=LDS_BYTES;
#undef SBAR
#undef WAIT_BAR
}

typedef short v4i16_t __attribute__((ext_vector_type(4)));
DI s16x4_t vtr16(const LAS unsigned char* p) { return __builtin_bit_cast(s16x4_t, __builtin_amdgcn_ds_read_tr16_b64_v4i16((LAS v4i16_t*)p)); }

struct NaState { f32x16_t o0, o1; float m, l; };
template <bool MASK> DI void na_tile(NaState& st, const bf16x8_t (&qf)[4], const LAS unsigned char* Kb, const LAS unsigned char* Vb, int koff, int lane,
                                     int kr, int qr, int qc, int rsq, int csq, const LAS float* BIAS) {
    const int ql = lane & 31, hf = lane >> 5, row = koff + ql;
    f32x16_t sc = {};
#pragma unroll
    for (int ks = 0; ks < 4; ++ks) { const bf16x8_t kf = *(const LAS bf16x8_t*)(Kb + row * 128 + (((2 * ks + hf) ^ (row & 7)) << 4)); sc = __builtin_amdgcn_mfma_f32_32x32x16_bf16(kf, qf[ks], sc, 0, 0, 0); }
    const LAS unsigned char* vp = Vb + ((lane >> 4) & 1) * 32 + (lane & 3) * 8 + (koff + 4 * hf + ((lane & 15) >> 2)) * 64;
    s16x4_t vl[2][2], vh[2][2];
#pragma unroll
    for (int dt = 0; dt < 2; ++dt)
#pragma unroll
        for (int s = 0; s < 2; ++s) { vl[dt][s] = vtr16(vp + dt * 4096 + s * 1024); vh[dt][s] = vtr16(vp + dt * 4096 + s * 1024 + 512); }
    float xs[16];
    if (MASK) {
        const bool row_ok = (kr >= rsq) && (kr < rsq + 8);
        const LAS float* rb = BIAS + (kr - qr + 7) * 31 + (15 - qc);
#pragma unroll
        for (int r = 0; r < 16; ++r) { const int kc = koff + crow16(r, hf); const bool ok = row_ok && (kc >= csq) && (kc < csq + 16);
            const float bias = ok ? rb[kc] : 0.f; xs[r] = ok ? (sc[r] * 0.125f + bias) * LOG2E : -1e30f; }
    } else {
#pragma unroll
        for (int r = 0; r < 16; ++r) xs[r] = sc[r] * (0.125f * LOG2E);
    }
    float tm = xs[0];
#pragma unroll
    for (int r = 1; r < 16; ++r) tm = fmaxf(tm, xs[r]);
    tm = fmaxf(tm, __shfl_xor(tm, 32));
    const float mn = fmaxf(st.m, tm), al = __builtin_amdgcn_exp2f(st.m - mn);
    float ps = 0.f;
#pragma unroll
    for (int r = 0; r < 16; ++r) { xs[r] = __builtin_amdgcn_exp2f(xs[r] - mn); ps += xs[r]; }
    st.l = st.l * al + ps; st.m = mn;
#pragma unroll
    for (int r = 0; r < 16; ++r) { st.o0[r] *= al; st.o1[r] *= al; }
#pragma unroll
    for (int s = 0; s < 2; ++s) { v4u w; w.x = cvtpk(xs[8 * s], xs[8 * s + 1]); w.y = cvtpk(xs[8 * s + 2], xs[8 * s + 3]); w.z = cvtpk(xs[8 * s + 4], xs[8 * s + 5]); w.w = cvtpk(xs[8 * s + 6], xs[8 * s + 7]);
        const bf16x8_t pf = __builtin_bit_cast(bf16x8_t, w);
        const bf16x8_t a0 = __builtin_shufflevector(vl[0][s], vh[0][s], 0, 1, 2, 3, 4, 5, 6, 7), a1 = __builtin_shufflevector(vl[1][s], vh[1][s], 0, 1, 2, 3, 4, 5, 6, 7);
        st.o0 = __builtin_amdgcn_mfma_f32_32x32x16_bf16(a0, pf, st.o0, 0, 0, 0);
        st.o1 = __builtin_amdgcn_mfma_f32_32x32x16_bf16(a1, pf, st.o1, 0, 0, 0); }
}

constexpr int NA_BLOCK_UNITS = 512 + 32;
DI void na_block_unit(int unit, const bf16_t* PROJ, const float* relb, bf16_t* YMIX, LAS unsigned char* lds, int tid, int wave, int lane) {
    LAS unsigned char* KB = lds; LAS unsigned char* VB = lds + 16384; LAS float* BIAS = (LAS float*)(lds + 32768);
    const bool lat = unit < 512;
    int b, h, R = 0;
    if (lat) { R = unit & 15; h = (unit >> 4) & 7; b = unit >> 7; } else { const int u = unit - 512; h = u & 7; b = u >> 3; }
    const int ql = lane & 31, hf = lane >> 5;
    int qrow, qr = 0, qc = 0, rsq = 0, csq = 0, c0 = 0, rlo = 0, rhi = 0, rsA = 0, nsteps = 4;
    if (lat) { const int rp = 2 * R + (wave >> 2), ci = wave & 3; qr = 2 * rp + (ql >> 4); qc = 16 * ci + (ql & 15); qrow = b * SEQ + qr * 64 + qc;
        rsq = min(max(qr - 4, 0), 56); csq = min(max(qc - 8, 0), 48); c0 = min(max(16 * ci - 8, 0), 32);
        rlo = min(max(2 * rp - 4, 0), 56); rhi = min(max(2 * rp - 3, 0), 56) + 8;
        rsA = min(max(4 * R - 4, 0), 56); const int rsB = min(max(4 * R - 1, 0), 56); nsteps = 4 + (rsB + 8 - rsA);
    } else qrow = NLAT + b * LC + 32 * wave + ql;
    __syncthreads();
    if (lat) for (int e = tid; e < 465; e += NTHREADS) BIAS[e] = relb[h * 465 + e];
    bf16x8_t qf[4];
    { const bf16_t* qp = PROJ + (size_t)qrow * N0 + 1024 + h * 64 + 8 * hf;
#pragma unroll
      for (int ks = 0; ks < 4; ++ks) qf[ks] = *(const bf16x8_t*)(qp + 16 * ks); }
    NaState st; st.o0 = (f32x16_t){}; st.o1 = (f32x16_t){}; st.m = -1e30f; st.l = 0.f;
    const int srow = tid >> 3, sch = tid & 7;
    const int kdst = srow * 128 + ((sch ^ (srow & 7)) << 4), vdst = (sch >> 2) * 4096 + srow * 64 + (sch & 3) * 16;
    auto step_row0 = [&](int s) -> int { return s < 4 ? NLAT + b * LC + 64 * s : b * SEQ + (rsA + s - 4) * 64; };
    v4u kreg, vreg;
    { const bf16_t* src = PROJ + (size_t)(step_row0(0) + srow) * N0 + h * 64 + sch * 8; kreg = *(const v4u*)(src + 1536); vreg = *(const v4u*)(src + 2048); }
#pragma unroll 1
    for (int s = 0; s < nsteps; ++s) {
        LAS unsigned char* kb = KB + (s & 1) * 8192; LAS unsigned char* vb = VB + (s & 1) * 8192;
        *(LAS v4u*)(kb + kdst) = kreg; *(LAS v4u*)(vb + vdst) = vreg;
        __syncthreads();
        if (s + 1 < nsteps) { const bf16_t* src = PROJ + (size_t)(step_row0(s + 1) + srow) * N0 + h * 64 + sch * 8; kreg = *(const v4u*)(src + 1536); vreg = *(const v4u*)(src + 2048); }
        if (s < 4) { na_tile<false>(st, qf, kb, vb, 0, lane, 0, 0, 0, 0, 0, BIAS); na_tile<false>(st, qf, kb, vb, 32, lane, 0, 0, 0, 0, 0, BIAS); }
        else { const int kr = rsA + s - 4; if (kr >= rlo && kr < rhi) na_tile<true>(st, qf, kb, vb, c0, lane, kr, qr, qc, rsq, csq, BIAS); }
    }
    st.l += __shfl_xor(st.l, 32);
    const float rl = 1.f / st.l;
    const bf16_t* gp = PROJ + (size_t)qrow * N0 + 2560 + h * 64; bf16_t* yp = YMIX + (size_t)qrow * DM + 512 + h * 64;
#pragma unroll
    for (int dt = 0; dt < 2; ++dt)
#pragma unroll
        for (int rg = 0; rg < 4; ++rg) { const int d = 32 * dt + 8 * rg + 4 * hf;
            const v2u gv = *(const v2u*)(gp + d);
            const float g0 = silu_f(bflo(gv.x)), g1 = silu_f(bfhi(gv.x)), g2 = silu_f(bflo(gv.y)), g3 = silu_f(bfhi(gv.y));
            const f32x16_t& oo = dt ? st.o1 : st.o0;
            v2u w; w.x = pk2(oo[4 * rg] * rl * g0, oo[4 * rg + 1] * rl * g1); w.y = pk2(oo[4 * rg + 2] * rl * g2, oo[4 * rg + 3] * rl * g3);
            *(v2u*)(yp + d) = w; }
}

#ifdef PROBE_TS_A
#define PSTAMP(i) do { if (blockIdx.x == 0 && tid == 0) ((volatile LAS unsigned*)(lds + 131072 + 320))[16 + (i)] = (unsigned)__builtin_amdgcn_s_memrealtime(); } while (0)
#else
#define PSTAMP(i) do {} while (0)
#endif
struct Args { const float* in[32]; float* out; unsigned char* ws; int ph_lo, ph_hi, li, pad; };
DI void phase3(const Args& args, LAS unsigned char* lds, int tid, int wave, int lane, int G, int pass) {
    unsigned char* ws = args.ws;
    for (int cu = blockIdx.x; cu < 256; cu += G)
        s5_scan_unit(cu, wave, (const bf16_t*)(ws + WS_UG), (const bf16_t*)(ws + WS_W16), (const float*)(ws + WS_L16), (bf16_t*)(ws + WS_CARRY0), (bf16_t*)(ws + WS_CARRY1), lane);
    PSTAMP(40);
    for (int u = blockIdx.x; u < NA_BLOCK_UNITS; u += G) na_block_unit(u, (const bf16_t*)(ws + WS_PROJ), args.in[20], (bf16_t*)(ws + WS_YMIX), lds, tid, wave, lane);
}
DI void phase4(const Args& args, LAS unsigned char* lds, int tid, int wave, int lane, int G) {
    unsigned char* ws = args.ws;
    constexpr int NIT = 32 * 4 * 17;
    const int i0 = (int)(((long)blockIdx.x * NIT) / G), i1 = (int)(((long)(blockIdx.x + 1) * NIT) / G);
    int gcur = -1;
    bf16x8_t wc[2][2][4];
    for (int it = i0; it < i1; ++it) {
        const int g = it / 68, b = (it % 68) / 17, s = it % 17;
        if (g != gcur) { __syncthreads(); for (int e = tid; e < 1024; e += NTHREADS) ((LAS v4u*)lds)[e] = ((const v4u*)(ws + WS_KT))[(size_t)g * 1024 + e];
            if (tid < 2) ((LAS v4u*)(lds + 16384))[tid] = (v4u){0u, 0u, 0u, 0u};
            s5_load_wc(wc, g, (const bf16_t*)(ws + WS_WC), wave, lane); gcur = g; __syncthreads(); }
        s5_out_item(g, b, s, (const bf16_t*)(ws + WS_UG), wc, (const bf16_t*)(ws + WS_CARRY0), (const bf16_t*)(ws + WS_CARRY1), args.in[17], (bf16_t*)(ws + WS_YPRE), lds, wave, lane);
    }
}
DI LruP make_lrup(const Args& args) { unsigned char* ws = args.ws;
    return LruP{(const bf16_t*)(ws + WS_PROJ), args.in[23], args.in[24], args.in[25], args.in[27], args.in[29], (const bf16_t*)(ws + WS_LRUWT), (f32x2_t*)(ws + WS_CARRY0), (bf16_t*)(ws + WS_YMIX)}; }
DI void phase9(const Args& args, LAS unsigned char* lds, int tid, int wave, int lane, int G) {
    unsigned char* ws = args.ws; const LruP lp = make_lrup(args);
    for (int blk = blockIdx.x; blk < 256; blk += G) lru_block(blk, false, lp, lds, tid, wave, lane);
    const int gw = blockIdx.x * NWAVES + wave, NGW = G * NWAVES;
    for (int r = gw; r < MROWS; r += NGW) qkprep_row(r, (const bf16_t*)(ws + WS_PROJ), args.in[30], args.in[31], (const float*)(ws + WS_ROPE), (bf16_t*)(ws + WS_QP), (bf16_t*)(ws + WS_KP), lane);
}
DI void phase10(const Args& args, LAS unsigned char* lds, int tid, int wave, int lane, int G) {
    unsigned char* ws = args.ws;
    const LruP lp = make_lrup(args);
    for (int blk = blockIdx.x; blk < 256; blk += G) lru_block(blk, true, lp, lds, tid, wave, lane);
    __syncthreads();
    const int bx = blockIdx.x, vcu = (G % 8 == 0) ? (bx % 8) * (G / 8) + bx / 8 : bx;
    typedef gqa_body::bf16 abf;
    for (int u = vcu; u < 512; u += G) {
        const int qb = u & 15, hq = (u >> 4) & 7, b = u >> 7;
        gqa_body::attn_unit<8>(b, hq, qb, (const abf*)(ws + WS_QP), (const abf*)(ws + WS_KP), (const abf*)(ws + WS_VT1), (abf*)(ws + WS_YMIX) + 512, (const abf*)(ws + WS_PROJ) + 1792, (char*)lds);
    }
}

constexpr int RING_BYTES = 131072, LDSCTL_OFF = RING_BYTES, MISC_OFF = LDSCTL_OFF + 320, LDS_BYTES = 147456;
constexpr int CW_BAR = 4096;
constexpr int N_PHASES = 13;
constexpr bool kSP2 = true, kALIGN = true;

DI void p0_adaln(LAS unsigned char* lds, const float* c, const float* cctx, const float* ada_w, const float* ada_b, float* MOD, int tid, int wave, int lane, int G) {
    LAS float* sl = (LAS float*)lds;
    LAS float* red = (LAS float*)(lds + 5 * 1024 * 4);
    if ((int)blockIdx.x >= 192) return;
    for (int e = tid; e < 5 * 1024; e += NTHREADS) { const int r = e >> 10, k = e & 1023; const float x = r < 4 ? c[r * 1024 + k] : cctx[k]; sl[e] = silu_f(x); }
    __syncthreads();
    for (int item = blockIdx.x; item < 192; item += G) {
        const int i = item / 96, cb = item % 96, col = cb * 32 + (lane & 31), kh = lane >> 5;
        const float* W = ada_w + (size_t)i * 1024 * 3072 + col;
        float acc[5] = {0.f, 0.f, 0.f, 0.f, 0.f};
#pragma unroll 8
        for (int kk = 0; kk < 64; ++kk) { const int k = wave * 128 + 2 * kk + kh; const float w = W[(size_t)k * 3072];
#pragma unroll
            for (int r = 0; r < 5; ++r) acc[r] += sl[r * 1024 + k] * w; }
#pragma unroll
        for (int r = 0; r < 5; ++r) { acc[r] += __shfl_xor(acc[r], 32); if (lane < 32) red[(wave * 5 + r) * 32 + lane] = acc[r]; }
        __syncthreads();
        if (tid < 160) { const int r = tid >> 5, cl = tid & 31; float s = ada_b[i * 3072 + cb * 32 + cl];
#pragma unroll
            for (int w = 0; w < 8; ++w) s += red[(w * 5 + r) * 32 + cl];
            MOD[(i * 5 + r) * 3072 + cb * 32 + cl] = s; }
        __syncthreads();
    }
}
DI void p0_transpose_item(const float* W, int K, int N, bf16_t* WT, int row_off, LAS float* scr, int item, int lane) {
    const int nblk = N / 32, kb = item / nblk, nb = item % nblk, k0 = 64 * kb, n0 = 32 * nb;
#pragma unroll 8
    for (int i = 0; i < 32; ++i) { const int kk = 2 * i + (lane >> 5); scr[kk * 33 + (lane & 31)] = W[(size_t)(k0 + kk) * N + n0 + (lane & 31)]; }
    LDS_WAIT(); asm volatile("" ::: "memory");
    const int c = lane & 7;
#pragma unroll
    for (int j = 0; j < 4; ++j) { const int n = (lane >> 3) + 8 * j; const LAS float* s = scr + (8 * c) * 33 + n;
        v4u o; o.x = pk2(s[0 * 33], s[1 * 33]); o.y = pk2(s[2 * 33], s[3 * 33]); o.z = pk2(s[4 * 33], s[5 * 33]); o.w = pk2(s[6 * 33], s[7 * 33]);
        *(v4u*)(WT + (size_t)(row_off + n0 + n) * K + k0 + 8 * c) = o; }
    LDS_WAIT(); asm volatile("" ::: "memory");
}

DI void load_row16(const float* src, int lane, float (&v)[16]) {
#pragma unroll
    for (int j = 0; j < 4; ++j) { const f32x4_t t = *(const f32x4_t*)(src + j * 256 + lane * 4); v[4 * j] = t[0]; v[4 * j + 1] = t[1]; v[4 * j + 2] = t[2]; v[4 * j + 3] = t[3]; }
}
DI float row_rinv(const float (&v)[16]) {
    float ss = 0.f;
#pragma unroll
    for (int j = 0; j < 16; ++j) ss += v[j] * v[j];
    ss = wave_sum(ss);
    return rsqrtf(ss * (1.f / DM) + EPSN);
}
DI void store_modnorm(const float (&v)[16], float rinv, const float* g, const float* m, bf16_t* dst, int lane) {
#pragma unroll
    for (int j = 0; j < 4; ++j) { const int col = j * 256 + lane * 4;
        const f32x4_t gg = *(const f32x4_t*)(g + col), sc = *(const f32x4_t*)(m + 1024 + col), sh = *(const f32x4_t*)(m + col);
        float y[4];
#pragma unroll
        for (int e = 0; e < 4; ++e) y[e] = v[4 * j + e] * rinv * gg[e] * (1.f + sc[e]) + sh[e];
        v2u o; o.x = pk2(y[0], y[1]); o.y = pk2(y[2], y[3]); *(v2u*)(dst + col) = o; }
}

__global__ void __launch_bounds__(NTHREADS, 2) mega(Args args) {
    extern __shared__ __attribute__((aligned(16))) unsigned char lds_raw[];
    LAS unsigned char* lds = (LAS unsigned char*)lds_raw;
    volatile LAS unsigned* MISC = (volatile LAS unsigned*)(lds + MISC_OFF);
    const int tid = threadIdx.x, lane = tid & 63, wave = __builtin_amdgcn_readfirstlane(tid >> 6);
    const int G = gridDim.x;
    unsigned char* ws = args.ws;
    gu32* ctl = (gu32*)(ws + WS_CTL);
    for (int u = tid; u < (LDS_BYTES - LDSCTL_OFF) / 4; u += NTHREADS) ((LAS unsigned*)(lds + LDSCTL_OFF))[u] = 0u;
    __syncthreads();
    XcdBarrier bar = xcd_barrier_post((unsigned*)(ctl + CW_BAR) + args.li * XCD_BAR_WORDS, MISC + 8);
    const int lo = args.ph_lo, hi = args.ph_hi;
#define IN(k) (lo <= (k) && (k) < hi)
#ifndef PROBE_REP
#define PROBE_REP 0
#endif
#define PHASE_LOOP(k) for (int rep_ = 0, nrep_ = IN(k) ? 1 + ((PROBE_REP >> (k)) & 1) : 0; rep_ < nrep_; (++rep_ < nrep_) ? xcd_barrier(bar) : (void)0)
#ifdef PROBE_TS_A
#define STAMP(i) do { if (blockIdx.x == 0 && tid == 0) MISC[16 + (i)] = (unsigned)__builtin_amdgcn_s_memrealtime(); } while (0)
#else
#define STAMP(i) do {} while (0)
#endif
#define SEAM(k) do { if (IN(k) && IN((k) + 1)) xcd_barrier(bar); } while (0)

    const float* x = args.in[0]; const float* cvec = args.in[1]; const float* ctxin = args.in[2]; const float* cctx = args.in[3];
    const float* ada_w = args.in[4]; const float* ada_b = args.in[5]; const float* pre_g = args.in[6]; const float* post_g = args.in[7];
    float* out = args.out;
    float* MOD = (float*)(ws + WS_MOD);
    bf16_t* XN = (bf16_t*)(ws + WS_XN); bf16_t* YMIX = (bf16_t*)(ws + WS_YMIX); bf16_t* PROJ = (bf16_t*)(ws + WS_PROJ); float* OUTF = (float*)(ws + WS_PROJ);
    bf16_t* YPRE = (bf16_t*)(ws + WS_YPRE);
    const int gw = blockIdx.x * NWAVES + wave, NGW = G * NWAVES;

    PHASE_LOOP(0) { STAMP(0);
        p0_adaln(lds, cvec, cctx, ada_w, ada_b, MOD, tid, wave, lane, G);
        for (int it = G - 1 - (int)blockIdx.x; it < 256; it += G)
            s5_tables_block(it, args.in[10], args.in[11], args.in[12], args.in[13], args.in[14], args.in[15], args.in[16], (bf16_t*)(ws + WS_W16), (bf16_t*)(ws + WS_WC), (bf16_t*)(ws + WS_KT), (float*)(ws + WS_L16), lds, tid);
    }
    STAMP(1);
    SEAM(0);
    PHASE_LOOP(1) { STAMP(2);
        for (int r = gw; r < MROWS; r += NGW) {
            const float* src = r < NLAT ? x + (size_t)r * DM : ctxin + (size_t)(r - NLAT) * DM;
            float v[16]; load_row16(src, lane, v);
            store_modnorm(v, row_rinv(v), pre_g, MOD + (r < NLAT ? (r >> 12) : 4) * 3072, XN + (size_t)r * DM, lane);
        }
        LAS float* scr = (LAS float*)(lds + 32768 + wave * 8704);
        constexpr int I0 = 16 * 96, I1 = 16 * 32, I2 = 16 * 72, I3 = 16 * 32, I4 = 8 * 16, NBIG = I0 + I1 + I2 + I3 + I4, NLRU = 32 * 2;
        for (int it = gw; it < NBIG + NLRU; it += NGW) {
            int r = it;
            if (r < I0) { p0_transpose_item(args.in[8], 1024, 3072, (bf16_t*)(ws + WS_WIN0T), 0, scr, r, lane); continue; } r -= I0;
            if (r < I1) { p0_transpose_item(args.in[9], 1024, 1024, (bf16_t*)(ws + WS_WOUT0T), 0, scr, r, lane); continue; } r -= I1;
            if (r < I2) { p0_transpose_item(args.in[21], 1024, 2304, (bf16_t*)(ws + WS_WIN1T), 0, scr, r, lane); continue; } r -= I2;
            if (r < I3) { p0_transpose_item(args.in[22], 1024, 1024, (bf16_t*)(ws + WS_WOUT1T), 0, scr, r, lane); continue; } r -= I3;
            if (r < I4) { p0_transpose_item(args.in[18], 512, 512, (bf16_t*)(ws + WS_WGLUT), 0, scr, r, lane); continue; } r -= I4;
            { const int mat = r >> 1, sub = r & 1, dir = mat >> 4, gate = (mat >> 3) & 1, blk = mat & 7;
              const float* W = (gate ? args.in[28] : args.in[26]) + (size_t)(dir * 8 + blk) * 4096;
              p0_transpose_item(W, 64, 64, (bf16_t*)(ws + WS_LRUWT), blk * 256 + (dir * 2 + gate) * 64, scr, sub, lane); }
        }
        float* ROPE = (float*)(ws + WS_ROPE);
        for (int e = blockIdx.x * NTHREADS + tid; e < SEQ * 32; e += G * NTHREADS) { const int t = e >> 5, i = e & 31, f = i & 15; const float pos = (float)(i < 16 ? (t >> 6) : (t & 63));
            const float inv = (float)exp(-log(10000.0) * (double)(2 * f) / 32.0); const float ang = pos * inv; ROPE[2 * e] = cosf(ang); ROPE[2 * e + 1] = sinf(ang); }
    }
    STAMP(3);
    SEAM(1);
    PHASE_LOOP(2) { STAMP(4);
        pg8::Gemm g{XN, (const bf16_t*)(ws + WS_WIN0T), MROWS, N0, DM}; pg8::StaticOrder S; S.init(MROWS, N0, G, (int)blockIdx.x);
        pg8::EpiProj E{PROJ, N0, nullptr, 1 << 30, 1 << 30, 512, false, (bf16_t*)(ws + WS_UG), 512};
        pg8::gemm_phase<pg8::EpiProj, pg8::StaticOrder, kALIGN, kSP2>(lds, g, S, E);
    }
    STAMP(5);
    SEAM(2);
    PHASE_LOOP(3) { STAMP(6); phase3(args, lds, tid, wave, lane, G, rep_); }
    STAMP(7);
    SEAM(3);
    PHASE_LOOP(4) { STAMP(8); phase4(args, lds, tid, wave, lane, G); }
    STAMP(9);
    SEAM(4);
    PHASE_LOOP(5) { STAMP(10);
        pg8::Gemm g{YPRE, (const bf16_t*)(ws + WS_WGLUT), MROWS, 512, 512, 1};   pg8::StaticOrder S; S.init(MROWS, 512, G, (int)blockIdx.x);
        pg8::EpiGlu E{YPRE, PROJ, args.in[19], YMIX};
        pg8::gemm_phase<pg8::EpiGlu, pg8::StaticOrder, kALIGN, kSP2>(lds, g, S, E);
    }
    STAMP(11);
    SEAM(5);
    PHASE_LOOP(6) { STAMP(12);
        pg8::Gemm g{YMIX, (const bf16_t*)(ws + WS_WOUT0T), MROWS, DM, DM}; pg8::StaticOrder S; S.init(MROWS, DM, G, (int)blockIdx.x);
        pg8::EpiF32 E{OUTF, DM};
        pg8::gemm_phase<pg8::EpiF32, pg8::StaticOrder, kALIGN, kSP2>(lds, g, S, E);
    }
    STAMP(13);
    SEAM(6);
    PHASE_LOOP(7) { STAMP(14);
        for (int r = gw; r < MROWS; r += NGW) {
            const int mrow = r < NLAT ? (r >> 12) : 4;
            const float* hin = r < NLAT ? x + (size_t)r * DM : ctxin + (size_t)(r - NLAT) * DM;
            float v[16], h[16]; load_row16(OUTF + (size_t)r * DM, lane, v); load_row16(hin, lane, h);
            const float rinv = row_rinv(v); const float* gt = MOD + mrow * 3072 + 2048;
#pragma unroll
            for (int j = 0; j < 4; ++j) { const int col = j * 256 + lane * 4; const f32x4_t pg = *(const f32x4_t*)(post_g + col), gg = *(const f32x4_t*)(gt + col);
#pragma unroll
                for (int e = 0; e < 4; ++e) h[4 * j + e] += gg[e] * (v[4 * j + e] * rinv * pg[e]);
                if (r < NLAT) *(f32x4_t*)(out + (size_t)r * DM + col) = (f32x4_t){h[4 * j], h[4 * j + 1], h[4 * j + 2], h[4 * j + 3]}; }
            store_modnorm(h, row_rinv(h), pre_g + DM, MOD + (5 + mrow) * 3072, XN + (size_t)r * DM, lane);
        }
    }
    STAMP(15);
    SEAM(7);
    PHASE_LOOP(8) { STAMP(16);
        pg8::Gemm g{XN, (const bf16_t*)(ws + WS_WIN1T), MROWS, N1, DM}; pg8::StaticOrder S; S.init(MROWS, N1, G, (int)blockIdx.x);
        pg8::EpiProj E{PROJ, N1, (bf16_t*)(ws + WS_VT1), 1664, 1792, 128, true, nullptr, 0};
        pg8::gemm_phase<pg8::EpiProj, pg8::StaticOrder, kALIGN, kSP2>(lds, g, S, E);
    }
    STAMP(17);
    SEAM(8);
    PHASE_LOOP(9) { STAMP(18); phase9(args, lds, tid, wave, lane, G); }
    STAMP(19);
    SEAM(9);
    PHASE_LOOP(10) { STAMP(20); phase10(args, lds, tid, wave, lane, G); }
    STAMP(21);
    SEAM(10);
    PHASE_LOOP(11) { STAMP(22);
        pg8::Gemm g{YMIX, (const bf16_t*)(ws + WS_WOUT1T), NLAT, DM, DM}; pg8::StaticOrder S; S.init(NLAT, DM, G, (int)blockIdx.x);
        pg8::EpiF32 E{OUTF, DM};
        pg8::gemm_phase<pg8::EpiF32, pg8::StaticOrder, kALIGN, kSP2>(lds, g, S, E);
    }
    STAMP(23);
    SEAM(11);
    PHASE_LOOP(12) { STAMP(24);
        for (int r = gw; r < NLAT; r += NGW) {
            float v[16], h[16]; load_row16(OUTF + (size_t)r * DM, lane, v); load_row16(out + (size_t)r * DM, lane, h);
            const float rinv = row_rinv(v); const float* gt = MOD + (5 + (r >> 12)) * 3072 + 2048;
#pragma unroll
            for (int j = 0; j < 4; ++j) { const int col = j * 256 + lane * 4; const f32x4_t pg = *(const f32x4_t*)(post_g + DM + col), gg = *(const f32x4_t*)(gt + col);
                f32x4_t o;
#pragma unroll
                for (int e = 0; e < 4; ++e) o[e] = h[4 * j + e] + gg[e] * (v[4 * j + e] * rinv * pg[e]);
                *(f32x4_t*)(out + (size_t)r * DM + col) = o; }
        }
    }
    STAMP(25);
#ifdef PROBE_TS_A
    if (blockIdx.x == 0 && tid == 0) { const unsigned dt = MISC[16 + PROBE_TS_B] - MISC[16 + PROBE_TS_A]; out[0] += (float)dt * (0.01f / (float)PROBE_TS_SCALE); }
#endif
#undef IN
#undef SEAM
}
__global__ void k_adaln(const float* c, const float* cctx, const float* ada_w, const float* ada_b, float* mod) {
    const int idx = blockIdx.x * blockDim.x + threadIdx.x;
    if (idx >= 2 * 5 * 3072) return;
    const int col = idx % 3072, r = (idx / 3072) % 5, i = idx / (3072 * 5);
    const float* cv = r < 4 ? c + r * 1024 : cctx;
    const float* W = ada_w + (size_t)i * 1024 * 3072;
    float acc = 0.f;
    for (int k = 0; k < 1024; ++k) acc += silu_f(cv[k]) * W[(size_t)k * 3072 + col];
    mod[idx] = acc + ada_b[i * 3072 + col];
}

__global__ void k_prenorm(const float* lat, const float* ctx, const float* g, const float* mod  , bf16_t* XN) {
    const int r = blockIdx.x * 4 + (threadIdx.x >> 6), lane = threadIdx.x & 63;
    if (r >= MROWS) return;
    const float* src = r < NLAT ? lat + (size_t)r * DM : ctx + (size_t)(r - NLAT) * DM;
    const float* m = mod + (r < NLAT ? (r >> 12) : 4) * 3072;
    float v[16]; float ss = 0.f;
#pragma unroll
    for (int j = 0; j < 4; ++j) { const float4 t = *(const float4*)(src + j * 256 + lane * 4); v[4 * j] = t.x; v[4 * j + 1] = t.y; v[4 * j + 2] = t.z; v[4 * j + 3] = t.w; }
#pragma unroll
    for (int j = 0; j < 16; ++j) ss += v[j] * v[j];
    ss = wave_sum(ss);
    const float rinv = rsqrtf(ss * (1.f / DM) + EPSN);
#pragma unroll
    for (int j = 0; j < 4; ++j)
#pragma unroll
        for (int e = 0; e < 4; ++e) { const int col = j * 256 + lane * 4 + e; const float y = v[4 * j + e] * rinv * g[col] * (1.f + m[1024 + col]) + m[col]; XN[(size_t)r * DM + col] = f2bf(y); }
}

__global__ void k_postnorm(const float* hlat, const float* hctx, const float* OUT, const float* pg, const float* mod, float* olat, float* octx, int nrows) {
    const int r = blockIdx.x * 4 + (threadIdx.x >> 6), lane = threadIdx.x & 63;
    if (r >= nrows) return;
    const float* hin = r < NLAT ? hlat + (size_t)r * DM : hctx + (size_t)(r - NLAT) * DM;
    float* ho = r < NLAT ? olat + (size_t)r * DM : octx + (size_t)(r - NLAT) * DM;
    const float* m = mod + (r < NLAT ? (r >> 12) : 4) * 3072 + 2048;
    const float* src = OUT + (size_t)r * DM;
    float v[16]; float ss = 0.f;
#pragma unroll
    for (int j = 0; j < 4; ++j) { const float4 t = *(const float4*)(src + j * 256 + lane * 4); v[4 * j] = t.x; v[4 * j + 1] = t.y; v[4 * j + 2] = t.z; v[4 * j + 3] = t.w; }
#pragma unroll
    for (int j = 0; j < 16; ++j) ss += v[j] * v[j];
    ss = wave_sum(ss);
    const float rinv = rsqrtf(ss * (1.f / DM) + EPSN);
#pragma unroll
    for (int j = 0; j < 4; ++j)
#pragma unroll
        for (int e = 0; e < 4; ++e) { const int col = j * 256 + lane * 4 + e; ho[col] = hin[col] + m[col] * (v[4 * j + e] * rinv * pg[col]); }
}

enum { GM_PROJ0 = 0, GM_PROJ1 = 1, GM_GLU = 2, GM_F32 = 3 };
struct GemmEpi { bf16_t* P; bf16_t* VT; const bf16_t* YPRE; const bf16_t* PROJ; const float* bglu; bf16_t* YMIX; float* OUT; };
template <int MODE> __global__ void __launch_bounds__(256) k_gemm(const bf16_t* A, const float* W, int M, int N, int K, GemmEpi e) {
    const int tx = threadIdx.x & 15, ty = threadIdx.x >> 4;
    const int c0 = blockIdx.x * 64 + tx * 4, r0 = blockIdx.y * 64 + ty * 4;
    float acc[4][4] = {};
    for (int k = 0; k < K; ++k) {
        const float4 w = *(const float4*)(W + (size_t)k * N + c0);
        const float wv[4] = {rbf(w.x), rbf(w.y), rbf(w.z), rbf(w.w)};
#pragma unroll
        for (int i = 0; i < 4; ++i) { const float a = bf2f(A[(size_t)(r0 + i) * K + k]);
#pragma unroll
            for (int j = 0; j < 4; ++j) acc[i][j] += a * wv[j]; }
    }
#pragma unroll
    for (int i = 0; i < 4; ++i)
#pragma unroll
        for (int j = 0; j < 4; ++j) {
            const int r = r0 + i, c = c0 + j; const float v = acc[i][j];
            if (MODE == GM_PROJ0) { e.P[(size_t)r * N0 + c] = f2bf(v);
                if (c >= 2048 && c < 2560) { const int hd = c - 2048; e.VT[((size_t)(row_batch(r) * 8) * 64 + hd) * POSN + row_pos(r)] = f2bf(v); } }
            else if (MODE == GM_PROJ1) { e.P[(size_t)r * N1 + c] = f2bf(v);
                if (c >= 1664 && c < 1792) { const int hd = c - 1664; e.VT[((size_t)(row_batch(r) * 2) * 64 + hd) * POSN + row_pos(r)] = f2bf(v); } }
            else if (MODE == GM_GLU) { const float y = bf2f(e.YPRE[(size_t)r * 512 + c]); const float ga = bf2f(e.PROJ[(size_t)r * N0 + 512 + c]);
                e.YMIX[(size_t)r * DM + c] = f2bf(y * sigmoid_f(v + e.bglu[c]) * silu_f(ga)); }
            else e.OUT[(size_t)r * N + c] = v;
        }
}

__global__ void __launch_bounds__(64) k_s5_scan(const bf16_t* PROJ, const float* lam_re, const float* lam_im, const float* log_dt, const float* b_re, const float* b_im,
                                                 const float* c_re, const float* c_im, float* YS) {
    const int p = threadIdx.x, id = blockIdx.x, dir = id & 1, g = (id >> 1) & 31, b = id >> 6;
    const int gi = (dir * 32 + g);
    const double lre = lam_re[gi * 64 + p], lim = lam_im[gi * 64 + p], dt = exp((double)log_dt[gi]);
    const double mag = exp(lre * dt); const float ar = (float)(mag * cos(lim * dt)), ai = (float)(mag * sin(lim * dt));
    const double nr = mag * cos(lim * dt) - 1.0, ni = mag * sin(lim * dt), den = lre * lre + lim * lim;
    const float cfr = (float)((nr * lre + ni * lim) / den), cfi = (float)((ni * lre - nr * lim) / den);
    float bbr[16], bbi[16], cr[16], ci[16];
#pragma unroll
    for (int h = 0; h < 16; ++h) { const float br = b_re[(gi * 64 + p) * 16 + h], bi = b_im[(gi * 64 + p) * 16 + h]; bbr[h] = cfr * br - cfi * bi; bbi[h] = cfr * bi + cfi * br;
        cr[h] = c_re[(gi * 16 + h) * 64 + p]; ci[h] = c_im[(gi * 16 + h) * 64 + p]; }
    float hr = 0.f, hi = 0.f;
    float* ys = YS + (size_t)dir * MROWS * 512;
    for (int pos = 0; pos < POSN; ++pos) {
        int row;
        if (dir == 0) row = pos_row(b, pos); else row = pos < LC ? NLAT + b * LC + (LC - 1 - pos) : b * SEQ + (SEQ - 1 - (pos - LC));
        const bf16_t* up = PROJ + (size_t)row * N0 + g * 16;
        float bur = 0.f, bui = 0.f;
#pragma unroll
        for (int h = 0; h < 16; ++h) { const float u = bf2f(up[h]); bur += bbr[h] * u; bui += bbi[h] * u; }
        const float nhr = ar * hr - ai * hi + bur, nhi = ar * hi + ai * hr + bui; hr = nhr; hi = nhi;
        float mine = 0.f;
#pragma unroll
        for (int h = 0; h < 16; ++h) { const float y = wave_sum(cr[h] * hr - ci[h] * hi); if (p == h) mine = y; }
        if (p < 16) ys[(size_t)row * 512 + g * 16 + p] = mine;
    }
}
__global__ void k_s5_finish(const bf16_t* PROJ, const float* YS, const float* dsk, bf16_t* YPRE) {
    const size_t idx = (size_t)blockIdx.x * blockDim.x + threadIdx.x; if (idx >= (size_t)MROWS * 512) return;
    const int ch = idx & 511; const size_t r = idx >> 9;
    const float y = dsk[ch] * bf2f(PROJ[r * N0 + ch]) + YS[idx] + YS[(size_t)MROWS * 512 + idx];
    YPRE[idx] = f2bf(gelu_tanh(y));
}

__global__ void __launch_bounds__(256) k_na_attn(const bf16_t* PROJ, const float* relb, bf16_t* YMIX) {
    const int wv = blockIdx.x * 4 + (threadIdx.x >> 6), lane = threadIdx.x & 63;
    if (wv >= MROWS * 8) return;
    const int h = wv & 7, r = wv >> 3, b = row_batch(r);
    const float q = bf2f(PROJ[(size_t)r * N0 + 1024 + h * 64 + lane]);
    float m = -INFINITY, l = 0.f, o = 0.f;
    if (r < NLAT) {
        const int t = r & 4095, qr = t >> 6, qc = t & 63;
        const int rs = min(max(qr - 4, 0), 56), cs = min(max(qc - 8, 0), 48);
        for (int kr = rs; kr < rs + 8; ++kr)
            for (int kc = cs; kc < cs + 16; ++kc) {
                const size_t kro = (size_t)(b * SEQ + kr * 64 + kc) * N0;
                float s = wave_sum(q * bf2f(PROJ[kro + 1536 + h * 64 + lane])) * 0.125f + relb[(h * 15 + (kr - qr + 7)) * 31 + (kc - qc + 15)];
                const float mn = fmaxf(m, s), al = __expf(m - mn), pp = __expf(s - mn);
                l = l * al + pp; o = o * al + pp * bf2f(PROJ[kro + 2048 + h * 64 + lane]); m = mn;
            }
    }
    for (int c = 0; c < LC; ++c) {
        const size_t kro = (size_t)(NLAT + b * LC + c) * N0;
        const float s = wave_sum(q * bf2f(PROJ[kro + 1536 + h * 64 + lane])) * 0.125f;
        const float mn = fmaxf(m, s), al = __expf(m - mn), pp = __expf(s - mn);
        l = l * al + pp; o = o * al + pp * bf2f(PROJ[kro + 2048 + h * 64 + lane]); m = mn;
    }
    const float gb = bf2f(PROJ[(size_t)r * N0 + 2560 + h * 64 + lane]);
    YMIX[(size_t)r * DM + 512 + h * 64 + lane] = f2bf(o / l * silu_f(gb));
}

__global__ void __launch_bounds__(64) k_lru(const bf16_t* P1, const float* conv_w, const float* conv_b, const float* lam, const float* w_a, const float* b_a,
                                            const float* w_x, const float* b_x, float* HS, bf16_t* YMIX) {
    __shared__ float xs[64];
    const int j = threadIdx.x, nb = blockIdx.x & 7, b = blockIdx.x >> 3, ch = nb * 64 + j;
    const float cw0 = conv_w[0 * 512 + ch], cw1 = conv_w[1 * 512 + ch], cw2 = conv_w[2 * 512 + ch], cw3 = conv_w[3 * 512 + ch], cb = conv_b[ch];
    for (int dir = 0; dir < 2; ++dir) {
        float wa[64], wx[64];
#pragma unroll
        for (int i = 0; i < 64; ++i) { wa[i] = w_a[((dir * 8 + nb) * 64 + i) * 64 + j]; wx[i] = w_x[((dir * 8 + nb) * 64 + i) * 64 + j]; }
        const float ba = b_a[dir * 512 + ch], bx = b_x[dir * 512 + ch];
        const float lm = lam[dir * 512 + ch]; const float sp = (-lm > 20.f) ? -lm : log1pf(__expf(-lm));
        float hst = 0.f;
        for (int pos = 0; pos < POSN; ++pos) {
            int s0, sl, t;
            if (pos < LC) { s0 = NLAT + b * LC; sl = LC; t = dir == 0 ? pos : LC - 1 - pos; }
            else { s0 = b * SEQ; sl = SEQ; t = dir == 0 ? pos - LC : SEQ - 1 - (pos - LC); }
            float xm1 = 0.f, x0, xp1 = 0.f, xp2 = 0.f;
            x0 = bf2f(P1[(size_t)(s0 + t) * N1 + ch]);
            if (t - 1 >= 0) xm1 = bf2f(P1[(size_t)(s0 + t - 1) * N1 + ch]);
            if (t + 1 < sl) xp1 = bf2f(P1[(size_t)(s0 + t + 1) * N1 + ch]);
            if (t + 2 < sl) xp2 = bf2f(P1[(size_t)(s0 + t + 2) * N1 + ch]);
            const float xc = cw0 * xm1 + cw1 * x0 + cw2 * xp1 + cw3 * xp2 + cb;
            __syncthreads(); xs[j] = xc; __syncthreads();
            float ga = ba, gx = bx;
#pragma unroll
            for (int i = 0; i < 64; ++i) { const float xi = xs[i]; ga += xi * wa[i]; gx += xi * wx[i]; }
            const float gr = sigmoid_f(ga), gi = sigmoid_f(gx);
            const float log_a = -8.f * gr * sp; const float a = __expf(log_a); const float mult = sqrtf(fmaxf(-expm1f(2.f * log_a), 0.f));
            hst = a * hst + mult * gi * xc;
            if (pos >= LC) { const size_t rr = (size_t)(s0 + t);
                if (dir == 0) HS[rr * 512 + ch] = hst;
                else { const float gc = bf2f(P1[rr * N1 + 512 + ch]); YMIX[rr * DM + ch] = f2bf((HS[rr * 512 + ch] + hst) * silu_f(gc)); } }
        }
    }
}

__global__ void __launch_bounds__(256) k_qkprep(const bf16_t* P1, const float* qn, const float* kn, bf16_t* QP, bf16_t* KP) {
    const int wv = blockIdx.x * 4 + (threadIdx.x >> 6), lane = threadIdx.x & 63;
    if (wv >= MROWS * 10) return;
    const int slot = wv % 10, r = wv / 10, b = row_batch(r);
    if (slot < 8 && r >= NLAT) return;
    const int col0 = slot < 8 ? 1024 + slot * 64 : 1536 + (slot - 8) * 64;
    const float x = bf2f(P1[(size_t)r * N1 + col0 + lane]);
    const float ss = wave_sum(x * x);
    float y = x * rsqrtf(ss * (1.f / 64.f) + EPSN) * (slot < 8 ? qn[lane] : kn[lane]);
    if (r < NLAT) {
        const int t = r & 4095, i = lane >> 1, f = i & 15; const float pos = (float)(i < 16 ? (t >> 6) : (t & 63));
        const float inv = (float)exp(-log(10000.0) * (double)(2 * f) / 32.0);
        const float ang = pos * inv; const float cs = cosf(ang), sn = sinf(ang);
        const float pr = __shfl_xor(y, 1);
        y = (lane & 1) ? (pr * sn + y * cs) : (y * cs - pr * sn);
    }
    if (slot < 8) QP[((size_t)(b * 8 + slot) * SEQ + (r & 4095)) * 64 + lane] = f2bf(y * (0.125f * LOG2E));
    else KP[((size_t)(b * 2 + (slot - 8)) * POSN + row_pos(r)) * 64 + lane] = f2bf(y);
}

__global__ void __launch_bounds__(256) k_gqa(const bf16_t* QP, const bf16_t* KP, const bf16_t* P1, bf16_t* YMIX) {
    const int wv = blockIdx.x * 4 + (threadIdx.x >> 6), lane = threadIdx.x & 63;
    if (wv >= NLAT * 8) return;
    const int hq = wv & 7, r = wv >> 3, b = r >> 12, t = r & 4095, kvh = hq >> 2;
    const float q = bf2f(QP[((size_t)(b * 8 + hq) * SEQ + t) * 64 + lane]);
    const bf16_t* kp = KP + (size_t)(b * 2 + kvh) * POSN * 64;
    float m = -INFINITY, l = 0.f, o = 0.f;
    for (int pos = 0; pos < POSN; ++pos) {
        const float s = wave_sum(q * bf2f(kp[(size_t)pos * 64 + lane]));
        const float v = bf2f(P1[(size_t)pos_row(b, pos) * N1 + 1664 + kvh * 64 + lane]);
        const float mn = fmaxf(m, s), al = exp2f(m - mn), pp = exp2f(s - mn);
        l = l * al + pp; o = o * al + pp * v; m = mn;
    }
    const float gd = bf2f(P1[(size_t)r * N1 + 1792 + hq * 64 + lane]);
    YMIX[(size_t)r * DM + 512 + hq * 64 + lane] = f2bf(o / l * silu_f(gd));
}

static int g_grid = 0;
static void launch_mega(Args a, int lo, int hi, int li, hipStream_t stream) {
    a.ph_lo = lo; a.ph_hi = hi; a.li = li;
    hipLaunchKernelGGL(mega, dim3(g_grid), dim3(NTHREADS), LDS_BYTES, stream, a);
    const hipError_t le = hipPeekAtLastError();
    if (le != hipSuccess) fprintf(stderr, "kernel_launch: mega[%d,%d) failed: %s\n", lo, hi, hipGetErrorName(le));
}
extern "C" void kernel_launch(void* const* d_in, const int* in_sizes, int n_in, void* d_out, int out_size, void* d_ws, size_t ws_size, hipStream_t stream) {
    if (g_grid == 0) {
        int dev = 0, cus = 0;
        if (hipGetDevice(&dev) != hipSuccess || hipDeviceGetAttribute(&cus, hipDeviceAttributeMultiprocessorCount, dev) != hipSuccess) { fprintf(stderr, "kernel_launch: device query failed\n"); g_grid = -1; return; }
        if (hipFuncSetAttribute((const void*)mega, hipFuncAttributeMaxDynamicSharedMemorySize, LDS_BYTES) != hipSuccess) { fprintf(stderr, "kernel_launch: hipFuncSetAttribute failed\n"); g_grid = -1; return; }
        int per_cu = 0;
        if (hipOccupancyMaxActiveBlocksPerMultiprocessor(&per_cu, (const void*)mega, NTHREADS, LDS_BYTES) != hipSuccess || per_cu < 1) fprintf(stderr, "kernel_launch: occupancy query says %d blocks/CU\n", per_cu);
        (void)hipGetLastError();
        g_grid = cus;
    }
    if (g_grid < 0) return;
    const float* x = (const float*)d_in[0]; const float* c = (const float*)d_in[1]; const float* ctx = (const float*)d_in[2]; const float* cctx = (const float*)d_in[3];
    const float* ada_w = (const float*)d_in[4]; const float* ada_b = (const float*)d_in[5]; const float* pre_g = (const float*)d_in[6]; const float* post_g = (const float*)d_in[7];
    const float* ev_w_in = (const float*)d_in[8]; const float* ev_w_out = (const float*)d_in[9];
    const float* s5_lre = (const float*)d_in[10]; const float* s5_lim = (const float*)d_in[11]; const float* s5_ldt = (const float*)d_in[12];
    const float* s5_bre = (const float*)d_in[13]; const float* s5_bim = (const float*)d_in[14]; const float* s5_cre = (const float*)d_in[15]; const float* s5_cim = (const float*)d_in[16];
    const float* s5_d = (const float*)d_in[17]; const float* s5_wglu = (const float*)d_in[18]; const float* s5_bglu = (const float*)d_in[19]; const float* relb = (const float*)d_in[20];
    const float* od_w_in = (const float*)d_in[21]; const float* od_w_out = (const float*)d_in[22]; const float* conv_w = (const float*)d_in[23]; const float* conv_b = (const float*)d_in[24];
    const float* lru_lam = (const float*)d_in[25]; const float* w_a = (const float*)d_in[26]; const float* b_a = (const float*)d_in[27]; const float* w_x = (const float*)d_in[28]; const float* b_x = (const float*)d_in[29];
    const float* qn = (const float*)d_in[30]; const float* kn = (const float*)d_in[31];
    char* ws = (char*)d_ws; float* out = (float*)d_out;
    float* MOD = (float*)(ws + WS_MOD); float* HC1 = (float*)(ws + WS_HC1);
    bf16_t* XN = (bf16_t*)(ws + WS_XN); bf16_t* YMIX = (bf16_t*)(ws + WS_YMIX); bf16_t* PROJ = (bf16_t*)(ws + WS_PROJ); float* OUTF = (float*)(ws + WS_PROJ);
    bf16_t* VT0 = (bf16_t*)(ws + WS_VT0); bf16_t* YPRE = (bf16_t*)(ws + WS_YPRE); bf16_t* QP = (bf16_t*)(ws + WS_QP); bf16_t* KP = (bf16_t*)(ws + WS_KP); bf16_t* VT1 = (bf16_t*)(ws + WS_VT1);
    float* YS = (float*)(ws + WS_YS); float* HS = (float*)(ws + WS_HS);
    (void)x; (void)c; (void)ctx; (void)cctx; (void)ada_w; (void)ada_b; (void)pre_g; (void)post_g; (void)ev_w_in; (void)ev_w_out; (void)s5_wglu; (void)od_w_in; (void)od_w_out; (void)MOD; (void)HC1; (void)XN; (void)OUTF; (void)VT0; (void)VT1; (void)out;

    if (hipMemsetAsync(ws + WS_CTL, 0, CTL_ZERO_BYTES, stream) != hipSuccess) { fprintf(stderr, "kernel_launch: memset failed\n"); return; }
    Args a{};
    for (int i = 0; i < 32; ++i) a.in[i] = (const float*)d_in[i];
    a.out = (float*)d_out; a.ws = (unsigned char*)d_ws;

    launch_mega(a, 0, N_PHASES, 0, stream);
    (void)relb; (void)conv_w; (void)conv_b; (void)lru_lam; (void)w_a; (void)b_a; (void)w_x; (void)b_x; (void)HS; (void)qn; (void)kn; (void)QP; (void)KP;
    (void)s5_lre; (void)s5_lim; (void)s5_ldt; (void)s5_bre; (void)s5_bim; (void)s5_cre; (void)s5_cim; (void)s5_d; (void)s5_bglu; (void)YS; (void)YPRE; (void)PROJ; (void)YMIX;
}
```

```cpp
#include <hip/hip_runtime.h>
#include <cstdint>
#include <cstdio>

typedef unsigned short bf16_t;
#define DI __device__ __forceinline__
#define GAS __attribute__((address_space(1)))
#define LAS __attribute__((address_space(3)))
typedef unsigned v4u __attribute__((ext_vector_type(4)));
typedef unsigned v2u __attribute__((ext_vector_type(2)));
typedef float f32x4_t __attribute__((ext_vector_type(4)));
typedef float f32x16_t __attribute__((ext_vector_type(16)));
typedef short bf16x8_t __attribute__((ext_vector_type(8)));
typedef short s16x4_t __attribute__((ext_vector_type(4)));
typedef GAS unsigned gu32;
typedef GAS unsigned long long gu64;
#define RLX_AGENT __ATOMIC_RELAXED, __HIP_MEMORY_SCOPE_AGENT
#define LDS_WAIT() asm volatile("s_waitcnt lgkmcnt(0)" ::: "memory")
#define VM_WAIT() asm volatile("s_waitcnt vmcnt(0)" ::: "memory")

DI float bf2f(bf16_t v) { return __uint_as_float((unsigned)v << 16); }
DI bf16_t f2bf(float f) { unsigned u = __float_as_uint(f); return (bf16_t)((u + 0x7fffu + ((u >> 16) & 1u)) >> 16); }
DI unsigned pk2(float lo, float hi) { return (unsigned)f2bf(lo) | ((unsigned)f2bf(hi) << 16); }
DI float bflo(unsigned w) { return __uint_as_float(w << 16); }
DI float bfhi(unsigned w) { return __uint_as_float(w & 0xffff0000u); }
DI float rbf(float f) { return bf2f(f2bf(f)); }
DI float wave_sum(float v) {
#pragma unroll
    for (int o = 1; o < 64; o <<= 1) v += __shfl_xor(v, o);
    return v;
}
DI float sigmoid_f(float x) { return __builtin_amdgcn_rcpf(1.f + __builtin_amdgcn_exp2f(-1.4426950408889634f * x)); }
DI float silu_f(float x) { return x * sigmoid_f(x); }
DI float gelu_tanh(float x) { const float u = 0.7978845608028654f * (x + 0.044715f * x * x * x); return 0.5f * x * (1.f + tanhf(u)); }
DI float gelu_fast(float x) { const float u = 1.5957691216057308f * (x + 0.044715f * x * x * x); return x * sigmoid_f(u); }

constexpr int NWAVES = 8, NTHREADS = 512;
constexpr int DM = 1024, NB = 4, SEQ = 4096, LC = 256;
constexpr int NLAT = NB * SEQ, NCTX = NB * LC, MROWS = NLAT + NCTX;
constexpr int N0 = 3072, N1 = 2304, POSN = LC + SEQ;
constexpr float EPSN = 1e-6f;
constexpr float LOG2E = 1.4426950408889634f;

constexpr size_t MiB = 1u << 20;
constexpr size_t WS_CTL = 0, CTL_ZERO_BYTES = 1 * MiB;
constexpr size_t WS_MOD = 1 * MiB;
constexpr size_t WS_ROPE = 2 * MiB;
constexpr size_t WS_L16 = 3 * MiB;
constexpr size_t WS_WIN0T = 4 * MiB;
constexpr size_t WS_WOUT0T = 10 * MiB;
constexpr size_t WS_WIN1T = 12 * MiB;
constexpr size_t WS_WOUT1T = 17 * MiB;
constexpr size_t WS_WGLUT = 19 * MiB;
constexpr size_t WS_LRUWT = 19 * MiB + 512 * 1024;
constexpr size_t WS_W16 = 20 * MiB;
constexpr size_t WS_WC = 24 * MiB;
constexpr size_t WS_KT = 28 * MiB;
constexpr size_t WS_LSUM = 29 * MiB;
constexpr size_t WS_XN = 32 * MiB;
constexpr size_t WS_YMIX = 66 * MiB;
constexpr size_t WS_PROJ = 100 * MiB;
constexpr size_t WS_VT0 = 202 * MiB;
constexpr size_t WS_UG = 202 * MiB;
constexpr size_t WS_CARRY1 = 219 * MiB;
constexpr size_t WS_YPRE = 228 * MiB;
constexpr size_t WS_QP = 202 * MiB;
constexpr size_t WS_KP = 218 * MiB;
constexpr size_t WS_VT1 = 223 * MiB;
constexpr size_t WS_YS = 32 * MiB;
constexpr size_t WS_HS = 32 * MiB;
constexpr size_t WS_HC1 = 246 * MiB;

DI int row_batch(int r) { return r < NLAT ? (r >> 12) : ((r - NLAT) >> 8); }
DI int row_pos(int r) { return r < NLAT ? LC + (r & 4095) : ((r - NLAT) & 255); }
DI int pos_row(int b, int pos) { return pos < LC ? NLAT + b * LC + pos : b * SEQ + (pos - LC); }

namespace pg8 {
#define PG8_LAS __attribute__((address_space(3)))
typedef unsigned short bf16_t;
typedef short bf16x8 __attribute__((ext_vector_type(8)));
typedef float f32x4 __attribute__((ext_vector_type(4)));
typedef unsigned u32x4 __attribute__((ext_vector_type(4)));
constexpr int BM = 256, BK = 64, HALF = 128, HTB = HALF * BK * 2  , STAGE_BYTES = 8 * HTB, NXCD = 8, WGM = 8;

__host__ __device__ __forceinline__ int lds_byte(int r, int c) { const int st = (r >> 4) * 2 + (c >> 5), rr = r & 15, cc = c & 31, ob = rr * 64 + cc * 2; return st * 1024 + (ob ^ (((ob >> 9) & 1) << 5)); }
__host__ __device__ __forceinline__ void stage_rc(int b, int& R, int& C) { const int st = b / 1024, sb = b % 1024, swz = sb ^ (((sb >> 9) & 1) << 5); R = (st >> 1) * 16 + swz / 64; C = (st & 1) * 32 + (swz % 64) / 2; }
__host__ __device__ __forceinline__ int perm32(int rho) { const int n = rho >> 4, i = rho & 15; return 8 * (i >> 2) + 4 * n + (i & 3); }

struct Unit { int pm, pn; };
struct Gemm { const bf16_t* A; const bf16_t* Bt; int M, N, K; int a_gmajor; };

struct StaticOrder {
    int nM, nN, nwg, G, c;
    __host__ __device__ void init(int M, int N, int G_, int c_) { nM = M / BM; nN = N / BM; nwg = nM * nN; G = G_; c = c_; }
    __host__ __device__ bool next(int i, Unit& u) const {
        const long L = (long)i * G + c; if (L >= nwg) return false;
        int wgid = (int)L; { const int q = nwg / NXCD, r = nwg % NXCD, xcd = wgid % NXCD, off = wgid / NXCD; wgid = (xcd < r ? xcd * (q + 1) : r * (q + 1) + (xcd - r) * q) + off; }
        const int nig = WGM * nN, gid = wgid / nig, fm = gid * WGM, gsz = (nM - fm) < WGM ? (nM - fm) : WGM;
        u.pm = fm + ((wgid % nig) % gsz); u.pn = (wgid % nig) / gsz; return true;
    }
    __device__ __forceinline__ void a_ready(const Unit&) const {}
    __device__ __forceinline__ void done(const Unit&) const {}
};

__device__ __forceinline__ unsigned cvt_pk_bf16(float lo, float hi) { unsigned r; asm volatile("v_cvt_pk_bf16_f32 %0, %1, %2" : "=v"(r) : "v"(lo), "v"(hi)); return r; }

struct EpiProj {
    static constexpr bool PERM = true, AFTER_DRAIN = false;
    bf16_t* P; int ldc; bf16_t* VT; int vt_lo, vt_hi, vt_w; bool vrow; bf16_t* UG; int ug_hi; int qs_lo, qs_hi; float qscale;
    __device__ __forceinline__ void operator()(const f32x4 (&acc)[2][2][4][2], const Unit& u, int wr, int wc, int fr, int fq) const {
        const int row0 = u.pm * BM + wr * 64 + fr, colt = u.pn * BM + wc * 32 + 8 * fq;
#pragma unroll
        for (int ai = 0; ai < 2; ++ai)
#pragma unroll
            for (int m = 0; m < 4; ++m) { const int r = row0 + ai * HALF + m * 16; bf16_t* rowp = P + (size_t)r * ldc + colt;
#pragma unroll
                for (int bj = 0; bj < 2; ++bj) { f32x4 v0 = acc[ai][bj][m][0], v1 = acc[ai][bj][m][1];
                    { const int cq = colt + bj * HALF; if (cq >= qs_lo && cq < qs_hi) { v0 = v0 * qscale; v1 = v1 * qscale; } }
                    u32x4 w; w.x = cvt_pk_bf16(v0[0], v0[1]); w.y = cvt_pk_bf16(v0[2], v0[3]); w.z = cvt_pk_bf16(v1[0], v1[1]); w.w = cvt_pk_bf16(v1[2], v1[3]);
                    const int c0 = colt + bj * HALF;
                    if (c0 < ug_hi) *(u32x4*)(UG + ((size_t)(c0 >> 4) * MROWS + r) * 16 + (c0 & 15)) = w; else *(u32x4*)(rowp + bj * HALF) = w;
                    if (c0 >= vt_lo && c0 < vt_hi && vrow) {
                        const int hd = c0 - vt_lo; *(u32x4*)(VT + ((size_t)(row_batch(r) * (vt_w >> 6) + (hd >> 6)) * POSN + row_pos(r)) * 64 + (hd & 63)) = w;
                    } else if (c0 >= vt_lo && c0 < vt_hi) {
                        bf16_t* vp = VT + ((size_t)row_batch(r) * vt_w + (c0 - vt_lo)) * POSN + row_pos(r);
                        vp[0 * POSN] = (bf16_t)(w.x & 0xffffu); vp[1 * POSN] = (bf16_t)(w.x >> 16); vp[2 * POSN] = (bf16_t)(w.y & 0xffffu); vp[3 * POSN] = (bf16_t)(w.y >> 16);
                        vp[4 * POSN] = (bf16_t)(w.z & 0xffffu); vp[5 * POSN] = (bf16_t)(w.z >> 16); vp[6 * POSN] = (bf16_t)(w.w & 0xffffu); vp[7 * POSN] = (bf16_t)(w.w >> 16);
                    } } }
    }
};
struct EpiGlu {
    static constexpr bool PERM = true, AFTER_DRAIN = false;
    const bf16_t* YPRE; const bf16_t* PROJ; const float* bglu; bf16_t* YMIX;
    __device__ __forceinline__ void operator()(const f32x4 (&acc)[2][2][4][2], const Unit& u, int wr, int wc, int fr, int fq) const {
        const int row0 = u.pm * BM + wr * 64 + fr, colt = u.pn * BM + wc * 32 + 8 * fq;
#pragma unroll
        for (int bj = 0; bj < 2; ++bj) { const int c0 = colt + bj * HALF;
            const f32x4 b0 = *(const f32x4*)(bglu + c0), b1 = *(const f32x4*)(bglu + c0 + 4);
#pragma unroll
            for (int ai = 0; ai < 2; ++ai)
#pragma unroll
                for (int m = 0; m < 4; ++m) { const int r = row0 + ai * HALF + m * 16;
                    const u32x4 yv = *(const u32x4*)(YPRE + ((size_t)(c0 >> 4) * MROWS + r) * 16 + (c0 & 15)), gv = *(const u32x4*)(PROJ + (size_t)r * N0 + 512 + c0);
                    const f32x4 a0 = acc[ai][bj][m][0] + b0, a1 = acc[ai][bj][m][1] + b1;
                    float o[8];
                    o[0] = bflo(yv.x) * sigmoid_f(a0[0]) * silu_f(bflo(gv.x)); o[1] = bfhi(yv.x) * sigmoid_f(a0[1]) * silu_f(bfhi(gv.x));
                    o[2] = bflo(yv.y) * sigmoid_f(a0[2]) * silu_f(bflo(gv.y)); o[3] = bfhi(yv.y) * sigmoid_f(a0[3]) * silu_f(bfhi(gv.y));
                    o[4] = bflo(yv.z) * sigmoid_f(a1[0]) * silu_f(bflo(gv.z)); o[5] = bfhi(yv.z) * sigmoid_f(a1[1]) * silu_f(bfhi(gv.z));
                    o[6] = bflo(yv.w) * sigmoid_f(a1[2]) * silu_f(bflo(gv.w)); o[7] = bfhi(yv.w) * sigmoid_f(a1[3]) * silu_f(bfhi(gv.w));
                    u32x4 w; w.x = cvt_pk_bf16(o[0], o[1]); w.y = cvt_pk_bf16(o[2], o[3]); w.z = cvt_pk_bf16(o[4], o[5]); w.w = cvt_pk_bf16(o[6], o[7]);
                    *(u32x4*)(YMIX + (size_t)r * DM + c0) = w; } }
    }
};
struct EpiF32 {
    static constexpr bool PERM = false, AFTER_DRAIN = false;
    float* O; int ldc;
    __device__ __forceinline__ void operator()(const f32x4 (&acc)[2][2][4][2], const Unit& u, int wr, int wc, int fr, int fq) const {
        const int row0 = u.pm * BM + wr * 64 + fr, col0 = u.pn * BM + wc * 32 + 4 * fq;
#pragma unroll
        for (int ai = 0; ai < 2; ++ai)
#pragma unroll
            for (int m = 0; m < 4; ++m) { float* rowp = O + (size_t)(row0 + ai * HALF + m * 16) * ldc + col0;
#pragma unroll
                for (int bj = 0; bj < 2; ++bj)
#pragma unroll
                    for (int n = 0; n < 2; ++n) *(f32x4*)(rowp + bj * HALF + n * 16) = acc[ai][bj][m][n]; }
    }
};
template <class Epi, class Sched, bool ALIGN_EPI = false, bool SP2 = false>
__device__ __forceinline__ void gemm_phase(PG8_LAS unsigned char* lds, const Gemm g, const Sched& S, const Epi& E) {
    const int tid = threadIdx.x, wid = __builtin_amdgcn_readfirstlane(tid >> 6), lane = tid & 63, wr = wid >> 2, wc = wid & 3, fr = lane & 15, fq = lane >> 4;
    const int K = g.K, nt = K / BK;
    unsigned voffA[2], voffB[2];
#pragma unroll
    for (int i = 0; i < 2; ++i) { int R, C; stage_rc(tid * 16 + i * 8192, R, C); const int Rb = Epi::PERM ? ((R & ~31) + perm32(R & 31)) : R;
        voffA[i] = g.a_gmajor ? (unsigned)(((C >> 4) * g.M + R) * 16 + (C & 15)) * 2u : (unsigned)(R * K + C) * 2u; voffB[i] = (unsigned)(Rb * K + C) * 2u; }
    const size_t kstep = (size_t)(BK * 2);
    const size_t hstep = (size_t)HALF * K * 2;
    const size_t tstep = 2 * hstep;
    const size_t kstepA = g.a_gmajor ? (size_t)(BK / 16) * g.M * 32 : kstep, hstepA = g.a_gmajor ? (size_t)HALF * 32 : hstep, tstepA = 2 * hstepA;
    const unsigned ldsw = (unsigned)wid * 1024u;
    const int aoff = lds_byte(wr * 64 + fr, fq * 8), boff = lds_byte(wc * 32 + fr, fq * 8);
#define PG8_SA(b, h) (((b) * 2 + (h)) * HTB)
#define PG8_SB(b, h) ((4 + (b) * 2 + (h)) * HTB)
#define PG8_STAGE(bufoff, gbase, voff) do { _Pragma("unroll") for (int _i = 0; _i < 2; ++_i) \
        __builtin_amdgcn_global_load_lds((const unsigned*)((const char*)(gbase) + (voff)[_i]), (PG8_LAS unsigned*)(lds + (bufoff) + ldsw + _i * 8192), 16, 0, 0); } while (0)
#define PG8_LDA(dst, b, h) do { _Pragma("unroll") for (int m = 0; m < 4; ++m) _Pragma("unroll") for (int k = 0; k < 2; ++k) dst[m][k] = *(const PG8_LAS bf16x8*)(lds + PG8_SA(b, h) + aoff + m * 2048 + k * 1024); } while (0)
#define PG8_LDB(dst, b, h) do { _Pragma("unroll") for (int n = 0; n < 2; ++n) _Pragma("unroll") for (int k = 0; k < 2; ++k) dst[n][k] = *(const PG8_LAS bf16x8*)(lds + PG8_SB(b, h) + boff + n * 2048 + k * 1024); } while (0)
#define PG8_MMA(ai, bj, At, Bt) do { __builtin_amdgcn_s_setprio(1); _Pragma("unroll") for (int m = 0; m < 4; ++m) _Pragma("unroll") for (int n = 0; n < 2; ++n) _Pragma("unroll") for (int k = 0; k < 2; ++k) \
        acc[ai][bj][m][n] = __builtin_amdgcn_mfma_f32_16x16x32_bf16(Bt[n][k], At[m][k], acc[ai][bj][m][n], 0, 0, 0); __builtin_amdgcn_s_setprio(0); } while (0)
#define PG8_WAIT_V(n) asm volatile("s_waitcnt vmcnt(" #n ")" ::: "memory")
#define PG8_WAIT_L(n) asm volatile("s_waitcnt lgkmcnt(" #n ")" ::: "memory")
#define PG8_BAR __builtin_amdgcn_s_barrier()
#define PG8_SCHED __builtin_amdgcn_sched_barrier(0)
    Unit cur, nxt; int ui = 0;
    if (!S.next(0, cur)) return;
    f32x4 acc[2][2][4][2];
#pragma unroll
    for (int a = 0; a < 2; ++a)
#pragma unroll
        for (int b = 0; b < 2; ++b)
#pragma unroll
            for (int m = 0; m < 4; ++m)
#pragma unroll
                for (int n = 0; n < 2; ++n) acc[a][b][m][n] = (f32x4){0.f, 0.f, 0.f, 0.f};
    bf16x8 At[4][2], B0[2][2], B1[2][2];
    const char* cA = (const char*)g.A + (size_t)cur.pm * tstepA; const char* cB = (const char*)g.Bt + (size_t)cur.pn * tstep;
    S.a_ready(cur);
    if constexpr (SP2) {
        PG8_STAGE(PG8_SB(0, 0), cB, voffB); PG8_STAGE(PG8_SB(0, 1), cB + hstep, voffB); PG8_STAGE(PG8_SA(0, 0), cA, voffA); PG8_STAGE(PG8_SA(0, 1), cA + hstepA, voffA);
        if (wr == 1) PG8_BAR;
        PG8_WAIT_V(2); PG8_BAR;
        PG8_STAGE(PG8_SB(1, 0), cB + kstep, voffB); PG8_STAGE(PG8_SA(1, 0), cA + kstepA, voffA); PG8_STAGE(PG8_SB(1, 1), cB + hstep + kstep, voffB);
        PG8_WAIT_V(6); PG8_BAR;
    } else {
        PG8_STAGE(PG8_SB(0, 0), cB, voffB); PG8_STAGE(PG8_SA(0, 0), cA, voffA); PG8_STAGE(PG8_SB(0, 1), cB + hstep, voffB); PG8_STAGE(PG8_SA(0, 1), cA + hstepA, voffA);
        if (wr == 1) PG8_BAR;
        PG8_WAIT_V(4); PG8_BAR;
        PG8_STAGE(PG8_SB(1, 0), cB + kstep, voffB); PG8_STAGE(PG8_SA(1, 0), cA + kstepA, voffA); PG8_STAGE(PG8_SB(1, 1), cB + hstep + kstep, voffB);
        PG8_WAIT_V(6); PG8_BAR;
    }
    for (;;) {
        const bool has_next = S.next(ui + 1, nxt);
        const char* nA = has_next ? (const char*)g.A + (size_t)nxt.pm * tstepA : cA; const char* nB = has_next ? (const char*)g.Bt + (size_t)nxt.pn * tstep : cB;
        for (int t = 0; t < nt; t += 2) {
            const bool last = (t == nt - 2);
            const char* a1 = cA + (size_t)(t + 1) * kstepA;
            const char* a2 = last ? nA : cA + (size_t)(t + 2) * kstepA; const char* b2 = last ? nB : cB + (size_t)(t + 2) * kstep;
            const char* a3 = a2 + kstepA; const char* b3 = b2 + kstep;
            if (last && has_next) S.a_ready(nxt);
            if constexpr (SP2) {
            PG8_LDB(B0, 0, 0); PG8_LDB(B1, 0, 1); PG8_SCHED; PG8_LDA(At, 0, 0); PG8_STAGE(PG8_SA(1, 1), a1 + hstepA, voffA);
            PG8_WAIT_V(8); PG8_WAIT_L(0); PG8_BAR; PG8_MMA(0, 0, At, B0); PG8_MMA(0, 1, At, B1); PG8_BAR; PG8_SCHED;
            PG8_LDA(At, 0, 1); PG8_STAGE(PG8_SB(0, 0), b2, voffB); PG8_STAGE(PG8_SB(0, 1), b2 + hstep, voffB); PG8_STAGE(PG8_SA(0, 0), a2, voffA);
            PG8_WAIT_V(8); PG8_WAIT_L(0); PG8_BAR; PG8_MMA(1, 0, At, B0); PG8_MMA(1, 1, At, B1); PG8_BAR; PG8_SCHED;
            PG8_LDB(B0, 1, 0); PG8_LDB(B1, 1, 1); PG8_SCHED; PG8_LDA(At, 1, 0); PG8_STAGE(PG8_SA(0, 1), a2 + hstepA, voffA);
            PG8_WAIT_V(8); PG8_WAIT_L(0); PG8_BAR; PG8_MMA(0, 0, At, B0); PG8_MMA(0, 1, At, B1); PG8_BAR; PG8_SCHED;
            PG8_LDA(At, 1, 1); PG8_STAGE(PG8_SB(1, 0), b3, voffB); PG8_STAGE(PG8_SB(1, 1), b3 + hstep, voffB); PG8_STAGE(PG8_SA(1, 0), a3, voffA);
            PG8_WAIT_V(8); PG8_WAIT_L(0); PG8_BAR; PG8_MMA(1, 0, At, B0); PG8_MMA(1, 1, At, B1); PG8_BAR; PG8_SCHED;
            } else {
            PG8_LDB(B0, 0, 0); PG8_SCHED; PG8_LDA(At, 0, 0); PG8_STAGE(PG8_SA(1, 1), a1 + hstepA, voffA);
            PG8_WAIT_L(8); PG8_BAR; PG8_WAIT_L(0); PG8_MMA(0, 0, At, B0); PG8_BAR; PG8_SCHED;
            PG8_LDB(B1, 0, 1); PG8_STAGE(PG8_SB(0, 0), b2, voffB);
            PG8_BAR; PG8_WAIT_L(0); PG8_MMA(0, 1, At, B1); PG8_BAR;
            PG8_LDA(At, 0, 1); PG8_STAGE(PG8_SA(0, 0), a2, voffA);
            PG8_BAR; PG8_WAIT_L(0); PG8_MMA(1, 0, At, B0); PG8_BAR; PG8_SCHED;
            PG8_STAGE(PG8_SB(0, 1), b2 + hstep, voffB);
            PG8_WAIT_V(6); PG8_BAR; PG8_MMA(1, 1, At, B1); PG8_BAR;
            PG8_LDB(B0, 1, 0); PG8_SCHED; PG8_LDA(At, 1, 0); PG8_STAGE(PG8_SA(0, 1), a2 + hstepA, voffA);
            PG8_WAIT_L(8); PG8_BAR; PG8_WAIT_L(0); PG8_MMA(0, 0, At, B0); PG8_BAR; PG8_SCHED;
            PG8_LDB(B1, 1, 1); PG8_STAGE(PG8_SB(1, 0), b3, voffB);
            PG8_BAR; PG8_WAIT_L(0); PG8_MMA(0, 1, At, B1); PG8_BAR;
            PG8_LDA(At, 1, 1); PG8_STAGE(PG8_SA(1, 0), a3, voffA);
            PG8_BAR; PG8_WAIT_L(0); PG8_MMA(1, 0, At, B0); PG8_BAR; PG8_SCHED;
            PG8_STAGE(PG8_SB(1, 1), b3 + hstep, voffB);
            PG8_WAIT_V(6); PG8_BAR; PG8_MMA(1, 1, At, B1); PG8_BAR;
            }
        }
        if constexpr (ALIGN_EPI) { if (wr == 0) PG8_BAR; }
        if constexpr (!Epi::AFTER_DRAIN) { E(acc, cur, wr, wc, fr, fq); S.done(cur); }
        if (!has_next) break;
#pragma unroll
        for (int a = 0; a < 2; ++a)
#pragma unroll
            for (int b = 0; b < 2; ++b)
#pragma unroll
                for (int m = 0; m < 4; ++m)
#pragma unroll
                    for (int n = 0; n < 2; ++n) acc[a][b][m][n] = (f32x4){0.f, 0.f, 0.f, 0.f};
        cur = nxt; cA = nA; cB = nB; ++ui;
        if constexpr (ALIGN_EPI) { if (wr == 1) PG8_BAR; }
    }
    PG8_WAIT_V(0);
    if constexpr (!ALIGN_EPI) { if (wr == 0) PG8_BAR; }
    PG8_BAR;
    if constexpr (Epi::AFTER_DRAIN) { E.fused(acc, cur, wr, wc, fr, fq, lds, wid, lane); S.done(cur); }
#undef PG8_SA
#undef PG8_SB
#undef PG8_STAGE
#undef PG8_LDA
#undef PG8_LDB
#undef PG8_MMA
#undef PG8_WAIT_V
#undef PG8_WAIT_L
#undef PG8_BAR
#undef PG8_SCHED
}
}
#define XB_TMO      128
#define XB_XCNT(j)  (256  + 64 * (j))
#define XB_XSUB(j)  (1280 + 64 * (j))
#define XB_XGEN(j)  (2304 + 64 * (j))
#define XB_TOP      3328
#define XB_TOPGEN   3392
#define XCD_BAR_WORDS 3456
#define XB_SPIN_CAP (1u << 18)

__device__ __forceinline__ unsigned xb_ld(unsigned* p)              { return __hip_atomic_load(p, __ATOMIC_RELAXED, __HIP_MEMORY_SCOPE_AGENT); }
__device__ __forceinline__ unsigned xb_add(unsigned* p, unsigned v) { return __hip_atomic_fetch_add(p, v, __ATOMIC_RELAXED, __HIP_MEMORY_SCOPE_AGENT); }
__device__ __forceinline__ unsigned xb_xcc_id() { return (unsigned)__builtin_amdgcn_s_getreg((3 << 11) | 20) & 0xFu; }
#define XB_SPIN(cond, bar) do { unsigned _sp = 0; while (cond) { __builtin_amdgcn_s_sleep(1); \
    if ((++_sp & 255u) == 0u) { if (xb_ld(&(bar)[XB_TMO])) break; if (_sp > XB_SPIN_CAP) { atomicAdd(&(bar)[XB_TMO], 1u); break; } } } } while (0)

struct XcdBarrier {
    unsigned* bar; unsigned x;
    volatile LAS unsigned* st;
};

__device__ __forceinline__ XcdBarrier xcd_barrier_post(unsigned* bar, volatile LAS unsigned* st) {
    XcdBarrier b; b.bar = bar; b.x = xb_xcc_id(); b.st = st;
    if (threadIdx.x == 0) (void)xb_add(&bar[XB_XCNT(b.x)], 1u);
    return b;
}
__device__ __forceinline__ void xcd_barrier_complete(unsigned* bar, unsigned x, unsigned& nloc, unsigned& nx) {
    const unsigned G = gridDim.x * gridDim.y * gridDim.z;
    unsigned sum, cnt, mine, sp = 0u;
    for (;;) {
        sum = 0u; cnt = 0u; mine = 0u;
#pragma unroll
        for (unsigned j = 0; j < 16; ++j) { const unsigned c = xb_ld(&bar[XB_XCNT(j)]); sum += c; cnt += (c > 0u) ? 1u : 0u; mine = (j == x) ? c : mine; }
        if (sum == G) break;
        __builtin_amdgcn_s_sleep(1);
        if ((++sp & 255u) == 0u) { if (xb_ld(&bar[XB_TMO])) break; if (sp > XB_SPIN_CAP) { atomicAdd(&bar[XB_TMO], 1u); break; } }
    }
    nloc = mine > 0u ? mine : 1u; nx = cnt > 0u ? cnt : 1u;
}

__device__ __forceinline__ void xcd_barrier(const XcdBarrier& b) {
    asm volatile("s_waitcnt vmcnt(0)" ::: "memory");
    __syncthreads();
    if (threadIdx.x == 0) {
        unsigned* bar = b.bar;
        __builtin_amdgcn_s_waitcnt(0);
        unsigned nloc = b.st[0], nx = b.st[1];
        if (nloc == 0u) { xcd_barrier_complete(bar, b.x, nloc, nx); b.st[0] = nloc; b.st[1] = nx; }
        const unsigned old = xb_add(&bar[XB_XSUB(b.x)], 1u);
        const unsigned gen = old / nloc;
        if (old + 1u == (gen + 1u) * nloc) {
            __builtin_amdgcn_fence(__ATOMIC_RELEASE, "agent");
            asm volatile("s_waitcnt vmcnt(0)" ::: "memory");
            const unsigned og = xb_add(&bar[XB_TOP], 1u);
            const unsigned tg = og / nx;
            if (og + 1u == (tg + 1u) * nx) xb_add(&bar[XB_TOPGEN], 1u);
            else XB_SPIN(xb_ld(&bar[XB_TOPGEN]) == tg, bar);
            __builtin_amdgcn_fence(__ATOMIC_ACQUIRE, "agent");
            xb_add(&bar[XB_XGEN(b.x)], 1u);
            asm volatile("s_waitcnt vmcnt(0)" ::: "memory");
        } else {
            XB_SPIN(xb_ld(&bar[XB_XGEN(b.x)]) == gen, bar);
            __builtin_amdgcn_fence(__ATOMIC_ACQUIRE, "agent");
            asm volatile("s_waitcnt vmcnt(0)" ::: "memory");
        }
    }
    __syncthreads();
}

DI int crow16(int reg, int hf) { return (reg & 3) + 8 * (reg >> 2) + 4 * hf; }
DI unsigned cvtpk(float lo, float hi) { typedef float f2 __attribute__((ext_vector_type(2))); typedef __bf16 b2 __attribute__((ext_vector_type(2))); f2 v = {lo, hi}; b2 b = __builtin_convertvector(v, b2); return __builtin_bit_cast(unsigned, b); }
struct AttnP { const bf16_t* Q; const bf16_t* K; const bf16_t* VT; const bf16_t* Gt; bf16_t* Y; const float* relb; };

template <int MODE> DI void attn_unit(int unit, const AttnP& P, int lane) {
    const int ql = lane & 31, hf = lane >> 5;
    int b, h, kvh, qrow, NT, rp = 0, ci = 0, rs0 = 0, c0 = 0, qr = 0, qc = 0, rsq = 0, csq = 0;
    if (MODE == 0) { ci = unit & 3; rp = (unit >> 2) & 31; h = (unit >> 7) & 7; b = unit >> 10; kvh = h;
        qr = 2 * rp + (ql >> 4); qc = 16 * ci + (ql & 15); qrow = b * SEQ + qr * 64 + qc;
        rs0 = min(max(2 * rp - 4, 0), 56); const int rs1 = min(max(2 * rp - 3, 0), 56); NT = 8 + (rs1 + 8 - rs0);
        c0 = min(max(16 * ci - 8, 0), 32); rsq = min(max(qr - 4, 0), 56); csq = min(max(qc - 8, 0), 48);
    } else if (MODE == 1) { const int qt = unit & 7; h = (unit >> 3) & 7; b = unit >> 6; kvh = h; qrow = NLAT + b * LC + 32 * qt + ql; NT = 8; }
    else { const int qt = unit & 127; h = (unit >> 7) & 7; b = unit >> 10; kvh = h >> 2; qrow = b * SEQ + 32 * qt + ql; NT = POSN / 32; }
    const bf16_t* qp; const bf16_t* kb; size_t kpitch; const bf16_t* vt; const bf16_t* gp; bf16_t* yp;
    if (MODE == 2) { qp = P.Q + ((size_t)(b * 8 + h) * SEQ + (qrow - b * SEQ)) * 64; kb = P.K + (size_t)(b * 2 + kvh) * POSN * 64; kpitch = 64;
        vt = P.VT + (size_t)(b * 2 + kvh) * 64 * POSN; gp = P.Gt + (size_t)qrow * N1 + 1792 + h * 64; }
    else { qp = P.Q + (size_t)qrow * N0 + 1024 + h * 64; kb = P.K + 1536 + h * 64; kpitch = N0; vt = P.VT + (size_t)(b * 8 + h) * 64 * POSN; gp = P.Gt + (size_t)qrow * N0 + 2560 + h * 64; }
    yp = P.Y + (size_t)qrow * DM + 512 + h * 64;
    bf16x8_t qf[4];
#pragma unroll
    for (int ks = 0; ks < 4; ++ks) qf[ks] = *(const bf16x8_t*)(qp + 16 * ks + 8 * hf);
    const bf16_t* vt0 = vt + (size_t)ql * POSN + 4 * hf;
    f32x16_t o0 = {}, o1 = {};
    float m = -1e30f, l = 0.f;
    auto tile_krow = [&](int t) -> int { if (MODE == 2) return 32 * t + ql; if (t < 8) return NLAT + b * LC + 32 * t + ql; return b * SEQ + (rs0 + t - 8) * 64 + c0 + ql; };
    auto tile_pos0 = [&](int t) -> int { if (MODE == 2) return 32 * t; if (t < 8) return 32 * t; return LC + (rs0 + t - 8) * 64 + c0; };
    bf16x8_t kn[4];
    { const bf16_t* kp = kb + (size_t)tile_krow(0) * kpitch + 8 * hf;
#pragma unroll
      for (int ks = 0; ks < 4; ++ks) kn[ks] = *(const bf16x8_t*)(kp + 16 * ks); }
#pragma unroll 1
    for (int t = 0; t < NT; ++t) {
        bf16x8_t kf[4];
#pragma unroll
        for (int ks = 0; ks < 4; ++ks) kf[ks] = kn[ks];
        if (t + 1 < NT) { const bf16_t* kp = kb + (size_t)tile_krow(t + 1) * kpitch + 8 * hf;
#pragma unroll
            for (int ks = 0; ks < 4; ++ks) kn[ks] = *(const bf16x8_t*)(kp + 16 * ks); }
        const bf16_t* vp = vt0 + tile_pos0(t);
        s16x4_t va[2][2][2];
#pragma unroll
        for (int dt = 0; dt < 2; ++dt)
#pragma unroll
            for (int s = 0; s < 2; ++s) { va[dt][s][0] = *(const s16x4_t*)(vp + (size_t)dt * 32 * POSN + 16 * s); va[dt][s][1] = *(const s16x4_t*)(vp + (size_t)dt * 32 * POSN + 16 * s + 8); }
        f32x16_t sc = {};
#pragma unroll
        for (int ks = 0; ks < 4; ++ks) sc = __builtin_amdgcn_mfma_f32_32x32x16_bf16(kf[ks], qf[ks], sc, 0, 0, 0);
        float xs[16];
        if (MODE == 0 && t >= 8) {
            const int kr = rs0 + t - 8; const bool row_ok = (kr >= rsq) && (kr < rsq + 8);
            const float* rb = P.relb + (h * 15 + (kr - qr + 7)) * 31 + (15 - qc);
#pragma unroll
            for (int r = 0; r < 16; ++r) { const int kc = c0 + crow16(r, hf); const bool ok = row_ok && (kc >= csq) && (kc < csq + 16);
                const float bias = ok ? rb[kc] : 0.f; xs[r] = ok ? (sc[r] * 0.125f + bias) * LOG2E : -1e30f; }
        } else {
#pragma unroll
            for (int r = 0; r < 16; ++r) xs[r] = (MODE == 2) ? sc[r] : sc[r] * (0.125f * LOG2E);
        }
        float tm = xs[0];
#pragma unroll
        for (int r = 1; r < 16; ++r) tm = fmaxf(tm, xs[r]);
        tm = fmaxf(tm, __shfl_xor(tm, 32));
        const float mn = fmaxf(m, tm), al = __builtin_amdgcn_exp2f(m - mn);
        float ps = 0.f;
#pragma unroll
        for (int r = 0; r < 16; ++r) { xs[r] = __builtin_amdgcn_exp2f(xs[r] - mn); ps += xs[r]; }
        l = l * al + ps; m = mn;
#pragma unroll
        for (int r = 0; r < 16; ++r) { o0[r] *= al; o1[r] *= al; }
        bf16x8_t pf[2];
#pragma unroll
        for (int s = 0; s < 2; ++s) { v4u w; w.x = cvtpk(xs[8 * s], xs[8 * s + 1]); w.y = cvtpk(xs[8 * s + 2], xs[8 * s + 3]); w.z = cvtpk(xs[8 * s + 4], xs[8 * s + 5]); w.w = cvtpk(xs[8 * s + 6], xs[8 * s + 7]);
            pf[s] = __builtin_bit_cast(bf16x8_t, w); }
#pragma unroll
        for (int s = 0; s < 2; ++s) {
            const bf16x8_t a0 = __builtin_shufflevector(va[0][s][0], va[0][s][1], 0, 1, 2, 3, 4, 5, 6, 7);
            const bf16x8_t a1 = __builtin_shufflevector(va[1][s][0], va[1][s][1], 0, 1, 2, 3, 4, 5, 6, 7);
            o0 = __builtin_amdgcn_mfma_f32_32x32x16_bf16(a0, pf[s], o0, 0, 0, 0);
            o1 = __builtin_amdgcn_mfma_f32_32x32x16_bf16(a1, pf[s], o1, 0, 0, 0);
        }
    }
    l += __shfl_xor(l, 32);
    const float rl = 1.f / l;
#pragma unroll
    for (int dt = 0; dt < 2; ++dt)
#pragma unroll
        for (int rg = 0; rg < 4; ++rg) { const int d = 32 * dt + 8 * rg + 4 * hf;
            const v2u gv = *(const v2u*)(gp + d);
            const float g0 = silu_f(bflo(gv.x)), g1 = silu_f(bfhi(gv.x)), g2 = silu_f(bflo(gv.y)), g3 = silu_f(bfhi(gv.y));
            const f32x16_t& oo = dt ? o1 : o0;
            v2u w; w.x = pk2(oo[4 * rg] * rl * g0, oo[4 * rg + 1] * rl * g1); w.y = pk2(oo[4 * rg + 2] * rl * g2, oo[4 * rg + 3] * rl * g3);
            *(v2u*)(yp + d) = w; }
}

typedef float f32x2_t __attribute__((ext_vector_type(2)));
constexpr int LRU_NCOL = 272;
struct LruP { const bf16_t* P1; const float* conv_w; const float* conv_b; const float* lam; const float* b_a; const float* b_x; const bf16_t* WT; f32x2_t* SUM16; bf16_t* YMIX; };
constexpr int LRU_WTL = 0, LRU_CWL = 36864, LRU_BAX = LRU_CWL + 1280, LRU_XW = LRU_BAX + 1536, LRU_CARRY = LRU_XW + 8 * 4160, LRU_FOLD = LRU_CARRY + 16384;

DI void lru_setup(int nb, const LruP& p, LAS unsigned char* lds, int tid) {
    __syncthreads();
    for (int e = tid; e < 256 * 8; e += NTHREADS) { const int row = e >> 3, ch = e & 7; *(LAS v4u*)(lds + LRU_WTL + row * 144 + ch * 16) = *(const v4u*)(p.WT + (size_t)(nb * 256 + row) * 64 + ch * 8); }
    LAS float* CW = (LAS float*)(lds + LRU_CWL); LAS float* BAX = (LAS float*)(lds + LRU_BAX);
    if (tid < 320) CW[tid] = tid < 256 ? p.conv_w[(tid >> 6) * 512 + nb * 64 + (tid & 63)] : p.conv_b[nb * 64 + (tid & 63)];
    if (tid < 128) { const int dir = tid >> 6, ch = tid & 63; BAX[(dir * 3 + 0) * 64 + ch] = p.b_a[dir * 512 + nb * 64 + ch]; BAX[(dir * 3 + 1) * 64 + ch] = p.b_x[dir * 512 + nb * 64 + ch];
        BAX[(dir * 3 + 2) * 64 + ch] = log1pf(__expf(-p.lam[dir * 512 + nb * 64 + ch])); }
    __syncthreads();
}

template <bool PASS2> DI void lru_micro(int b, int col, int nb, int ci, const LruP& p, LAS unsigned char* lds, int wave, int lane) {
    const int n = lane & 15, q = lane >> 4;
    const int s0 = col < 16 ? NLAT + b * LC : b * SEQ, sl = col < 16 ? LC : SEQ, t0 = col < 16 ? col * 16 : (col - 16) * 16;
    LAS float* CW = (LAS float*)(lds + LRU_CWL); LAS float* BAX = (LAS float*)(lds + LRU_BAX); LAS float* XW = (LAS float*)(lds + LRU_XW + wave * 4160);
    v4u xr[4][2];
#pragma unroll
    for (int j = 0; j < 4; ++j) { const int tt = t0 + n + j - 1; const bool ok = tt >= 0 && tt < sl;
#pragma unroll
        for (int ks = 0; ks < 2; ++ks) { xr[j][ks] = (v4u){0u, 0u, 0u, 0u}; if (ok) xr[j][ks] = *(const v4u*)(p.P1 + (size_t)(s0 + tt) * N1 + nb * 64 + 32 * ks + 8 * q); } }
    bf16x8_t af[2];
#pragma unroll
    for (int ks = 0; ks < 2; ++ks) { const int c = 32 * ks + 8 * q;
        float xc[8];
        const f32x4_t bb0 = *(const LAS f32x4_t*)(CW + 256 + c), bb1 = *(const LAS f32x4_t*)(CW + 256 + c + 4);
#pragma unroll
        for (int e = 0; e < 4; ++e) { xc[e] = bb0[e]; xc[4 + e] = bb1[e]; }
#pragma unroll
        for (int j = 0; j < 4; ++j) { const f32x4_t w0 = *(const LAS f32x4_t*)(CW + j * 64 + c), w1 = *(const LAS f32x4_t*)(CW + j * 64 + c + 4); const v4u xx = xr[j][ks];
            xc[0] += w0[0] * bflo(xx.x); xc[1] += w0[1] * bfhi(xx.x); xc[2] += w0[2] * bflo(xx.y); xc[3] += w0[3] * bfhi(xx.y);
            xc[4] += w1[0] * bflo(xx.z); xc[5] += w1[1] * bfhi(xx.z); xc[6] += w1[2] * bflo(xx.w); xc[7] += w1[3] * bfhi(xx.w); }
        v4u w; w.x = pk2(xc[0], xc[1]); w.y = pk2(xc[2], xc[3]); w.z = pk2(xc[4], xc[5]); w.w = pk2(xc[6], xc[7]); af[ks] = __builtin_bit_cast(bf16x8_t, w);
#pragma unroll
        for (int e = 0; e < 8; ++e) XW[n * 65 + c + e] = xc[e]; }
    float hsum[4][4];
#pragma unroll
    for (int c4 = 0; c4 < 4; ++c4)
#pragma unroll
        for (int r = 0; r < 4; ++r) hsum[c4][r] = 0.f;
#pragma unroll 1
    for (int dir = 0; dir < 2; ++dir) {
        f32x4_t acc[8];
#pragma unroll
        for (int nt = 0; nt < 8; ++nt) { acc[nt] = (f32x4_t){0.f, 0.f, 0.f, 0.f};
            const LAS unsigned char* wrow = lds + LRU_WTL + ((dir * 2 + (nt >> 2)) * 64 + (nt & 3) * 16 + n) * 144 + 16 * q;
#pragma unroll
            for (int ks = 0; ks < 2; ++ks) { const bf16x8_t bfr = *(const LAS bf16x8_t*)(wrow + 64 * ks); acc[nt] = __builtin_amdgcn_mfma_f32_16x16x32_bf16(af[ks], bfr, acc[nt], 0, 0, 0); } }
        float a[4][4], bt[4][4];
#pragma unroll
        for (int c4 = 0; c4 < 4; ++c4) { const int ch = c4 * 16 + n;
            const float ba = BAX[(dir * 3 + 0) * 64 + ch], bx = BAX[(dir * 3 + 1) * 64 + ch], sp = BAX[(dir * 3 + 2) * 64 + ch];
#pragma unroll
            for (int r = 0; r < 4; ++r) { const float gr = sigmoid_f(acc[c4][r] + ba), gi = sigmoid_f(acc[c4 + 4][r] + bx);
                const float log_a = -8.f * gr * sp; const float av = __builtin_amdgcn_exp2f(log_a * LOG2E); a[c4][r] = av;
                const float x2 = 2.f * log_a;
                const float ser = -x2 * (1.f + x2 * (0.5f + x2 * (0.16666667f + x2 * (0.041666668f + x2 * 0.0083333338f))));
                const float om = x2 > -0.5f ? ser : 1.f - av * av;
                bt[c4][r] = __builtin_amdgcn_sqrtf(fmaxf(om, 0.f)) * gi * XW[(4 * q + r) * 65 + ch]; } }
        float Pq[4], Sq[4];
#pragma unroll
        for (int c4 = 0; c4 < 4; ++c4) { float P = 1.f, S = 0.f;
#pragma unroll
            for (int rr = 0; rr < 4; ++rr) { const int r = dir == 0 ? rr : 3 - rr; S = a[c4][r] * S + bt[c4][r]; P *= a[c4][r]; }
            Pq[c4] = P; Sq[c4] = S; }
        float Pin[4], Sin[4];
#pragma unroll
        for (int c4 = 0; c4 < 4; ++c4) { float P = 1.f, S = 0.f, Pw = 1.f, Sw = 0.f;
#pragma unroll
            for (int kk = 0; kk < 4; ++kk) { const int k = dir == 0 ? kk : 3 - kk;
                const float pk = __shfl(Pq[c4], n + 16 * k), sk = __shfl(Sq[c4], n + 16 * k);
                const bool before = dir == 0 ? (k < q) : (k > q);
                if (before) { S = pk * S + sk; P *= pk; }
                Sw = pk * Sw + sk; Pw *= pk; }
            Pin[c4] = P; Sin[c4] = S;
            if (!PASS2 && q == 0) p.SUM16[((size_t)((b * 8 + nb) * LRU_NCOL + col) * 2 + dir) * 64 + c4 * 16 + n] = (f32x2_t){Pw, Sw}; }
        if (PASS2) {
            const LAS float* CARRYL = (const LAS float*)(lds + LRU_CARRY);
#pragma unroll
            for (int c4 = 0; c4 < 4; ++c4) { float h = CARRYL[(dir * 32 + ci) * 64 + c4 * 16 + n];
                h = Pin[c4] * h + Sin[c4];
#pragma unroll
                for (int rr = 0; rr < 4; ++rr) { const int r = dir == 0 ? rr : 3 - rr; h = a[c4][r] * h + bt[c4][r]; hsum[c4][r] += h; } }
        }
    }
    if (PASS2) {
        asm volatile("s_waitcnt lgkmcnt(0)" ::: "memory");
#pragma unroll
        for (int c4 = 0; c4 < 4; ++c4)
#pragma unroll
            for (int r = 0; r < 4; ++r) XW[(4 * q + r) * 65 + c4 * 16 + n] = hsum[c4][r];
        asm volatile("s_waitcnt lgkmcnt(0)" ::: "memory");
        const int tk = lane >> 2, cg = lane & 3; const size_t row = (size_t)(s0 + t0 + tk);
        const bf16_t* gp = p.P1 + row * N1 + 512 + nb * 64 + cg * 16;
        const v4u g0 = *(const v4u*)gp, g1 = *(const v4u*)(gp + 8);
        float y[16];
#pragma unroll
        for (int e = 0; e < 16; ++e) y[e] = XW[tk * 65 + cg * 16 + e];
        v4u o0, o1;
        o0.x = pk2(y[0] * silu_f(bflo(g0.x)), y[1] * silu_f(bfhi(g0.x))); o0.y = pk2(y[2] * silu_f(bflo(g0.y)), y[3] * silu_f(bfhi(g0.y)));
        o0.z = pk2(y[4] * silu_f(bflo(g0.z)), y[5] * silu_f(bfhi(g0.z))); o0.w = pk2(y[6] * silu_f(bflo(g0.w)), y[7] * silu_f(bfhi(g0.w)));
        o1.x = pk2(y[8] * silu_f(bflo(g1.x)), y[9] * silu_f(bfhi(g1.x))); o1.y = pk2(y[10] * silu_f(bflo(g1.y)), y[11] * silu_f(bfhi(g1.y)));
        o1.z = pk2(y[12] * silu_f(bflo(g1.z)), y[13] * silu_f(bfhi(g1.z))); o1.w = pk2(y[14] * silu_f(bflo(g1.w)), y[15] * silu_f(bfhi(g1.w)));
        bf16_t* yp = p.YMIX + row * DM + nb * 64 + cg * 16;
        *(v4u*)yp = o0; *(v4u*)(yp + 8) = o1;
    }
    asm volatile("s_waitcnt lgkmcnt(0)" ::: "memory");
}

DI int lru_order_col(int dir, int k) { return dir == 0 ? k : (k < 16 ? 15 - k : 16 + (271 - k)); }

DI void lru_block(int blk, bool pass2, const LruP& p, LAS unsigned char* lds, int tid, int wave, int lane) {
    const int nb = blk & 7, b = (blk >> 3) & 3, cr = blk >> 5;
    lru_setup(nb, p, lds, tid);
    if (!pass2) {
        for (int i = wave; i < 34; i += NWAVES) { const int col = i < 32 ? 16 + 32 * cr + i : 2 * cr + (i - 32); lru_micro<false>(b, col, nb, 0, p, lds, wave, lane); }
        return;
    }
    LAS float* CARRYL = (LAS float*)(lds + LRU_CARRY); LAS f32x2_t* FOLD = (LAS f32x2_t*)(lds + LRU_FOLD);
    const int chain = tid & 127, part = tid >> 7, dir = chain >> 6, ch = chain & 63;
    const f32x2_t* SB = p.SUM16 + (size_t)(b * 8 + nb) * LRU_NCOL * 128 + dir * 64 + ch;
    const int kfirst = dir == 0 ? 16 + 32 * cr : 240 - 32 * cr;
    { const int k0 = (kfirst * part) >> 2, k1 = (kfirst * (part + 1)) >> 2;
      float P = 1.f, S = 0.f;
#pragma unroll 4
      for (int k = k0; k < k1; ++k) { const f32x2_t s = SB[(size_t)lru_order_col(dir, k) * 128]; S = s[0] * S + s[1]; P *= s[0]; }
      FOLD[part * 128 + chain] = (f32x2_t){P, S}; }
    __syncthreads();
    if (part == 0) { float S = 0.f;
#pragma unroll
        for (int pp = 0; pp < 4; ++pp) { const f32x2_t s = FOLD[pp * 128 + chain]; S = s[0] * S + s[1]; }
        for (int i = 0; i < 32; ++i) { const int col = lru_order_col(dir, kfirst + i), ci = col - (16 + 32 * cr);
            CARRYL[(dir * 32 + ci) * 64 + ch] = S; const f32x2_t s = SB[(size_t)col * 128]; S = s[0] * S + s[1]; } }
    __syncthreads();
    for (int i = wave; i < 32; i += NWAVES) lru_micro<true>(b, 16 + 32 * cr + i, nb, i, p, lds, wave, lane);
}

DI float row16_sum(float v) {
    v += __builtin_bit_cast(float, __builtin_amdgcn_update_dpp(0, __builtin_bit_cast(int, v), 0xB1, 0xf, 0xf, false));
    v += __builtin_bit_cast(float, __builtin_amdgcn_update_dpp(0, __builtin_bit_cast(int, v), 0x4E, 0xf, 0xf, false));
    v += __builtin_bit_cast(float, __builtin_amdgcn_update_dpp(0, __builtin_bit_cast(int, v), 0x141, 0xf, 0xf, false));
    v += __builtin_bit_cast(float, __builtin_amdgcn_update_dpp(0, __builtin_bit_cast(int, v), 0x140, 0xf, 0xf, false));
    return v;
}
DI void qkprep_row(int r, const bf16_t* P1, const float* qn, const float* kn, const float* ROPE, bf16_t* QP, bf16_t* KP, int lane) {
    const int b = row_batch(r); const bool lat = r < NLAT; const int t = r & 4095, l16 = lane & 15, hh = lane >> 4;
    f32x4_t cs = {1.f, 0.f, 1.f, 0.f};
    if (lat) cs = *(const f32x4_t*)(ROPE + ((size_t)t * 32 + 2 * l16) * 2);
    const f32x4_t wq = *(const f32x4_t*)(qn + 4 * l16), wk = *(const f32x4_t*)(kn + 4 * l16);
#pragma unroll
    for (int hg = 0; hg < 3; ++hg) {
        if (hg < 2 && !lat) continue;
        const int slot = hg < 2 ? hg * 4 + hh : 8 + (hh & 1);
        const int col0 = slot < 8 ? 1024 + slot * 64 : 1536 + (slot - 8) * 64;
        const v2u xx = *(const v2u*)(P1 + (size_t)r * N1 + col0 + 4 * l16);
        float x[4] = {bflo(xx.x), bfhi(xx.x), bflo(xx.y), bfhi(xx.y)};
        const float ss = row16_sum(x[0] * x[0] + x[1] * x[1] + x[2] * x[2] + x[3] * x[3]);
        const float rinv = rsqrtf(ss * (1.f / 64.f) + EPSN);
        const f32x4_t w = hg < 2 ? wq : wk;
#pragma unroll
        for (int e = 0; e < 4; ++e) x[e] *= rinv * w[e];
        const float y0 = x[0] * cs[0] - x[1] * cs[1], y1 = x[0] * cs[1] + x[1] * cs[0], y2 = x[2] * cs[2] - x[3] * cs[3], y3 = x[2] * cs[3] + x[3] * cs[2];
        if (hg < 2) { const float sc = 0.125f * LOG2E; v2u o; o.x = pk2(y0 * sc, y1 * sc); o.y = pk2(y2 * sc, y3 * sc); *(v2u*)(QP + ((size_t)(b * 8 + slot) * SEQ + t) * 64 + 4 * l16) = o; }
        else if (hh < 2) { v2u o; o.x = pk2(y0, y1); o.y = pk2(y2, y3); *(v2u*)(KP + ((size_t)(b * 2 + (slot - 8)) * POSN + row_pos(r)) * 64 + 4 * l16) = o; }
    }
}

constexpr size_t WS_CARRY0 = 246 * MiB;
constexpr int S5_NCOL = 272;

DI void s5_lambar_pow(double lre, double lim, double dt, int e, double& pr, double& pi) { const double mag = exp(lre * dt * e), ang = lim * dt * e; pr = mag * cos(ang); pi = mag * sin(ang); }
typedef double f64x2_t __attribute__((ext_vector_type(2)));
DI void s5_tables_block(int item, const float* lam_re, const float* lam_im, const float* log_dt, const float* b_re, const float* b_im, const float* c_re, const float* c_im,
                        bf16_t* W16, bf16_t* WC, bf16_t* KT, float* L16, LAS unsigned char* lds, int tid) {
    const int part = item & 3, gd = item >> 2, g = gd >> 1, dir = gd & 1, gi = dir * 32 + g;
    LAS f64x2_t* POW = (LAS f64x2_t*)lds;
    LAS f64x2_t* PC = POW + 17 * 64;
    __syncthreads();
    if (tid < 64) { const int p = tid;
        const double dt = exp((double)log_dt[gi]), lre = lam_re[gi * 64 + p], lim = lam_im[gi * 64 + p];
        double l1r, l1i; s5_lambar_pow(lre, lim, dt, 1, l1r, l1i);
        const double nr = l1r - 1.0, ni = l1i, den = lre * lre + lim * lim, cfr = (nr * lre + ni * lim) / den, cfi = (ni * lre - nr * lim) / den;
        double pr = 1.0, pi = 0.0;
        for (int e = 0; e <= 16; ++e) { POW[e * 64 + p] = (f64x2_t){pr, pi}; PC[e * 64 + p] = (f64x2_t){pr * cfr - pi * cfi, pr * cfi + pi * cfr};
            if (e == 16 && part == 0) { L16[((g * 2 + dir) * 64 + p) * 2] = (float)pr; L16[((g * 2 + dir) * 64 + p) * 2 + 1] = (float)pi; }
            const double tr = pr * l1r - pi * l1i, ti = pr * l1i + pi * l1r; pr = tr; pi = ti; } }
    __syncthreads();
    for (int idx = tid; idx < 32 * 256; idx += NTHREADS) { const int row = 32 * part + (idx >> 8), k = idx & 255, p = row >> 1, c = row & 1, tp = k >> 4, hi = k & 15;
        const f64x2_t z = PC[(dir == 0 ? 15 - tp : tp) * 64 + p]; const double br = b_re[(gi * 64 + p) * 16 + hi], bi = b_im[(gi * 64 + p) * 16 + hi];
        W16[(size_t)(gd * 128 + row) * 256 + k] = f2bf((float)(c == 0 ? z[0] * br - z[1] * bi : z[0] * bi + z[1] * br)); }
    for (int idx = tid; idx < 64 * 128; idx += NTHREADS) { const int row = 64 * part + (idx >> 7), k = idx & 127, p = k >> 1, c = k & 1, t = row >> 4, ho = row & 15;
        const f64x2_t z = POW[((dir == 0 ? t : 15 - t) + 1) * 64 + p]; const double cr = c_re[(gi * 16 + ho) * 64 + p], ci = c_im[(gi * 16 + ho) * 64 + p];
        WC[(size_t)(gd * 256 + row) * 128 + k] = f2bf((float)(c == 0 ? cr * z[0] - ci * z[1] : -(cr * z[1] + ci * z[0]))); }
    for (int idx = tid; idx < 1024; idx += NTHREADS) { const int e = 1024 * part + idx, tau = e >> 8, ho = (e >> 4) & 15, hi = e & 15;
        double acc = 0.0;
#pragma unroll 4
        for (int p = 0; p < 64; ++p) { const f64x2_t z = PC[tau * 64 + p]; const double cr = c_re[(gi * 16 + ho) * 64 + p], ci = c_im[(gi * 16 + ho) * 64 + p];
            const double ar = cr * z[0] - ci * z[1], ai = cr * z[1] + ci * z[0];
            acc += ar * (double)b_re[(gi * 64 + p) * 16 + hi] - ai * (double)b_im[(gi * 64 + p) * 16 + hi]; }
        KT[(size_t)gd * 4096 + e] = f2bf((float)acc); }
}

DI int s5_tile_row0(int b, int s) { return s == 0 ? NLAT + b * LC : b * SEQ + (s - 1) * 256; }
template <int D> DI float dpp_shr(float v) { return __builtin_bit_cast(float, __builtin_amdgcn_update_dpp(0, __builtin_bit_cast(int, v), 0x110 + D, 0xf, 0xf, true)); }
DI void cmul(float ar, float ai, float br, float bi, float& cr, float& ci) { cr = ar * br - ai * bi; ci = ar * bi + ai * br; }

DI void s5_scan_unit(int cu, int m, const bf16_t* UG, const bf16_t* W16, const float* L16, bf16_t* CARRY0, bf16_t* CARRY1, int lane) {
    const int dir = cu & 1, b = (cu >> 1) & 3, g = cu >> 3;
    const int n = lane & 15, q = lane >> 4;
    bf16x8_t wf[8];
#pragma unroll
    for (int ks = 0; ks < 8; ++ks) wf[ks] = *(const bf16x8_t*)(W16 + ((size_t)(g * 2 + dir) * 128 + m * 16 + n) * 256 + 32 * ks + 8 * q);
    float Lr[2][5], Li[2][5];
    float Lnr[2], Lni[2];
    float cr[2], ci[2];
#pragma unroll
    for (int st = 0; st < 2; ++st) { const int p = 8 * m + 2 * q + st;
        Lr[st][0] = L16[((g * 2 + dir) * 64 + p) * 2]; Li[st][0] = L16[((g * 2 + dir) * 64 + p) * 2 + 1];
#pragma unroll
        for (int k = 1; k < 5; ++k) cmul(Lr[st][k - 1], Li[st][k - 1], Lr[st][k - 1], Li[st][k - 1], Lr[st][k], Li[st][k]);
        float rr = 1.f, ri = 0.f;
#pragma unroll
        for (int k = 0; k < 5; ++k) if ((n + 1) & (1 << k)) { float tr, ti; cmul(rr, ri, Lr[st][k], Li[st][k], tr, ti); rr = tr; ri = ti; }
        Lnr[st] = rr; Lni[st] = ri; cr[st] = 0.f; ci[st] = 0.f; }
    bf16_t* CARRY = (dir == 0 ? CARRY0 : CARRY1) + (size_t)(b * 32 + g) * S5_NCOL * 128;
    const int jcol = dir == 0 ? n : 15 - n;
    bf16x8_t un[8];
    { const bf16_t* ub = UG + ((size_t)g * MROWS + s5_tile_row0(b, 0) + jcol * 16 + (q >> 1)) * 16 + 8 * (q & 1);
#pragma unroll
      for (int ks = 0; ks < 8; ++ks) un[ks] = *(const bf16x8_t*)(ub + (2 * ks) * 16); }
#pragma unroll 1
    for (int it = 0; it < 17; ++it) {
        const int s = it == 0 ? 0 : (dir == 0 ? it : 17 - it);
        bf16x8_t uf[8];
#pragma unroll
        for (int ks = 0; ks < 8; ++ks) uf[ks] = un[ks];
        if (it + 1 < 17) { const int sn = dir == 0 ? it + 1 : 16 - it;
            const bf16_t* ub = UG + ((size_t)g * MROWS + s5_tile_row0(b, sn) + jcol * 16 + (q >> 1)) * 16 + 8 * (q & 1);
#pragma unroll
            for (int ks = 0; ks < 8; ++ks) un[ks] = *(const bf16x8_t*)(ub + (2 * ks) * 16); }
        f32x4_t acc = {0.f, 0.f, 0.f, 0.f};
#pragma unroll
        for (int ks = 0; ks < 8; ++ks) acc = __builtin_amdgcn_mfma_f32_16x16x32_bf16(wf[ks], uf[ks], acc, 0, 0, 0);
        float hin[4];
#pragma unroll
        for (int st = 0; st < 2; ++st) {
            float xr = acc[2 * st], xi = acc[2 * st + 1];
            { float yr, yi, tr, ti;
              yr = dpp_shr<1>(xr); yi = dpp_shr<1>(xi); cmul(Lr[st][0], Li[st][0], yr, yi, tr, ti); xr += tr; xi += ti;
              yr = dpp_shr<2>(xr); yi = dpp_shr<2>(xi); cmul(Lr[st][1], Li[st][1], yr, yi, tr, ti); xr += tr; xi += ti;
              yr = dpp_shr<4>(xr); yi = dpp_shr<4>(xi); cmul(Lr[st][2], Li[st][2], yr, yi, tr, ti); xr += tr; xi += ti;
              yr = dpp_shr<8>(xr); yi = dpp_shr<8>(xi); cmul(Lr[st][3], Li[st][3], yr, yi, tr, ti); xr += tr; xi += ti; }
            float tr, ti; cmul(Lnr[st], Lni[st], cr[st], ci[st], tr, ti);
            const float Hr = xr + tr, Hi = xi + ti;
            const float pr = dpp_shr<1>(Hr), pi = dpp_shr<1>(Hi);
            hin[2 * st] = n == 0 ? cr[st] : pr; hin[2 * st + 1] = n == 0 ? ci[st] : pi;
            cr[st] = __shfl(Hr, (lane & 48) | 15); ci[st] = __shfl(Hi, (lane & 48) | 15);
        }
        v2u w; w.x = pk2(hin[0], hin[1]); w.y = pk2(hin[2], hin[3]);
        *(v2u*)(CARRY + (size_t)(s * 16 + jcol) * 128 + m * 16 + 4 * q) = w;
    }
}

DI void s5_load_wc(bf16x8_t (&wc)[2][2][4], int g, const bf16_t* WC, int wave, int lane) {
    const int n = lane & 15, q = lane >> 4;
#pragma unroll
    for (int m2 = 0; m2 < 2; ++m2)
#pragma unroll
        for (int dir = 0; dir < 2; ++dir)
#pragma unroll
            for (int ks = 0; ks < 4; ++ks) wc[m2][dir][ks] = *(const bf16x8_t*)(WC + ((size_t)(g * 2 + dir) * 256 + (2 * wave + m2) * 16 + n) * 128 + 8 * q + 32 * ks);
}
DI void s5_out_item(int g, int b, int s, const bf16_t* UG, const bf16x8_t (&wc)[2][2][4], const bf16_t* CARRY0, const bf16_t* CARRY1, const float* dsk, bf16_t* YPRE, LAS unsigned char* lds, int wave, int lane) {
    const int n = lane & 15, q = lane >> 4;
    const int row0 = s5_tile_row0(b, s);
    const bf16_t* ub = UG + ((size_t)g * MROWS + row0 + n * 16 + (q >> 1)) * 16 + 8 * (q & 1);
    bf16x8_t uf[8];
#pragma unroll
    for (int ks = 0; ks < 8; ++ks) uf[ks] = *(const bf16x8_t*)(ub + (2 * ks) * 16);
    bf16x8_t cf[2][4];
#pragma unroll
    for (int dir = 0; dir < 2; ++dir)
#pragma unroll
        for (int ks = 0; ks < 4; ++ks) cf[dir][ks] = *(const bf16x8_t*)((dir == 0 ? CARRY0 : CARRY1) + ((size_t)(b * 32 + g) * S5_NCOL + s * 16 + n) * 128 + 32 * ks + 8 * q);
    v2u uu[2];
#pragma unroll
    for (int m2 = 0; m2 < 2; ++m2) uu[m2] = *(const v2u*)(UG + ((size_t)g * MROWS + row0 + n * 16 + 2 * wave + m2) * 16 + 4 * q);
    const f32x4_t dd = *(const f32x4_t*)(dsk + g * 16 + 4 * q);
#pragma unroll
    for (int m2 = 0; m2 < 2; ++m2) {
        const int mt = 2 * wave + m2;
        bf16x8_t ta[2][8];
#pragma unroll
        for (int dir = 0; dir < 2; ++dir)
#pragma unroll
            for (int ks = 0; ks < 8; ++ks) { const int tp = 2 * ks + (q >> 1), tau = dir == 0 ? mt - tp : tp - mt;
                const int off = tau >= 0 ? (((dir * 16 + tau) * 16 + n) * 32 + 16 * (q & 1)) : 16384;
                ta[dir][ks] = *(const LAS bf16x8_t*)(lds + off); }
        f32x4_t acc = {0.f, 0.f, 0.f, 0.f};
#pragma unroll
        for (int dir = 0; dir < 2; ++dir) {
#pragma unroll
            for (int ks = 0; ks < 4; ++ks) acc = __builtin_amdgcn_mfma_f32_16x16x32_bf16(wc[m2][dir][ks], cf[dir][ks], acc, 0, 0, 0);
#pragma unroll
            for (int ks = 0; ks < 8; ++ks) acc = __builtin_amdgcn_mfma_f32_16x16x32_bf16(ta[dir][ks], uf[ks], acc, 0, 0, 0);
        }
        const size_t tok = (size_t)(row0 + n * 16 + mt);
        const float y0 = gelu_fast(acc[0] + dd[0] * bflo(uu[m2].x)), y1 = gelu_fast(acc[1] + dd[1] * bfhi(uu[m2].x)), y2 = gelu_fast(acc[2] + dd[2] * bflo(uu[m2].y)), y3 = gelu_fast(acc[3] + dd[3] * bfhi(uu[m2].y));
        v2u w; w.x = pk2(y0, y1); w.y = pk2(y2, y3);
        *(v2u*)(YPRE + ((size_t)g * MROWS + tok) * 16 + 4 * q) = w;
    }
}

#include <hip/hip_bf16.h>
namespace gqa_body {
using bf16=__hip_bfloat16;
using bf16x8=__attribute__((ext_vector_type(8)))short;
using s16x4=__attribute__((ext_vector_type(4)))short;
using f32x16=__attribute__((ext_vector_type(16)))float;
using u32x4=__attribute__((ext_vector_type(4)))unsigned;
constexpr int NHEAD=8,SEQQ=4096,SKV=4352,D=64,QPITCH=64,KPITCH=64,VPITCH=64,OPITCH=1024,GPITCH=2304;
constexpr int NW=8,QBLK=32,QB=QBLK*NW,KVBLK=64,NQB=SEQQ/QB,NTILES=SKV/KVBLK;
constexpr int ATTN_UNIT_ROWS=QB;
__device__ __forceinline__ int crow(int r,int hi){return (r&3)+8*(r>>2)+4*hi;}
#define SBAR() __builtin_amdgcn_sched_barrier(0)
constexpr int NSLOT=3, SLOTB=8192;
constexpr int LDS_K=0, LDS_V=NSLOT*SLOTB, LDS_WS=2*NSLOT*SLOTB, LDS_OST=LDS_WS+NW*64*4, LDS_BYTES=LDS_OST+NW*4096;
constexpr float C2=0.125f*1.4426950408889634f;
__device__ __forceinline__ void glds16(const void*gsrc,unsigned lds_dst){unsigned keep;
  asm volatile("s_mov_b32 %0, m0\n\ts_mov_b32 m0, %2\n\ts_nop 0\n\tglobal_load_lds_dwordx4 %1, off\n\ts_mov_b32 m0, %0":"=&s"(keep):"v"(gsrc),"s"(lds_dst):"memory");}
__device__ __forceinline__ float max3f(float a,float b,float c){float r;asm("v_max3_f32 %0, %1, %2, %3":"=v"(r):"v"(a),"v"(b),"v"(c));return r;}
__device__ __forceinline__ float max2f(float a,float b){float r;asm("v_max_f32_e32 %0, %1, %2":"=v"(r):"v"(a),"v"(b));return r;}
__device__ __forceinline__ float fadd_s(float a,float b){float r;asm("v_add_f32_e32 %0, %1, %2":"=v"(r):"v"(a),"v"(b));return r;}
__device__ __forceinline__ float fsub_s(float a,float b){float r;asm("v_sub_f32_e32 %0, %1, %2":"=v"(r):"v"(a),"v"(b));return r;}
typedef float f32x2_t __attribute__((ext_vector_type(2))); typedef __bf16 bf16x2_t __attribute__((ext_vector_type(2)));
__device__ __forceinline__ unsigned cvtpk_s(float lo,float hi){f32x2_t v={lo,hi};bf16x2_t b=__builtin_convertvector(v,bf16x2_t);return __builtin_bit_cast(unsigned,b);}
#define WAIT_BAR(N) asm volatile("s_waitcnt vmcnt(" #N ") lgkmcnt(0)\n\ts_barrier":::"memory")

__device__ __forceinline__ void qkt(f32x16&p0,f32x16&p1,const char*Kslot,const bf16x8*qr,const f32x16&negm,int r32,int hi){
  const char*kb=Kslot+hi*1024+r32*16;
  #pragma unroll
  for(int d0=0;d0<4;++d0){
    const bf16x8 b0=*reinterpret_cast<const bf16x8*>(kb+d0*2048);
    const bf16x8 b1=*reinterpret_cast<const bf16x8*>(kb+d0*2048+512);
    if(d0==0){p0=__builtin_amdgcn_mfma_f32_32x32x16_bf16(b0,qr[0],negm,0,0,0);p1=__builtin_amdgcn_mfma_f32_32x32x16_bf16(b1,qr[0],negm,0,0,0);}
    else{p0=__builtin_amdgcn_mfma_f32_32x32x16_bf16(b0,qr[d0],p0,0,0,0);p1=__builtin_amdgcn_mfma_f32_32x32x16_bf16(b1,qr[d0],p1,0,0,0);}}
}
typedef __attribute__((address_space(3))) const char* lds_cptr;
typedef short v4i16_t __attribute__((ext_vector_type(4)));
__device__ __forceinline__ void kload8(bf16x8*kf,lds_cptr kp){
  kf[0]=*(const __attribute__((address_space(3))) bf16x8*)(kp);      kf[1]=*(const __attribute__((address_space(3))) bf16x8*)(kp+512);
  kf[2]=*(const __attribute__((address_space(3))) bf16x8*)(kp+2048); kf[3]=*(const __attribute__((address_space(3))) bf16x8*)(kp+2560);
  kf[4]=*(const __attribute__((address_space(3))) bf16x8*)(kp+4096); kf[5]=*(const __attribute__((address_space(3))) bf16x8*)(kp+4608);
  kf[6]=*(const __attribute__((address_space(3))) bf16x8*)(kp+6144); kf[7]=*(const __attribute__((address_space(3))) bf16x8*)(kp+6656);
}
__device__ __forceinline__ void kload2(bf16x8*kf,lds_cptr kp,int j){ kf[2*j]=*(const __attribute__((address_space(3))) bf16x8*)(kp+j*2048); kf[2*j+1]=*(const __attribute__((address_space(3))) bf16x8*)(kp+j*2048+512); }
__device__ __forceinline__ s16x4 vtr(lds_cptr p){ return __builtin_bit_cast(s16x4,__builtin_amdgcn_ds_read_tr16_b64_v4i16((__attribute__((address_space(3))) v4i16_t*)p)); }
__device__ __forceinline__ float rowmax(const f32x16&p0,const f32x16&p1){
  float a=max3f(p0[0],p0[1],p1[0]),b=max3f(p0[2],p0[3],p1[1]);a=max3f(a,p1[2],p1[3]);
  #pragma unroll
  for(int r=4;r<16;r+=4){a=max3f(a,p0[r],p0[r+1]);b=max3f(b,p0[r+2],p0[r+3]);a=max3f(a,p1[r],p1[r+1]);b=max3f(b,p1[r+2],p1[r+3]);}
  const float m=max2f(a,b);
  auto rr=__builtin_amdgcn_permlane32_swap(__float_as_uint(m),__float_as_uint(m),false,false);
  return max2f(__uint_as_float(rr[0]),__uint_as_float(rr[1]));
}
__device__ __forceinline__ void pv(f32x16*o,int vb,bf16x8 pa0,bf16x8 pa1,bf16x8 pa2,bf16x8 pa3){
  #pragma unroll
  for(int d0=0;d0<2;++d0){s16x4 lo[4],hi[4];
    #pragma unroll
    for(int ks=0;ks<4;++ks){
      asm volatile("ds_read_b64_tr_b16 %0,%1 offset:%c2":"=&v"(lo[ks]):"v"(vb),"i"(d0*4096+ks*1024):"memory");
      asm volatile("ds_read_b64_tr_b16 %0,%1 offset:%c2":"=&v"(hi[ks]):"v"(vb),"i"(d0*4096+ks*1024+512):"memory");}
    asm volatile("s_waitcnt lgkmcnt(0)":::"memory");SBAR();
    #define PK(k) (bf16x8){lo[k][0],lo[k][1],lo[k][2],lo[k][3],hi[k][0],hi[k][1],hi[k][2],hi[k][3]}
    o[d0]=__builtin_amdgcn_mfma_f32_32x32x16_bf16(pa0,PK(0),o[d0],0,0,0);
    o[d0]=__builtin_amdgcn_mfma_f32_32x32x16_bf16(pa1,PK(1),o[d0],0,0,0);
    o[d0]=__builtin_amdgcn_mfma_f32_32x32x16_bf16(pa2,PK(2),o[d0],0,0,0);
    o[d0]=__builtin_amdgcn_mfma_f32_32x32x16_bf16(pa3,PK(3),o[d0],0,0,0);
    #undef PK
  }
}

#ifndef ATTN_STORE16
#define ATTN_STORE16(p,v) (*(u32x4*)(p)=(v))
#endif
template<int THRL> __device__ __forceinline__ void attn_unit(int b,int h,int qb,const bf16*Q,const bf16*__restrict__ K,const bf16*__restrict__ V,bf16*O,const bf16*Gt,char*shm){
  const int tid=threadIdx.x,lane=tid&63,r32=lane&31,hi=lane>>5; const int wid=__builtin_amdgcn_readfirstlane(tid>>6);
  const int q0=qb*QB;
  const bf16*Qw=Q+((long)(b*NHEAD+h)*SEQQ+q0+wid*QBLK)*QPITCH;
  const bf16*Kh=K+(long)(b*2+(h>>2))*SKV*KPITCH,*Vh=V+(long)(b*2+(h>>2))*SKV*VPITCH;
  const unsigned lds0=(unsigned)(uintptr_t)shm;
  float*wsf=(float*)(shm+LDS_WS)+wid*64;
  const bf16*ksrc=Kh+(long)lane*KPITCH+wid*8;
  const bf16*vsrc=Vh+(long)(16*(wid&3)+(lane>>2))*VPITCH+(wid>>2)*32+(lane&3)*8;
  const unsigned kdst=lds0+LDS_K+wid*1024, vdst=lds0+LDS_V+wid*1024;
  #define DMA_K(t,slot) glds16(ksrc+(long)(t)*KVBLK*KPITCH,(unsigned)__builtin_amdgcn_readfirstlane(kdst+(slot)))
  #define DMA_V(t,slot) glds16(vsrc+(long)(t)*KVBLK*VPITCH,(unsigned)__builtin_amdgcn_readfirstlane(vdst+(slot)))
  const int vb0=(int)(lds0+LDS_V)+((lane>>4)&1)*32+(lane&3)*8+(4*hi+((lane&15)>>2))*64;
  const char*Kbase=shm+LDS_K; bf16x8 kf[8];
  const lds_cptr shm3=(lds_cptr)shm; const lds_cptr kp0=shm3+LDS_K+hi*1024+r32*16; const lds_cptr vp0=shm3+LDS_V+((lane>>4)&1)*32+(lane&3)*8+(4*hi+((lane&15)>>2))*64;
  constexpr int NT=NTILES;
  DMA_K(0,0);DMA_V(0,0);DMA_K(1,SLOTB);
  bf16x8 qr[4];
  #pragma unroll
  for(int d0=0;d0<4;++d0)qr[d0]=*reinterpret_cast<const bf16x8*>(&Qw[(long)r32*QPITCH+d0*16+hi*8]);
  float mhat=0.f,l_reg=0.f;f32x16 o[2];o[0]=f32x16{};o[1]=f32x16{};f32x16 negm=f32x16{};asm volatile("":"+v"(negm));
  #define CMASK(P0,P1,t) do{}while(0)
  bool resc=false;
  #define START(P0,P1) do{ const float rm=rowmax(P0,P1); resc=false; \
    { const float dl=rm; mhat=fadd_s(mhat,dl); \
      _Pragma("unroll") for(int r=0;r<16;++r){P0[r]=fsub_s(P0[r],dl);P1[r]=fsub_s(P1[r],dl);} \
      _Pragma("unroll") for(int r=0;r<16;++r)negm[r]=-mhat; asm volatile("":"+v"(negm)); } \
    _Pragma("unroll") for(int r=0;r<16;++r)P0[r]=__builtin_amdgcn_exp2f(P0[r]); }while(0)
  #define RESC() do{ if(resc){ asm volatile("s_waitcnt lgkmcnt(0)":::"memory"); \
      _Pragma("unroll") for(int d_=0;d_<2;++d_) _Pragma("unroll") for(int r=0;r<16;++r)o[d_][r]*=wsf[crow(r,hi)]; } }while(0)
  f32x16 pA0,pA1,pB0,pB1;
  int sl_prev=0,sl_cur=0,sl_next=SLOTB;
  #define ROT() do{sl_prev=sl_cur;sl_cur=sl_next;sl_next=(sl_next==(NSLOT-1)*SLOTB)?0:sl_next+SLOTB;}while(0)
  DMA_K(2,2*SLOTB);
  WAIT_BAR(3);
  qkt(pA0,pA1,Kbase,qr,negm,r32,hi);asm volatile("s_nop 15\n\ts_nop 7":"+v"(pA0),"+v"(pA1));CMASK(pA0,pA1,0);
  START(pA0,pA1);
  _Pragma("unroll") for(int r=0;r<16;++r)pA1[r]=__builtin_amdgcn_exp2f(pA1[r]);
  WAIT_BAR(0);
  DMA_K(3,0);DMA_V(1,SLOTB);
  ROT();
  kload8(kf,kp0+sl_cur);
  WAIT_BAR(2);
  s16x4 vlo[8],vhi[8]; u32x4 pw0,pw1,pw2,pw3;
  #define PKW(P,B) cvtpk_s(P[B],P[B+1])
  #define PAF(k) __builtin_bit_cast(bf16x8,pw##k)
  #define VFR(i) (bf16x8){vlo[i][0],vlo[i][1],vlo[i][2],vlo[i][3],vhi[i][0],vhi[i][1],vhi[i][2],vhi[i][3]}
  #define PIN(x) asm volatile("":"+v"(x))
  #define MX3(a,b,c) __builtin_fmaxf(__builtin_fmaxf((a),(b)),(c))
  #define GAPA(MF,A0,A1,A2,A3,W0,W1,PW) do{ MF; sacc+=A0; sacc+=A1; sacc+=A2; sacc+=A3; PIN(sacc); W0; W1; PIN(PW); SBAR(); }while(0)
  #define EX(v) __builtin_amdgcn_exp2f(v)
  #define GAPB(MF,X,B) do{ MF; X[B]=EX(X[B]); X[B+1]=EX(X[B+1]); X[B+2]=EX(X[B+2]); X[B+3]=EX(X[B+3]); PIN(X); SBAR(); }while(0)
  #define VRD(i) do{ vlo[i]=vtr(vp_+(((i)>>2)*4096+((i)&3)*1024)); vhi[i]=vtr(vp_+(((i)>>2)*4096+((i)&3)*1024+512)); }while(0)
  #define KRD(G,j) do{ if(G){ kload2(kf,kp0+sl_next,j); SBAR(); } }while(0)
  #define STEP(C0,C1,P0,P1,t,GK,GV,GL) do{ SBAR(); \
    const lds_cptr vp_=vp0+sl_prev; \
    VRD(0); SBAR(); float sacc=(P0[0]+P0[1]); \
    GAPA(C0=__builtin_amdgcn_mfma_f32_32x32x16_bf16(kf[0],qr[0],negm,0,0,0), P0[2],P0[3],P0[4],P0[5],     pw0[0]=PKW(P0,0), pw0[1]=PKW(P0,2), pw0); \
    VRD(4); SBAR(); GAPA(C1=__builtin_amdgcn_mfma_f32_32x32x16_bf16(kf[1],qr[0],negm,0,0,0), P0[6],P0[7],P0[8],P0[9],     pw0[2]=PKW(P0,4), pw0[3]=PKW(P0,6), pw0); \
    VRD(1); SBAR(); GAPA(C0=__builtin_amdgcn_mfma_f32_32x32x16_bf16(kf[2],qr[1],C0,0,0,0),   P0[10],P0[11],P0[12],P0[13], pw1[0]=PKW(P0,8), pw1[1]=PKW(P0,10), pw1); \
    VRD(5); SBAR(); GAPA(C1=__builtin_amdgcn_mfma_f32_32x32x16_bf16(kf[3],qr[1],C1,0,0,0),   P0[14],P0[15],P1[0],P1[1],   pw1[2]=PKW(P0,12),pw1[3]=PKW(P0,14), pw1); \
    VRD(2); SBAR(); GAPA(C0=__builtin_amdgcn_mfma_f32_32x32x16_bf16(kf[4],qr[2],C0,0,0,0),   P1[2],P1[3],P1[4],P1[5],     pw2[0]=PKW(P1,0), pw2[1]=PKW(P1,2), pw2); \
    VRD(6); SBAR(); GAPA(C1=__builtin_amdgcn_mfma_f32_32x32x16_bf16(kf[5],qr[2],C1,0,0,0),   P1[6],P1[7],P1[8],P1[9],     pw2[2]=PKW(P1,4), pw2[3]=PKW(P1,6), pw2); \
    VRD(3); SBAR(); GAPA(C0=__builtin_amdgcn_mfma_f32_32x32x16_bf16(kf[6],qr[3],C0,0,0,0),   P1[10],P1[11],P1[12],P1[13], pw3[0]=PKW(P1,8), pw3[1]=PKW(P1,10), pw3); \
    VRD(7); SBAR(); GAPA(C1=__builtin_amdgcn_mfma_f32_32x32x16_bf16(kf[7],qr[3],C1,0,0,0),   P1[14],P1[15],0.f,0.f,       pw3[2]=PKW(P1,12),pw3[3]=PKW(P1,14), pw3); \
    l_reg+=sacc; \
    if(GK){DMA_K((t)+3,sl_cur);} if(GV){DMA_V((t)+1,sl_next);} \
    CMASK(C0,C1,t); \
    { float a=MX3(C0[0],C0[1],C1[0]),b=MX3(C0[2],C0[3],C1[1]); a=MX3(a,C1[2],C1[3]); \
      _Pragma("unroll") for(int r=4;r<16;r+=4){a=MX3(a,C0[r],C0[r+1]);b=MX3(b,C0[r+2],C0[r+3]);a=MX3(a,C1[r],C1[r+1]);b=MX3(b,C1[r+2],C1[r+3]);} \
      float rm=__builtin_fmaxf(a,b); { auto rr=__builtin_amdgcn_permlane32_swap(__float_as_uint(rm),__float_as_uint(rm),false,false); rm=__builtin_fmaxf(__uint_as_float(rr[0]),__uint_as_float(rr[1])); } \
      resc=false; \
      if(__builtin_expect(__any(rm>(float)THRL),0)){ const float dl=__builtin_fmaxf(rm,0.f); mhat+=dl; \
        _Pragma("unroll") for(int r=0;r<16;++r){C0[r]-=dl;C1[r]-=dl;} \
        _Pragma("unroll") for(int r=0;r<16;++r)negm[r]=-mhat; asm volatile("":"+v"(negm)); \
        const float f=__builtin_amdgcn_exp2f(-dl); l_reg*=f; if(hi==0)wsf[r32]=f; resc=true; } } \
    SBAR(); \
    GAPB(o[0]=__builtin_amdgcn_mfma_f32_32x32x16_bf16(PAF(0),VFR(0),o[0],0,0,0), C0,0); \
    GAPB(o[1]=__builtin_amdgcn_mfma_f32_32x32x16_bf16(PAF(0),VFR(4),o[1],0,0,0), C0,4); \
    KRD(GL,0); GAPB(o[0]=__builtin_amdgcn_mfma_f32_32x32x16_bf16(PAF(1),VFR(1),o[0],0,0,0), C0,8); \
    KRD(GL,1); GAPB(o[1]=__builtin_amdgcn_mfma_f32_32x32x16_bf16(PAF(1),VFR(5),o[1],0,0,0), C0,12); \
    KRD(GL,2); GAPB(o[0]=__builtin_amdgcn_mfma_f32_32x32x16_bf16(PAF(2),VFR(2),o[0],0,0,0), C1,0); \
    KRD(GL,3); GAPB(o[1]=__builtin_amdgcn_mfma_f32_32x32x16_bf16(PAF(2),VFR(6),o[1],0,0,0), C1,4); \
    GAPB(o[0]=__builtin_amdgcn_mfma_f32_32x32x16_bf16(PAF(3),VFR(3),o[0],0,0,0), C1,8); \
    GAPB(o[1]=__builtin_amdgcn_mfma_f32_32x32x16_bf16(PAF(3),VFR(7),o[1],0,0,0), C1,12); \
    }while(0)
  int t=1;
  #undef CMASK
  #define CMASK(P0,P1,t) do{}while(0)
  for(;t+5<NT;t+=2){
    STEP(pB0,pB1,pA0,pA1,t,true,true,true);     WAIT_BAR(2); RESC(); ROT();
    STEP(pA0,pA1,pB0,pB1,t+1,true,true,true);   WAIT_BAR(2); RESC(); ROT();
  }
  #undef CMASK
  #define CMASK(P0,P1,t) do{}while(0)
  #define ENDW(tt) do{ if((tt)+3<NT){WAIT_BAR(2);} else if((tt)+2<NT){WAIT_BAR(1);} else {WAIT_BAR(0);} }while(0)
  for(;t+1<NT;t+=2){
    STEP(pB0,pB1,pA0,pA1,t,(t+3<NT),(t+1<NT),(t+1<NT));       ENDW(t);   RESC(); ROT();
    STEP(pA0,pA1,pB0,pB1,t+1,(t+4<NT),(t+2<NT),(t+2<NT));     ENDW(t+1); RESC(); ROT();
  }
  STEP(pB0,pB1,pA0,pA1,NT-1,false,false,false); RESC();
  { float sacc=pB0[0]+pB0[1]; _Pragma("unroll") for(int r=2;r<16;++r)sacc+=pB0[r]; _Pragma("unroll") for(int r=0;r<16;++r)sacc+=pB1[r]; l_reg+=sacc;
    pw0=(u32x4){PKW(pB0,0),PKW(pB0,2),PKW(pB0,4),PKW(pB0,6)};pw1=(u32x4){PKW(pB0,8),PKW(pB0,10),PKW(pB0,12),PKW(pB0,14)};pw2=(u32x4){PKW(pB1,0),PKW(pB1,2),PKW(pB1,4),PKW(pB1,6)};pw3=(u32x4){PKW(pB1,8),PKW(pB1,10),PKW(pB1,12),PKW(pB1,14)};
    SBAR(); pv(o,vb0+sl_cur,PAF(0),PAF(1),PAF(2),PAF(3)); }
  #undef PKW
  #undef PAF
  #undef VFR
  #undef PIN
  #undef MX3
  #undef GAPA
  #undef GAPB
  #undef EX
  #undef VRD
  #undef KRD
  #undef STEP
  #undef ENDW
  {auto rr=__builtin_amdgcn_permlane32_swap(__float_as_uint(l_reg),__float_as_uint(l_reg),false,false);l_reg=__uint_as_float(rr[0])+__uint_as_float(rr[1]);}
  if(hi==0)wsf[32+r32]=l_reg;asm volatile("s_waitcnt lgkmcnt(0)":::"memory");
  float rli[16];
  #pragma unroll
  for(int r=0;r<16;++r)rli[r]=__builtin_amdgcn_rcpf(wsf[32+crow(r,hi)]);
  bf16*Ow=O+((long)b*SEQQ+q0+wid*QBLK)*OPITCH+h*D; const bf16*Gw=Gt+((long)b*SEQQ+q0+wid*QBLK)*GPITCH+h*D;
  { bf16*stg=(bf16*)(shm+LDS_OST)+wid*2048;
    #pragma unroll
    for(int r=0;r<16;++r){const int orow=crow(r,hi);
      #pragma unroll
      for(int d0=0;d0<2;++d0)stg[orow*64+d0*32+r32]=__float2bfloat16(o[d0][r]*rli[r]);}
    asm volatile("s_waitcnt lgkmcnt(0)":::"memory");
    #pragma unroll
    for(int i=0;i<4;++i){const int row=i*8+(lane>>3),ch=lane&7; const u32x4 v=*(const u32x4*)(stg+row*64+ch*8); const u32x4 gv=*(const u32x4*)(Gw+(long)row*GPITCH+ch*8); u32x4 w;
      w.x=pk2(bflo(v.x)*silu_f(bflo(gv.x)),bfhi(v.x)*silu_f(bfhi(gv.x))); w.y=pk2(bflo(v.y)*silu_f(bflo(gv.y)),bfhi(v.y)*silu_f(bfhi(gv.y)));
      w.z=pk2(bflo(v.z)*silu_f(bflo(gv.z)),bfhi(v.z)*silu_f(bfhi(gv.z))); w.w=pk2(bflo(v.w)*silu_f(bflo(gv.w)),bfhi(v.w)*silu_f(bfhi(gv.w)));
      ATTN_STORE16(Ow+(long)row*OPITCH+ch*8,w);} }
  asm volatile("s_waitcnt lgkmcnt(0)\n\ts_barrier":::"memory");
  #undef DMA_K
  #undef DMA_V
  #undef CMASK
  #undef START
  #undef RESC
  #undef ROT
}
constexpr int ATTN_LDS_BYTES=LDS_BYTES;
#undef SBAR
#undef WAIT_BAR
}

typedef short v4i16_t __attribute__((ext_vector_type(4)));
DI s16x4_t vtr16(const LAS unsigned char* p) { return __builtin_bit_cast(s16x4_t, __builtin_amdgcn_ds_read_tr16_b64_v4i16((LAS v4i16_t*)p)); }

struct NaState { f32x16_t o0, o1; float m, l; };
template <bool MASK> DI void na_tile(NaState& st, const bf16x8_t (&qf)[4], const LAS unsigned char* Kb, const LAS unsigned char* Vb, int koff, int lane,
                                     int kr, int qr, int qc, int rsq, int csq, const LAS float* BIAS) {
    const int ql = lane & 31, hf = lane >> 5, row = koff + ql;
    f32x16_t sc = {};
    if (MASK) {
        const bool row_ok = (kr >= rsq) && (kr < rsq + 8);
        const int bbase = (kr - qr + 7) * 31 + (15 - qc);
#pragma unroll
        for (int r = 0; r < 16; ++r) { const int kc = koff + crow16(r, hf); const bool ok = row_ok && (kc >= csq) && (kc < csq + 16); sc[r] = BIAS[ok ? bbase + kc : 465]; }
    }
#pragma unroll
    for (int ks = 0; ks < 4; ++ks) { const bf16x8_t kf = *(const LAS bf16x8_t*)(Kb + row * 128 + (((2 * ks + hf) ^ (row & 7)) << 4)); sc = __builtin_amdgcn_mfma_f32_32x32x16_bf16(kf, qf[ks], sc, 0, 0, 0); }
    const LAS unsigned char* vp = Vb + ((lane >> 4) & 1) * 32 + (lane & 3) * 8 + (koff + 4 * hf + ((lane & 15) >> 2)) * 64;
    s16x4_t vl[2][2], vh[2][2];
#pragma unroll
    for (int dt = 0; dt < 2; ++dt)
#pragma unroll
        for (int s = 0; s < 2; ++s) { vl[dt][s] = vtr16(vp + dt * 4096 + s * 1024); vh[dt][s] = vtr16(vp + dt * 4096 + s * 1024 + 512); }
    float tm = fmaxf(fmaxf(sc[0], sc[1]), sc[2]);
#pragma unroll
    for (int r = 3; r < 15; r += 2) tm = fmaxf(fmaxf(tm, sc[r]), sc[r + 1]);
    tm = fmaxf(tm, sc[15]);
    tm = fmaxf(tm, __shfl_xor(tm, 32));
    const bool mv = tm > st.m + 8.f;
    if (__builtin_amdgcn_ballot_w64(mv) != 0ull) {
        const float mn = mv ? tm : st.m, al = __builtin_amdgcn_exp2f(st.m - mn);
        st.l *= al; st.m = mn;
#pragma unroll
        for (int r = 0; r < 16; ++r) { st.o0[r] *= al; st.o1[r] *= al; }
    }
    float xs[16]; float ps = 0.f;
#pragma unroll
    for (int r = 0; r < 16; ++r) { xs[r] = __builtin_amdgcn_exp2f(sc[r] - st.m); ps += xs[r]; }
    st.l += ps;
#pragma unroll
    for (int s = 0; s < 2; ++s) { v4u w; w.x = cvtpk(xs[8 * s], xs[8 * s + 1]); w.y = cvtpk(xs[8 * s + 2], xs[8 * s + 3]); w.z = cvtpk(xs[8 * s + 4], xs[8 * s + 5]); w.w = cvtpk(xs[8 * s + 6], xs[8 * s + 7]);
        const bf16x8_t pf = __builtin_bit_cast(bf16x8_t, w);
        const bf16x8_t a0 = __builtin_shufflevector(vl[0][s], vh[0][s], 0, 1, 2, 3, 4, 5, 6, 7), a1 = __builtin_shufflevector(vl[1][s], vh[1][s], 0, 1, 2, 3, 4, 5, 6, 7);
        st.o0 = __builtin_amdgcn_mfma_f32_32x32x16_bf16(a0, pf, st.o0, 0, 0, 0);
        st.o1 = __builtin_amdgcn_mfma_f32_32x32x16_bf16(a1, pf, st.o1, 0, 0, 0); }
}

constexpr int NA_BLOCK_UNITS = 512 + 32;
DI void na_block_unit(int unit, const bf16_t* PROJ, const float* relb, bf16_t* YMIX, LAS unsigned char* lds, int tid, int wave, int lane) {
    LAS unsigned char* KB = lds; LAS unsigned char* VB = lds + 16384; LAS float* BIAS = (LAS float*)(lds + 32768);
    const bool lat = unit < 512;
    int b, h, R = 0;
    if (lat) { R = unit & 15; h = (unit >> 4) & 7; b = unit >> 7; } else { const int u = unit - 512; h = u & 7; b = u >> 3; }
    const int ql = lane & 31, hf = lane >> 5;
    int qrow, qr = 0, qc = 0, rsq = 0, csq = 0, c0 = 0, rlo = 0, rhi = 0, rsA = 0, nsteps = 4;
    if (lat) { const int rp = 2 * R + (wave >> 2), ci = wave & 3; qr = 2 * rp + (ql >> 4); qc = 16 * ci + (ql & 15); qrow = b * SEQ + qr * 64 + qc;
        rsq = min(max(qr - 4, 0), 56); csq = min(max(qc - 8, 0), 48); c0 = min(max(16 * ci - 8, 0), 32);
        rlo = min(max(2 * rp - 4, 0), 56); rhi = min(max(2 * rp - 3, 0), 56) + 8;
        rsA = min(max(4 * R - 4, 0), 56); const int rsB = min(max(4 * R - 1, 0), 56); nsteps = 4 + (rsB + 8 - rsA);
    } else qrow = NLAT + b * LC + 32 * wave + ql;
    __syncthreads();
    if (lat) for (int e = tid; e < 466; e += NTHREADS) BIAS[e] = e < 465 ? relb[h * 465 + e] * LOG2E : -1e30f;
    bf16x8_t qf[4];
    { const bf16_t* qp = PROJ + (size_t)qrow * N0 + 1024 + h * 64 + 8 * hf;
#pragma unroll
      for (int ks = 0; ks < 4; ++ks) qf[ks] = *(const bf16x8_t*)(qp + 16 * ks); }
    NaState st; st.o0 = (f32x16_t){}; st.o1 = (f32x16_t){}; st.m = -1e30f; st.l = 0.f;
    const int srow = tid >> 3, sch = tid & 7;
    const int kdst = srow * 128 + ((sch ^ (srow & 7)) << 4), vdst = (sch >> 2) * 4096 + srow * 64 + (sch & 3) * 16;
    auto step_row0 = [&](int s) -> int { return s < 4 ? NLAT + b * LC + 64 * s : b * SEQ + (rsA + s - 4) * 64; };
    v4u kreg, vreg;
    { const bf16_t* src = PROJ + (size_t)(step_row0(0) + srow) * N0 + h * 64 + sch * 8; kreg = *(const v4u*)(src + 1536); vreg = *(const v4u*)(src + 2048); }
#pragma unroll 1
    for (int s = 0; s < nsteps; ++s) {
        LAS unsigned char* kb = KB + (s & 1) * 8192; LAS unsigned char* vb = VB + (s & 1) * 8192;
        *(LAS v4u*)(kb + kdst) = kreg; *(LAS v4u*)(vb + vdst) = vreg;
        __syncthreads();
        if (s + 1 < nsteps) { const bf16_t* src = PROJ + (size_t)(step_row0(s + 1) + srow) * N0 + h * 64 + sch * 8; kreg = *(const v4u*)(src + 1536); vreg = *(const v4u*)(src + 2048); }
        if (s < 4) { na_tile<false>(st, qf, kb, vb, 0, lane, 0, 0, 0, 0, 0, BIAS); na_tile<false>(st, qf, kb, vb, 32, lane, 0, 0, 0, 0, 0, BIAS); }
        else { const int kr = rsA + s - 4; if (kr >= rlo && kr < rhi) na_tile<true>(st, qf, kb, vb, c0, lane, kr, qr, qc, rsq, csq, BIAS); }
    }
    st.l += __shfl_xor(st.l, 32);
    const float rl = 1.f / st.l;
    const bf16_t* gp = PROJ + (size_t)qrow * N0 + 2560 + h * 64; bf16_t* yp = YMIX + (size_t)qrow * DM + 512 + h * 64;
#pragma unroll
    for (int dt = 0; dt < 2; ++dt)
#pragma unroll
        for (int rg = 0; rg < 4; ++rg) { const int d = 32 * dt + 8 * rg + 4 * hf;
            const v2u gv = *(const v2u*)(gp + d);
            const float g0 = silu_f(bflo(gv.x)), g1 = silu_f(bfhi(gv.x)), g2 = silu_f(bflo(gv.y)), g3 = silu_f(bfhi(gv.y));
            const f32x16_t& oo = dt ? st.o1 : st.o0;
            v2u w; w.x = pk2(oo[4 * rg] * rl * g0, oo[4 * rg + 1] * rl * g1); w.y = pk2(oo[4 * rg + 2] * rl * g2, oo[4 * rg + 3] * rl * g3);
            *(v2u*)(yp + d) = w; }
}

#ifdef PROBE_TS_A
#define PSTAMP(i) do { if (blockIdx.x == 0 && tid == 0) ((volatile LAS unsigned*)(lds + 131072 + 320))[16 + (i)] = (unsigned)__builtin_amdgcn_s_memrealtime(); } while (0)
#else
#define PSTAMP(i) do {} while (0)
#endif
struct Args { const float* in[32]; float* out; unsigned char* ws; int ph_lo, ph_hi, li, pad; };
DI void phase3(const Args& args, LAS unsigned char* lds, int tid, int wave, int lane, int G, int pass) {
    unsigned char* ws = args.ws;
    for (int cu = blockIdx.x; cu < 256; cu += G)
        s5_scan_unit(cu, wave, (const bf16_t*)(ws + WS_UG), (const bf16_t*)(ws + WS_W16), (const float*)(ws + WS_L16), (bf16_t*)(ws + WS_CARRY0), (bf16_t*)(ws + WS_CARRY1), lane);
    PSTAMP(40);
    for (int u = blockIdx.x; u < NA_BLOCK_UNITS; u += G) na_block_unit(u, (const bf16_t*)(ws + WS_PROJ), args.in[20], (bf16_t*)(ws + WS_YMIX), lds, tid, wave, lane);
}
DI void phase4(const Args& args, LAS unsigned char* lds, int tid, int wave, int lane, int G) {
    unsigned char* ws = args.ws;
    constexpr int NIT = 32 * 4 * 17;
    const int i0 = (int)(((long)blockIdx.x * NIT) / G), i1 = (int)(((long)(blockIdx.x + 1) * NIT) / G);
    int gcur = -1;
    bf16x8_t wc[2][2][4];
    for (int it = i0; it < i1; ++it) {
        const int g = it / 68, b = (it % 68) / 17, s = it % 17;
        if (g != gcur) { __syncthreads(); for (int e = tid; e < 1024; e += NTHREADS) ((LAS v4u*)lds)[e] = ((const v4u*)(ws + WS_KT))[(size_t)g * 1024 + e];
            if (tid < 2) ((LAS v4u*)(lds + 16384))[tid] = (v4u){0u, 0u, 0u, 0u};
            s5_load_wc(wc, g, (const bf16_t*)(ws + WS_WC), wave, lane); gcur = g; __syncthreads(); }
        s5_out_item(g, b, s, (const bf16_t*)(ws + WS_UG), wc, (const bf16_t*)(ws + WS_CARRY0), (const bf16_t*)(ws + WS_CARRY1), args.in[17], (bf16_t*)(ws + WS_YPRE), lds, wave, lane);
    }
}
DI LruP make_lrup(const Args& args) { unsigned char* ws = args.ws;
    return LruP{(const bf16_t*)(ws + WS_PROJ), args.in[23], args.in[24], args.in[25], args.in[27], args.in[29], (const bf16_t*)(ws + WS_LRUWT), (f32x2_t*)(ws + WS_CARRY0), (bf16_t*)(ws + WS_YMIX)}; }
DI void phase9(const Args& args, LAS unsigned char* lds, int tid, int wave, int lane, int G) {
    unsigned char* ws = args.ws; const LruP lp = make_lrup(args);
    for (int blk = blockIdx.x; blk < 256; blk += G) lru_block(blk, false, lp, lds, tid, wave, lane);
    const int gw = blockIdx.x * NWAVES + wave, NGW = G * NWAVES;
    for (int r = gw; r < MROWS; r += NGW) qkprep_row(r, (const bf16_t*)(ws + WS_PROJ), args.in[30], args.in[31], (const float*)(ws + WS_ROPE), (bf16_t*)(ws + WS_QP), (bf16_t*)(ws + WS_KP), lane);
}
DI void phase10(const Args& args, LAS unsigned char* lds, int tid, int wave, int lane, int G) {
    unsigned char* ws = args.ws;
    const LruP lp = make_lrup(args);
    for (int blk = blockIdx.x; blk < 256; blk += G) lru_block(blk, true, lp, lds, tid, wave, lane);
    __syncthreads();
    const int bx = blockIdx.x, vcu = (G % 8 == 0) ? (bx % 8) * (G / 8) + bx / 8 : bx;
    typedef gqa_body::bf16 abf;
    for (int u = vcu; u < 512; u += G) {
        const int qb = u & 15, hq = (u >> 4) & 7, b = u >> 7;
        gqa_body::attn_unit<8>(b, hq, qb, (const abf*)(ws + WS_QP), (const abf*)(ws + WS_KP), (const abf*)(ws + WS_VT1), (abf*)(ws + WS_YMIX) + 512, (const abf*)(ws + WS_PROJ) + 1792, (char*)lds);
    }
}

constexpr int RING_BYTES = 131072, LDSCTL_OFF = RING_BYTES, MISC_OFF = LDSCTL_OFF + 320, LDS_BYTES = 147456;
constexpr int CW_BAR = 4096;
constexpr int N_PHASES = 13;
constexpr bool kSP2 = true, kALIGN = true;

DI void p0_adaln(LAS unsigned char* lds, const float* c, const float* cctx, const float* ada_w, const float* ada_b, float* MOD, int tid, int wave, int lane, int G) {
    LAS float* sl = (LAS float*)lds;
    LAS float* red = (LAS float*)(lds + 5 * 1024 * 4);
    if ((int)blockIdx.x >= 192) return;
    for (int e = tid; e < 5 * 1024; e += NTHREADS) { const int r = e >> 10, k = e & 1023; const float x = r < 4 ? c[r * 1024 + k] : cctx[k]; sl[e] = silu_f(x); }
    __syncthreads();
    for (int item = blockIdx.x; item < 192; item += G) {
        const int i = item / 96, cb = item % 96, col = cb * 32 + (lane & 31), kh = lane >> 5;
        const float* W = ada_w + (size_t)i * 1024 * 3072 + col;
        float acc[5] = {0.f, 0.f, 0.f, 0.f, 0.f};
#pragma unroll 8
        for (int kk = 0; kk < 64; ++kk) { const int k = wave * 128 + 2 * kk + kh; const float w = W[(size_t)k * 3072];
#pragma unroll
            for (int r = 0; r < 5; ++r) acc[r] += sl[r * 1024 + k] * w; }
#pragma unroll
        for (int r = 0; r < 5; ++r) { acc[r] += __shfl_xor(acc[r], 32); if (lane < 32) red[(wave * 5 + r) * 32 + lane] = acc[r]; }
        __syncthreads();
        if (tid < 160) { const int r = tid >> 5, cl = tid & 31; float s = ada_b[i * 3072 + cb * 32 + cl];
#pragma unroll
            for (int w = 0; w < 8; ++w) s += red[(w * 5 + r) * 32 + cl];
            MOD[(i * 5 + r) * 3072 + cb * 32 + cl] = s; }
        __syncthreads();
    }
}
DI void p0_transpose_item(const float* W, int K, int N, bf16_t* WT, int row_off, LAS float* scr, int item, int lane) {
    const int nblk = N / 32, kb = item / nblk, nb = item % nblk, k0 = 64 * kb, n0 = 32 * nb;
#pragma unroll 8
    for (int i = 0; i < 32; ++i) { const int kk = 2 * i + (lane >> 5); scr[kk * 33 + (lane & 31)] = W[(size_t)(k0 + kk) * N + n0 + (lane & 31)]; }
    LDS_WAIT(); asm volatile("" ::: "memory");
    const int c = lane & 7;
#pragma unroll
    for (int j = 0; j < 4; ++j) { const int n = (lane >> 3) + 8 * j; const LAS float* s = scr + (8 * c) * 33 + n;
        v4u o; o.x = pk2(s[0 * 33], s[1 * 33]); o.y = pk2(s[2 * 33], s[3 * 33]); o.z = pk2(s[4 * 33], s[5 * 33]); o.w = pk2(s[6 * 33], s[7 * 33]);
        *(v4u*)(WT + (size_t)(row_off + n0 + n) * K + k0 + 8 * c) = o; }
    LDS_WAIT(); asm volatile("" ::: "memory");
}

DI void load_row16(const float* src, int lane, float (&v)[16]) {
#pragma unroll
    for (int j = 0; j < 4; ++j) { const f32x4_t t = *(const f32x4_t*)(src + j * 256 + lane * 4); v[4 * j] = t[0]; v[4 * j + 1] = t[1]; v[4 * j + 2] = t[2]; v[4 * j + 3] = t[3]; }
}
DI float row_rinv(const float (&v)[16]) {
    float ss = 0.f;
#pragma unroll
    for (int j = 0; j < 16; ++j) ss += v[j] * v[j];
    ss = wave_sum(ss);
    return rsqrtf(ss * (1.f / DM) + EPSN);
}
DI void store_modnorm(const float (&v)[16], float rinv, const float* g, const float* m, bf16_t* dst, int lane) {
#pragma unroll
    for (int j = 0; j < 4; ++j) { const int col = j * 256 + lane * 4;
        const f32x4_t gg = *(const f32x4_t*)(g + col), sc = *(const f32x4_t*)(m + 1024 + col), sh = *(const f32x4_t*)(m + col);
        float y[4];
#pragma unroll
        for (int e = 0; e < 4; ++e) y[e] = v[4 * j + e] * rinv * gg[e] * (1.f + sc[e]) + sh[e];
        v2u o; o.x = pk2(y[0], y[1]); o.y = pk2(y[2], y[3]); *(v2u*)(dst + col) = o; }
}

__global__ void __launch_bounds__(NTHREADS, 2) mega(Args args) {
    extern __shared__ __attribute__((aligned(16))) unsigned char lds_raw[];
    LAS unsigned char* lds = (LAS unsigned char*)lds_raw;
    volatile LAS unsigned* MISC = (volatile LAS unsigned*)(lds + MISC_OFF);
    const int tid = threadIdx.x, lane = tid & 63, wave = __builtin_amdgcn_readfirstlane(tid >> 6);
    const int G = gridDim.x;
    unsigned char* ws = args.ws;
    gu32* ctl = (gu32*)(ws + WS_CTL);
    for (int u = tid; u < (LDS_BYTES - LDSCTL_OFF) / 4; u += NTHREADS) ((LAS unsigned*)(lds + LDSCTL_OFF))[u] = 0u;
    __syncthreads();
    XcdBarrier bar = xcd_barrier_post((unsigned*)(ctl + CW_BAR) + args.li * XCD_BAR_WORDS, MISC + 8);
    const int lo = args.ph_lo, hi = args.ph_hi;
#define IN(k) (lo <= (k) && (k) < hi)
#ifndef PROBE_REP
#define PROBE_REP 0
#endif
#define PHASE_LOOP(k) for (int rep_ = 0, nrep_ = IN(k) ? 1 + ((PROBE_REP >> (k)) & 1) : 0; rep_ < nrep_; (++rep_ < nrep_) ? xcd_barrier(bar) : (void)0)
#ifdef PROBE_TS_A
#define STAMP(i) do { if (blockIdx.x == 0 && tid == 0) MISC[16 + (i)] = (unsigned)__builtin_amdgcn_s_memrealtime(); } while (0)
#else
#define STAMP(i) do {} while (0)
#endif
#define SEAM(k) do { if (IN(k) && IN((k) + 1)) xcd_barrier(bar); } while (0)

    const float* x = args.in[0]; const float* cvec = args.in[1]; const float* ctxin = args.in[2]; const float* cctx = args.in[3];
    const float* ada_w = args.in[4]; const float* ada_b = args.in[5]; const float* pre_g = args.in[6]; const float* post_g = args.in[7];
    float* out = args.out;
    float* MOD = (float*)(ws + WS_MOD);
    bf16_t* XN = (bf16_t*)(ws + WS_XN); bf16_t* YMIX = (bf16_t*)(ws + WS_YMIX); bf16_t* PROJ = (bf16_t*)(ws + WS_PROJ); float* OUTF = (float*)(ws + WS_PROJ);
    bf16_t* YPRE = (bf16_t*)(ws + WS_YPRE);
    const int gw = blockIdx.x * NWAVES + wave, NGW = G * NWAVES;

    PHASE_LOOP(0) { STAMP(0);
        p0_adaln(lds, cvec, cctx, ada_w, ada_b, MOD, tid, wave, lane, G);
        for (int it = G - 1 - (int)blockIdx.x; it < 256; it += G)
            s5_tables_block(it, args.in[10], args.in[11], args.in[12], args.in[13], args.in[14], args.in[15], args.in[16], (bf16_t*)(ws + WS_W16), (bf16_t*)(ws + WS_WC), (bf16_t*)(ws + WS_KT), (float*)(ws + WS_L16), lds, tid);
    }
    STAMP(1);
    SEAM(0);
    PHASE_LOOP(1) { STAMP(2);
        for (int r = gw; r < MROWS; r += NGW) {
            const float* src = r < NLAT ? x + (size_t)r * DM : ctxin + (size_t)(r - NLAT) * DM;
            float v[16]; load_row16(src, lane, v);
            store_modnorm(v, row_rinv(v), pre_g, MOD + (r < NLAT ? (r >> 12) : 4) * 3072, XN + (size_t)r * DM, lane);
        }
        LAS float* scr = (LAS float*)(lds + 32768 + wave * 8704);
        constexpr int I0 = 16 * 96, I1 = 16 * 32, I2 = 16 * 72, I3 = 16 * 32, I4 = 8 * 16, NBIG = I0 + I1 + I2 + I3 + I4, NLRU = 32 * 2;
        for (int it = gw; it < NBIG + NLRU; it += NGW) {
            int r = it;
            if (r < I0) { p0_transpose_item(args.in[8], 1024, 3072, (bf16_t*)(ws + WS_WIN0T), 0, scr, r, lane); continue; } r -= I0;
            if (r < I1) { p0_transpose_item(args.in[9], 1024, 1024, (bf16_t*)(ws + WS_WOUT0T), 0, scr, r, lane); continue; } r -= I1;
            if (r < I2) { p0_transpose_item(args.in[21], 1024, 2304, (bf16_t*)(ws + WS_WIN1T), 0, scr, r, lane); continue; } r -= I2;
            if (r < I3) { p0_transpose_item(args.in[22], 1024, 1024, (bf16_t*)(ws + WS_WOUT1T), 0, scr, r, lane); continue; } r -= I3;
            if (r < I4) { p0_transpose_item(args.in[18], 512, 512, (bf16_t*)(ws + WS_WGLUT), 0, scr, r, lane); continue; } r -= I4;
            { const int mat = r >> 1, sub = r & 1, dir = mat >> 4, gate = (mat >> 3) & 1, blk = mat & 7;
              const float* W = (gate ? args.in[28] : args.in[26]) + (size_t)(dir * 8 + blk) * 4096;
              p0_transpose_item(W, 64, 64, (bf16_t*)(ws + WS_LRUWT), blk * 256 + (dir * 2 + gate) * 64, scr, sub, lane); }
        }
        float* ROPE = (float*)(ws + WS_ROPE);
        for (int e = blockIdx.x * NTHREADS + tid; e < SEQ * 32; e += G * NTHREADS) { const int t = e >> 5, i = e & 31, f = i & 15; const float pos = (float)(i < 16 ? (t >> 6) : (t & 63));
            const float inv = (float)exp(-log(10000.0) * (double)(2 * f) / 32.0); const float ang = pos * inv; ROPE[2 * e] = cosf(ang); ROPE[2 * e + 1] = sinf(ang); }
    }
    STAMP(3);
    SEAM(1);
    PHASE_LOOP(2) { STAMP(4);
        pg8::Gemm g{XN, (const bf16_t*)(ws + WS_WIN0T), MROWS, N0, DM}; pg8::StaticOrder S; S.init(MROWS, N0, G, (int)blockIdx.x);
        pg8::EpiProj E{PROJ, N0, nullptr, 1 << 30, 1 << 30, 512, false, (bf16_t*)(ws + WS_UG), 512, 1024, 1536, 0.125f * LOG2E};
        pg8::gemm_phase<pg8::EpiProj, pg8::StaticOrder, kALIGN, kSP2>(lds, g, S, E);
    }
    STAMP(5);
    SEAM(2);
    PHASE_LOOP(3) { STAMP(6); phase3(args, lds, tid, wave, lane, G, rep_); }
    STAMP(7);
    SEAM(3);
    PHASE_LOOP(4) { STAMP(8); phase4(args, lds, tid, wave, lane, G); }
    STAMP(9);
    SEAM(4);
    PHASE_LOOP(5) { STAMP(10);
        pg8::Gemm g{YPRE, (const bf16_t*)(ws + WS_WGLUT), MROWS, 512, 512, 1};   pg8::StaticOrder S; S.init(MROWS, 512, G, (int)blockIdx.x);
        pg8::EpiGlu E{YPRE, PROJ, args.in[19], YMIX};
        pg8::gemm_phase<pg8::EpiGlu, pg8::StaticOrder, kALIGN, kSP2>(lds, g, S, E);
    }
    STAMP(11);
    SEAM(5);
    PHASE_LOOP(6) { STAMP(12);
        pg8::Gemm g{YMIX, (const bf16_t*)(ws + WS_WOUT0T), MROWS, DM, DM}; pg8::StaticOrder S; S.init(MROWS, DM, G, (int)blockIdx.x);
        pg8::EpiF32 E{OUTF, DM};
        pg8::gemm_phase<pg8::EpiF32, pg8::StaticOrder, kALIGN, kSP2>(lds, g, S, E);
    }
    STAMP(13);
    SEAM(6);
    PHASE_LOOP(7) { STAMP(14);
        for (int r = gw; r < MROWS; r += NGW) {
            const int mrow = r < NLAT ? (r >> 12) : 4;
            const float* hin = r < NLAT ? x + (size_t)r * DM : ctxin + (size_t)(r - NLAT) * DM;
            float v[16], h[16]; load_row16(OUTF + (size_t)r * DM, lane, v); load_row16(hin, lane, h);
            const float rinv = row_rinv(v); const float* gt = MOD + mrow * 3072 + 2048;
#pragma unroll
            for (int j = 0; j < 4; ++j) { const int col = j * 256 + lane * 4; const f32x4_t pg = *(const f32x4_t*)(post_g + col), gg = *(const f32x4_t*)(gt + col);
#pragma unroll
                for (int e = 0; e < 4; ++e) h[4 * j + e] += gg[e] * (v[4 * j + e] * rinv * pg[e]);
                if (r < NLAT) *(f32x4_t*)(out + (size_t)r * DM + col) = (f32x4_t){h[4 * j], h[4 * j + 1], h[4 * j + 2], h[4 * j + 3]}; }
            store_modnorm(h, row_rinv(h), pre_g + DM, MOD + (5 + mrow) * 3072, XN + (size_t)r * DM, lane);
        }
    }
    STAMP(15);
    SEAM(7);
    PHASE_LOOP(8) { STAMP(16);
        pg8::Gemm g{XN, (const bf16_t*)(ws + WS_WIN1T), MROWS, N1, DM}; pg8::StaticOrder S; S.init(MROWS, N1, G, (int)blockIdx.x);
        pg8::EpiProj E{PROJ, N1, (bf16_t*)(ws + WS_VT1), 1664, 1792, 128, true, nullptr, 0, 0, 0, 1.f};
        pg8::gemm_phase<pg8::EpiProj, pg8::StaticOrder, kALIGN, kSP2>(lds, g, S, E);
    }
    STAMP(17);
    SEAM(8);
    PHASE_LOOP(9) { STAMP(18); phase9(args, lds, tid, wave, lane, G); }
    STAMP(19);
    SEAM(9);
    PHASE_LOOP(10) { STAMP(20); phase10(args, lds, tid, wave, lane, G); }
    STAMP(21);
    SEAM(10);
    PHASE_LOOP(11) { STAMP(22);
        pg8::Gemm g{YMIX, (const bf16_t*)(ws + WS_WOUT1T), NLAT, DM, DM}; pg8::StaticOrder S; S.init(NLAT, DM, G, (int)blockIdx.x);
        pg8::EpiF32 E{OUTF, DM};
        pg8::gemm_phase<pg8::EpiF32, pg8::StaticOrder, kALIGN, kSP2>(lds, g, S, E);
    }
    STAMP(23);
    SEAM(11);
    PHASE_LOOP(12) { STAMP(24);
        for (int r = gw; r < NLAT; r += NGW) {
            float v[16], h[16]; load_row16(OUTF + (size_t)r * DM, lane, v); load_row16(out + (size_t)r * DM, lane, h);
            const float rinv = row_rinv(v); const float* gt = MOD + (5 + (r >> 12)) * 3072 + 2048;
#pragma unroll
            for (int j = 0; j < 4; ++j) { const int col = j * 256 + lane * 4; const f32x4_t pg = *(const f32x4_t*)(post_g + DM + col), gg = *(const f32x4_t*)(gt + col);
                f32x4_t o;
#pragma unroll
                for (int e = 0; e < 4; ++e) o[e] = h[4 * j + e] + gg[e] * (v[4 * j + e] * rinv * pg[e]);
                *(f32x4_t*)(out + (size_t)r * DM + col) = o; }
        }
    }
    STAMP(25);
#ifdef PROBE_TS_A
    if (blockIdx.x == 0 && tid == 0) { const unsigned dt = MISC[16 + PROBE_TS_B] - MISC[16 + PROBE_TS_A]; out[0] += (float)dt * (0.01f / (float)PROBE_TS_SCALE); }
#endif
#undef IN
#undef SEAM
}
__global__ void k_adaln(const float* c, const float* cctx, const float* ada_w, const float* ada_b, float* mod) {
    const int idx = blockIdx.x * blockDim.x + threadIdx.x;
    if (idx >= 2 * 5 * 3072) return;
    const int col = idx % 3072, r = (idx / 3072) % 5, i = idx / (3072 * 5);
    const float* cv = r < 4 ? c + r * 1024 : cctx;
    const float* W = ada_w + (size_t)i * 1024 * 3072;
    float acc = 0.f;
    for (int k = 0; k < 1024; ++k) acc += silu_f(cv[k]) * W[(size_t)k * 3072 + col];
    mod[idx] = acc + ada_b[i * 3072 + col];
}

__global__ void k_prenorm(const float* lat, const float* ctx, const float* g, const float* mod  , bf16_t* XN) {
    const int r = blockIdx.x * 4 + (threadIdx.x >> 6), lane = threadIdx.x & 63;
    if (r >= MROWS) return;
    const float* src = r < NLAT ? lat + (size_t)r * DM : ctx + (size_t)(r - NLAT) * DM;
    const float* m = mod + (r < NLAT ? (r >> 12) : 4) * 3072;
    float v[16]; float ss = 0.f;
#pragma unroll
    for (int j = 0; j < 4; ++j) { const float4 t = *(const float4*)(src + j * 256 + lane * 4); v[4 * j] = t.x; v[4 * j + 1] = t.y; v[4 * j + 2] = t.z; v[4 * j + 3] = t.w; }
#pragma unroll
    for (int j = 0; j < 16; ++j) ss += v[j] * v[j];
    ss = wave_sum(ss);
    const float rinv = rsqrtf(ss * (1.f / DM) + EPSN);
#pragma unroll
    for (int j = 0; j < 4; ++j)
#pragma unroll
        for (int e = 0; e < 4; ++e) { const int col = j * 256 + lane * 4 + e; const float y = v[4 * j + e] * rinv * g[col] * (1.f + m[1024 + col]) + m[col]; XN[(size_t)r * DM + col] = f2bf(y); }
}

__global__ void k_postnorm(const float* hlat, const float* hctx, const float* OUT, const float* pg, const float* mod, float* olat, float* octx, int nrows) {
    const int r = blockIdx.x * 4 + (threadIdx.x >> 6), lane = threadIdx.x & 63;
    if (r >= nrows) return;
    const float* hin = r < NLAT ? hlat + (size_t)r * DM : hctx + (size_t)(r - NLAT) * DM;
    float* ho = r < NLAT ? olat + (size_t)r * DM : octx + (size_t)(r - NLAT) * DM;
    const float* m = mod + (r < NLAT ? (r >> 12) : 4) * 3072 + 2048;
    const float* src = OUT + (size_t)r * DM;
    float v[16]; float ss = 0.f;
#pragma unroll
    for (int j = 0; j < 4; ++j) { const float4 t = *(const float4*)(src + j * 256 + lane * 4); v[4 * j] = t.x; v[4 * j + 1] = t.y; v[4 * j + 2] = t.z; v[4 * j + 3] = t.w; }
#pragma unroll
    for (int j = 0; j < 16; ++j) ss += v[j] * v[j];
    ss = wave_sum(ss);
    const float rinv = rsqrtf(ss * (1.f / DM) + EPSN);
#pragma unroll
    for (int j = 0; j < 4; ++j)
#pragma unroll
        for (int e = 0; e < 4; ++e) { const int col = j * 256 + lane * 4 + e; ho[col] = hin[col] + m[col] * (v[4 * j + e] * rinv * pg[col]); }
}

enum { GM_PROJ0 = 0, GM_PROJ1 = 1, GM_GLU = 2, GM_F32 = 3 };
struct GemmEpi { bf16_t* P; bf16_t* VT; const bf16_t* YPRE; const bf16_t* PROJ; const float* bglu; bf16_t* YMIX; float* OUT; };
template <int MODE> __global__ void __launch_bounds__(256) k_gemm(const bf16_t* A, const float* W, int M, int N, int K, GemmEpi e) {
    const int tx = threadIdx.x & 15, ty = threadIdx.x >> 4;
    const int c0 = blockIdx.x * 64 + tx * 4, r0 = blockIdx.y * 64 + ty * 4;
    float acc[4][4] = {};
    for (int k = 0; k < K; ++k) {
        const float4 w = *(const float4*)(W + (size_t)k * N + c0);
        const float wv[4] = {rbf(w.x), rbf(w.y), rbf(w.z), rbf(w.w)};
#pragma unroll
        for (int i = 0; i < 4; ++i) { const float a = bf2f(A[(size_t)(r0 + i) * K + k]);
#pragma unroll
            for (int j = 0; j < 4; ++j) acc[i][j] += a * wv[j]; }
    }
#pragma unroll
    for (int i = 0; i < 4; ++i)
#pragma unroll
        for (int j = 0; j < 4; ++j) {
            const int r = r0 + i, c = c0 + j; const float v = acc[i][j];
            if (MODE == GM_PROJ0) { e.P[(size_t)r * N0 + c] = f2bf(v);
                if (c >= 2048 && c < 2560) { const int hd = c - 2048; e.VT[((size_t)(row_batch(r) * 8) * 64 + hd) * POSN + row_pos(r)] = f2bf(v); } }
            else if (MODE == GM_PROJ1) { e.P[(size_t)r * N1 + c] = f2bf(v);
                if (c >= 1664 && c < 1792) { const int hd = c - 1664; e.VT[((size_t)(row_batch(r) * 2) * 64 + hd) * POSN + row_pos(r)] = f2bf(v); } }
            else if (MODE == GM_GLU) { const float y = bf2f(e.YPRE[(size_t)r * 512 + c]); const float ga = bf2f(e.PROJ[(size_t)r * N0 + 512 + c]);
                e.YMIX[(size_t)r * DM + c] = f2bf(y * sigmoid_f(v + e.bglu[c]) * silu_f(ga)); }
            else e.OUT[(size_t)r * N + c] = v;
        }
}

__global__ void __launch_bounds__(64) k_s5_scan(const bf16_t* PROJ, const float* lam_re, const float* lam_im, const float* log_dt, const float* b_re, const float* b_im,
                                                 const float* c_re, const float* c_im, float* YS) {
    const int p = threadIdx.x, id = blockIdx.x, dir = id & 1, g = (id >> 1) & 31, b = id >> 6;
    const int gi = (dir * 32 + g);
    const double lre = lam_re[gi * 64 + p], lim = lam_im[gi * 64 + p], dt = exp((double)log_dt[gi]);
    const double mag = exp(lre * dt); const float ar = (float)(mag * cos(lim * dt)), ai = (float)(mag * sin(lim * dt));
    const double nr = mag * cos(lim * dt) - 1.0, ni = mag * sin(lim * dt), den = lre * lre + lim * lim;
    const float cfr = (float)((nr * lre + ni * lim) / den), cfi = (float)((ni * lre - nr * lim) / den);
    float bbr[16], bbi[16], cr[16], ci[16];
#pragma unroll
    for (int h = 0; h < 16; ++h) { const float br = b_re[(gi * 64 + p) * 16 + h], bi = b_im[(gi * 64 + p) * 16 + h]; bbr[h] = cfr * br - cfi * bi; bbi[h] = cfr * bi + cfi * br;
        cr[h] = c_re[(gi * 16 + h) * 64 + p]; ci[h] = c_im[(gi * 16 + h) * 64 + p]; }
    float hr = 0.f, hi = 0.f;
    float* ys = YS + (size_t)dir * MROWS * 512;
    for (int pos = 0; pos < POSN; ++pos) {
        int row;
        if (dir == 0) row = pos_row(b, pos); else row = pos < LC ? NLAT + b * LC + (LC - 1 - pos) : b * SEQ + (SEQ - 1 - (pos - LC));
        const bf16_t* up = PROJ + (size_t)row * N0 + g * 16;
        float bur = 0.f, bui = 0.f;
#pragma unroll
        for (int h = 0; h < 16; ++h) { const float u = bf2f(up[h]); bur += bbr[h] * u; bui += bbi[h] * u; }
        const float nhr = ar * hr - ai * hi + bur, nhi = ar * hi + ai * hr + bui; hr = nhr; hi = nhi;
        float mine = 0.f;
#pragma unroll
        for (int h = 0; h < 16; ++h) { const float y = wave_sum(cr[h] * hr - ci[h] * hi); if (p == h) mine = y; }
        if (p < 16) ys[(size_t)row * 512 + g * 16 + p] = mine;
    }
}
__global__ void k_s5_finish(const bf16_t* PROJ, const float* YS, const float* dsk, bf16_t* YPRE) {
    const size_t idx = (size_t)blockIdx.x * blockDim.x + threadIdx.x; if (idx >= (size_t)MROWS * 512) return;
    const int ch = idx & 511; const size_t r = idx >> 9;
    const float y = dsk[ch] * bf2f(PROJ[r * N0 + ch]) + YS[idx] + YS[(size_t)MROWS * 512 + idx];
    YPRE[idx] = f2bf(gelu_tanh(y));
}

__global__ void __launch_bounds__(256) k_na_attn(const bf16_t* PROJ, const float* relb, bf16_t* YMIX) {
    const int wv = blockIdx.x * 4 + (threadIdx.x >> 6), lane = threadIdx.x & 63;
    if (wv >= MROWS * 8) return;
    const int h = wv & 7, r = wv >> 3, b = row_batch(r);
    const float q = bf2f(PROJ[(size_t)r * N0 + 1024 + h * 64 + lane]);
    float m = -INFINITY, l = 0.f, o = 0.f;
    if (r < NLAT) {
        const int t = r & 4095, qr = t >> 6, qc = t & 63;
        const int rs = min(max(qr - 4, 0), 56), cs = min(max(qc - 8, 0), 48);
        for (int kr = rs; kr < rs + 8; ++kr)
            for (int kc = cs; kc < cs + 16; ++kc) {
                const size_t kro = (size_t)(b * SEQ + kr * 64 + kc) * N0;
                float s = wave_sum(q * bf2f(PROJ[kro + 1536 + h * 64 + lane])) * 0.125f + relb[(h * 15 + (kr - qr + 7)) * 31 + (kc - qc + 15)];
                const float mn = fmaxf(m, s), al = __expf(m - mn), pp = __expf(s - mn);
                l = l * al + pp; o = o * al + pp * bf2f(PROJ[kro + 2048 + h * 64 + lane]); m = mn;
            }
    }
    for (int c = 0; c < LC; ++c) {
        const size_t kro = (size_t)(NLAT + b * LC + c) * N0;
        const float s = wave_sum(q * bf2f(PROJ[kro + 1536 + h * 64 + lane])) * 0.125f;
        const float mn = fmaxf(m, s), al = __expf(m - mn), pp = __expf(s - mn);
        l = l * al + pp; o = o * al + pp * bf2f(PROJ[kro + 2048 + h * 64 + lane]); m = mn;
    }
    const float gb = bf2f(PROJ[(size_t)r * N0 + 2560 + h * 64 + lane]);
    YMIX[(size_t)r * DM + 512 + h * 64 + lane] = f2bf(o / l * silu_f(gb));
}

__global__ void __launch_bounds__(64) k_lru(const bf16_t* P1, const float* conv_w, const float* conv_b, const float* lam, const float* w_a, const float* b_a,
                                            const float* w_x, const float* b_x, float* HS, bf16_t* YMIX) {
    __shared__ float xs[64];
    const int j = threadIdx.x, nb = blockIdx.x & 7, b = blockIdx.x >> 3, ch = nb * 64 + j;
    const float cw0 = conv_w[0 * 512 + ch], cw1 = conv_w[1 * 512 + ch], cw2 = conv_w[2 * 512 + ch], cw3 = conv_w[3 * 512 + ch], cb = conv_b[ch];
    for (int dir = 0; dir < 2; ++dir) {
        float wa[64], wx[64];
#pragma unroll
        for (int i = 0; i < 64; ++i) { wa[i] = w_a[((dir * 8 + nb) * 64 + i) * 64 + j]; wx[i] = w_x[((dir * 8 + nb) * 64 + i) * 64 + j]; }
        const float ba = b_a[dir * 512 + ch], bx = b_x[dir * 512 + ch];
        const float lm = lam[dir * 512 + ch]; const float sp = (-lm > 20.f) ? -lm : log1pf(__expf(-lm));
        float hst = 0.f;
        for (int pos = 0; pos < POSN; ++pos) {
            int s0, sl, t;
            if (pos < LC) { s0 = NLAT + b * LC; sl = LC; t = dir == 0 ? pos : LC - 1 - pos; }
            else { s0 = b * SEQ; sl = SEQ; t = dir == 0 ? pos - LC : SEQ - 1 - (pos - LC); }
            float xm1 = 0.f, x0, xp1 = 0.f, xp2 = 0.f;
            x0 = bf2f(P1[(size_t)(s0 + t) * N1 + ch]);
            if (t - 1 >= 0) xm1 = bf2f(P1[(size_t)(s0 + t - 1) * N1 + ch]);
            if (t + 1 < sl) xp1 = bf2f(P1[(size_t)(s0 + t + 1) * N1 + ch]);
            if (t + 2 < sl) xp2 = bf2f(P1[(size_t)(s0 + t + 2) * N1 + ch]);
            const float xc = cw0 * xm1 + cw1 * x0 + cw2 * xp1 + cw3 * xp2 + cb;
            __syncthreads(); xs[j] = xc; __syncthreads();
            float ga = ba, gx = bx;
#pragma unroll
            for (int i = 0; i < 64; ++i) { const float xi = xs[i]; ga += xi * wa[i]; gx += xi * wx[i]; }
            const float gr = sigmoid_f(ga), gi = sigmoid_f(gx);
            const float log_a = -8.f * gr * sp; const float a = __expf(log_a); const float mult = sqrtf(fmaxf(-expm1f(2.f * log_a), 0.f));
            hst = a * hst + mult * gi * xc;
            if (pos >= LC) { const size_t rr = (size_t)(s0 + t);
                if (dir == 0) HS[rr * 512 + ch] = hst;
                else { const float gc = bf2f(P1[rr * N1 + 512 + ch]); YMIX[rr * DM + ch] = f2bf((HS[rr * 512 + ch] + hst) * silu_f(gc)); } }
        }
    }
}

__global__ void __launch_bounds__(256) k_qkprep(const bf16_t* P1, const float* qn, const float* kn, bf16_t* QP, bf16_t* KP) {
    const int wv = blockIdx.x * 4 + (threadIdx.x >> 6), lane = threadIdx.x & 63;
    if (wv >= MROWS * 10) return;
    const int slot = wv % 10, r = wv / 10, b = row_batch(r);
    if (slot < 8 && r >= NLAT) return;
    const int col0 = slot < 8 ? 1024 + slot * 64 : 1536 + (slot - 8) * 64;
    const float x = bf2f(P1[(size_t)r * N1 + col0 + lane]);
    const float ss = wave_sum(x * x);
    float y = x * rsqrtf(ss * (1.f / 64.f) + EPSN) * (slot < 8 ? qn[lane] : kn[lane]);
    if (r < NLAT) {
        const int t = r & 4095, i = lane >> 1, f = i & 15; const float pos = (float)(i < 16 ? (t >> 6) : (t & 63));
        const float inv = (float)exp(-log(10000.0) * (double)(2 * f) / 32.0);
        const float ang = pos * inv; const float cs = cosf(ang), sn = sinf(ang);
        const float pr = __shfl_xor(y, 1);
        y = (lane & 1) ? (pr * sn + y * cs) : (y * cs - pr * sn);
    }
    if (slot < 8) QP[((size_t)(b * 8 + slot) * SEQ + (r & 4095)) * 64 + lane] = f2bf(y * (0.125f * LOG2E));
    else KP[((size_t)(b * 2 + (slot - 8)) * POSN + row_pos(r)) * 64 + lane] = f2bf(y);
}

__global__ void __launch_bounds__(256) k_gqa(const bf16_t* QP, const bf16_t* KP, const bf16_t* P1, bf16_t* YMIX) {
    const int wv = blockIdx.x * 4 + (threadIdx.x >> 6), lane = threadIdx.x & 63;
    if (wv >= NLAT * 8) return;
    const int hq = wv & 7, r = wv >> 3, b = r >> 12, t = r & 4095, kvh = hq >> 2;
    const float q = bf2f(QP[((size_t)(b * 8 + hq) * SEQ + t) * 64 + lane]);
    const bf16_t* kp = KP + (size_t)(b * 2 + kvh) * POSN * 64;
    float m = -INFINITY, l = 0.f, o = 0.f;
    for (int pos = 0; pos < POSN; ++pos) {
        const float s = wave_sum(q * bf2f(kp[(size_t)pos * 64 + lane]));
        const float v = bf2f(P1[(size_t)pos_row(b, pos) * N1 + 1664 + kvh * 64 + lane]);
        const float mn = fmaxf(m, s), al = exp2f(m - mn), pp = exp2f(s - mn);
        l = l * al + pp; o = o * al + pp * v; m = mn;
    }
    const float gd = bf2f(P1[(size_t)r * N1 + 1792 + hq * 64 + lane]);
    YMIX[(size_t)r * DM + 512 + hq * 64 + lane] = f2bf(o / l * silu_f(gd));
}

static int g_grid = 0;
static void launch_mega(Args a, int lo, int hi, int li, hipStream_t stream) {
    a.ph_lo = lo; a.ph_hi = hi; a.li = li;
    hipLaunchKernelGGL(mega, dim3(g_grid), dim3(NTHREADS), LDS_BYTES, stream, a);
    const hipError_t le = hipPeekAtLastError();
    if (le != hipSuccess) fprintf(stderr, "kernel_launch: mega[%d,%d) failed: %s\n", lo, hi, hipGetErrorName(le));
}
extern "C" void kernel_launch(void* const* d_in, const int* in_sizes, int n_in, void* d_out, int out_size, void* d_ws, size_t ws_size, hipStream_t stream) {
    if (g_grid == 0) {
        int dev = 0, cus = 0;
        if (hipGetDevice(&dev) != hipSuccess || hipDeviceGetAttribute(&cus, hipDeviceAttributeMultiprocessorCount, dev) != hipSuccess) { fprintf(stderr, "kernel_launch: device query failed\n"); g_grid = -1; return; }
        if (hipFuncSetAttribute((const void*)mega, hipFuncAttributeMaxDynamicSharedMemorySize, LDS_BYTES) != hipSuccess) { fprintf(stderr, "kernel_launch: hipFuncSetAttribute failed\n"); g_grid = -1; return; }
        int per_cu = 0;
        if (hipOccupancyMaxActiveBlocksPerMultiprocessor(&per_cu, (const void*)mega, NTHREADS, LDS_BYTES) != hipSuccess || per_cu < 1) fprintf(stderr, "kernel_launch: occupancy query says %d blocks/CU\n", per_cu);
        (void)hipGetLastError();
        g_grid = cus;
    }
    if (g_grid < 0) return;
    const float* x = (const float*)d_in[0]; const float* c = (const float*)d_in[1]; const float* ctx = (const float*)d_in[2]; const float* cctx = (const float*)d_in[3];
    const float* ada_w = (const float*)d_in[4]; const float* ada_b = (const float*)d_in[5]; const float* pre_g = (const float*)d_in[6]; const float* post_g = (const float*)d_in[7];
    const float* ev_w_in = (const float*)d_in[8]; const float* ev_w_out = (const float*)d_in[9];
    const float* s5_lre = (const float*)d_in[10]; const float* s5_lim = (const float*)d_in[11]; const float* s5_ldt = (const float*)d_in[12];
    const float* s5_bre = (const float*)d_in[13]; const float* s5_bim = (const float*)d_in[14]; const float* s5_cre = (const float*)d_in[15]; const float* s5_cim = (const float*)d_in[16];
    const float* s5_d = (const float*)d_in[17]; const float* s5_wglu = (const float*)d_in[18]; const float* s5_bglu = (const float*)d_in[19]; const float* relb = (const float*)d_in[20];
    const float* od_w_in = (const float*)d_in[21]; const float* od_w_out = (const float*)d_in[22]; const float* conv_w = (const float*)d_in[23]; const float* conv_b = (const float*)d_in[24];
    const float* lru_lam = (const float*)d_in[25]; const float* w_a = (const float*)d_in[26]; const float* b_a = (const float*)d_in[27]; const float* w_x = (const float*)d_in[28]; const float* b_x = (const float*)d_in[29];
    const float* qn = (const float*)d_in[30]; const float* kn = (const float*)d_in[31];
    char* ws = (char*)d_ws; float* out = (float*)d_out;
    float* MOD = (float*)(ws + WS_MOD); float* HC1 = (float*)(ws + WS_HC1);
    bf16_t* XN = (bf16_t*)(ws + WS_XN); bf16_t* YMIX = (bf16_t*)(ws + WS_YMIX); bf16_t* PROJ = (bf16_t*)(ws + WS_PROJ); float* OUTF = (float*)(ws + WS_PROJ);
    bf16_t* VT0 = (bf16_t*)(ws + WS_VT0); bf16_t* YPRE = (bf16_t*)(ws + WS_YPRE); bf16_t* QP = (bf16_t*)(ws + WS_QP); bf16_t* KP = (bf16_t*)(ws + WS_KP); bf16_t* VT1 = (bf16_t*)(ws + WS_VT1);
    float* YS = (float*)(ws + WS_YS); float* HS = (float*)(ws + WS_HS);
    (void)x; (void)c; (void)ctx; (void)cctx; (void)ada_w; (void)ada_b; (void)pre_g; (void)post_g; (void)ev_w_in; (void)ev_w_out; (void)s5_wglu; (void)od_w_in; (void)od_w_out; (void)MOD; (void)HC1; (void)XN; (void)OUTF; (void)VT0; (void)VT1; (void)out;

    if (hipMemsetAsync(ws + WS_CTL, 0, CTL_ZERO_BYTES, stream) != hipSuccess) { fprintf(stderr, "kernel_launch: memset failed\n"); return; }
    Args a{};
    for (int i = 0; i < 32; ++i) a.in[i] = (const float*)d_in[i];
    a.out = (float*)d_out; a.ws = (unsigned char*)d_ws;

    launch_mega(a, 0, N_PHASES, 0, stream);
    (void)relb; (void)conv_w; (void)conv_b; (void)lru_lam; (void)w_a; (void)b_a; (void)w_x; (void)b_x; (void)HS; (void)qn; (void)kn; (void)QP; (void)KP;
    (void)s5_lre; (void)s5_lim; (void)s5_ldt; (void)s5_bre; (void)s5_bim; (void)s5_cre; (void)s5_cim; (void)s5_d; (void)s5_bglu; (void)YS; (void)YPRE; (void)PROJ; (void)YMIX;
}
```

```cpp
#include <hip/hip_runtime.h>
#include <cstdint>
#include <cstdio>

typedef unsigned short bf16_t;
#define DI __device__ __forceinline__
#define GAS __attribute__((address_space(1)))
#define LAS __attribute__((address_space(3)))
typedef unsigned v4u __attribute__((ext_vector_type(4)));
typedef unsigned v2u __attribute__((ext_vector_type(2)));
typedef float f32x4_t __attribute__((ext_vector_type(4)));
typedef float f32x16_t __attribute__((ext_vector_type(16)));
typedef short bf16x8_t __attribute__((ext_vector_type(8)));
typedef short s16x4_t __attribute__((ext_vector_type(4)));
typedef GAS unsigned gu32;
typedef GAS unsigned long long gu64;
#define RLX_AGENT __ATOMIC_RELAXED, __HIP_MEMORY_SCOPE_AGENT
#define LDS_WAIT() asm volatile("s_waitcnt lgkmcnt(0)" ::: "memory")
#define VM_WAIT() asm volatile("s_waitcnt vmcnt(0)" ::: "memory")

DI float bf2f(bf16_t v) { return __uint_as_float((unsigned)v << 16); }
DI bf16_t f2bf(float f) { unsigned u = __float_as_uint(f); return (bf16_t)((u + 0x7fffu + ((u >> 16) & 1u)) >> 16); }
DI unsigned pk2(float lo, float hi) { return (unsigned)f2bf(lo) | ((unsigned)f2bf(hi) << 16); }
DI float bflo(unsigned w) { return __uint_as_float(w << 16); }
DI float bfhi(unsigned w) { return __uint_as_float(w & 0xffff0000u); }
DI float rbf(float f) { return bf2f(f2bf(f)); }
DI float wave_sum(float v) {
#pragma unroll
    for (int o = 1; o < 64; o <<= 1) v += __shfl_xor(v, o);
    return v;
}
DI float sigmoid_f(float x) { return __builtin_amdgcn_rcpf(1.f + __builtin_amdgcn_exp2f(-1.4426950408889634f * x)); }
DI float silu_f(float x) { return x * sigmoid_f(x); }
DI float gelu_tanh(float x) { const float u = 0.7978845608028654f * (x + 0.044715f * x * x * x); return 0.5f * x * (1.f + tanhf(u)); }
DI float gelu_fast(float x) { const float u = 1.5957691216057308f * (x + 0.044715f * x * x * x); return x * sigmoid_f(u); }

constexpr int NWAVES = 8, NTHREADS = 512;
constexpr int DM = 1024, NB = 4, SEQ = 4096, LC = 256;
constexpr int NLAT = NB * SEQ, NCTX = NB * LC, MROWS = NLAT + NCTX;
constexpr int N0 = 3072, N1 = 2304, POSN = LC + SEQ;
constexpr float EPSN = 1e-6f;
constexpr float LOG2E = 1.4426950408889634f;

constexpr size_t MiB = 1u << 20;
constexpr size_t WS_CTL = 0, CTL_ZERO_BYTES = 1 * MiB;
constexpr size_t WS_MOD = 1 * MiB;
constexpr size_t WS_ROPE = 2 * MiB;
constexpr size_t WS_L16 = 3 * MiB;
constexpr size_t WS_WIN0T = 4 * MiB;
constexpr size_t WS_WOUT0T = 10 * MiB;
constexpr size_t WS_WIN1T = 12 * MiB;
constexpr size_t WS_WOUT1T = 17 * MiB;
constexpr size_t WS_WGLUT = 19 * MiB;
constexpr size_t WS_LRUWT = 19 * MiB + 512 * 1024;
constexpr size_t WS_W16 = 20 * MiB;
constexpr size_t WS_WC = 24 * MiB;
constexpr size_t WS_KT = 28 * MiB;
constexpr size_t WS_LSUM = 29 * MiB;
constexpr size_t WS_XN = 32 * MiB;
constexpr size_t WS_YMIX = 66 * MiB;
constexpr size_t WS_PROJ = 100 * MiB;
constexpr size_t WS_VT0 = 202 * MiB;
constexpr size_t WS_UG = 202 * MiB;
constexpr size_t WS_CARRY1 = 219 * MiB;
constexpr size_t WS_YPRE = 228 * MiB;
constexpr size_t WS_QP = 202 * MiB;
constexpr size_t WS_KP = 218 * MiB;
constexpr size_t WS_VT1 = 223 * MiB;
constexpr size_t WS_YS = 32 * MiB;
constexpr size_t WS_HS = 32 * MiB;
constexpr size_t WS_HC1 = 246 * MiB;

DI int row_batch(int r) { return r < NLAT ? (r >> 12) : ((r - NLAT) >> 8); }
DI int row_pos(int r) { return r < NLAT ? LC + (r & 4095) : ((r - NLAT) & 255); }
DI int pos_row(int b, int pos) { return pos < LC ? NLAT + b * LC + pos : b * SEQ + (pos - LC); }

namespace pg8 {
#define PG8_LAS __attribute__((address_space(3)))
typedef unsigned short bf16_t;
typedef short bf16x8 __attribute__((ext_vector_type(8)));
typedef float f32x4 __attribute__((ext_vector_type(4)));
typedef unsigned u32x4 __attribute__((ext_vector_type(4)));
constexpr int BM = 256, BK = 64, HALF = 128, HTB = HALF * BK * 2  , STAGE_BYTES = 8 * HTB, NXCD = 8, WGM = 8;

__host__ __device__ __forceinline__ int lds_byte(int r, int c) { const int st = (r >> 4) * 2 + (c >> 5), rr = r & 15, cc = c & 31, ob = rr * 64 + cc * 2; return st * 1024 + (ob ^ (((ob >> 9) & 1) << 5)); }
__host__ __device__ __forceinline__ void stage_rc(int b, int& R, int& C) { const int st = b / 1024, sb = b % 1024, swz = sb ^ (((sb >> 9) & 1) << 5); R = (st >> 1) * 16 + swz / 64; C = (st & 1) * 32 + (swz % 64) / 2; }
__host__ __device__ __forceinline__ int perm32(int rho) { const int n = rho >> 4, i = rho & 15; return 8 * (i >> 2) + 4 * n + (i & 3); }

struct Unit { int pm, pn; };
struct Gemm { const bf16_t* A; const bf16_t* Bt; int M, N, K; int a_gmajor; };

struct StaticOrder {
    int nM, nN, nwg, G, c;
    __host__ __device__ void init(int M, int N, int G_, int c_) { nM = M / BM; nN = N / BM; nwg = nM * nN; G = G_; c = c_; }
    __host__ __device__ bool next(int i, Unit& u) const {
        const long L = (long)i * G + c; if (L >= nwg) return false;
        int wgid = (int)L; { const int q = nwg / NXCD, r = nwg % NXCD, xcd = wgid % NXCD, off = wgid / NXCD; wgid = (xcd < r ? xcd * (q + 1) : r * (q + 1) + (xcd - r) * q) + off; }
        const int nig = WGM * nN, gid = wgid / nig, fm = gid * WGM, gsz = (nM - fm) < WGM ? (nM - fm) : WGM;
        u.pm = fm + ((wgid % nig) % gsz); u.pn = (wgid % nig) / gsz; return true;
    }
    __device__ __forceinline__ void a_ready(const Unit&) const {}
    __device__ __forceinline__ void done(const Unit&) const {}
};

__device__ __forceinline__ unsigned cvt_pk_bf16(float lo, float hi) { unsigned r; asm volatile("v_cvt_pk_bf16_f32 %0, %1, %2" : "=v"(r) : "v"(lo), "v"(hi)); return r; }

struct EpiProj {
    static constexpr bool PERM = true, AFTER_DRAIN = false;
    bf16_t* P; int ldc; bf16_t* VT; int vt_lo, vt_hi, vt_w; bool vrow; bf16_t* UG; int ug_hi; int qs_lo, qs_hi; float qscale;
    __device__ __forceinline__ void operator()(const f32x4 (&acc)[2][2][4][2], const Unit& u, int wr, int wc, int fr, int fq) const {
        const int row0 = u.pm * BM + wr * 64 + fr, colt = u.pn * BM + wc * 32 + 8 * fq;
#pragma unroll
        for (int ai = 0; ai < 2; ++ai)
#pragma unroll
            for (int m = 0; m < 4; ++m) { const int r = row0 + ai * HALF + m * 16; bf16_t* rowp = P + (size_t)r * ldc + colt;
#pragma unroll
                for (int bj = 0; bj < 2; ++bj) { f32x4 v0 = acc[ai][bj][m][0], v1 = acc[ai][bj][m][1];
                    { const int cq = colt + bj * HALF; if (cq >= qs_lo && cq < qs_hi) { v0 = v0 * qscale; v1 = v1 * qscale; } }
                    u32x4 w; w.x = cvt_pk_bf16(v0[0], v0[1]); w.y = cvt_pk_bf16(v0[2], v0[3]); w.z = cvt_pk_bf16(v1[0], v1[1]); w.w = cvt_pk_bf16(v1[2], v1[3]);
                    const int c0 = colt + bj * HALF;
                    if (c0 < ug_hi) *(u32x4*)(UG + ((size_t)(c0 >> 4) * MROWS + r) * 16 + (c0 & 15)) = w; else *(u32x4*)(rowp + bj * HALF) = w;
                    if (c0 >= vt_lo && c0 < vt_hi && vrow) {
                        const int hd = c0 - vt_lo; *(u32x4*)(VT + ((size_t)(row_batch(r) * (vt_w >> 6) + (hd >> 6)) * POSN + row_pos(r)) * 64 + (hd & 63)) = w;
                    } else if (c0 >= vt_lo && c0 < vt_hi) {
                        bf16_t* vp = VT + ((size_t)row_batch(r) * vt_w + (c0 - vt_lo)) * POSN + row_pos(r);
                        vp[0 * POSN] = (bf16_t)(w.x & 0xffffu); vp[1 * POSN] = (bf16_t)(w.x >> 16); vp[2 * POSN] = (bf16_t)(w.y & 0xffffu); vp[3 * POSN] = (bf16_t)(w.y >> 16);
                        vp[4 * POSN] = (bf16_t)(w.z & 0xffffu); vp[5 * POSN] = (bf16_t)(w.z >> 16); vp[6 * POSN] = (bf16_t)(w.w & 0xffffu); vp[7 * POSN] = (bf16_t)(w.w >> 16);
                    } } }
    }
};
struct EpiGlu {
    static constexpr bool PERM = true, AFTER_DRAIN = false;
    const bf16_t* YPRE; const bf16_t* PROJ; const float* bglu; bf16_t* YMIX;
    __device__ __forceinline__ void operator()(const f32x4 (&acc)[2][2][4][2], const Unit& u, int wr, int wc, int fr, int fq) const {
        const int row0 = u.pm * BM + wr * 64 + fr, colt = u.pn * BM + wc * 32 + 8 * fq;
#pragma unroll
        for (int bj = 0; bj < 2; ++bj) { const int c0 = colt + bj * HALF;
            const f32x4 b0 = *(const f32x4*)(bglu + c0), b1 = *(const f32x4*)(bglu + c0 + 4);
#pragma unroll
            for (int ai = 0; ai < 2; ++ai)
#pragma unroll
                for (int m = 0; m < 4; ++m) { const int r = row0 + ai * HALF + m * 16;
                    const u32x4 yv = *(const u32x4*)(YPRE + ((size_t)(c0 >> 4) * MROWS + r) * 16 + (c0 & 15)), gv = *(const u32x4*)(PROJ + (size_t)r * N0 + 512 + c0);
                    const f32x4 a0 = acc[ai][bj][m][0] + b0, a1 = acc[ai][bj][m][1] + b1;
                    float o[8];
                    o[0] = bflo(yv.x) * sigmoid_f(a0[0]) * silu_f(bflo(gv.x)); o[1] = bfhi(yv.x) * sigmoid_f(a0[1]) * silu_f(bfhi(gv.x));
                    o[2] = bflo(yv.y) * sigmoid_f(a0[2]) * silu_f(bflo(gv.y)); o[3] = bfhi(yv.y) * sigmoid_f(a0[3]) * silu_f(bfhi(gv.y));
                    o[4] = bflo(yv.z) * sigmoid_f(a1[0]) * silu_f(bflo(gv.z)); o[5] = bfhi(yv.z) * sigmoid_f(a1[1]) * silu_f(bfhi(gv.z));
                    o[6] = bflo(yv.w) * sigmoid_f(a1[2]) * silu_f(bflo(gv.w)); o[7] = bfhi(yv.w) * sigmoid_f(a1[3]) * silu_f(bfhi(gv.w));
                    u32x4 w; w.x = cvt_pk_bf16(o[0], o[1]); w.y = cvt_pk_bf16(o[2], o[3]); w.z = cvt_pk_bf16(o[4], o[5]); w.w = cvt_pk_bf16(o[6], o[7]);
                    *(u32x4*)(YMIX + (size_t)r * DM + c0) = w; } }
    }
};
struct EpiF32 {
    static constexpr bool PERM = false, AFTER_DRAIN = false;
    float* O; int ldc;
    __device__ __forceinline__ void operator()(const f32x4 (&acc)[2][2][4][2], const Unit& u, int wr, int wc, int fr, int fq) const {
        const int row0 = u.pm * BM + wr * 64 + fr, col0 = u.pn * BM + wc * 32 + 4 * fq;
#pragma unroll
        for (int ai = 0; ai < 2; ++ai)
#pragma unroll
            for (int m = 0; m < 4; ++m) { float* rowp = O + (size_t)(row0 + ai * HALF + m * 16) * ldc + col0;
#pragma unroll
                for (int bj = 0; bj < 2; ++bj)
#pragma unroll
                    for (int n = 0; n < 2; ++n) *(f32x4*)(rowp + bj * HALF + n * 16) = acc[ai][bj][m][n]; }
    }
};
template <class Epi, class Sched, bool ALIGN_EPI = false, bool SP2 = false>
__device__ __forceinline__ void gemm_phase(PG8_LAS unsigned char* lds, const Gemm g, const Sched& S, const Epi& E) {
    const int tid = threadIdx.x, wid = __builtin_amdgcn_readfirstlane(tid >> 6), lane = tid & 63, wr = wid >> 2, wc = wid & 3, fr = lane & 15, fq = lane >> 4;
    const int K = g.K, nt = K / BK;
    unsigned voffA[2], voffB[2];
#pragma unroll
    for (int i = 0; i < 2; ++i) { int R, C; stage_rc(tid * 16 + i * 8192, R, C); const int Rb = Epi::PERM ? ((R & ~31) + perm32(R & 31)) : R;
        voffA[i] = g.a_gmajor ? (unsigned)(((C >> 4) * g.M + R) * 16 + (C & 15)) * 2u : (unsigned)(R * K + C) * 2u; voffB[i] = (unsigned)(Rb * K + C) * 2u; }
    const size_t kstep = (size_t)(BK * 2);
    const size_t hstep = (size_t)HALF * K * 2;
    const size_t tstep = 2 * hstep;
    const size_t kstepA = g.a_gmajor ? (size_t)(BK / 16) * g.M * 32 : kstep, hstepA = g.a_gmajor ? (size_t)HALF * 32 : hstep, tstepA = 2 * hstepA;
    const unsigned ldsw = (unsigned)wid * 1024u;
    const int aoff = lds_byte(wr * 64 + fr, fq * 8), boff = lds_byte(wc * 32 + fr, fq * 8);
#define PG8_SA(b, h) (((b) * 2 + (h)) * HTB)
#define PG8_SB(b, h) ((4 + (b) * 2 + (h)) * HTB)
#define PG8_STAGE(bufoff, gbase, voff) do { _Pragma("unroll") for (int _i = 0; _i < 2; ++_i) \
        __builtin_amdgcn_global_load_lds((const unsigned*)((const char*)(gbase) + (voff)[_i]), (PG8_LAS unsigned*)(lds + (bufoff) + ldsw + _i * 8192), 16, 0, 0); } while (0)
#define PG8_LDA(dst, b, h) do { _Pragma("unroll") for (int m = 0; m < 4; ++m) _Pragma("unroll") for (int k = 0; k < 2; ++k) dst[m][k] = *(const PG8_LAS bf16x8*)(lds + PG8_SA(b, h) + aoff + m * 2048 + k * 1024); } while (0)
#define PG8_LDB(dst, b, h) do { _Pragma("unroll") for (int n = 0; n < 2; ++n) _Pragma("unroll") for (int k = 0; k < 2; ++k) dst[n][k] = *(const PG8_LAS bf16x8*)(lds + PG8_SB(b, h) + boff + n * 2048 + k * 1024); } while (0)
#define PG8_MMA(ai, bj, At, Bt) do { __builtin_amdgcn_s_setprio(1); _Pragma("unroll") for (int m = 0; m < 4; ++m) _Pragma("unroll") for (int n = 0; n < 2; ++n) _Pragma("unroll") for (int k = 0; k < 2; ++k) \
        acc[ai][bj][m][n] = __builtin_amdgcn_mfma_f32_16x16x32_bf16(Bt[n][k], At[m][k], acc[ai][bj][m][n], 0, 0, 0); __builtin_amdgcn_s_setprio(0); } while (0)
#define PG8_WAIT_V(n) asm volatile("s_waitcnt vmcnt(" #n ")" ::: "memory")
#define PG8_WAIT_L(n) asm volatile("s_waitcnt lgkmcnt(" #n ")" ::: "memory")
#define PG8_BAR __builtin_amdgcn_s_barrier()
#define PG8_SCHED __builtin_amdgcn_sched_barrier(0)
    Unit cur, nxt; int ui = 0;
    if (!S.next(0, cur)) return;
    f32x4 acc[2][2][4][2];
#pragma unroll
    for (int a = 0; a < 2; ++a)
#pragma unroll
        for (int b = 0; b < 2; ++b)
#pragma unroll
            for (int m = 0; m < 4; ++m)
#pragma unroll
                for (int n = 0; n < 2; ++n) acc[a][b][m][n] = (f32x4){0.f, 0.f, 0.f, 0.f};
    bf16x8 At[4][2], B0[2][2], B1[2][2];
    const char* cA = (const char*)g.A + (size_t)cur.pm * tstepA; const char* cB = (const char*)g.Bt + (size_t)cur.pn * tstep;
    S.a_ready(cur);
    if constexpr (SP2) {
        PG8_STAGE(PG8_SB(0, 0), cB, voffB); PG8_STAGE(PG8_SB(0, 1), cB + hstep, voffB); PG8_STAGE(PG8_SA(0, 0), cA, voffA); PG8_STAGE(PG8_SA(0, 1), cA + hstepA, voffA);
        if (wr == 1) PG8_BAR;
        PG8_WAIT_V(2); PG8_BAR;
        PG8_STAGE(PG8_SB(1, 0), cB + kstep, voffB); PG8_STAGE(PG8_SA(1, 0), cA + kstepA, voffA); PG8_STAGE(PG8_SB(1, 1), cB + hstep + kstep, voffB);
        PG8_WAIT_V(6); PG8_BAR;
    } else {
        PG8_STAGE(PG8_SB(0, 0), cB, voffB); PG8_STAGE(PG8_SA(0, 0), cA, voffA); PG8_STAGE(PG8_SB(0, 1), cB + hstep, voffB); PG8_STAGE(PG8_SA(0, 1), cA + hstepA, voffA);
        if (wr == 1) PG8_BAR;
        PG8_WAIT_V(4); PG8_BAR;
        PG8_STAGE(PG8_SB(1, 0), cB + kstep, voffB); PG8_STAGE(PG8_SA(1, 0), cA + kstepA, voffA); PG8_STAGE(PG8_SB(1, 1), cB + hstep + kstep, voffB);
        PG8_WAIT_V(6); PG8_BAR;
    }
    for (;;) {
        const bool has_next = S.next(ui + 1, nxt);
        const char* nA = has_next ? (const char*)g.A + (size_t)nxt.pm * tstepA : cA; const char* nB = has_next ? (const char*)g.Bt + (size_t)nxt.pn * tstep : cB;
        for (int t = 0; t < nt; t += 2) {
            const bool last = (t == nt - 2);
            const char* a1 = cA + (size_t)(t + 1) * kstepA;
            const char* a2 = last ? nA : cA + (size_t)(t + 2) * kstepA; const char* b2 = last ? nB : cB + (size_t)(t + 2) * kstep;
            const char* a3 = a2 + kstepA; const char* b3 = b2 + kstep;
            if (last && has_next) S.a_ready(nxt);
            if constexpr (SP2) {
            PG8_LDB(B0, 0, 0); PG8_LDB(B1, 0, 1); PG8_SCHED; PG8_LDA(At, 0, 0); PG8_STAGE(PG8_SA(1, 1), a1 + hstepA, voffA);
            PG8_WAIT_V(8); PG8_WAIT_L(0); PG8_BAR; PG8_MMA(0, 0, At, B0); PG8_MMA(0, 1, At, B1); PG8_BAR; PG8_SCHED;
            PG8_LDA(At, 0, 1); PG8_STAGE(PG8_SB(0, 0), b2, voffB); PG8_STAGE(PG8_SB(0, 1), b2 + hstep, voffB); PG8_STAGE(PG8_SA(0, 0), a2, voffA);
            PG8_WAIT_V(8); PG8_WAIT_L(0); PG8_BAR; PG8_MMA(1, 0, At, B0); PG8_MMA(1, 1, At, B1); PG8_BAR; PG8_SCHED;
            PG8_LDB(B0, 1, 0); PG8_LDB(B1, 1, 1); PG8_SCHED; PG8_LDA(At, 1, 0); PG8_STAGE(PG8_SA(0, 1), a2 + hstepA, voffA);
            PG8_WAIT_V(8); PG8_WAIT_L(0); PG8_BAR; PG8_MMA(0, 0, At, B0); PG8_MMA(0, 1, At, B1); PG8_BAR; PG8_SCHED;
            PG8_LDA(At, 1, 1); PG8_STAGE(PG8_SB(1, 0), b3, voffB); PG8_STAGE(PG8_SB(1, 1), b3 + hstep, voffB); PG8_STAGE(PG8_SA(1, 0), a3, voffA);
            PG8_WAIT_V(8); PG8_WAIT_L(0); PG8_BAR; PG8_MMA(1, 0, At, B0); PG8_MMA(1, 1, At, B1); PG8_BAR; PG8_SCHED;
            } else {
            PG8_LDB(B0, 0, 0); PG8_SCHED; PG8_LDA(At, 0, 0); PG8_STAGE(PG8_SA(1, 1), a1 + hstepA, voffA);
            PG8_WAIT_L(8); PG8_BAR; PG8_WAIT_L(0); PG8_MMA(0, 0, At, B0); PG8_BAR; PG8_SCHED;
            PG8_LDB(B1, 0, 1); PG8_STAGE(PG8_SB(0, 0), b2, voffB);
            PG8_BAR; PG8_WAIT_L(0); PG8_MMA(0, 1, At, B1); PG8_BAR;
            PG8_LDA(At, 0, 1); PG8_STAGE(PG8_SA(0, 0), a2, voffA);
            PG8_BAR; PG8_WAIT_L(0); PG8_MMA(1, 0, At, B0); PG8_BAR; PG8_SCHED;
            PG8_STAGE(PG8_SB(0, 1), b2 + hstep, voffB);
            PG8_WAIT_V(6); PG8_BAR; PG8_MMA(1, 1, At, B1); PG8_BAR;
            PG8_LDB(B0, 1, 0); PG8_SCHED; PG8_LDA(At, 1, 0); PG8_STAGE(PG8_SA(0, 1), a2 + hstepA, voffA);
            PG8_WAIT_L(8); PG8_BAR; PG8_WAIT_L(0); PG8_MMA(0, 0, At, B0); PG8_BAR; PG8_SCHED;
            PG8_LDB(B1, 1, 1); PG8_STAGE(PG8_SB(1, 0), b3, voffB);
            PG8_BAR; PG8_WAIT_L(0); PG8_MMA(0, 1, At, B1); PG8_BAR;
            PG8_LDA(At, 1, 1); PG8_STAGE(PG8_SA(1, 0), a3, voffA);
            PG8_BAR; PG8_WAIT_L(0); PG8_MMA(1, 0, At, B0); PG8_BAR; PG8_SCHED;
            PG8_STAGE(PG8_SB(1, 1), b3 + hstep, voffB);
            PG8_WAIT_V(6); PG8_BAR; PG8_MMA(1, 1, At, B1); PG8_BAR;
            }
        }
        if constexpr (ALIGN_EPI) { if (wr == 0) PG8_BAR; }
        if constexpr (!Epi::AFTER_DRAIN) { E(acc, cur, wr, wc, fr, fq); S.done(cur); }
        if (!has_next) break;
#pragma unroll
        for (int a = 0; a < 2; ++a)
#pragma unroll
            for (int b = 0; b < 2; ++b)
#pragma unroll
                for (int m = 0; m < 4; ++m)
#pragma unroll
                    for (int n = 0; n < 2; ++n) acc[a][b][m][n] = (f32x4){0.f, 0.f, 0.f, 0.f};
        cur = nxt; cA = nA; cB = nB; ++ui;
        if constexpr (ALIGN_EPI) { if (wr == 1) PG8_BAR; }
    }
    PG8_WAIT_V(0);
    if constexpr (!ALIGN_EPI) { if (wr == 0) PG8_BAR; }
    PG8_BAR;
    if constexpr (Epi::AFTER_DRAIN) { E.fused(acc, cur, wr, wc, fr, fq, lds, wid, lane); S.done(cur); }
#undef PG8_SA
#undef PG8_SB
#undef PG8_STAGE
#undef PG8_LDA
#undef PG8_LDB
#undef PG8_MMA
#undef PG8_WAIT_V
#undef PG8_WAIT_L
#undef PG8_BAR
#undef PG8_SCHED
}
}
#define XB_TMO      128
#define XB_XCNT(j)  (256  + 64 * (j))
#define XB_XSUB(j)  (1280 + 64 * (j))
#define XB_XGEN(j)  (2304 + 64 * (j))
#define XB_TOP      3328
#define XB_TOPGEN   3392
#define XCD_BAR_WORDS 3456
#define XB_SPIN_CAP (1u << 18)

__device__ __forceinline__ unsigned xb_ld(unsigned* p)              { return __hip_atomic_load(p, __ATOMIC_RELAXED, __HIP_MEMORY_SCOPE_AGENT); }
__device__ __forceinline__ unsigned xb_add(unsigned* p, unsigned v) { return __hip_atomic_fetch_add(p, v, __ATOMIC_RELAXED, __HIP_MEMORY_SCOPE_AGENT); }
__device__ __forceinline__ unsigned xb_xcc_id() { return (unsigned)__builtin_amdgcn_s_getreg((3 << 11) | 20) & 0xFu; }
#define XB_SPIN(cond, bar) do { unsigned _sp = 0; while (cond) { __builtin_amdgcn_s_sleep(1); \
    if ((++_sp & 255u) == 0u) { if (xb_ld(&(bar)[XB_TMO])) break; if (_sp > XB_SPIN_CAP) { atomicAdd(&(bar)[XB_TMO], 1u); break; } } } } while (0)

struct XcdBarrier {
    unsigned* bar; unsigned x;
    volatile LAS unsigned* st;
};

__device__ __forceinline__ XcdBarrier xcd_barrier_post(unsigned* bar, volatile LAS unsigned* st) {
    XcdBarrier b; b.bar = bar; b.x = xb_xcc_id(); b.st = st;
    if (threadIdx.x == 0) (void)xb_add(&bar[XB_XCNT(b.x)], 1u);
    return b;
}
__device__ __forceinline__ void xcd_barrier_complete(unsigned* bar, unsigned x, unsigned& nloc, unsigned& nx) {
    const unsigned G = gridDim.x * gridDim.y * gridDim.z;
    unsigned sum, cnt, mine, sp = 0u;
    for (;;) {
        sum = 0u; cnt = 0u; mine = 0u;
#pragma unroll
        for (unsigned j = 0; j < 16; ++j) { const unsigned c = xb_ld(&bar[XB_XCNT(j)]); sum += c; cnt += (c > 0u) ? 1u : 0u; mine = (j == x) ? c : mine; }
        if (sum == G) break;
        __builtin_amdgcn_s_sleep(1);
        if ((++sp & 255u) == 0u) { if (xb_ld(&bar[XB_TMO])) break; if (sp > XB_SPIN_CAP) { atomicAdd(&bar[XB_TMO], 1u); break; } }
    }
    nloc = mine > 0u ? mine : 1u; nx = cnt > 0u ? cnt : 1u;
}

__device__ __forceinline__ void xcd_barrier(const XcdBarrier& b) {
    asm volatile("s_waitcnt vmcnt(0)" ::: "memory");
    __syncthreads();
    if (threadIdx.x == 0) {
        unsigned* bar = b.bar;
        __builtin_amdgcn_s_waitcnt(0);
        unsigned nloc = b.st[0], nx = b.st[1];
        if (nloc == 0u) { xcd_barrier_complete(bar, b.x, nloc, nx); b.st[0] = nloc; b.st[1] = nx; }
        const unsigned old = xb_add(&bar[XB_XSUB(b.x)], 1u);
        const unsigned gen = old / nloc;
        if (old + 1u == (gen + 1u) * nloc) {
            __builtin_amdgcn_fence(__ATOMIC_RELEASE, "agent");
            asm volatile("s_waitcnt vmcnt(0)" ::: "memory");
            const unsigned og = xb_add(&bar[XB_TOP], 1u);
            const unsigned tg = og / nx;
            if (og + 1u == (tg + 1u) * nx) xb_add(&bar[XB_TOPGEN], 1u);
            else XB_SPIN(xb_ld(&bar[XB_TOPGEN]) == tg, bar);
            __builtin_amdgcn_fence(__ATOMIC_ACQUIRE, "agent");
            xb_add(&bar[XB_XGEN(b.x)], 1u);
            asm volatile("s_waitcnt vmcnt(0)" ::: "memory");
        } else {
            XB_SPIN(xb_ld(&bar[XB_XGEN(b.x)]) == gen, bar);
            __builtin_amdgcn_fence(__ATOMIC_ACQUIRE, "agent");
            asm volatile("s_waitcnt vmcnt(0)" ::: "memory");
        }
    }
    __syncthreads();
}

DI int crow16(int reg, int hf) { return (reg & 3) + 8 * (reg >> 2) + 4 * hf; }
DI unsigned cvtpk(float lo, float hi) { typedef float f2 __attribute__((ext_vector_type(2))); typedef __bf16 b2 __attribute__((ext_vector_type(2))); f2 v = {lo, hi}; b2 b = __builtin_convertvector(v, b2); return __builtin_bit_cast(unsigned, b); }
struct AttnP { const bf16_t* Q; const bf16_t* K; const bf16_t* VT; const bf16_t* Gt; bf16_t* Y; const float* relb; };

template <int MODE> DI void attn_unit(int unit, const AttnP& P, int lane) {
    const int ql = lane & 31, hf = lane >> 5;
    int b, h, kvh, qrow, NT, rp = 0, ci = 0, rs0 = 0, c0 = 0, qr = 0, qc = 0, rsq = 0, csq = 0;
    if (MODE == 0) { ci = unit & 3; rp = (unit >> 2) & 31; h = (unit >> 7) & 7; b = unit >> 10; kvh = h;
        qr = 2 * rp + (ql >> 4); qc = 16 * ci + (ql & 15); qrow = b * SEQ + qr * 64 + qc;
        rs0 = min(max(2 * rp - 4, 0), 56); const int rs1 = min(max(2 * rp - 3, 0), 56); NT = 8 + (rs1 + 8 - rs0);
        c0 = min(max(16 * ci - 8, 0), 32); rsq = min(max(qr - 4, 0), 56); csq = min(max(qc - 8, 0), 48);
    } else if (MODE == 1) { const int qt = unit & 7; h = (unit >> 3) & 7; b = unit >> 6; kvh = h; qrow = NLAT + b * LC + 32 * qt + ql; NT = 8; }
    else { const int qt = unit & 127; h = (unit >> 7) & 7; b = unit >> 10; kvh = h >> 2; qrow = b * SEQ + 32 * qt + ql; NT = POSN / 32; }
    const bf16_t* qp; const bf16_t* kb; size_t kpitch; const bf16_t* vt; const bf16_t* gp; bf16_t* yp;
    if (MODE == 2) { qp = P.Q + ((size_t)(b * 8 + h) * SEQ + (qrow - b * SEQ)) * 64; kb = P.K + (size_t)(b * 2 + kvh) * POSN * 64; kpitch = 64;
        vt = P.VT + (size_t)(b * 2 + kvh) * 64 * POSN; gp = P.Gt + (size_t)qrow * N1 + 1792 + h * 64; }
    else { qp = P.Q + (size_t)qrow * N0 + 1024 + h * 64; kb = P.K + 1536 + h * 64; kpitch = N0; vt = P.VT + (size_t)(b * 8 + h) * 64 * POSN; gp = P.Gt + (size_t)qrow * N0 + 2560 + h * 64; }
    yp = P.Y + (size_t)qrow * DM + 512 + h * 64;
    bf16x8_t qf[4];
#pragma unroll
    for (int ks = 0; ks < 4; ++ks) qf[ks] = *(const bf16x8_t*)(qp + 16 * ks + 8 * hf);
    const bf16_t* vt0 = vt + (size_t)ql * POSN + 4 * hf;
    f32x16_t o0 = {}, o1 = {};
    float m = -1e30f, l = 0.f;
    auto tile_krow = [&](int t) -> int { if (MODE == 2) return 32 * t + ql; if (t < 8) return NLAT + b * LC + 32 * t + ql; return b * SEQ + (rs0 + t - 8) * 64 + c0 + ql; };
    auto tile_pos0 = [&](int t) -> int { if (MODE == 2) return 32 * t; if (t < 8) return 32 * t; return LC + (rs0 + t - 8) * 64 + c0; };
    bf16x8_t kn[4];
    { const bf16_t* kp = kb + (size_t)tile_krow(0) * kpitch + 8 * hf;
#pragma unroll
      for (int ks = 0; ks < 4; ++ks) kn[ks] = *(const bf16x8_t*)(kp + 16 * ks); }
#pragma unroll 1
    for (int t = 0; t < NT; ++t) {
        bf16x8_t kf[4];
#pragma unroll
        for (int ks = 0; ks < 4; ++ks) kf[ks] = kn[ks];
        if (t + 1 < NT) { const bf16_t* kp = kb + (size_t)tile_krow(t + 1) * kpitch + 8 * hf;
#pragma unroll
            for (int ks = 0; ks < 4; ++ks) kn[ks] = *(const bf16x8_t*)(kp + 16 * ks); }
        const bf16_t* vp = vt0 + tile_pos0(t);
        s16x4_t va[2][2][2];
#pragma unroll
        for (int dt = 0; dt < 2; ++dt)
#pragma unroll
            for (int s = 0; s < 2; ++s) { va[dt][s][0] = *(const s16x4_t*)(vp + (size_t)dt * 32 * POSN + 16 * s); va[dt][s][1] = *(const s16x4_t*)(vp + (size_t)dt * 32 * POSN + 16 * s + 8); }
        f32x16_t sc = {};
#pragma unroll
        for (int ks = 0; ks < 4; ++ks) sc = __builtin_amdgcn_mfma_f32_32x32x16_bf16(kf[ks], qf[ks], sc, 0, 0, 0);
        float xs[16];
        if (MODE == 0 && t >= 8) {
            const int kr = rs0 + t - 8; const bool row_ok = (kr >= rsq) && (kr < rsq + 8);
            const float* rb = P.relb + (h * 15 + (kr - qr + 7)) * 31 + (15 - qc);
#pragma unroll
            for (int r = 0; r < 16; ++r) { const int kc = c0 + crow16(r, hf); const bool ok = row_ok && (kc >= csq) && (kc < csq + 16);
                const float bias = ok ? rb[kc] : 0.f; xs[r] = ok ? (sc[r] * 0.125f + bias) * LOG2E : -1e30f; }
        } else {
#pragma unroll
            for (int r = 0; r < 16; ++r) xs[r] = (MODE == 2) ? sc[r] : sc[r] * (0.125f * LOG2E);
        }
        float tm = xs[0];
#pragma unroll
        for (int r = 1; r < 16; ++r) tm = fmaxf(tm, xs[r]);
        tm = fmaxf(tm, __shfl_xor(tm, 32));
        const float mn = fmaxf(m, tm), al = __builtin_amdgcn_exp2f(m - mn);
        float ps = 0.f;
#pragma unroll
        for (int r = 0; r < 16; ++r) { xs[r] = __builtin_amdgcn_exp2f(xs[r] - mn); ps += xs[r]; }
        l = l * al + ps; m = mn;
#pragma unroll
        for (int r = 0; r < 16; ++r) { o0[r] *= al; o1[r] *= al; }
        bf16x8_t pf[2];
#pragma unroll
        for (int s = 0; s < 2; ++s) { v4u w; w.x = cvtpk(xs[8 * s], xs[8 * s + 1]); w.y = cvtpk(xs[8 * s + 2], xs[8 * s + 3]); w.z = cvtpk(xs[8 * s + 4], xs[8 * s + 5]); w.w = cvtpk(xs[8 * s + 6], xs[8 * s + 7]);
            pf[s] = __builtin_bit_cast(bf16x8_t, w); }
#pragma unroll
        for (int s = 0; s < 2; ++s) {
            const bf16x8_t a0 = __builtin_shufflevector(va[0][s][0], va[0][s][1], 0, 1, 2, 3, 4, 5, 6, 7);
            const bf16x8_t a1 = __builtin_shufflevector(va[1][s][0], va[1][s][1], 0, 1, 2, 3, 4, 5, 6, 7);
            o0 = __builtin_amdgcn_mfma_f32_32x32x16_bf16(a0, pf[s], o0, 0, 0, 0);
            o1 = __builtin_amdgcn_mfma_f32_32x32x16_bf16(a1, pf[s], o1, 0, 0, 0);
        }
    }
    l += __shfl_xor(l, 32);
    const float rl = 1.f / l;
#pragma unroll
    for (int dt = 0; dt < 2; ++dt)
#pragma unroll
        for (int rg = 0; rg < 4; ++rg) { const int d = 32 * dt + 8 * rg + 4 * hf;
            const v2u gv = *(const v2u*)(gp + d);
            const float g0 = silu_f(bflo(gv.x)), g1 = silu_f(bfhi(gv.x)), g2 = silu_f(bflo(gv.y)), g3 = silu_f(bfhi(gv.y));
            const f32x16_t& oo = dt ? o1 : o0;
            v2u w; w.x = pk2(oo[4 * rg] * rl * g0, oo[4 * rg + 1] * rl * g1); w.y = pk2(oo[4 * rg + 2] * rl * g2, oo[4 * rg + 3] * rl * g3);
            *(v2u*)(yp + d) = w; }
}

typedef float f32x2_t __attribute__((ext_vector_type(2)));
constexpr int LRU_NCOL = 272;
struct LruP { const bf16_t* P1; const float* conv_w; const float* conv_b; const float* lam; const float* b_a; const float* b_x; const bf16_t* WT; f32x2_t* SUM16; bf16_t* YMIX; };
constexpr int LRU_WTL = 0, LRU_CWL = 36864, LRU_BAX = LRU_CWL + 1280, LRU_XW = LRU_BAX + 1536, LRU_CARRY = LRU_XW + 8 * 4160, LRU_FOLD = LRU_CARRY + 16384;

DI void lru_setup(int nb, const LruP& p, LAS unsigned char* lds, int tid) {
    __syncthreads();
    for (int e = tid; e < 256 * 8; e += NTHREADS) { const int row = e >> 3, ch = e & 7; *(LAS v4u*)(lds + LRU_WTL + row * 144 + ch * 16) = *(const v4u*)(p.WT + (size_t)(nb * 256 + row) * 64 + ch * 8); }
    LAS float* CW = (LAS float*)(lds + LRU_CWL); LAS float* BAX = (LAS float*)(lds + LRU_BAX);
    if (tid < 320) CW[tid] = tid < 256 ? p.conv_w[(tid >> 6) * 512 + nb * 64 + (tid & 63)] : p.conv_b[nb * 64 + (tid & 63)];
    if (tid < 128) { const int dir = tid >> 6, ch = tid & 63; BAX[(dir * 3 + 0) * 64 + ch] = p.b_a[dir * 512 + nb * 64 + ch]; BAX[(dir * 3 + 1) * 64 + ch] = p.b_x[dir * 512 + nb * 64 + ch];
        BAX[(dir * 3 + 2) * 64 + ch] = log1pf(__expf(-p.lam[dir * 512 + nb * 64 + ch])); }
    __syncthreads();
}

template <bool PASS2> DI void lru_micro(int b, int col, int nb, int ci, const LruP& p, LAS unsigned char* lds, int wave, int lane) {
    const int n = lane & 15, q = lane >> 4;
    const int s0 = col < 16 ? NLAT + b * LC : b * SEQ, sl = col < 16 ? LC : SEQ, t0 = col < 16 ? col * 16 : (col - 16) * 16;
    LAS float* CW = (LAS float*)(lds + LRU_CWL); LAS float* BAX = (LAS float*)(lds + LRU_BAX); LAS float* XW = (LAS float*)(lds + LRU_XW + wave * 4160);
    v4u xr[4][2];
#pragma unroll
    for (int j = 0; j < 4; ++j) { const int tt = t0 + n + j - 1; const bool ok = tt >= 0 && tt < sl;
#pragma unroll
        for (int ks = 0; ks < 2; ++ks) { xr[j][ks] = (v4u){0u, 0u, 0u, 0u}; if (ok) xr[j][ks] = *(const v4u*)(p.P1 + (size_t)(s0 + tt) * N1 + nb * 64 + 32 * ks + 8 * q); } }
    bf16x8_t af[2];
#pragma unroll
    for (int ks = 0; ks < 2; ++ks) { const int c = 32 * ks + 8 * q;
        float xc[8];
        const f32x4_t bb0 = *(const LAS f32x4_t*)(CW + 256 + c), bb1 = *(const LAS f32x4_t*)(CW + 256 + c + 4);
#pragma unroll
        for (int e = 0; e < 4; ++e) { xc[e] = bb0[e]; xc[4 + e] = bb1[e]; }
#pragma unroll
        for (int j = 0; j < 4; ++j) { const f32x4_t w0 = *(const LAS f32x4_t*)(CW + j * 64 + c), w1 = *(const LAS f32x4_t*)(CW + j * 64 + c + 4); const v4u xx = xr[j][ks];
            xc[0] += w0[0] * bflo(xx.x); xc[1] += w0[1] * bfhi(xx.x); xc[2] += w0[2] * bflo(xx.y); xc[3] += w0[3] * bfhi(xx.y);
            xc[4] += w1[0] * bflo(xx.z); xc[5] += w1[1] * bfhi(xx.z); xc[6] += w1[2] * bflo(xx.w); xc[7] += w1[3] * bfhi(xx.w); }
        v4u w; w.x = pk2(xc[0], xc[1]); w.y = pk2(xc[2], xc[3]); w.z = pk2(xc[4], xc[5]); w.w = pk2(xc[6], xc[7]); af[ks] = __builtin_bit_cast(bf16x8_t, w);
#pragma unroll
        for (int e = 0; e < 8; ++e) XW[n * 65 + c + e] = xc[e]; }
    float hsum[4][4];
#pragma unroll
    for (int c4 = 0; c4 < 4; ++c4)
#pragma unroll
        for (int r = 0; r < 4; ++r) hsum[c4][r] = 0.f;
#pragma unroll 1
    for (int dir = 0; dir < 2; ++dir) {
        f32x4_t acc[8];
#pragma unroll
        for (int nt = 0; nt < 8; ++nt) { acc[nt] = (f32x4_t){0.f, 0.f, 0.f, 0.f};
            const LAS unsigned char* wrow = lds + LRU_WTL + ((dir * 2 + (nt >> 2)) * 64 + (nt & 3) * 16 + n) * 144 + 16 * q;
#pragma unroll
            for (int ks = 0; ks < 2; ++ks) { const bf16x8_t bfr = *(const LAS bf16x8_t*)(wrow + 64 * ks); acc[nt] = __builtin_amdgcn_mfma_f32_16x16x32_bf16(af[ks], bfr, acc[nt], 0, 0, 0); } }
        float a[4][4], bt[4][4];
#pragma unroll
        for (int c4 = 0; c4 < 4; ++c4) { const int ch = c4 * 16 + n;
            const float ba = BAX[(dir * 3 + 0) * 64 + ch], bx = BAX[(dir * 3 + 1) * 64 + ch], sp = BAX[(dir * 3 + 2) * 64 + ch];
#pragma unroll
            for (int r = 0; r < 4; ++r) { const float gr = sigmoid_f(acc[c4][r] + ba), gi = sigmoid_f(acc[c4 + 4][r] + bx);
                const float log_a = -8.f * gr * sp; const float av = __builtin_amdgcn_exp2f(log_a * LOG2E); a[c4][r] = av;
                const float x2 = 2.f * log_a;
                const float ser = -x2 * (1.f + x2 * (0.5f + x2 * (0.16666667f + x2 * (0.041666668f + x2 * 0.0083333338f))));
                const float om = x2 > -0.5f ? ser : 1.f - av * av;
                bt[c4][r] = __builtin_amdgcn_sqrtf(fmaxf(om, 0.f)) * gi * XW[(4 * q + r) * 65 + ch]; } }
        float Pq[4], Sq[4];
#pragma unroll
        for (int c4 = 0; c4 < 4; ++c4) { float P = 1.f, S = 0.f;
#pragma unroll
            for (int rr = 0; rr < 4; ++rr) { const int r = dir == 0 ? rr : 3 - rr; S = a[c4][r] * S + bt[c4][r]; P *= a[c4][r]; }
            Pq[c4] = P; Sq[c4] = S; }
        float Pin[4], Sin[4];
#pragma unroll
        for (int c4 = 0; c4 < 4; ++c4) { float P = 1.f, S = 0.f, Pw = 1.f, Sw = 0.f;
#pragma unroll
            for (int kk = 0; kk < 4; ++kk) { const int k = dir == 0 ? kk : 3 - kk;
                const float pk = __shfl(Pq[c4], n + 16 * k), sk = __shfl(Sq[c4], n + 16 * k);
                const bool before = dir == 0 ? (k < q) : (k > q);
                if (before) { S = pk * S + sk; P *= pk; }
                Sw = pk * Sw + sk; Pw *= pk; }
            Pin[c4] = P; Sin[c4] = S;
            if (!PASS2 && q == 0) p.SUM16[((size_t)((b * 8 + nb) * LRU_NCOL + col) * 2 + dir) * 64 + c4 * 16 + n] = (f32x2_t){Pw, Sw}; }
        if (PASS2) {
            const LAS float* CARRYL = (const LAS float*)(lds + LRU_CARRY);
#pragma unroll
            for (int c4 = 0; c4 < 4; ++c4) { float h = CARRYL[(dir * 32 + ci) * 64 + c4 * 16 + n];
                h = Pin[c4] * h + Sin[c4];
#pragma unroll
                for (int rr = 0; rr < 4; ++rr) { const int r = dir == 0 ? rr : 3 - rr; h = a[c4][r] * h + bt[c4][r]; hsum[c4][r] += h; } }
        }
    }
    if (PASS2) {
        asm volatile("s_waitcnt lgkmcnt(0)" ::: "memory");
#pragma unroll
        for (int c4 = 0; c4 < 4; ++c4)
#pragma unroll
            for (int r = 0; r < 4; ++r) XW[(4 * q + r) * 65 + c4 * 16 + n] = hsum[c4][r];
        asm volatile("s_waitcnt lgkmcnt(0)" ::: "memory");
        const int tk = lane >> 2, cg = lane & 3; const size_t row = (size_t)(s0 + t0 + tk);
        const bf16_t* gp = p.P1 + row * N1 + 512 + nb * 64 + cg * 16;
        const v4u g0 = *(const v4u*)gp, g1 = *(const v4u*)(gp + 8);
        float y[16];
#pragma unroll
        for (int e = 0; e < 16; ++e) y[e] = XW[tk * 65 + cg * 16 + e];
        v4u o0, o1;
        o0.x = pk2(y[0] * silu_f(bflo(g0.x)), y[1] * silu_f(bfhi(g0.x))); o0.y = pk2(y[2] * silu_f(bflo(g0.y)), y[3] * silu_f(bfhi(g0.y)));
        o0.z = pk2(y[4] * silu_f(bflo(g0.z)), y[5] * silu_f(bfhi(g0.z))); o0.w = pk2(y[6] * silu_f(bflo(g0.w)), y[7] * silu_f(bfhi(g0.w)));
        o1.x = pk2(y[8] * silu_f(bflo(g1.x)), y[9] * silu_f(bfhi(g1.x))); o1.y = pk2(y[10] * silu_f(bflo(g1.y)), y[11] * silu_f(bfhi(g1.y)));
        o1.z = pk2(y[12] * silu_f(bflo(g1.z)), y[13] * silu_f(bfhi(g1.z))); o1.w = pk2(y[14] * silu_f(bflo(g1.w)), y[15] * silu_f(bfhi(g1.w)));
        bf16_t* yp = p.YMIX + row * DM + nb * 64 + cg * 16;
        *(v4u*)yp = o0; *(v4u*)(yp + 8) = o1;
    }
    asm volatile("s_waitcnt lgkmcnt(0)" ::: "memory");
}

DI int lru_order_col(int dir, int k) { return dir == 0 ? k : (k < 16 ? 15 - k : 16 + (271 - k)); }

DI void lru_block(int blk, bool pass2, const LruP& p, LAS unsigned char* lds, int tid, int wave, int lane) {
    const int nb = blk & 7, b = (blk >> 3) & 3, cr = blk >> 5;
    lru_setup(nb, p, lds, tid);
    if (!pass2) {
        for (int i = wave; i < 34; i += NWAVES) { const int col = i < 32 ? 16 + 32 * cr + i : 2 * cr + (i - 32); lru_micro<false>(b, col, nb, 0, p, lds, wave, lane); }
        return;
    }
    LAS float* CARRYL = (LAS float*)(lds + LRU_CARRY); LAS f32x2_t* FOLD = (LAS f32x2_t*)(lds + LRU_FOLD);
    const int chain = tid & 127, part = tid >> 7, dir = chain >> 6, ch = chain & 63;
    const f32x2_t* SB = p.SUM16 + (size_t)(b * 8 + nb) * LRU_NCOL * 128 + dir * 64 + ch;
    const int kfirst = dir == 0 ? 16 + 32 * cr : 240 - 32 * cr;
    { const int k0 = (kfirst * part) >> 2, k1 = (kfirst * (part + 1)) >> 2;
      f32x2_t sv[60];
#pragma unroll
      for (int i = 0; i < 60; ++i) { sv[i] = (f32x2_t){1.f, 0.f}; if (k0 + i < k1) sv[i] = SB[(size_t)lru_order_col(dir, k0 + i) * 128]; }
      float P = 1.f, S = 0.f;
#pragma unroll
      for (int i = 0; i < 60; ++i) { S = sv[i][0] * S + sv[i][1]; P *= sv[i][0]; }
      FOLD[part * 128 + chain] = (f32x2_t){P, S}; }
    __syncthreads();
    if (part == 0) { float S = 0.f;
#pragma unroll
        for (int pp = 0; pp < 4; ++pp) { const f32x2_t s = FOLD[pp * 128 + chain]; S = s[0] * S + s[1]; }
        f32x2_t sv[32];
#pragma unroll
        for (int i = 0; i < 32; ++i) sv[i] = SB[(size_t)lru_order_col(dir, kfirst + i) * 128];
#pragma unroll
        for (int i = 0; i < 32; ++i) { const int col = lru_order_col(dir, kfirst + i), ci = col - (16 + 32 * cr);
            CARRYL[(dir * 32 + ci) * 64 + ch] = S; S = sv[i][0] * S + sv[i][1]; } }
    __syncthreads();
    for (int i = wave; i < 32; i += NWAVES) lru_micro<true>(b, 16 + 32 * cr + i, nb, i, p, lds, wave, lane);
}

DI float row16_sum(float v) {
    v += __builtin_bit_cast(float, __builtin_amdgcn_update_dpp(0, __builtin_bit_cast(int, v), 0xB1, 0xf, 0xf, false));
    v += __builtin_bit_cast(float, __builtin_amdgcn_update_dpp(0, __builtin_bit_cast(int, v), 0x4E, 0xf, 0xf, false));
    v += __builtin_bit_cast(float, __builtin_amdgcn_update_dpp(0, __builtin_bit_cast(int, v), 0x141, 0xf, 0xf, false));
    v += __builtin_bit_cast(float, __builtin_amdgcn_update_dpp(0, __builtin_bit_cast(int, v), 0x140, 0xf, 0xf, false));
    return v;
}
DI void qkprep_row(int r, const bf16_t* P1, const float* qn, const float* kn, const float* ROPE, bf16_t* QP, bf16_t* KP, int lane) {
    const int b = row_batch(r); const bool lat = r < NLAT; const int t = r & 4095, l16 = lane & 15, hh = lane >> 4;
    f32x4_t cs = {1.f, 0.f, 1.f, 0.f};
    if (lat) cs = *(const f32x4_t*)(ROPE + ((size_t)t * 32 + 2 * l16) * 2);
    const f32x4_t wq = *(const f32x4_t*)(qn + 4 * l16), wk = *(const f32x4_t*)(kn + 4 * l16);
#pragma unroll
    for (int hg = 0; hg < 3; ++hg) {
        if (hg < 2 && !lat) continue;
        const int slot = hg < 2 ? hg * 4 + hh : 8 + (hh & 1);
        const int col0 = slot < 8 ? 1024 + slot * 64 : 1536 + (slot - 8) * 64;
        const v2u xx = *(const v2u*)(P1 + (size_t)r * N1 + col0 + 4 * l16);
        float x[4] = {bflo(xx.x), bfhi(xx.x), bflo(xx.y), bfhi(xx.y)};
        const float ss = row16_sum(x[0] * x[0] + x[1] * x[1] + x[2] * x[2] + x[3] * x[3]);
        const float rinv = rsqrtf(ss * (1.f / 64.f) + EPSN);
        const f32x4_t w = hg < 2 ? wq : wk;
#pragma unroll
        for (int e = 0; e < 4; ++e) x[e] *= rinv * w[e];
        const float y0 = x[0] * cs[0] - x[1] * cs[1], y1 = x[0] * cs[1] + x[1] * cs[0], y2 = x[2] * cs[2] - x[3] * cs[3], y3 = x[2] * cs[3] + x[3] * cs[2];
        if (hg < 2) { const float sc = 0.125f * LOG2E; v2u o; o.x = pk2(y0 * sc, y1 * sc); o.y = pk2(y2 * sc, y3 * sc); *(v2u*)(QP + ((size_t)(b * 8 + slot) * SEQ + t) * 64 + 4 * l16) = o; }
        else if (hh < 2) { v2u o; o.x = pk2(y0, y1); o.y = pk2(y2, y3); *(v2u*)(KP + ((size_t)(b * 2 + (slot - 8)) * POSN + row_pos(r)) * 64 + 4 * l16) = o; }
    }
}

constexpr size_t WS_CARRY0 = 246 * MiB;
constexpr int S5_NCOL = 272;

DI void s5_lambar_pow(double lre, double lim, double dt, int e, double& pr, double& pi) { const double mag = exp(lre * dt * e), ang = lim * dt * e; pr = mag * cos(ang); pi = mag * sin(ang); }
typedef double f64x2_t __attribute__((ext_vector_type(2)));
DI void s5_tables_block(int item, const float* lam_re, const float* lam_im, const float* log_dt, const float* b_re, const float* b_im, const float* c_re, const float* c_im,
                        bf16_t* W16, bf16_t* WC, bf16_t* KT, float* L16, LAS unsigned char* lds, int tid) {
    const int part = item & 3, gd = item >> 2, g = gd >> 1, dir = gd & 1, gi = dir * 32 + g;
    LAS f64x2_t* POW = (LAS f64x2_t*)lds;
    LAS f64x2_t* PC = POW + 17 * 64;
    __syncthreads();
    if (tid < 64) { const int p = tid;
        const double dt = exp((double)log_dt[gi]), lre = lam_re[gi * 64 + p], lim = lam_im[gi * 64 + p];
        double l1r, l1i; s5_lambar_pow(lre, lim, dt, 1, l1r, l1i);
        const double nr = l1r - 1.0, ni = l1i, den = lre * lre + lim * lim, cfr = (nr * lre + ni * lim) / den, cfi = (ni * lre - nr * lim) / den;
        double pr = 1.0, pi = 0.0;
        for (int e = 0; e <= 16; ++e) { POW[e * 64 + p] = (f64x2_t){pr, pi}; PC[e * 64 + p] = (f64x2_t){pr * cfr - pi * cfi, pr * cfi + pi * cfr};
            if (e == 16 && part == 0) { L16[((g * 2 + dir) * 64 + p) * 2] = (float)pr; L16[((g * 2 + dir) * 64 + p) * 2 + 1] = (float)pi; }
            const double tr = pr * l1r - pi * l1i, ti = pr * l1i + pi * l1r; pr = tr; pi = ti; } }
    __syncthreads();
    for (int idx = tid; idx < 32 * 256; idx += NTHREADS) { const int row = 32 * part + (idx >> 8), k = idx & 255, p = row >> 1, c = row & 1, tp = k >> 4, hi = k & 15;
        const f64x2_t z = PC[(dir == 0 ? 15 - tp : tp) * 64 + p]; const double br = b_re[(gi * 64 + p) * 16 + hi], bi = b_im[(gi * 64 + p) * 16 + hi];
        W16[(size_t)(gd * 128 + row) * 256 + k] = f2bf((float)(c == 0 ? z[0] * br - z[1] * bi : z[0] * bi + z[1] * br)); }
    for (int idx = tid; idx < 64 * 128; idx += NTHREADS) { const int row = 64 * part + (idx >> 7), k = idx & 127, p = k >> 1, c = k & 1, t = row >> 4, ho = row & 15;
        const f64x2_t z = POW[((dir == 0 ? t : 15 - t) + 1) * 64 + p]; const double cr = c_re[(gi * 16 + ho) * 64 + p], ci = c_im[(gi * 16 + ho) * 64 + p];
        WC[(size_t)(gd * 256 + row) * 128 + k] = f2bf((float)(c == 0 ? cr * z[0] - ci * z[1] : -(cr * z[1] + ci * z[0]))); }
    for (int idx = tid; idx < 1024; idx += NTHREADS) { const int e = 1024 * part + idx, tau = e >> 8, ho = (e >> 4) & 15, hi = e & 15;
        double acc = 0.0;
#pragma unroll 4
        for (int p = 0; p < 64; ++p) { const f64x2_t z = PC[tau * 64 + p]; const double cr = c_re[(gi * 16 + ho) * 64 + p], ci = c_im[(gi * 16 + ho) * 64 + p];
            const double ar = cr * z[0] - ci * z[1], ai = cr * z[1] + ci * z[0];
            acc += ar * (double)b_re[(gi * 64 + p) * 16 + hi] - ai * (double)b_im[(gi * 64 + p) * 16 + hi]; }
        KT[(size_t)gd * 4096 + e] = f2bf((float)acc); }
}

DI int s5_tile_row0(int b, int s) { return s == 0 ? NLAT + b * LC : b * SEQ + (s - 1) * 256; }
template <int D> DI float dpp_shr(float v) { return __builtin_bit_cast(float, __builtin_amdgcn_update_dpp(0, __builtin_bit_cast(int, v), 0x110 + D, 0xf, 0xf, true)); }
DI void cmul(float ar, float ai, float br, float bi, float& cr, float& ci) { cr = ar * br - ai * bi; ci = ar * bi + ai * br; }

DI void s5_scan_unit(int cu, int m, LAS unsigned char* lds, int tid, const bf16_t* UG, const bf16_t* W16, const float* L16, bf16_t* CARRY0, bf16_t* CARRY1, int lane) {
    const int dir = cu & 1, b = (cu >> 1) & 3, g = cu >> 3;
    const int n = lane & 15, q = lane >> 4;
    __syncthreads();
    { v4u tmp[17];
#pragma unroll
      for (int i = 0; i < 17; ++i) { const int c = tid + i * NTHREADS, T = c >> 1; const int row = T < 256 ? NLAT + b * LC + T : b * SEQ + (T - 256);
          tmp[i] = *(const v4u*)(UG + ((size_t)g * MROWS + row) * 16 + 8 * (c & 1)); }
#pragma unroll
      for (int i = 0; i < 17; ++i) { const int c = tid + i * NTHREADS, T = c >> 1; *(LAS v4u*)(lds + (T >> 4) * 528 + (T & 15) * 32 + 16 * (c & 1)) = tmp[i]; } }
    bf16x8_t wf[8];
#pragma unroll
    for (int ks = 0; ks < 8; ++ks) wf[ks] = *(const bf16x8_t*)(W16 + ((size_t)(g * 2 + dir) * 128 + m * 16 + n) * 256 + 32 * ks + 8 * q);
    float Lr[2][5], Li[2][5];
    float Lnr[2], Lni[2];
    float cr[2], ci[2];
#pragma unroll
    for (int st = 0; st < 2; ++st) { const int p = 8 * m + 2 * q + st;
        Lr[st][0] = L16[((g * 2 + dir) * 64 + p) * 2]; Li[st][0] = L16[((g * 2 + dir) * 64 + p) * 2 + 1];
#pragma unroll
        for (int k = 1; k < 5; ++k) cmul(Lr[st][k - 1], Li[st][k - 1], Lr[st][k - 1], Li[st][k - 1], Lr[st][k], Li[st][k]);
        float rr = 1.f, ri = 0.f;
#pragma unroll
        for (int k = 0; k < 5; ++k) if ((n + 1) & (1 << k)) { float tr, ti; cmul(rr, ri, Lr[st][k], Li[st][k], tr, ti); rr = tr; ri = ti; }
        Lnr[st] = rr; Lni[st] = ri; cr[st] = 0.f; ci[st] = 0.f; }
    bf16_t* CARRY = (dir == 0 ? CARRY0 : CARRY1) + (size_t)(b * 32 + g) * S5_NCOL * 128;
    const int jcol = dir == 0 ? n : 15 - n;
    __syncthreads();
#pragma unroll 1
    for (int it = 0; it < 17; ++it) {
        const int s = it == 0 ? 0 : (dir == 0 ? it : 17 - it);
        const LAS unsigned char* ub = lds + (s * 16 + jcol) * 528 + (q >> 1) * 32 + 16 * (q & 1);
        bf16x8_t uf[8];
#pragma unroll
        for (int ks = 0; ks < 8; ++ks) uf[ks] = *(const LAS bf16x8_t*)(ub + ks * 64);
        f32x4_t acc = {0.f, 0.f, 0.f, 0.f};
#pragma unroll
        for (int ks = 0; ks < 8; ++ks) acc = __builtin_amdgcn_mfma_f32_16x16x32_bf16(wf[ks], uf[ks], acc, 0, 0, 0);
        float hin[4];
#pragma unroll
        for (int st = 0; st < 2; ++st) {
            float xr = acc[2 * st], xi = acc[2 * st + 1];
            { float yr, yi, tr, ti;
              yr = dpp_shr<1>(xr); yi = dpp_shr<1>(xi); cmul(Lr[st][0], Li[st][0], yr, yi, tr, ti); xr += tr; xi += ti;
              yr = dpp_shr<2>(xr); yi = dpp_shr<2>(xi); cmul(Lr[st][1], Li[st][1], yr, yi, tr, ti); xr += tr; xi += ti;
              yr = dpp_shr<4>(xr); yi = dpp_shr<4>(xi); cmul(Lr[st][2], Li[st][2], yr, yi, tr, ti); xr += tr; xi += ti;
              yr = dpp_shr<8>(xr); yi = dpp_shr<8>(xi); cmul(Lr[st][3], Li[st][3], yr, yi, tr, ti); xr += tr; xi += ti; }
            float tr, ti; cmul(Lnr[st], Lni[st], cr[st], ci[st], tr, ti);
            const float Hr = xr + tr, Hi = xi + ti;
            const float pr = dpp_shr<1>(Hr), pi = dpp_shr<1>(Hi);
            hin[2 * st] = n == 0 ? cr[st] : pr; hin[2 * st + 1] = n == 0 ? ci[st] : pi;
            cr[st] = __shfl(Hr, (lane & 48) | 15); ci[st] = __shfl(Hi, (lane & 48) | 15);
        }
        v2u w; w.x = pk2(hin[0], hin[1]); w.y = pk2(hin[2], hin[3]);
        *(v2u*)(CARRY + (size_t)(s * 16 + jcol) * 128 + m * 16 + 4 * q) = w;
    }
}

DI void s5_load_wc(bf16x8_t (&wc)[2][2][4], int g, const bf16_t* WC, int wave, int lane) {
    const int n = lane & 15, q = lane >> 4;
#pragma unroll
    for (int m2 = 0; m2 < 2; ++m2)
#pragma unroll
        for (int dir = 0; dir < 2; ++dir)
#pragma unroll
            for (int ks = 0; ks < 4; ++ks) wc[m2][dir][ks] = *(const bf16x8_t*)(WC + ((size_t)(g * 2 + dir) * 256 + (2 * wave + m2) * 16 + n) * 128 + 8 * q + 32 * ks);
}
DI void s5_out_item(int g, int b, int s, const bf16_t* UG, const bf16x8_t (&wc)[2][2][4], const bf16_t* CARRY0, const bf16_t* CARRY1, const float* dsk, bf16_t* YPRE, LAS unsigned char* lds, int wave, int lane) {
    const int n = lane & 15, q = lane >> 4;
    const int row0 = s5_tile_row0(b, s);
    const bf16_t* ub = UG + ((size_t)g * MROWS + row0 + n * 16 + (q >> 1)) * 16 + 8 * (q & 1);
    bf16x8_t uf[8];
#pragma unroll
    for (int ks = 0; ks < 8; ++ks) uf[ks] = *(const bf16x8_t*)(ub + (2 * ks) * 16);
    bf16x8_t cf[2][4];
#pragma unroll
    for (int dir = 0; dir < 2; ++dir)
#pragma unroll
        for (int ks = 0; ks < 4; ++ks) cf[dir][ks] = *(const bf16x8_t*)((dir == 0 ? CARRY0 : CARRY1) + ((size_t)(b * 32 + g) * S5_NCOL + s * 16 + n) * 128 + 32 * ks + 8 * q);
    v2u uu[2];
#pragma unroll
    for (int m2 = 0; m2 < 2; ++m2) uu[m2] = *(const v2u*)(UG + ((size_t)g * MROWS + row0 + n * 16 + 2 * wave + m2) * 16 + 4 * q);
    const f32x4_t dd = *(const f32x4_t*)(dsk + g * 16 + 4 * q);
#pragma unroll
    for (int m2 = 0; m2 < 2; ++m2) {
        const int mt = 2 * wave + m2;
        bf16x8_t ta[2][8];
#pragma unroll
        for (int dir = 0; dir < 2; ++dir)
#pragma unroll
            for (int ks = 0; ks < 8; ++ks) { const int tp = 2 * ks + (q >> 1), tau = dir == 0 ? mt - tp : tp - mt;
                const int off = tau >= 0 ? (((dir * 16 + tau) * 16 + n) * 32 + 16 * (q & 1)) : 16384;
                ta[dir][ks] = *(const LAS bf16x8_t*)(lds + off); }
        f32x4_t acc = {0.f, 0.f, 0.f, 0.f};
#pragma unroll
        for (int dir = 0; dir < 2; ++dir) {
#pragma unroll
            for (int ks = 0; ks < 4; ++ks) acc = __builtin_amdgcn_mfma_f32_16x16x32_bf16(wc[m2][dir][ks], cf[dir][ks], acc, 0, 0, 0);
#pragma unroll
            for (int ks = 0; ks < 8; ++ks) acc = __builtin_amdgcn_mfma_f32_16x16x32_bf16(ta[dir][ks], uf[ks], acc, 0, 0, 0);
        }
        const size_t tok = (size_t)(row0 + n * 16 + mt);
        const float y0 = gelu_fast(acc[0] + dd[0] * bflo(uu[m2].x)), y1 = gelu_fast(acc[1] + dd[1] * bfhi(uu[m2].x)), y2 = gelu_fast(acc[2] + dd[2] * bflo(uu[m2].y)), y3 = gelu_fast(acc[3] + dd[3] * bfhi(uu[m2].y));
        v2u w; w.x = pk2(y0, y1); w.y = pk2(y2, y3);
        *(v2u*)(YPRE + ((size_t)g * MROWS + tok) * 16 + 4 * q) = w;
    }
}

#include <hip/hip_bf16.h>
namespace gqa_body {
using bf16=__hip_bfloat16;
using bf16x8=__attribute__((ext_vector_type(8)))short;
using s16x4=__attribute__((ext_vector_type(4)))short;
using f32x16=__attribute__((ext_vector_type(16)))float;
using u32x4=__attribute__((ext_vector_type(4)))unsigned;
constexpr int NHEAD=8,SEQQ=4096,SKV=4352,D=64,QPITCH=64,KPITCH=64,VPITCH=64,OPITCH=1024,GPITCH=2304;
constexpr int NW=8,QBLK=32,QB=QBLK*NW,KVBLK=64,NQB=SEQQ/QB,NTILES=SKV/KVBLK;
constexpr int ATTN_UNIT_ROWS=QB;
__device__ __forceinline__ int crow(int r,int hi){return (r&3)+8*(r>>2)+4*hi;}
#define SBAR() __builtin_amdgcn_sched_barrier(0)
constexpr int NSLOT=3, SLOTB=8192;
constexpr int LDS_K=0, LDS_V=NSLOT*SLOTB, LDS_WS=2*NSLOT*SLOTB, LDS_OST=LDS_WS+NW*64*4, LDS_BYTES=LDS_OST+NW*4096;
constexpr float C2=0.125f*1.4426950408889634f;
__device__ __forceinline__ void glds16(const void*gsrc,unsigned lds_dst){unsigned keep;
  asm volatile("s_mov_b32 %0, m0\n\ts_mov_b32 m0, %2\n\ts_nop 0\n\tglobal_load_lds_dwordx4 %1, off\n\ts_mov_b32 m0, %0":"=&s"(keep):"v"(gsrc),"s"(lds_dst):"memory");}
__device__ __forceinline__ float max3f(float a,float b,float c){float r;asm("v_max3_f32 %0, %1, %2, %3":"=v"(r):"v"(a),"v"(b),"v"(c));return r;}
__device__ __forceinline__ float max2f(float a,float b){float r;asm("v_max_f32_e32 %0, %1, %2":"=v"(r):"v"(a),"v"(b));return r;}
__device__ __forceinline__ float fadd_s(float a,float b){float r;asm("v_add_f32_e32 %0, %1, %2":"=v"(r):"v"(a),"v"(b));return r;}
__device__ __forceinline__ float fsub_s(float a,float b){float r;asm("v_sub_f32_e32 %0, %1, %2":"=v"(r):"v"(a),"v"(b));return r;}
typedef float f32x2_t __attribute__((ext_vector_type(2))); typedef __bf16 bf16x2_t __attribute__((ext_vector_type(2)));
__device__ __forceinline__ unsigned cvtpk_s(float lo,float hi){f32x2_t v={lo,hi};bf16x2_t b=__builtin_convertvector(v,bf16x2_t);return __builtin_bit_cast(unsigned,b);}
#define WAIT_BAR(N) asm volatile("s_waitcnt vmcnt(" #N ") lgkmcnt(0)\n\ts_barrier":::"memory")

__device__ __forceinline__ void qkt(f32x16&p0,f32x16&p1,const char*Kslot,const bf16x8*qr,const f32x16&negm,int r32,int hi){
  const char*kb=Kslot+hi*1024+r32*16;
  #pragma unroll
  for(int d0=0;d0<4;++d0){
    const bf16x8 b0=*reinterpret_cast<const bf16x8*>(kb+d0*2048);
    const bf16x8 b1=*reinterpret_cast<const bf16x8*>(kb+d0*2048+512);
    if(d0==0){p0=__builtin_amdgcn_mfma_f32_32x32x16_bf16(b0,qr[0],negm,0,0,0);p1=__builtin_amdgcn_mfma_f32_32x32x16_bf16(b1,qr[0],negm,0,0,0);}
    else{p0=__builtin_amdgcn_mfma_f32_32x32x16_bf16(b0,qr[d0],p0,0,0,0);p1=__builtin_amdgcn_mfma_f32_32x32x16_bf16(b1,qr[d0],p1,0,0,0);}}
}
typedef __attribute__((address_space(3))) const char* lds_cptr;
typedef short v4i16_t __attribute__((ext_vector_type(4)));
__device__ __forceinline__ void kload8(bf16x8*kf,lds_cptr kp){
  kf[0]=*(const __attribute__((address_space(3))) bf16x8*)(kp);      kf[1]=*(const __attribute__((address_space(3))) bf16x8*)(kp+512);
  kf[2]=*(const __attribute__((address_space(3))) bf16x8*)(kp+2048); kf[3]=*(const __attribute__((address_space(3))) bf16x8*)(kp+2560);
  kf[4]=*(const __attribute__((address_space(3))) bf16x8*)(kp+4096); kf[5]=*(const __attribute__((address_space(3))) bf16x8*)(kp+4608);
  kf[6]=*(const __attribute__((address_space(3))) bf16x8*)(kp+6144); kf[7]=*(const __attribute__((address_space(3))) bf16x8*)(kp+6656);
}
__device__ __forceinline__ void kload2(bf16x8*kf,lds_cptr kp,int j){ kf[2*j]=*(const __attribute__((address_space(3))) bf16x8*)(kp+j*2048); kf[2*j+1]=*(const __attribute__((address_space(3))) bf16x8*)(kp+j*2048+512); }
__device__ __forceinline__ s16x4 vtr(lds_cptr p){ return __builtin_bit_cast(s16x4,__builtin_amdgcn_ds_read_tr16_b64_v4i16((__attribute__((address_space(3))) v4i16_t*)p)); }
__device__ __forceinline__ float rowmax(const f32x16&p0,const f32x16&p1){
  float a=max3f(p0[0],p0[1],p1[0]),b=max3f(p0[2],p0[3],p1[1]);a=max3f(a,p1[2],p1[3]);
  #pragma unroll
  for(int r=4;r<16;r+=4){a=max3f(a,p0[r],p0[r+1]);b=max3f(b,p0[r+2],p0[r+3]);a=max3f(a,p1[r],p1[r+1]);b=max3f(b,p1[r+2],p1[r+3]);}
  const float m=max2f(a,b);
  auto rr=__builtin_amdgcn_permlane32_swap(__float_as_uint(m),__float_as_uint(m),false,false);
  return max2f(__uint_as_float(rr[0]),__uint_as_float(rr[1]));
}
__device__ __forceinline__ void pv(f32x16*o,int vb,bf16x8 pa0,bf16x8 pa1,bf16x8 pa2,bf16x8 pa3){
  #pragma unroll
  for(int d0=0;d0<2;++d0){s16x4 lo[4],hi[4];
    #pragma unroll
    for(int ks=0;ks<4;++ks){
      asm volatile("ds_read_b64_tr_b16 %0,%1 offset:%c2":"=&v"(lo[ks]):"v"(vb),"i"(d0*4096+ks*1024):"memory");
      asm volatile("ds_read_b64_tr_b16 %0,%1 offset:%c2":"=&v"(hi[ks]):"v"(vb),"i"(d0*4096+ks*1024+512):"memory");}
    asm volatile("s_waitcnt lgkmcnt(0)":::"memory");SBAR();
    #define PK(k) (bf16x8){lo[k][0],lo[k][1],lo[k][2],lo[k][3],hi[k][0],hi[k][1],hi[k][2],hi[k][3]}
    o[d0]=__builtin_amdgcn_mfma_f32_32x32x16_bf16(pa0,PK(0),o[d0],0,0,0);
    o[d0]=__builtin_amdgcn_mfma_f32_32x32x16_bf16(pa1,PK(1),o[d0],0,0,0);
    o[d0]=__builtin_amdgcn_mfma_f32_32x32x16_bf16(pa2,PK(2),o[d0],0,0,0);
    o[d0]=__builtin_amdgcn_mfma_f32_32x32x16_bf16(pa3,PK(3),o[d0],0,0,0);
    #undef PK
  }
}

#ifndef ATTN_STORE16
#define ATTN_STORE16(p,v) (*(u32x4*)(p)=(v))
#endif
template<int THRL> __device__ __forceinline__ void attn_unit(int b,int h,int qb,const bf16*Q,const bf16*__restrict__ K,const bf16*__restrict__ V,bf16*O,const bf16*Gt,char*shm){
  const int tid=threadIdx.x,lane=tid&63,r32=lane&31,hi=lane>>5; const int wid=__builtin_amdgcn_readfirstlane(tid>>6);
  const int q0=qb*QB;
  const bf16*Qw=Q+((long)(b*NHEAD+h)*SEQQ+q0+wid*QBLK)*QPITCH;
  const bf16*Kh=K+(long)(b*2+(h>>2))*SKV*KPITCH,*Vh=V+(long)(b*2+(h>>2))*SKV*VPITCH;
  const unsigned lds0=(unsigned)(uintptr_t)shm;
  float*wsf=(float*)(shm+LDS_WS)+wid*64;
  const bf16*ksrc=Kh+(long)lane*KPITCH+wid*8;
  const bf16*vsrc=Vh+(long)(16*(wid&3)+(lane>>2))*VPITCH+(wid>>2)*32+(lane&3)*8;
  const unsigned kdst=lds0+LDS_K+wid*1024, vdst=lds0+LDS_V+wid*1024;
  #define DMA_K(t,slot) glds16(ksrc+(long)(t)*KVBLK*KPITCH,(unsigned)__builtin_amdgcn_readfirstlane(kdst+(slot)))
  #define DMA_V(t,slot) glds16(vsrc+(long)(t)*KVBLK*VPITCH,(unsigned)__builtin_amdgcn_readfirstlane(vdst+(slot)))
  const int vb0=(int)(lds0+LDS_V)+((lane>>4)&1)*32+(lane&3)*8+(4*hi+((lane&15)>>2))*64;
  const char*Kbase=shm+LDS_K; bf16x8 kf[8];
  const lds_cptr shm3=(lds_cptr)shm; const lds_cptr kp0=shm3+LDS_K+hi*1024+r32*16; const lds_cptr vp0=shm3+LDS_V+((lane>>4)&1)*32+(lane&3)*8+(4*hi+((lane&15)>>2))*64;
  constexpr int NT=NTILES;
  DMA_K(0,0);DMA_V(0,0);DMA_K(1,SLOTB);
  bf16x8 qr[4];
  #pragma unroll
  for(int d0=0;d0<4;++d0)qr[d0]=*reinterpret_cast<const bf16x8*>(&Qw[(long)r32*QPITCH+d0*16+hi*8]);
  float mhat=0.f,l_reg=0.f;f32x16 o[2];o[0]=f32x16{};o[1]=f32x16{};f32x16 negm=f32x16{};asm volatile("":"+v"(negm));
  #define CMASK(P0,P1,t) do{}while(0)
  bool resc=false;
  #define START(P0,P1) do{ const float rm=rowmax(P0,P1); resc=false; \
    { const float dl=rm; mhat=fadd_s(mhat,dl); \
      _Pragma("unroll") for(int r=0;r<16;++r){P0[r]=fsub_s(P0[r],dl);P1[r]=fsub_s(P1[r],dl);} \
      _Pragma("unroll") for(int r=0;r<16;++r)negm[r]=-mhat; asm volatile("":"+v"(negm)); } \
    _Pragma("unroll") for(int r=0;r<16;++r)P0[r]=__builtin_amdgcn_exp2f(P0[r]); }while(0)
  #define RESC() do{ if(resc){ asm volatile("s_waitcnt lgkmcnt(0)":::"memory"); \
      _Pragma("unroll") for(int d_=0;d_<2;++d_) _Pragma("unroll") for(int r=0;r<16;++r)o[d_][r]*=wsf[crow(r,hi)]; } }while(0)
  f32x16 pA0,pA1,pB0,pB1;
  int sl_prev=0,sl_cur=0,sl_next=SLOTB;
  #define ROT() do{sl_prev=sl_cur;sl_cur=sl_next;sl_next=(sl_next==(NSLOT-1)*SLOTB)?0:sl_next+SLOTB;}while(0)
  DMA_K(2,2*SLOTB);
  WAIT_BAR(3);
  qkt(pA0,pA1,Kbase,qr,negm,r32,hi);asm volatile("s_nop 15\n\ts_nop 7":"+v"(pA0),"+v"(pA1));CMASK(pA0,pA1,0);
  START(pA0,pA1);
  _Pragma("unroll") for(int r=0;r<16;++r)pA1[r]=__builtin_amdgcn_exp2f(pA1[r]);
  WAIT_BAR(0);
  DMA_K(3,0);DMA_V(1,SLOTB);
  ROT();
  kload8(kf,kp0+sl_cur);
  WAIT_BAR(2);
  s16x4 vlo[8],vhi[8]; u32x4 pw0,pw1,pw2,pw3;
  #define PKW(P,B) cvtpk_s(P[B],P[B+1])
  #define PAF(k) __builtin_bit_cast(bf16x8,pw##k)
  #define VFR(i) (bf16x8){vlo[i][0],vlo[i][1],vlo[i][2],vlo[i][3],vhi[i][0],vhi[i][1],vhi[i][2],vhi[i][3]}
  #define PIN(x) asm volatile("":"+v"(x))
  #define MX3(a,b,c) __builtin_fmaxf(__builtin_fmaxf((a),(b)),(c))
  #define GAPA(MF,A0,A1,A2,A3,W0,W1,PW) do{ MF; sacc+=A0; sacc+=A1; sacc+=A2; sacc+=A3; PIN(sacc); W0; W1; PIN(PW); SBAR(); }while(0)
  #define EX(v) __builtin_amdgcn_exp2f(v)
  #define GAPB(MF,X,B) do{ MF; X[B]=EX(X[B]); X[B+1]=EX(X[B+1]); X[B+2]=EX(X[B+2]); X[B+3]=EX(X[B+3]); PIN(X); SBAR(); }while(0)
  #define VRD(i) do{ vlo[i]=vtr(vp_+(((i)>>2)*4096+((i)&3)*1024)); vhi[i]=vtr(vp_+(((i)>>2)*4096+((i)&3)*1024+512)); }while(0)
  #define KRD(G,j) do{ if(G){ kload2(kf,kp0+sl_next,j); SBAR(); } }while(0)
  #define STEP(C0,C1,P0,P1,t,GK,GV,GL) do{ SBAR(); \
    const lds_cptr vp_=vp0+sl_prev; \
    VRD(0); SBAR(); float sacc=(P0[0]+P0[1]); \
    GAPA(C0=__builtin_amdgcn_mfma_f32_32x32x16_bf16(kf[0],qr[0],negm,0,0,0), P0[2],P0[3],P0[4],P0[5],     pw0[0]=PKW(P0,0), pw0[1]=PKW(P0,2), pw0); \
    VRD(4); SBAR(); GAPA(C1=__builtin_amdgcn_mfma_f32_32x32x16_bf16(kf[1],qr[0],negm,0,0,0), P0[6],P0[7],P0[8],P0[9],     pw0[2]=PKW(P0,4), pw0[3]=PKW(P0,6), pw0); \
    VRD(1); SBAR(); GAPA(C0=__builtin_amdgcn_mfma_f32_32x32x16_bf16(kf[2],qr[1],C0,0,0,0),   P0[10],P0[11],P0[12],P0[13], pw1[0]=PKW(P0,8), pw1[1]=PKW(P0,10), pw1); \
    VRD(5); SBAR(); GAPA(C1=__builtin_amdgcn_mfma_f32_32x32x16_bf16(kf[3],qr[1],C1,0,0,0),   P0[14],P0[15],P1[0],P1[1],   pw1[2]=PKW(P0,12),pw1[3]=PKW(P0,14), pw1); \
    VRD(2); SBAR(); GAPA(C0=__builtin_amdgcn_mfma_f32_32x32x16_bf16(kf[4],qr[2],C0,0,0,0),   P1[2],P1[3],P1[4],P1[5],     pw2[0]=PKW(P1,0), pw2[1]=PKW(P1,2), pw2); \
    VRD(6); SBAR(); GAPA(C1=__builtin_amdgcn_mfma_f32_32x32x16_bf16(kf[5],qr[2],C1,0,0,0),   P1[6],P1[7],P1[8],P1[9],     pw2[2]=PKW(P1,4), pw2[3]=PKW(P1,6), pw2); \
    VRD(3); SBAR(); GAPA(C0=__builtin_amdgcn_mfma_f32_32x32x16_bf16(kf[6],qr[3],C0,0,0,0),   P1[10],P1[11],P1[12],P1[13], pw3[0]=PKW(P1,8), pw3[1]=PKW(P1,10), pw3); \
    VRD(7); SBAR(); GAPA(C1=__builtin_amdgcn_mfma_f32_32x32x16_bf16(kf[7],qr[3],C1,0,0,0),   P1[14],P1[15],0.f,0.f,       pw3[2]=PKW(P1,12),pw3[3]=PKW(P1,14), pw3); \
    l_reg+=sacc; \
    if(GK){DMA_K((t)+3,sl_cur);} if(GV){DMA_V((t)+1,sl_next);} \
    CMASK(C0,C1,t); \
    { float a=MX3(C0[0],C0[1],C1[0]),b=MX3(C0[2],C0[3],C1[1]); a=MX3(a,C1[2],C1[3]); \
      _Pragma("unroll") for(int r=4;r<16;r+=4){a=MX3(a,C0[r],C0[r+1]);b=MX3(b,C0[r+2],C0[r+3]);a=MX3(a,C1[r],C1[r+1]);b=MX3(b,C1[r+2],C1[r+3]);} \
      float rm=__builtin_fmaxf(a,b); { auto rr=__builtin_amdgcn_permlane32_swap(__float_as_uint(rm),__float_as_uint(rm),false,false); rm=__builtin_fmaxf(__uint_as_float(rr[0]),__uint_as_float(rr[1])); } \
      resc=false; \
      if(__builtin_expect(__any(rm>(float)THRL),0)){ const float dl=__builtin_fmaxf(rm,0.f); mhat+=dl; \
        _Pragma("unroll") for(int r=0;r<16;++r){C0[r]-=dl;C1[r]-=dl;} \
        _Pragma("unroll") for(int r=0;r<16;++r)negm[r]=-mhat; asm volatile("":"+v"(negm)); \
        const float f=__builtin_amdgcn_exp2f(-dl); l_reg*=f; if(hi==0)wsf[r32]=f; resc=true; } } \
    SBAR(); \
    GAPB(o[0]=__builtin_amdgcn_mfma_f32_32x32x16_bf16(PAF(0),VFR(0),o[0],0,0,0), C0,0); \
    GAPB(o[1]=__builtin_amdgcn_mfma_f32_32x32x16_bf16(PAF(0),VFR(4),o[1],0,0,0), C0,4); \
    KRD(GL,0); GAPB(o[0]=__builtin_amdgcn_mfma_f32_32x32x16_bf16(PAF(1),VFR(1),o[0],0,0,0), C0,8); \
    KRD(GL,1); GAPB(o[1]=__builtin_amdgcn_mfma_f32_32x32x16_bf16(PAF(1),VFR(5),o[1],0,0,0), C0,12); \
    KRD(GL,2); GAPB(o[0]=__builtin_amdgcn_mfma_f32_32x32x16_bf16(PAF(2),VFR(2),o[0],0,0,0), C1,0); \
    KRD(GL,3); GAPB(o[1]=__builtin_amdgcn_mfma_f32_32x32x16_bf16(PAF(2),VFR(6),o[1],0,0,0), C1,4); \
    GAPB(o[0]=__builtin_amdgcn_mfma_f32_32x32x16_bf16(PAF(3),VFR(3),o[0],0,0,0), C1,8); \
    GAPB(o[1]=__builtin_amdgcn_mfma_f32_32x32x16_bf16(PAF(3),VFR(7),o[1],0,0,0), C1,12); \
    }while(0)
  int t=1;
  #undef CMASK
  #define CMASK(P0,P1,t) do{}while(0)
  for(;t+5<NT;t+=2){
    STEP(pB0,pB1,pA0,pA1,t,true,true,true);     WAIT_BAR(2); RESC(); ROT();
    STEP(pA0,pA1,pB0,pB1,t+1,true,true,true);   WAIT_BAR(2); RESC(); ROT();
  }
  #undef CMASK
  #define CMASK(P0,P1,t) do{}while(0)
  #define ENDW(tt) do{ if((tt)+3<NT){WAIT_BAR(2);} else if((tt)+2<NT){WAIT_BAR(1);} else {WAIT_BAR(0);} }while(0)
  for(;t+1<NT;t+=2){
    STEP(pB0,pB1,pA0,pA1,t,(t+3<NT),(t+1<NT),(t+1<NT));       ENDW(t);   RESC(); ROT();
    STEP(pA0,pA1,pB0,pB1,t+1,(t+4<NT),(t+2<NT),(t+2<NT));     ENDW(t+1); RESC(); ROT();
  }
  STEP(pB0,pB1,pA0,pA1,NT-1,false,false,false); RESC();
  { float sacc=pB0[0]+pB0[1]; _Pragma("unroll") for(int r=2;r<16;++r)sacc+=pB0[r]; _Pragma("unroll") for(int r=0;r<16;++r)sacc+=pB1[r]; l_reg+=sacc;
    pw0=(u32x4){PKW(pB0,0),PKW(pB0,2),PKW(pB0,4),PKW(pB0,6)};pw1=(u32x4){PKW(pB0,8),PKW(pB0,10),PKW(pB0,12),PKW(pB0,14)};pw2=(u32x4){PKW(pB1,0),PKW(pB1,2),PKW(pB1,4),PKW(pB1,6)};pw3=(u32x4){PKW(pB1,8),PKW(pB1,10),PKW(pB1,12),PKW(pB1,14)};
    SBAR(); pv(o,vb0+sl_cur,PAF(0),PAF(1),PAF(2),PAF(3)); }
  #undef PKW
  #undef PAF
  #undef VFR
  #undef PIN
  #undef MX3
  #undef GAPA
  #undef GAPB
  #undef EX
  #undef VRD
  #undef KRD
  #undef STEP
  #undef ENDW
  {auto rr=__builtin_amdgcn_permlane32_swap(__float_as_uint(l_reg),__float_as_uint(l_reg),false,false);l_reg=__uint_as_float(rr[0])+__uint_as_float(rr[1]);}
  if(hi==0)wsf[32+r32]=l_reg;asm volatile("s_waitcnt lgkmcnt(0)":::"memory");
  float rli[16];
  #pragma unroll
  for(int r=0;r<16;++r)rli[r]=__builtin_amdgcn_rcpf(wsf[32+crow(r,hi)]);
  bf16*Ow=O+((long)b*SEQQ+q0+wid*QBLK)*OPITCH+h*D; const bf16*Gw=Gt+((long)b*SEQQ+q0+wid*QBLK)*GPITCH+h*D;
  { bf16*stg=(bf16*)(shm+LDS_OST)+wid*2048;
    #pragma unroll
    for(int r=0;r<16;++r){const int orow=crow(r,hi);
      #pragma unroll
      for(int d0=0;d0<2;++d0)stg[orow*64+d0*32+r32]=__float2bfloat16(o[d0][r]*rli[r]);}
    asm volatile("s_waitcnt lgkmcnt(0)":::"memory");
    #pragma unroll
    for(int i=0;i<4;++i){const int row=i*8+(lane>>3),ch=lane&7; const u32x4 v=*(const u32x4*)(stg+row*64+ch*8); const u32x4 gv=*(const u32x4*)(Gw+(long)row*GPITCH+ch*8); u32x4 w;
      w.x=pk2(bflo(v.x)*silu_f(bflo(gv.x)),bfhi(v.x)*silu_f(bfhi(gv.x))); w.y=pk2(bflo(v.y)*silu_f(bflo(gv.y)),bfhi(v.y)*silu_f(bfhi(gv.y)));
      w.z=pk2(bflo(v.z)*silu_f(bflo(gv.z)),bfhi(v.z)*silu_f(bfhi(gv.z))); w.w=pk2(bflo(v.w)*silu_f(bflo(gv.w)),bfhi(v.w)*silu_f(bfhi(gv.w)));
      ATTN_STORE16(Ow+(long)row*OPITCH+ch*8,w);} }
  asm volatile("s_waitcnt lgkmcnt(0)\n\ts_barrier":::"memory");
  #undef DMA_K
  #undef DMA_V
  #undef CMASK
  #undef START
  #undef RESC
  #undef ROT
}
constexpr int ATTN_LDS_BYTES=LDS_BYTES;
#undef SBAR
#undef WAIT_BAR
}

typedef short v4i16_t __attribute__((ext_vector_type(4)));
DI s16x4_t vtr16(const LAS unsigned char* p) { return __builtin_bit_cast(s16x4_t, __builtin_amdgcn_ds_read_tr16_b64_v4i16((LAS v4i16_t*)p)); }

struct NaState { f32x16_t o0, o1; float m, l; };
template <bool MASK> DI void na_tile(NaState& st, const bf16x8_t (&qf)[4], const LAS unsigned char* Kb, const LAS unsigned char* Vb, int koff, int lane,
                                     int kr, int qr, int qc, int rsq, int csq, const LAS float* BIAS) {
    const int ql = lane & 31, hf = lane >> 5, row = koff + ql;
    f32x16_t sc = {};
    if (MASK) {
        const bool row_ok = (kr >= rsq) && (kr < rsq + 8);
        const int bbase = (kr - qr + 7) * 31 + (15 - qc);
#pragma unroll
        for (int r = 0; r < 16; ++r) { const int kc = koff + crow16(r, hf); const bool ok = row_ok && (kc >= csq) && (kc < csq + 16); sc[r] = BIAS[ok ? bbase + kc : 465]; }
    }
#pragma unroll
    for (int ks = 0; ks < 4; ++ks) { const bf16x8_t kf = *(const LAS bf16x8_t*)(Kb + row * 128 + (((2 * ks + hf) ^ (row & 7)) << 4)); sc = __builtin_amdgcn_mfma_f32_32x32x16_bf16(kf, qf[ks], sc, 0, 0, 0); }
    const LAS unsigned char* vp = Vb + ((lane >> 4) & 1) * 32 + (lane & 3) * 8 + (koff + 4 * hf + ((lane & 15) >> 2)) * 64;
    s16x4_t vl[2][2], vh[2][2];
#pragma unroll
    for (int dt = 0; dt < 2; ++dt)
#pragma unroll
        for (int s = 0; s < 2; ++s) { vl[dt][s] = vtr16(vp + dt * 4096 + s * 1024); vh[dt][s] = vtr16(vp + dt * 4096 + s * 1024 + 512); }
    float tm = fmaxf(fmaxf(sc[0], sc[1]), sc[2]);
#pragma unroll
    for (int r = 3; r < 15; r += 2) tm = fmaxf(fmaxf(tm, sc[r]), sc[r + 1]);
    tm = fmaxf(tm, sc[15]);
    tm = fmaxf(tm, __shfl_xor(tm, 32));
    const bool mv = tm > st.m + 8.f;
    if (__builtin_amdgcn_ballot_w64(mv) != 0ull) {
        const float mn = mv ? tm : st.m, al = __builtin_amdgcn_exp2f(st.m - mn);
        st.l *= al; st.m = mn;
#pragma unroll
        for (int r = 0; r < 16; ++r) { st.o0[r] *= al; st.o1[r] *= al; }
    }
    float xs[16]; float ps = 0.f;
#pragma unroll
    for (int r = 0; r < 16; ++r) { xs[r] = __builtin_amdgcn_exp2f(sc[r] - st.m); ps += xs[r]; }
    st.l += ps;
#pragma unroll
    for (int s = 0; s < 2; ++s) { v4u w; w.x = cvtpk(xs[8 * s], xs[8 * s + 1]); w.y = cvtpk(xs[8 * s + 2], xs[8 * s + 3]); w.z = cvtpk(xs[8 * s + 4], xs[8 * s + 5]); w.w = cvtpk(xs[8 * s + 6], xs[8 * s + 7]);
        const bf16x8_t pf = __builtin_bit_cast(bf16x8_t, w);
        const bf16x8_t a0 = __builtin_shufflevector(vl[0][s], vh[0][s], 0, 1, 2, 3, 4, 5, 6, 7), a1 = __builtin_shufflevector(vl[1][s], vh[1][s], 0, 1, 2, 3, 4, 5, 6, 7);
        st.o0 = __builtin_amdgcn_mfma_f32_32x32x16_bf16(a0, pf, st.o0, 0, 0, 0);
        st.o1 = __builtin_amdgcn_mfma_f32_32x32x16_bf16(a1, pf, st.o1, 0, 0, 0); }
}

constexpr int NA_BLOCK_UNITS = 512 + 32;
DI void na_block_unit(int unit, const bf16_t* PROJ, const float* relb, bf16_t* YMIX, LAS unsigned char* lds, int tid, int wave, int lane) {
    LAS unsigned char* KB = lds; LAS unsigned char* VB = lds + 16384; LAS float* BIAS = (LAS float*)(lds + 32768);
    const bool lat = unit < 512;
    int b, h, R = 0;
    if (lat) { R = unit & 15; h = (unit >> 4) & 7; b = unit >> 7; } else { const int u = unit - 512; h = u & 7; b = u >> 3; }
    const int ql = lane & 31, hf = lane >> 5;
    int qrow, qr = 0, qc = 0, rsq = 0, csq = 0, c0 = 0, rlo = 0, rhi = 0, rsA = 0, nsteps = 4;
    if (lat) { const int rp = 2 * R + (wave >> 2), ci = wave & 3; qr = 2 * rp + (ql >> 4); qc = 16 * ci + (ql & 15); qrow = b * SEQ + qr * 64 + qc;
        rsq = min(max(qr - 4, 0), 56); csq = min(max(qc - 8, 0), 48); c0 = min(max(16 * ci - 8, 0), 32);
        rlo = min(max(2 * rp - 4, 0), 56); rhi = min(max(2 * rp - 3, 0), 56) + 8;
        rsA = min(max(4 * R - 4, 0), 56); const int rsB = min(max(4 * R - 1, 0), 56); nsteps = 4 + (rsB + 8 - rsA);
    } else qrow = NLAT + b * LC + 32 * wave + ql;
    __syncthreads();
    if (lat) for (int e = tid; e < 466; e += NTHREADS) BIAS[e] = e < 465 ? relb[h * 465 + e] * LOG2E : -1e30f;
    bf16x8_t qf[4];
    { const bf16_t* qp = PROJ + (size_t)qrow * N0 + 1024 + h * 64 + 8 * hf;
#pragma unroll
      for (int ks = 0; ks < 4; ++ks) qf[ks] = *(const bf16x8_t*)(qp + 16 * ks); }
    NaState st; st.o0 = (f32x16_t){}; st.o1 = (f32x16_t){}; st.m = -1e30f; st.l = 0.f;
    const int srow = tid >> 3, sch = tid & 7;
    const int kdst = srow * 128 + ((sch ^ (srow & 7)) << 4), vdst = (sch >> 2) * 4096 + srow * 64 + (sch & 3) * 16;
    auto step_row0 = [&](int s) -> int { return s < 4 ? NLAT + b * LC + 64 * s : b * SEQ + (rsA + s - 4) * 64; };
    v4u kr0, vr0, kr1, vr1, kr2, vr2;
#define NA_LOAD(KR, VR, S_) do { if ((S_) < nsteps) { const bf16_t* src_ = PROJ + (size_t)(step_row0(S_) + srow) * N0 + h * 64 + sch * 8; KR = *(const v4u*)(src_ + 1536); VR = *(const v4u*)(src_ + 2048); } } while (0)
#define NA_STEP(KR, VR, S_) do { if ((S_) < nsteps) { LAS unsigned char* kb = KB + ((S_) & 1) * 8192; LAS unsigned char* vb = VB + ((S_) & 1) * 8192; \
        *(LAS v4u*)(kb + kdst) = KR; *(LAS v4u*)(vb + vdst) = VR; __syncthreads(); NA_LOAD(KR, VR, (S_) + 3); \
        if ((S_) < 4) { na_tile<false>(st, qf, kb, vb, 0, lane, 0, 0, 0, 0, 0, BIAS); na_tile<false>(st, qf, kb, vb, 32, lane, 0, 0, 0, 0, 0, BIAS); } \
        else { const int kr = rsA + (S_) - 4; if (kr >= rlo && kr < rhi) na_tile<true>(st, qf, kb, vb, c0, lane, kr, qr, qc, rsq, csq, BIAS); } } } while (0)
    kr0 = vr0 = kr1 = vr1 = kr2 = vr2 = (v4u){0u, 0u, 0u, 0u};
    NA_LOAD(kr0, vr0, 0); NA_LOAD(kr1, vr1, 1); NA_LOAD(kr2, vr2, 2);
#pragma unroll 1
    for (int s = 0; s < nsteps; s += 3) { NA_STEP(kr0, vr0, s); NA_STEP(kr1, vr1, s + 1); NA_STEP(kr2, vr2, s + 2); }
#undef NA_LOAD
#undef NA_STEP
    st.l += __shfl_xor(st.l, 32);
    const float rl = 1.f / st.l;
    const bf16_t* gp = PROJ + (size_t)qrow * N0 + 2560 + h * 64; bf16_t* yp = YMIX + (size_t)qrow * DM + 512 + h * 64;
#pragma unroll
    for (int dt = 0; dt < 2; ++dt)
#pragma unroll
        for (int rg = 0; rg < 4; ++rg) { const int d = 32 * dt + 8 * rg + 4 * hf;
            const v2u gv = *(const v2u*)(gp + d);
            const float g0 = silu_f(bflo(gv.x)), g1 = silu_f(bfhi(gv.x)), g2 = silu_f(bflo(gv.y)), g3 = silu_f(bfhi(gv.y));
            const f32x16_t& oo = dt ? st.o1 : st.o0;
            v2u w; w.x = pk2(oo[4 * rg] * rl * g0, oo[4 * rg + 1] * rl * g1); w.y = pk2(oo[4 * rg + 2] * rl * g2, oo[4 * rg + 3] * rl * g3);
            *(v2u*)(yp + d) = w; }
}

#ifdef PROBE_TS_A
#define PSTAMP(i) do { if (blockIdx.x == 0 && tid == 0) ((volatile LAS unsigned*)(lds + 147456 - 1024 + 64))[16 + (i)] = (unsigned)__builtin_amdgcn_s_memrealtime(); } while (0)
#else
#define PSTAMP(i) do {} while (0)
#endif
struct Args { const float* in[32]; float* out; unsigned char* ws; int ph_lo, ph_hi, li, pad; };
DI void phase3(const Args& args, LAS unsigned char* lds, int tid, int wave, int lane, int G, int pass) {
    unsigned char* ws = args.ws;
    for (int cu = blockIdx.x; cu < 256; cu += G)
        s5_scan_unit(cu, wave, lds, tid, (const bf16_t*)(ws + WS_UG), (const bf16_t*)(ws + WS_W16), (const float*)(ws + WS_L16), (bf16_t*)(ws + WS_CARRY0), (bf16_t*)(ws + WS_CARRY1), lane);
    PSTAMP(40);
    for (int u = blockIdx.x; u < NA_BLOCK_UNITS; u += G) na_block_unit(u, (const bf16_t*)(ws + WS_PROJ), args.in[20], (bf16_t*)(ws + WS_YMIX), lds, tid, wave, lane);
}
DI void phase4(const Args& args, LAS unsigned char* lds, int tid, int wave, int lane, int G) {
    unsigned char* ws = args.ws;
    constexpr int NIT = 32 * 4 * 17;
    const int i0 = (int)(((long)blockIdx.x * NIT) / G), i1 = (int)(((long)(blockIdx.x + 1) * NIT) / G);
    int gcur = -1;
    bf16x8_t wc[2][2][4];
    for (int it = i0; it < i1; ++it) {
        const int g = it / 68, b = (it % 68) / 17, s = it % 17;
        if (g != gcur) { __syncthreads(); for (int e = tid; e < 1024; e += NTHREADS) ((LAS v4u*)lds)[e] = ((const v4u*)(ws + WS_KT))[(size_t)g * 1024 + e];
            if (tid < 2) ((LAS v4u*)(lds + 16384))[tid] = (v4u){0u, 0u, 0u, 0u};
            s5_load_wc(wc, g, (const bf16_t*)(ws + WS_WC), wave, lane); gcur = g; __syncthreads(); }
        s5_out_item(g, b, s, (const bf16_t*)(ws + WS_UG), wc, (const bf16_t*)(ws + WS_CARRY0), (const bf16_t*)(ws + WS_CARRY1), args.in[17], (bf16_t*)(ws + WS_YPRE), lds, wave, lane);
    }
}
DI LruP make_lrup(const Args& args) { unsigned char* ws = args.ws;
    return LruP{(const bf16_t*)(ws + WS_PROJ), args.in[23], args.in[24], args.in[25], args.in[27], args.in[29], (const bf16_t*)(ws + WS_LRUWT), (f32x2_t*)(ws + WS_CARRY0), (bf16_t*)(ws + WS_YMIX)}; }
DI void phase9(const Args& args, LAS unsigned char* lds, int tid, int wave, int lane, int G) {
    unsigned char* ws = args.ws; const LruP lp = make_lrup(args);
    for (int blk = blockIdx.x; blk < 256; blk += G) lru_block(blk, false, lp, lds, tid, wave, lane);
    const int gw = blockIdx.x * NWAVES + wave, NGW = G * NWAVES;
    for (int r = gw; r < MROWS; r += NGW) qkprep_row(r, (const bf16_t*)(ws + WS_PROJ), args.in[30], args.in[31], (const float*)(ws + WS_ROPE), (bf16_t*)(ws + WS_QP), (bf16_t*)(ws + WS_KP), lane);
}
DI void phase10(const Args& args, LAS unsigned char* lds, int tid, int wave, int lane, int G) {
    unsigned char* ws = args.ws;
    const LruP lp = make_lrup(args);
    for (int blk = blockIdx.x; blk < 256; blk += G) lru_block(blk, true, lp, lds, tid, wave, lane);
    __syncthreads();
    PSTAMP(41);
    const int bx = blockIdx.x, vcu = (G % 8 == 0) ? (bx % 8) * (G / 8) + bx / 8 : bx;
    typedef gqa_body::bf16 abf;
    for (int u = vcu; u < 512; u += G) {
        const int qb = u & 15, hq = (u >> 4) & 7, b = u >> 7;
        gqa_body::attn_unit<8>(b, hq, qb, (const abf*)(ws + WS_QP), (const abf*)(ws + WS_KP), (const abf*)(ws + WS_VT1), (abf*)(ws + WS_YMIX) + 512, (const abf*)(ws + WS_PROJ) + 1792, (char*)lds);
    }
}

constexpr int RING_BYTES = 131072, LDS_BYTES = 147456, LDSCTL_OFF = LDS_BYTES - 1024, MISC_OFF = LDSCTL_OFF + 64;
constexpr int CW_BAR = 4096;
constexpr int N_PHASES = 13;
constexpr bool kSP2 = true, kALIGN = true;

DI void p0_adaln(LAS unsigned char* lds, const float* c, const float* cctx, const float* ada_w, const float* ada_b, float* MOD, int tid, int wave, int lane, int G) {
    LAS float* sl = (LAS float*)lds;
    LAS float* red = (LAS float*)(lds + 5 * 1024 * 4);
    if ((int)blockIdx.x >= 192) return;
    for (int e = tid; e < 5 * 1024; e += NTHREADS) { const int r = e >> 10, k = e & 1023; const float x = r < 4 ? c[r * 1024 + k] : cctx[k]; sl[e] = silu_f(x); }
    __syncthreads();
    for (int item = blockIdx.x; item < 192; item += G) {
        const int i = item / 96, cb = item % 96, col = cb * 32 + (lane & 31), kh = lane >> 5;
        const float* W = ada_w + (size_t)i * 1024 * 3072 + col;
        float acc[5] = {0.f, 0.f, 0.f, 0.f, 0.f};
#pragma unroll 8
        for (int kk = 0; kk < 64; ++kk) { const int k = wave * 128 + 2 * kk + kh; const float w = W[(size_t)k * 3072];
#pragma unroll
            for (int r = 0; r < 5; ++r) acc[r] += sl[r * 1024 + k] * w; }
#pragma unroll
        for (int r = 0; r < 5; ++r) { acc[r] += __shfl_xor(acc[r], 32); if (lane < 32) red[(wave * 5 + r) * 32 + lane] = acc[r]; }
        __syncthreads();
        if (tid < 160) { const int r = tid >> 5, cl = tid & 31; float s = ada_b[i * 3072 + cb * 32 + cl];
#pragma unroll
            for (int w = 0; w < 8; ++w) s += red[(w * 5 + r) * 32 + cl];
            MOD[(i * 5 + r) * 3072 + cb * 32 + cl] = s; }
        __syncthreads();
    }
}
DI void p0_transpose_item(const float* W, int K, int N, bf16_t* WT, int row_off, LAS float* scr, int item, int lane) {
    const int nblk = N / 32, kb = item / nblk, nb = item % nblk, k0 = 64 * kb, n0 = 32 * nb;
#pragma unroll 8
    for (int i = 0; i < 32; ++i) { const int kk = 2 * i + (lane >> 5); scr[kk * 33 + (lane & 31)] = W[(size_t)(k0 + kk) * N + n0 + (lane & 31)]; }
    LDS_WAIT(); asm volatile("" ::: "memory");
    const int c = lane & 7;
#pragma unroll
    for (int j = 0; j < 4; ++j) { const int n = (lane >> 3) + 8 * j; const LAS float* s = scr + (8 * c) * 33 + n;
        v4u o; o.x = pk2(s[0 * 33], s[1 * 33]); o.y = pk2(s[2 * 33], s[3 * 33]); o.z = pk2(s[4 * 33], s[5 * 33]); o.w = pk2(s[6 * 33], s[7 * 33]);
        *(v4u*)(WT + (size_t)(row_off + n0 + n) * K + k0 + 8 * c) = o; }
    LDS_WAIT(); asm volatile("" ::: "memory");
}

DI void load_row16(const float* src, int lane, float (&v)[16]) {
#pragma unroll
    for (int j = 0; j < 4; ++j) { const f32x4_t t = *(const f32x4_t*)(src + j * 256 + lane * 4); v[4 * j] = t[0]; v[4 * j + 1] = t[1]; v[4 * j + 2] = t[2]; v[4 * j + 3] = t[3]; }
}
DI float row_rinv(const float (&v)[16]) {
    float ss = 0.f;
#pragma unroll
    for (int j = 0; j < 16; ++j) ss += v[j] * v[j];
    ss = wave_sum(ss);
    return rsqrtf(ss * (1.f / DM) + EPSN);
}
DI void store_modnorm(const float (&v)[16], float rinv, const float* g, const float* m, bf16_t* dst, int lane) {
#pragma unroll
    for (int j = 0; j < 4; ++j) { const int col = j * 256 + lane * 4;
        const f32x4_t gg = *(const f32x4_t*)(g + col), sc = *(const f32x4_t*)(m + 1024 + col), sh = *(const f32x4_t*)(m + col);
        float y[4];
#pragma unroll
        for (int e = 0; e < 4; ++e) y[e] = v[4 * j + e] * rinv * gg[e] * (1.f + sc[e]) + sh[e];
        v2u o; o.x = pk2(y[0], y[1]); o.y = pk2(y[2], y[3]); *(v2u*)(dst + col) = o; }
}

__global__ void __launch_bounds__(NTHREADS, 2) mega(Args args) {
    extern __shared__ __attribute__((aligned(16))) unsigned char lds_raw[];
    LAS unsigned char* lds = (LAS unsigned char*)lds_raw;
    volatile LAS unsigned* MISC = (volatile LAS unsigned*)(lds + MISC_OFF);
    const int tid = threadIdx.x, lane = tid & 63, wave = __builtin_amdgcn_readfirstlane(tid >> 6);
    const int G = gridDim.x;
    unsigned char* ws = args.ws;
    gu32* ctl = (gu32*)(ws + WS_CTL);
    for (int u = tid; u < (LDS_BYTES - LDSCTL_OFF) / 4; u += NTHREADS) ((LAS unsigned*)(lds + LDSCTL_OFF))[u] = 0u;
    __syncthreads();
    XcdBarrier bar = xcd_barrier_post((unsigned*)(ctl + CW_BAR) + args.li * XCD_BAR_WORDS, MISC + 8);
    const int lo = args.ph_lo, hi = args.ph_hi;
#define IN(k) (lo <= (k) && (k) < hi)
#ifndef PROBE_REP
#define PROBE_REP 0
#endif
#define PHASE_LOOP(k) for (int rep_ = 0, nrep_ = IN(k) ? 1 + ((PROBE_REP >> (k)) & 1) : 0; rep_ < nrep_; (++rep_ < nrep_) ? xcd_barrier(bar) : (void)0)
#ifdef PROBE_TS_A
#define STAMP(i) do { if (blockIdx.x == 0 && tid == 0) MISC[16 + (i)] = (unsigned)__builtin_amdgcn_s_memrealtime(); } while (0)
#else
#define STAMP(i) do {} while (0)
#endif
#define SEAM(k) do { if (IN(k) && IN((k) + 1)) xcd_barrier(bar); } while (0)

    const float* x = args.in[0]; const float* cvec = args.in[1]; const float* ctxin = args.in[2]; const float* cctx = args.in[3];
    const float* ada_w = args.in[4]; const float* ada_b = args.in[5]; const float* pre_g = args.in[6]; const float* post_g = args.in[7];
    float* out = args.out;
    float* MOD = (float*)(ws + WS_MOD);
    bf16_t* XN = (bf16_t*)(ws + WS_XN); bf16_t* YMIX = (bf16_t*)(ws + WS_YMIX); bf16_t* PROJ = (bf16_t*)(ws + WS_PROJ); float* OUTF = (float*)(ws + WS_PROJ);
    bf16_t* YPRE = (bf16_t*)(ws + WS_YPRE);
    const int gw = blockIdx.x * NWAVES + wave, NGW = G * NWAVES;

    PHASE_LOOP(0) { STAMP(0);
        p0_adaln(lds, cvec, cctx, ada_w, ada_b, MOD, tid, wave, lane, G);
        for (int it = G - 1 - (int)blockIdx.x; it < 256; it += G)
            s5_tables_block(it, args.in[10], args.in[11], args.in[12], args.in[13], args.in[14], args.in[15], args.in[16], (bf16_t*)(ws + WS_W16), (bf16_t*)(ws + WS_WC), (bf16_t*)(ws + WS_KT), (float*)(ws + WS_L16), lds, tid);
    }
    STAMP(1);
    SEAM(0);
    PHASE_LOOP(1) { STAMP(2);
        for (int r = gw; r < MROWS; r += NGW) {
            const float* src = r < NLAT ? x + (size_t)r * DM : ctxin + (size_t)(r - NLAT) * DM;
            float v[16]; load_row16(src, lane, v);
            store_modnorm(v, row_rinv(v), pre_g, MOD + (r < NLAT ? (r >> 12) : 4) * 3072, XN + (size_t)r * DM, lane);
        }
        LAS float* scr = (LAS float*)(lds + 32768 + wave * 8704);
        constexpr int I0 = 16 * 96, I1 = 16 * 32, I2 = 16 * 72, I3 = 16 * 32, I4 = 8 * 16, NBIG = I0 + I1 + I2 + I3 + I4, NLRU = 32 * 2;
        for (int it = gw; it < NBIG + NLRU; it += NGW) {
            int r = it;
            if (r < I0) { p0_transpose_item(args.in[8], 1024, 3072, (bf16_t*)(ws + WS_WIN0T), 0, scr, r, lane); continue; } r -= I0;
            if (r < I1) { p0_transpose_item(args.in[9], 1024, 1024, (bf16_t*)(ws + WS_WOUT0T), 0, scr, r, lane); continue; } r -= I1;
            if (r < I2) { p0_transpose_item(args.in[21], 1024, 2304, (bf16_t*)(ws + WS_WIN1T), 0, scr, r, lane); continue; } r -= I2;
            if (r < I3) { p0_transpose_item(args.in[22], 1024, 1024, (bf16_t*)(ws + WS_WOUT1T), 0, scr, r, lane); continue; } r -= I3;
            if (r < I4) { p0_transpose_item(args.in[18], 512, 512, (bf16_t*)(ws + WS_WGLUT), 0, scr, r, lane); continue; } r -= I4;
            { const int mat = r >> 1, sub = r & 1, dir = mat >> 4, gate = (mat >> 3) & 1, blk = mat & 7;
              const float* W = (gate ? args.in[28] : args.in[26]) + (size_t)(dir * 8 + blk) * 4096;
              p0_transpose_item(W, 64, 64, (bf16_t*)(ws + WS_LRUWT), blk * 256 + (dir * 2 + gate) * 64, scr, sub, lane); }
        }
        float* ROPE = (float*)(ws + WS_ROPE);
        for (int e = blockIdx.x * NTHREADS + tid; e < SEQ * 32; e += G * NTHREADS) { const int t = e >> 5, i = e & 31, f = i & 15; const float pos = (float)(i < 16 ? (t >> 6) : (t & 63));
            const float inv = (float)exp(-log(10000.0) * (double)(2 * f) / 32.0); const float ang = pos * inv; ROPE[2 * e] = cosf(ang); ROPE[2 * e + 1] = sinf(ang); }
    }
    STAMP(3);
    SEAM(1);
    PHASE_LOOP(2) { STAMP(4);
        pg8::Gemm g{XN, (const bf16_t*)(ws + WS_WIN0T), MROWS, N0, DM}; pg8::StaticOrder S; S.init(MROWS, N0, G, (int)blockIdx.x);
        pg8::EpiProj E{PROJ, N0, nullptr, 1 << 30, 1 << 30, 512, false, (bf16_t*)(ws + WS_UG), 512, 1024, 1536, 0.125f * LOG2E};
        pg8::gemm_phase<pg8::EpiProj, pg8::StaticOrder, kALIGN, kSP2>(lds, g, S, E);
    }
    STAMP(5);
    SEAM(2);
    PHASE_LOOP(3) { STAMP(6); phase3(args, lds, tid, wave, lane, G, rep_); }
    STAMP(7);
    SEAM(3);
    PHASE_LOOP(4) { STAMP(8); phase4(args, lds, tid, wave, lane, G); }
    STAMP(9);
    SEAM(4);
    PHASE_LOOP(5) { STAMP(10);
        pg8::Gemm g{YPRE, (const bf16_t*)(ws + WS_WGLUT), MROWS, 512, 512, 1};   pg8::StaticOrder S; S.init(MROWS, 512, G, (int)blockIdx.x);
        pg8::EpiGlu E{YPRE, PROJ, args.in[19], YMIX};
        pg8::gemm_phase<pg8::EpiGlu, pg8::StaticOrder, kALIGN, kSP2>(lds, g, S, E);
    }
    STAMP(11);
    SEAM(5);
    PHASE_LOOP(6) { STAMP(12);
        pg8::Gemm g{YMIX, (const bf16_t*)(ws + WS_WOUT0T), MROWS, DM, DM}; pg8::StaticOrder S; S.init(MROWS, DM, G, (int)blockIdx.x);
        pg8::EpiF32 E{OUTF, DM};
        pg8::gemm_phase<pg8::EpiF32, pg8::StaticOrder, kALIGN, kSP2>(lds, g, S, E);
    }
    STAMP(13);
    SEAM(6);
    PHASE_LOOP(7) { STAMP(14);
        for (int r = gw; r < MROWS; r += NGW) {
            const int mrow = r < NLAT ? (r >> 12) : 4;
            const float* hin = r < NLAT ? x + (size_t)r * DM : ctxin + (size_t)(r - NLAT) * DM;
            float v[16], h[16]; load_row16(OUTF + (size_t)r * DM, lane, v); load_row16(hin, lane, h);
            const float rinv = row_rinv(v); const float* gt = MOD + mrow * 3072 + 2048;
#pragma unroll
            for (int j = 0; j < 4; ++j) { const int col = j * 256 + lane * 4; const f32x4_t pg = *(const f32x4_t*)(post_g + col), gg = *(const f32x4_t*)(gt + col);
#pragma unroll
                for (int e = 0; e < 4; ++e) h[4 * j + e] += gg[e] * (v[4 * j + e] * rinv * pg[e]);
                if (r < NLAT) *(f32x4_t*)(out + (size_t)r * DM + col) = (f32x4_t){h[4 * j], h[4 * j + 1], h[4 * j + 2], h[4 * j + 3]}; }
            store_modnorm(h, row_rinv(h), pre_g + DM, MOD + (5 + mrow) * 3072, XN + (size_t)r * DM, lane);
        }
    }
    STAMP(15);
    SEAM(7);
    PHASE_LOOP(8) { STAMP(16);
        pg8::Gemm g{XN, (const bf16_t*)(ws + WS_WIN1T), MROWS, N1, DM}; pg8::StaticOrder S; S.init(MROWS, N1, G, (int)blockIdx.x);
        pg8::EpiProj E{PROJ, N1, (bf16_t*)(ws + WS_VT1), 1664, 1792, 128, true, nullptr, 0, 0, 0, 1.f};
        pg8::gemm_phase<pg8::EpiProj, pg8::StaticOrder, kALIGN, kSP2>(lds, g, S, E);
    }
    STAMP(17);
    SEAM(8);
    PHASE_LOOP(9) { STAMP(18); phase9(args, lds, tid, wave, lane, G); }
    STAMP(19);
    SEAM(9);
    PHASE_LOOP(10) { STAMP(20); phase10(args, lds, tid, wave, lane, G); }
    STAMP(21);
    SEAM(10);
    PHASE_LOOP(11) { STAMP(22);
        pg8::Gemm g{YMIX, (const bf16_t*)(ws + WS_WOUT1T), NLAT, DM, DM}; pg8::StaticOrder S; S.init(NLAT, DM, G, (int)blockIdx.x);
        pg8::EpiF32 E{OUTF, DM};
        pg8::gemm_phase<pg8::EpiF32, pg8::StaticOrder, kALIGN, kSP2>(lds, g, S, E);
    }
    STAMP(23);
    SEAM(11);
    PHASE_LOOP(12) { STAMP(24);
        for (int r = gw; r < NLAT; r += NGW) {
            float v[16], h[16]; load_row16(OUTF + (size_t)r * DM, lane, v); load_row16(out + (size_t)r * DM, lane, h);
            const float rinv = row_rinv(v); const float* gt = MOD + (5 + (r >> 12)) * 3072 + 2048;
#pragma unroll
            for (int j = 0; j < 4; ++j) { const int col = j * 256 + lane * 4; const f32x4_t pg = *(const f32x4_t*)(post_g + DM + col), gg = *(const f32x4_t*)(gt + col);
                f32x4_t o;
#pragma unroll
                for (int e = 0; e < 4; ++e) o[e] = h[4 * j + e] + gg[e] * (v[4 * j + e] * rinv * pg[e]);
                *(f32x4_t*)(out + (size_t)r * DM + col) = o; }
        }
    }
    STAMP(25);
#ifdef PROBE_TS_A
    if (blockIdx.x == 0 && tid == 0) { const unsigned dt = MISC[16 + PROBE_TS_B] - MISC[16 + PROBE_TS_A]; out[0] += (float)dt * (0.01f / (float)PROBE_TS_SCALE); }
#endif
#undef IN
#undef SEAM
}
__global__ void k_adaln(const float* c, const float* cctx, const float* ada_w, const float* ada_b, float* mod) {
    const int idx = blockIdx.x * blockDim.x + threadIdx.x;
    if (idx >= 2 * 5 * 3072) return;
    const int col = idx % 3072, r = (idx / 3072) % 5, i = idx / (3072 * 5);
    const float* cv = r < 4 ? c + r * 1024 : cctx;
    const float* W = ada_w + (size_t)i * 1024 * 3072;
    float acc = 0.f;
    for (int k = 0; k < 1024; ++k) acc += silu_f(cv[k]) * W[(size_t)k * 3072 + col];
    mod[idx] = acc + ada_b[i * 3072 + col];
}

__global__ void k_prenorm(const float* lat, const float* ctx, const float* g, const float* mod  , bf16_t* XN) {
    const int r = blockIdx.x * 4 + (threadIdx.x >> 6), lane = threadIdx.x & 63;
    if (r >= MROWS) return;
    const float* src = r < NLAT ? lat + (size_t)r * DM : ctx + (size_t)(r - NLAT) * DM;
    const float* m = mod + (r < NLAT ? (r >> 12) : 4) * 3072;
    float v[16]; float ss = 0.f;
#pragma unroll
    for (int j = 0; j < 4; ++j) { const float4 t = *(const float4*)(src + j * 256 + lane * 4); v[4 * j] = t.x; v[4 * j + 1] = t.y; v[4 * j + 2] = t.z; v[4 * j + 3] = t.w; }
#pragma unroll
    for (int j = 0; j < 16; ++j) ss += v[j] * v[j];
    ss = wave_sum(ss);
    const float rinv = rsqrtf(ss * (1.f / DM) + EPSN);
#pragma unroll
    for (int j = 0; j < 4; ++j)
#pragma unroll
        for (int e = 0; e < 4; ++e) { const int col = j * 256 + lane * 4 + e; const float y = v[4 * j + e] * rinv * g[col] * (1.f + m[1024 + col]) + m[col]; XN[(size_t)r * DM + col] = f2bf(y); }
}

__global__ void k_postnorm(const float* hlat, const float* hctx, const float* OUT, const float* pg, const float* mod, float* olat, float* octx, int nrows) {
    const int r = blockIdx.x * 4 + (threadIdx.x >> 6), lane = threadIdx.x & 63;
    if (r >= nrows) return;
    const float* hin = r < NLAT ? hlat + (size_t)r * DM : hctx + (size_t)(r - NLAT) * DM;
    float* ho = r < NLAT ? olat + (size_t)r * DM : octx + (size_t)(r - NLAT) * DM;
    const float* m = mod + (r < NLAT ? (r >> 12) : 4) * 3072 + 2048;
    const float* src = OUT + (size_t)r * DM;
    float v[16]; float ss = 0.f;
#pragma unroll
    for (int j = 0; j < 4; ++j) { const float4 t = *(const float4*)(src + j * 256 + lane * 4); v[4 * j] = t.x; v[4 * j + 1] = t.y; v[4 * j + 2] = t.z; v[4 * j + 3] = t.w; }
#pragma unroll
    for (int j = 0; j < 16; ++j) ss += v[j] * v[j];
    ss = wave_sum(ss);
    const float rinv = rsqrtf(ss * (1.f / DM) + EPSN);
#pragma unroll
    for (int j = 0; j < 4; ++j)
#pragma unroll
        for (int e = 0; e < 4; ++e) { const int col = j * 256 + lane * 4 + e; ho[col] = hin[col] + m[col] * (v[4 * j + e] * rinv * pg[col]); }
}

enum { GM_PROJ0 = 0, GM_PROJ1 = 1, GM_GLU = 2, GM_F32 = 3 };
struct GemmEpi { bf16_t* P; bf16_t* VT; const bf16_t* YPRE; const bf16_t* PROJ; const float* bglu; bf16_t* YMIX; float* OUT; };
template <int MODE> __global__ void __launch_bounds__(256) k_gemm(const bf16_t* A, const float* W, int M, int N, int K, GemmEpi e) {
    const int tx = threadIdx.x & 15, ty = threadIdx.x >> 4;
    const int c0 = blockIdx.x * 64 + tx * 4, r0 = blockIdx.y * 64 + ty * 4;
    float acc[4][4] = {};
    for (int k = 0; k < K; ++k) {
        const float4 w = *(const float4*)(W + (size_t)k * N + c0);
        const float wv[4] = {rbf(w.x), rbf(w.y), rbf(w.z), rbf(w.w)};
#pragma unroll
        for (int i = 0; i < 4; ++i) { const float a = bf2f(A[(size_t)(r0 + i) * K + k]);
#pragma unroll
            for (int j = 0; j < 4; ++j) acc[i][j] += a * wv[j]; }
    }
#pragma unroll
    for (int i = 0; i < 4; ++i)
#pragma unroll
        for (int j = 0; j < 4; ++j) {
            const int r = r0 + i, c = c0 + j; const float v = acc[i][j];
            if (MODE == GM_PROJ0) { e.P[(size_t)r * N0 + c] = f2bf(v);
                if (c >= 2048 && c < 2560) { const int hd = c - 2048; e.VT[((size_t)(row_batch(r) * 8) * 64 + hd) * POSN + row_pos(r)] = f2bf(v); } }
            else if (MODE == GM_PROJ1) { e.P[(size_t)r * N1 + c] = f2bf(v);
                if (c >= 1664 && c < 1792) { const int hd = c - 1664; e.VT[((size_t)(row_batch(r) * 2) * 64 + hd) * POSN + row_pos(r)] = f2bf(v); } }
            else if (MODE == GM_GLU) { const float y = bf2f(e.YPRE[(size_t)r * 512 + c]); const float ga = bf2f(e.PROJ[(size_t)r * N0 + 512 + c]);
                e.YMIX[(size_t)r * DM + c] = f2bf(y * sigmoid_f(v + e.bglu[c]) * silu_f(ga)); }
            else e.OUT[(size_t)r * N + c] = v;
        }
}

__global__ void __launch_bounds__(64) k_s5_scan(const bf16_t* PROJ, const float* lam_re, const float* lam_im, const float* log_dt, const float* b_re, const float* b_im,
                                                 const float* c_re, const float* c_im, float* YS) {
    const int p = threadIdx.x, id = blockIdx.x, dir = id & 1, g = (id >> 1) & 31, b = id >> 6;
    const int gi = (dir * 32 + g);
    const double lre = lam_re[gi * 64 + p], lim = lam_im[gi * 64 + p], dt = exp((double)log_dt[gi]);
    const double mag = exp(lre * dt); const float ar = (float)(mag * cos(lim * dt)), ai = (float)(mag * sin(lim * dt));
    const double nr = mag * cos(lim * dt) - 1.0, ni = mag * sin(lim * dt), den = lre * lre + lim * lim;
    const float cfr = (float)((nr * lre + ni * lim) / den), cfi = (float)((ni * lre - nr * lim) / den);
    float bbr[16], bbi[16], cr[16], ci[16];
#pragma unroll
    for (int h = 0; h < 16; ++h) { const float br = b_re[(gi * 64 + p) * 16 + h], bi = b_im[(gi * 64 + p) * 16 + h]; bbr[h] = cfr * br - cfi * bi; bbi[h] = cfr * bi + cfi * br;
        cr[h] = c_re[(gi * 16 + h) * 64 + p]; ci[h] = c_im[(gi * 16 + h) * 64 + p]; }
    float hr = 0.f, hi = 0.f;
    float* ys = YS + (size_t)dir * MROWS * 512;
    for (int pos = 0; pos < POSN; ++pos) {
        int row;
        if (dir == 0) row = pos_row(b, pos); else row = pos < LC ? NLAT + b * LC + (LC - 1 - pos) : b * SEQ + (SEQ - 1 - (pos - LC));
        const bf16_t* up = PROJ + (size_t)row * N0 + g * 16;
        float bur = 0.f, bui = 0.f;
#pragma unroll
        for (int h = 0; h < 16; ++h) { const float u = bf2f(up[h]); bur += bbr[h] * u; bui += bbi[h] * u; }
        const float nhr = ar * hr - ai * hi + bur, nhi = ar * hi + ai * hr + bui; hr = nhr; hi = nhi;
        float mine = 0.f;
#pragma unroll
        for (int h = 0; h < 16; ++h) { const float y = wave_sum(cr[h] * hr - ci[h] * hi); if (p == h) mine = y; }
        if (p < 16) ys[(size_t)row * 512 + g * 16 + p] = mine;
    }
}
__global__ void k_s5_finish(const bf16_t* PROJ, const float* YS, const float* dsk, bf16_t* YPRE) {
    const size_t idx = (size_t)blockIdx.x * blockDim.x + threadIdx.x; if (idx >= (size_t)MROWS * 512) return;
    const int ch = idx & 511; const size_t r = idx >> 9;
    const float y = dsk[ch] * bf2f(PROJ[r * N0 + ch]) + YS[idx] + YS[(size_t)MROWS * 512 + idx];
    YPRE[idx] = f2bf(gelu_tanh(y));
}

__global__ void __launch_bounds__(256) k_na_attn(const bf16_t* PROJ, const float* relb, bf16_t* YMIX) {
    const int wv = blockIdx.x * 4 + (threadIdx.x >> 6), lane = threadIdx.x & 63;
    if (wv >= MROWS * 8) return;
    const int h = wv & 7, r = wv >> 3, b = row_batch(r);
    const float q = bf2f(PROJ[(size_t)r * N0 + 1024 + h * 64 + lane]);
    float m = -INFINITY, l = 0.f, o = 0.f;
    if (r < NLAT) {
        const int t = r & 4095, qr = t >> 6, qc = t & 63;
        const int rs = min(max(qr - 4, 0), 56), cs = min(max(qc - 8, 0), 48);
        for (int kr = rs; kr < rs + 8; ++kr)
            for (int kc = cs; kc < cs + 16; ++kc) {
                const size_t kro = (size_t)(b * SEQ + kr * 64 + kc) * N0;
                float s = wave_sum(q * bf2f(PROJ[kro + 1536 + h * 64 + lane])) * 0.125f + relb[(h * 15 + (kr - qr + 7)) * 31 + (kc - qc + 15)];
                const float mn = fmaxf(m, s), al = __expf(m - mn), pp = __expf(s - mn);
                l = l * al + pp; o = o * al + pp * bf2f(PROJ[kro + 2048 + h * 64 + lane]); m = mn;
            }
    }
    for (int c = 0; c < LC; ++c) {
        const size_t kro = (size_t)(NLAT + b * LC + c) * N0;
        const float s = wave_sum(q * bf2f(PROJ[kro + 1536 + h * 64 + lane])) * 0.125f;
        const float mn = fmaxf(m, s), al = __expf(m - mn), pp = __expf(s - mn);
        l = l * al + pp; o = o * al + pp * bf2f(PROJ[kro + 2048 + h * 64 + lane]); m = mn;
    }
    const float gb = bf2f(PROJ[(size_t)r * N0 + 2560 + h * 64 + lane]);
    YMIX[(size_t)r * DM + 512 + h * 64 + lane] = f2bf(o / l * silu_f(gb));
}

__global__ void __launch_bounds__(64) k_lru(const bf16_t* P1, const float* conv_w, const float* conv_b, const float* lam, const float* w_a, const float* b_a,
                                            const float* w_x, const float* b_x, float* HS, bf16_t* YMIX) {
    __shared__ float xs[64];
    const int j = threadIdx.x, nb = blockIdx.x & 7, b = blockIdx.x >> 3, ch = nb * 64 + j;
    const float cw0 = conv_w[0 * 512 + ch], cw1 = conv_w[1 * 512 + ch], cw2 = conv_w[2 * 512 + ch], cw3 = conv_w[3 * 512 + ch], cb = conv_b[ch];
    for (int dir = 0; dir < 2; ++dir) {
        float wa[64], wx[64];
#pragma unroll
        for (int i = 0; i < 64; ++i) { wa[i] = w_a[((dir * 8 + nb) * 64 + i) * 64 + j]; wx[i] = w_x[((dir * 8 + nb) * 64 + i) * 64 + j]; }
        const float ba = b_a[dir * 512 + ch], bx = b_x[dir * 512 + ch];
        const float lm = lam[dir * 512 + ch]; const float sp = (-lm > 20.f) ? -lm : log1pf(__expf(-lm));
        float hst = 0.f;
        for (int pos = 0; pos < POSN; ++pos) {
            int s0, sl, t;
            if (pos < LC) { s0 = NLAT + b * LC; sl = LC; t = dir == 0 ? pos : LC - 1 - pos; }
            else { s0 = b * SEQ; sl = SEQ; t = dir == 0 ? pos - LC : SEQ - 1 - (pos - LC); }
            float xm1 = 0.f, x0, xp1 = 0.f, xp2 = 0.f;
            x0 = bf2f(P1[(size_t)(s0 + t) * N1 + ch]);
            if (t - 1 >= 0) xm1 = bf2f(P1[(size_t)(s0 + t - 1) * N1 + ch]);
            if (t + 1 < sl) xp1 = bf2f(P1[(size_t)(s0 + t + 1) * N1 + ch]);
            if (t + 2 < sl) xp2 = bf2f(P1[(size_t)(s0 + t + 2) * N1 + ch]);
            const float xc = cw0 * xm1 + cw1 * x0 + cw2 * xp1 + cw3 * xp2 + cb;
            __syncthreads(); xs[j] = xc; __syncthreads();
            float ga = ba, gx = bx;
#pragma unroll
            for (int i = 0; i < 64; ++i) { const float xi = xs[i]; ga += xi * wa[i]; gx += xi * wx[i]; }
            const float gr = sigmoid_f(ga), gi = sigmoid_f(gx);
            const float log_a = -8.f * gr * sp; const float a = __expf(log_a); const float mult = sqrtf(fmaxf(-expm1f(2.f * log_a), 0.f));
            hst = a * hst + mult * gi * xc;
            if (pos >= LC) { const size_t rr = (size_t)(s0 + t);
                if (dir == 0) HS[rr * 512 + ch] = hst;
                else { const float gc = bf2f(P1[rr * N1 + 512 + ch]); YMIX[rr * DM + ch] = f2bf((HS[rr * 512 + ch] + hst) * silu_f(gc)); } }
        }
    }
}

__global__ void __launch_bounds__(256) k_qkprep(const bf16_t* P1, const float* qn, const float* kn, bf16_t* QP, bf16_t* KP) {
    const int wv = blockIdx.x * 4 + (threadIdx.x >> 6), lane = threadIdx.x & 63;
    if (wv >= MROWS * 10) return;
    const int slot = wv % 10, r = wv / 10, b = row_batch(r);
    if (slot < 8 && r >= NLAT) return;
    const int col0 = slot < 8 ? 1024 + slot * 64 : 1536 + (slot - 8) * 64;
    const float x = bf2f(P1[(size_t)r * N1 + col0 + lane]);
    const float ss = wave_sum(x * x);
    float y = x * rsqrtf(ss * (1.f / 64.f) + EPSN) * (slot < 8 ? qn[lane] : kn[lane]);
    if (r < NLAT) {
        const int t = r & 4095, i = lane >> 1, f = i & 15; const float pos = (float)(i < 16 ? (t >> 6) : (t & 63));
        const float inv = (float)exp(-log(10000.0) * (double)(2 * f) / 32.0);
        const float ang = pos * inv; const float cs = cosf(ang), sn = sinf(ang);
        const float pr = __shfl_xor(y, 1);
        y = (lane & 1) ? (pr * sn + y * cs) : (y * cs - pr * sn);
    }
    if (slot < 8) QP[((size_t)(b * 8 + slot) * SEQ + (r & 4095)) * 64 + lane] = f2bf(y * (0.125f * LOG2E));
    else KP[((size_t)(b * 2 + (slot - 8)) * POSN + row_pos(r)) * 64 + lane] = f2bf(y);
}

__global__ void __launch_bounds__(256) k_gqa(const bf16_t* QP, const bf16_t* KP, const bf16_t* P1, bf16_t* YMIX) {
    const int wv = blockIdx.x * 4 + (threadIdx.x >> 6), lane = threadIdx.x & 63;
    if (wv >= NLAT * 8) return;
    const int hq = wv & 7, r = wv >> 3, b = r >> 12, t = r & 4095, kvh = hq >> 2;
    const float q = bf2f(QP[((size_t)(b * 8 + hq) * SEQ + t) * 64 + lane]);
    const bf16_t* kp = KP + (size_t)(b * 2 + kvh) * POSN * 64;
    float m = -INFINITY, l = 0.f, o = 0.f;
    for (int pos = 0; pos < POSN; ++pos) {
        const float s = wave_sum(q * bf2f(kp[(size_t)pos * 64 + lane]));
        const float v = bf2f(P1[(size_t)pos_row(b, pos) * N1 + 1664 + kvh * 64 + lane]);
        const float mn = fmaxf(m, s), al = exp2f(m - mn), pp = exp2f(s - mn);
        l = l * al + pp; o = o * al + pp * v; m = mn;
    }
    const float gd = bf2f(P1[(size_t)r * N1 + 1792 + hq * 64 + lane]);
    YMIX[(size_t)r * DM + 512 + hq * 64 + lane] = f2bf(o / l * silu_f(gd));
}

static int g_grid = 0;
static void launch_mega(Args a, int lo, int hi, int li, hipStream_t stream) {
    a.ph_lo = lo; a.ph_hi = hi; a.li = li;
    hipLaunchKernelGGL(mega, dim3(g_grid), dim3(NTHREADS), LDS_BYTES, stream, a);
    const hipError_t le = hipPeekAtLastError();
    if (le != hipSuccess) fprintf(stderr, "kernel_launch: mega[%d,%d) failed: %s\n", lo, hi, hipGetErrorName(le));
}
extern "C" void kernel_launch(void* const* d_in, const int* in_sizes, int n_in, void* d_out, int out_size, void* d_ws, size_t ws_size, hipStream_t stream) {
    if (g_grid == 0) {
        int dev = 0, cus = 0;
        if (hipGetDevice(&dev) != hipSuccess || hipDeviceGetAttribute(&cus, hipDeviceAttributeMultiprocessorCount, dev) != hipSuccess) { fprintf(stderr, "kernel_launch: device query failed\n"); g_grid = -1; return; }
        if (hipFuncSetAttribute((const void*)mega, hipFuncAttributeMaxDynamicSharedMemorySize, LDS_BYTES) != hipSuccess) { fprintf(stderr, "kernel_launch: hipFuncSetAttribute failed\n"); g_grid = -1; return; }
        int per_cu = 0;
        if (hipOccupancyMaxActiveBlocksPerMultiprocessor(&per_cu, (const void*)mega, NTHREADS, LDS_BYTES) != hipSuccess || per_cu < 1) fprintf(stderr, "kernel_launch: occupancy query says %d blocks/CU\n", per_cu);
        (void)hipGetLastError();
        g_grid = cus;
    }
    if (g_grid < 0) return;
    const float* x = (const float*)d_in[0]; const float* c = (const float*)d_in[1]; const float* ctx = (const float*)d_in[2]; const float* cctx = (const float*)d_in[3];
    const float* ada_w = (const float*)d_in[4]; const float* ada_b = (const float*)d_in[5]; const float* pre_g = (const float*)d_in[6]; const float* post_g = (const float*)d_in[7];
    const float* ev_w_in = (const float*)d_in[8]; const float* ev_w_out = (const float*)d_in[9];
    const float* s5_lre = (const float*)d_in[10]; const float* s5_lim = (const float*)d_in[11]; const float* s5_ldt = (const float*)d_in[12];
    const float* s5_bre = (const float*)d_in[13]; const float* s5_bim = (const float*)d_in[14]; const float* s5_cre = (const float*)d_in[15]; const float* s5_cim = (const float*)d_in[16];
    const float* s5_d = (const float*)d_in[17]; const float* s5_wglu = (const float*)d_in[18]; const float* s5_bglu = (const float*)d_in[19]; const float* relb = (const float*)d_in[20];
    const float* od_w_in = (const float*)d_in[21]; const float* od_w_out = (const float*)d_in[22]; const float* conv_w = (const float*)d_in[23]; const float* conv_b = (const float*)d_in[24];
    const float* lru_lam = (const float*)d_in[25]; const float* w_a = (const float*)d_in[26]; const float* b_a = (const float*)d_in[27]; const float* w_x = (const float*)d_in[28]; const float* b_x = (const float*)d_in[29];
    const float* qn = (const float*)d_in[30]; const float* kn = (const float*)d_in[31];
    char* ws = (char*)d_ws; float* out = (float*)d_out;
    float* MOD = (float*)(ws + WS_MOD); float* HC1 = (float*)(ws + WS_HC1);
    bf16_t* XN = (bf16_t*)(ws + WS_XN); bf16_t* YMIX = (bf16_t*)(ws + WS_YMIX); bf16_t* PROJ = (bf16_t*)(ws + WS_PROJ); float* OUTF = (float*)(ws + WS_PROJ);
    bf16_t* VT0 = (bf16_t*)(ws + WS_VT0); bf16_t* YPRE = (bf16_t*)(ws + WS_YPRE); bf16_t* QP = (bf16_t*)(ws + WS_QP); bf16_t* KP = (bf16_t*)(ws + WS_KP); bf16_t* VT1 = (bf16_t*)(ws + WS_VT1);
    float* YS = (float*)(ws + WS_YS); float* HS = (float*)(ws + WS_HS);
    (void)x; (void)c; (void)ctx; (void)cctx; (void)ada_w; (void)ada_b; (void)pre_g; (void)post_g; (void)ev_w_in; (void)ev_w_out; (void)s5_wglu; (void)od_w_in; (void)od_w_out; (void)MOD; (void)HC1; (void)XN; (void)OUTF; (void)VT0; (void)VT1; (void)out;

    if (hipMemsetAsync(ws + WS_CTL, 0, CTL_ZERO_BYTES, stream) != hipSuccess) { fprintf(stderr, "kernel_launch: memset failed\n"); return; }
    Args a{};
    for (int i = 0; i < 32; ++i) a.in[i] = (const float*)d_in[i];
    a.out = (float*)d_out; a.ws = (unsigned char*)d_ws;

    launch_mega(a, 0, N_PHASES, 0, stream);
    (void)relb; (void)conv_w; (void)conv_b; (void)lru_lam; (void)w_a; (void)b_a; (void)w_x; (void)b_x; (void)HS; (void)qn; (void)kn; (void)QP; (void)KP;
    (void)s5_lre; (void)s5_lim; (void)s5_ldt; (void)s5_bre; (void)s5_bim; (void)s5_cre; (void)s5_cim; (void)s5_d; (void)s5_bglu; (void)YS; (void)YPRE; (void)PROJ; (void)YMIX;
}
```
